# Optimizing an MI355X kernel written in HIP

```python
import jax
import jax.numpy as jnp
from jax import lax
import numpy as np

D_MODEL = 1024
BATCH = 32
SEQ = 2048
DEPTH = 1
DEC_BATCH = 2
DEC_SEQ = 16384
PAST_LEN = 128

D_MIX = D_MODEL
GLA_HEADS = 4
GLA_V = D_MIX // 2
GLA_DV = GLA_V // GLA_HEADS
GLA_DK = GLA_DV // 2
GLA_QK = GLA_HEADS * GLA_DK
GLA_LOWRANK = 16
GLA_NORMALIZER = 16.0
LOG_GATE_MIN = -1.0
RET_HEADS = 4
RET_V = D_MIX - GLA_V
RET_DV = RET_V // RET_HEADS
RET_DK = RET_DV
RET_QK = RET_HEADS * RET_DK
CHUNK = 64
D_FF = 4 * D_MODEL
ROPE_BASE = 10000.0
EPS = 1e-6
IN_WIDTHS = (GLA_QK, GLA_QK, GLA_V, GLA_V, GLA_LOWRANK, GLA_LOWRANK, RET_QK, RET_QK, RET_V, RET_V)
D_IN = 2 * GLA_QK + 2 * GLA_V + 2 * GLA_LOWRANK + 2 * RET_QK + 2 * RET_V

kernel_name = "hybrid_gla_retention_encoder"


def rmsnorm(x, w):
    x32 = x.astype(jnp.float32)
    y = x32 * lax.rsqrt(jnp.mean(x32 * x32, axis=-1, keepdims=True) + EPS)
    return (y * w.astype(jnp.float32)).astype(x.dtype)


def head_rmsnorm(o, w):
    return o * lax.rsqrt(jnp.mean(o * o, axis=-1, keepdims=True) + EPS) * w.astype(jnp.float32)


def head_groupnorm(o, w, b):
    H, dv = o.shape[-2], o.shape[-1]
    mu = jnp.mean(o, axis=-1, keepdims=True)
    var = jnp.mean(jnp.square(o - mu), axis=-1, keepdims=True)
    y = (o - mu) * lax.rsqrt(var + EPS)
    return y * w.astype(jnp.float32).reshape(H, dv) + b.astype(jnp.float32).reshape(H, dv)


def rotary(x, pos):
    half = x.shape[-1] // 2
    inv_freq = jnp.power(ROPE_BASE, -jnp.arange(half, dtype=jnp.float32) / half)
    ang = pos[:, None] * inv_freq[None, :]
    cos = jnp.cos(ang)[None, :, None, :]
    sin = jnp.sin(ang)[None, :, None, :]
    x1, x2 = x[..., :half], x[..., half:]
    return jnp.concatenate([x1 * cos - x2 * sin, x1 * sin + x2 * cos], axis=-1)


def split_columns(proj):
    outs = []
    start = 0
    for width in IN_WIDTHS:
        outs.append(proj[..., start:start + width])
        start += width
    return outs


def chunked_gated_recurrence(q, k, v, log_a, inclusive):
    B, L, H, dk = q.shape
    dv = v.shape[-1]
    n = L // CHUNK

    def blk(t):
        return t.astype(jnp.float32).reshape(B, n, CHUNK, H, t.shape[-1])

    q, k, v, log_a = blk(q), blk(k), blk(v), blk(log_a)
    b = jnp.cumsum(log_a, axis=2)
    b_last = b[:, :, -1:]
    q_dec = q * jnp.exp(b)
    k_inv = k * jnp.exp(-b)
    k_end = k * jnp.exp(b_last - b)
    scores = jnp.einsum('bncht,bnsht->bnhcs', q_dec, k_inv)
    mask = jnp.tril(jnp.ones((CHUNK, CHUNK), dtype=bool), k=0 if inclusive else -1)
    scores = jnp.where(mask, scores, 0.0)
    o_intra = jnp.einsum('bnhcs,bnshv->bnchv', scores, v)
    chunk_kv = jnp.einsum('bncht,bnchv->bnhtv', k_end, v)
    chunk_decay = jnp.exp(b_last[:, :, 0])

    def step(state, inp):
        kv, dec = inp
        return dec[..., None] * state + kv, state

    init = jnp.zeros((B, H, dk, dv), jnp.float32)
    _, states = lax.scan(step, init, (jnp.moveaxis(chunk_kv, 1, 0), jnp.moveaxis(chunk_decay, 1, 0)))
    states = jnp.moveaxis(states, 0, 1)
    o_inter = jnp.einsum('bncht,bnhtv->bnchv', q_dec, states)
    return (o_intra + o_inter).reshape(B, L, H, dv)


def bidirectional_recurrence(q, k, v, log_a_fwd, log_a_bwd):
    flip = lambda t: jnp.flip(t, axis=1)
    fwd = chunked_gated_recurrence(q, k, v, log_a_fwd, True)
    bwd = flip(chunked_gated_recurrence(flip(q), flip(k), flip(v), flip(log_a_bwd), False))
    return fwd + bwd


def encoder_layer(x, attn_norm_w, w_in, w_alpha_fwd, b_alpha_fwd, w_alpha_bwd, b_alpha_bwd,
                  gla_norm_w, ret_norm_w, ret_norm_b, w_out, mlp_norm_w, w_ff1, w_ff2):
    B, L, _ = x.shape
    f32 = jnp.float32
    h = rmsnorm(x, attn_norm_w)
    proj = jnp.einsum('bld,de->ble', h, w_in)
    gq, gk, gv, gg, ga_f, ga_b, rq, rk, rv, rg = split_columns(proj)

    def heads(t, n_heads):
        return t.astype(f32).reshape(B, L, n_heads, -1)

    gla_q = heads(gq, GLA_HEADS) * GLA_DK ** -0.5
    gla_k = heads(gk, GLA_HEADS)
    gla_v = heads(gv, GLA_HEADS)

    def log_gate(lr, w, b):
        z = jnp.einsum('blr,rk->blk', lr.astype(f32), w.astype(f32)) + b.astype(f32)
        log_a = jnp.maximum(jax.nn.log_sigmoid(z) / GLA_NORMALIZER, LOG_GATE_MIN)
        return log_a.reshape(B, L, GLA_HEADS, GLA_DK)

    log_a_f = log_gate(ga_f, w_alpha_fwd, b_alpha_fwd)
    log_a_b = log_gate(ga_b, w_alpha_bwd, b_alpha_bwd)
    o_gla = bidirectional_recurrence(gla_q, gla_k, gla_v, log_a_f, log_a_b)
    o_gla = head_rmsnorm(o_gla, gla_norm_w).reshape(B, L, GLA_V) * jax.nn.silu(gg.astype(f32))

    pos = jnp.arange(L, dtype=f32)
    ret_q = rotary(heads(rq, RET_HEADS), pos) * RET_DK ** -0.5
    ret_k = rotary(heads(rk, RET_HEADS), pos)
    ret_v = heads(rv, RET_HEADS)
    log_gamma = jnp.log1p(-jnp.power(2.0, -5.0 - jnp.arange(RET_HEADS, dtype=f32)))
    log_decay = jnp.broadcast_to(log_gamma[None, None, :, None], (B, L, RET_HEADS, RET_DK))
    o_ret = bidirectional_recurrence(ret_q, ret_k, ret_v, log_decay, log_decay)
    o_ret = head_groupnorm(o_ret, ret_norm_w, ret_norm_b).reshape(B, L, RET_V) * jax.nn.silu(rg.astype(f32))

    mixed = jnp.concatenate([o_gla, o_ret], axis=-1).astype(x.dtype)
    x = x + jnp.einsum('ble,ed->bld', mixed, w_out)

    h = rmsnorm(x, mlp_norm_w)
    ff = jnp.square(jax.nn.relu(jnp.einsum('bld,df->blf', h, w_ff1)))
    return x + jnp.einsum('blf,fd->bld', ff, w_ff2)


def trunk(x, attn_norm_w, w_in, w_alpha_fwd, b_alpha_fwd, w_alpha_bwd, b_alpha_bwd,
          gla_norm_w, ret_norm_w, ret_norm_b, w_out, mlp_norm_w, w_ff1, w_ff2, final_norm_w):
    for l in range(DEPTH):
        x = encoder_layer(x, attn_norm_w[l], w_in[l], w_alpha_fwd[l], b_alpha_fwd[l],
                          w_alpha_bwd[l], b_alpha_bwd[l], gla_norm_w[l], ret_norm_w[l],
                          ret_norm_b[l], w_out[l], mlp_norm_w[l], w_ff1[l], w_ff2[l])
    return rmsnorm(x, final_norm_w)


def setup_inputs(seed: int = 0) -> dict:
    key = jax.random.key(seed)
    ks = jax.random.split(key, 16)
    f32 = jnp.float32
    nrm = lambda k, shape: jax.random.normal(k, shape, f32)
    return {
        'x_prompt': nrm(ks[0], (BATCH, SEQ, D_MODEL)),
        'x_sample': nrm(ks[1], (DEC_BATCH, DEC_SEQ, D_MODEL)),
        'attn_norm_w': 1.0 + 0.02 * nrm(ks[2], (DEPTH, D_MODEL)),
        'w_in': nrm(ks[3], (DEPTH, D_MODEL, D_IN)) * D_MODEL ** -0.5,
        'w_alpha_fwd': nrm(ks[4], (DEPTH, GLA_LOWRANK, GLA_QK)) * GLA_LOWRANK ** -0.5,
        'b_alpha_fwd': 0.1 * nrm(ks[5], (DEPTH, GLA_QK)),
        'w_alpha_bwd': nrm(ks[6], (DEPTH, GLA_LOWRANK, GLA_QK)) * GLA_LOWRANK ** -0.5,
        'b_alpha_bwd': 0.1 * nrm(ks[7], (DEPTH, GLA_QK)),
        'gla_norm_w': 1.0 + 0.02 * nrm(ks[8], (DEPTH, GLA_DV)),
        'ret_norm_w': 1.0 + 0.02 * nrm(ks[9], (DEPTH, RET_V)),
        'ret_norm_b': 0.02 * nrm(ks[10], (DEPTH, RET_V)),
        'w_out': nrm(ks[11], (DEPTH, D_MIX, D_MODEL)) * D_MIX ** -0.5,
        'mlp_norm_w': 1.0 + 0.02 * nrm(ks[12], (DEPTH, D_MODEL)),
        'w_ff1': nrm(ks[13], (DEPTH, D_MODEL, D_FF)) * D_MODEL ** -0.5,
        'w_ff2': nrm(ks[14], (DEPTH, D_FF, D_MODEL)) * D_FF ** -0.5,
        'final_norm_w': 1.0 + 0.02 * nrm(ks[15], (D_MODEL,)),
    }


def reference(x_prompt, x_sample, attn_norm_w, w_in, w_alpha_fwd, b_alpha_fwd, w_alpha_bwd, b_alpha_bwd,
              gla_norm_w, ret_norm_w, ret_norm_b, w_out, mlp_norm_w, w_ff1, w_ff2, final_norm_w):
    y_prompt = trunk(x_prompt, attn_norm_w, w_in, w_alpha_fwd, b_alpha_fwd, w_alpha_bwd, b_alpha_bwd,
                     gla_norm_w, ret_norm_w, ret_norm_b, w_out, mlp_norm_w, w_ff1, w_ff2, final_norm_w)
    y_sample = trunk(x_sample, attn_norm_w, w_in, w_alpha_fwd, b_alpha_fwd, w_alpha_bwd, b_alpha_bwd,
                     gla_norm_w, ret_norm_w, ret_norm_b, w_out, mlp_norm_w, w_ff1, w_ff2, final_norm_w)
    return (y_prompt, y_sample)
```

```cpp
#include <hip/hip_runtime.h>
#include <cstdio>
#ifndef MK_SINGLE
#define MK_SINGLE 1
#endif
namespace pg8 {
#define PG8_LAS __attribute__((address_space(3)))
typedef unsigned short bf16_t;
typedef short bf16x8 __attribute__((ext_vector_type(8)));
typedef float f32x4 __attribute__((ext_vector_type(4)));
typedef unsigned u32x4 __attribute__((ext_vector_type(4)));
constexpr int BM = 256, BK = 64, HALF = 128, HTB = HALF * BK * 2  , STAGE_BYTES = 8 * HTB, NXCD = 8, WGM = 8;

__host__ __device__ __forceinline__ int lds_byte(int r, int c) { const int st = (r >> 4) * 2 + (c >> 5), rr = r & 15, cc = c & 31, ob = rr * 64 + cc * 2; return st * 1024 + (ob ^ (((ob >> 9) & 1) << 5)); }
__host__ __device__ __forceinline__ void stage_rc(int b, int& R, int& C) { const int st = b / 1024, sb = b % 1024, swz = sb ^ (((sb >> 9) & 1) << 5); R = (st >> 1) * 16 + swz / 64; C = (st & 1) * 32 + (swz % 64) / 2; }
__host__ __device__ __forceinline__ int perm32(int rho) { const int n = rho >> 4, i = rho & 15; return 8 * (i >> 2) + 4 * n + (i & 3); }

struct Unit { int pm, pn; };
struct Gemm { const bf16_t* A; const bf16_t* Bt; int M, N, K, lda; };

struct StaticOrder {
    int nM, nN, nwg, G, c;
    __host__ __device__ void init(int M, int N, int G_, int c_) { nM = M / BM; nN = N / BM; nwg = nM * nN; G = G_; c = c_; }
    __host__ __device__ bool next(int i, Unit& u) const {
        const long L = (long)i * G + c; if (L >= nwg) return false;
        int wgid = (int)L; { const int q = nwg / NXCD, r = nwg % NXCD, xcd = wgid % NXCD, off = wgid / NXCD; wgid = (xcd < r ? xcd * (q + 1) : r * (q + 1) + (xcd - r) * q) + off; }
        const int nig = WGM * nN, gid = wgid / nig, fm = gid * WGM, gsz = (nM - fm) < WGM ? (nM - fm) : WGM;
        u.pm = fm + ((wgid % nig) % gsz); u.pn = (wgid % nig) / gsz; return true;
    }
    __device__ __forceinline__ void a_ready(const Unit&) const {}
    __device__ __forceinline__ void done(const Unit&) const {}
};

__device__ __forceinline__ unsigned cvt_pk_bf16(float lo, float hi) { unsigned r; asm volatile("v_cvt_pk_bf16_f32 %0, %1, %2" : "=v"(r) : "v"(lo), "v"(hi)); return r; }
__device__ __forceinline__ u32x4 pack8(const f32x4& a, const f32x4& b) { u32x4 w; w.x = cvt_pk_bf16(a[0], a[1]); w.y = cvt_pk_bf16(a[2], a[3]); w.z = cvt_pk_bf16(b[0], b[1]); w.w = cvt_pk_bf16(b[2], b[3]); return w; }
constexpr int NPROJ = 3584, DMODEL = 1024, DFF = 4096, MPROMPT = 65536;

struct EpiInProj {
    static constexpr bool PERM = true, AFTER_DRAIN = false;
    bf16_t* P; const float* rstd; const float* rcos; const float* rsin;
    __device__ __forceinline__ void operator()(const f32x4 (&acc)[2][2][4][2], const Unit& u, int wr, int wc, int fr, int fq) const {
        const int row0 = u.pm * BM + wr * 64 + fr, colb = u.pn * BM + wc * 32 + 8 * fq;
        const bool rot = (u.pn >= 8) && (u.pn < 12);
        const int i0 = (4 * wc + fq) * 4;
#pragma unroll
        for (int ai = 0; ai < 2; ++ai)
#pragma unroll
            for (int m = 0; m < 4; ++m) {
                const int row = row0 + ai * HALF + m * 16;
                const float rs = rstd[row];
                const int pos = row < MPROMPT ? (row & 2047) : (row & 16383);
                bf16_t* rowp = P + (size_t)row * NPROJ + colb;
                f32x4 c4 = (f32x4){1.f, 1.f, 1.f, 1.f}, s4 = (f32x4){0.f, 0.f, 0.f, 0.f};
                if (rot) { c4 = *(const f32x4*)(rcos + pos * 64 + i0); s4 = *(const f32x4*)(rsin + pos * 64 + i0); }
#pragma unroll
                for (int bj = 0; bj < 2; ++bj) {
                    f32x4 v0 = acc[ai][bj][m][0] * rs, v1 = acc[ai][bj][m][1] * rs;
                    if (rot) { const f32x4 lo = v0 * c4 - v1 * s4, hi = v0 * s4 + v1 * c4; v0 = lo; v1 = hi; }
                    *(u32x4*)(rowp + bj * HALF) = pack8(v0, v1);
                }
            }
    }
};
struct EpiResid {
    static constexpr bool PERM = true, AFTER_DRAIN = false;
    const float* xp; const float* xs; float* out; bf16_t* A2; float* sq;
    __device__ __forceinline__ void operator()(const f32x4 (&acc)[2][2][4][2], const Unit& u, int wr, int wc, int fr, int fq) const {
        const int row0 = u.pm * BM + wr * 64 + fr, colb = u.pn * BM + wc * 32 + 8 * fq;
#pragma unroll
        for (int ai = 0; ai < 2; ++ai)
#pragma unroll
            for (int m = 0; m < 4; ++m) {
                const int row = row0 + ai * HALF + m * 16;
                const float* xrow = (row < MPROMPT ? xp + (size_t)row * DMODEL : xs + (size_t)(row - MPROMPT) * DMODEL) + colb;
                float* orow = out + (size_t)row * DMODEL + colb;
                float ss = 0.f;
#pragma unroll
                for (int bj = 0; bj < 2; ++bj) {
                    const f32x4 x0 = *(const f32x4*)(xrow + bj * HALF), x1 = *(const f32x4*)(xrow + bj * HALF + 4);
                    const f32x4 v0 = acc[ai][bj][m][0] + x0, v1 = acc[ai][bj][m][1] + x1;
                    *(f32x4*)(orow + bj * HALF) = v0; *(f32x4*)(orow + bj * HALF + 4) = v1;
                    if (A2) *(u32x4*)(A2 + (size_t)row * DMODEL + colb + bj * HALF) = pack8(v0, v1);
                    ss += (v0[0] * v0[0] + v0[1] * v0[1]) + (v0[2] * v0[2] + v0[3] * v0[3]) + (v1[0] * v1[0] + v1[1] * v1[1]) + (v1[2] * v1[2] + v1[3] * v1[3]);
                }
                ss += __shfl_xor(ss, 16); ss += __shfl_xor(ss, 32);
                if (fq == 0) sq[(size_t)row * 16 + u.pn * 4 + wc] = ss;
            }
    }
};
struct EpiFF1 {
    static constexpr bool PERM = true, AFTER_DRAIN = false;
    bf16_t* H; const float* sq;
    __device__ __forceinline__ void operator()(const f32x4 (&acc)[2][2][4][2], const Unit& u, int wr, int wc, int fr, int fq) const {
        const int row0 = u.pm * BM + wr * 64 + fr, colb = u.pn * BM + wc * 32 + 8 * fq;
#pragma unroll
        for (int ai = 0; ai < 2; ++ai)
#pragma unroll
            for (int m = 0; m < 4; ++m) {
                const int row = row0 + ai * HALF + m * 16;
                const f32x4* s4 = (const f32x4*)(sq + (size_t)row * 16);
                const f32x4 t = (s4[0] + s4[1]) + (s4[2] + s4[3]);
                const float r2 = 1.0f / (((t[0] + t[1]) + (t[2] + t[3])) * (1.0f / 1024.0f) + 1e-6f);
                bf16_t* rowp = H + (size_t)row * DFF + colb;
#pragma unroll
                for (int bj = 0; bj < 2; ++bj) {
                    f32x4 v0 = acc[ai][bj][m][0], v1 = acc[ai][bj][m][1];
#pragma unroll
                    for (int j = 0; j < 4; ++j) { const float a = fmaxf(v0[j], 0.f), b = fmaxf(v1[j], 0.f); v0[j] = a * a * r2; v1[j] = b * b * r2; }
                    *(u32x4*)(rowp + bj * HALF) = pack8(v0, v1);
                }
            }
    }
};
template <class Epi, class Sched, bool ALIGN_EPI = false, bool SP2 = false>
__device__ __forceinline__ void gemm_phase(PG8_LAS unsigned char* lds, const Gemm g, const Sched& S, const Epi& E) {
    const int tid = threadIdx.x, wid = __builtin_amdgcn_readfirstlane(tid >> 6), lane = tid & 63, wr = wid >> 2, wc = wid & 3, fr = lane & 15, fq = lane >> 4;
    const int K = g.K, nt = K / BK;
    unsigned voffA[2], voffB[2];
#pragma unroll
    for (int i = 0; i < 2; ++i) { int R, C; stage_rc(tid * 16 + i * 8192, R, C); const int Rb = Epi::PERM ? ((R & ~31) + perm32(R & 31)) : R;
        voffA[i] = (unsigned)(R * g.lda + C) * 2u; voffB[i] = (unsigned)(Rb * K + C) * 2u; }
    const size_t kstep = (size_t)(BK * 2);
    const size_t hstepB = (size_t)HALF * K * 2, hstepA = (size_t)HALF * g.lda * 2;
    const size_t tstepB = 2 * hstepB, tstepA = 2 * hstepA;
    const unsigned ldsw = (unsigned)wid * 1024u;
    const int aoff = lds_byte(wr * 64 + fr, fq * 8), boff = lds_byte(wc * 32 + fr, fq * 8);
#define PG8_SA(b, h) (((b) * 2 + (h)) * HTB)
#define PG8_SB(b, h) ((4 + (b) * 2 + (h)) * HTB)
#define PG8_STAGE(bufoff, gbase, voff) do { _Pragma("unroll") for (int _i = 0; _i < 2; ++_i) \
        __builtin_amdgcn_global_load_lds((const unsigned*)((const char*)(gbase) + (voff)[_i]), (PG8_LAS unsigned*)(lds + (bufoff) + ldsw + _i * 8192), 16, 0, 0); } while (0)
#define PG8_LDA(dst, b, h) do { _Pragma("unroll") for (int m = 0; m < 4; ++m) _Pragma("unroll") for (int k = 0; k < 2; ++k) dst[m][k] = *(const PG8_LAS bf16x8*)(lds + PG8_SA(b, h) + aoff + m * 2048 + k * 1024); } while (0)
#define PG8_LDB(dst, b, h) do { _Pragma("unroll") for (int n = 0; n < 2; ++n) _Pragma("unroll") for (int k = 0; k < 2; ++k) dst[n][k] = *(const PG8_LAS bf16x8*)(lds + PG8_SB(b, h) + boff + n * 2048 + k * 1024); } while (0)
#define PG8_MMA(ai, bj, At, Bt) do { __builtin_amdgcn_s_setprio(1); _Pragma("unroll") for (int m = 0; m < 4; ++m) _Pragma("unroll") for (int n = 0; n < 2; ++n) _Pragma("unroll") for (int k = 0; k < 2; ++k) \
        acc[ai][bj][m][n] = __builtin_amdgcn_mfma_f32_16x16x32_bf16(Bt[n][k], At[m][k], acc[ai][bj][m][n], 0, 0, 0); __builtin_amdgcn_s_setprio(0); } while (0)
#define PG8_WAIT_V(n) asm volatile("s_waitcnt vmcnt(" #n ")" ::: "memory")
#define PG8_WAIT_L(n) asm volatile("s_waitcnt lgkmcnt(" #n ")" ::: "memory")
#define PG8_BAR __builtin_amdgcn_s_barrier()
#define PG8_SCHED __builtin_amdgcn_sched_barrier(0)
    Unit cur, nxt; int ui = 0;
    if (!S.next(0, cur)) return;
    f32x4 acc[2][2][4][2];
#pragma unroll
    for (int a = 0; a < 2; ++a)
#pragma unroll
        for (int b = 0; b < 2; ++b)
#pragma unroll
            for (int m = 0; m < 4; ++m)
#pragma unroll
                for (int n = 0; n < 2; ++n) acc[a][b][m][n] = (f32x4){0.f, 0.f, 0.f, 0.f};
    bf16x8 At[4][2], B0[2][2], B1[2][2];
    const char* cA = (const char*)g.A + (size_t)cur.pm * tstepA; const char* cB = (const char*)g.Bt + (size_t)cur.pn * tstepB;
    S.a_ready(cur);
    if constexpr (SP2) {
        PG8_STAGE(PG8_SB(0, 0), cB, voffB); PG8_STAGE(PG8_SB(0, 1), cB + hstepB, voffB); PG8_STAGE(PG8_SA(0, 0), cA, voffA); PG8_STAGE(PG8_SA(0, 1), cA + hstepA, voffA);
        if (wr == 1) PG8_BAR;
        PG8_WAIT_V(2); PG8_BAR;
        PG8_STAGE(PG8_SB(1, 0), cB + kstep, voffB); PG8_STAGE(PG8_SA(1, 0), cA + kstep, voffA); PG8_STAGE(PG8_SB(1, 1), cB + hstepB + kstep, voffB);
        PG8_WAIT_V(6); PG8_BAR;
    } else {
        PG8_STAGE(PG8_SB(0, 0), cB, voffB); PG8_STAGE(PG8_SA(0, 0), cA, voffA); PG8_STAGE(PG8_SB(0, 1), cB + hstepB, voffB); PG8_STAGE(PG8_SA(0, 1), cA + hstepA, voffA);
        if (wr == 1) PG8_BAR;
        PG8_WAIT_V(4); PG8_BAR;
        PG8_STAGE(PG8_SB(1, 0), cB + kstep, voffB); PG8_STAGE(PG8_SA(1, 0), cA + kstep, voffA); PG8_STAGE(PG8_SB(1, 1), cB + hstepB + kstep, voffB);
        PG8_WAIT_V(6); PG8_BAR;
    }
    for (;;) {
        const bool has_next = S.next(ui + 1, nxt);
        const char* nA = has_next ? (const char*)g.A + (size_t)nxt.pm * tstepA : cA; const char* nB = has_next ? (const char*)g.Bt + (size_t)nxt.pn * tstepB : cB;
        for (int t = 0; t < nt; t += 2) {
            const bool last = (t == nt - 2);
            const char* a1 = cA + (size_t)(t + 1) * kstep;
            const char* a2 = last ? nA : cA + (size_t)(t + 2) * kstep; const char* b2 = last ? nB : cB + (size_t)(t + 2) * kstep;
            const char* a3 = a2 + kstep; const char* b3 = b2 + kstep;
            if (last && has_next) S.a_ready(nxt);
            if constexpr (SP2) {
            PG8_LDB(B0, 0, 0); PG8_LDB(B1, 0, 1); PG8_SCHED; PG8_LDA(At, 0, 0); PG8_STAGE(PG8_SA(1, 1), a1 + hstepA, voffA);
            PG8_WAIT_V(8); PG8_WAIT_L(0); PG8_BAR; PG8_MMA(0, 0, At, B0); PG8_MMA(0, 1, At, B1); PG8_BAR; PG8_SCHED;
            PG8_LDA(At, 0, 1); PG8_STAGE(PG8_SB(0, 0), b2, voffB); PG8_STAGE(PG8_SB(0, 1), b2 + hstepB, voffB); PG8_STAGE(PG8_SA(0, 0), a2, voffA);
            PG8_WAIT_V(8); PG8_WAIT_L(0); PG8_BAR; PG8_MMA(1, 0, At, B0); PG8_MMA(1, 1, At, B1); PG8_BAR; PG8_SCHED;
            PG8_LDB(B0, 1, 0); PG8_LDB(B1, 1, 1); PG8_SCHED; PG8_LDA(At, 1, 0); PG8_STAGE(PG8_SA(0, 1), a2 + hstepA, voffA);
            PG8_WAIT_V(8); PG8_WAIT_L(0); PG8_BAR; PG8_MMA(0, 0, At, B0); PG8_MMA(0, 1, At, B1); PG8_BAR; PG8_SCHED;
            PG8_LDA(At, 1, 1); PG8_STAGE(PG8_SB(1, 0), b3, voffB); PG8_STAGE(PG8_SB(1, 1), b3 + hstepB, voffB); PG8_STAGE(PG8_SA(1, 0), a3, voffA);
            PG8_WAIT_V(8); PG8_WAIT_L(0); PG8_BAR; PG8_MMA(1, 0, At, B0); PG8_MMA(1, 1, At, B1); PG8_BAR; PG8_SCHED;
            } else {
            PG8_LDB(B0, 0, 0); PG8_SCHED; PG8_LDA(At, 0, 0); PG8_STAGE(PG8_SA(1, 1), a1 + hstepA, voffA);
            PG8_WAIT_L(8); PG8_BAR; PG8_WAIT_L(0); PG8_MMA(0, 0, At, B0); PG8_BAR; PG8_SCHED;
            PG8_LDB(B1, 0, 1); PG8_STAGE(PG8_SB(0, 0), b2, voffB);
            PG8_BAR; PG8_WAIT_L(0); PG8_MMA(0, 1, At, B1); PG8_BAR;
            PG8_LDA(At, 0, 1); PG8_STAGE(PG8_SA(0, 0), a2, voffA);
            PG8_BAR; PG8_WAIT_L(0); PG8_MMA(1, 0, At, B0); PG8_BAR; PG8_SCHED;
            PG8_STAGE(PG8_SB(0, 1), b2 + hstepB, voffB);
            PG8_WAIT_V(6); PG8_BAR; PG8_MMA(1, 1, At, B1); PG8_BAR;
            PG8_LDB(B0, 1, 0); PG8_SCHED; PG8_LDA(At, 1, 0); PG8_STAGE(PG8_SA(0, 1), a2 + hstepA, voffA);
            PG8_WAIT_L(8); PG8_BAR; PG8_WAIT_L(0); PG8_MMA(0, 0, At, B0); PG8_BAR; PG8_SCHED;
            PG8_LDB(B1, 1, 1); PG8_STAGE(PG8_SB(1, 0), b3, voffB);
            PG8_BAR; PG8_WAIT_L(0); PG8_MMA(0, 1, At, B1); PG8_BAR;
            PG8_LDA(At, 1, 1); PG8_STAGE(PG8_SA(1, 0), a3, voffA);
            PG8_BAR; PG8_WAIT_L(0); PG8_MMA(1, 0, At, B0); PG8_BAR; PG8_SCHED;
            PG8_STAGE(PG8_SB(1, 1), b3 + hstepB, voffB);
            PG8_WAIT_V(6); PG8_BAR; PG8_MMA(1, 1, At, B1); PG8_BAR;
            }
        }
        if constexpr (ALIGN_EPI) { if (wr == 0) PG8_BAR; }
        if constexpr (!Epi::AFTER_DRAIN) { E(acc, cur, wr, wc, fr, fq); S.done(cur); }
        if (!has_next) break;
#pragma unroll
        for (int a = 0; a < 2; ++a)
#pragma unroll
            for (int b = 0; b < 2; ++b)
#pragma unroll
                for (int m = 0; m < 4; ++m)
#pragma unroll
                    for (int n = 0; n < 2; ++n) acc[a][b][m][n] = (f32x4){0.f, 0.f, 0.f, 0.f};
        cur = nxt; cA = nA; cB = nB; ++ui;
        if constexpr (ALIGN_EPI) { if (wr == 1) PG8_BAR; }
    }
    PG8_WAIT_V(0);
    if constexpr (!ALIGN_EPI) { if (wr == 0) PG8_BAR; }
    PG8_BAR;
    if constexpr (Epi::AFTER_DRAIN) { E.fused(acc, cur, wr, wc, fr, fq, lds, wid, lane); S.done(cur); }
#undef PG8_SA
#undef PG8_SB
#undef PG8_STAGE
#undef PG8_LDA
#undef PG8_LDB
#undef PG8_MMA
#undef PG8_WAIT_V
#undef PG8_WAIT_L
#undef PG8_BAR
#undef PG8_SCHED
}
}
#define GAS __attribute__((address_space(1)))
#define LAS __attribute__((address_space(3)))
typedef unsigned short bf16;
typedef unsigned v4u __attribute__((ext_vector_type(4)));
typedef float f32x4 __attribute__((ext_vector_type(4)));
typedef short bf16x8 __attribute__((ext_vector_type(8)));
typedef GAS unsigned gu32;
typedef GAS unsigned long long gu64;
#define RLX_AGENT __ATOMIC_RELAXED, __HIP_MEMORY_SCOPE_AGENT
#define LDS_WAIT() asm volatile("s_waitcnt lgkmcnt(0)" ::: "memory")
#define VM_WAIT() asm volatile("s_waitcnt vmcnt(0)" ::: "memory")
__device__ __forceinline__ unsigned long long rt() { return __builtin_amdgcn_s_memrealtime(); }
__device__ __forceinline__ unsigned f2bf(float f) { unsigned u = __builtin_bit_cast(unsigned, f); return (u + 0x7fffu + ((u >> 16) & 1u)) >> 16; }
__device__ __forceinline__ unsigned pk2(float lo, float hi) { return f2bf(lo) | (f2bf(hi) << 16); }

#define XB_TMO      128
#define XB_XCNT(j)  (256  + 64 * (j))
#define XB_XSUB(j)  (1280 + 64 * (j))
#define XB_XGEN(j)  (2304 + 64 * (j))
#define XB_TOP      3328
#define XB_TOPGEN   3392
#define XCD_BAR_WORDS 3456
#define XB_SPIN_CAP (1u << 18)

__device__ __forceinline__ unsigned xb_ld(unsigned* p)              { return __hip_atomic_load(p, __ATOMIC_RELAXED, __HIP_MEMORY_SCOPE_AGENT); }
__device__ __forceinline__ unsigned xb_add(unsigned* p, unsigned v) { return __hip_atomic_fetch_add(p, v, __ATOMIC_RELAXED, __HIP_MEMORY_SCOPE_AGENT); }
__device__ __forceinline__ unsigned xb_xcc_id() { return (unsigned)__builtin_amdgcn_s_getreg((3 << 11) | 20) & 0xFu; }
#define XB_SPIN(cond, bar) do { unsigned _sp = 0; while (cond) { __builtin_amdgcn_s_sleep(1); \
    if ((++_sp & 255u) == 0u) { if (xb_ld(&(bar)[XB_TMO])) break; if (_sp > XB_SPIN_CAP) { atomicAdd(&(bar)[XB_TMO], 1u); break; } } } } while (0)

struct XcdBarrier {
    unsigned* bar; unsigned x;
    volatile LAS unsigned* st;
};

__device__ __forceinline__ XcdBarrier xcd_barrier_post(unsigned* bar, volatile LAS unsigned* st) {
    XcdBarrier b; b.bar = bar; b.x = xb_xcc_id(); b.st = st;
    if (threadIdx.x == 0) (void)xb_add(&bar[XB_XCNT(b.x)], 1u);
    return b;
}
__device__ __forceinline__ void xcd_barrier_complete(unsigned* bar, unsigned x, unsigned& nloc, unsigned& nx) {
    const unsigned G = gridDim.x * gridDim.y * gridDim.z;
    unsigned sum, cnt, mine, sp = 0u;
    for (;;) {
        sum = 0u; cnt = 0u; mine = 0u;
#pragma unroll
        for (unsigned j = 0; j < 16; ++j) { const unsigned c = xb_ld(&bar[XB_XCNT(j)]); sum += c; cnt += (c > 0u) ? 1u : 0u; mine = (j == x) ? c : mine; }
        if (sum == G) break;
        __builtin_amdgcn_s_sleep(1);
        if ((++sp & 255u) == 0u) { if (xb_ld(&bar[XB_TMO])) break; if (sp > XB_SPIN_CAP) { atomicAdd(&bar[XB_TMO], 1u); break; } }
    }
    nloc = mine > 0u ? mine : 1u; nx = cnt > 0u ? cnt : 1u;
}

__device__ __forceinline__ void xcd_barrier(const XcdBarrier& b) {
    asm volatile("s_waitcnt vmcnt(0)" ::: "memory");
    __syncthreads();
    if (threadIdx.x == 0) {
        unsigned* bar = b.bar;
        __builtin_amdgcn_s_waitcnt(0);
        unsigned nloc = b.st[0], nx = b.st[1];
        if (nloc == 0u) { xcd_barrier_complete(bar, b.x, nloc, nx); b.st[0] = nloc; b.st[1] = nx; }
        const unsigned old = xb_add(&bar[XB_XSUB(b.x)], 1u);
        const unsigned gen = old / nloc;
        if (old + 1u == (gen + 1u) * nloc) {
            __builtin_amdgcn_fence(__ATOMIC_RELEASE, "agent");
            asm volatile("s_waitcnt vmcnt(0)" ::: "memory");
            const unsigned og = xb_add(&bar[XB_TOP], 1u);
            const unsigned tg = og / nx;
            if (og + 1u == (tg + 1u) * nx) xb_add(&bar[XB_TOPGEN], 1u);
            else XB_SPIN(xb_ld(&bar[XB_TOPGEN]) == tg, bar);
            __builtin_amdgcn_fence(__ATOMIC_ACQUIRE, "agent");
            xb_add(&bar[XB_XGEN(b.x)], 1u);
            asm volatile("s_waitcnt vmcnt(0)" ::: "memory");
        } else {
            XB_SPIN(xb_ld(&bar[XB_XGEN(b.x)]) == gen, bar);
            __builtin_amdgcn_fence(__ATOMIC_ACQUIRE, "agent");
            asm volatile("s_waitcnt vmcnt(0)" ::: "memory");
        }
    }
    __syncthreads();
}
constexpr int NWAVES = 8;
constexpr int M_TOK = 98304, M_PROMPT = 65536, D = 1024, NP = 3584, NWIN = 3616, FF = 4096;
constexpr int L_PROMPT = 2048, L_SAMPLE = 16384;
constexpr float EPS = 1e-6f;
constexpr size_t MiB = 1u << 20;
constexpr size_t WS_CTL = 0, CTL_ZERO_BYTES = 1 * MiB;
constexpr size_t WS_WIN = 1 * MiB;
constexpr size_t WS_WOUT = 9 * MiB;
constexpr size_t WS_W1 = 11 * MiB;
constexpr size_t WS_W2 = 19 * MiB;
constexpr size_t WS_ROPE = 27 * MiB;
constexpr size_t WS_GA = 35 * MiB;
constexpr size_t WS_RSTD = 47 * MiB;
constexpr size_t WS_SQ1 = 48 * MiB;
constexpr size_t WS_SQ2 = 54 * MiB;
constexpr size_t WS_DEC = 60 * MiB;
constexpr size_t WS_R0 = 64 * MiB;
constexpr size_t WS_R1 = 256 * MiB;
constexpr size_t WS_END = 1024 * MiB;
constexpr int CW_BAR = 4096;
constexpr int RING_OFF = 0, RING_BYTES = 131072;
constexpr int LDSCTL_OFF = RING_BYTES, MISC_OFF = LDSCTL_OFF + 320;
constexpr int LDS_BYTES = 147456;

struct Frame {
    LAS unsigned char* lds;
    volatile LAS unsigned* MISC;
    int tid, lane, wave, vcu, G;
};
__device__ __forceinline__ float wave_sum(float v) {
#pragma unroll
    for (int o = 1; o < 64; o <<= 1) v += __shfl_xor(v, o);
    return v;
}
__device__ __forceinline__ float bf2f(bf16 b) { return __uint_as_float((unsigned)b << 16); }
__device__ __forceinline__ unsigned cvtpk(float lo, float hi) { unsigned r; asm volatile("v_cvt_pk_bf16_f32 %0, %1, %2" : "=v"(r) : "v"(lo), "v"(hi)); return r; }

__device__ __forceinline__ void win_map(int nd, int& sc, float& cs) {
    cs = 1.f;
    if (nd < 512) sc = 512 + nd;
    else if (nd < 1024) sc = 2592 + (nd - 512);
    else if (nd < 1280) { sc = nd - 1024; cs = 0.125f; }
    else if (nd < 1536) sc = 256 + (nd - 1280);
    else if (nd < 2048) sc = 1024 + (nd - 1536);
    else if (nd < 3072) {
        const bool isq = nd < 2560; const int p = nd - (isq ? 2048 : 2560), h = p >> 7, pp = p & 127, u = pp >> 3, j = pp & 7;
        const int d = (j < 4) ? 4 * u + j : 64 + 4 * u + (j - 4);
        sc = (isq ? 1568 : 2080) + 128 * h + d; if (isq) cs = 0.08838834764831845f; }
    else if (nd < 3584) sc = 3104 + (nd - 3072);
    else sc = 1536 + (nd - 3584);
}
template <bool MAP>
__device__ __forceinline__ void p0_transpose_item(const float* W, int K, int Nsrc, int nblk, const float* ks, bf16* WT, LAS float* scr, int item, int lane) {
    const int kb = item / nblk, nb = item % nblk, k0 = 64 * kb, n0 = 32 * nb;
    int sc = n0 + (lane & 31); float cs = 1.f;
    if (MAP) win_map(n0 + (lane & 31), sc, cs);
#pragma unroll 8
    for (int i = 0; i < 32; ++i) { const int kk = 2 * i + (lane >> 5); float w = W[(size_t)(k0 + kk) * Nsrc + sc] * cs; if (ks) w *= ks[k0 + kk]; scr[kk * 33 + (lane & 31)] = w; }
    LDS_WAIT(); asm volatile("" ::: "memory");
    const int c = lane & 7;
#pragma unroll
    for (int j = 0; j < 4; ++j) { const int n = (lane >> 3) + 8 * j; const LAS float* s = scr + (8 * c) * 33 + n;
        v4u o; o.x = cvtpk(s[0 * 33], s[1 * 33]); o.y = cvtpk(s[2 * 33], s[3 * 33]); o.z = cvtpk(s[4 * 33], s[5 * 33]); o.w = cvtpk(s[6 * 33], s[7 * 33]);
        *(GAS v4u*)(WT + (size_t)(n0 + n) * K + k0 + 8 * c) = o; }
    LDS_WAIT(); asm volatile("" ::: "memory");
}
__device__ __forceinline__ void rope_entry(int e, float* rcos, float* rsin) {
    const int pos = e >> 6, i = e & 63;
    double inv = 1.0, b = 0.8659643233600653;
#pragma unroll
    for (int bit = 0; bit < 6; ++bit) { if ((i >> bit) & 1) inv *= b; b *= b; }
    const double ang = (double)pos * inv;
    const double n = __builtin_rint(ang * 0.6366197723675814);
    double r = __builtin_fma(-n, 1.5707963267948966, ang); r = __builtin_fma(-n, 6.123233995736766e-17, r);
    const double r2 = r * r;
    double s = -1.0 / 1307674368000.0;
    s = s * r2 + 1.0 / 6227020800.0; s = s * r2 - 1.0 / 39916800.0; s = s * r2 + 1.0 / 362880.0; s = s * r2 - 1.0 / 5040.0; s = s * r2 + 1.0 / 120.0; s = s * r2 - 1.0 / 6.0; s = s * r2 * r + r;
    double c = 1.0 / 20922789888000.0;
    c = c * r2 - 1.0 / 87178291200.0; c = c * r2 + 1.0 / 479001600.0; c = c * r2 - 1.0 / 3628800.0; c = c * r2 + 1.0 / 40320.0; c = c * r2 - 1.0 / 720.0; c = c * r2 + 1.0 / 24.0; c = c * r2 - 0.5; c = c * r2 + 1.0;
    const int q = ((int)n) & 3;
    const double cs = (q == 0) ? c : (q == 1) ? -s : (q == 2) ? -c : s;
    const double sn = (q == 0) ? s : (q == 1) ? c : (q == 2) ? -s : -c;
    rcos[e] = (float)cs; rsin[e] = (float)sn;
}
struct P0Args { const float *xp, *xs, *anw, *win, *wout, *mnw, *w1, *w2; bf16 *Win_t, *Wout_t, *W1_t, *W2_t, *Xb; float *rcos, *rsin, *ga, *rstd; };
__device__ __forceinline__ void p0_prologue(Frame& F, const P0Args& a) {
    LAS float* scr = (LAS float*)(F.lds + RING_OFF + F.wave * 16384);
    const int gw = F.vcu * NWAVES + F.wave, NGW = F.G * NWAVES;
    constexpr int I_IN = (D / 64) * (NWIN / 32), I_O = (D / 64) * (D / 32), I_1 = (D / 64) * (FF / 32), I_2 = (FF / 64) * (D / 32);
    constexpr int NITEMS = I_IN + I_O + I_1 + I_2;
    for (int it = gw; it < NITEMS; it += NGW) {
        int r = it;
        if (r < I_IN) { p0_transpose_item<true>(a.win, D, NWIN, NWIN / 32, a.anw, a.Win_t, scr, r, F.lane); continue; } r -= I_IN;
        if (r < I_O) { p0_transpose_item<false>(a.wout, D, D, D / 32, nullptr, a.Wout_t, scr, r, F.lane); continue; } r -= I_O;
        if (r < I_1) { p0_transpose_item<false>(a.w1, D, FF, FF / 32, a.mnw, a.W1_t, scr, r, F.lane); continue; } r -= I_1;
        p0_transpose_item<false>(a.w2, FF, D, D / 32, nullptr, a.W2_t, scr, r, F.lane);
    }
    for (int e = (blockIdx.x * NWAVES * 64) + F.tid; e < 16384 * 64; e += F.G * NWAVES * 64) rope_entry(e, a.rcos, a.rsin);
    __syncthreads();
    LAS bf16* wl = (LAS bf16*)(F.lds + RING_OFF);
    for (int e = F.tid; e < 32 * 1024; e += NWAVES * 64) { const int k = e >> 5, c = e & 31; wl[c * 1032 + k] = (bf16)(cvtpk(a.win[(size_t)k * NWIN + 1536 + c] * a.anw[k], 0.f) & 0xffffu); }
    __syncthreads();
    const int r = F.lane & 15, g = F.lane >> 4;
    for (int item = gw; item < M_TOK / 16; item += NGW) {
        const int row = item * 16 + r;
        const float* xrow = (row < M_PROMPT ? a.xp + (size_t)row * D : a.xs + (size_t)(row - M_PROMPT) * D) + 8 * g;
        bf16* xb = a.Xb + (size_t)row * D + 8 * g;
        f32x4 acc0 = {0.f, 0.f, 0.f, 0.f}, acc1 = {0.f, 0.f, 0.f, 0.f}; float ss = 0.f;
#pragma unroll 4
        for (int s = 0; s < 32; ++s) {
            const f32x4 x0 = *(const GAS f32x4*)(xrow + 32 * s), x1 = *(const GAS f32x4*)(xrow + 32 * s + 4);
            ss += (x0[0] * x0[0] + x0[1] * x0[1]) + (x0[2] * x0[2] + x0[3] * x0[3]) + (x1[0] * x1[0] + x1[1] * x1[1]) + (x1[2] * x1[2] + x1[3] * x1[3]);
            v4u p; p.x = cvtpk(x0[0], x0[1]); p.y = cvtpk(x0[2], x0[3]); p.z = cvtpk(x1[0], x1[1]); p.w = cvtpk(x1[2], x1[3]);
            *(GAS v4u*)(xb + 32 * s) = p;
            const bf16x8 af = __builtin_bit_cast(bf16x8, p);
            const bf16x8 b0 = *(const LAS bf16x8*)(wl + r * 1032 + 32 * s + 8 * g), b1 = *(const LAS bf16x8*)(wl + (16 + r) * 1032 + 32 * s + 8 * g);
            acc0 = __builtin_amdgcn_mfma_f32_16x16x32_bf16(af, b0, acc0, 0, 0, 0);
            acc1 = __builtin_amdgcn_mfma_f32_16x16x32_bf16(af, b1, acc1, 0, 0, 0);
        }
        ss += __shfl_xor(ss, 16); ss += __shfl_xor(ss, 32);
        const float rs = 1.0f / sqrtf(ss * (1.0f / 1024.0f) + EPS);
        if (g == 0) a.rstd[row] = rs;
#pragma unroll
        for (int q = 0; q < 4; ++q) { const int rr = 4 * g + q; const float rq = __shfl(rs, rr);
            a.ga[(size_t)(item * 16 + rr) * 32 + r] = acc0[q] * rq; a.ga[(size_t)(item * 16 + rr) * 32 + 16 + r] = acc1[q] * rq; }
    }
}

__device__ __forceinline__ float log_sigmoid_f(float z) { return fminf(z, 0.f) - log1pf(expf(-fabsf(z))); }
struct MixArgs { bf16* proj; const float* ga; const float *waf, *baf, *wab, *bab; float* of; const float *gnw, *rnw, *rnb; };
constexpr int NTB = 16;
template <int DK, bool GLA, bool BWD>
__device__ __forceinline__ void naive_sweep(Frame& F, const MixArgs& a, int job) {
    const int grp = F.tid >> 7, gt = F.tid & 127;
    int seq, head; if (job < 16) { seq = 32 + (job >> 3); head = job & 7; } else { seq = (job - 16) >> 3; head = (job - 16) & 7; }
    const int L = seq < 32 ? L_PROMPT : L_SAMPLE, row_base = seq < 32 ? seq * L_PROMPT : M_PROMPT + (seq - 32) * L_SAMPLE;
    const int hh = GLA ? head : head - 4;
    const int qcol = GLA ? 1024 + 64 * hh : 2048 + 128 * hh, kcol = GLA ? 1280 + 64 * hh : 2560 + 128 * hh, vcol = 128 * head;
    LAS float* sq = (LAS float*)(F.lds + grp * (3 * NTB * 128 * 4)); LAS float* sk = sq + NTB * DK; LAS float* sa = sk + NTB * DK;
    const float gam = 1.0f - exp2f(-5.0f - (float)hh);
    const float* wal = BWD ? a.wab : a.waf; const float* bal = BWD ? a.bab : a.baf;
    float S[DK];
#pragma unroll
    for (int t = 0; t < DK; ++t) S[t] = 0.f;
    for (int t0 = 0; t0 < L; t0 += NTB) {
        __syncthreads();
        for (int e = gt; e < NTB * DK; e += 128) {
            const int tok = e / DK, t = e % DK, tp = t0 + tok, row = row_base + (BWD ? L - 1 - tp : tp);
            const bf16* pr = a.proj + (size_t)row * NP;
            sq[e] = bf2f(pr[qcol + t]); sk[e] = bf2f(pr[kcol + t]);
            if (GLA) { const float* gar = a.ga + (size_t)row * 32 + (BWD ? 16 : 0); float z = bal[64 * hh + t];
#pragma unroll
                for (int r = 0; r < 16; ++r) z += gar[r] * wal[r * 256 + 64 * hh + t];
                sa[e] = expf(fmaxf(log_sigmoid_f(z) * (1.0f / 16.0f), -1.0f)); }
        }
        __syncthreads();
        for (int tok = 0; tok < NTB; ++tok) {
            const int tp = t0 + tok, row = row_base + (BWD ? L - 1 - tp : tp);
            const float vv = bf2f(a.proj[(size_t)row * NP + vcol + gt]);
            float o = 0.f;
#pragma unroll
            for (int t4 = 0; t4 < DK / 4; ++t4) {
                const f32x4 q = *(const LAS f32x4*)(sq + tok * DK + 4 * t4), k = *(const LAS f32x4*)(sk + tok * DK + 4 * t4);
                f32x4 al = {gam, gam, gam, gam}; if (GLA) al = *(const LAS f32x4*)(sa + tok * DK + 4 * t4);
#pragma unroll
                for (int j = 0; j < 4; ++j) {
                    if (!BWD) { S[4 * t4 + j] = al[j] * S[4 * t4 + j] + k[j] * vv; o += q[j] * S[4 * t4 + j]; }
                    else { S[4 * t4 + j] *= al[j]; o += q[j] * S[4 * t4 + j]; S[4 * t4 + j] += k[j] * vv; }
                }
            }
            float* op = a.of + (size_t)row * D + 128 * head + gt;
            if (!BWD) *op = o; else *op += o;
        }
    }
}
template <bool BWD>
__device__ __forceinline__ void naive_mix_phase(Frame& F, const MixArgs& a) {
    if (blockIdx.x >= 68) return;
    const int job = blockIdx.x * 4 + (F.tid >> 7);
    if ((blockIdx.x & 1) == 0) naive_sweep<64, true, BWD>(F, a, job); else naive_sweep<128, false, BWD>(F, a, job);
}
__device__ __forceinline__ void naive_combine(Frame& F, const MixArgs& a) {
    const int gw = F.vcu * NWAVES + F.wave, NGW = F.G * NWAVES, c = 2 * F.lane;
    for (int item = gw; item < M_TOK * 8; item += NGW) {
        const int row = item >> 3, head = item & 7;
        const float* op = a.of + (size_t)row * D + 128 * head + c;
        float o0 = op[0], o1 = op[1], y0, y1;
        if (head < 4) { const float r = 1.0f / sqrtf(wave_sum(o0 * o0 + o1 * o1) * (1.0f / 128.0f) + EPS); y0 = o0 * r * a.gnw[c]; y1 = o1 * r * a.gnw[c + 1]; }
        else { const float mu = wave_sum(o0 + o1) * (1.0f / 128.0f); o0 -= mu; o1 -= mu; const float r = 1.0f / sqrtf(wave_sum(o0 * o0 + o1 * o1) * (1.0f / 128.0f) + EPS);
            const int cc = 128 * (head - 4) + c; y0 = o0 * r * a.rnw[cc] + a.rnb[cc]; y1 = o1 * r * a.rnw[cc + 1] + a.rnb[cc + 1]; }
        bf16* pr = a.proj + (size_t)row * NP;
        const int gcol = (head < 4 ? 1536 + 128 * head : 3072 + 128 * (head - 4)) + c;
        const unsigned gw2 = *(const unsigned*)(pr + gcol);
        const float g0 = __uint_as_float(gw2 << 16), g1 = __uint_as_float(gw2 & 0xffff0000u);
        y0 *= g0 / (1.0f + expf(-g0)); y1 *= g1 / (1.0f + expf(-g1));
        *(unsigned*)(pr + 128 * head + c) = cvtpk(y0, y1);
    }
}
__device__ __forceinline__ void final_norm(Frame& F, float* out, const float* sq, const float* w) {
    const int gw = F.vcu * NWAVES + F.wave, NGW = F.G * NWAVES;
    for (int row = gw; row < M_TOK; row += NGW) {
        const f32x4* s4 = (const f32x4*)(sq + (size_t)row * 16);
        const f32x4 t = (s4[0] + s4[1]) + (s4[2] + s4[3]);
        const float r = 1.0f / sqrtf(((t[0] + t[1]) + (t[2] + t[3])) * (1.0f / 1024.0f) + EPS);
        GAS f32x4* o = (GAS f32x4*)(out + (size_t)row * D) + F.lane; const f32x4* w4 = (const f32x4*)w + F.lane;
#pragma unroll
        for (int j = 0; j < 4; ++j) o[64 * j] = o[64 * j] * r * w4[64 * j];
    }
}

constexpr int NPH = 9;
struct Args { const float* in[16]; float* out; unsigned char* ws; int ph_lo, ph_hi, use_bar, pad; };
__global__ void __launch_bounds__(NWAVES * 64, 2) fwd_kernel(Args args) {
    extern __shared__ __attribute__((aligned(16))) unsigned char lds[];
    Frame F;
    F.lds = (LAS unsigned char*)lds;
    F.MISC = (volatile LAS unsigned*)(F.lds + MISC_OFF);
    F.tid = threadIdx.x; F.lane = F.tid & 63; F.wave = __builtin_amdgcn_readfirstlane(F.tid >> 6);
    F.G = gridDim.x; { const int bx = blockIdx.x; F.vcu = (F.G % 8 == 0) ? (bx % 8) * (F.G / 8) + bx / 8 : bx; }
    unsigned char* ws = args.ws;
    gu32* ctl = (gu32*)(ws + WS_CTL);
    for (int u = F.tid; u < (LDS_BYTES - LDSCTL_OFF) / 4; u += NWAVES * 64) ((LAS unsigned*)(F.lds + LDSCTL_OFF))[u] = 0u;
    __syncthreads();
    XcdBarrier bar; bar.bar = (unsigned*)(ctl + CW_BAR); bar.x = 0; bar.st = nullptr;
    if (args.use_bar) bar = xcd_barrier_post((unsigned*)(ctl + CW_BAR), F.MISC + 8);
    const int lo = args.ph_lo, hi = args.ph_hi;
#define IN(k) (lo <= (k) && (k) < hi)
#define SEAM(k) do { if (IN(k) && IN((k) + 1)) xcd_barrier(bar); } while (0)
    bf16* Win_t = (bf16*)(ws + WS_WIN); bf16* Wout_t = (bf16*)(ws + WS_WOUT); bf16* W1_t = (bf16*)(ws + WS_W1); bf16* W2_t = (bf16*)(ws + WS_W2);
    float* rcos = (float*)(ws + WS_ROPE); float* rsin = rcos + 16384 * 64;
    float* ga = (float*)(ws + WS_GA); float* rstd = (float*)(ws + WS_RSTD); float* sq1 = (float*)(ws + WS_SQ1); float* sq2 = (float*)(ws + WS_SQ2);
    bf16* Xb = (bf16*)(ws + WS_R0); bf16* A2 = (bf16*)(ws + WS_R0); bf16* proj = (bf16*)(ws + WS_R1); bf16* Hb = (bf16*)(ws + WS_R1);
    const float* xp = args.in[0]; const float* xs = args.in[1];

    if (IN(0)) { const P0Args pa{xp, xs, args.in[2], args.in[3], args.in[11], args.in[12], args.in[13], args.in[14], Win_t, Wout_t, W1_t, W2_t, Xb, rcos, rsin, ga, rstd};
        p0_prologue(F, pa); __syncthreads(); }
    SEAM(0);
    if (IN(1)) { pg8::Gemm g{Xb, Win_t, M_TOK, NP, D, D}; pg8::StaticOrder S; S.init(M_TOK, NP, F.G, (int)blockIdx.x);
        pg8::EpiInProj E{proj, rstd, rcos, rsin};
        pg8::gemm_phase<pg8::EpiInProj, pg8::StaticOrder, true, true>(F.lds + RING_OFF, g, S, E); }
    SEAM(1);
    const MixArgs ma{proj, ga, args.in[4], args.in[5], args.in[6], args.in[7], args.out, args.in[8], args.in[9], args.in[10]};
    if (IN(2)) { naive_mix_phase<false>(F, ma); __syncthreads(); }
    SEAM(2);
    if (IN(3)) { naive_mix_phase<true>(F, ma); __syncthreads(); }
    SEAM(3);
    if (IN(4)) { naive_combine(F, ma); }
    SEAM(4);
    if (IN(5)) { pg8::Gemm g{proj, Wout_t, M_TOK, D, D, NP}; pg8::StaticOrder S; S.init(M_TOK, D, F.G, (int)blockIdx.x);
        pg8::EpiResid E{xp, xs, args.out, A2, sq1};
        pg8::gemm_phase<pg8::EpiResid, pg8::StaticOrder, true, true>(F.lds + RING_OFF, g, S, E); }
    SEAM(5);
    if (IN(6)) { pg8::Gemm g{A2, W1_t, M_TOK, FF, D, D}; pg8::StaticOrder S; S.init(M_TOK, FF, F.G, (int)blockIdx.x);
        pg8::EpiFF1 E{Hb, sq1};
        pg8::gemm_phase<pg8::EpiFF1, pg8::StaticOrder, true, true>(F.lds + RING_OFF, g, S, E); }
    SEAM(6);
    if (IN(7)) { pg8::Gemm g{Hb, W2_t, M_TOK, D, FF, FF}; pg8::StaticOrder S; S.init(M_TOK, D, F.G, (int)blockIdx.x);
        pg8::EpiResid E{args.out, args.out + (size_t)M_PROMPT * D, args.out, nullptr, sq2};
        pg8::gemm_phase<pg8::EpiResid, pg8::StaticOrder, true, true>(F.lds + RING_OFF, g, S, E); }
    SEAM(7);
    if (IN(8)) { final_norm(F, args.out, sq2, args.in[15]); }
#undef IN
#undef SEAM
}

extern "C" void kernel_launch(void* const* d_in, const int* in_sizes, int n_in, void* d_out, int out_size, void* d_ws, size_t ws_size, hipStream_t stream) {
    static int grid = 0;
    if (grid == 0) {
        if (n_in != 16 || in_sizes[0] != M_PROMPT * D || out_size != M_TOK * D || ws_size < WS_END) {
            fprintf(stderr, "kernel_launch: unexpected shapes (n_in %d, in0 %d, out %d, ws %zu); nothing launched\n", n_in, n_in > 0 ? in_sizes[0] : -1, out_size, ws_size); grid = -1; return; }
        int dev = 0, cus = 0, per_cu = 0;
        if (hipGetDevice(&dev) != hipSuccess || hipDeviceGetAttribute(&cus, hipDeviceAttributeMultiprocessorCount, dev) != hipSuccess) { grid = -1; return; }
        if (hipFuncSetAttribute((const void*)fwd_kernel, hipFuncAttributeMaxDynamicSharedMemorySize, LDS_BYTES) != hipSuccess) { fprintf(stderr, "kernel_launch: hipFuncSetAttribute failed\n"); grid = -1; return; }
        if (hipOccupancyMaxActiveBlocksPerMultiprocessor(&per_cu, (const void*)fwd_kernel, NWAVES * 64, LDS_BYTES) != hipSuccess || per_cu < 1)
            fprintf(stderr, "kernel_launch: note: occupancy query reports %d workgroups per CU\n", per_cu);
        (void)hipGetLastError();
        grid = cus;
    }
    if (grid < 0) return;
    if (hipMemsetAsync((char*)d_ws + WS_CTL, 0, CTL_ZERO_BYTES, stream) != hipSuccess) return;
    Args a{};
    for (int i = 0; i < 16; ++i) a.in[i] = (const float*)d_in[i];
    a.out = (float*)d_out; a.ws = (unsigned char*)d_ws;
#if MK_SINGLE
    a.ph_lo = 0; a.ph_hi = NPH; a.use_bar = 1;
    hipLaunchKernelGGL(fwd_kernel, dim3(grid), dim3(NWAVES * 64), LDS_BYTES, stream, a);
#else
    for (int p = 0; p < NPH; ++p) { a.ph_lo = p; a.ph_hi = p + 1; a.use_bar = 0;
        hipLaunchKernelGGL(fwd_kernel, dim3(grid), dim3(NWAVES * 64), LDS_BYTES, stream, a); }
#endif
}
```

```cpp
#include <hip/hip_runtime.h>
#include <cstdio>
#ifndef MK_SINGLE
#define MK_SINGLE 1
#endif
#ifndef MIX_GLA
#define MIX_GLA 1
#define MIX_RET 1
#endif
namespace pg8 {
#define PG8_LAS __attribute__((address_space(3)))
typedef unsigned short bf16_t;
typedef short bf16x8 __attribute__((ext_vector_type(8)));
typedef float f32x4 __attribute__((ext_vector_type(4)));
typedef unsigned u32x4 __attribute__((ext_vector_type(4)));
constexpr int BM = 256, BK = 64, HALF = 128, HTB = HALF * BK * 2  , STAGE_BYTES = 8 * HTB, NXCD = 8, WGM = 8;

__host__ __device__ __forceinline__ int lds_byte(int r, int c) { const int st = (r >> 4) * 2 + (c >> 5), rr = r & 15, cc = c & 31, ob = rr * 64 + cc * 2; return st * 1024 + (ob ^ (((ob >> 9) & 1) << 5)); }
__host__ __device__ __forceinline__ void stage_rc(int b, int& R, int& C) { const int st = b / 1024, sb = b % 1024, swz = sb ^ (((sb >> 9) & 1) << 5); R = (st >> 1) * 16 + swz / 64; C = (st & 1) * 32 + (swz % 64) / 2; }
__host__ __device__ __forceinline__ int perm32(int rho) { const int n = rho >> 4, i = rho & 15; return 8 * (i >> 2) + 4 * n + (i & 3); }

struct Unit { int pm, pn; };
struct Gemm { const bf16_t* A; const bf16_t* Bt; int M, N, K, lda; };

struct StaticOrder {
    int nM, nN, nwg, G, c;
    __host__ __device__ void init(int M, int N, int G_, int c_) { nM = M / BM; nN = N / BM; nwg = nM * nN; G = G_; c = c_; }
    __host__ __device__ bool next(int i, Unit& u) const {
        const long L = (long)i * G + c; if (L >= nwg) return false;
        int wgid = (int)L; { const int q = nwg / NXCD, r = nwg % NXCD, xcd = wgid % NXCD, off = wgid / NXCD; wgid = (xcd < r ? xcd * (q + 1) : r * (q + 1) + (xcd - r) * q) + off; }
        const int nig = WGM * nN, gid = wgid / nig, fm = gid * WGM, gsz = (nM - fm) < WGM ? (nM - fm) : WGM;
        u.pm = fm + ((wgid % nig) % gsz); u.pn = (wgid % nig) / gsz; return true;
    }
    __device__ __forceinline__ void a_ready(const Unit&) const {}
    __device__ __forceinline__ void done(const Unit&) const {}
};

__device__ __forceinline__ unsigned cvt_pk_bf16(float lo, float hi) { unsigned r; asm volatile("v_cvt_pk_bf16_f32 %0, %1, %2" : "=v"(r) : "v"(lo), "v"(hi)); return r; }
__device__ __forceinline__ u32x4 pack8(const f32x4& a, const f32x4& b) { u32x4 w; w.x = cvt_pk_bf16(a[0], a[1]); w.y = cvt_pk_bf16(a[2], a[3]); w.z = cvt_pk_bf16(b[0], b[1]); w.w = cvt_pk_bf16(b[2], b[3]); return w; }
constexpr int NPROJ = 3584, DMODEL = 1024, DFF = 4096, MPROMPT = 65536;

struct EpiInProj {
    static constexpr bool PERM = true, AFTER_DRAIN = false;
    bf16_t* P; const float* rstd; const float* rcos; const float* rsin;
    __device__ __forceinline__ void operator()(const f32x4 (&acc)[2][2][4][2], const Unit& u, int wr, int wc, int fr, int fq) const {
        const int row0 = u.pm * BM + wr * 64 + fr, colb = u.pn * BM + wc * 32 + 8 * fq;
        const bool rot = (u.pn >= 8) && (u.pn < 12);
        const int i0 = (4 * wc + fq) * 4;
#pragma unroll
        for (int ai = 0; ai < 2; ++ai)
#pragma unroll
            for (int m = 0; m < 4; ++m) {
                const int row = row0 + ai * HALF + m * 16;
                const float rs = rstd[row];
                const int pos = row < MPROMPT ? (row & 2047) : (row & 16383);
                bf16_t* rowp = P + (size_t)row * NPROJ + colb;
                f32x4 c4 = (f32x4){1.f, 1.f, 1.f, 1.f}, s4 = (f32x4){0.f, 0.f, 0.f, 0.f};
                if (rot) { c4 = *(const f32x4*)(rcos + pos * 64 + i0); s4 = *(const f32x4*)(rsin + pos * 64 + i0); }
#pragma unroll
                for (int bj = 0; bj < 2; ++bj) {
                    f32x4 v0 = acc[ai][bj][m][0] * rs, v1 = acc[ai][bj][m][1] * rs;
                    if (rot) { const f32x4 lo = v0 * c4 - v1 * s4, hi = v0 * s4 + v1 * c4; v0 = lo; v1 = hi; }
                    *(u32x4*)(rowp + bj * HALF) = pack8(v0, v1);
                }
            }
    }
};
struct EpiResid {
    static constexpr bool PERM = true, AFTER_DRAIN = false;
    const float* xp; const float* xs; float* out; bf16_t* A2; float* sq;
    __device__ __forceinline__ void operator()(const f32x4 (&acc)[2][2][4][2], const Unit& u, int wr, int wc, int fr, int fq) const {
        const int row0 = u.pm * BM + wr * 64 + fr, colb = u.pn * BM + wc * 32 + 8 * fq;
#pragma unroll
        for (int ai = 0; ai < 2; ++ai)
#pragma unroll
            for (int m = 0; m < 4; ++m) {
                const int row = row0 + ai * HALF + m * 16;
                const float* xrow = (row < MPROMPT ? xp + (size_t)row * DMODEL : xs + (size_t)(row - MPROMPT) * DMODEL) + colb;
                float* orow = out + (size_t)row * DMODEL + colb;
                float ss = 0.f;
#pragma unroll
                for (int bj = 0; bj < 2; ++bj) {
                    const f32x4 x0 = *(const f32x4*)(xrow + bj * HALF), x1 = *(const f32x4*)(xrow + bj * HALF + 4);
                    const f32x4 v0 = acc[ai][bj][m][0] + x0, v1 = acc[ai][bj][m][1] + x1;
                    *(f32x4*)(orow + bj * HALF) = v0; *(f32x4*)(orow + bj * HALF + 4) = v1;
                    if (A2) *(u32x4*)(A2 + (size_t)row * DMODEL + colb + bj * HALF) = pack8(v0, v1);
                    ss += (v0[0] * v0[0] + v0[1] * v0[1]) + (v0[2] * v0[2] + v0[3] * v0[3]) + (v1[0] * v1[0] + v1[1] * v1[1]) + (v1[2] * v1[2] + v1[3] * v1[3]);
                }
                ss += __shfl_xor(ss, 16); ss += __shfl_xor(ss, 32);
                if (fq == 0) sq[(size_t)row * 16 + u.pn * 4 + wc] = ss;
            }
    }
};
struct EpiFF1 {
    static constexpr bool PERM = true, AFTER_DRAIN = false;
    bf16_t* H; const float* sq;
    __device__ __forceinline__ void operator()(const f32x4 (&acc)[2][2][4][2], const Unit& u, int wr, int wc, int fr, int fq) const {
        const int row0 = u.pm * BM + wr * 64 + fr, colb = u.pn * BM + wc * 32 + 8 * fq;
#pragma unroll
        for (int ai = 0; ai < 2; ++ai)
#pragma unroll
            for (int m = 0; m < 4; ++m) {
                const int row = row0 + ai * HALF + m * 16;
                const f32x4* s4 = (const f32x4*)(sq + (size_t)row * 16);
                const f32x4 t = (s4[0] + s4[1]) + (s4[2] + s4[3]);
                const float r2 = 1.0f / (((t[0] + t[1]) + (t[2] + t[3])) * (1.0f / 1024.0f) + 1e-6f);
                bf16_t* rowp = H + (size_t)row * DFF + colb;
#pragma unroll
                for (int bj = 0; bj < 2; ++bj) {
                    f32x4 v0 = acc[ai][bj][m][0], v1 = acc[ai][bj][m][1];
#pragma unroll
                    for (int j = 0; j < 4; ++j) { const float a = fmaxf(v0[j], 0.f), b = fmaxf(v1[j], 0.f); v0[j] = a * a * r2; v1[j] = b * b * r2; }
                    *(u32x4*)(rowp + bj * HALF) = pack8(v0, v1);
                }
            }
    }
};
template <class Epi, class Sched, bool ALIGN_EPI = false, bool SP2 = false>
__device__ __forceinline__ void gemm_phase(PG8_LAS unsigned char* lds, const Gemm g, const Sched& S, const Epi& E) {
    const int tid = threadIdx.x, wid = __builtin_amdgcn_readfirstlane(tid >> 6), lane = tid & 63, wr = wid >> 2, wc = wid & 3, fr = lane & 15, fq = lane >> 4;
    const int K = g.K, nt = K / BK;
    unsigned voffA[2], voffB[2];
#pragma unroll
    for (int i = 0; i < 2; ++i) { int R, C; stage_rc(tid * 16 + i * 8192, R, C); const int Rb = Epi::PERM ? ((R & ~31) + perm32(R & 31)) : R;
        voffA[i] = (unsigned)(R * g.lda + C) * 2u; voffB[i] = (unsigned)(Rb * K + C) * 2u; }
    const size_t kstep = (size_t)(BK * 2);
    const size_t hstepB = (size_t)HALF * K * 2, hstepA = (size_t)HALF * g.lda * 2;
    const size_t tstepB = 2 * hstepB, tstepA = 2 * hstepA;
    const unsigned ldsw = (unsigned)wid * 1024u;
    const int aoff = lds_byte(wr * 64 + fr, fq * 8), boff = lds_byte(wc * 32 + fr, fq * 8);
#define PG8_SA(b, h) (((b) * 2 + (h)) * HTB)
#define PG8_SB(b, h) ((4 + (b) * 2 + (h)) * HTB)
#define PG8_STAGE(bufoff, gbase, voff) do { _Pragma("unroll") for (int _i = 0; _i < 2; ++_i) \
        __builtin_amdgcn_global_load_lds((const unsigned*)((const char*)(gbase) + (voff)[_i]), (PG8_LAS unsigned*)(lds + (bufoff) + ldsw + _i * 8192), 16, 0, 0); } while (0)
#define PG8_LDA(dst, b, h) do { _Pragma("unroll") for (int m = 0; m < 4; ++m) _Pragma("unroll") for (int k = 0; k < 2; ++k) dst[m][k] = *(const PG8_LAS bf16x8*)(lds + PG8_SA(b, h) + aoff + m * 2048 + k * 1024); } while (0)
#define PG8_LDB(dst, b, h) do { _Pragma("unroll") for (int n = 0; n < 2; ++n) _Pragma("unroll") for (int k = 0; k < 2; ++k) dst[n][k] = *(const PG8_LAS bf16x8*)(lds + PG8_SB(b, h) + boff + n * 2048 + k * 1024); } while (0)
#define PG8_MMA(ai, bj, At, Bt) do { __builtin_amdgcn_s_setprio(1); _Pragma("unroll") for (int m = 0; m < 4; ++m) _Pragma("unroll") for (int n = 0; n < 2; ++n) _Pragma("unroll") for (int k = 0; k < 2; ++k) \
        acc[ai][bj][m][n] = __builtin_amdgcn_mfma_f32_16x16x32_bf16(Bt[n][k], At[m][k], acc[ai][bj][m][n], 0, 0, 0); __builtin_amdgcn_s_setprio(0); } while (0)
#define PG8_WAIT_V(n) asm volatile("s_waitcnt vmcnt(" #n ")" ::: "memory")
#define PG8_WAIT_L(n) asm volatile("s_waitcnt lgkmcnt(" #n ")" ::: "memory")
#define PG8_BAR __builtin_amdgcn_s_barrier()
#define PG8_SCHED __builtin_amdgcn_sched_barrier(0)
    Unit cur, nxt; int ui = 0;
    if (!S.next(0, cur)) return;
    f32x4 acc[2][2][4][2];
#pragma unroll
    for (int a = 0; a < 2; ++a)
#pragma unroll
        for (int b = 0; b < 2; ++b)
#pragma unroll
            for (int m = 0; m < 4; ++m)
#pragma unroll
                for (int n = 0; n < 2; ++n) acc[a][b][m][n] = (f32x4){0.f, 0.f, 0.f, 0.f};
    bf16x8 At[4][2], B0[2][2], B1[2][2];
    const char* cA = (const char*)g.A + (size_t)cur.pm * tstepA; const char* cB = (const char*)g.Bt + (size_t)cur.pn * tstepB;
    S.a_ready(cur);
    if constexpr (SP2) {
        PG8_STAGE(PG8_SB(0, 0), cB, voffB); PG8_STAGE(PG8_SB(0, 1), cB + hstepB, voffB); PG8_STAGE(PG8_SA(0, 0), cA, voffA); PG8_STAGE(PG8_SA(0, 1), cA + hstepA, voffA);
        if (wr == 1) PG8_BAR;
        PG8_WAIT_V(2); PG8_BAR;
        PG8_STAGE(PG8_SB(1, 0), cB + kstep, voffB); PG8_STAGE(PG8_SA(1, 0), cA + kstep, voffA); PG8_STAGE(PG8_SB(1, 1), cB + hstepB + kstep, voffB);
        PG8_WAIT_V(6); PG8_BAR;
    } else {
        PG8_STAGE(PG8_SB(0, 0), cB, voffB); PG8_STAGE(PG8_SA(0, 0), cA, voffA); PG8_STAGE(PG8_SB(0, 1), cB + hstepB, voffB); PG8_STAGE(PG8_SA(0, 1), cA + hstepA, voffA);
        if (wr == 1) PG8_BAR;
        PG8_WAIT_V(4); PG8_BAR;
        PG8_STAGE(PG8_SB(1, 0), cB + kstep, voffB); PG8_STAGE(PG8_SA(1, 0), cA + kstep, voffA); PG8_STAGE(PG8_SB(1, 1), cB + hstepB + kstep, voffB);
        PG8_WAIT_V(6); PG8_BAR;
    }
    for (;;) {
        const bool has_next = S.next(ui + 1, nxt);
        const char* nA = has_next ? (const char*)g.A + (size_t)nxt.pm * tstepA : cA; const char* nB = has_next ? (const char*)g.Bt + (size_t)nxt.pn * tstepB : cB;
        for (int t = 0; t < nt; t += 2) {
            const bool last = (t == nt - 2);
            const char* a1 = cA + (size_t)(t + 1) * kstep;
            const char* a2 = last ? nA : cA + (size_t)(t + 2) * kstep; const char* b2 = last ? nB : cB + (size_t)(t + 2) * kstep;
            const char* a3 = a2 + kstep; const char* b3 = b2 + kstep;
            if (last && has_next) S.a_ready(nxt);
            if constexpr (SP2) {
            PG8_LDB(B0, 0, 0); PG8_LDB(B1, 0, 1); PG8_SCHED; PG8_LDA(At, 0, 0); PG8_STAGE(PG8_SA(1, 1), a1 + hstepA, voffA);
            PG8_WAIT_V(8); PG8_WAIT_L(0); PG8_BAR; PG8_MMA(0, 0, At, B0); PG8_MMA(0, 1, At, B1); PG8_BAR; PG8_SCHED;
            PG8_LDA(At, 0, 1); PG8_STAGE(PG8_SB(0, 0), b2, voffB); PG8_STAGE(PG8_SB(0, 1), b2 + hstepB, voffB); PG8_STAGE(PG8_SA(0, 0), a2, voffA);
            PG8_WAIT_V(8); PG8_WAIT_L(0); PG8_BAR; PG8_MMA(1, 0, At, B0); PG8_MMA(1, 1, At, B1); PG8_BAR; PG8_SCHED;
            PG8_LDB(B0, 1, 0); PG8_LDB(B1, 1, 1); PG8_SCHED; PG8_LDA(At, 1, 0); PG8_STAGE(PG8_SA(0, 1), a2 + hstepA, voffA);
            PG8_WAIT_V(8); PG8_WAIT_L(0); PG8_BAR; PG8_MMA(0, 0, At, B0); PG8_MMA(0, 1, At, B1); PG8_BAR; PG8_SCHED;
            PG8_LDA(At, 1, 1); PG8_STAGE(PG8_SB(1, 0), b3, voffB); PG8_STAGE(PG8_SB(1, 1), b3 + hstepB, voffB); PG8_STAGE(PG8_SA(1, 0), a3, voffA);
            PG8_WAIT_V(8); PG8_WAIT_L(0); PG8_BAR; PG8_MMA(1, 0, At, B0); PG8_MMA(1, 1, At, B1); PG8_BAR; PG8_SCHED;
            } else {
            PG8_LDB(B0, 0, 0); PG8_SCHED; PG8_LDA(At, 0, 0); PG8_STAGE(PG8_SA(1, 1), a1 + hstepA, voffA);
            PG8_WAIT_L(8); PG8_BAR; PG8_WAIT_L(0); PG8_MMA(0, 0, At, B0); PG8_BAR; PG8_SCHED;
            PG8_LDB(B1, 0, 1); PG8_STAGE(PG8_SB(0, 0), b2, voffB);
            PG8_BAR; PG8_WAIT_L(0); PG8_MMA(0, 1, At, B1); PG8_BAR;
            PG8_LDA(At, 0, 1); PG8_STAGE(PG8_SA(0, 0), a2, voffA);
            PG8_BAR; PG8_WAIT_L(0); PG8_MMA(1, 0, At, B0); PG8_BAR; PG8_SCHED;
            PG8_STAGE(PG8_SB(0, 1), b2 + hstepB, voffB);
            PG8_WAIT_V(6); PG8_BAR; PG8_MMA(1, 1, At, B1); PG8_BAR;
            PG8_LDB(B0, 1, 0); PG8_SCHED; PG8_LDA(At, 1, 0); PG8_STAGE(PG8_SA(0, 1), a2 + hstepA, voffA);
            PG8_WAIT_L(8); PG8_BAR; PG8_WAIT_L(0); PG8_MMA(0, 0, At, B0); PG8_BAR; PG8_SCHED;
            PG8_LDB(B1, 1, 1); PG8_STAGE(PG8_SB(1, 0), b3, voffB);
            PG8_BAR; PG8_WAIT_L(0); PG8_MMA(0, 1, At, B1); PG8_BAR;
            PG8_LDA(At, 1, 1); PG8_STAGE(PG8_SA(1, 0), a3, voffA);
            PG8_BAR; PG8_WAIT_L(0); PG8_MMA(1, 0, At, B0); PG8_BAR; PG8_SCHED;
            PG8_STAGE(PG8_SB(1, 1), b3 + hstepB, voffB);
            PG8_WAIT_V(6); PG8_BAR; PG8_MMA(1, 1, At, B1); PG8_BAR;
            }
        }
        if constexpr (ALIGN_EPI) { if (wr == 0) PG8_BAR; }
        if constexpr (!Epi::AFTER_DRAIN) { E(acc, cur, wr, wc, fr, fq); S.done(cur); }
        if (!has_next) break;
#pragma unroll
        for (int a = 0; a < 2; ++a)
#pragma unroll
            for (int b = 0; b < 2; ++b)
#pragma unroll
                for (int m = 0; m < 4; ++m)
#pragma unroll
                    for (int n = 0; n < 2; ++n) acc[a][b][m][n] = (f32x4){0.f, 0.f, 0.f, 0.f};
        cur = nxt; cA = nA; cB = nB; ++ui;
        if constexpr (ALIGN_EPI) { if (wr == 1) PG8_BAR; }
    }
    PG8_WAIT_V(0);
    if constexpr (!ALIGN_EPI) { if (wr == 0) PG8_BAR; }
    PG8_BAR;
    if constexpr (Epi::AFTER_DRAIN) { E.fused(acc, cur, wr, wc, fr, fq, lds, wid, lane); S.done(cur); }
#undef PG8_SA
#undef PG8_SB
#undef PG8_STAGE
#undef PG8_LDA
#undef PG8_LDB
#undef PG8_MMA
#undef PG8_WAIT_V
#undef PG8_WAIT_L
#undef PG8_BAR
#undef PG8_SCHED
}
}
#define GAS __attribute__((address_space(1)))
#define LAS __attribute__((address_space(3)))
typedef unsigned short bf16;
typedef unsigned v4u __attribute__((ext_vector_type(4)));
typedef float f32x4 __attribute__((ext_vector_type(4)));
typedef short bf16x8 __attribute__((ext_vector_type(8)));
typedef GAS unsigned gu32;
typedef GAS unsigned long long gu64;
#define RLX_AGENT __ATOMIC_RELAXED, __HIP_MEMORY_SCOPE_AGENT
#define LDS_WAIT() asm volatile("s_waitcnt lgkmcnt(0)" ::: "memory")
#define VM_WAIT() asm volatile("s_waitcnt vmcnt(0)" ::: "memory")
__device__ __forceinline__ unsigned long long rt() { return __builtin_amdgcn_s_memrealtime(); }
__device__ __forceinline__ unsigned f2bf(float f) { unsigned u = __builtin_bit_cast(unsigned, f); return (u + 0x7fffu + ((u >> 16) & 1u)) >> 16; }
__device__ __forceinline__ unsigned pk2(float lo, float hi) { return f2bf(lo) | (f2bf(hi) << 16); }

#define XB_TMO      128
#define XB_XCNT(j)  (256  + 64 * (j))
#define XB_XSUB(j)  (1280 + 64 * (j))
#define XB_XGEN(j)  (2304 + 64 * (j))
#define XB_TOP      3328
#define XB_TOPGEN   3392
#define XCD_BAR_WORDS 3456
#define XB_SPIN_CAP (1u << 18)

__device__ __forceinline__ unsigned xb_ld(unsigned* p)              { return __hip_atomic_load(p, __ATOMIC_RELAXED, __HIP_MEMORY_SCOPE_AGENT); }
__device__ __forceinline__ unsigned xb_add(unsigned* p, unsigned v) { return __hip_atomic_fetch_add(p, v, __ATOMIC_RELAXED, __HIP_MEMORY_SCOPE_AGENT); }
__device__ __forceinline__ unsigned xb_xcc_id() { return (unsigned)__builtin_amdgcn_s_getreg((3 << 11) | 20) & 0xFu; }
#define XB_SPIN(cond, bar) do { unsigned _sp = 0; while (cond) { __builtin_amdgcn_s_sleep(1); \
    if ((++_sp & 255u) == 0u) { if (xb_ld(&(bar)[XB_TMO])) break; if (_sp > XB_SPIN_CAP) { atomicAdd(&(bar)[XB_TMO], 1u); break; } } } } while (0)

struct XcdBarrier {
    unsigned* bar; unsigned x;
    volatile LAS unsigned* st;
};

__device__ __forceinline__ XcdBarrier xcd_barrier_post(unsigned* bar, volatile LAS unsigned* st) {
    XcdBarrier b; b.bar = bar; b.x = xb_xcc_id(); b.st = st;
    if (threadIdx.x == 0) (void)xb_add(&bar[XB_XCNT(b.x)], 1u);
    return b;
}
__device__ __forceinline__ void xcd_barrier_complete(unsigned* bar, unsigned x, unsigned& nloc, unsigned& nx) {
    const unsigned G = gridDim.x * gridDim.y * gridDim.z;
    unsigned sum, cnt, mine, sp = 0u;
    for (;;) {
        sum = 0u; cnt = 0u; mine = 0u;
#pragma unroll
        for (unsigned j = 0; j < 16; ++j) { const unsigned c = xb_ld(&bar[XB_XCNT(j)]); sum += c; cnt += (c > 0u) ? 1u : 0u; mine = (j == x) ? c : mine; }
        if (sum == G) break;
        __builtin_amdgcn_s_sleep(1);
        if ((++sp & 255u) == 0u) { if (xb_ld(&bar[XB_TMO])) break; if (sp > XB_SPIN_CAP) { atomicAdd(&bar[XB_TMO], 1u); break; } }
    }
    nloc = mine > 0u ? mine : 1u; nx = cnt > 0u ? cnt : 1u;
}

__device__ __forceinline__ void xcd_barrier(const XcdBarrier& b) {
    asm volatile("s_waitcnt vmcnt(0)" ::: "memory");
    __syncthreads();
    if (threadIdx.x == 0) {
        unsigned* bar = b.bar;
        __builtin_amdgcn_s_waitcnt(0);
        unsigned nloc = b.st[0], nx = b.st[1];
        if (nloc == 0u) { xcd_barrier_complete(bar, b.x, nloc, nx); b.st[0] = nloc; b.st[1] = nx; }
        const unsigned old = xb_add(&bar[XB_XSUB(b.x)], 1u);
        const unsigned gen = old / nloc;
        if (old + 1u == (gen + 1u) * nloc) {
            __builtin_amdgcn_fence(__ATOMIC_RELEASE, "agent");
            asm volatile("s_waitcnt vmcnt(0)" ::: "memory");
            const unsigned og = xb_add(&bar[XB_TOP], 1u);
            const unsigned tg = og / nx;
            if (og + 1u == (tg + 1u) * nx) xb_add(&bar[XB_TOPGEN], 1u);
            else XB_SPIN(xb_ld(&bar[XB_TOPGEN]) == tg, bar);
            __builtin_amdgcn_fence(__ATOMIC_ACQUIRE, "agent");
            xb_add(&bar[XB_XGEN(b.x)], 1u);
            asm volatile("s_waitcnt vmcnt(0)" ::: "memory");
        } else {
            XB_SPIN(xb_ld(&bar[XB_XGEN(b.x)]) == gen, bar);
            __builtin_amdgcn_fence(__ATOMIC_ACQUIRE, "agent");
            asm volatile("s_waitcnt vmcnt(0)" ::: "memory");
        }
    }
    __syncthreads();
}
constexpr int NWAVES = 8;
constexpr int M_TOK = 98304, M_PROMPT = 65536, D = 1024, NP = 3584, NWIN = 3616, FF = 4096;
constexpr int L_PROMPT = 2048, L_SAMPLE = 16384;
constexpr float EPS = 1e-6f;
constexpr size_t MiB = 1u << 20;
constexpr size_t WS_CTL = 0, CTL_ZERO_BYTES = 1 * MiB;
constexpr size_t WS_WIN = 1 * MiB;
constexpr size_t WS_WOUT = 9 * MiB;
constexpr size_t WS_W1 = 11 * MiB;
constexpr size_t WS_W2 = 19 * MiB;
constexpr size_t WS_ROPE = 27 * MiB;
constexpr size_t WS_GA = 35 * MiB;
constexpr size_t WS_RSTD = 47 * MiB;
constexpr size_t WS_SQ1 = 48 * MiB;
constexpr size_t WS_SQ2 = 54 * MiB;
constexpr size_t WS_DEC = 60 * MiB;
constexpr size_t WS_R0 = 64 * MiB;
constexpr size_t WS_R1 = 256 * MiB;
constexpr size_t WS_END = 1024 * MiB;
constexpr int CW_BAR = 4096;
constexpr int RING_OFF = 0, RING_BYTES = 131072;
constexpr int LDSCTL_OFF = 147456 - 1024, MISC_OFF = LDSCTL_OFF + 320;
constexpr int LDS_BYTES = 147456;

struct Frame {
    LAS unsigned char* lds;
    volatile LAS unsigned* MISC;
    int tid, lane, wave, vcu, G;
};
__device__ __forceinline__ float wave_sum(float v) {
#pragma unroll
    for (int o = 1; o < 64; o <<= 1) v += __shfl_xor(v, o);
    return v;
}
__device__ __forceinline__ float bf2f(bf16 b) { return __uint_as_float((unsigned)b << 16); }
__device__ __forceinline__ unsigned cvtpk(float lo, float hi) { unsigned r; asm volatile("v_cvt_pk_bf16_f32 %0, %1, %2" : "=v"(r) : "v"(lo), "v"(hi)); return r; }

__device__ __forceinline__ void win_map(int nd, int& sc, float& cs) {
    cs = 1.f;
    if (nd < 512) sc = 512 + nd;
    else if (nd < 1024) sc = 2592 + (nd - 512);
    else if (nd < 1280) { sc = nd - 1024; cs = 0.125f; }
    else if (nd < 1536) sc = 256 + (nd - 1280);
    else if (nd < 2048) sc = 1024 + (nd - 1536);
    else if (nd < 3072) {
        const bool isq = nd < 2560; const int p = nd - (isq ? 2048 : 2560), h = p >> 7, pp = p & 127, u = pp >> 3, j = pp & 7;
        const int d = (j < 4) ? 4 * u + j : 64 + 4 * u + (j - 4);
        sc = (isq ? 1568 : 2080) + 128 * h + d; if (isq) cs = 0.08838834764831845f; }
    else if (nd < 3584) sc = 3104 + (nd - 3072);
    else sc = 1536 + (nd - 3584);
}
template <bool MAP>
__device__ __forceinline__ void p0_transpose_item(const float* W, int K, int Nsrc, int nblk, const float* ks, bf16* WT, LAS float* scr, int item, int lane) {
    const int kb = item / nblk, nb = item % nblk, k0 = 64 * kb, n0 = 32 * nb;
    int sc = n0 + (lane & 31); float cs = 1.f;
    if (MAP) win_map(n0 + (lane & 31), sc, cs);
#pragma unroll 8
    for (int i = 0; i < 32; ++i) { const int kk = 2 * i + (lane >> 5); float w = W[(size_t)(k0 + kk) * Nsrc + sc] * cs; if (ks) w *= ks[k0 + kk]; scr[kk * 33 + (lane & 31)] = w; }
    LDS_WAIT(); asm volatile("" ::: "memory");
    const int c = lane & 7;
#pragma unroll
    for (int j = 0; j < 4; ++j) { const int n = (lane >> 3) + 8 * j; const LAS float* s = scr + (8 * c) * 33 + n;
        v4u o; o.x = cvtpk(s[0 * 33], s[1 * 33]); o.y = cvtpk(s[2 * 33], s[3 * 33]); o.z = cvtpk(s[4 * 33], s[5 * 33]); o.w = cvtpk(s[6 * 33], s[7 * 33]);
        *(GAS v4u*)(WT + (size_t)(n0 + n) * K + k0 + 8 * c) = o; }
    LDS_WAIT(); asm volatile("" ::: "memory");
}
__device__ __forceinline__ void rope_entry(int e, float* rcos, float* rsin) {
    const int pos = e >> 6, i = e & 63;
    double inv = 1.0, b = 0.8659643233600653;
#pragma unroll
    for (int bit = 0; bit < 6; ++bit) { if ((i >> bit) & 1) inv *= b; b *= b; }
    const double ang = (double)pos * inv;
    const double n = __builtin_rint(ang * 0.6366197723675814);
    double r = __builtin_fma(-n, 1.5707963267948966, ang); r = __builtin_fma(-n, 6.123233995736766e-17, r);
    const double r2 = r * r;
    double s = -1.0 / 1307674368000.0;
    s = s * r2 + 1.0 / 6227020800.0; s = s * r2 - 1.0 / 39916800.0; s = s * r2 + 1.0 / 362880.0; s = s * r2 - 1.0 / 5040.0; s = s * r2 + 1.0 / 120.0; s = s * r2 - 1.0 / 6.0; s = s * r2 * r + r;
    double c = 1.0 / 20922789888000.0;
    c = c * r2 - 1.0 / 87178291200.0; c = c * r2 + 1.0 / 479001600.0; c = c * r2 - 1.0 / 3628800.0; c = c * r2 + 1.0 / 40320.0; c = c * r2 - 1.0 / 720.0; c = c * r2 + 1.0 / 24.0; c = c * r2 - 0.5; c = c * r2 + 1.0;
    const int q = ((int)n) & 3;
    const double cs = (q == 0) ? c : (q == 1) ? -s : (q == 2) ? -c : s;
    const double sn = (q == 0) ? s : (q == 1) ? c : (q == 2) ? -s : -c;
    rcos[e] = (float)cs; rsin[e] = (float)sn;
}
struct P0Args { const float *xp, *xs, *anw, *win, *wout, *mnw, *w1, *w2; bf16 *Win_t, *Wout_t, *W1_t, *W2_t, *Xb; float *rcos, *rsin, *ga, *rstd; };
__device__ __forceinline__ void p0_prologue(Frame& F, const P0Args& a) {
    LAS float* scr = (LAS float*)(F.lds + RING_OFF + F.wave * 16384);
    const int gw = F.vcu * NWAVES + F.wave, NGW = F.G * NWAVES;
    constexpr int I_IN = (D / 64) * (NWIN / 32), I_O = (D / 64) * (D / 32), I_1 = (D / 64) * (FF / 32), I_2 = (FF / 64) * (D / 32);
    constexpr int NITEMS = I_IN + I_O + I_1 + I_2;
    for (int it = gw; it < NITEMS; it += NGW) {
        int r = it;
        if (r < I_IN) { p0_transpose_item<true>(a.win, D, NWIN, NWIN / 32, a.anw, a.Win_t, scr, r, F.lane); continue; } r -= I_IN;
        if (r < I_O) { p0_transpose_item<false>(a.wout, D, D, D / 32, nullptr, a.Wout_t, scr, r, F.lane); continue; } r -= I_O;
        if (r < I_1) { p0_transpose_item<false>(a.w1, D, FF, FF / 32, a.mnw, a.W1_t, scr, r, F.lane); continue; } r -= I_1;
        p0_transpose_item<false>(a.w2, FF, D, D / 32, nullptr, a.W2_t, scr, r, F.lane);
    }
    for (int e = (blockIdx.x * NWAVES * 64) + F.tid; e < 16384 * 64; e += F.G * NWAVES * 64) rope_entry(e, a.rcos, a.rsin);
    __syncthreads();
    LAS bf16* wl = (LAS bf16*)(F.lds + RING_OFF);
    for (int e = F.tid; e < 32 * 1024; e += NWAVES * 64) { const int k = e >> 5, c = e & 31; wl[c * 1032 + k] = (bf16)(cvtpk(a.win[(size_t)k * NWIN + 1536 + c] * a.anw[k], 0.f) & 0xffffu); }
    __syncthreads();
    const int r = F.lane & 15, g = F.lane >> 4;
    for (int item = gw; item < M_TOK / 16; item += NGW) {
        const int row = item * 16 + r;
        const float* xrow = (row < M_PROMPT ? a.xp + (size_t)row * D : a.xs + (size_t)(row - M_PROMPT) * D) + 8 * g;
        bf16* xb = a.Xb + (size_t)row * D + 8 * g;
        f32x4 acc0 = {0.f, 0.f, 0.f, 0.f}, acc1 = {0.f, 0.f, 0.f, 0.f}; float ss = 0.f;
#pragma unroll 4
        for (int s = 0; s < 32; ++s) {
            const f32x4 x0 = *(const GAS f32x4*)(xrow + 32 * s), x1 = *(const GAS f32x4*)(xrow + 32 * s + 4);
            ss += (x0[0] * x0[0] + x0[1] * x0[1]) + (x0[2] * x0[2] + x0[3] * x0[3]) + (x1[0] * x1[0] + x1[1] * x1[1]) + (x1[2] * x1[2] + x1[3] * x1[3]);
            v4u p; p.x = cvtpk(x0[0], x0[1]); p.y = cvtpk(x0[2], x0[3]); p.z = cvtpk(x1[0], x1[1]); p.w = cvtpk(x1[2], x1[3]);
            *(GAS v4u*)(xb + 32 * s) = p;
            const bf16x8 af = __builtin_bit_cast(bf16x8, p);
            const bf16x8 b0 = *(const LAS bf16x8*)(wl + r * 1032 + 32 * s + 8 * g), b1 = *(const LAS bf16x8*)(wl + (16 + r) * 1032 + 32 * s + 8 * g);
            acc0 = __builtin_amdgcn_mfma_f32_16x16x32_bf16(af, b0, acc0, 0, 0, 0);
            acc1 = __builtin_amdgcn_mfma_f32_16x16x32_bf16(af, b1, acc1, 0, 0, 0);
        }
        ss += __shfl_xor(ss, 16); ss += __shfl_xor(ss, 32);
        const float rs = 1.0f / sqrtf(ss * (1.0f / 1024.0f) + EPS);
        if (g == 0) a.rstd[row] = rs;
#pragma unroll
        for (int q = 0; q < 4; ++q) { const int rr = 4 * g + q; const float rq = __shfl(rs, rr);
            a.ga[(size_t)(item * 16 + rr) * 32 + r] = acc0[q] * rq; a.ga[(size_t)(item * 16 + rr) * 32 + 16 + r] = acc1[q] * rq; }
    }
}

__device__ __forceinline__ float log_sigmoid_f(float z) { return fminf(z, 0.f) - log1pf(expf(-fabsf(z))); }
struct MixArgs { bf16* proj; const float* ga; const float *waf, *baf, *wab, *bab; float* of; const float *gnw, *rnw, *rnb; };
constexpr int NTB = 16;
template <int DK, bool GLA, bool BWD>
__device__ __forceinline__ void naive_sweep(Frame& F, const MixArgs& a, int job) {
    const int grp = F.tid >> 7, gt = F.tid & 127;
    int seq, head; if (job < 16) { seq = 32 + (job >> 3); head = job & 7; } else { seq = (job - 16) >> 3; head = (job - 16) & 7; }
    const int L = seq < 32 ? L_PROMPT : L_SAMPLE, row_base = seq < 32 ? seq * L_PROMPT : M_PROMPT + (seq - 32) * L_SAMPLE;
    const int hh = GLA ? head : head - 4;
    const int qcol = GLA ? 1024 + 64 * hh : 2048 + 128 * hh, kcol = GLA ? 1280 + 64 * hh : 2560 + 128 * hh, vcol = 128 * head;
    LAS float* sq = (LAS float*)(F.lds + grp * (3 * NTB * 128 * 4)); LAS float* sk = sq + NTB * DK; LAS float* sa = sk + NTB * DK;
    const float gam = 1.0f - exp2f(-5.0f - (float)hh);
    const float* wal = BWD ? a.wab : a.waf; const float* bal = BWD ? a.bab : a.baf;
    float S[DK];
#pragma unroll
    for (int t = 0; t < DK; ++t) S[t] = 0.f;
    for (int t0 = 0; t0 < L; t0 += NTB) {
        __syncthreads();
        for (int e = gt; e < NTB * DK; e += 128) {
            const int tok = e / DK, t = e % DK, tp = t0 + tok, row = row_base + (BWD ? L - 1 - tp : tp);
            const bf16* pr = a.proj + (size_t)row * NP;
            sq[e] = bf2f(pr[qcol + t]); sk[e] = bf2f(pr[kcol + t]);
            if (GLA) { const float* gar = a.ga + (size_t)row * 32 + (BWD ? 16 : 0); float z = bal[64 * hh + t];
#pragma unroll
                for (int r = 0; r < 16; ++r) z += gar[r] * wal[r * 256 + 64 * hh + t];
                sa[e] = expf(fmaxf(log_sigmoid_f(z) * (1.0f / 16.0f), -1.0f)); }
        }
        __syncthreads();
        for (int tok = 0; tok < NTB; ++tok) {
            const int tp = t0 + tok, row = row_base + (BWD ? L - 1 - tp : tp);
            const float vv = bf2f(a.proj[(size_t)row * NP + vcol + gt]);
            float o = 0.f;
#pragma unroll
            for (int t4 = 0; t4 < DK / 4; ++t4) {
                const f32x4 q = *(const LAS f32x4*)(sq + tok * DK + 4 * t4), k = *(const LAS f32x4*)(sk + tok * DK + 4 * t4);
                f32x4 al = {gam, gam, gam, gam}; if (GLA) al = *(const LAS f32x4*)(sa + tok * DK + 4 * t4);
#pragma unroll
                for (int j = 0; j < 4; ++j) {
                    if (!BWD) { S[4 * t4 + j] = al[j] * S[4 * t4 + j] + k[j] * vv; o += q[j] * S[4 * t4 + j]; }
                    else { S[4 * t4 + j] *= al[j]; o += q[j] * S[4 * t4 + j]; S[4 * t4 + j] += k[j] * vv; }
                }
            }
            float* op = a.of + (size_t)row * D + 128 * head + gt;
            if (!BWD) *op = o; else *op += o;
        }
    }
}
template <bool BWD>
__device__ __forceinline__ void naive_mix_phase(Frame& F, const MixArgs& a) {
    if (blockIdx.x >= 68) return;
    const int job = blockIdx.x * 4 + (F.tid >> 7);
    if ((blockIdx.x & 1) == 0) { if (!MIX_GLA) naive_sweep<64, true, BWD>(F, a, job); } else { if (!MIX_RET) naive_sweep<128, false, BWD>(F, a, job); }
}
__device__ __forceinline__ void naive_combine(Frame& F, const MixArgs& a) {
    const int gw = F.vcu * NWAVES + F.wave, NGW = F.G * NWAVES, c = 2 * F.lane;
    for (int item = gw; item < M_TOK * 8; item += NGW) {
        const int row = item >> 3, head = item & 7;
        if (head < 4 ? MIX_GLA : MIX_RET) continue;
        const float* op = a.of + (size_t)row * D + 128 * head + c;
        float o0 = op[0], o1 = op[1], y0, y1;
        if (head < 4) { const float r = 1.0f / sqrtf(wave_sum(o0 * o0 + o1 * o1) * (1.0f / 128.0f) + EPS); y0 = o0 * r * a.gnw[c]; y1 = o1 * r * a.gnw[c + 1]; }
        else { const float mu = wave_sum(o0 + o1) * (1.0f / 128.0f); o0 -= mu; o1 -= mu; const float r = 1.0f / sqrtf(wave_sum(o0 * o0 + o1 * o1) * (1.0f / 128.0f) + EPS);
            const int cc = 128 * (head - 4) + c; y0 = o0 * r * a.rnw[cc] + a.rnb[cc]; y1 = o1 * r * a.rnw[cc + 1] + a.rnb[cc + 1]; }
        bf16* pr = a.proj + (size_t)row * NP;
        const int gcol = (head < 4 ? 1536 + 128 * head : 3072 + 128 * (head - 4)) + c;
        const unsigned gw2 = *(const unsigned*)(pr + gcol);
        const float g0 = __uint_as_float(gw2 << 16), g1 = __uint_as_float(gw2 & 0xffff0000u);
        y0 *= g0 / (1.0f + expf(-g0)); y1 *= g1 / (1.0f + expf(-g1));
        *(unsigned*)(pr + 128 * head + c) = cvtpk(y0, y1);
    }
}
__device__ __forceinline__ void final_norm(Frame& F, float* out, const float* sq, const float* w) {
    const int gw = F.vcu * NWAVES + F.wave, NGW = F.G * NWAVES;
    for (int row = gw; row < M_TOK; row += NGW) {
        const f32x4* s4 = (const f32x4*)(sq + (size_t)row * 16);
        const f32x4 t = (s4[0] + s4[1]) + (s4[2] + s4[3]);
        const float r = 1.0f / sqrtf(((t[0] + t[1]) + (t[2] + t[3])) * (1.0f / 1024.0f) + EPS);
        GAS f32x4* o = (GAS f32x4*)(out + (size_t)row * D) + F.lane; const f32x4* w4 = (const f32x4*)w + F.lane;
#pragma unroll
        for (int j = 0; j < 4; ++j) o[64 * j] = o[64 * j] * r * w4[64 * j];
    }
}

typedef __bf16 bf16v2 __attribute__((ext_vector_type(2)));
typedef unsigned u32x2 __attribute__((ext_vector_type(2)));
__device__ __forceinline__ unsigned cvtpk_c(float lo, float hi) { bf16v2 v = {(__bf16)lo, (__bf16)hi}; return __builtin_bit_cast(unsigned, v); }
__device__ __forceinline__ float bflo(unsigned w) { return __uint_as_float(w << 16); }
__device__ __forceinline__ float bfhi(unsigned w) { return __uint_as_float(w & 0xffff0000u); }
__device__ __forceinline__ void tr_read4(unsigned a0, unsigned a1, unsigned a2, unsigned a3, u32x2& r0, u32x2& r1, u32x2& r2, u32x2& r3) {
    asm volatile("ds_read_b64_tr_b16 %0, %4\n\tds_read_b64_tr_b16 %1, %5\n\tds_read_b64_tr_b16 %2, %6\n\tds_read_b64_tr_b16 %3, %7\n\ts_waitcnt lgkmcnt(0)"
                 : "=&v"(r0), "=&v"(r1), "=&v"(r2), "=&v"(r3) : "v"(a0), "v"(a1), "v"(a2), "v"(a3) : "memory");
}
constexpr size_t ST_SC_BYTES = 393216;
__device__ __forceinline__ size_t state_off(int sc, bool gla, int hh, int dir) { return (size_t)sc * ST_SC_BYTES + (gla ? (size_t)(hh * 2 + dir) * 16384 : (size_t)131072 + (size_t)(hh * 2 + dir) * 32768); }
struct CMixArgs { bf16* proj; const float* ga; const float *waf, *baf, *wab, *bab; unsigned char* st; float* dec; const float *gnw, *rnw, *rnb; };
constexpr int OB_PITCH = 132;

template <int DK, bool GLA, bool WITH_O>
__device__ __forceinline__ void mix_unit(Frame& F, const CMixArgs& a, int sc, int hh) {
    constexpr int NT = DK / 16, NS = DK / 32, TPW = DK / 8, NQ = TPW / 8;
    constexpr int RQ = DK * 2 + 16, RP = 144, RV = 272;
    constexpr int O_QD = 0, O_KI = 64 * RQ, O_KE = 2 * 64 * RQ, O_PB = 3 * 64 * RQ, O_VB = O_PB + 64 * RP, O_DC = O_VB + 64 * RV, O_WAL = O_DC + DK * 4, O_OB = O_WAL + (GLA ? 8704 : 0);
    LAS unsigned char* L = F.lds;
    const int lane = F.lane, w = F.wave, g = lane >> 4, lr = lane & 15, q4 = lr >> 2, p4 = lr & 3;
    const int row0 = sc * 256, head = GLA ? hh : 4 + hh;
    const int qcol = GLA ? 1024 + 64 * hh : 2048 + 128 * hh, kcol = GLA ? 1280 + 64 * hh : 2560 + 128 * hh, vcol = 128 * head;
    const float gam = 1.0f - exp2f(-5.0f - (float)hh), l2g = log2f(gam);
    const unsigned lbase = (unsigned)(size_t)L;

    __syncthreads();
    if (GLA) { LAS float* wl = (LAS float*)(L + O_WAL);
        for (int e = F.tid; e < 2 * 16 * 64; e += NWAVES * 64) { const int d = e >> 10, r = (e >> 6) & 15, t = e & 63; wl[e] = (d ? a.wab : a.waf)[r * 256 + 64 * hh + t]; }
        if (F.tid < 128) { const int d = F.tid >> 6, t = F.tid & 63; wl[2048 + F.tid] = (d ? a.bab : a.baf)[64 * hh + t]; } }

    f32x4 o[4];
    u32x2 ofp[WITH_O ? 4 : 1][4];
    f32x4 S[NT];
    float dtot[GLA ? 8 : 1];
    v4u rq[NQ], rk[NQ], rv[2]; f32x4 rga[4];
#define LOAD_CHUNK(cc_, dd_) do { const int row_ = row0 + 64 * (cc_) + lane; const bf16* pr_ = a.proj + (size_t)row_ * NP; \
        _Pragma("unroll") for (int x = 0; x < NQ; ++x) { if (WITH_O) rq[x] = *(const GAS v4u*)(pr_ + qcol + TPW * w + 8 * x); rk[x] = *(const GAS v4u*)(pr_ + kcol + TPW * w + 8 * x); } \
        rv[0] = *(const GAS v4u*)(pr_ + vcol + 16 * w); rv[1] = *(const GAS v4u*)(pr_ + vcol + 16 * w + 8); \
        if (GLA) { _Pragma("unroll") for (int x = 0; x < 4; ++x) rga[x] = *(const GAS f32x4*)(a.ga + (size_t)row_ * 32 + 16 * (dd_) + 4 * x); } } while (0)
    LOAD_CHUNK(0, 0);
#pragma unroll
    for (int dir = 0; dir < 2; ++dir) {
        if (WITH_O) { const unsigned char* sp = a.st + state_off(sc, GLA, hh, dir) + (size_t)(unsigned)(w * NT * 512 + lane * 8);
#pragma unroll
            for (int tt = 0; tt < NT; ++tt) { const u32x2 pk = *(const GAS u32x2*)(sp + tt * 512); S[tt] = (f32x4){bflo(pk.x), bfhi(pk.x), bflo(pk.y), bfhi(pk.y)}; } }
        else {
#pragma unroll
            for (int tt = 0; tt < NT; ++tt) S[tt] = (f32x4){0.f, 0.f, 0.f, 0.f}; }
        if (GLA && !WITH_O) {
#pragma unroll
            for (int e = 0; e < 8; ++e) dtot[e] = 1.f; }
#pragma unroll 1
        for (int st = 0; st < 4; ++st) {
            const int c = dir ? 3 - st : st;
            __syncthreads();
            {
                const int i = lane;
                if (GLA) {
                    float la[8];
                    { const LAS float* wl = (const LAS float*)(L + O_WAL) + dir * 1024 + 8 * w; const LAS float* bl = (const LAS float*)(L + O_WAL) + 2048 + dir * 64 + 8 * w;
                      f32x4 z0 = *(const LAS f32x4*)bl, z1 = *(const LAS f32x4*)(bl + 4);
#pragma unroll
                      for (int r = 0; r < 16; ++r) { const float gr = rga[r >> 2][r & 3]; z0 += gr * *(const LAS f32x4*)(wl + r * 64); z1 += gr * *(const LAS f32x4*)(wl + r * 64 + 4); }
#pragma unroll
                      for (int e = 0; e < 8; ++e) { const float z = e < 4 ? z0[e & 3] : z1[e & 3];
                          const float ls = fminf(z, 0.f) - __logf(1.0f + __expf(-fabsf(z)));
                          la[e] = fmaxf(ls * (1.0f / 16.0f), -1.0f); } }
#pragma unroll
                    for (int d = 1; d < 64; d <<= 1) {
#pragma unroll
                        for (int e = 0; e < 8; ++e) { const float y = dir ? __shfl_down(la[e], d) : __shfl_up(la[e], d); if (dir ? (lane + d < 64) : (lane >= d)) la[e] += y; } }
                    v4u oq, ok, oe; float q8[8], k8[8], e8[8];
#pragma unroll
                    for (int e = 0; e < 8; ++e) { const float bl_ = __shfl(la[e], dir ? 0 : 63); const float eb = __expf(la[e]);
                        const unsigned wq = WITH_O ? ((const unsigned*)&rq[0])[e >> 1] : 0u, wk = ((const unsigned*)&rk[0])[e >> 1];
                        const float qv = (e & 1) ? bfhi(wq) : bflo(wq), kv = (e & 1) ? bfhi(wk) : bflo(wk);
                        q8[e] = qv * eb; k8[e] = kv * __expf(-la[e]); e8[e] = kv * __expf(bl_ - la[e]);
                        const float el = __expf(bl_);
                        if (!WITH_O) dtot[e] *= el;
                        if (lane == 0) ((LAS float*)(L + O_DC))[8 * w + e] = el; }
                    oq.x = cvtpk_c(q8[0], q8[1]); oq.y = cvtpk_c(q8[2], q8[3]); oq.z = cvtpk_c(q8[4], q8[5]); oq.w = cvtpk_c(q8[6], q8[7]);
                    ok.x = cvtpk_c(k8[0], k8[1]); ok.y = cvtpk_c(k8[2], k8[3]); ok.z = cvtpk_c(k8[4], k8[5]); ok.w = cvtpk_c(k8[6], k8[7]);
                    oe.x = cvtpk_c(e8[0], e8[1]); oe.y = cvtpk_c(e8[2], e8[3]); oe.z = cvtpk_c(e8[4], e8[5]); oe.w = cvtpk_c(e8[6], e8[7]);
                    if (WITH_O) { *(LAS v4u*)(L + O_QD + i * RQ + 16 * w) = oq; *(LAS v4u*)(L + O_KI + i * RQ + 16 * w) = ok; }
                    *(LAS v4u*)(L + O_KE + i * RQ + 16 * w) = oe;
                } else {
                    const float nq = dir ? (float)(64 - i) : (float)(i + 1), ne = dir ? (float)i : (float)(63 - i);
                    const float eb = exp2f(l2g * nq), ei = exp2f(-l2g * nq), ee = exp2f(l2g * ne);
#pragma unroll
                    for (int x = 0; x < NQ; ++x) { v4u oq, ok, oe;
#pragma unroll
                        for (int j = 0; j < 4; ++j) { const unsigned wq = WITH_O ? ((const unsigned*)&rq[x])[j] : 0u, wk = ((const unsigned*)&rk[x])[j];
                            ((unsigned*)&oq)[j] = cvtpk_c(bflo(wq) * eb, bfhi(wq) * eb); ((unsigned*)&ok)[j] = cvtpk_c(bflo(wk) * ei, bfhi(wk) * ei); ((unsigned*)&oe)[j] = cvtpk_c(bflo(wk) * ee, bfhi(wk) * ee); }
                        if (WITH_O) { *(LAS v4u*)(L + O_QD + i * RQ + 2 * TPW * w + 16 * x) = oq; *(LAS v4u*)(L + O_KI + i * RQ + 2 * TPW * w + 16 * x) = ok; }
                        *(LAS v4u*)(L + O_KE + i * RQ + 2 * TPW * w + 16 * x) = oe; }
                    if (lane < TPW) ((LAS float*)(L + O_DC))[TPW * w + lane] = exp2f(l2g * 64.0f);
                }
                *(LAS v4u*)(L + O_VB + i * RV + 32 * w) = rv[0]; *(LAS v4u*)(L + O_VB + i * RV + 32 * w + 16) = rv[1];
            }
            if (st < 3) LOAD_CHUNK(dir ? 2 - st : st + 1, dir); else if (dir == 0) LOAD_CHUNK(3, 1);
            __syncthreads();
            if (WITH_O) {
                const int mi = w >> 1;
#pragma unroll
                for (int jj = 0; jj < 2; ++jj) { const int nj = 2 * (w & 1) + jj;
                    f32x4 acc = {0.f, 0.f, 0.f, 0.f};
#pragma unroll
                    for (int s = 0; s < NS; ++s) {
                        const bf16x8 af = *(const LAS bf16x8*)(L + O_KI + (16 * nj + lr) * RQ + 64 * s + 16 * g);
                        const bf16x8 bf = *(const LAS bf16x8*)(L + O_QD + (16 * mi + lr) * RQ + 64 * s + 16 * g);
                        acc = __builtin_amdgcn_mfma_f32_16x16x32_bf16(af, bf, acc, 0, 0, 0); }
                    const int ii = 16 * mi + lr;
#pragma unroll
                    for (int r = 0; r < 4; ++r) { const int j = 16 * nj + 4 * g + r; const bool keep = dir ? (j > ii) : (j <= ii); acc[r] = keep ? acc[r] : 0.f; }
                    u32x2 pk; pk.x = cvtpk_c(acc[0], acc[1]); pk.y = cvtpk_c(acc[2], acc[3]);
                    *(LAS u32x2*)(L + O_PB + ii * RP + 32 * nj + 8 * g) = pk; }
                __syncthreads();
            }
            {
                u32x2 v00, v01, v10, v11;
                { const unsigned vb = lbase + O_VB + (8 * g + q4) * RV + 32 * w + 8 * p4;
                  tr_read4(vb, vb + 4 * RV, vb + 32 * RV, vb + 36 * RV, v00, v01, v10, v11); }
                const bf16x8 vf0 = __builtin_bit_cast(bf16x8, (v4u){v00.x, v00.y, v01.x, v01.y}), vf1 = __builtin_bit_cast(bf16x8, (v4u){v10.x, v10.y, v11.x, v11.y});
                if (WITH_O) {
#pragma unroll
                    for (int m = 0; m < 4; ++m) {
                        const bf16x8 p0 = *(const LAS bf16x8*)(L + O_PB + (16 * m + lr) * RP + 16 * g), p1 = *(const LAS bf16x8*)(L + O_PB + (16 * m + lr) * RP + 64 + 16 * g);
                        o[m] = __builtin_amdgcn_mfma_f32_16x16x32_bf16(p0, vf0, (f32x4){0.f, 0.f, 0.f, 0.f}, 0, 0, 0);
                        o[m] = __builtin_amdgcn_mfma_f32_16x16x32_bf16(p1, vf1, o[m], 0, 0, 0); }
#pragma unroll
                    for (int s = 0; s < NS; ++s) {
                        const bf16x8 sf = __builtin_bit_cast(bf16x8, (v4u){cvtpk_c(S[2 * s][0], S[2 * s][1]), cvtpk_c(S[2 * s][2], S[2 * s][3]), cvtpk_c(S[2 * s + 1][0], S[2 * s + 1][1]), cvtpk_c(S[2 * s + 1][2], S[2 * s + 1][3])});
#pragma unroll
                        for (int m = 0; m < 4; ++m) {
                            const u32x2 lo = *(const LAS u32x2*)(L + O_QD + (16 * m + lr) * RQ + 64 * s + 8 * g), hi = *(const LAS u32x2*)(L + O_QD + (16 * m + lr) * RQ + 64 * s + 32 + 8 * g);
                            const bf16x8 qf = __builtin_bit_cast(bf16x8, (v4u){lo.x, lo.y, hi.x, hi.y});
                            o[m] = __builtin_amdgcn_mfma_f32_16x16x32_bf16(qf, sf, o[m], 0, 0, 0); } }
                }
#pragma unroll
                for (int tt = 0; tt < NT; ++tt) {
                    const f32x4 d4 = *(const LAS f32x4*)(L + O_DC + (16 * tt + 4 * g) * 4);
                    S[tt] = S[tt] * d4;
                    u32x2 k00, k01, k10, k11;
                    const unsigned kb = lbase + O_KE + (8 * g + q4) * RQ + 32 * tt + 8 * p4;
                    tr_read4(kb, kb + 4 * RQ, kb + 32 * RQ, kb + 36 * RQ, k00, k01, k10, k11);
                    S[tt] = __builtin_amdgcn_mfma_f32_16x16x32_bf16(__builtin_bit_cast(bf16x8, (v4u){k00.x, k00.y, k01.x, k01.y}), vf0, S[tt], 0, 0, 0);
                    S[tt] = __builtin_amdgcn_mfma_f32_16x16x32_bf16(__builtin_bit_cast(bf16x8, (v4u){k10.x, k10.y, k11.x, k11.y}), vf1, S[tt], 0, 0, 0);
                }
            }
            if (WITH_O) {
                if (dir == 0) {
#pragma unroll
                    for (int cc = 0; cc < 4; ++cc) if (cc == c) {
#pragma unroll
                        for (int m = 0; m < 4; ++m) { ofp[cc][m].x = cvtpk_c(o[m][0], o[m][1]); ofp[cc][m].y = cvtpk_c(o[m][2], o[m][3]); } }
                } else {
#pragma unroll
                    for (int cc = 0; cc < 4; ++cc) if (cc == c) {
#pragma unroll
                        for (int m = 0; m < 4; ++m) { o[m][0] += bflo(ofp[cc][m].x); o[m][1] += bfhi(ofp[cc][m].x); o[m][2] += bflo(ofp[cc][m].y); o[m][3] += bfhi(ofp[cc][m].y); } }
                    LAS float* ob = (LAS float*)(L + O_OB);
#pragma unroll
                    for (int m = 0; m < 4; ++m)
#pragma unroll
                        for (int r = 0; r < 4; ++r) ob[(16 * m + 4 * g + r) * OB_PITCH + 16 * w + lr] = o[m][r];
                    __syncthreads();
                    const int cidx = 2 * lane;
                    const int gcol = (GLA ? 1536 + 128 * hh : 3072 + 128 * hh) + cidx;
                    float w0, w1, b0 = 0.f, b1 = 0.f;
                    if (GLA) { w0 = a.gnw[cidx]; w1 = a.gnw[cidx + 1]; } else { w0 = a.rnw[128 * hh + cidx]; w1 = a.rnw[128 * hh + cidx + 1]; b0 = a.rnb[128 * hh + cidx]; b1 = a.rnb[128 * hh + cidx + 1]; }
#pragma unroll 2
                    for (int rr = 0; rr < 8; ++rr) {
                        const int row = 8 * w + rr;
                        float o0 = ob[row * OB_PITCH + cidx], o1 = ob[row * OB_PITCH + cidx + 1], y0, y1;
                        if (GLA) { const float rs = 1.0f / sqrtf(wave_sum(o0 * o0 + o1 * o1) * (1.0f / 128.0f) + EPS); y0 = o0 * rs * w0; y1 = o1 * rs * w1; }
                        else { const float mu = wave_sum(o0 + o1) * (1.0f / 128.0f); o0 -= mu; o1 -= mu; const float rs = 1.0f / sqrtf(wave_sum(o0 * o0 + o1 * o1) * (1.0f / 128.0f) + EPS); y0 = o0 * rs * w0 + b0; y1 = o1 * rs * w1 + b1; }
                        bf16* pr = a.proj + (size_t)(row0 + 64 * c + row) * NP;
                        const unsigned gw2 = *(const GAS unsigned*)(pr + gcol);
                        const float g0 = bflo(gw2), g1 = bfhi(gw2);
                        y0 *= g0 / (1.0f + __expf(-g0)); y1 *= g1 / (1.0f + __expf(-g1));
                        *(GAS unsigned*)(pr + vcol + cidx) = cvtpk_c(y0, y1);
                    }
                }
            }
        }
        if (!WITH_O) {
            unsigned char* sp = a.st + state_off(sc, GLA, hh, dir) + (size_t)(unsigned)(w * NT * 512 + lane * 8);
#pragma unroll
            for (int tt = 0; tt < NT; ++tt) { u32x2 pk; pk.x = cvtpk_c(S[tt][0], S[tt][1]); pk.y = cvtpk_c(S[tt][2], S[tt][3]); *(GAS u32x2*)(sp + tt * 512) = pk; }
            if (GLA && lane == 0) { float* dp = a.dec + (size_t)((sc * 4 + hh) * 2 + dir) * 64 + 8 * w;
#pragma unroll
                for (int e = 0; e < 8; ++e) dp[e] = dtot[e]; }
        }
    }
}
#undef LOAD_CHUNK
template <bool WITH_O>
__device__ __forceinline__ void cmix_phase(Frame& F, const CMixArgs& a) {
#if MIX_GLA
#pragma unroll 1
    for (int p = (int)blockIdx.x; p < 1536; p += F.G) mix_unit<64, true, WITH_O>(F, a, p >> 2, p & 3);
#endif
#if MIX_RET
#pragma unroll 1
    for (int p = (int)blockIdx.x; p < 1536; p += F.G) mix_unit<128, false, WITH_O>(F, a, p >> 2, p & 3);
#endif
    __syncthreads();
}
__device__ __forceinline__ void scan_phase(Frame& F, const CMixArgs& a) {
    const int nthreads = F.G * NWAVES * 64;
    for (int chain = (int)blockIdx.x * NWAVES * 64 + F.tid; chain < 34 * 49152; chain += nthreads) {
        const int sq = chain / 49152, cidx = chain % 49152;
        const int seq = sq < 2 ? 32 + sq : sq - 2;
        const int sc0 = seq < 32 ? seq * 8 : 256 + (seq - 32) * 64, ns = seq < 32 ? 8 : 64;
        const bool gla = cidx < 16384; const int c2 = gla ? cidx : cidx - 16384;
        const int hd = gla ? (c2 >> 11) : (c2 >> 12), v = gla ? (c2 & 2047) : (c2 & 4095), hh = hd >> 1, dir = hd & 1;
        if ((gla && !MIX_GLA) || (!gla && !MIX_RET)) continue;
        const int t0 = 16 * ((v >> 6) & 3) + 4 * ((v & 63) >> 4);
        const float gret = exp2f(256.0f * __log2f(1.0f - exp2f(-5.0f - (float)hh)));
        f32x4 cst = {0.f, 0.f, 0.f, 0.f};
        for (int blk = 0; blk < ns; blk += 8) {
            u32x2 kv[8]; f32x4 d[8];
#pragma unroll
            for (int j = 0; j < 8; ++j) { const int n = dir ? ns - 1 - (blk + j) : blk + j;
                kv[j] = *(const GAS u32x2*)(a.st + state_off(sc0 + n, gla, hh, dir) + (size_t)v * 8);
                d[j] = gla ? *(const GAS f32x4*)(a.dec + (size_t)(((sc0 + n) * 4 + hh) * 2 + dir) * 64 + t0) : (f32x4){gret, gret, gret, gret}; }
#pragma unroll
            for (int j = 0; j < 8; ++j) { const int n = dir ? ns - 1 - (blk + j) : blk + j;
                u32x2 pk; pk.x = cvtpk_c(cst[0], cst[1]); pk.y = cvtpk_c(cst[2], cst[3]);
                *(GAS u32x2*)(a.st + state_off(sc0 + n, gla, hh, dir) + (size_t)v * 8) = pk;
                cst = d[j] * cst + (f32x4){bflo(kv[j].x), bfhi(kv[j].x), bflo(kv[j].y), bfhi(kv[j].y)}; }
        }
    }
}

#define NAIVE_MIX (!(MIX_GLA && MIX_RET))
constexpr int PB0 = NAIVE_MIX ? 8 : 5, NPH = PB0 + 4;
struct Args { const float* in[16]; float* out; unsigned char* ws; int ph_lo, ph_hi, use_bar, pad; };
__global__ void __launch_bounds__(NWAVES * 64, 2) fwd_kernel(Args args) {
    extern __shared__ __attribute__((aligned(16))) unsigned char lds[];
    Frame F;
    F.lds = (LAS unsigned char*)lds;
    F.MISC = (volatile LAS unsigned*)(F.lds + MISC_OFF);
    F.tid = threadIdx.x; F.lane = F.tid & 63; F.wave = __builtin_amdgcn_readfirstlane(F.tid >> 6);
    F.G = gridDim.x; { const int bx = blockIdx.x; F.vcu = (F.G % 8 == 0) ? (bx % 8) * (F.G / 8) + bx / 8 : bx; }
    unsigned char* ws = args.ws;
    gu32* ctl = (gu32*)(ws + WS_CTL);
    for (int u = F.tid; u < (LDS_BYTES - LDSCTL_OFF) / 4; u += NWAVES * 64) ((LAS unsigned*)(F.lds + LDSCTL_OFF))[u] = 0u;
    __syncthreads();
    XcdBarrier bar; bar.bar = (unsigned*)(ctl + CW_BAR); bar.x = 0; bar.st = nullptr;
    if (args.use_bar) bar = xcd_barrier_post((unsigned*)(ctl + CW_BAR), F.MISC + 8);
    const int lo = args.ph_lo, hi = args.ph_hi;
#define IN(k) (lo <= (k) && (k) < hi)
#define SEAM(k) do { if (IN(k) && IN((k) + 1)) xcd_barrier(bar); } while (0)
    if (IN(0)) { const P0Args pa{args.in[0], args.in[1], args.in[2], args.in[3], args.in[11], args.in[12], args.in[13], args.in[14], (bf16*)(ws + WS_WIN), (bf16*)(ws + WS_WOUT), (bf16*)(ws + WS_W1), (bf16*)(ws + WS_W2),
            (bf16*)(ws + WS_R0), (float*)(ws + WS_ROPE), (float*)(ws + WS_ROPE) + 16384 * 64, (float*)(ws + WS_GA), (float*)(ws + WS_RSTD)};
        p0_prologue(F, pa); __syncthreads(); }
    SEAM(0);
    if (IN(1)) { pg8::Gemm g{(bf16*)(ws + WS_R0), (bf16*)(ws + WS_WIN), M_TOK, NP, D, D}; pg8::StaticOrder S; S.init(M_TOK, NP, F.G, (int)blockIdx.x);
        pg8::EpiInProj E{(bf16*)(ws + WS_R1), (float*)(ws + WS_RSTD), (float*)(ws + WS_ROPE), (float*)(ws + WS_ROPE) + 16384 * 64};
        pg8::gemm_phase<pg8::EpiInProj, pg8::StaticOrder, true, true>(F.lds + RING_OFF, g, S, E); }
    SEAM(1);
    if (IN(2)) { const CMixArgs ca{(bf16*)(ws + WS_R1), (float*)(ws + WS_GA), args.in[4], args.in[5], args.in[6], args.in[7], ws + WS_R0, (float*)(ws + WS_DEC), args.in[8], args.in[9], args.in[10]};
        cmix_phase<false>(F, ca); }
    SEAM(2);
    if (IN(3)) { const CMixArgs ca{(bf16*)(ws + WS_R1), (float*)(ws + WS_GA), args.in[4], args.in[5], args.in[6], args.in[7], ws + WS_R0, (float*)(ws + WS_DEC), args.in[8], args.in[9], args.in[10]};
        scan_phase(F, ca); }
    SEAM(3);
    if (IN(4)) { const CMixArgs ca{(bf16*)(ws + WS_R1), (float*)(ws + WS_GA), args.in[4], args.in[5], args.in[6], args.in[7], ws + WS_R0, (float*)(ws + WS_DEC), args.in[8], args.in[9], args.in[10]};
        cmix_phase<true>(F, ca); }
    SEAM(4);
#if NAIVE_MIX
    { const MixArgs ma{(bf16*)(ws + WS_R1), (float*)(ws + WS_GA), args.in[4], args.in[5], args.in[6], args.in[7], args.out, args.in[8], args.in[9], args.in[10]};
    if (IN(5)) { naive_mix_phase<false>(F, ma); __syncthreads(); }
    SEAM(5);
    if (IN(6)) { naive_mix_phase<true>(F, ma); __syncthreads(); }
    SEAM(6);
    if (IN(7)) { naive_combine(F, ma); }
    SEAM(7); }
#endif
    if (IN(PB0)) { pg8::Gemm g{(bf16*)(ws + WS_R1), (bf16*)(ws + WS_WOUT), M_TOK, D, D, NP}; pg8::StaticOrder S; S.init(M_TOK, D, F.G, (int)blockIdx.x);
        pg8::EpiResid E{args.in[0], args.in[1], args.out, (bf16*)(ws + WS_R0), (float*)(ws + WS_SQ1)};
        pg8::gemm_phase<pg8::EpiResid, pg8::StaticOrder, true, true>(F.lds + RING_OFF, g, S, E); }
    SEAM(PB0);
    if (IN(PB0 + 1)) { pg8::Gemm g{(bf16*)(ws + WS_R0), (bf16*)(ws + WS_W1), M_TOK, FF, D, D}; pg8::StaticOrder S; S.init(M_TOK, FF, F.G, (int)blockIdx.x);
        pg8::EpiFF1 E{(bf16*)(ws + WS_R1), (float*)(ws + WS_SQ1)};
        pg8::gemm_phase<pg8::EpiFF1, pg8::StaticOrder, true, true>(F.lds + RING_OFF, g, S, E); }
    SEAM(PB0 + 1);
    if (IN(PB0 + 2)) { pg8::Gemm g{(bf16*)(ws + WS_R1), (bf16*)(ws + WS_W2), M_TOK, D, FF, FF}; pg8::StaticOrder S; S.init(M_TOK, D, F.G, (int)blockIdx.x);
        pg8::EpiResid E{args.out, args.out + (size_t)M_PROMPT * D, args.out, nullptr, (float*)(ws + WS_SQ2)};
        pg8::gemm_phase<pg8::EpiResid, pg8::StaticOrder, true, true>(F.lds + RING_OFF, g, S, E); }
    SEAM(PB0 + 2);
    if (IN(PB0 + 3)) { final_norm(F, args.out, (float*)(ws + WS_SQ2), args.in[15]); }
#undef IN
#undef SEAM
}

extern "C" void kernel_launch(void* const* d_in, const int* in_sizes, int n_in, void* d_out, int out_size, void* d_ws, size_t ws_size, hipStream_t stream) {
    static int grid = 0;
    if (grid == 0) {
        if (n_in != 16 || in_sizes[0] != M_PROMPT * D || out_size != M_TOK * D || ws_size < WS_END) {
            fprintf(stderr, "kernel_launch: unexpected shapes (n_in %d, in0 %d, out %d, ws %zu); nothing launched\n", n_in, n_in > 0 ? in_sizes[0] : -1, out_size, ws_size); grid = -1; return; }
        int dev = 0, cus = 0, per_cu = 0;
        if (hipGetDevice(&dev) != hipSuccess || hipDeviceGetAttribute(&cus, hipDeviceAttributeMultiprocessorCount, dev) != hipSuccess) { grid = -1; return; }
        if (hipFuncSetAttribute((const void*)fwd_kernel, hipFuncAttributeMaxDynamicSharedMemorySize, LDS_BYTES) != hipSuccess) { fprintf(stderr, "kernel_launch: hipFuncSetAttribute failed\n"); grid = -1; return; }
        if (hipOccupancyMaxActiveBlocksPerMultiprocessor(&per_cu, (const void*)fwd_kernel, NWAVES * 64, LDS_BYTES) != hipSuccess || per_cu < 1)
            fprintf(stderr, "kernel_launch: note: occupancy query reports %d workgroups per CU\n", per_cu);
        (void)hipGetLastError();
        grid = cus;
    }
    if (grid < 0) return;
    if (hipMemsetAsync((char*)d_ws + WS_CTL, 0, CTL_ZERO_BYTES, stream) != hipSuccess) return;
    Args a{};
    for (int i = 0; i < 16; ++i) a.in[i] = (const float*)d_in[i];
    a.out = (float*)d_out; a.ws = (unsigned char*)d_ws;
#if MK_SINGLE
    a.ph_lo = 0; a.ph_hi = NPH; a.use_bar = 1;
    hipLaunchKernelGGL(fwd_kernel, dim3(grid), dim3(NWAVES * 64), LDS_BYTES, stream, a);
#else
    for (int p = 0; p < NPH; ++p) { a.ph_lo = p; a.ph_hi = p + 1; a.use_bar = 0;
        hipLaunchKernelGGL(fwd_kernel, dim3(grid), dim3(NWAVES * 64), LDS_BYTES, stream, a); }
#endif
}
```

```cpp
#include <hip/hip_runtime.h>
#include <cstdio>
#ifndef MK_SINGLE
#define MK_SINGLE 1
#endif
#ifndef MIX_GLA
#define MIX_GLA 1
#define MIX_RET 1
#define REP1 0
#define REP2 0
#define REP3 0
#define REP4 0
#define REP6 0
#endif
namespace pg8 {
#define PG8_LAS __attribute__((address_space(3)))
typedef unsigned short bf16_t;
typedef short bf16x8 __attribute__((ext_vector_type(8)));
typedef float f32x4 __attribute__((ext_vector_type(4)));
typedef unsigned u32x4 __attribute__((ext_vector_type(4)));
constexpr int BM = 256, BK = 64, HALF = 128, HTB = HALF * BK * 2  , STAGE_BYTES = 8 * HTB, NXCD = 8, WGM = 8;

__host__ __device__ __forceinline__ int lds_byte(int r, int c) { const int st = (r >> 4) * 2 + (c >> 5), rr = r & 15, cc = c & 31, ob = rr * 64 + cc * 2; return st * 1024 + (ob ^ (((ob >> 9) & 1) << 5)); }
__host__ __device__ __forceinline__ void stage_rc(int b, int& R, int& C) { const int st = b / 1024, sb = b % 1024, swz = sb ^ (((sb >> 9) & 1) << 5); R = (st >> 1) * 16 + swz / 64; C = (st & 1) * 32 + (swz % 64) / 2; }
__host__ __device__ __forceinline__ int perm32(int rho) { const int n = rho >> 4, i = rho & 15; return 8 * (i >> 2) + 4 * n + (i & 3); }

struct Unit { int pm, pn; };
struct Gemm { const bf16_t* A; const bf16_t* Bt; int M, N, K, lda; };

struct StaticOrder {
    int nM, nN, nwg, G, c;
    __host__ __device__ void init(int M, int N, int G_, int c_) { nM = M / BM; nN = N / BM; nwg = nM * nN; G = G_; c = c_; }
    __host__ __device__ bool next(int i, Unit& u) const {
        const long L = (long)i * G + c; if (L >= nwg) return false;
        int wgid = (int)L; { const int q = nwg / NXCD, r = nwg % NXCD, xcd = wgid % NXCD, off = wgid / NXCD; wgid = (xcd < r ? xcd * (q + 1) : r * (q + 1) + (xcd - r) * q) + off; }
        const int nig = WGM * nN, gid = wgid / nig, fm = gid * WGM, gsz = (nM - fm) < WGM ? (nM - fm) : WGM;
        u.pm = fm + ((wgid % nig) % gsz); u.pn = (wgid % nig) / gsz; return true;
    }
    __device__ __forceinline__ void a_ready(const Unit&) const {}
    __device__ __forceinline__ void done(const Unit&) const {}
};

__device__ __forceinline__ unsigned cvt_pk_bf16(float lo, float hi) { unsigned r; asm volatile("v_cvt_pk_bf16_f32 %0, %1, %2" : "=v"(r) : "v"(lo), "v"(hi)); return r; }
__device__ __forceinline__ u32x4 pack8(const f32x4& a, const f32x4& b) { u32x4 w; w.x = cvt_pk_bf16(a[0], a[1]); w.y = cvt_pk_bf16(a[2], a[3]); w.z = cvt_pk_bf16(b[0], b[1]); w.w = cvt_pk_bf16(b[2], b[3]); return w; }
constexpr int NPROJ = 3584, DMODEL = 1024, DFF = 4096, MPROMPT = 65536;

struct EpiInProj {
    static constexpr bool PERM = true, AFTER_DRAIN = false;
    bf16_t* P; const float* rstd; const float* rcos; const float* rsin;
    __device__ __forceinline__ void operator()(const f32x4 (&acc)[2][2][4][2], const Unit& u, int wr, int wc, int fr, int fq) const {
        const int row0 = u.pm * BM + wr * 64 + fr, colb = u.pn * BM + wc * 32 + 8 * fq;
        const bool rot = (u.pn >= 8) && (u.pn < 12);
        const int i0 = (4 * wc + fq) * 4;
#pragma unroll
        for (int ai = 0; ai < 2; ++ai)
#pragma unroll
            for (int m = 0; m < 4; ++m) {
                const int row = row0 + ai * HALF + m * 16;
                const float rs = rstd[row];
                const int pos = row < MPROMPT ? (row & 2047) : (row & 16383);
                bf16_t* rowp = P + (size_t)row * NPROJ + colb;
                f32x4 c4 = (f32x4){1.f, 1.f, 1.f, 1.f}, s4 = (f32x4){0.f, 0.f, 0.f, 0.f};
                if (rot) { c4 = *(const f32x4*)(rcos + pos * 64 + i0); s4 = *(const f32x4*)(rsin + pos * 64 + i0); }
#pragma unroll
                for (int bj = 0; bj < 2; ++bj) {
                    f32x4 v0 = acc[ai][bj][m][0] * rs, v1 = acc[ai][bj][m][1] * rs;
                    if (rot) { const f32x4 lo = v0 * c4 - v1 * s4, hi = v0 * s4 + v1 * c4; v0 = lo; v1 = hi; }
                    *(u32x4*)(rowp + bj * HALF) = pack8(v0, v1);
                }
            }
    }
};
struct EpiResid {
    static constexpr bool PERM = true, AFTER_DRAIN = false;
    const float* xp; const float* xs; float* out; bf16_t* A2; float* sq;
    __device__ __forceinline__ void operator()(const f32x4 (&acc)[2][2][4][2], const Unit& u, int wr, int wc, int fr, int fq) const {
        const int row0 = u.pm * BM + wr * 64 + fr, colb = u.pn * BM + wc * 32 + 8 * fq;
#pragma unroll
        for (int ai = 0; ai < 2; ++ai)
#pragma unroll
            for (int m = 0; m < 4; ++m) {
                const int row = row0 + ai * HALF + m * 16;
                const float* xrow = (row < MPROMPT ? xp + (size_t)row * DMODEL : xs + (size_t)(row - MPROMPT) * DMODEL) + colb;
                float* orow = out + (size_t)row * DMODEL + colb;
                float ss = 0.f;
#pragma unroll
                for (int bj = 0; bj < 2; ++bj) {
                    const f32x4 x0 = *(const f32x4*)(xrow + bj * HALF), x1 = *(const f32x4*)(xrow + bj * HALF + 4);
                    const f32x4 v0 = acc[ai][bj][m][0] + x0, v1 = acc[ai][bj][m][1] + x1;
                    *(f32x4*)(orow + bj * HALF) = v0; *(f32x4*)(orow + bj * HALF + 4) = v1;
                    if (A2) *(u32x4*)(A2 + (size_t)row * DMODEL + colb + bj * HALF) = pack8(v0, v1);
                    ss += (v0[0] * v0[0] + v0[1] * v0[1]) + (v0[2] * v0[2] + v0[3] * v0[3]) + (v1[0] * v1[0] + v1[1] * v1[1]) + (v1[2] * v1[2] + v1[3] * v1[3]);
                }
                ss += __shfl_xor(ss, 16); ss += __shfl_xor(ss, 32);
                if (fq == 0) sq[(size_t)row * 16 + u.pn * 4 + wc] = ss;
            }
    }
};
struct EpiFF1 {
    static constexpr bool PERM = true, AFTER_DRAIN = false;
    bf16_t* H; const float* sq;
    __device__ __forceinline__ void operator()(const f32x4 (&acc)[2][2][4][2], const Unit& u, int wr, int wc, int fr, int fq) const {
        const int row0 = u.pm * BM + wr * 64 + fr, colb = u.pn * BM + wc * 32 + 8 * fq;
#pragma unroll
        for (int ai = 0; ai < 2; ++ai)
#pragma unroll
            for (int m = 0; m < 4; ++m) {
                const int row = row0 + ai * HALF + m * 16;
                const f32x4* s4 = (const f32x4*)(sq + (size_t)row * 16);
                const f32x4 t = (s4[0] + s4[1]) + (s4[2] + s4[3]);
                const float r2 = 1.0f / (((t[0] + t[1]) + (t[2] + t[3])) * (1.0f / 1024.0f) + 1e-6f);
                bf16_t* rowp = H + (size_t)row * DFF + colb;
#pragma unroll
                for (int bj = 0; bj < 2; ++bj) {
                    f32x4 v0 = acc[ai][bj][m][0], v1 = acc[ai][bj][m][1];
#pragma unroll
                    for (int j = 0; j < 4; ++j) { const float a = fmaxf(v0[j], 0.f), b = fmaxf(v1[j], 0.f); v0[j] = a * a * r2; v1[j] = b * b * r2; }
                    *(u32x4*)(rowp + bj * HALF) = pack8(v0, v1);
                }
            }
    }
};

struct EpiPlain {
    static constexpr bool PERM = true, AFTER_DRAIN = false;
    bf16_t* P;
    __device__ __forceinline__ void operator()(const f32x4 (&acc)[2][2][4][2], const Unit& u, int wr, int wc, int fr, int fq) const {
        const int row0 = u.pm * BM + wr * 64 + fr, colb = u.pn * BM + wc * 32 + 8 * fq;
#pragma unroll
        for (int ai = 0; ai < 2; ++ai)
#pragma unroll
            for (int m = 0; m < 4; ++m) { bf16_t* rowp = P + (size_t)(row0 + ai * HALF + m * 16) * NPROJ + colb;
#pragma unroll
                for (int bj = 0; bj < 2; ++bj) *(u32x4*)(rowp + bj * HALF) = pack8(acc[ai][bj][m][0], acc[ai][bj][m][1]); }
    }
};

struct EpiResidX {
    static constexpr bool PERM = true, AFTER_DRAIN = false;
    const float* xp; const float* xs; bf16_t* A2; float* sq;
    __device__ __forceinline__ void operator()(const f32x4 (&acc)[2][2][4][2], const Unit& u, int wr, int wc, int fr, int fq) const {
        const int row0 = u.pm * BM + wr * 64 + fr, colb = u.pn * BM + wc * 32 + 8 * fq;
#pragma unroll
        for (int ai = 0; ai < 2; ++ai)
#pragma unroll
            for (int m = 0; m < 4; ++m) {
                const int row = row0 + ai * HALF + m * 16;
                const float* xrow = (row < MPROMPT ? xp + (size_t)row * DMODEL : xs + (size_t)(row - MPROMPT) * DMODEL) + colb;
                float ss = 0.f;
#pragma unroll
                for (int bj = 0; bj < 2; ++bj) {
                    const f32x4 x0 = *(const f32x4*)(xrow + bj * HALF), x1 = *(const f32x4*)(xrow + bj * HALF + 4);
                    const f32x4 v0 = acc[ai][bj][m][0] + x0, v1 = acc[ai][bj][m][1] + x1;
                    *(u32x4*)(A2 + (size_t)row * DMODEL + colb + bj * HALF) = pack8(v0, v1);
                    ss += (v0[0] * v0[0] + v0[1] * v0[1]) + (v0[2] * v0[2] + v0[3] * v0[3]) + (v1[0] * v1[0] + v1[1] * v1[1]) + (v1[2] * v1[2] + v1[3] * v1[3]);
                }
                ss += __shfl_xor(ss, 16); ss += __shfl_xor(ss, 32);
                if (fq == 0) sq[(size_t)row * 16 + u.pn * 4 + wc] = ss;
            }
    }
};
struct EpiResidB {
    static constexpr bool PERM = true, AFTER_DRAIN = false;
    bf16_t* A2; float* sq;
    __device__ __forceinline__ void operator()(const f32x4 (&acc)[2][2][4][2], const Unit& u, int wr, int wc, int fr, int fq) const {
        const int row0 = u.pm * BM + wr * 64 + fr, colb = u.pn * BM + wc * 32 + 8 * fq;
#pragma unroll
        for (int ai = 0; ai < 2; ++ai)
#pragma unroll
            for (int m = 0; m < 4; ++m) {
                const int row = row0 + ai * HALF + m * 16;
                bf16_t* xr = A2 + (size_t)row * DMODEL + colb;
                float ss = 0.f;
#pragma unroll
                for (int bj = 0; bj < 2; ++bj) {
                    const u32x4 xw = *(const u32x4*)(xr + bj * HALF);
                    const f32x4 x0 = {__uint_as_float(xw.x << 16), __uint_as_float(xw.x & 0xffff0000u), __uint_as_float(xw.y << 16), __uint_as_float(xw.y & 0xffff0000u)};
                    const f32x4 x1 = {__uint_as_float(xw.z << 16), __uint_as_float(xw.z & 0xffff0000u), __uint_as_float(xw.w << 16), __uint_as_float(xw.w & 0xffff0000u)};
                    const f32x4 v0 = acc[ai][bj][m][0] + x0, v1 = acc[ai][bj][m][1] + x1;
                    *(u32x4*)(xr + bj * HALF) = pack8(v0, v1);
                    ss += (v0[0] * v0[0] + v0[1] * v0[1]) + (v0[2] * v0[2] + v0[3] * v0[3]) + (v1[0] * v1[0] + v1[1] * v1[1]) + (v1[2] * v1[2] + v1[3] * v1[3]);
                }
                ss += __shfl_xor(ss, 16); ss += __shfl_xor(ss, 32);
                if (fq == 0) sq[(size_t)row * 16 + u.pn * 4 + wc] = ss;
            }
    }
};
template <class Epi, class Sched, bool ALIGN_EPI = false, bool SP2 = false>
__device__ __forceinline__ void gemm_phase(PG8_LAS unsigned char* lds, const Gemm g, const Sched& S, const Epi& E) {
    const int tid = threadIdx.x, wid = __builtin_amdgcn_readfirstlane(tid >> 6), lane = tid & 63, wr = wid >> 2, wc = wid & 3, fr = lane & 15, fq = lane >> 4;
    const int K = g.K, nt = K / BK;
    unsigned voffA[2], voffB[2];
#pragma unroll
    for (int i = 0; i < 2; ++i) { int R, C; stage_rc(tid * 16 + i * 8192, R, C); const int Rb = Epi::PERM ? ((R & ~31) + perm32(R & 31)) : R;
        voffA[i] = (unsigned)(R * g.lda + C) * 2u; voffB[i] = (unsigned)(Rb * K + C) * 2u; }
    const size_t kstep = (size_t)(BK * 2);
    const size_t hstepB = (size_t)HALF * K * 2, hstepA = (size_t)HALF * g.lda * 2;
    const size_t tstepB = 2 * hstepB, tstepA = 2 * hstepA;
    const unsigned ldsw = (unsigned)wid * 1024u;
    const int aoff = lds_byte(wr * 64 + fr, fq * 8), boff = lds_byte(wc * 32 + fr, fq * 8);
#define PG8_SA(b, h) (((b) * 2 + (h)) * HTB)
#define PG8_SB(b, h) ((4 + (b) * 2 + (h)) * HTB)
#define PG8_STAGE(bufoff, gbase, voff) do { _Pragma("unroll") for (int _i = 0; _i < 2; ++_i) \
        __builtin_amdgcn_global_load_lds((const unsigned*)((const char*)(gbase) + (voff)[_i]), (PG8_LAS unsigned*)(lds + (bufoff) + ldsw + _i * 8192), 16, 0, 0); } while (0)
#define PG8_LDA(dst, b, h) do { _Pragma("unroll") for (int m = 0; m < 4; ++m) _Pragma("unroll") for (int k = 0; k < 2; ++k) dst[m][k] = *(const PG8_LAS bf16x8*)(lds + PG8_SA(b, h) + aoff + m * 2048 + k * 1024); } while (0)
#define PG8_LDB(dst, b, h) do { _Pragma("unroll") for (int n = 0; n < 2; ++n) _Pragma("unroll") for (int k = 0; k < 2; ++k) dst[n][k] = *(const PG8_LAS bf16x8*)(lds + PG8_SB(b, h) + boff + n * 2048 + k * 1024); } while (0)
#define PG8_MMA(ai, bj, At, Bt) do { __builtin_amdgcn_s_setprio(1); _Pragma("unroll") for (int m = 0; m < 4; ++m) _Pragma("unroll") for (int n = 0; n < 2; ++n) _Pragma("unroll") for (int k = 0; k < 2; ++k) \
        acc[ai][bj][m][n] = __builtin_amdgcn_mfma_f32_16x16x32_bf16(Bt[n][k], At[m][k], acc[ai][bj][m][n], 0, 0, 0); __builtin_amdgcn_s_setprio(0); } while (0)
#define PG8_WAIT_V(n) asm volatile("s_waitcnt vmcnt(" #n ")" ::: "memory")
#define PG8_WAIT_L(n) asm volatile("s_waitcnt lgkmcnt(" #n ")" ::: "memory")
#define PG8_BAR __builtin_amdgcn_s_barrier()
#define PG8_SCHED __builtin_amdgcn_sched_barrier(0)
    Unit cur, nxt; int ui = 0;
    if (!S.next(0, cur)) return;
    f32x4 acc[2][2][4][2];
#pragma unroll
    for (int a = 0; a < 2; ++a)
#pragma unroll
        for (int b = 0; b < 2; ++b)
#pragma unroll
            for (int m = 0; m < 4; ++m)
#pragma unroll
                for (int n = 0; n < 2; ++n) acc[a][b][m][n] = (f32x4){0.f, 0.f, 0.f, 0.f};
    bf16x8 At[4][2], B0[2][2], B1[2][2];
    const char* cA = (const char*)g.A + (size_t)cur.pm * tstepA; const char* cB = (const char*)g.Bt + (size_t)cur.pn * tstepB;
    S.a_ready(cur);
    if constexpr (SP2) {
        PG8_STAGE(PG8_SB(0, 0), cB, voffB); PG8_STAGE(PG8_SB(0, 1), cB + hstepB, voffB); PG8_STAGE(PG8_SA(0, 0), cA, voffA); PG8_STAGE(PG8_SA(0, 1), cA + hstepA, voffA);
        if (wr == 1) PG8_BAR;
        PG8_WAIT_V(2); PG8_BAR;
        PG8_STAGE(PG8_SB(1, 0), cB + kstep, voffB); PG8_STAGE(PG8_SA(1, 0), cA + kstep, voffA); PG8_STAGE(PG8_SB(1, 1), cB + hstepB + kstep, voffB);
        PG8_WAIT_V(6); PG8_BAR;
    } else {
        PG8_STAGE(PG8_SB(0, 0), cB, voffB); PG8_STAGE(PG8_SA(0, 0), cA, voffA); PG8_STAGE(PG8_SB(0, 1), cB + hstepB, voffB); PG8_STAGE(PG8_SA(0, 1), cA + hstepA, voffA);
        if (wr == 1) PG8_BAR;
        PG8_WAIT_V(4); PG8_BAR;
        PG8_STAGE(PG8_SB(1, 0), cB + kstep, voffB); PG8_STAGE(PG8_SA(1, 0), cA + kstep, voffA); PG8_STAGE(PG8_SB(1, 1), cB + hstepB + kstep, voffB);
        PG8_WAIT_V(6); PG8_BAR;
    }
    for (;;) {
        const bool has_next = S.next(ui + 1, nxt);
        const char* nA = has_next ? (const char*)g.A + (size_t)nxt.pm * tstepA : cA; const char* nB = has_next ? (const char*)g.Bt + (size_t)nxt.pn * tstepB : cB;
        for (int t = 0; t < nt; t += 2) {
            const bool last = (t == nt - 2);
            const char* a1 = cA + (size_t)(t + 1) * kstep;
            const char* a2 = last ? nA : cA + (size_t)(t + 2) * kstep; const char* b2 = last ? nB : cB + (size_t)(t + 2) * kstep;
            const char* a3 = a2 + kstep; const char* b3 = b2 + kstep;
            if (last && has_next) S.a_ready(nxt);
            if constexpr (SP2) {
            PG8_LDB(B0, 0, 0); PG8_LDB(B1, 0, 1); PG8_SCHED; PG8_LDA(At, 0, 0); PG8_STAGE(PG8_SA(1, 1), a1 + hstepA, voffA);
            PG8_WAIT_V(8); PG8_WAIT_L(0); PG8_BAR; PG8_MMA(0, 0, At, B0); PG8_MMA(0, 1, At, B1); PG8_BAR; PG8_SCHED;
            PG8_LDA(At, 0, 1); PG8_STAGE(PG8_SB(0, 0), b2, voffB); PG8_STAGE(PG8_SB(0, 1), b2 + hstepB, voffB); PG8_STAGE(PG8_SA(0, 0), a2, voffA);
            PG8_WAIT_V(8); PG8_WAIT_L(0); PG8_BAR; PG8_MMA(1, 0, At, B0); PG8_MMA(1, 1, At, B1); PG8_BAR; PG8_SCHED;
            PG8_LDB(B0, 1, 0); PG8_LDB(B1, 1, 1); PG8_SCHED; PG8_LDA(At, 1, 0); PG8_STAGE(PG8_SA(0, 1), a2 + hstepA, voffA);
            PG8_WAIT_V(8); PG8_WAIT_L(0); PG8_BAR; PG8_MMA(0, 0, At, B0); PG8_MMA(0, 1, At, B1); PG8_BAR; PG8_SCHED;
            PG8_LDA(At, 1, 1); PG8_STAGE(PG8_SB(1, 0), b3, voffB); PG8_STAGE(PG8_SB(1, 1), b3 + hstepB, voffB); PG8_STAGE(PG8_SA(1, 0), a3, voffA);
            PG8_WAIT_V(8); PG8_WAIT_L(0); PG8_BAR; PG8_MMA(1, 0, At, B0); PG8_MMA(1, 1, At, B1); PG8_BAR; PG8_SCHED;
            } else {
            PG8_LDB(B0, 0, 0); PG8_SCHED; PG8_LDA(At, 0, 0); PG8_STAGE(PG8_SA(1, 1), a1 + hstepA, voffA);
            PG8_WAIT_L(8); PG8_BAR; PG8_WAIT_L(0); PG8_MMA(0, 0, At, B0); PG8_BAR; PG8_SCHED;
            PG8_LDB(B1, 0, 1); PG8_STAGE(PG8_SB(0, 0), b2, voffB);
            PG8_BAR; PG8_WAIT_L(0); PG8_MMA(0, 1, At, B1); PG8_BAR;
            PG8_LDA(At, 0, 1); PG8_STAGE(PG8_SA(0, 0), a2, voffA);
            PG8_BAR; PG8_WAIT_L(0); PG8_MMA(1, 0, At, B0); PG8_BAR; PG8_SCHED;
            PG8_STAGE(PG8_SB(0, 1), b2 + hstepB, voffB);
            PG8_WAIT_V(6); PG8_BAR; PG8_MMA(1, 1, At, B1); PG8_BAR;
            PG8_LDB(B0, 1, 0); PG8_SCHED; PG8_LDA(At, 1, 0); PG8_STAGE(PG8_SA(0, 1), a2 + hstepA, voffA);
            PG8_WAIT_L(8); PG8_BAR; PG8_WAIT_L(0); PG8_MMA(0, 0, At, B0); PG8_BAR; PG8_SCHED;
            PG8_LDB(B1, 1, 1); PG8_STAGE(PG8_SB(1, 0), b3, voffB);
            PG8_BAR; PG8_WAIT_L(0); PG8_MMA(0, 1, At, B1); PG8_BAR;
            PG8_LDA(At, 1, 1); PG8_STAGE(PG8_SA(1, 0), a3, voffA);
            PG8_BAR; PG8_WAIT_L(0); PG8_MMA(1, 0, At, B0); PG8_BAR; PG8_SCHED;
            PG8_STAGE(PG8_SB(1, 1), b3 + hstepB, voffB);
            PG8_WAIT_V(6); PG8_BAR; PG8_MMA(1, 1, At, B1); PG8_BAR;
            }
        }
        if constexpr (ALIGN_EPI) { if (wr == 0) PG8_BAR; }
        if constexpr (!Epi::AFTER_DRAIN) { E(acc, cur, wr, wc, fr, fq); S.done(cur); }
        if (!has_next) break;
#pragma unroll
        for (int a = 0; a < 2; ++a)
#pragma unroll
            for (int b = 0; b < 2; ++b)
#pragma unroll
                for (int m = 0; m < 4; ++m)
#pragma unroll
                    for (int n = 0; n < 2; ++n) acc[a][b][m][n] = (f32x4){0.f, 0.f, 0.f, 0.f};
        cur = nxt; cA = nA; cB = nB; ++ui;
        if constexpr (ALIGN_EPI) { if (wr == 1) PG8_BAR; }
    }
    PG8_WAIT_V(0);
    if constexpr (!ALIGN_EPI) { if (wr == 0) PG8_BAR; }
    PG8_BAR;
    if constexpr (Epi::AFTER_DRAIN) { E.fused(acc, cur, wr, wc, fr, fq, lds, wid, lane); S.done(cur); }
#undef PG8_SA
#undef PG8_SB
#undef PG8_STAGE
#undef PG8_LDA
#undef PG8_LDB
#undef PG8_MMA
#undef PG8_WAIT_V
#undef PG8_WAIT_L
#undef PG8_BAR
#undef PG8_SCHED
}
}
#define GAS __attribute__((address_space(1)))
#define LAS __attribute__((address_space(3)))
typedef unsigned short bf16;
typedef unsigned v4u __attribute__((ext_vector_type(4)));
typedef float f32x4 __attribute__((ext_vector_type(4)));
typedef short bf16x8 __attribute__((ext_vector_type(8)));
typedef GAS unsigned gu32;
typedef GAS unsigned long long gu64;
#define RLX_AGENT __ATOMIC_RELAXED, __HIP_MEMORY_SCOPE_AGENT
#define LDS_WAIT() asm volatile("s_waitcnt lgkmcnt(0)" ::: "memory")
#define VM_WAIT() asm volatile("s_waitcnt vmcnt(0)" ::: "memory")
__device__ __forceinline__ unsigned long long rt() { return __builtin_amdgcn_s_memrealtime(); }
__device__ __forceinline__ unsigned f2bf(float f) { unsigned u = __builtin_bit_cast(unsigned, f); return (u + 0x7fffu + ((u >> 16) & 1u)) >> 16; }
__device__ __forceinline__ unsigned pk2(float lo, float hi) { return f2bf(lo) | (f2bf(hi) << 16); }

#define XB_TMO      128
#define XB_XCNT(j)  (256  + 64 * (j))
#define XB_XSUB(j)  (1280 + 64 * (j))
#define XB_XGEN(j)  (2304 + 64 * (j))
#define XB_TOP      3328
#define XB_TOPGEN   3392
#define XCD_BAR_WORDS 3456
#define XB_SPIN_CAP (1u << 18)

__device__ __forceinline__ unsigned xb_ld(unsigned* p)              { return __hip_atomic_load(p, __ATOMIC_RELAXED, __HIP_MEMORY_SCOPE_AGENT); }
__device__ __forceinline__ unsigned xb_add(unsigned* p, unsigned v) { return __hip_atomic_fetch_add(p, v, __ATOMIC_RELAXED, __HIP_MEMORY_SCOPE_AGENT); }
__device__ __forceinline__ unsigned xb_xcc_id() { return (unsigned)__builtin_amdgcn_s_getreg((3 << 11) | 20) & 0xFu; }
#define XB_SPIN(cond, bar) do { unsigned _sp = 0; while (cond) { __builtin_amdgcn_s_sleep(1); \
    if ((++_sp & 255u) == 0u) { if (xb_ld(&(bar)[XB_TMO])) break; if (_sp > XB_SPIN_CAP) { atomicAdd(&(bar)[XB_TMO], 1u); break; } } } } while (0)

struct XcdBarrier {
    unsigned* bar; unsigned x;
    volatile LAS unsigned* st;
};

__device__ __forceinline__ XcdBarrier xcd_barrier_post(unsigned* bar, volatile LAS unsigned* st) {
    XcdBarrier b; b.bar = bar; b.x = xb_xcc_id(); b.st = st;
    if (threadIdx.x == 0) (void)xb_add(&bar[XB_XCNT(b.x)], 1u);
    return b;
}
__device__ __forceinline__ void xcd_barrier_complete(unsigned* bar, unsigned x, unsigned& nloc, unsigned& nx) {
    const unsigned G = gridDim.x * gridDim.y * gridDim.z;
    unsigned sum, cnt, mine, sp = 0u;
    for (;;) {
        sum = 0u; cnt = 0u; mine = 0u;
#pragma unroll
        for (unsigned j = 0; j < 16; ++j) { const unsigned c = xb_ld(&bar[XB_XCNT(j)]); sum += c; cnt += (c > 0u) ? 1u : 0u; mine = (j == x) ? c : mine; }
        if (sum == G) break;
        __builtin_amdgcn_s_sleep(1);
        if ((++sp & 255u) == 0u) { if (xb_ld(&bar[XB_TMO])) break; if (sp > XB_SPIN_CAP) { atomicAdd(&bar[XB_TMO], 1u); break; } }
    }
    nloc = mine > 0u ? mine : 1u; nx = cnt > 0u ? cnt : 1u;
}

__device__ __forceinline__ void xcd_barrier(const XcdBarrier& b) {
    asm volatile("s_waitcnt vmcnt(0)" ::: "memory");
    __syncthreads();
    if (threadIdx.x == 0) {
        unsigned* bar = b.bar;
        __builtin_amdgcn_s_waitcnt(0);
        unsigned nloc = b.st[0], nx = b.st[1];
        if (nloc == 0u) { xcd_barrier_complete(bar, b.x, nloc, nx); b.st[0] = nloc; b.st[1] = nx; }
        const unsigned old = xb_add(&bar[XB_XSUB(b.x)], 1u);
        const unsigned gen = old / nloc;
        if (old + 1u == (gen + 1u) * nloc) {
            __builtin_amdgcn_fence(__ATOMIC_RELEASE, "agent");
            asm volatile("s_waitcnt vmcnt(0)" ::: "memory");
            const unsigned og = xb_add(&bar[XB_TOP], 1u);
            const unsigned tg = og / nx;
            if (og + 1u == (tg + 1u) * nx) xb_add(&bar[XB_TOPGEN], 1u);
            else XB_SPIN(xb_ld(&bar[XB_TOPGEN]) == tg, bar);
            __builtin_amdgcn_fence(__ATOMIC_ACQUIRE, "agent");
            xb_add(&bar[XB_XGEN(b.x)], 1u);
            asm volatile("s_waitcnt vmcnt(0)" ::: "memory");
        } else {
            XB_SPIN(xb_ld(&bar[XB_XGEN(b.x)]) == gen, bar);
            __builtin_amdgcn_fence(__ATOMIC_ACQUIRE, "agent");
            asm volatile("s_waitcnt vmcnt(0)" ::: "memory");
        }
    }
    __syncthreads();
}
constexpr int NWAVES = 8;
constexpr int M_TOK = 98304, M_PROMPT = 65536, D = 1024, NP = 3584, NWIN = 3616, FF = 4096;
constexpr int L_PROMPT = 2048, L_SAMPLE = 16384;
constexpr float EPS = 1e-6f;
constexpr size_t MiB = 1u << 20;
constexpr size_t WS_CTL = 0, CTL_ZERO_BYTES = 1 * MiB;
constexpr size_t WS_WIN = 1 * MiB;
constexpr size_t WS_WOUT = 9 * MiB;
constexpr size_t WS_W1 = 11 * MiB;
constexpr size_t WS_W2 = 19 * MiB;
constexpr size_t WS_ROPE = 27 * MiB;
constexpr size_t WS_GA = 35 * MiB;
constexpr size_t WS_RSTD = 47 * MiB;
constexpr size_t WS_SQ1 = 48 * MiB;
constexpr size_t WS_SQ2 = 54 * MiB;
constexpr size_t WS_DEC = 60 * MiB;
constexpr size_t WS_R0 = 64 * MiB;
constexpr size_t WS_R1 = 256 * MiB;
constexpr size_t WS_END = 1024 * MiB;
constexpr int CW_BAR = 4096;
constexpr int RING_OFF = 0, RING_BYTES = 131072;
constexpr int LDSCTL_OFF = 147456 - 1024, MISC_OFF = LDSCTL_OFF + 320;
constexpr int LDS_BYTES = 147456;

struct Frame {
    LAS unsigned char* lds;
    volatile LAS unsigned* MISC;
    int tid, lane, wave, vcu, G;
};
__device__ __forceinline__ float wave_sum(float v) {
#pragma unroll
    for (int o = 1; o < 64; o <<= 1) v += __shfl_xor(v, o);
    return v;
}
__device__ __forceinline__ float bf2f(bf16 b) { return __uint_as_float((unsigned)b << 16); }
__device__ __forceinline__ unsigned cvtpk(float lo, float hi) { unsigned r; asm volatile("v_cvt_pk_bf16_f32 %0, %1, %2" : "=v"(r) : "v"(lo), "v"(hi)); return r; }

__device__ __forceinline__ void win_map(int nd, int& sc, float& cs) {
    cs = 1.f;
    if (nd < 512) sc = 512 + nd;
    else if (nd < 1024) sc = 2592 + (nd - 512);
    else if (nd < 1280) { sc = nd - 1024; cs = 0.125f; }
    else if (nd < 1536) sc = 256 + (nd - 1280);
    else if (nd < 2048) sc = 1024 + (nd - 1536);
    else if (nd < 3072) {
        const bool isq = nd < 2560; const int p = nd - (isq ? 2048 : 2560), h = p >> 7, pp = p & 127, u = pp >> 3, j = pp & 7;
        const int d = (j < 4) ? 4 * u + j : 64 + 4 * u + (j - 4);
        sc = (isq ? 1568 : 2080) + 128 * h + d; if (isq) cs = 0.08838834764831845f; }
    else if (nd < 3584) sc = 3104 + (nd - 3072);
    else sc = 1536 + (nd - 3584);
}
template <bool MAP>
__device__ __forceinline__ void p0_transpose_item(const float* W, int K, int Nsrc, int nblk, const float* ks, bf16* WT, LAS float* scr, int item, int lane) {
    const int kb = item / nblk, nb = item % nblk, k0 = 64 * kb, n0 = 32 * nb;
    int sc = n0 + (lane & 31); float cs = 1.f;
    if (MAP) win_map(n0 + (lane & 31), sc, cs);
#pragma unroll 8
    for (int i = 0; i < 32; ++i) { const int kk = 2 * i + (lane >> 5); float w = W[(size_t)(k0 + kk) * Nsrc + sc] * cs; if (ks) w *= ks[k0 + kk]; scr[kk * 33 + (lane & 31)] = w; }
    LDS_WAIT(); asm volatile("" ::: "memory");
    const int c = lane & 7;
#pragma unroll
    for (int j = 0; j < 4; ++j) { const int n = (lane >> 3) + 8 * j; const LAS float* s = scr + (8 * c) * 33 + n;
        v4u o; o.x = cvtpk(s[0 * 33], s[1 * 33]); o.y = cvtpk(s[2 * 33], s[3 * 33]); o.z = cvtpk(s[4 * 33], s[5 * 33]); o.w = cvtpk(s[6 * 33], s[7 * 33]);
        *(GAS v4u*)(WT + (size_t)(n0 + n) * K + k0 + 8 * c) = o; }
    LDS_WAIT(); asm volatile("" ::: "memory");
}
__device__ __forceinline__ void rope_entry(int e, float* rcos, float* rsin) {
    const int pos = e >> 6, i = e & 63;
    double inv = 1.0, b = 0.8659643233600653;
#pragma unroll
    for (int bit = 0; bit < 6; ++bit) { if ((i >> bit) & 1) inv *= b; b *= b; }
    const double ang = (double)pos * inv;
    const double n = __builtin_rint(ang * 0.6366197723675814);
    double r = __builtin_fma(-n, 1.5707963267948966, ang); r = __builtin_fma(-n, 6.123233995736766e-17, r);
    const double r2 = r * r;
    double s = -1.0 / 1307674368000.0;
    s = s * r2 + 1.0 / 6227020800.0; s = s * r2 - 1.0 / 39916800.0; s = s * r2 + 1.0 / 362880.0; s = s * r2 - 1.0 / 5040.0; s = s * r2 + 1.0 / 120.0; s = s * r2 - 1.0 / 6.0; s = s * r2 * r + r;
    double c = 1.0 / 20922789888000.0;
    c = c * r2 - 1.0 / 87178291200.0; c = c * r2 + 1.0 / 479001600.0; c = c * r2 - 1.0 / 3628800.0; c = c * r2 + 1.0 / 40320.0; c = c * r2 - 1.0 / 720.0; c = c * r2 + 1.0 / 24.0; c = c * r2 - 0.5; c = c * r2 + 1.0;
    const int q = ((int)n) & 3;
    const double cs = (q == 0) ? c : (q == 1) ? -s : (q == 2) ? -c : s;
    const double sn = (q == 0) ? s : (q == 1) ? c : (q == 2) ? -s : -c;
    rcos[e] = (float)cs; rsin[e] = (float)sn;
}
struct P0Args { const float *xp, *xs, *anw, *win, *wout, *mnw, *w1, *w2; bf16 *Win_t, *Wout_t, *W1_t, *W2_t, *Xb; float *rcos, *rsin, *ga, *rstd; };
__device__ __forceinline__ void p0_prologue(Frame& F, const P0Args& a) {
    LAS float* scr = (LAS float*)(F.lds + RING_OFF + F.wave * 16384);
    const int gw = F.vcu * NWAVES + F.wave, NGW = F.G * NWAVES;
    constexpr int I_IN = (D / 64) * (NWIN / 32), I_O = (D / 64) * (D / 32), I_1 = (D / 64) * (FF / 32), I_2 = (FF / 64) * (D / 32);
    constexpr int NITEMS = I_IN + I_O + I_1 + I_2;
    for (int it = gw; it < NITEMS; it += NGW) {
        int r = it;
        if (r < I_IN) { p0_transpose_item<true>(a.win, D, NWIN, NWIN / 32, a.anw, a.Win_t, scr, r, F.lane); continue; } r -= I_IN;
        if (r < I_O) { p0_transpose_item<false>(a.wout, D, D, D / 32, nullptr, a.Wout_t, scr, r, F.lane); continue; } r -= I_O;
        if (r < I_1) { p0_transpose_item<false>(a.w1, D, FF, FF / 32, a.mnw, a.W1_t, scr, r, F.lane); continue; } r -= I_1;
        p0_transpose_item<false>(a.w2, FF, D, D / 32, nullptr, a.W2_t, scr, r, F.lane);
    }
    for (int e = (blockIdx.x * NWAVES * 64) + F.tid; e < 16384 * 64; e += F.G * NWAVES * 64) rope_entry(e, a.rcos, a.rsin);
    __syncthreads();
    LAS bf16* wl = (LAS bf16*)(F.lds + RING_OFF);
    for (int e = F.tid; e < 32 * 1024; e += NWAVES * 64) { const int k = e >> 5, c = e & 31; wl[c * 1032 + k] = (bf16)(cvtpk(a.win[(size_t)k * NWIN + 1536 + c] * a.anw[k], 0.f) & 0xffffu); }
    __syncthreads();
    const int r = F.lane & 15, g = F.lane >> 4;
    for (int item = gw; item < M_TOK / 16; item += NGW) {
        const int row = item * 16 + r;
        const float* xrow = (row < M_PROMPT ? a.xp + (size_t)row * D : a.xs + (size_t)(row - M_PROMPT) * D) + 8 * g;
        bf16* xb = a.Xb + (size_t)row * D + 8 * g;
        f32x4 acc0 = {0.f, 0.f, 0.f, 0.f}, acc1 = {0.f, 0.f, 0.f, 0.f}; float ss = 0.f;
#pragma unroll 4
        for (int s = 0; s < 32; ++s) {
            const f32x4 x0 = *(const GAS f32x4*)(xrow + 32 * s), x1 = *(const GAS f32x4*)(xrow + 32 * s + 4);
            ss += (x0[0] * x0[0] + x0[1] * x0[1]) + (x0[2] * x0[2] + x0[3] * x0[3]) + (x1[0] * x1[0] + x1[1] * x1[1]) + (x1[2] * x1[2] + x1[3] * x1[3]);
            v4u p; p.x = cvtpk(x0[0], x0[1]); p.y = cvtpk(x0[2], x0[3]); p.z = cvtpk(x1[0], x1[1]); p.w = cvtpk(x1[2], x1[3]);
            *(GAS v4u*)(xb + 32 * s) = p;
            const bf16x8 af = __builtin_bit_cast(bf16x8, p);
            const bf16x8 b0 = *(const LAS bf16x8*)(wl + r * 1032 + 32 * s + 8 * g), b1 = *(const LAS bf16x8*)(wl + (16 + r) * 1032 + 32 * s + 8 * g);
            acc0 = __builtin_amdgcn_mfma_f32_16x16x32_bf16(af, b0, acc0, 0, 0, 0);
            acc1 = __builtin_amdgcn_mfma_f32_16x16x32_bf16(af, b1, acc1, 0, 0, 0);
        }
        ss += __shfl_xor(ss, 16); ss += __shfl_xor(ss, 32);
        const float rs = 1.0f / sqrtf(ss * (1.0f / 1024.0f) + EPS);
        if (g == 0) a.rstd[row] = rs;
#pragma unroll
        for (int q = 0; q < 4; ++q) { const int rr = 4 * g + q; const float rq = __shfl(rs, rr);
            a.ga[(size_t)(item * 16 + rr) * 32 + r] = acc0[q] * rq; a.ga[(size_t)(item * 16 + rr) * 32 + 16 + r] = acc1[q] * rq; }
    }
}

__device__ __forceinline__ float log_sigmoid_f(float z) { return fminf(z, 0.f) - log1pf(expf(-fabsf(z))); }
struct MixArgs { bf16* proj; const float* ga; const float *waf, *baf, *wab, *bab; float* of; const float *gnw, *rnw, *rnb; };
constexpr int NTB = 16;
template <int DK, bool GLA, bool BWD>
__device__ __forceinline__ void naive_sweep(Frame& F, const MixArgs& a, int job) {
    const int grp = F.tid >> 7, gt = F.tid & 127;
    int seq, head; if (job < 16) { seq = 32 + (job >> 3); head = job & 7; } else { seq = (job - 16) >> 3; head = (job - 16) & 7; }
    const int L = seq < 32 ? L_PROMPT : L_SAMPLE, row_base = seq < 32 ? seq * L_PROMPT : M_PROMPT + (seq - 32) * L_SAMPLE;
    const int hh = GLA ? head : head - 4;
    const int qcol = GLA ? 1024 + 64 * hh : 2048 + 128 * hh, kcol = GLA ? 1280 + 64 * hh : 2560 + 128 * hh, vcol = 128 * head;
    LAS float* sq = (LAS float*)(F.lds + grp * (3 * NTB * 128 * 4)); LAS float* sk = sq + NTB * DK; LAS float* sa = sk + NTB * DK;
    const float gam = 1.0f - exp2f(-5.0f - (float)hh);
    const float* wal = BWD ? a.wab : a.waf; const float* bal = BWD ? a.bab : a.baf;
    float S[DK];
#pragma unroll
    for (int t = 0; t < DK; ++t) S[t] = 0.f;
    for (int t0 = 0; t0 < L; t0 += NTB) {
        __syncthreads();
        for (int e = gt; e < NTB * DK; e += 128) {
            const int tok = e / DK, t = e % DK, tp = t0 + tok, row = row_base + (BWD ? L - 1 - tp : tp);
            const bf16* pr = a.proj + (size_t)row * NP;
            sq[e] = bf2f(pr[qcol + t]); sk[e] = bf2f(pr[kcol + t]);
            if (GLA) { const float* gar = a.ga + (size_t)row * 32 + (BWD ? 16 : 0); float z = bal[64 * hh + t];
#pragma unroll
                for (int r = 0; r < 16; ++r) z += gar[r] * wal[r * 256 + 64 * hh + t];
                sa[e] = expf(fmaxf(log_sigmoid_f(z) * (1.0f / 16.0f), -1.0f)); }
        }
        __syncthreads();
        for (int tok = 0; tok < NTB; ++tok) {
            const int tp = t0 + tok, row = row_base + (BWD ? L - 1 - tp : tp);
            const float vv = bf2f(a.proj[(size_t)row * NP + vcol + gt]);
            float o = 0.f;
#pragma unroll
            for (int t4 = 0; t4 < DK / 4; ++t4) {
                const f32x4 q = *(const LAS f32x4*)(sq + tok * DK + 4 * t4), k = *(const LAS f32x4*)(sk + tok * DK + 4 * t4);
                f32x4 al = {gam, gam, gam, gam}; if (GLA) al = *(const LAS f32x4*)(sa + tok * DK + 4 * t4);
#pragma unroll
                for (int j = 0; j < 4; ++j) {
                    if (!BWD) { S[4 * t4 + j] = al[j] * S[4 * t4 + j] + k[j] * vv; o += q[j] * S[4 * t4 + j]; }
                    else { S[4 * t4 + j] *= al[j]; o += q[j] * S[4 * t4 + j]; S[4 * t4 + j] += k[j] * vv; }
                }
            }
            float* op = a.of + (size_t)row * D + 128 * head + gt;
            if (!BWD) *op = o; else *op += o;
        }
    }
}
template <bool BWD>
__device__ __forceinline__ void naive_mix_phase(Frame& F, const MixArgs& a) {
    if (blockIdx.x >= 68) return;
    const int job = blockIdx.x * 4 + (F.tid >> 7);
    if ((blockIdx.x & 1) == 0) { if (!MIX_GLA) naive_sweep<64, true, BWD>(F, a, job); } else { if (!MIX_RET) naive_sweep<128, false, BWD>(F, a, job); }
}
__device__ __forceinline__ void naive_combine(Frame& F, const MixArgs& a) {
    const int gw = F.vcu * NWAVES + F.wave, NGW = F.G * NWAVES, c = 2 * F.lane;
    for (int item = gw; item < M_TOK * 8; item += NGW) {
        const int row = item >> 3, head = item & 7;
        if (head < 4 ? MIX_GLA : MIX_RET) continue;
        const float* op = a.of + (size_t)row * D + 128 * head + c;
        float o0 = op[0], o1 = op[1], y0, y1;
        if (head < 4) { const float r = 1.0f / sqrtf(wave_sum(o0 * o0 + o1 * o1) * (1.0f / 128.0f) + EPS); y0 = o0 * r * a.gnw[c]; y1 = o1 * r * a.gnw[c + 1]; }
        else { const float mu = wave_sum(o0 + o1) * (1.0f / 128.0f); o0 -= mu; o1 -= mu; const float r = 1.0f / sqrtf(wave_sum(o0 * o0 + o1 * o1) * (1.0f / 128.0f) + EPS);
            const int cc = 128 * (head - 4) + c; y0 = o0 * r * a.rnw[cc] + a.rnb[cc]; y1 = o1 * r * a.rnw[cc + 1] + a.rnb[cc + 1]; }
        bf16* pr = a.proj + (size_t)row * NP;
        const int gcol = (head < 4 ? 1536 + 128 * head : 3072 + 128 * (head - 4)) + c;
        const unsigned gw2 = *(const unsigned*)(pr + gcol);
        const float g0 = __uint_as_float(gw2 << 16), g1 = __uint_as_float(gw2 & 0xffff0000u);
        y0 *= g0 / (1.0f + expf(-g0)); y1 *= g1 / (1.0f + expf(-g1));
        *(unsigned*)(pr + 128 * head + c) = cvtpk(y0, y1);
    }
}
__device__ __forceinline__ void final_norm(Frame& F, float* out, const bf16* x2b, const float* sq, const float* w) {
    const int gw = F.vcu * NWAVES + F.wave, NGW = F.G * NWAVES;
    for (int row = gw; row < M_TOK; row += NGW) {
        const f32x4* s4 = (const f32x4*)(sq + (size_t)row * 16);
        const f32x4 t = (s4[0] + s4[1]) + (s4[2] + s4[3]);
        const float r = 1.0f / sqrtf(((t[0] + t[1]) + (t[2] + t[3])) * (1.0f / 1024.0f) + EPS);
        const GAS v4u* xi = (const GAS v4u*)(x2b + (size_t)row * D) + F.lane;
        GAS f32x4* o = (GAS f32x4*)(out + (size_t)row * D) + 2 * F.lane; const f32x4* w4 = (const f32x4*)w + 2 * F.lane;
#pragma unroll
        for (int j = 0; j < 2; ++j) { const v4u xw = xi[64 * j];
            const f32x4 x0 = {__uint_as_float(xw.x << 16), __uint_as_float(xw.x & 0xffff0000u), __uint_as_float(xw.y << 16), __uint_as_float(xw.y & 0xffff0000u)};
            const f32x4 x1 = {__uint_as_float(xw.z << 16), __uint_as_float(xw.z & 0xffff0000u), __uint_as_float(xw.w << 16), __uint_as_float(xw.w & 0xffff0000u)};
            o[128 * j] = x0 * r * w4[128 * j]; o[128 * j + 1] = x1 * r * w4[128 * j + 1]; }
    }
}

typedef __bf16 bf16v2 __attribute__((ext_vector_type(2)));
typedef unsigned u32x2 __attribute__((ext_vector_type(2)));
__device__ __forceinline__ unsigned cvtpk_c(float lo, float hi) { bf16v2 v = {(__bf16)lo, (__bf16)hi}; return __builtin_bit_cast(unsigned, v); }
__device__ __forceinline__ float bflo(unsigned w) { return __uint_as_float(w << 16); }
__device__ __forceinline__ float bfhi(unsigned w) { return __uint_as_float(w & 0xffff0000u); }
__device__ __forceinline__ int opaque_i(int x) { asm volatile("" : "+v"(x)); return x; }
typedef short s16x4 __attribute__((ext_vector_type(4)));
#define TRRD(ptr) __builtin_amdgcn_ds_read_tr16_b64_v4i16((LAS s16x4*)(ptr))
constexpr size_t ST_SC_BYTES = 393216;
__device__ __forceinline__ size_t state_off(int sc, bool gla, int hh, int dir) { return (size_t)sc * ST_SC_BYTES + (gla ? (size_t)(hh * 2 + dir) * 16384 : (size_t)131072 + (size_t)(hh * 2 + dir) * 32768); }
struct CMixArgs { bf16* proj; const float* ga; const float *waf, *baf, *wab, *bab; unsigned char* st; float* dec; const float *gnw, *rnw, *rnb; bf16* mo; int mop; unsigned char* sto; unsigned char* ofs; };
constexpr int OB_PITCH = 132;

template <bool GLA> struct RawSet;
template <> struct RawSet<true> { v4u q, k, v0, v1; f32x4 ga[4]; };
template <> struct RawSet<false> { v4u q0, q1, k0, k1, v0, v1; };

template <bool GLA, bool WITH_O>
__device__ __forceinline__ void raw_load(RawSet<GLA>& R, const CMixArgs& a, int p, int s, int w, int lane0) {
    const int lane = opaque_i(lane0), sc = p >> 2, hh = p & 3, dir = s >> 2, c = dir ? 7 - s : s;
    const int row = sc * 256 + 64 * c + 8 * w + (lane >> 3), pc = lane & 7;
    const bf16* pr = a.proj + (size_t)row * NP + 8 * pc;
    if constexpr (GLA) {
        if (WITH_O) R.q = *(const GAS v4u*)(pr + 1024 + 64 * hh);
        R.k = *(const GAS v4u*)(pr + 1280 + 64 * hh);
        R.v0 = *(const GAS v4u*)(pr + 128 * hh); R.v1 = *(const GAS v4u*)(pr + 128 * hh + 64);
#pragma unroll
        for (int x = 0; x < 4; ++x) R.ga[x] = *(const GAS f32x4*)(a.ga + (size_t)row * 32 + 16 * dir + 4 * x);
    } else {
        if (WITH_O) { R.q0 = *(const GAS v4u*)(pr + 2048 + 128 * hh); R.q1 = *(const GAS v4u*)(pr + 2048 + 128 * hh + 64); }
        R.k0 = *(const GAS v4u*)(pr + 2560 + 128 * hh); R.k1 = *(const GAS v4u*)(pr + 2560 + 128 * hh + 64);
        R.v0 = *(const GAS v4u*)(pr + 512 + 128 * hh); R.v1 = *(const GAS v4u*)(pr + 512 + 128 * hh + 64);
    }
}

template <int DK, bool GLA, bool WITH_O> struct MixLds {
    static constexpr int NT = DK / 16, NS = DK / 32;
    static constexpr int RQ = DK * 2 + 16, RP = 144, RV = 272;
    static constexpr int O_QD = 0, O_KI = 64 * RQ, O_KE = 2 * 64 * RQ, O_PB = 3 * 64 * RQ, O_VB = O_PB + 64 * RP, O_DC = O_VB + 64 * RV, O_WAL = O_DC + DK * 4,
                         O_WT = O_WAL + (GLA ? 8704 : 0), O_OB = O_WT + (GLA ? 2048 : 0), O_END = O_OB + 64 * OB_PITCH * 4;
    static_assert(O_END <= 146432, "mixer LDS map");
};

template <int DK, bool GLA, bool WITH_O>
__device__ __forceinline__ void mix_step(Frame& F, const CMixArgs& a, int p, int s, int pnext, RawSet<GLA>& R, f32x4 (&S)[DK / 16], float (&dsum)[8]) {
    typedef MixLds<DK, GLA, WITH_O> ML;
    constexpr int NT = ML::NT, NS = ML::NS, RQ = ML::RQ, RP = ML::RP, RV = ML::RV;
    LAS unsigned char* L = F.lds;
    const int lane0 = F.lane, w = F.wave;
    const int sc = p >> 2, hh = p & 3, dir = s >> 2, c = dir ? 7 - s : s, row0 = sc * 256, head = GLA ? hh : 4 + hh, vcol = 128 * head;
    __syncthreads();
    {
        const int lane = opaque_i(lane0), i = 8 * w + (lane >> 3), pc = lane & 7;
        *(LAS v4u*)(L + ML::O_VB + i * RV + 16 * pc) = R.v0; *(LAS v4u*)(L + ML::O_VB + i * RV + 128 + 16 * pc) = R.v1;
        if constexpr (GLA) {
            float la[8];
            { const LAS float* wl = (const LAS float*)(L + ML::O_WAL) + dir * 1024 + 8 * pc; const LAS float* bl = (const LAS float*)(L + ML::O_WAL) + 2048 + dir * 64 + 8 * pc;
              f32x4 z0 = *(const LAS f32x4*)bl, z1 = *(const LAS f32x4*)(bl + 4);
#pragma unroll
              for (int r = 0; r < 16; ++r) { const float gr = R.ga[r >> 2][r & 3]; z0 += gr * *(const LAS f32x4*)(wl + r * 64); z1 += gr * *(const LAS f32x4*)(wl + r * 64 + 4); }
#pragma unroll
              for (int e = 0; e < 8; ++e) { const float z = e < 4 ? z0[e & 3] : z1[e & 3];
                  const float ls = fminf(z, 0.f) - __logf(1.0f + __expf(-fabsf(z)));
                  la[e] = fmaxf(ls * (1.0f / 16.0f), -1.0f); } }
            const int tk = lane >> 3;
#pragma unroll
            for (int d = 1; d < 8; d <<= 1) { const int src = dir ? tk + d : tk - d; const bool ok = dir ? (src < 8) : (src >= 0);
#pragma unroll
                for (int e = 0; e < 8; ++e) { const float y = __shfl(la[e], (lane & 7) + 8 * (src & 7)); if (ok) la[e] += y; } }
            if (tk == (dir ? 0 : 7)) { LAS float* wt = (LAS float*)(L + ML::O_WT) + w * 64 + 8 * pc; *(LAS f32x4*)wt = (f32x4){la[0], la[1], la[2], la[3]}; *(LAS f32x4*)(wt + 4) = (f32x4){la[4], la[5], la[6], la[7]}; }
            __syncthreads();
            float pre[8], tot[8];
#pragma unroll
            for (int e = 0; e < 8; ++e) { pre[e] = 0.f; tot[e] = 0.f; }
#pragma unroll
            for (int ww = 0; ww < 8; ++ww) { const LAS float* wt = (const LAS float*)(L + ML::O_WT) + ww * 64 + 8 * pc; const f32x4 t0 = *(const LAS f32x4*)wt, t1 = *(const LAS f32x4*)(wt + 4);
                const bool in = dir ? (ww > w) : (ww < w);
#pragma unroll
                for (int e = 0; e < 8; ++e) { const float t = e < 4 ? t0[e & 3] : t1[e & 3]; tot[e] += t; if (in) pre[e] += t; } }
            float q8[8], k8[8], e8[8];
#pragma unroll
            for (int e = 0; e < 8; ++e) { const float b = la[e] + pre[e], bl_ = tot[e];
                const unsigned wq = WITH_O ? ((const unsigned*)&R.q)[e >> 1] : 0u, wk = ((const unsigned*)&R.k)[e >> 1];
                const float qv = (e & 1) ? bfhi(wq) : bflo(wq), kv = (e & 1) ? bfhi(wk) : bflo(wk);
                q8[e] = qv * __expf(b); k8[e] = kv * __expf(-b); e8[e] = kv * __expf(bl_ - b);
                if (!WITH_O) dsum[e] += bl_;
                if (w == 0 && tk == 0) ((LAS float*)(L + ML::O_DC))[8 * pc + e] = __expf(bl_); }
            v4u oq, ok, oe;
            oq.x = cvtpk_c(q8[0], q8[1]); oq.y = cvtpk_c(q8[2], q8[3]); oq.z = cvtpk_c(q8[4], q8[5]); oq.w = cvtpk_c(q8[6], q8[7]);
            ok.x = cvtpk_c(k8[0], k8[1]); ok.y = cvtpk_c(k8[2], k8[3]); ok.z = cvtpk_c(k8[4], k8[5]); ok.w = cvtpk_c(k8[6], k8[7]);
            oe.x = cvtpk_c(e8[0], e8[1]); oe.y = cvtpk_c(e8[2], e8[3]); oe.z = cvtpk_c(e8[4], e8[5]); oe.w = cvtpk_c(e8[6], e8[7]);
            if (WITH_O) { *(LAS v4u*)(L + ML::O_QD + i * RQ + 16 * pc) = oq; *(LAS v4u*)(L + ML::O_KI + i * RQ + 16 * pc) = ok; }
            *(LAS v4u*)(L + ML::O_KE + i * RQ + 16 * pc) = oe;
        } else {
            const float l2g = hh == 0 ? -0.045803689613124f : hh == 1 ? -0.022720076500083f : hh == 2 ? -0.011315313227834f : -0.005646563141142f;
            const float nq = dir ? (float)(64 - i) : (float)(i + 1), ne = dir ? (float)i : (float)(63 - i);
            const float eb = exp2f(l2g * nq), ei = exp2f(-l2g * nq), ee = exp2f(l2g * ne);
#pragma unroll
            for (int x = 0; x < 2; ++x) { v4u oq, ok, oe; const v4u rq = x ? R.q1 : R.q0, rk = x ? R.k1 : R.k0;
#pragma unroll
                for (int j = 0; j < 4; ++j) { const unsigned wq = WITH_O ? ((const unsigned*)&rq)[j] : 0u, wk = ((const unsigned*)&rk)[j];
                    ((unsigned*)&oq)[j] = cvtpk_c(bflo(wq) * eb, bfhi(wq) * eb); ((unsigned*)&ok)[j] = cvtpk_c(bflo(wk) * ei, bfhi(wk) * ei); ((unsigned*)&oe)[j] = cvtpk_c(bflo(wk) * ee, bfhi(wk) * ee); }
                if (WITH_O) { *(LAS v4u*)(L + ML::O_QD + i * RQ + 128 * x + 16 * pc) = oq; *(LAS v4u*)(L + ML::O_KI + i * RQ + 128 * x + 16 * pc) = ok; }
                *(LAS v4u*)(L + ML::O_KE + i * RQ + 128 * x + 16 * pc) = oe; }
            if (w == 0 && lane < 32) *(LAS f32x4*)(L + ML::O_DC + lane * 16) = (f32x4){exp2f(l2g * 64.0f), exp2f(l2g * 64.0f), exp2f(l2g * 64.0f), exp2f(l2g * 64.0f)};
        }
    }
    if (s < 6) raw_load<GLA, WITH_O>(R, a, p, s + 2, w, lane0); else if (pnext < 1536) raw_load<GLA, WITH_O>(R, a, pnext, s - 6, w, lane0);
    u32x2 ofr[4]; v4u gt0, gt1;
    unsigned char* ofs = nullptr;
    if (WITH_O) { const int lane = opaque_i(lane0);
        ofs = a.ofs + ((size_t)(((GLA ? 0 : 1536) + p) * 4 + c) * 8 + w) * 2048 + lane * 8;
        if (dir) {
#pragma unroll
            for (int m = 0; m < 4; ++m) ofr[m] = *(const GAS u32x2*)(ofs + m * 512);
            const bf16* gp = a.proj + (size_t)(row0 + 64 * c + 8 * w + (lane >> 3)) * NP + (GLA ? 1536 + 128 * hh : 3072 + 128 * hh) + 16 * (lane & 7);
            gt0 = *(const GAS v4u*)gp; gt1 = *(const GAS v4u*)(gp + 8); } }
    __syncthreads();
    if (WITH_O) {
        const int lane = opaque_i(lane0), g = lane >> 4, lr = lane & 15;
        const int mi = w >> 1;
#pragma unroll
        for (int jj = 0; jj < 2; ++jj) { const int nj = 2 * (w & 1) + jj;
            f32x4 acc = {0.f, 0.f, 0.f, 0.f};
#pragma unroll
            for (int s2 = 0; s2 < NS; ++s2) {
                const bf16x8 af = *(const LAS bf16x8*)(L + ML::O_KI + (16 * nj + lr) * RQ + 64 * s2 + 16 * g);
                const bf16x8 bf = *(const LAS bf16x8*)(L + ML::O_QD + (16 * mi + lr) * RQ + 64 * s2 + 16 * g);
                acc = __builtin_amdgcn_mfma_f32_16x16x32_bf16(af, bf, acc, 0, 0, 0); }
            const int ii = 16 * mi + lr;
#pragma unroll
            for (int r = 0; r < 4; ++r) { const int j = 16 * nj + 4 * g + r; const bool keep = dir ? (j > ii) : (j <= ii); acc[r] = keep ? acc[r] : 0.f; }
            u32x2 pk; pk.x = cvtpk_c(acc[0], acc[1]); pk.y = cvtpk_c(acc[2], acc[3]);
            *(LAS u32x2*)(L + ML::O_PB + ii * RP + 32 * nj + 8 * g) = pk; }
        __syncthreads();
    }
    f32x4 o[4];
    {
        const int lane = opaque_i(lane0), g = lane >> 4, lr = lane & 15, q4 = lr >> 2, p4 = lr & 3;
        const LAS unsigned char* vb = L + ML::O_VB + (8 * g + q4) * RV + 32 * w + 8 * p4;
        const bf16x8 vf0 = __builtin_shufflevector(TRRD(vb), TRRD(vb + 4 * RV), 0, 1, 2, 3, 4, 5, 6, 7), vf1 = __builtin_shufflevector(TRRD(vb + 32 * RV), TRRD(vb + 36 * RV), 0, 1, 2, 3, 4, 5, 6, 7);
        if (WITH_O) {
#pragma unroll
            for (int m = 0; m < 4; ++m) {
                const bf16x8 p0 = *(const LAS bf16x8*)(L + ML::O_PB + (16 * m + lr) * RP + 16 * g), p1 = *(const LAS bf16x8*)(L + ML::O_PB + (16 * m + lr) * RP + 64 + 16 * g);
                o[m] = __builtin_amdgcn_mfma_f32_16x16x32_bf16(p0, vf0, (f32x4){0.f, 0.f, 0.f, 0.f}, 0, 0, 0);
                o[m] = __builtin_amdgcn_mfma_f32_16x16x32_bf16(p1, vf1, o[m], 0, 0, 0); }
#pragma unroll
            for (int s2 = 0; s2 < NS; ++s2) {
                const bf16x8 sf = __builtin_bit_cast(bf16x8, (v4u){cvtpk_c(S[2 * s2][0], S[2 * s2][1]), cvtpk_c(S[2 * s2][2], S[2 * s2][3]), cvtpk_c(S[2 * s2 + 1][0], S[2 * s2 + 1][1]), cvtpk_c(S[2 * s2 + 1][2], S[2 * s2 + 1][3])});
#pragma unroll
                for (int m = 0; m < 4; ++m) {
                    const u32x2 lo = *(const LAS u32x2*)(L + ML::O_QD + (16 * m + lr) * RQ + 64 * s2 + 8 * g), hi = *(const LAS u32x2*)(L + ML::O_QD + (16 * m + lr) * RQ + 64 * s2 + 32 + 8 * g);
                    const bf16x8 qf = __builtin_bit_cast(bf16x8, (v4u){lo.x, lo.y, hi.x, hi.y});
                    o[m] = __builtin_amdgcn_mfma_f32_16x16x32_bf16(qf, sf, o[m], 0, 0, 0); } }
        }
#pragma unroll
        for (int tt = 0; tt < NT; ++tt) {
            const f32x4 d4 = *(const LAS f32x4*)(L + ML::O_DC + (16 * tt + 4 * g) * 4);
            S[tt] = S[tt] * d4;
            const LAS unsigned char* kb = L + ML::O_KE + (8 * g + q4) * RQ + 32 * tt + 8 * p4;
            const bf16x8 kf0 = __builtin_shufflevector(TRRD(kb), TRRD(kb + 4 * RQ), 0, 1, 2, 3, 4, 5, 6, 7), kf1 = __builtin_shufflevector(TRRD(kb + 32 * RQ), TRRD(kb + 36 * RQ), 0, 1, 2, 3, 4, 5, 6, 7);
            S[tt] = __builtin_amdgcn_mfma_f32_16x16x32_bf16(kf0, vf0, S[tt], 0, 0, 0);
            S[tt] = __builtin_amdgcn_mfma_f32_16x16x32_bf16(kf1, vf1, S[tt], 0, 0, 0);
        }
    }
    if (WITH_O) {
        const int lane = opaque_i(lane0), g = lane >> 4, lr = lane & 15;
        if (dir == 0) {
#pragma unroll
            for (int m = 0; m < 4; ++m) { u32x2 pk; pk.x = cvtpk_c(o[m][0], o[m][1]); pk.y = cvtpk_c(o[m][2], o[m][3]); *(GAS u32x2*)(ofs + m * 512) = pk; }
        } else {
            LAS float* ob = (LAS float*)(L + ML::O_OB);
#pragma unroll
            for (int m = 0; m < 4; ++m) { const f32x4 t = {o[m][0] + bflo(ofr[m].x), o[m][1] + bfhi(ofr[m].x), o[m][2] + bflo(ofr[m].y), o[m][3] + bfhi(ofr[m].y)};
#pragma unroll
                for (int r = 0; r < 4; ++r) ob[(16 * m + 4 * g + r) * OB_PITCH + 16 * w + lr] = t[r]; }
            __syncthreads();
            const int row = 8 * w + (lane >> 3), pc = lane & 7;
            f32x4 x[4];
#pragma unroll
            for (int k = 0; k < 4; ++k) x[k] = *(const LAS f32x4*)(ob + row * OB_PITCH + 16 * pc + 4 * k);
            float rs;
            if (GLA) { float ss = 0.f;
#pragma unroll
                for (int k = 0; k < 4; ++k) ss += (x[k][0] * x[k][0] + x[k][1] * x[k][1]) + (x[k][2] * x[k][2] + x[k][3] * x[k][3]);
                ss += __shfl_xor(ss, 1); ss += __shfl_xor(ss, 2); ss += __shfl_xor(ss, 4);
                rs = __builtin_amdgcn_rsqf(ss * (1.0f / 128.0f) + EPS); }
            else { float sm = 0.f;
#pragma unroll
                for (int k = 0; k < 4; ++k) sm += (x[k][0] + x[k][1]) + (x[k][2] + x[k][3]);
                sm += __shfl_xor(sm, 1); sm += __shfl_xor(sm, 2); sm += __shfl_xor(sm, 4);
                const float mu = sm * (1.0f / 128.0f); float ss = 0.f;
#pragma unroll
                for (int k = 0; k < 4; ++k) { x[k] = x[k] - mu; ss += (x[k][0] * x[k][0] + x[k][1] * x[k][1]) + (x[k][2] * x[k][2] + x[k][3] * x[k][3]); }
                ss += __shfl_xor(ss, 1); ss += __shfl_xor(ss, 2); ss += __shfl_xor(ss, 4);
                rs = __builtin_amdgcn_rsqf(ss * (1.0f / 128.0f) + EPS); }
            const float* wp = GLA ? a.gnw + 16 * pc : a.rnw + 128 * hh + 16 * pc; const float* bp = a.rnb + 128 * hh + 16 * pc;
            unsigned ow[8];
#pragma unroll
            for (int k = 0; k < 4; ++k) { const f32x4 w4 = *(const GAS f32x4*)(wp + 4 * k); f32x4 y = x[k] * rs * w4;
                if (!GLA) y = y + *(const GAS f32x4*)(bp + 4 * k);
                const unsigned ga_ = k < 2 ? ((const unsigned*)&gt0)[2 * k] : ((const unsigned*)&gt1)[2 * k - 4], gb_ = k < 2 ? ((const unsigned*)&gt0)[2 * k + 1] : ((const unsigned*)&gt1)[2 * k - 3];
                const float g0 = bflo(ga_), g1 = bfhi(ga_), g2 = bflo(gb_), g3 = bfhi(gb_);
                y[0] *= g0 * __builtin_amdgcn_rcpf(1.0f + __expf(-g0)); y[1] *= g1 * __builtin_amdgcn_rcpf(1.0f + __expf(-g1));
                y[2] *= g2 * __builtin_amdgcn_rcpf(1.0f + __expf(-g2)); y[3] *= g3 * __builtin_amdgcn_rcpf(1.0f + __expf(-g3));
                ow[2 * k] = cvtpk_c(y[0], y[1]); ow[2 * k + 1] = cvtpk_c(y[2], y[3]); }
            bf16* op = a.mo + (size_t)(row0 + 64 * c + row) * a.mop + vcol + 16 * pc;
            *(GAS v4u*)op = (v4u){ow[0], ow[1], ow[2], ow[3]}; *(GAS v4u*)(op + 8) = (v4u){ow[4], ow[5], ow[6], ow[7]};
        }
    }
}

template <int DK, bool GLA, bool WITH_O>
__device__ __forceinline__ void mix_units(Frame& F, const CMixArgs& a) {
    typedef MixLds<DK, GLA, WITH_O> ML;
    constexpr int NT = DK / 16;
    const int w = F.wave, lane0 = F.lane;
    int p = (int)blockIdx.x;
    if (p >= 1536) return;
    RawSet<GLA> RA, RB;
    raw_load<GLA, WITH_O>(RA, a, p, 0, w, lane0); raw_load<GLA, WITH_O>(RB, a, p, 1, w, lane0);
    f32x4 S[NT]; float dsum[8];
#pragma unroll 1
    for (; p < 1536; p += F.G) {
        const int sc = p >> 2, hh = p & 3, pnext = p + F.G;
        if (GLA) { __syncthreads();
            LAS float* wl = (LAS float*)(F.lds + ML::O_WAL);
            for (int e = F.tid; e < 2 * 16 * 64; e += NWAVES * 64) { const int d = e >> 10, r = (e >> 6) & 15, t = e & 63; wl[e] = (d ? a.wab : a.waf)[r * 256 + 64 * hh + t]; }
            if (F.tid < 128) { const int d = F.tid >> 6, t = F.tid & 63; wl[2048 + F.tid] = (d ? a.bab : a.baf)[64 * hh + t]; } }
#pragma unroll 1
        for (int dir = 0; dir < 2; ++dir) {
            const int lane = opaque_i(lane0);
            unsigned char* sp = a.st + state_off(sc, GLA, hh, dir) + (size_t)(unsigned)(w * NT * 512 + lane * 8);
            if (WITH_O) {
#pragma unroll
                for (int tt = 0; tt < NT; ++tt) { const u32x2 pk = *(const GAS u32x2*)(sp + tt * 512); S[tt] = (f32x4){bflo(pk.x), bfhi(pk.x), bflo(pk.y), bfhi(pk.y)}; } }
            else {
#pragma unroll
                for (int tt = 0; tt < NT; ++tt) S[tt] = (f32x4){0.f, 0.f, 0.f, 0.f};
#pragma unroll
                for (int e = 0; e < 8; ++e) dsum[e] = 0.f; }
#pragma unroll 1
            for (int h2 = 0; h2 < 2; ++h2) {
                mix_step<DK, GLA, WITH_O>(F, a, p, 4 * dir + 2 * h2, pnext, RA, S, dsum);
                mix_step<DK, GLA, WITH_O>(F, a, p, 4 * dir + 2 * h2 + 1, pnext, RB, S, dsum);
            }
            if (!WITH_O) {
#pragma unroll
                for (int tt = 0; tt < NT; ++tt) { u32x2 pk; pk.x = cvtpk_c(S[tt][0], S[tt][1]); pk.y = cvtpk_c(S[tt][2], S[tt][3]); *(GAS u32x2*)(sp + tt * 512) = pk; }
                if (GLA && w == 0 && lane < 8) { float* dp = a.dec + (size_t)((sc * 4 + hh) * 2 + dir) * 64 + 8 * lane;
#pragma unroll
                    for (int e = 0; e < 8; ++e) dp[e] = __expf(dsum[e]); }
            }
        }
    }
}
struct RetKV { v4u k0, k1, v0, v1; };
__device__ __forceinline__ void ret_kv_load(RetKV& R, const CMixArgs& a, int p, int kb, int tid0) {
    const int tid = opaque_i(tid0), sc = p >> 2, hh = p & 3;
    const int r0 = tid >> 4, c16 = tid & 15;
    const bf16* pr = a.proj + (size_t)(sc * 256 + 64 * kb + r0) * NP + 8 * c16;
    R.k0 = *(const GAS v4u*)(pr + 2560 + 128 * hh); R.k1 = *(const GAS v4u*)(pr + (size_t)32 * NP + 2560 + 128 * hh);
    R.v0 = *(const GAS v4u*)(pr + 512 + 128 * hh);  R.v1 = *(const GAS v4u*)(pr + (size_t)32 * NP + 512 + 128 * hh);
}
constexpr int RD_RK = 272, RD_KB = 64 * RD_RK;
__device__ __forceinline__ void ret_block(Frame& F, const CMixArgs& a, int p, int kb, int pnext, RetKV& R, const bf16x8 (&Qf)[2][4], f32x4 (&O)[8][2]) {
    LAS unsigned char* L = F.lds;
    const int w = F.wave, hh = p & 3;
    const float l2g = hh == 0 ? -0.045803689613124f : hh == 1 ? -0.022720076500083f : hh == 2 ? -0.011315313227834f : -0.005646563141142f;
    LAS unsigned char* KB = L + (kb & 1) * RD_KB; LAS unsigned char* VB = L + 2 * RD_KB + (kb & 1) * RD_KB;
    { const int tid = opaque_i(F.tid), r0 = tid >> 4, c16 = tid & 15;
      *(LAS v4u*)(KB + r0 * RD_RK + 16 * c16) = R.k0; *(LAS v4u*)(KB + (r0 + 32) * RD_RK + 16 * c16) = R.k1;
      *(LAS v4u*)(VB + r0 * RD_RK + 16 * c16) = R.v0; *(LAS v4u*)(VB + (r0 + 32) * RD_RK + 16 * c16) = R.v1; }
    if (kb < 3) ret_kv_load(R, a, p, kb + 1, F.tid); else if (pnext < 1536) ret_kv_load(R, a, pnext, 0, F.tid);
    __syncthreads();
    const int lane = opaque_i(F.lane), g = lane >> 4, lr = lane & 15, q4 = lr >> 2, p4 = lr & 3;
#pragma unroll
    for (int sp = 0; sp < 2; ++sp) {
        f32x4 st[2][2];
#pragma unroll
        for (int h = 0; h < 2; ++h)
#pragma unroll
            for (int it = 0; it < 2; ++it) st[h][it] = (f32x4){0.f, 0.f, 0.f, 0.f};
#pragma unroll
        for (int s = 0; s < 4; ++s)
#pragma unroll
            for (int h = 0; h < 2; ++h) {
                const LAS unsigned char* kp = KB + (32 * sp + 16 * h + lr) * RD_RK + 64 * s + 8 * g;
                const u32x2 lo = *(const LAS u32x2*)kp, hi = *(const LAS u32x2*)(kp + 32);
                const bf16x8 kf = __builtin_bit_cast(bf16x8, (v4u){lo.x, lo.y, hi.x, hi.y});
#pragma unroll
                for (int it = 0; it < 2; ++it) st[h][it] = __builtin_amdgcn_mfma_f32_16x16x32_bf16(kf, Qf[it][s], st[h][it], 0, 0, 0);
                if (h == 1 && (s & 1)) __builtin_amdgcn_sched_barrier(0);
            }
        bf16x8 pf[2];
#pragma unroll
        for (int it = 0; it < 2; ++it) {
            const int i = 32 * w + 16 * it + lr;
            unsigned pw[4];
#pragma unroll
            for (int h = 0; h < 2; ++h) { float e[4];
#pragma unroll
                for (int r = 0; r < 4; ++r) { const int j = 64 * kb + 32 * sp + 16 * h + 4 * g + r; const int d = i - j; e[r] = st[h][it][r] * __builtin_amdgcn_exp2f(l2g * (float)(d < 0 ? -d : d)); }
                pw[2 * h] = cvtpk_c(e[0], e[1]); pw[2 * h + 1] = cvtpk_c(e[2], e[3]); }
            pf[it] = __builtin_bit_cast(bf16x8, (v4u){pw[0], pw[1], pw[2], pw[3]});
        }
#pragma unroll
        for (int dt = 0; dt < 8; ++dt) {
            const LAS unsigned char* vp = VB + (32 * sp + 4 * g + q4) * RD_RK + 32 * dt + 8 * p4;
            const bf16x8 vf = __builtin_shufflevector(TRRD(vp), TRRD(vp + 16 * RD_RK), 0, 1, 2, 3, 4, 5, 6, 7);
#pragma unroll
            for (int it = 0; it < 2; ++it) O[dt][it] = __builtin_amdgcn_mfma_f32_16x16x32_bf16(vf, pf[it], O[dt][it], 0, 0, 0);
            if (dt & 1) __builtin_amdgcn_sched_barrier(0);
        }
    }
}
__device__ __forceinline__ void ret_q_load(bf16x8 (&Qf)[2][4], const CMixArgs& a, int p, int w, int lane0) {
    const int lane = opaque_i(lane0), g = lane >> 4, lr = lane & 15, sc = p >> 2, hh = p & 3;
#pragma unroll
    for (int it = 0; it < 2; ++it) { const bf16* qp = a.proj + (size_t)(sc * 256 + 32 * w + 16 * it + lr) * NP + 2048 + 128 * hh + 4 * g;
#pragma unroll
        for (int s = 0; s < 4; ++s) { const u32x2 lo = *(const GAS u32x2*)(qp + 32 * s), hi = *(const GAS u32x2*)(qp + 32 * s + 16); Qf[it][s] = __builtin_bit_cast(bf16x8, (v4u){lo.x, lo.y, hi.x, hi.y}); } }
}
__device__ __forceinline__ void ret_units_direct(Frame& F, const CMixArgs& a) {
    const int w = F.wave;
    int p = (int)blockIdx.x;
    if (p >= 1536) return;
    RetKV RA; bf16x8 Qf[2][4];
    ret_kv_load(RA, a, p, 0, F.tid);
    ret_q_load(Qf, a, p, w, F.lane);
#pragma unroll 1
    for (; p < 1536; p += F.G) {
        const int sc = p >> 2, hh = p & 3, pnext = p + F.G;
        const float l2g = hh == 0 ? -0.045803689613124f : hh == 1 ? -0.022720076500083f : hh == 2 ? -0.011315313227834f : -0.005646563141142f;
        f32x4 O[8][2];
#pragma unroll
        for (int dt = 0; dt < 8; ++dt)
#pragma unroll
            for (int it = 0; it < 2; ++it) O[dt][it] = (f32x4){0.f, 0.f, 0.f, 0.f};
#pragma unroll 1
        for (int kb = 0; kb < 4; ++kb) ret_block(F, a, p, kb, pnext, RA, Qf, O);
        { const int lane = opaque_i(F.lane), lr = lane & 15;
#pragma unroll
          for (int dir = 0; dir < 2; ++dir) {
              const unsigned char* sp_ = a.st + state_off(sc, false, hh, dir) + (size_t)(unsigned)(lane * 8);
              float f[2];
#pragma unroll
              for (int it = 0; it < 2; ++it) { const int i = 32 * w + 16 * it + lr; f[it] = __builtin_amdgcn_exp2f(l2g * (float)(dir ? 256 - i : i + 1)); }
#pragma unroll
              for (int s = 0; s < 4; ++s) {
                  bf16x8 qs[2];
#pragma unroll
                  for (int it = 0; it < 2; ++it) { const v4u qw = __builtin_bit_cast(v4u, Qf[it][s]); v4u o;
#pragma unroll
                      for (int j = 0; j < 4; ++j) ((unsigned*)&o)[j] = cvtpk_c(bflo(((const unsigned*)&qw)[j]) * f[it], bfhi(((const unsigned*)&qw)[j]) * f[it]);
                      qs[it] = __builtin_bit_cast(bf16x8, o); }
#pragma unroll
                  for (int dt = 0; dt < 8; ++dt) { const u32x2 lo = *(const GAS u32x2*)(sp_ + (dt * 8 + 2 * s) * 512), hi = *(const GAS u32x2*)(sp_ + (dt * 8 + 2 * s + 1) * 512);
                      const bf16x8 cf = __builtin_bit_cast(bf16x8, (v4u){lo.x, lo.y, hi.x, hi.y});
#pragma unroll
                      for (int it = 0; it < 2; ++it) O[dt][it] = __builtin_amdgcn_mfma_f32_16x16x32_bf16(cf, qs[it], O[dt][it], 0, 0, 0); }
                  __builtin_amdgcn_sched_barrier(0);
              }
          } }
        if (pnext < 1536) ret_q_load(Qf, a, pnext, w, F.lane);
        { const int lane = opaque_i(F.lane), g = lane >> 4, lr = lane & 15;
#pragma unroll
          for (int it = 0; it < 2; ++it) {
              const size_t row = (size_t)(sc * 256 + 32 * w + 16 * it + lr);
              const bf16* gp = a.proj + row * NP + 3072 + 128 * hh + 4 * g; bf16* op = a.mo + row * a.mop + 512 + 128 * hh + 4 * g;
              u32x2 gt[8];
#pragma unroll
              for (int dt = 0; dt < 8; ++dt) gt[dt] = *(const GAS u32x2*)(gp + 16 * dt);
              float sm = 0.f;
#pragma unroll
              for (int dt = 0; dt < 8; ++dt) sm += (O[dt][it][0] + O[dt][it][1]) + (O[dt][it][2] + O[dt][it][3]);
              sm += __shfl_xor(sm, 16); sm += __shfl_xor(sm, 32);
              const float mu = sm * (1.0f / 128.0f); float ss = 0.f;
#pragma unroll
              for (int dt = 0; dt < 8; ++dt) { O[dt][it] = O[dt][it] - mu; ss += (O[dt][it][0] * O[dt][it][0] + O[dt][it][1] * O[dt][it][1]) + (O[dt][it][2] * O[dt][it][2] + O[dt][it][3] * O[dt][it][3]); }
              ss += __shfl_xor(ss, 16); ss += __shfl_xor(ss, 32);
              const float rs = __builtin_amdgcn_rsqf(ss * (1.0f / 128.0f) + EPS);
#pragma unroll
              for (int dt = 0; dt < 8; ++dt) { const f32x4 w4 = *(const GAS f32x4*)(a.rnw + 128 * hh + 16 * dt + 4 * g), b4 = *(const GAS f32x4*)(a.rnb + 128 * hh + 16 * dt + 4 * g);
                  f32x4 y = O[dt][it] * rs * w4 + b4;
                  const float g0 = bflo(gt[dt].x), g1 = bfhi(gt[dt].x), g2 = bflo(gt[dt].y), g3 = bfhi(gt[dt].y);
                  y[0] *= g0 * __builtin_amdgcn_rcpf(1.0f + __expf(-g0)); y[1] *= g1 * __builtin_amdgcn_rcpf(1.0f + __expf(-g1));
                  y[2] *= g2 * __builtin_amdgcn_rcpf(1.0f + __expf(-g2)); y[3] *= g3 * __builtin_amdgcn_rcpf(1.0f + __expf(-g3));
                  u32x2 pk; pk.x = cvtpk_c(y[0], y[1]); pk.y = cvtpk_c(y[2], y[3]);
                  *(GAS u32x2*)(op + 16 * dt) = pk; }
          } }
    }
}

template <bool WITH_O>
__device__ __forceinline__ void cmix_phase(Frame& F, const CMixArgs& a, int which = 3) {
#if MIX_GLA
    if (which & 1) { mix_units<64, true, WITH_O>(F, a);
    __syncthreads(); }
#endif
#if MIX_RET
    if (which & 2) { if constexpr (WITH_O) ret_units_direct(F, a); else mix_units<128, false, false>(F, a);
    __syncthreads(); }
#endif
}
__device__ __forceinline__ void scan_phase(Frame& F, const CMixArgs& a) {
    const int nthreads = F.G * NWAVES * 64;
    for (int chain = (int)blockIdx.x * NWAVES * 64 + F.tid; chain < 34 * 49152; chain += nthreads) {
        const int sq = chain / 49152, cidx = chain % 49152;
        const int seq = sq < 2 ? 32 + sq : sq - 2;
        const int sc0 = seq < 32 ? seq * 8 : 256 + (seq - 32) * 64, ns = seq < 32 ? 8 : 64;
        const bool gla = cidx < 16384; const int c2 = gla ? cidx : cidx - 16384;
        const int hd = gla ? (c2 >> 11) : (c2 >> 12), v = gla ? (c2 & 2047) : (c2 & 4095), hh = hd >> 1, dir = hd & 1;
        if ((gla && !MIX_GLA) || (!gla && !MIX_RET)) continue;
        const int t0 = 16 * ((v >> 6) & 3) + 4 * ((v & 63) >> 4);
        const float gret = exp2f(256.0f * log2f(1.0f - exp2f(-5.0f - (float)hh)));
        f32x4 cst = {0.f, 0.f, 0.f, 0.f};
        for (int blk = 0; blk < ns; blk += 8) {
            u32x2 kv[8]; f32x4 d[8];
#pragma unroll
            for (int j = 0; j < 8; ++j) { const int n = dir ? ns - 1 - (blk + j) : blk + j;
                kv[j] = *(const GAS u32x2*)(a.st + state_off(sc0 + n, gla, hh, dir) + (size_t)v * 8);
                d[j] = gla ? *(const GAS f32x4*)(a.dec + (size_t)(((sc0 + n) * 4 + hh) * 2 + dir) * 64 + t0) : (f32x4){gret, gret, gret, gret}; }
#pragma unroll
            for (int j = 0; j < 8; ++j) { const int n = dir ? ns - 1 - (blk + j) : blk + j;
                u32x2 pk; pk.x = cvtpk_c(cst[0], cst[1]); pk.y = cvtpk_c(cst[2], cst[3]);
                *(GAS u32x2*)(a.sto + state_off(sc0 + n, gla, hh, dir) + (size_t)v * 8) = pk;
                cst = d[j] * cst + (f32x4){bflo(kv[j].x), bfhi(kv[j].x), bflo(kv[j].y), bfhi(kv[j].y)}; }
        }
    }
}

#define NAIVE_MIX (!(MIX_GLA && MIX_RET))
constexpr int PB0 = NAIVE_MIX ? 8 : 5, NPH = PB0 + 4;
struct Args { const float* in[16]; float* out; unsigned char* ws; int ph_lo, ph_hi, use_bar, pad; };
__global__ void __launch_bounds__(NWAVES * 64, 2) fwd_kernel(Args args) {
    extern __shared__ __attribute__((aligned(16))) unsigned char lds[];
    Frame F;
    F.lds = (LAS unsigned char*)lds;
    F.MISC = (volatile LAS unsigned*)(F.lds + MISC_OFF);
    F.tid = threadIdx.x; F.lane = F.tid & 63; F.wave = __builtin_amdgcn_readfirstlane(F.tid >> 6);
    F.G = gridDim.x; { const int bx = blockIdx.x; F.vcu = (F.G % 8 == 0) ? (bx % 8) * (F.G / 8) + bx / 8 : bx; }
    unsigned char* ws = args.ws;
    gu32* ctl = (gu32*)(ws + WS_CTL);
    for (int u = F.tid; u < (LDS_BYTES - LDSCTL_OFF) / 4; u += NWAVES * 64) ((LAS unsigned*)(F.lds + LDSCTL_OFF))[u] = 0u;
    __syncthreads();
    XcdBarrier bar; bar.bar = (unsigned*)(ctl + CW_BAR); bar.x = 0; bar.st = nullptr;
    if (args.use_bar) bar = xcd_barrier_post((unsigned*)(ctl + CW_BAR), F.MISC + 8);
    const int lo = args.ph_lo, hi = args.ph_hi;
#define IN(k) (lo <= (k) && (k) < hi)
#define SEAM(k) do { if (IN(k) && IN((k) + 1)) xcd_barrier(bar); } while (0)
    if (IN(0)) { const P0Args pa{args.in[0], args.in[1], args.in[2], args.in[3], args.in[11], args.in[12], args.in[13], args.in[14], (bf16*)(ws + WS_WIN), (bf16*)(ws + WS_WOUT), (bf16*)(ws + WS_W1), (bf16*)(ws + WS_W2),
            (bf16*)(ws + WS_R0), (float*)(ws + WS_ROPE), (float*)(ws + WS_ROPE) + 16384 * 64, (float*)(ws + WS_GA), (float*)(ws + WS_RSTD)};
        p0_prologue(F, pa); __syncthreads(); }
    SEAM(0);
    if (IN(1)) { pg8::Gemm g{(bf16*)(ws + WS_R0), (bf16*)(ws + WS_WIN), M_TOK, NP, D, D}; pg8::StaticOrder S; S.init(M_TOK, NP, F.G, (int)blockIdx.x);
        pg8::EpiInProj E{(bf16*)(ws + WS_R1), (float*)(ws + WS_RSTD), (float*)(ws + WS_ROPE), (float*)(ws + WS_ROPE) + 16384 * 64};
#if REP1 == 2
        { pg8::EpiPlain E2{(bf16*)(ws + WS_R1)}; pg8::gemm_phase<pg8::EpiPlain, pg8::StaticOrder, true, true>(F.lds + RING_OFF, g, S, E2); } __syncthreads();
#endif
        pg8::gemm_phase<pg8::EpiInProj, pg8::StaticOrder, true, true>(F.lds + RING_OFF, g, S, E);
#if REP1 == 1
        __syncthreads(); pg8::gemm_phase<pg8::EpiInProj, pg8::StaticOrder, true, true>(F.lds + RING_OFF, g, S, E);
#endif
    }
    SEAM(1);
    if (IN(2)) { const CMixArgs ca{(bf16*)(ws + WS_R1), (float*)(ws + WS_GA), args.in[4], args.in[5], args.in[6], args.in[7], ws + WS_R0, (float*)(ws + WS_DEC), args.in[8], args.in[9], args.in[10], (bf16*)(ws + WS_R1), NP, ws + WS_R0, (unsigned char*)args.out};
        cmix_phase<false>(F, ca);
#if REP2
        cmix_phase<false>(F, ca, REP2);
#endif
    }
    SEAM(2);
    if (IN(3)) { const CMixArgs ca{(bf16*)(ws + WS_R1), (float*)(ws + WS_GA), args.in[4], args.in[5], args.in[6], args.in[7], ws + WS_R0, (float*)(ws + WS_DEC), args.in[8], args.in[9], args.in[10], (bf16*)(ws + WS_R1), NP, ws + WS_R0, (unsigned char*)args.out};
#if REP3
        { CMixArgs cb = ca; cb.sto = (unsigned char*)args.out + (size_t)224 * MiB; scan_phase(F, cb); }
#endif
        scan_phase(F, ca); }
    SEAM(3);
    if (IN(4)) { const CMixArgs ca{(bf16*)(ws + WS_R1), (float*)(ws + WS_GA), args.in[4], args.in[5], args.in[6], args.in[7], ws + WS_R0, (float*)(ws + WS_DEC), args.in[8], args.in[9], args.in[10], (bf16*)(ws + WS_R1), NP, ws + WS_R0, (unsigned char*)args.out};
#if REP4
        { CMixArgs cb = ca; cb.mo = (bf16*)((unsigned char*)args.out + (size_t)192 * MiB); cb.mop = 1024; cmix_phase<true>(F, cb, REP4); }
#endif
        cmix_phase<true>(F, ca); }
    SEAM(4);
#if NAIVE_MIX
    { const MixArgs ma{(bf16*)(ws + WS_R1), (float*)(ws + WS_GA), args.in[4], args.in[5], args.in[6], args.in[7], args.out, args.in[8], args.in[9], args.in[10]};
    if (IN(5)) { naive_mix_phase<false>(F, ma); __syncthreads(); }
    SEAM(5);
    if (IN(6)) { naive_mix_phase<true>(F, ma); __syncthreads(); }
    SEAM(6);
    if (IN(7)) { naive_combine(F, ma); }
    SEAM(7); }
#endif
    if (IN(PB0)) { pg8::Gemm g{(bf16*)(ws + WS_R1), (bf16*)(ws + WS_WOUT), M_TOK, D, D, NP}; pg8::StaticOrder S; S.init(M_TOK, D, F.G, (int)blockIdx.x);
        pg8::EpiResidX E{args.in[0], args.in[1], (bf16*)(ws + WS_R0), (float*)(ws + WS_SQ1)};
        pg8::gemm_phase<pg8::EpiResidX, pg8::StaticOrder, true, true>(F.lds + RING_OFF, g, S, E); }
    SEAM(PB0);
    if (IN(PB0 + 1)) { pg8::Gemm g{(bf16*)(ws + WS_R0), (bf16*)(ws + WS_W1), M_TOK, FF, D, D}; pg8::StaticOrder S; S.init(M_TOK, FF, F.G, (int)blockIdx.x);
        pg8::EpiFF1 E{(bf16*)(ws + WS_R1), (float*)(ws + WS_SQ1)};
        pg8::gemm_phase<pg8::EpiFF1, pg8::StaticOrder, true, true>(F.lds + RING_OFF, g, S, E);
#if REP6
        __syncthreads(); pg8::gemm_phase<pg8::EpiFF1, pg8::StaticOrder, true, true>(F.lds + RING_OFF, g, S, E);
#endif
    }
    SEAM(PB0 + 1);
    if (IN(PB0 + 2)) { pg8::Gemm g{(bf16*)(ws + WS_R1), (bf16*)(ws + WS_W2), M_TOK, D, FF, FF}; pg8::StaticOrder S; S.init(M_TOK, D, F.G, (int)blockIdx.x);
        pg8::EpiResidB E{(bf16*)(ws + WS_R0), (float*)(ws + WS_SQ2)};
        pg8::gemm_phase<pg8::EpiResidB, pg8::StaticOrder, true, true>(F.lds + RING_OFF, g, S, E); }
    SEAM(PB0 + 2);
    if (IN(PB0 + 3)) { final_norm(F, args.out, (const bf16*)(ws + WS_R0), (float*)(ws + WS_SQ2), args.in[15]); }
#undef IN
#undef SEAM
}

extern "C" void kernel_launch(void* const* d_in, const int* in_sizes, int n_in, void* d_out, int out_size, void* d_ws, size_t ws_size, hipStream_t stream) {
    static int grid = 0;
    if (grid == 0) {
        if (n_in != 16 || in_sizes[0] != M_PROMPT * D || out_size != M_TOK * D || ws_size < WS_END) {
            fprintf(stderr, "kernel_launch: unexpected shapes (n_in %d, in0 %d, out %d, ws %zu); nothing launched\n", n_in, n_in > 0 ? in_sizes[0] : -1, out_size, ws_size); grid = -1; return; }
        int dev = 0, cus = 0, per_cu = 0;
        if (hipGetDevice(&dev) != hipSuccess || hipDeviceGetAttribute(&cus, hipDeviceAttributeMultiprocessorCount, dev) != hipSuccess) { grid = -1; return; }
        if (hipFuncSetAttribute((const void*)fwd_kernel, hipFuncAttributeMaxDynamicSharedMemorySize, LDS_BYTES) != hipSuccess) { fprintf(stderr, "kernel_launch: hipFuncSetAttribute failed\n"); grid = -1; return; }
        if (hipOccupancyMaxActiveBlocksPerMultiprocessor(&per_cu, (const void*)fwd_kernel, NWAVES * 64, LDS_BYTES) != hipSuccess || per_cu < 1)
            fprintf(stderr, "kernel_launch: note: occupancy query reports %d workgroups per CU\n", per_cu);
        (void)hipGetLastError();
        grid = cus;
    }
    if (grid < 0) return;
    if (hipMemsetAsync((char*)d_ws + WS_CTL, 0, CTL_ZERO_BYTES, stream) != hipSuccess) return;
    Args a{};
    for (int i = 0; i < 16; ++i) a.in[i] = (const float*)d_in[i];
    a.out = (float*)d_out; a.ws = (unsigned char*)d_ws;
#if MK_SINGLE
    a.ph_lo = 0; a.ph_hi = NPH; a.use_bar = 1;
    hipLaunchKernelGGL(fwd_kernel, dim3(grid), dim3(NWAVES * 64), LDS_BYTES, stream, a);
#else
    for (int p = 0; p < NPH; ++p) { a.ph_lo = p; a.ph_hi = p + 1; a.use_bar = 0;
        hipLaunchKernelGGL(fwd_kernel, dim3(grid), dim3(NWAVES * 64), LDS_BYTES, stream, a); }
#endif
}
```

```cpp
#include <hip/hip_runtime.h>
#include <cstdio>
#ifndef MK_SINGLE
#define MK_SINGLE 1
#endif
#ifndef MIX_GLA
#define MIX_GLA 1
#define MIX_RET 1
#define REP1 0
#define REP2 0
#define REP3 0
#define REP4 0
#define REP6 0
#define DUP 0
#define ABLV 0
#define REP0 0
#endif
namespace pg8 {
#define PG8_LAS __attribute__((address_space(3)))
typedef unsigned short bf16_t;
typedef short bf16x8 __attribute__((ext_vector_type(8)));
typedef float f32x4 __attribute__((ext_vector_type(4)));
typedef unsigned u32x4 __attribute__((ext_vector_type(4)));
constexpr int BM = 256, BK = 64, HALF = 128, HTB = HALF * BK * 2  , STAGE_BYTES = 8 * HTB, NXCD = 8, WGM = 8;

__host__ __device__ __forceinline__ int lds_byte(int r, int c) { const int st = (r >> 4) * 2 + (c >> 5), rr = r & 15, cc = c & 31, ob = rr * 64 + cc * 2; return st * 1024 + (ob ^ (((ob >> 9) & 1) << 5)); }
__host__ __device__ __forceinline__ void stage_rc(int b, int& R, int& C) { const int st = b / 1024, sb = b % 1024, swz = sb ^ (((sb >> 9) & 1) << 5); R = (st >> 1) * 16 + swz / 64; C = (st & 1) * 32 + (swz % 64) / 2; }
__host__ __device__ __forceinline__ int perm32(int rho) { const int n = rho >> 4, i = rho & 15; return 8 * (i >> 2) + 4 * n + (i & 3); }

struct Unit { int pm, pn; };
struct Gemm { const bf16_t* A; const bf16_t* Bt; int M, N, K, lda; };

struct StaticOrder {
    int nM, nN, nwg, G, c;
    __host__ __device__ void init(int M, int N, int G_, int c_) { nM = M / BM; nN = N / BM; nwg = nM * nN; G = G_; c = c_; }
    __host__ __device__ bool next(int i, Unit& u) const {
        const long L = (long)i * G + c; if (L >= nwg) return false;
        int wgid = (int)L; { const int q = nwg / NXCD, r = nwg % NXCD, xcd = wgid % NXCD, off = wgid / NXCD; wgid = (xcd < r ? xcd * (q + 1) : r * (q + 1) + (xcd - r) * q) + off; }
        const int nig = WGM * nN, gid = wgid / nig, fm = gid * WGM, gsz = (nM - fm) < WGM ? (nM - fm) : WGM;
        u.pm = fm + ((wgid % nig) % gsz); u.pn = (wgid % nig) / gsz; return true;
    }
    __device__ __forceinline__ void a_ready(const Unit&) const {}
    __device__ __forceinline__ void done(const Unit&) const {}
};
struct InProjOrder {
    int x, r;
    __host__ __device__ void init(int c_) { x = c_ & 7; r = c_ >> 3; }
    __host__ __device__ bool next(int i, Unit& u) const {
        if (i >= 21) return false;
        const int gi = i / 7, ri = i % 7;
        if (ri < 6) { u.pm = x * 48 + 16 * gi + 8 * (ri & 1) + (r & 7); u.pn = 4 * (ri >> 1) + (r >> 3); }
        else { u.pm = x * 48 + 16 * gi + (r & 15); u.pn = 12 + (r >> 4); }
        return true;
    }
    __device__ __forceinline__ void a_ready(const Unit&) const {}
    __device__ __forceinline__ void done(const Unit&) const {}
};
__device__ __forceinline__ unsigned cvt_pk_bf16(float lo, float hi) { unsigned r; asm volatile("v_cvt_pk_bf16_f32 %0, %1, %2" : "=v"(r) : "v"(lo), "v"(hi)); return r; }
__device__ __forceinline__ u32x4 pack8(const f32x4& a, const f32x4& b) { u32x4 w; w.x = cvt_pk_bf16(a[0], a[1]); w.y = cvt_pk_bf16(a[2], a[3]); w.z = cvt_pk_bf16(b[0], b[1]); w.w = cvt_pk_bf16(b[2], b[3]); return w; }
constexpr int NPROJ = 3584, DMODEL = 1024, DFF = 4096, MPROMPT = 65536;

constexpr size_t MTOK = 98304;
constexpr size_t PL_GV = 0, PL_RV = PL_GV + 4 * MTOK * 128, PL_GQ = PL_RV + 4 * MTOK * 128, PL_GK = PL_GQ + 4 * MTOK * 64, PL_GG = PL_GK + 4 * MTOK * 64,
                 PL_RQ = PL_GG + 4 * MTOK * 128, PL_RK = PL_RQ + 4 * MTOK * 128, PL_RG = PL_RK + 4 * MTOK * 128, PL_END = PL_RG + 4 * MTOK * 128;
__device__ __forceinline__ void plane_of(int pn, int bj, int wc, size_t& off, int& W, int& col) {
    W = 128; col = 32 * wc; int hh = 2 * (pn & 1) + bj; size_t grp;
    switch (pn >> 1) { case 0: grp = PL_GV; break; case 1: grp = PL_RV; break; case 3: grp = PL_GG; break; case 4: grp = PL_RQ; break; case 5: grp = PL_RK; break; case 6: grp = PL_RG; break;
        default: grp = (pn & 1) ? PL_GK : PL_GQ; W = 64; hh = 2 * bj + (wc >> 1); col = 32 * (wc & 1); break; }
    off = grp + (size_t)hh * MTOK * (size_t)W;
}
struct EpiInProj {
    static constexpr bool PERM = true, AFTER_DRAIN = false;
    bf16_t* P; const float* rstd; const float* rcos; const float* rsin;
    __device__ __forceinline__ void operator()(const f32x4 (&acc)[2][2][4][2], const Unit& u, int wr, int wc, int fr, int fq) const {
        const int row0 = u.pm * BM + wr * 64 + fr;
        const bool rot = (u.pn >= 8) && (u.pn < 12);
        const int i0 = (4 * wc + fq) * 4;
        size_t poff[2]; int W, col;
        plane_of(u.pn, 0, wc, poff[0], W, col); plane_of(u.pn, 1, wc, poff[1], W, col);
#pragma unroll
        for (int ai = 0; ai < 2; ++ai)
#pragma unroll
            for (int m = 0; m < 4; ++m) {
                const int row = row0 + ai * HALF + m * 16;
                const float rs = rstd[row];
                const int pos = row < MPROMPT ? (row & 2047) : (row & 16383);
                f32x4 c4 = (f32x4){1.f, 1.f, 1.f, 1.f}, s4 = (f32x4){0.f, 0.f, 0.f, 0.f};
                if (rot) { c4 = *(const f32x4*)(rcos + pos * 64 + i0); s4 = *(const f32x4*)(rsin + pos * 64 + i0); }
#pragma unroll
                for (int bj = 0; bj < 2; ++bj) {
                    f32x4 v0 = acc[ai][bj][m][0] * rs, v1 = acc[ai][bj][m][1] * rs;
                    if (rot) { const f32x4 lo = v0 * c4 - v1 * s4, hi = v0 * s4 + v1 * c4; v0 = lo; v1 = hi; }
                    *(u32x4*)(P + poff[bj] + (size_t)row * W + col + 8 * fq) = pack8(v0, v1);
                }
            }
    }
};
struct EpiResid {
    static constexpr bool PERM = true, AFTER_DRAIN = false;
    const float* xp; const float* xs; float* out; bf16_t* A2; float* sq;
    __device__ __forceinline__ void operator()(const f32x4 (&acc)[2][2][4][2], const Unit& u, int wr, int wc, int fr, int fq) const {
        const int row0 = u.pm * BM + wr * 64 + fr, colb = u.pn * BM + wc * 32 + 8 * fq;
#pragma unroll
        for (int ai = 0; ai < 2; ++ai)
#pragma unroll
            for (int m = 0; m < 4; ++m) {
                const int row = row0 + ai * HALF + m * 16;
                const float* xrow = (row < MPROMPT ? xp + (size_t)row * DMODEL : xs + (size_t)(row - MPROMPT) * DMODEL) + colb;
                float* orow = out + (size_t)row * DMODEL + colb;
                float ss = 0.f;
#pragma unroll
                for (int bj = 0; bj < 2; ++bj) {
                    const f32x4 x0 = *(const f32x4*)(xrow + bj * HALF), x1 = *(const f32x4*)(xrow + bj * HALF + 4);
                    const f32x4 v0 = acc[ai][bj][m][0] + x0, v1 = acc[ai][bj][m][1] + x1;
                    *(f32x4*)(orow + bj * HALF) = v0; *(f32x4*)(orow + bj * HALF + 4) = v1;
                    if (A2) *(u32x4*)(A2 + (size_t)row * DMODEL + colb + bj * HALF) = pack8(v0, v1);
                    ss += (v0[0] * v0[0] + v0[1] * v0[1]) + (v0[2] * v0[2] + v0[3] * v0[3]) + (v1[0] * v1[0] + v1[1] * v1[1]) + (v1[2] * v1[2] + v1[3] * v1[3]);
                }
                ss += __shfl_xor(ss, 16); ss += __shfl_xor(ss, 32);
                if (fq == 0) sq[(size_t)row * 16 + u.pn * 4 + wc] = ss;
            }
    }
};
struct EpiFF1 {
    static constexpr bool PERM = true, AFTER_DRAIN = false;
    bf16_t* H; const float* sq;
    __device__ __forceinline__ void operator()(const f32x4 (&acc)[2][2][4][2], const Unit& u, int wr, int wc, int fr, int fq) const {
        const int row0 = u.pm * BM + wr * 64 + fr, colb = u.pn * BM + wc * 32 + 8 * fq;
#pragma unroll
        for (int ai = 0; ai < 2; ++ai)
#pragma unroll
            for (int m = 0; m < 4; ++m) {
                const int row = row0 + ai * HALF + m * 16;
                const f32x4* s4 = (const f32x4*)(sq + (size_t)row * 16);
                const f32x4 t = (s4[0] + s4[1]) + (s4[2] + s4[3]);
                const float r2 = 1.0f / (((t[0] + t[1]) + (t[2] + t[3])) * (1.0f / 1024.0f) + 1e-6f);
                bf16_t* rowp = H + (size_t)row * DFF + colb;
#pragma unroll
                for (int bj = 0; bj < 2; ++bj) {
                    f32x4 v0 = acc[ai][bj][m][0], v1 = acc[ai][bj][m][1];
#pragma unroll
                    for (int j = 0; j < 4; ++j) { const float a = fmaxf(v0[j], 0.f), b = fmaxf(v1[j], 0.f); v0[j] = a * a * r2; v1[j] = b * b * r2; }
                    *(u32x4*)(rowp + bj * HALF) = pack8(v0, v1);
                }
            }
    }
};

struct EpiPlain {
    static constexpr bool PERM = true, AFTER_DRAIN = false;
    bf16_t* P;
    __device__ __forceinline__ void operator()(const f32x4 (&acc)[2][2][4][2], const Unit& u, int wr, int wc, int fr, int fq) const {
        const int row0 = u.pm * BM + wr * 64 + fr;
        size_t poff[2]; int W, col;
        plane_of(u.pn, 0, wc, poff[0], W, col); plane_of(u.pn, 1, wc, poff[1], W, col);
#pragma unroll
        for (int ai = 0; ai < 2; ++ai)
#pragma unroll
            for (int m = 0; m < 4; ++m) { const int row = row0 + ai * HALF + m * 16;
#pragma unroll
                for (int bj = 0; bj < 2; ++bj) *(u32x4*)(P + poff[bj] + (size_t)row * W + col + 8 * fq) = pack8(acc[ai][bj][m][0], acc[ai][bj][m][1]); }
    }
};

struct EpiResidX {
    static constexpr bool PERM = true, AFTER_DRAIN = false;
    const float* xp; const float* xs; bf16_t* A2; float* sq;
    __device__ __forceinline__ void operator()(const f32x4 (&acc)[2][2][4][2], const Unit& u, int wr, int wc, int fr, int fq) const {
        const int row0 = u.pm * BM + wr * 64 + fr, colb = u.pn * BM + wc * 32 + 8 * fq;
#pragma unroll
        for (int ai = 0; ai < 2; ++ai)
#pragma unroll
            for (int m = 0; m < 4; ++m) {
                const int row = row0 + ai * HALF + m * 16;
                const float* xrow = (row < MPROMPT ? xp + (size_t)row * DMODEL : xs + (size_t)(row - MPROMPT) * DMODEL) + colb;
                float ss = 0.f;
#pragma unroll
                for (int bj = 0; bj < 2; ++bj) {
                    const f32x4 x0 = *(const f32x4*)(xrow + bj * HALF), x1 = *(const f32x4*)(xrow + bj * HALF + 4);
                    const f32x4 v0 = acc[ai][bj][m][0] + x0, v1 = acc[ai][bj][m][1] + x1;
                    *(u32x4*)(A2 + (size_t)row * DMODEL + colb + bj * HALF) = pack8(v0, v1);
                    ss += (v0[0] * v0[0] + v0[1] * v0[1]) + (v0[2] * v0[2] + v0[3] * v0[3]) + (v1[0] * v1[0] + v1[1] * v1[1]) + (v1[2] * v1[2] + v1[3] * v1[3]);
                }
                ss += __shfl_xor(ss, 16); ss += __shfl_xor(ss, 32);
                if (fq == 0) sq[(size_t)row * 16 + u.pn * 4 + wc] = ss;
            }
    }
};
struct EpiResidB {
    static constexpr bool PERM = true, AFTER_DRAIN = false;
    bf16_t* A2; float* sq;
    __device__ __forceinline__ void operator()(const f32x4 (&acc)[2][2][4][2], const Unit& u, int wr, int wc, int fr, int fq) const {
        const int row0 = u.pm * BM + wr * 64 + fr, colb = u.pn * BM + wc * 32 + 8 * fq;
#pragma unroll
        for (int ai = 0; ai < 2; ++ai)
#pragma unroll
            for (int m = 0; m < 4; ++m) {
                const int row = row0 + ai * HALF + m * 16;
                bf16_t* xr = A2 + (size_t)row * DMODEL + colb;
                float ss = 0.f;
#pragma unroll
                for (int bj = 0; bj < 2; ++bj) {
                    const u32x4 xw = *(const u32x4*)(xr + bj * HALF);
                    const f32x4 x0 = {__uint_as_float(xw.x << 16), __uint_as_float(xw.x & 0xffff0000u), __uint_as_float(xw.y << 16), __uint_as_float(xw.y & 0xffff0000u)};
                    const f32x4 x1 = {__uint_as_float(xw.z << 16), __uint_as_float(xw.z & 0xffff0000u), __uint_as_float(xw.w << 16), __uint_as_float(xw.w & 0xffff0000u)};
                    const f32x4 v0 = acc[ai][bj][m][0] + x0, v1 = acc[ai][bj][m][1] + x1;
                    *(u32x4*)(xr + bj * HALF) = pack8(v0, v1);
                    ss += (v0[0] * v0[0] + v0[1] * v0[1]) + (v0[2] * v0[2] + v0[3] * v0[3]) + (v1[0] * v1[0] + v1[1] * v1[1]) + (v1[2] * v1[2] + v1[3] * v1[3]);
                }
                ss += __shfl_xor(ss, 16); ss += __shfl_xor(ss, 32);
                if (fq == 0) sq[(size_t)row * 16 + u.pn * 4 + wc] = ss;
            }
    }
};
template <class Epi, class Sched, bool ALIGN_EPI = false, bool SP2 = false>
__device__ __forceinline__ void gemm_phase(PG8_LAS unsigned char* lds, const Gemm g, const Sched& S, const Epi& E) {
    const int tid = threadIdx.x, wid = __builtin_amdgcn_readfirstlane(tid >> 6), lane = tid & 63, wr = wid >> 2, wc = wid & 3, fr = lane & 15, fq = lane >> 4;
    const int K = g.K, nt = K / BK;
    unsigned voffA[2], voffB[2];
#pragma unroll
    for (int i = 0; i < 2; ++i) { int R, C; stage_rc(tid * 16 + i * 8192, R, C); const int Rb = Epi::PERM ? ((R & ~31) + perm32(R & 31)) : R;
        voffA[i] = (unsigned)(R * g.lda + C) * 2u; voffB[i] = (unsigned)(Rb * K + C) * 2u; }
    const size_t kstep = (size_t)(BK * 2);
    const size_t hstepB = (size_t)HALF * K * 2, hstepA = (size_t)HALF * g.lda * 2;
    const size_t tstepB = 2 * hstepB, tstepA = 2 * hstepA;
    const unsigned ldsw = (unsigned)wid * 1024u;
    const int aoff = lds_byte(wr * 64 + fr, fq * 8), boff = lds_byte(wc * 32 + fr, fq * 8);
#define PG8_SA(b, h) (((b) * 2 + (h)) * HTB)
#define PG8_SB(b, h) ((4 + (b) * 2 + (h)) * HTB)
#define PG8_STAGE(bufoff, gbase, voff) do { _Pragma("unroll") for (int _i = 0; _i < 2; ++_i) \
        __builtin_amdgcn_global_load_lds((const unsigned*)((const char*)(gbase) + (voff)[_i]), (PG8_LAS unsigned*)(lds + (bufoff) + ldsw + _i * 8192), 16, 0, 0); } while (0)
#define PG8_LDA(dst, b, h) do { _Pragma("unroll") for (int m = 0; m < 4; ++m) _Pragma("unroll") for (int k = 0; k < 2; ++k) dst[m][k] = *(const PG8_LAS bf16x8*)(lds + PG8_SA(b, h) + aoff + m * 2048 + k * 1024); } while (0)
#define PG8_LDB(dst, b, h) do { _Pragma("unroll") for (int n = 0; n < 2; ++n) _Pragma("unroll") for (int k = 0; k < 2; ++k) dst[n][k] = *(const PG8_LAS bf16x8*)(lds + PG8_SB(b, h) + boff + n * 2048 + k * 1024); } while (0)
#define PG8_MMA(ai, bj, At, Bt) do { __builtin_amdgcn_s_setprio(1); _Pragma("unroll") for (int m = 0; m < 4; ++m) _Pragma("unroll") for (int n = 0; n < 2; ++n) _Pragma("unroll") for (int k = 0; k < 2; ++k) \
        acc[ai][bj][m][n] = __builtin_amdgcn_mfma_f32_16x16x32_bf16(Bt[n][k], At[m][k], acc[ai][bj][m][n], 0, 0, 0); __builtin_amdgcn_s_setprio(0); } while (0)
#define PG8_WAIT_V(n) asm volatile("s_waitcnt vmcnt(" #n ")" ::: "memory")
#define PG8_WAIT_L(n) asm volatile("s_waitcnt lgkmcnt(" #n ")" ::: "memory")
#define PG8_BAR __builtin_amdgcn_s_barrier()
#define PG8_SCHED __builtin_amdgcn_sched_barrier(0)
    Unit cur, nxt; int ui = 0;
    if (!S.next(0, cur)) return;
    f32x4 acc[2][2][4][2];
#pragma unroll
    for (int a = 0; a < 2; ++a)
#pragma unroll
        for (int b = 0; b < 2; ++b)
#pragma unroll
            for (int m = 0; m < 4; ++m)
#pragma unroll
                for (int n = 0; n < 2; ++n) acc[a][b][m][n] = (f32x4){0.f, 0.f, 0.f, 0.f};
    bf16x8 At[4][2], B0[2][2], B1[2][2];
    const char* cA = (const char*)g.A + (size_t)cur.pm * tstepA; const char* cB = (const char*)g.Bt + (size_t)cur.pn * tstepB;
    S.a_ready(cur);
    if constexpr (SP2) {
        PG8_STAGE(PG8_SB(0, 0), cB, voffB); PG8_STAGE(PG8_SB(0, 1), cB + hstepB, voffB); PG8_STAGE(PG8_SA(0, 0), cA, voffA); PG8_STAGE(PG8_SA(0, 1), cA + hstepA, voffA);
        if (wr == 1) PG8_BAR;
        PG8_WAIT_V(2); PG8_BAR;
        PG8_STAGE(PG8_SB(1, 0), cB + kstep, voffB); PG8_STAGE(PG8_SA(1, 0), cA + kstep, voffA); PG8_STAGE(PG8_SB(1, 1), cB + hstepB + kstep, voffB);
        PG8_WAIT_V(6); PG8_BAR;
    } else {
        PG8_STAGE(PG8_SB(0, 0), cB, voffB); PG8_STAGE(PG8_SA(0, 0), cA, voffA); PG8_STAGE(PG8_SB(0, 1), cB + hstepB, voffB); PG8_STAGE(PG8_SA(0, 1), cA + hstepA, voffA);
        if (wr == 1) PG8_BAR;
        PG8_WAIT_V(4); PG8_BAR;
        PG8_STAGE(PG8_SB(1, 0), cB + kstep, voffB); PG8_STAGE(PG8_SA(1, 0), cA + kstep, voffA); PG8_STAGE(PG8_SB(1, 1), cB + hstepB + kstep, voffB);
        PG8_WAIT_V(6); PG8_BAR;
    }
    for (;;) {
        const bool has_next = S.next(ui + 1, nxt);
        const char* nA = has_next ? (const char*)g.A + (size_t)nxt.pm * tstepA : cA; const char* nB = has_next ? (const char*)g.Bt + (size_t)nxt.pn * tstepB : cB;
        for (int t = 0; t < nt; t += 2) {
            const bool last = (t == nt - 2);
            const char* a1 = cA + (size_t)(t + 1) * kstep;
            const char* a2 = last ? nA : cA + (size_t)(t + 2) * kstep; const char* b2 = last ? nB : cB + (size_t)(t + 2) * kstep;
            const char* a3 = a2 + kstep; const char* b3 = b2 + kstep;
            if (last && has_next) S.a_ready(nxt);
            if constexpr (SP2) {
            PG8_LDB(B0, 0, 0); PG8_LDB(B1, 0, 1); PG8_SCHED; PG8_LDA(At, 0, 0); PG8_STAGE(PG8_SA(1, 1), a1 + hstepA, voffA);
            PG8_WAIT_V(8); PG8_WAIT_L(0); PG8_BAR; PG8_MMA(0, 0, At, B0); PG8_MMA(0, 1, At, B1); PG8_BAR; PG8_SCHED;
            PG8_LDA(At, 0, 1); PG8_STAGE(PG8_SB(0, 0), b2, voffB); PG8_STAGE(PG8_SB(0, 1), b2 + hstepB, voffB); PG8_STAGE(PG8_SA(0, 0), a2, voffA);
            PG8_WAIT_V(8); PG8_WAIT_L(0); PG8_BAR; PG8_MMA(1, 0, At, B0); PG8_MMA(1, 1, At, B1); PG8_BAR; PG8_SCHED;
            PG8_LDB(B0, 1, 0); PG8_LDB(B1, 1, 1); PG8_SCHED; PG8_LDA(At, 1, 0); PG8_STAGE(PG8_SA(0, 1), a2 + hstepA, voffA);
            PG8_WAIT_V(8); PG8_WAIT_L(0); PG8_BAR; PG8_MMA(0, 0, At, B0); PG8_MMA(0, 1, At, B1); PG8_BAR; PG8_SCHED;
            PG8_LDA(At, 1, 1); PG8_STAGE(PG8_SB(1, 0), b3, voffB); PG8_STAGE(PG8_SB(1, 1), b3 + hstepB, voffB); PG8_STAGE(PG8_SA(1, 0), a3, voffA);
            PG8_WAIT_V(8); PG8_WAIT_L(0); PG8_BAR; PG8_MMA(1, 0, At, B0); PG8_MMA(1, 1, At, B1); PG8_BAR; PG8_SCHED;
            } else {
            PG8_LDB(B0, 0, 0); PG8_SCHED; PG8_LDA(At, 0, 0); PG8_STAGE(PG8_SA(1, 1), a1 + hstepA, voffA);
            PG8_WAIT_L(8); PG8_BAR; PG8_WAIT_L(0); PG8_MMA(0, 0, At, B0); PG8_BAR; PG8_SCHED;
            PG8_LDB(B1, 0, 1); PG8_STAGE(PG8_SB(0, 0), b2, voffB);
            PG8_BAR; PG8_WAIT_L(0); PG8_MMA(0, 1, At, B1); PG8_BAR;
            PG8_LDA(At, 0, 1); PG8_STAGE(PG8_SA(0, 0), a2, voffA);
            PG8_BAR; PG8_WAIT_L(0); PG8_MMA(1, 0, At, B0); PG8_BAR; PG8_SCHED;
            PG8_STAGE(PG8_SB(0, 1), b2 + hstepB, voffB);
            PG8_WAIT_V(6); PG8_BAR; PG8_MMA(1, 1, At, B1); PG8_BAR;
            PG8_LDB(B0, 1, 0); PG8_SCHED; PG8_LDA(At, 1, 0); PG8_STAGE(PG8_SA(0, 1), a2 + hstepA, voffA);
            PG8_WAIT_L(8); PG8_BAR; PG8_WAIT_L(0); PG8_MMA(0, 0, At, B0); PG8_BAR; PG8_SCHED;
            PG8_LDB(B1, 1, 1); PG8_STAGE(PG8_SB(1, 0), b3, voffB);
            PG8_BAR; PG8_WAIT_L(0); PG8_MMA(0, 1, At, B1); PG8_BAR;
            PG8_LDA(At, 1, 1); PG8_STAGE(PG8_SA(1, 0), a3, voffA);
            PG8_BAR; PG8_WAIT_L(0); PG8_MMA(1, 0, At, B0); PG8_BAR; PG8_SCHED;
            PG8_STAGE(PG8_SB(1, 1), b3 + hstepB, voffB);
            PG8_WAIT_V(6); PG8_BAR; PG8_MMA(1, 1, At, B1); PG8_BAR;
            }
        }
        if constexpr (ALIGN_EPI) { if (wr == 0) PG8_BAR; }
        if constexpr (!Epi::AFTER_DRAIN) { E(acc, cur, wr, wc, fr, fq); S.done(cur); }
        if (!has_next) break;
#pragma unroll
        for (int a = 0; a < 2; ++a)
#pragma unroll
            for (int b = 0; b < 2; ++b)
#pragma unroll
                for (int m = 0; m < 4; ++m)
#pragma unroll
                    for (int n = 0; n < 2; ++n) acc[a][b][m][n] = (f32x4){0.f, 0.f, 0.f, 0.f};
        cur = nxt; cA = nA; cB = nB; ++ui;
        if constexpr (ALIGN_EPI) { if (wr == 1) PG8_BAR; }
    }
    PG8_WAIT_V(0);
    if constexpr (!ALIGN_EPI) { if (wr == 0) PG8_BAR; }
    PG8_BAR;
    if constexpr (Epi::AFTER_DRAIN) { E.fused(acc, cur, wr, wc, fr, fq, lds, wid, lane); S.done(cur); }
#undef PG8_SA
#undef PG8_SB
#undef PG8_STAGE
#undef PG8_LDA
#undef PG8_LDB
#undef PG8_MMA
#undef PG8_WAIT_V
#undef PG8_WAIT_L
#undef PG8_BAR
#undef PG8_SCHED
}
}
#define GAS __attribute__((address_space(1)))
#define LAS __attribute__((address_space(3)))
typedef unsigned short bf16;
typedef unsigned v4u __attribute__((ext_vector_type(4)));
typedef float f32x4 __attribute__((ext_vector_type(4)));
typedef short bf16x8 __attribute__((ext_vector_type(8)));
typedef GAS unsigned gu32;
typedef GAS unsigned long long gu64;
#define RLX_AGENT __ATOMIC_RELAXED, __HIP_MEMORY_SCOPE_AGENT
#define LDS_WAIT() asm volatile("s_waitcnt lgkmcnt(0)" ::: "memory")
#define VM_WAIT() asm volatile("s_waitcnt vmcnt(0)" ::: "memory")
__device__ __forceinline__ unsigned long long rt() { return __builtin_amdgcn_s_memrealtime(); }
__device__ __forceinline__ unsigned f2bf(float f) { unsigned u = __builtin_bit_cast(unsigned, f); return (u + 0x7fffu + ((u >> 16) & 1u)) >> 16; }
__device__ __forceinline__ unsigned pk2(float lo, float hi) { return f2bf(lo) | (f2bf(hi) << 16); }

#define XB_TMO      128
#define XB_XCNT(j)  (256  + 64 * (j))
#define XB_XSUB(j)  (1280 + 64 * (j))
#define XB_XGEN(j)  (2304 + 64 * (j))
#define XB_TOP      3328
#define XB_TOPGEN   3392
#define XCD_BAR_WORDS 3456
#define XB_SPIN_CAP (1u << 18)

__device__ __forceinline__ unsigned xb_ld(unsigned* p)              { return __hip_atomic_load(p, __ATOMIC_RELAXED, __HIP_MEMORY_SCOPE_AGENT); }
__device__ __forceinline__ unsigned xb_add(unsigned* p, unsigned v) { return __hip_atomic_fetch_add(p, v, __ATOMIC_RELAXED, __HIP_MEMORY_SCOPE_AGENT); }
__device__ __forceinline__ unsigned xb_xcc_id() { return (unsigned)__builtin_amdgcn_s_getreg((3 << 11) | 20) & 0xFu; }
#define XB_SPIN(cond, bar) do { unsigned _sp = 0; while (cond) { __builtin_amdgcn_s_sleep(1); \
    if ((++_sp & 255u) == 0u) { if (xb_ld(&(bar)[XB_TMO])) break; if (_sp > XB_SPIN_CAP) { atomicAdd(&(bar)[XB_TMO], 1u); break; } } } } while (0)

struct XcdBarrier {
    unsigned* bar; unsigned x;
    volatile LAS unsigned* st;
};

__device__ __forceinline__ XcdBarrier xcd_barrier_post(unsigned* bar, volatile LAS unsigned* st) {
    XcdBarrier b; b.bar = bar; b.x = xb_xcc_id(); b.st = st;
    if (threadIdx.x == 0) (void)xb_add(&bar[XB_XCNT(b.x)], 1u);
    return b;
}
__device__ __forceinline__ void xcd_barrier_complete(unsigned* bar, unsigned x, unsigned& nloc, unsigned& nx) {
    const unsigned G = gridDim.x * gridDim.y * gridDim.z;
    unsigned sum, cnt, mine, sp = 0u;
    for (;;) {
        sum = 0u; cnt = 0u; mine = 0u;
#pragma unroll
        for (unsigned j = 0; j < 16; ++j) { const unsigned c = xb_ld(&bar[XB_XCNT(j)]); sum += c; cnt += (c > 0u) ? 1u : 0u; mine = (j == x) ? c : mine; }
        if (sum == G) break;
        __builtin_amdgcn_s_sleep(1);
        if ((++sp & 255u) == 0u) { if (xb_ld(&bar[XB_TMO])) break; if (sp > XB_SPIN_CAP) { atomicAdd(&bar[XB_TMO], 1u); break; } }
    }
    nloc = mine > 0u ? mine : 1u; nx = cnt > 0u ? cnt : 1u;
}

__device__ __forceinline__ void xcd_barrier(const XcdBarrier& b) {
    asm volatile("s_waitcnt vmcnt(0)" ::: "memory");
    __syncthreads();
    if (threadIdx.x == 0) {
        unsigned* bar = b.bar;
        __builtin_amdgcn_s_waitcnt(0);
        unsigned nloc = b.st[0], nx = b.st[1];
        if (nloc == 0u) { xcd_barrier_complete(bar, b.x, nloc, nx); b.st[0] = nloc; b.st[1] = nx; }
        const unsigned old = xb_add(&bar[XB_XSUB(b.x)], 1u);
        const unsigned gen = old / nloc;
        if (old + 1u == (gen + 1u) * nloc) {
            __builtin_amdgcn_fence(__ATOMIC_RELEASE, "agent");
            asm volatile("s_waitcnt vmcnt(0)" ::: "memory");
            const unsigned og = xb_add(&bar[XB_TOP], 1u);
            const unsigned tg = og / nx;
            if (og + 1u == (tg + 1u) * nx) xb_add(&bar[XB_TOPGEN], 1u);
            else XB_SPIN(xb_ld(&bar[XB_TOPGEN]) == tg, bar);
            __builtin_amdgcn_fence(__ATOMIC_ACQUIRE, "agent");
            xb_add(&bar[XB_XGEN(b.x)], 1u);
            asm volatile("s_waitcnt vmcnt(0)" ::: "memory");
        } else {
            XB_SPIN(xb_ld(&bar[XB_XGEN(b.x)]) == gen, bar);
            __builtin_amdgcn_fence(__ATOMIC_ACQUIRE, "agent");
            asm volatile("s_waitcnt vmcnt(0)" ::: "memory");
        }
    }
    __syncthreads();
}
constexpr int NWAVES = 8;
constexpr int M_TOK = 98304, M_PROMPT = 65536, D = 1024, NP = 3584, NWIN = 3616, FF = 4096;
constexpr int L_PROMPT = 2048, L_SAMPLE = 16384;
constexpr float EPS = 1e-6f;
constexpr size_t MiB = 1u << 20;
constexpr size_t WS_CTL = 0, CTL_ZERO_BYTES = 1 * MiB;
constexpr size_t WS_WIN = 1 * MiB;
constexpr size_t WS_WOUT = 9 * MiB;
constexpr size_t WS_W1 = 11 * MiB;
constexpr size_t WS_W2 = 19 * MiB;
constexpr size_t WS_ROPE = 27 * MiB;
constexpr size_t WS_GA = 35 * MiB;
constexpr size_t WS_RSTD = 47 * MiB;
constexpr size_t WS_SQ1 = 48 * MiB;
constexpr size_t WS_SQ2 = 54 * MiB;
constexpr size_t WS_DEC = 60 * MiB;
constexpr size_t WS_R0 = 64 * MiB;
constexpr size_t WS_R1 = 256 * MiB;
constexpr size_t WS_END = 1024 * MiB;
constexpr int CW_BAR = 4096;
constexpr int RING_OFF = 0, RING_BYTES = 131072;
constexpr int LDSCTL_OFF = 147456 - 1024, MISC_OFF = LDSCTL_OFF + 320;
constexpr int LDS_BYTES = 147456;

struct Frame {
    LAS unsigned char* lds;
    volatile LAS unsigned* MISC;
    int tid, lane, wave, vcu, G;
};
__device__ __forceinline__ float wave_sum(float v) {
#pragma unroll
    for (int o = 1; o < 64; o <<= 1) v += __shfl_xor(v, o);
    return v;
}
__device__ __forceinline__ float bf2f(bf16 b) { return __uint_as_float((unsigned)b << 16); }
__device__ __forceinline__ unsigned cvtpk(float lo, float hi) { unsigned r; asm volatile("v_cvt_pk_bf16_f32 %0, %1, %2" : "=v"(r) : "v"(lo), "v"(hi)); return r; }

__device__ __forceinline__ void win_map(int nd, int& sc, float& cs) {
    cs = 1.f;
    if (nd < 512) sc = 512 + nd;
    else if (nd < 1024) sc = 2592 + (nd - 512);
    else if (nd < 1280) { sc = nd - 1024; cs = 0.125f; }
    else if (nd < 1536) sc = 256 + (nd - 1280);
    else if (nd < 2048) sc = 1024 + (nd - 1536);
    else if (nd < 3072) {
        const bool isq = nd < 2560; const int p = nd - (isq ? 2048 : 2560), h = p >> 7, pp = p & 127, u = pp >> 3, j = pp & 7;
        const int d = (j < 4) ? 4 * u + j : 64 + 4 * u + (j - 4);
        sc = (isq ? 1568 : 2080) + 128 * h + d; if (isq) cs = 0.08838834764831845f; }
    else if (nd < 3584) sc = 3104 + (nd - 3072);
    else sc = 1536 + (nd - 3584);
}
template <bool MAP>
__device__ __forceinline__ void p0_transpose_item(const float* W, int K, int Nsrc, int nblk, const float* ks, bf16* WT, LAS float* scr, int item, int lane) {
    const int kb = item / nblk, nb = item % nblk, k0 = 64 * kb, n0 = 32 * nb;
    int sc = n0 + (lane & 31); float cs = 1.f;
    if (MAP) win_map(n0 + (lane & 31), sc, cs);
#pragma unroll 8
    for (int i = 0; i < 32; ++i) { const int kk = 2 * i + (lane >> 5); float w = W[(size_t)(k0 + kk) * Nsrc + sc] * cs; if (ks) w *= ks[k0 + kk]; scr[kk * 33 + (lane & 31)] = w; }
    LDS_WAIT(); asm volatile("" ::: "memory");
    const int c = lane & 7;
#pragma unroll
    for (int j = 0; j < 4; ++j) { const int n = (lane >> 3) + 8 * j; const LAS float* s = scr + (8 * c) * 33 + n;
        v4u o; o.x = cvtpk(s[0 * 33], s[1 * 33]); o.y = cvtpk(s[2 * 33], s[3 * 33]); o.z = cvtpk(s[4 * 33], s[5 * 33]); o.w = cvtpk(s[6 * 33], s[7 * 33]);
        *(GAS v4u*)(WT + (size_t)(n0 + n) * K + k0 + 8 * c) = o; }
    LDS_WAIT(); asm volatile("" ::: "memory");
}
__device__ __forceinline__ void rope_entry(int e, float* rcos, float* rsin) {
    const int pos = e >> 6, i = e & 63;
    double inv = 1.0, b = 0.8659643233600653;
#pragma unroll
    for (int bit = 0; bit < 6; ++bit) { if ((i >> bit) & 1) inv *= b; b *= b; }
    const double ang = (double)pos * inv;
    const double n = __builtin_rint(ang * 0.6366197723675814);
    double r = __builtin_fma(-n, 1.5707963267948966, ang); r = __builtin_fma(-n, 6.123233995736766e-17, r);
    const double r2 = r * r;
    double s = -1.0 / 1307674368000.0;
    s = s * r2 + 1.0 / 6227020800.0; s = s * r2 - 1.0 / 39916800.0; s = s * r2 + 1.0 / 362880.0; s = s * r2 - 1.0 / 5040.0; s = s * r2 + 1.0 / 120.0; s = s * r2 - 1.0 / 6.0; s = s * r2 * r + r;
    double c = 1.0 / 20922789888000.0;
    c = c * r2 - 1.0 / 87178291200.0; c = c * r2 + 1.0 / 479001600.0; c = c * r2 - 1.0 / 3628800.0; c = c * r2 + 1.0 / 40320.0; c = c * r2 - 1.0 / 720.0; c = c * r2 + 1.0 / 24.0; c = c * r2 - 0.5; c = c * r2 + 1.0;
    const int q = ((int)n) & 3;
    const double cs = (q == 0) ? c : (q == 1) ? -s : (q == 2) ? -c : s;
    const double sn = (q == 0) ? s : (q == 1) ? c : (q == 2) ? -s : -c;
    rcos[e] = (float)cs; rsin[e] = (float)sn;
}
struct P0Args { const float *xp, *xs, *anw, *win, *wout, *mnw, *w1, *w2; bf16 *Win_t, *Wout_t, *W1_t, *W2_t, *Xb; float *rcos, *rsin, *ga, *rstd; };
__device__ __forceinline__ void p0_prologue(Frame& F, const P0Args& a) {
    LAS float* scr = (LAS float*)(F.lds + RING_OFF + F.wave * 16384);
    const int gw = F.vcu * NWAVES + F.wave, NGW = F.G * NWAVES;
    constexpr int I_IN = (D / 64) * (NWIN / 32), I_O = (D / 64) * (D / 32), I_1 = (D / 64) * (FF / 32), I_2 = (FF / 64) * (D / 32);
    constexpr int NITEMS = I_IN + I_O + I_1 + I_2;
    for (int it = gw; it < NITEMS; it += NGW) {
        int r = it;
        if (r < I_IN) { p0_transpose_item<true>(a.win, D, NWIN, NWIN / 32, a.anw, a.Win_t, scr, r, F.lane); continue; } r -= I_IN;
        if (r < I_O) { p0_transpose_item<false>(a.wout, D, D, D / 32, nullptr, a.Wout_t, scr, r, F.lane); continue; } r -= I_O;
        if (r < I_1) { p0_transpose_item<false>(a.w1, D, FF, FF / 32, a.mnw, a.W1_t, scr, r, F.lane); continue; } r -= I_1;
        p0_transpose_item<false>(a.w2, FF, D, D / 32, nullptr, a.W2_t, scr, r, F.lane);
    }
    for (int e = (blockIdx.x * NWAVES * 64) + F.tid; e < 16384 * 64; e += F.G * NWAVES * 64) rope_entry(e, a.rcos, a.rsin);
    __syncthreads();
    LAS bf16* wl = (LAS bf16*)(F.lds + RING_OFF);
    for (int e = F.tid; e < 32 * 1024; e += NWAVES * 64) { const int k = e >> 5, c = e & 31; wl[c * 1032 + k] = (bf16)(cvtpk(a.win[(size_t)k * NWIN + 1536 + c] * a.anw[k], 0.f) & 0xffffu); }
    __syncthreads();
    const int r = F.lane & 15, g = F.lane >> 4;
    LAS unsigned char* tl = F.lds + RING_OFF + 66048 + F.wave * 8448;
    for (int item = gw; item < M_TOK / 16; item += NGW) {
        const int row0 = item * 16;
        const float* xb0 = (row0 < M_PROMPT ? a.xp + (size_t)row0 * D : a.xs + (size_t)(row0 - M_PROMPT) * D) + 4 * F.lane;
        bf16* xo = a.Xb + (size_t)row0 * D + 4 * F.lane;
        f32x4 acc0 = {0.f, 0.f, 0.f, 0.f}, acc1 = {0.f, 0.f, 0.f, 0.f}; float ss = 0.f;
#pragma unroll 1
        for (int kc = 0; kc < 4; ++kc) {
            f32x4 xv[16];
#pragma unroll
            for (int rr = 0; rr < 16; ++rr) xv[rr] = *(const GAS f32x4*)(xb0 + (size_t)rr * D + 256 * kc);
#pragma unroll
            for (int rr = 0; rr < 16; ++rr) { unsigned long long pk = (unsigned long long)cvtpk(xv[rr][0], xv[rr][1]) | ((unsigned long long)cvtpk(xv[rr][2], xv[rr][3]) << 32);
                *(LAS unsigned long long*)(tl + rr * 528 + F.lane * 8) = pk; *(GAS unsigned long long*)(xo + (size_t)rr * D + 256 * kc) = pk; }
            asm volatile("s_waitcnt lgkmcnt(0)" ::: "memory");
#pragma unroll
            for (int s8 = 0; s8 < 8; ++s8) {
                const bf16x8 af = *(const LAS bf16x8*)(tl + r * 528 + 64 * s8 + 16 * g);
                const int k0 = 256 * kc + 32 * s8 + 8 * g;
                const bf16x8 b0 = *(const LAS bf16x8*)(wl + r * 1032 + k0), b1 = *(const LAS bf16x8*)(wl + (16 + r) * 1032 + k0);
                acc0 = __builtin_amdgcn_mfma_f32_16x16x32_bf16(af, b0, acc0, 0, 0, 0);
                acc1 = __builtin_amdgcn_mfma_f32_16x16x32_bf16(af, b1, acc1, 0, 0, 0);
                const v4u aw = __builtin_bit_cast(v4u, af);
#pragma unroll
                for (int j = 0; j < 4; ++j) { const unsigned u = ((const unsigned*)&aw)[j]; const float lo = __uint_as_float(u << 16), hi = __uint_as_float(u & 0xffff0000u); ss += lo * lo + hi * hi; }
            }
            asm volatile("s_waitcnt lgkmcnt(0)" ::: "memory");
        }
        ss += __shfl_xor(ss, 16); ss += __shfl_xor(ss, 32);
        const float rs = 1.0f / sqrtf(ss * (1.0f / 1024.0f) + EPS);
        if (g == 0) a.rstd[row0 + r] = rs;
#pragma unroll
        for (int q = 0; q < 4; ++q) { const int rr = 4 * g + q; const float rq = __shfl(rs, rr);
            a.ga[(size_t)(row0 + rr) * 32 + r] = acc0[q] * rq; a.ga[(size_t)(row0 + rr) * 32 + 16 + r] = acc1[q] * rq; }
    }
}

__device__ __forceinline__ float log_sigmoid_f(float z) { return fminf(z, 0.f) - log1pf(expf(-fabsf(z))); }
struct MixArgs { bf16* proj; const float* ga; const float *waf, *baf, *wab, *bab; float* of; const float *gnw, *rnw, *rnb; };
constexpr int NTB = 16;
template <int DK, bool GLA, bool BWD>
__device__ __forceinline__ void naive_sweep(Frame& F, const MixArgs& a, int job) {
    const int grp = F.tid >> 7, gt = F.tid & 127;
    int seq, head; if (job < 16) { seq = 32 + (job >> 3); head = job & 7; } else { seq = (job - 16) >> 3; head = (job - 16) & 7; }
    const int L = seq < 32 ? L_PROMPT : L_SAMPLE, row_base = seq < 32 ? seq * L_PROMPT : M_PROMPT + (seq - 32) * L_SAMPLE;
    const int hh = GLA ? head : head - 4;
    const int qcol = GLA ? 1024 + 64 * hh : 2048 + 128 * hh, kcol = GLA ? 1280 + 64 * hh : 2560 + 128 * hh, vcol = 128 * head;
    LAS float* sq = (LAS float*)(F.lds + grp * (3 * NTB * 128 * 4)); LAS float* sk = sq + NTB * DK; LAS float* sa = sk + NTB * DK;
    const float gam = 1.0f - exp2f(-5.0f - (float)hh);
    const float* wal = BWD ? a.wab : a.waf; const float* bal = BWD ? a.bab : a.baf;
    float S[DK];
#pragma unroll
    for (int t = 0; t < DK; ++t) S[t] = 0.f;
    for (int t0 = 0; t0 < L; t0 += NTB) {
        __syncthreads();
        for (int e = gt; e < NTB * DK; e += 128) {
            const int tok = e / DK, t = e % DK, tp = t0 + tok, row = row_base + (BWD ? L - 1 - tp : tp);
            const bf16* pr = a.proj + (size_t)row * NP;
            sq[e] = bf2f(pr[qcol + t]); sk[e] = bf2f(pr[kcol + t]);
            if (GLA) { const float* gar = a.ga + (size_t)row * 32 + (BWD ? 16 : 0); float z = bal[64 * hh + t];
#pragma unroll
                for (int r = 0; r < 16; ++r) z += gar[r] * wal[r * 256 + 64 * hh + t];
                sa[e] = expf(fmaxf(log_sigmoid_f(z) * (1.0f / 16.0f), -1.0f)); }
        }
        __syncthreads();
        for (int tok = 0; tok < NTB; ++tok) {
            const int tp = t0 + tok, row = row_base + (BWD ? L - 1 - tp : tp);
            const float vv = bf2f(a.proj[(size_t)row * NP + vcol + gt]);
            float o = 0.f;
#pragma unroll
            for (int t4 = 0; t4 < DK / 4; ++t4) {
                const f32x4 q = *(const LAS f32x4*)(sq + tok * DK + 4 * t4), k = *(const LAS f32x4*)(sk + tok * DK + 4 * t4);
                f32x4 al = {gam, gam, gam, gam}; if (GLA) al = *(const LAS f32x4*)(sa + tok * DK + 4 * t4);
#pragma unroll
                for (int j = 0; j < 4; ++j) {
                    if (!BWD) { S[4 * t4 + j] = al[j] * S[4 * t4 + j] + k[j] * vv; o += q[j] * S[4 * t4 + j]; }
                    else { S[4 * t4 + j] *= al[j]; o += q[j] * S[4 * t4 + j]; S[4 * t4 + j] += k[j] * vv; }
                }
            }
            float* op = a.of + (size_t)row * D + 128 * head + gt;
            if (!BWD) *op = o; else *op += o;
        }
    }
}
template <bool BWD>
__device__ __forceinline__ void naive_mix_phase(Frame& F, const MixArgs& a) {
    if (blockIdx.x >= 68) return;
    const int job = blockIdx.x * 4 + (F.tid >> 7);
    if ((blockIdx.x & 1) == 0) { if (!MIX_GLA) naive_sweep<64, true, BWD>(F, a, job); } else { if (!MIX_RET) naive_sweep<128, false, BWD>(F, a, job); }
}
__device__ __forceinline__ void naive_combine(Frame& F, const MixArgs& a) {
    const int gw = F.vcu * NWAVES + F.wave, NGW = F.G * NWAVES, c = 2 * F.lane;
    for (int item = gw; item < M_TOK * 8; item += NGW) {
        const int row = item >> 3, head = item & 7;
        if (head < 4 ? MIX_GLA : MIX_RET) continue;
        const float* op = a.of + (size_t)row * D + 128 * head + c;
        float o0 = op[0], o1 = op[1], y0, y1;
        if (head < 4) { const float r = 1.0f / sqrtf(wave_sum(o0 * o0 + o1 * o1) * (1.0f / 128.0f) + EPS); y0 = o0 * r * a.gnw[c]; y1 = o1 * r * a.gnw[c + 1]; }
        else { const float mu = wave_sum(o0 + o1) * (1.0f / 128.0f); o0 -= mu; o1 -= mu; const float r = 1.0f / sqrtf(wave_sum(o0 * o0 + o1 * o1) * (1.0f / 128.0f) + EPS);
            const int cc = 128 * (head - 4) + c; y0 = o0 * r * a.rnw[cc] + a.rnb[cc]; y1 = o1 * r * a.rnw[cc + 1] + a.rnb[cc + 1]; }
        bf16* pr = a.proj + (size_t)row * NP;
        const int gcol = (head < 4 ? 1536 + 128 * head : 3072 + 128 * (head - 4)) + c;
        const unsigned gw2 = *(const unsigned*)(pr + gcol);
        const float g0 = __uint_as_float(gw2 << 16), g1 = __uint_as_float(gw2 & 0xffff0000u);
        y0 *= g0 / (1.0f + expf(-g0)); y1 *= g1 / (1.0f + expf(-g1));
        *(unsigned*)(pr + 128 * head + c) = cvtpk(y0, y1);
    }
}
__device__ __forceinline__ void final_norm(Frame& F, float* out, const bf16* x2b, const float* sq, const float* w) {
    const int gw = F.vcu * NWAVES + F.wave, NGW = F.G * NWAVES;
    for (int row = gw; row < M_TOK; row += NGW) {
        const f32x4* s4 = (const f32x4*)(sq + (size_t)row * 16);
        const f32x4 t = (s4[0] + s4[1]) + (s4[2] + s4[3]);
        const float r = 1.0f / sqrtf(((t[0] + t[1]) + (t[2] + t[3])) * (1.0f / 1024.0f) + EPS);
        const GAS v4u* xi = (const GAS v4u*)(x2b + (size_t)row * D) + F.lane;
        GAS f32x4* o = (GAS f32x4*)(out + (size_t)row * D) + 2 * F.lane; const f32x4* w4 = (const f32x4*)w + 2 * F.lane;
#pragma unroll
        for (int j = 0; j < 2; ++j) { const v4u xw = xi[64 * j];
            const f32x4 x0 = {__uint_as_float(xw.x << 16), __uint_as_float(xw.x & 0xffff0000u), __uint_as_float(xw.y << 16), __uint_as_float(xw.y & 0xffff0000u)};
            const f32x4 x1 = {__uint_as_float(xw.z << 16), __uint_as_float(xw.z & 0xffff0000u), __uint_as_float(xw.w << 16), __uint_as_float(xw.w & 0xffff0000u)};
            o[128 * j] = x0 * r * w4[128 * j]; o[128 * j + 1] = x1 * r * w4[128 * j + 1]; }
    }
}

typedef __bf16 bf16v2 __attribute__((ext_vector_type(2)));
typedef unsigned u32x2 __attribute__((ext_vector_type(2)));
__device__ __forceinline__ unsigned cvtpk_c(float lo, float hi) { bf16v2 v = {(__bf16)lo, (__bf16)hi}; return __builtin_bit_cast(unsigned, v); }
__device__ __forceinline__ float bflo(unsigned w) { return __uint_as_float(w << 16); }
__device__ __forceinline__ float bfhi(unsigned w) { return __uint_as_float(w & 0xffff0000u); }
__device__ __forceinline__ int opaque_i(int x) { asm volatile("" : "+v"(x)); return x; }
typedef short s16x4 __attribute__((ext_vector_type(4)));
#define TRRD(ptr) __builtin_amdgcn_ds_read_tr16_b64_v4i16((LAS s16x4*)(ptr))
constexpr size_t ST_SC_BYTES = 393216;
__device__ __forceinline__ size_t state_off(int sc, bool gla, int hh, int dir) { return (size_t)sc * ST_SC_BYTES + (gla ? (size_t)(hh * 2 + dir) * 16384 : (size_t)131072 + (size_t)(hh * 2 + dir) * 32768); }
struct CMixArgs { bf16* proj; const float* ga; const float *waf, *baf, *wab, *bab; unsigned char* st; float* dec; const float *gnw, *rnw, *rnb; bf16* mo; int mop; unsigned char* sto; unsigned char* ofs; float* bb0; float* bb1; };
constexpr int OB_PITCH = 132;

template <bool GLA> struct RawSet;
template <> struct RawSet<true> { v4u q, k, v0, v1; f32x4 b0, b1, l0, l1; };
template <> struct RawSet<false> { v4u q0, q1, k0, k1, v0, v1; };

template <bool GLA, bool WITH_O>
__device__ __forceinline__ void raw_load(RawSet<GLA>& R, const CMixArgs& a, int p, int s, int w, int lane0) {
    const int lane = opaque_i(lane0), sc = p >> 2, hh = p & 3, dir = s >> 2, c = dir ? 7 - s : s;
    const size_t row = (size_t)(sc * 256 + 64 * c + 8 * w + (lane >> 3)); const int pc = lane & 7;
    if constexpr (GLA) {
        if (WITH_O) R.q = *(const GAS v4u*)(a.proj + pg8::PL_GQ + (hh * pg8::MTOK + row) * 64 + 8 * pc);
        R.k = *(const GAS v4u*)(a.proj + pg8::PL_GK + (hh * pg8::MTOK + row) * 64 + 8 * pc);
        const bf16* pv = a.proj + pg8::PL_GV + (hh * pg8::MTOK + row) * 128 + 8 * pc;
        R.v0 = *(const GAS v4u*)pv; R.v1 = *(const GAS v4u*)(pv + 64);
        const float* bp = (dir ? a.bb1 : a.bb0) + ((size_t)(p * 4 + c) * 64) * 64 + 8 * pc;
        const int ti = 8 * w + (lane >> 3);
        R.b0 = *(const GAS f32x4*)(bp + ti * 64); R.b1 = *(const GAS f32x4*)(bp + ti * 64 + 4);
        R.l0 = *(const GAS f32x4*)(bp + (dir ? 0 : 63) * 64); R.l1 = *(const GAS f32x4*)(bp + (dir ? 0 : 63) * 64 + 4);
    } else {
        if (WITH_O) { const bf16* pq = a.proj + pg8::PL_RQ + (hh * pg8::MTOK + row) * 128 + 8 * pc; R.q0 = *(const GAS v4u*)pq; R.q1 = *(const GAS v4u*)(pq + 64); }
        const bf16* pk = a.proj + pg8::PL_RK + (hh * pg8::MTOK + row) * 128 + 8 * pc; R.k0 = *(const GAS v4u*)pk; R.k1 = *(const GAS v4u*)(pk + 64);
        const bf16* pv = a.proj + pg8::PL_RV + (hh * pg8::MTOK + row) * 128 + 8 * pc; R.v0 = *(const GAS v4u*)pv; R.v1 = *(const GAS v4u*)(pv + 64);
    }
}

template <int DK, bool GLA, bool WITH_O> struct MixLds {
    static constexpr int NT = DK / 16, NS = DK / 32;
    static constexpr int RQ = DK * 2 + 16, RP = 144, RV = 272;
    static constexpr int O_QD = 0, O_KI = 64 * RQ, O_KE = 2 * 64 * RQ, O_PB = 3 * 64 * RQ, O_VB = O_PB + 64 * RP, O_DC = O_VB + 64 * RV, O_WAL = O_DC + DK * 4,
                         O_OB = O_WAL, O_END = O_OB + 64 * OB_PITCH * 4;
    static_assert(O_END <= 146432, "mixer LDS map");
};

template <int DK, bool GLA, bool WITH_O>
__device__ __forceinline__ void mix_step(Frame& F, const CMixArgs& a, int p, int s, int pnext, RawSet<GLA>& R, f32x4 (&S)[DK / 16], float (&dsum)[8], u32x2 (&ofp)[4][4]) {
    typedef MixLds<DK, GLA, WITH_O> ML;
    constexpr int NT = ML::NT, NS = ML::NS, RQ = ML::RQ, RP = ML::RP, RV = ML::RV;
    LAS unsigned char* L = F.lds;
    const int lane0 = F.lane, w = F.wave;
    const int sc = p >> 2, hh = p & 3, dir = s >> 2, c = dir ? 7 - s : s, row0 = sc * 256, head = GLA ? hh : 4 + hh, vcol = 128 * head;
    __syncthreads();
    {
        const int lane = opaque_i(lane0), i = 8 * w + (lane >> 3), pc = lane & 7;
        *(LAS v4u*)(L + ML::O_VB + i * RV + 16 * pc) = R.v0; *(LAS v4u*)(L + ML::O_VB + i * RV + 128 + 16 * pc) = R.v1;
        if constexpr (GLA) {
            const int tk = lane >> 3;
            float q8[8], k8[8], e8[8];
#pragma unroll
            for (int e = 0; e < 8; ++e) { const float b = e < 4 ? R.b0[e & 3] : R.b1[e & 3], bl_ = e < 4 ? R.l0[e & 3] : R.l1[e & 3];
                const unsigned wq = WITH_O ? ((const unsigned*)&R.q)[e >> 1] : 0u, wk = ((const unsigned*)&R.k)[e >> 1];
                const float qv = (e & 1) ? bfhi(wq) : bflo(wq), kv = (e & 1) ? bfhi(wk) : bflo(wk);
                q8[e] = qv * __expf(b); k8[e] = kv * __expf(-b); e8[e] = kv * __expf(bl_ - b);
                if (!WITH_O) dsum[e] += bl_;
                if (w == 0 && tk == 0) ((LAS float*)(L + ML::O_DC))[8 * pc + e] = __expf(bl_); }
            v4u oq, ok, oe;
            oq.x = cvtpk_c(q8[0], q8[1]); oq.y = cvtpk_c(q8[2], q8[3]); oq.z = cvtpk_c(q8[4], q8[5]); oq.w = cvtpk_c(q8[6], q8[7]);
            ok.x = cvtpk_c(k8[0], k8[1]); ok.y = cvtpk_c(k8[2], k8[3]); ok.z = cvtpk_c(k8[4], k8[5]); ok.w = cvtpk_c(k8[6], k8[7]);
            oe.x = cvtpk_c(e8[0], e8[1]); oe.y = cvtpk_c(e8[2], e8[3]); oe.z = cvtpk_c(e8[4], e8[5]); oe.w = cvtpk_c(e8[6], e8[7]);
            if (WITH_O) { *(LAS v4u*)(L + ML::O_QD + i * RQ + 16 * pc) = oq; *(LAS v4u*)(L + ML::O_KI + i * RQ + 16 * pc) = ok; }
            *(LAS v4u*)(L + ML::O_KE + i * RQ + 16 * pc) = oe;
        } else {
            const float l2g = hh == 0 ? -0.045803689613124f : hh == 1 ? -0.022720076500083f : hh == 2 ? -0.011315313227834f : -0.005646563141142f;
            const float nq = dir ? (float)(64 - i) : (float)(i + 1), ne = dir ? (float)i : (float)(63 - i);
            const float eb = exp2f(l2g * nq), ei = exp2f(-l2g * nq), ee = exp2f(l2g * ne);
#pragma unroll
            for (int x = 0; x < 2; ++x) { v4u oq, ok, oe; const v4u rq = x ? R.q1 : R.q0, rk = x ? R.k1 : R.k0;
#pragma unroll
                for (int j = 0; j < 4; ++j) { const unsigned wq = WITH_O ? ((const unsigned*)&rq)[j] : 0u, wk = ((const unsigned*)&rk)[j];
                    ((unsigned*)&oq)[j] = cvtpk_c(bflo(wq) * eb, bfhi(wq) * eb); ((unsigned*)&ok)[j] = cvtpk_c(bflo(wk) * ei, bfhi(wk) * ei); ((unsigned*)&oe)[j] = cvtpk_c(bflo(wk) * ee, bfhi(wk) * ee); }
                if (WITH_O) { *(LAS v4u*)(L + ML::O_QD + i * RQ + 128 * x + 16 * pc) = oq; *(LAS v4u*)(L + ML::O_KI + i * RQ + 128 * x + 16 * pc) = ok; }
                *(LAS v4u*)(L + ML::O_KE + i * RQ + 128 * x + 16 * pc) = oe; }
            if (w == 0 && lane < 32) *(LAS f32x4*)(L + ML::O_DC + lane * 16) = (f32x4){exp2f(l2g * 64.0f), exp2f(l2g * 64.0f), exp2f(l2g * 64.0f), exp2f(l2g * 64.0f)};
        }
    }
    v4u gt0, gt1; f32x4 nw[4], nb[4];
    if (WITH_O) { const int lane = opaque_i(lane0);
        const bf16* gp = a.proj + (GLA ? pg8::PL_GG : pg8::PL_RG) + (dir ? (hh * pg8::MTOK + (size_t)(row0 + 64 * c + 8 * w + (lane >> 3))) * 128 + 16 * (lane & 7) : (size_t)0);
        gt0 = *(const GAS v4u*)gp; gt1 = *(const GAS v4u*)(gp + 8);
        const float* wp = GLA ? a.gnw + 16 * (lane & 7) : a.rnw + 128 * hh + 16 * (lane & 7);
#pragma unroll
        for (int k = 0; k < 4; ++k) { nw[k] = *(const GAS f32x4*)(wp + 4 * k); if (!GLA) nb[k] = *(const GAS f32x4*)(a.rnb + 128 * hh + 16 * (lane & 7) + 4 * k); } }
    raw_load<GLA, WITH_O>(R, a, s < 6 ? p : (pnext < 1536 ? pnext : p), s < 6 ? s + 2 : s - 6, w, lane0);
    __syncthreads();
    if (WITH_O) {
        const int lane = opaque_i(lane0), g = lane >> 4, lr = lane & 15;
        const int mi = w >> 1;
        bf16x8 kf[2][NS], qf2[NS];
#pragma unroll
        for (int s2 = 0; s2 < NS; ++s2) { qf2[s2] = *(const LAS bf16x8*)(L + ML::O_QD + (16 * mi + lr) * RQ + 64 * s2 + 16 * g);
#pragma unroll
            for (int jj = 0; jj < 2; ++jj) kf[jj][s2] = *(const LAS bf16x8*)(L + ML::O_KI + (16 * (2 * (w & 1) + jj) + lr) * RQ + 64 * s2 + 16 * g); }
        __builtin_amdgcn_sched_barrier(0);
#pragma unroll
        for (int jj = 0; jj < 2; ++jj) { const int nj = 2 * (w & 1) + jj;
            f32x4 acc = {0.f, 0.f, 0.f, 0.f};
#pragma unroll
            for (int s2 = 0; s2 < NS; ++s2) acc = __builtin_amdgcn_mfma_f32_16x16x32_bf16(kf[jj][s2], qf2[s2], acc, 0, 0, 0);
            const int ii = 16 * mi + lr;
#pragma unroll
            for (int r = 0; r < 4; ++r) { const int j = 16 * nj + 4 * g + r; const bool keep = dir ? (j > ii) : (j <= ii); acc[r] = keep ? acc[r] : 0.f; }
            u32x2 pk; pk.x = cvtpk_c(acc[0], acc[1]); pk.y = cvtpk_c(acc[2], acc[3]);
            *(LAS u32x2*)(L + ML::O_PB + ii * RP + 32 * nj + 8 * g) = pk; }
        __syncthreads();
    }
    f32x4 o[4];
    {
        const int lane = opaque_i(lane0), g = lane >> 4, lr = lane & 15, q4 = lr >> 2, p4 = lr & 3;
        const LAS unsigned char* vb = L + ML::O_VB + (8 * g + q4) * RV + 32 * w + 8 * p4;
        const bf16x8 vf0 = __builtin_shufflevector(TRRD(vb), TRRD(vb + 4 * RV), 0, 1, 2, 3, 4, 5, 6, 7), vf1 = __builtin_shufflevector(TRRD(vb + 32 * RV), TRRD(vb + 36 * RV), 0, 1, 2, 3, 4, 5, 6, 7);
        if (WITH_O) {
            { bf16x8 pf[4][2];
#pragma unroll
              for (int m = 0; m < 4; ++m) { pf[m][0] = *(const LAS bf16x8*)(L + ML::O_PB + (16 * m + lr) * RP + 16 * g); pf[m][1] = *(const LAS bf16x8*)(L + ML::O_PB + (16 * m + lr) * RP + 64 + 16 * g); }
              __builtin_amdgcn_sched_barrier(0);
#pragma unroll
              for (int m = 0; m < 4; ++m) { o[m] = __builtin_amdgcn_mfma_f32_16x16x32_bf16(pf[m][0], vf0, (f32x4){0.f, 0.f, 0.f, 0.f}, 0, 0, 0); o[m] = __builtin_amdgcn_mfma_f32_16x16x32_bf16(pf[m][1], vf1, o[m], 0, 0, 0); }
              __builtin_amdgcn_sched_barrier(0); }
#pragma unroll
            for (int sh = 0; sh < NS / 2; ++sh) {
                u32x2 ql[2][4][2];
#pragma unroll
                for (int x = 0; x < 2; ++x)
#pragma unroll
                    for (int m = 0; m < 4; ++m) { ql[x][m][0] = *(const LAS u32x2*)(L + ML::O_QD + (16 * m + lr) * RQ + 64 * (2 * sh + x) + 8 * g); ql[x][m][1] = *(const LAS u32x2*)(L + ML::O_QD + (16 * m + lr) * RQ + 64 * (2 * sh + x) + 32 + 8 * g); }
                __builtin_amdgcn_sched_barrier(0);
#pragma unroll
                for (int x = 0; x < 2; ++x) { const int s2 = 2 * sh + x;
                    const bf16x8 sf = __builtin_bit_cast(bf16x8, (v4u){cvtpk_c(S[2 * s2][0], S[2 * s2][1]), cvtpk_c(S[2 * s2][2], S[2 * s2][3]), cvtpk_c(S[2 * s2 + 1][0], S[2 * s2 + 1][1]), cvtpk_c(S[2 * s2 + 1][2], S[2 * s2 + 1][3])});
#pragma unroll
                    for (int m = 0; m < 4; ++m) o[m] = __builtin_amdgcn_mfma_f32_16x16x32_bf16(__builtin_bit_cast(bf16x8, (v4u){ql[x][m][0].x, ql[x][m][0].y, ql[x][m][1].x, ql[x][m][1].y}), sf, o[m], 0, 0, 0); }
                __builtin_amdgcn_sched_barrier(0);
            }
        }
#pragma unroll
        for (int th = 0; th < NT / 4; ++th) {
            f32x4 d4[4]; bf16x8 kf0[4], kf1[4];
#pragma unroll
            for (int x = 0; x < 4; ++x) { const int tt = 4 * th + x;
                d4[x] = *(const LAS f32x4*)(L + ML::O_DC + (16 * tt + 4 * g) * 4);
                const LAS unsigned char* kb = L + ML::O_KE + (8 * g + q4) * RQ + 32 * tt + 8 * p4;
                kf0[x] = __builtin_shufflevector(TRRD(kb), TRRD(kb + 4 * RQ), 0, 1, 2, 3, 4, 5, 6, 7); kf1[x] = __builtin_shufflevector(TRRD(kb + 32 * RQ), TRRD(kb + 36 * RQ), 0, 1, 2, 3, 4, 5, 6, 7); }
            __builtin_amdgcn_sched_barrier(0);
#pragma unroll
            for (int x = 0; x < 4; ++x) { const int tt = 4 * th + x;
                S[tt] = S[tt] * d4[x];
                S[tt] = __builtin_amdgcn_mfma_f32_16x16x32_bf16(kf0[x], vf0, S[tt], 0, 0, 0);
                S[tt] = __builtin_amdgcn_mfma_f32_16x16x32_bf16(kf1[x], vf1, S[tt], 0, 0, 0); }
            __builtin_amdgcn_sched_barrier(0);
        }
    }
    if (WITH_O) {
        const int lane = opaque_i(lane0), g = lane >> 4, lr = lane & 15;
        if (dir == 0) {
#pragma unroll
            for (int cc = 0; cc < 4; ++cc) if (cc == c) {
#pragma unroll
                for (int m = 0; m < 4; ++m) { ofp[cc][m].x = cvtpk_c(o[m][0], o[m][1]); ofp[cc][m].y = cvtpk_c(o[m][2], o[m][3]); } }
        } else {
            u32x2 ofr[4];
#pragma unroll
            for (int cc = 0; cc < 4; ++cc) if (cc == c) {
#pragma unroll
                for (int m = 0; m < 4; ++m) ofr[m] = ofp[cc][m]; }
            LAS float* ob = (LAS float*)(L + ML::O_OB);
#pragma unroll
            for (int m = 0; m < 4; ++m) { const f32x4 t = {o[m][0] + bflo(ofr[m].x), o[m][1] + bfhi(ofr[m].x), o[m][2] + bflo(ofr[m].y), o[m][3] + bfhi(ofr[m].y)};
#pragma unroll
                for (int r = 0; r < 4; ++r) ob[(16 * m + 4 * g + r) * OB_PITCH + 16 * w + lr] = t[r]; }
            __syncthreads();
            const int row = 8 * w + (lane >> 3), pc = lane & 7;
            f32x4 x[4];
#pragma unroll
            for (int k = 0; k < 4; ++k) x[k] = *(const LAS f32x4*)(ob + row * OB_PITCH + 16 * pc + 4 * k);
            float rs;
            if (GLA) { float ss = 0.f;
#pragma unroll
                for (int k = 0; k < 4; ++k) ss += (x[k][0] * x[k][0] + x[k][1] * x[k][1]) + (x[k][2] * x[k][2] + x[k][3] * x[k][3]);
                ss += __shfl_xor(ss, 1); ss += __shfl_xor(ss, 2); ss += __shfl_xor(ss, 4);
                rs = __builtin_amdgcn_rsqf(ss * (1.0f / 128.0f) + EPS); }
            else { float sm = 0.f;
#pragma unroll
                for (int k = 0; k < 4; ++k) sm += (x[k][0] + x[k][1]) + (x[k][2] + x[k][3]);
                sm += __shfl_xor(sm, 1); sm += __shfl_xor(sm, 2); sm += __shfl_xor(sm, 4);
                const float mu = sm * (1.0f / 128.0f); float ss = 0.f;
#pragma unroll
                for (int k = 0; k < 4; ++k) { x[k] = x[k] - mu; ss += (x[k][0] * x[k][0] + x[k][1] * x[k][1]) + (x[k][2] * x[k][2] + x[k][3] * x[k][3]); }
                ss += __shfl_xor(ss, 1); ss += __shfl_xor(ss, 2); ss += __shfl_xor(ss, 4);
                rs = __builtin_amdgcn_rsqf(ss * (1.0f / 128.0f) + EPS); }
            unsigned ow[8];
#pragma unroll
            for (int k = 0; k < 4; ++k) { f32x4 y = x[k] * rs * nw[k];
                if (!GLA) y = y + nb[k];
                const unsigned ga_ = k < 2 ? ((const unsigned*)&gt0)[2 * k] : ((const unsigned*)&gt1)[2 * k - 4], gb_ = k < 2 ? ((const unsigned*)&gt0)[2 * k + 1] : ((const unsigned*)&gt1)[2 * k - 3];
                const float g0 = bflo(ga_), g1 = bfhi(ga_), g2 = bflo(gb_), g3 = bfhi(gb_);
                y[0] *= g0 * __builtin_amdgcn_rcpf(1.0f + __expf(-g0)); y[1] *= g1 * __builtin_amdgcn_rcpf(1.0f + __expf(-g1));
                y[2] *= g2 * __builtin_amdgcn_rcpf(1.0f + __expf(-g2)); y[3] *= g3 * __builtin_amdgcn_rcpf(1.0f + __expf(-g3));
                ow[2 * k] = cvtpk_c(y[0], y[1]); ow[2 * k + 1] = cvtpk_c(y[2], y[3]); }
            bf16* op = a.mo + (size_t)(row0 + 64 * c + row) * a.mop + vcol + 16 * pc;
            *(GAS v4u*)op = (v4u){ow[0], ow[1], ow[2], ow[3]}; *(GAS v4u*)(op + 8) = (v4u){ow[4], ow[5], ow[6], ow[7]};
        }
    }
}


__device__ __forceinline__ void gla_b_stage(Frame& F, const CMixArgs& a, int p) {
    const int sc = p >> 2, hh = p & 3, w = F.wave;
    LAS float* gl = (LAS float*)F.lds;
    __syncthreads();
    { const int tid = opaque_i(F.tid);
#pragma unroll
      for (int x = 0; x < 4; ++x) *(LAS f32x4*)(gl + 4 * (tid + 512 * x)) = *(const GAS f32x4*)(a.ga + (size_t)sc * 256 * 32 + 4 * (tid + 512 * x)); }
    __syncthreads();
    const int t = opaque_i(F.lane), dir = w >> 2, c = w & 3;
    const float* wa = (dir ? a.wab : a.waf) + 64 * hh + t;
    float wv[16];
#pragma unroll
    for (int r = 0; r < 16; ++r) wv[r] = wa[r * 256];
    const float bias = (dir ? a.bab : a.baf)[64 * hh + t];
    float* bp = (dir ? a.bb1 : a.bb0) + ((size_t)(p * 4 + c) * 64) * 64 + t;
    float acc = 0.f;
#pragma unroll 1
    for (int k4 = 0; k4 < 64; k4 += 4) {
        f32x4 gv[4][4];
#pragma unroll
        for (int j = 0; j < 4; ++j) { const int i = dir ? 63 - (k4 + j) : k4 + j; const LAS float* gr = gl + (64 * c + i) * 32 + 16 * dir;
#pragma unroll
            for (int x = 0; x < 4; ++x) gv[j][x] = *(const LAS f32x4*)(gr + 4 * x); }
        __builtin_amdgcn_sched_barrier(0);
#pragma unroll
        for (int j = 0; j < 4; ++j) { const int i = dir ? 63 - (k4 + j) : k4 + j;
            float z = bias;
#pragma unroll
            for (int r = 0; r < 16; ++r) z += gv[j][r >> 2][r & 3] * wv[r];
            const float ls = fminf(z, 0.f) - __logf(1.0f + __expf(-fabsf(z)));
            acc += fmaxf(ls * (1.0f / 16.0f), -1.0f);
            bp[i * 64] = acc; }
    }
}

template <int DK, bool GLA, bool WITH_O>
__device__ __forceinline__ void mix_units(Frame& F, const CMixArgs& a) {
    typedef MixLds<DK, GLA, WITH_O> ML;
    constexpr int NT = DK / 16;
    const int w = F.wave, lane0 = F.lane;
    int p = (int)blockIdx.x;
    if (p >= 1536) return;
    if (GLA && !WITH_O) {
#pragma unroll 1
        for (int pp = p; pp < 1536; pp += F.G) gla_b_stage(F, a, pp);
        asm volatile("s_waitcnt vmcnt(0)" ::: "memory"); __syncthreads(); }
    RawSet<GLA> RA, RB;
    raw_load<GLA, WITH_O>(RA, a, p, 0, w, lane0); raw_load<GLA, WITH_O>(RB, a, p, 1, w, lane0);
    f32x4 S[NT]; float dsum[8]; u32x2 ofp[4][4];
#pragma unroll 1
    for (; p < 1536; p += F.G) {
        const int sc = p >> 2, hh = p & 3, pnext = p + F.G;
#pragma unroll 1
        for (int dir = 0; dir < 2; ++dir) {
            const int lane = opaque_i(lane0);
            unsigned char* sp = a.st + state_off(sc, GLA, hh, dir) + (size_t)(unsigned)(w * NT * 512 + lane * 8);
            if (WITH_O) {
#pragma unroll
                for (int tt = 0; tt < NT; ++tt) { const u32x2 pk = *(const GAS u32x2*)(sp + tt * 512); S[tt] = (f32x4){bflo(pk.x), bfhi(pk.x), bflo(pk.y), bfhi(pk.y)}; } }
            else {
#pragma unroll
                for (int tt = 0; tt < NT; ++tt) S[tt] = (f32x4){0.f, 0.f, 0.f, 0.f};
#pragma unroll
                for (int e = 0; e < 8; ++e) dsum[e] = 0.f; }
#pragma unroll 1
            for (int h2 = 0; h2 < 2; ++h2) {
                mix_step<DK, GLA, WITH_O>(F, a, p, 4 * dir + 2 * h2, pnext, RA, S, dsum, ofp);
                mix_step<DK, GLA, WITH_O>(F, a, p, 4 * dir + 2 * h2 + 1, pnext, RB, S, dsum, ofp);
            }
            if (!WITH_O) {
#pragma unroll
                for (int tt = 0; tt < NT; ++tt) { u32x2 pk; pk.x = cvtpk_c(S[tt][0], S[tt][1]); pk.y = cvtpk_c(S[tt][2], S[tt][3]); *(GAS u32x2*)(sp + tt * 512) = pk; }
                if (GLA && w == 0 && lane < 8) { float* dp = a.dec + (size_t)((sc * 4 + hh) * 2 + dir) * 64 + 8 * lane;
#pragma unroll
                    for (int e = 0; e < 8; ++e) dp[e] = __expf(dsum[e]); }
            }
        }
    }
}
struct RetKV { v4u k0, k1, v0, v1; };
__device__ __forceinline__ void ret_kv_load(RetKV& R, const CMixArgs& a, int p, int kb, int tid0) {
    const int tid = opaque_i(tid0), sc = p >> 2, hh = p & 3;
    const int r0 = tid >> 4, c16 = tid & 15;
    const size_t row = (size_t)(sc * 256 + 64 * kb + r0);
    const bf16* pk = a.proj + pg8::PL_RK + (hh * pg8::MTOK + row) * 128 + 8 * c16; const bf16* pv = a.proj + pg8::PL_RV + (hh * pg8::MTOK + row) * 128 + 8 * c16;
    R.k0 = *(const GAS v4u*)pk; R.k1 = *(const GAS v4u*)(pk + 32 * 128);
    R.v0 = *(const GAS v4u*)pv; R.v1 = *(const GAS v4u*)(pv + 32 * 128);
}
constexpr int RD_RK = 272, RD_KB = 64 * RD_RK;
__device__ __forceinline__ void ret_block(Frame& F, const CMixArgs& a, int p, int kb, int pnext, RetKV& R, const bf16x8 (&Qf)[2][4], f32x4 (&O)[8][2]) {
    LAS unsigned char* L = F.lds;
    const int w = F.wave, hh = p & 3;
    const float l2g = hh == 0 ? -0.045803689613124f : hh == 1 ? -0.022720076500083f : hh == 2 ? -0.011315313227834f : -0.005646563141142f;
    LAS unsigned char* KB = L + (kb & 1) * RD_KB; LAS unsigned char* VB = L + 2 * RD_KB + (kb & 1) * RD_KB;
    { const int tid = opaque_i(F.tid), r0 = tid >> 4, c16 = tid & 15;
      *(LAS v4u*)(KB + r0 * RD_RK + 16 * c16) = R.k0; *(LAS v4u*)(KB + (r0 + 32) * RD_RK + 16 * c16) = R.k1;
      *(LAS v4u*)(VB + r0 * RD_RK + 16 * c16) = R.v0; *(LAS v4u*)(VB + (r0 + 32) * RD_RK + 16 * c16) = R.v1; }
    ret_kv_load(R, a, kb < 3 ? p : (pnext < 1536 ? pnext : p), kb < 3 ? kb + 1 : 0, F.tid);
    __syncthreads();
    const int lane = opaque_i(F.lane), g = lane >> 4, lr = lane & 15, q4 = lr >> 2, p4 = lr & 3;
#pragma unroll
    for (int sp = 0; sp < 2; ++sp) {
        f32x4 st[2][2];
#pragma unroll
        for (int h = 0; h < 2; ++h)
#pragma unroll
            for (int it = 0; it < 2; ++it) st[h][it] = (f32x4){0.f, 0.f, 0.f, 0.f};
        { bf16x8 kf[2][4];
#pragma unroll
          for (int s = 0; s < 4; ++s)
#pragma unroll
              for (int h = 0; h < 2; ++h) {
                  const LAS unsigned char* kp = KB + (32 * sp + 16 * h + lr) * RD_RK + 64 * s + 8 * g;
                  const u32x2 lo = *(const LAS u32x2*)kp, hi = *(const LAS u32x2*)(kp + 32);
                  kf[h][s] = __builtin_bit_cast(bf16x8, (v4u){lo.x, lo.y, hi.x, hi.y}); }
          __builtin_amdgcn_sched_barrier(0);
#pragma unroll
          for (int s = 0; s < 4; ++s)
#pragma unroll
              for (int h = 0; h < 2; ++h)
#pragma unroll
                  for (int it = 0; it < 2; ++it) st[h][it] = __builtin_amdgcn_mfma_f32_16x16x32_bf16(kf[h][s], Qf[it][s], st[h][it], 0, 0, 0);
          __builtin_amdgcn_sched_barrier(0); }
        bf16x8 pf[2];
#pragma unroll
        for (int it = 0; it < 2; ++it) {
            const int i = 32 * w + 16 * it + lr;
            unsigned pw[4];
#pragma unroll
            for (int h = 0; h < 2; ++h) { float e[4];
#pragma unroll
                for (int r = 0; r < 4; ++r) { const int j = 64 * kb + 32 * sp + 16 * h + 4 * g + r; const int d = i - j; e[r] = st[h][it][r] * __builtin_amdgcn_exp2f(l2g * (float)(d < 0 ? -d : d)); }
                pw[2 * h] = cvtpk_c(e[0], e[1]); pw[2 * h + 1] = cvtpk_c(e[2], e[3]); }
            pf[it] = __builtin_bit_cast(bf16x8, (v4u){pw[0], pw[1], pw[2], pw[3]});
        }
        { bf16x8 vf[8];
#pragma unroll
          for (int dt = 0; dt < 8; ++dt) { const LAS unsigned char* vp = VB + (32 * sp + 4 * g + q4) * RD_RK + 32 * dt + 8 * p4;
              vf[dt] = __builtin_shufflevector(TRRD(vp), TRRD(vp + 16 * RD_RK), 0, 1, 2, 3, 4, 5, 6, 7); }
          __builtin_amdgcn_sched_barrier(0);
#pragma unroll
          for (int dt = 0; dt < 8; ++dt)
#pragma unroll
              for (int it = 0; it < 2; ++it) O[dt][it] = __builtin_amdgcn_mfma_f32_16x16x32_bf16(vf[dt], pf[it], O[dt][it], 0, 0, 0);
          __builtin_amdgcn_sched_barrier(0); }
    }
}
__device__ __forceinline__ void ret_q_load(bf16x8 (&Qf)[2][4], const CMixArgs& a, int p, int w, int lane0) {
    const int lane = opaque_i(lane0), g = lane >> 4, lr = lane & 15, sc = p >> 2, hh = p & 3;
#pragma unroll
    for (int it = 0; it < 2; ++it) { const bf16* qp = a.proj + pg8::PL_RQ + (hh * pg8::MTOK + (size_t)(sc * 256 + 32 * w + 16 * it + lr)) * 128 + 4 * g;
#pragma unroll
        for (int s = 0; s < 4; ++s) { const u32x2 lo = *(const GAS u32x2*)(qp + 32 * s), hi = *(const GAS u32x2*)(qp + 32 * s + 16); Qf[it][s] = __builtin_bit_cast(bf16x8, (v4u){lo.x, lo.y, hi.x, hi.y}); } }
}
__device__ __forceinline__ void ret_units_direct(Frame& F, const CMixArgs& a) {
    const int w = F.wave;
    int p = (int)blockIdx.x;
    if (p >= 1536) return;
    RetKV RA; bf16x8 Qf[2][4];
    ret_kv_load(RA, a, p, 0, F.tid);
    ret_q_load(Qf, a, p, w, F.lane);
#pragma unroll 1
    for (; p < 1536; p += F.G) {
        const int sc = p >> 2, hh = p & 3, pnext = p + F.G;
        const float l2g = hh == 0 ? -0.045803689613124f : hh == 1 ? -0.022720076500083f : hh == 2 ? -0.011315313227834f : -0.005646563141142f;
        f32x4 O[8][2];
#pragma unroll
        for (int dt = 0; dt < 8; ++dt)
#pragma unroll
            for (int it = 0; it < 2; ++it) O[dt][it] = (f32x4){0.f, 0.f, 0.f, 0.f};
#pragma unroll 1
        for (int kb = 0; kb < 4; ++kb) ret_block(F, a, p, kb, pnext, RA, Qf, O);
        { const int lane = opaque_i(F.lane), lr = lane & 15;
#pragma unroll
          for (int dir = 0; dir < 2; ++dir) {
              const unsigned char* sp_ = a.st + state_off(sc, false, hh, dir) + (size_t)(unsigned)(lane * 8);
              float f[2];
#pragma unroll
              for (int it = 0; it < 2; ++it) { const int i = 32 * w + 16 * it + lr; f[it] = __builtin_amdgcn_exp2f(l2g * (float)(dir ? 256 - i : i + 1)); }
#pragma unroll
              for (int s = 0; s < 4; ++s) {
                  bf16x8 qs[2];
#pragma unroll
                  for (int it = 0; it < 2; ++it) { const v4u qw = __builtin_bit_cast(v4u, Qf[it][s]); v4u o;
#pragma unroll
                      for (int j = 0; j < 4; ++j) ((unsigned*)&o)[j] = cvtpk_c(bflo(((const unsigned*)&qw)[j]) * f[it], bfhi(((const unsigned*)&qw)[j]) * f[it]);
                      qs[it] = __builtin_bit_cast(bf16x8, o); }
#pragma unroll
                  for (int dt = 0; dt < 8; ++dt) { const u32x2 lo = *(const GAS u32x2*)(sp_ + (dt * 8 + 2 * s) * 512), hi = *(const GAS u32x2*)(sp_ + (dt * 8 + 2 * s + 1) * 512);
                      const bf16x8 cf = __builtin_bit_cast(bf16x8, (v4u){lo.x, lo.y, hi.x, hi.y});
#pragma unroll
                      for (int it = 0; it < 2; ++it) O[dt][it] = __builtin_amdgcn_mfma_f32_16x16x32_bf16(cf, qs[it], O[dt][it], 0, 0, 0); }
                  __builtin_amdgcn_sched_barrier(0);
              }
          } }
        ret_q_load(Qf, a, pnext < 1536 ? pnext : p, w, F.lane);
        { const int lane = opaque_i(F.lane), g = lane >> 4, lr = lane & 15;
#pragma unroll
          for (int it = 0; it < 2; ++it) {
              const size_t row = (size_t)(sc * 256 + 32 * w + 16 * it + lr);
              const bf16* gp = a.proj + pg8::PL_RG + (hh * pg8::MTOK + row) * 128 + 4 * g; bf16* op = a.mo + row * a.mop + 512 + 128 * hh + 4 * g;
              u32x2 gt[8];
#pragma unroll
              for (int dt = 0; dt < 8; ++dt) gt[dt] = *(const GAS u32x2*)(gp + 16 * dt);
              float sm = 0.f;
#pragma unroll
              for (int dt = 0; dt < 8; ++dt) sm += (O[dt][it][0] + O[dt][it][1]) + (O[dt][it][2] + O[dt][it][3]);
              sm += __shfl_xor(sm, 16); sm += __shfl_xor(sm, 32);
              const float mu = sm * (1.0f / 128.0f); float ss = 0.f;
#pragma unroll
              for (int dt = 0; dt < 8; ++dt) { O[dt][it] = O[dt][it] - mu; ss += (O[dt][it][0] * O[dt][it][0] + O[dt][it][1] * O[dt][it][1]) + (O[dt][it][2] * O[dt][it][2] + O[dt][it][3] * O[dt][it][3]); }
              ss += __shfl_xor(ss, 16); ss += __shfl_xor(ss, 32);
              const float rs = __builtin_amdgcn_rsqf(ss * (1.0f / 128.0f) + EPS);
#pragma unroll
              for (int dt = 0; dt < 8; ++dt) { const f32x4 w4 = *(const GAS f32x4*)(a.rnw + 128 * hh + 16 * dt + 4 * g), b4 = *(const GAS f32x4*)(a.rnb + 128 * hh + 16 * dt + 4 * g);
                  f32x4 y = O[dt][it] * rs * w4 + b4;
                  const float g0 = bflo(gt[dt].x), g1 = bfhi(gt[dt].x), g2 = bflo(gt[dt].y), g3 = bfhi(gt[dt].y);
                  y[0] *= g0 * __builtin_amdgcn_rcpf(1.0f + __expf(-g0)); y[1] *= g1 * __builtin_amdgcn_rcpf(1.0f + __expf(-g1));
                  y[2] *= g2 * __builtin_amdgcn_rcpf(1.0f + __expf(-g2)); y[3] *= g3 * __builtin_amdgcn_rcpf(1.0f + __expf(-g3));
                  u32x2 pk; pk.x = cvtpk_c(y[0], y[1]); pk.y = cvtpk_c(y[2], y[3]);
                  *(GAS u32x2*)(op + 16 * dt) = pk; }
          } }
    }
}

template <bool WITH_O>
__device__ __forceinline__ void cmix_phase(Frame& F, const CMixArgs& a, int which = 3) {
#if MIX_GLA
    if (which & 1) { mix_units<64, true, WITH_O>(F, a);
    __syncthreads(); }
#endif
#if MIX_RET
    if (which & 2) { if constexpr (WITH_O) ret_units_direct(F, a); else mix_units<128, false, false>(F, a);
    __syncthreads(); }
#endif
}
__device__ __forceinline__ void scan_phase(Frame& F, const CMixArgs& a) {
    const int nthreads = F.G * NWAVES * 64;
    for (int chain = (int)blockIdx.x * NWAVES * 64 + F.tid; chain < 34 * 49152; chain += nthreads) {
        const int sq = chain / 49152, cidx = chain % 49152;
        const int seq = sq < 2 ? 32 + sq : sq - 2;
        const int sc0 = seq < 32 ? seq * 8 : 256 + (seq - 32) * 64, ns = seq < 32 ? 8 : 64;
        const bool gla = cidx < 16384; const int c2 = gla ? cidx : cidx - 16384;
        const int hd = gla ? (c2 >> 11) : (c2 >> 12), v = gla ? (c2 & 2047) : (c2 & 4095), hh = hd >> 1, dir = hd & 1;
        if ((gla && !MIX_GLA) || (!gla && !MIX_RET)) continue;
        const int t0 = 16 * ((v >> 6) & 3) + 4 * ((v & 63) >> 4);
        const float gret = exp2f(256.0f * log2f(1.0f - exp2f(-5.0f - (float)hh)));
        f32x4 cst = {0.f, 0.f, 0.f, 0.f};
        for (int blk = 0; blk < ns; blk += 8) {
            u32x2 kv[8]; f32x4 d[8];
#pragma unroll
            for (int j = 0; j < 8; ++j) { const int n = dir ? ns - 1 - (blk + j) : blk + j;
                kv[j] = *(const GAS u32x2*)(a.st + state_off(sc0 + n, gla, hh, dir) + (size_t)v * 8);
                d[j] = gla ? *(const GAS f32x4*)(a.dec + (size_t)(((sc0 + n) * 4 + hh) * 2 + dir) * 64 + t0) : (f32x4){gret, gret, gret, gret}; }
#pragma unroll
            for (int j = 0; j < 8; ++j) { const int n = dir ? ns - 1 - (blk + j) : blk + j;
                u32x2 pk; pk.x = cvtpk_c(cst[0], cst[1]); pk.y = cvtpk_c(cst[2], cst[3]);
                *(GAS u32x2*)(a.sto + state_off(sc0 + n, gla, hh, dir) + (size_t)v * 8) = pk;
                cst = d[j] * cst + (f32x4){bflo(kv[j].x), bfhi(kv[j].x), bflo(kv[j].y), bfhi(kv[j].y)}; }
        }
    }
}

#define NAIVE_MIX (!(MIX_GLA && MIX_RET))
constexpr int PB0 = NAIVE_MIX ? 8 : 5, NPH = PB0 + 4;
struct Args { const float* in[16]; float* out; unsigned char* ws; int ph_lo, ph_hi, use_bar, pad; };
__global__ void __launch_bounds__(NWAVES * 64, 2) fwd_kernel(Args args) {
    extern __shared__ __attribute__((aligned(16))) unsigned char lds[];
    Frame F;
    F.lds = (LAS unsigned char*)lds;
    F.MISC = (volatile LAS unsigned*)(F.lds + MISC_OFF);
    F.tid = threadIdx.x; F.lane = F.tid & 63; F.wave = __builtin_amdgcn_readfirstlane(F.tid >> 6);
    F.G = gridDim.x; { const int bx = blockIdx.x; F.vcu = (F.G % 8 == 0) ? (bx % 8) * (F.G / 8) + bx / 8 : bx; }
    unsigned char* ws = args.ws;
    gu32* ctl = (gu32*)(ws + WS_CTL);
    for (int u = F.tid; u < (LDS_BYTES - LDSCTL_OFF) / 4; u += NWAVES * 64) ((LAS unsigned*)(F.lds + LDSCTL_OFF))[u] = 0u;
    __syncthreads();
    XcdBarrier bar; bar.bar = (unsigned*)(ctl + CW_BAR); bar.x = 0; bar.st = nullptr;
    if (args.use_bar) bar = xcd_barrier_post((unsigned*)(ctl + CW_BAR), F.MISC + 8);
    const int lo = args.ph_lo, hi = args.ph_hi;
#define IN(k) (lo <= (k) && (k) < hi)
#define SEAM(k) do { if (IN(k) && IN((k) + 1)) xcd_barrier(bar); } while (0)
    if (IN(0)) { const P0Args pa{args.in[0], args.in[1], args.in[2], args.in[3], args.in[11], args.in[12], args.in[13], args.in[14], (bf16*)(ws + WS_WIN), (bf16*)(ws + WS_WOUT), (bf16*)(ws + WS_W1), (bf16*)(ws + WS_W2),
            (bf16*)(ws + WS_R0), (float*)(ws + WS_ROPE), (float*)(ws + WS_ROPE) + 16384 * 64, (float*)(ws + WS_GA), (float*)(ws + WS_RSTD)};
        p0_prologue(F, pa); __syncthreads();
#if REP0
        p0_prologue(F, pa); __syncthreads();
#endif
    }
    SEAM(0);
    if (IN(1)) { pg8::Gemm g{(bf16*)(ws + WS_R0), (bf16*)(ws + WS_WIN), M_TOK, NP, D, D}; pg8::StaticOrder S; S.init(M_TOK, NP, F.G, (int)blockIdx.x);
        pg8::EpiInProj E{(bf16*)(ws + WS_R1), (float*)(ws + WS_RSTD), (float*)(ws + WS_ROPE), (float*)(ws + WS_ROPE) + 16384 * 64};
#if REP1 == 2
        { pg8::EpiPlain E2{(bf16*)(ws + WS_R1)}; pg8::gemm_phase<pg8::EpiPlain, pg8::StaticOrder, true, true>(F.lds + RING_OFF, g, S, E2); } __syncthreads();
#endif
        pg8::gemm_phase<pg8::EpiInProj, pg8::StaticOrder, true, true>(F.lds + RING_OFF, g, S, E);
#if REP1 == 1
        __syncthreads(); pg8::gemm_phase<pg8::EpiInProj, pg8::StaticOrder, true, true>(F.lds + RING_OFF, g, S, E);
#endif
    }
    SEAM(1);
    if (IN(2)) { const CMixArgs ca{(bf16*)(ws + WS_R1), (float*)(ws + WS_GA), args.in[4], args.in[5], args.in[6], args.in[7], ws + WS_R0, (float*)(ws + WS_DEC), args.in[8], args.in[9], args.in[10], (bf16*)((unsigned char*)args.out + (size_t)192 * MiB), D, ws + WS_R0, (unsigned char*)args.out, (float*)((unsigned char*)args.out + (size_t)96 * MiB), (float*)(ws + WS_R1 + (size_t)672 * MiB)};
        cmix_phase<false>(F, ca);
#if REP2
        cmix_phase<false>(F, ca, REP2);
#endif
    }
    SEAM(2);
    if (IN(3)) { const CMixArgs ca{(bf16*)(ws + WS_R1), (float*)(ws + WS_GA), args.in[4], args.in[5], args.in[6], args.in[7], ws + WS_R0, (float*)(ws + WS_DEC), args.in[8], args.in[9], args.in[10], (bf16*)((unsigned char*)args.out + (size_t)192 * MiB), D, ws + WS_R0, (unsigned char*)args.out, (float*)((unsigned char*)args.out + (size_t)96 * MiB), (float*)(ws + WS_R1 + (size_t)672 * MiB)};
#if REP3
        { CMixArgs cb = ca; cb.sto = (unsigned char*)args.out + (size_t)224 * MiB; scan_phase(F, cb); }
#endif
        scan_phase(F, ca); }
    SEAM(3);
    if (IN(4)) { const CMixArgs ca{(bf16*)(ws + WS_R1), (float*)(ws + WS_GA), args.in[4], args.in[5], args.in[6], args.in[7], ws + WS_R0, (float*)(ws + WS_DEC), args.in[8], args.in[9], args.in[10], (bf16*)((unsigned char*)args.out + (size_t)192 * MiB), D, ws + WS_R0, (unsigned char*)args.out, (float*)((unsigned char*)args.out + (size_t)96 * MiB), (float*)(ws + WS_R1 + (size_t)672 * MiB)};
#if REP4
        { CMixArgs cb = ca; cmix_phase<true>(F, cb, REP4); }
#endif
        cmix_phase<true>(F, ca); }
    SEAM(4);
#if NAIVE_MIX
    { const MixArgs ma{(bf16*)(ws + WS_R1), (float*)(ws + WS_GA), args.in[4], args.in[5], args.in[6], args.in[7], args.out, args.in[8], args.in[9], args.in[10]};
    if (IN(5)) { naive_mix_phase<false>(F, ma); __syncthreads(); }
    SEAM(5);
    if (IN(6)) { naive_mix_phase<true>(F, ma); __syncthreads(); }
    SEAM(6);
    if (IN(7)) { naive_combine(F, ma); }
    SEAM(7); }
#endif
    if (IN(PB0)) { pg8::Gemm g{(bf16*)((unsigned char*)args.out + (size_t)192 * MiB), (bf16*)(ws + WS_WOUT), M_TOK, D, D, D}; pg8::StaticOrder S; S.init(M_TOK, D, F.G, (int)blockIdx.x);
        pg8::EpiResidX E{args.in[0], args.in[1], (bf16*)(ws + WS_R0), (float*)(ws + WS_SQ1)};
        pg8::gemm_phase<pg8::EpiResidX, pg8::StaticOrder, true, true>(F.lds + RING_OFF, g, S, E); }
    SEAM(PB0);
    if (IN(PB0 + 1)) { pg8::Gemm g{(bf16*)(ws + WS_R0), (bf16*)(ws + WS_W1), M_TOK, FF, D, D}; pg8::StaticOrder S; S.init(M_TOK, FF, F.G, (int)blockIdx.x);
        pg8::EpiFF1 E{(bf16*)(ws + WS_R1), (float*)(ws + WS_SQ1)};
        pg8::gemm_phase<pg8::EpiFF1, pg8::StaticOrder, true, true>(F.lds + RING_OFF, g, S, E);
#if REP6
        __syncthreads(); pg8::gemm_phase<pg8::EpiFF1, pg8::StaticOrder, true, true>(F.lds + RING_OFF, g, S, E);
#endif
    }
    SEAM(PB0 + 1);
    if (IN(PB0 + 2)) { pg8::Gemm g{(bf16*)(ws + WS_R1), (bf16*)(ws + WS_W2), M_TOK, D, FF, FF}; pg8::StaticOrder S; S.init(M_TOK, D, F.G, (int)blockIdx.x);
        pg8::EpiResidB E{(bf16*)(ws + WS_R0), (float*)(ws + WS_SQ2)};
        pg8::gemm_phase<pg8::EpiResidB, pg8::StaticOrder, true, true>(F.lds + RING_OFF, g, S, E); }
    SEAM(PB0 + 2);
    if (IN(PB0 + 3)) { final_norm(F, args.out, (const bf16*)(ws + WS_R0), (float*)(ws + WS_SQ2), args.in[15]); }
#undef IN
#undef SEAM
}

extern "C" void kernel_launch(void* const* d_in, const int* in_sizes, int n_in, void* d_out, int out_size, void* d_ws, size_t ws_size, hipStream_t stream) {
    static int grid = 0;
    if (grid == 0) {
        if (n_in != 16 || in_sizes[0] != M_PROMPT * D || out_size != M_TOK * D || ws_size < WS_END) {
            fprintf(stderr, "kernel_launch: unexpected shapes (n_in %d, in0 %d, out %d, ws %zu); nothing launched\n", n_in, n_in > 0 ? in_sizes[0] : -1, out_size, ws_size); grid = -1; return; }
        int dev = 0, cus = 0, per_cu = 0;
        if (hipGetDevice(&dev) != hipSuccess || hipDeviceGetAttribute(&cus, hipDeviceAttributeMultiprocessorCount, dev) != hipSuccess) { grid = -1; return; }
        if (hipFuncSetAttribute((const void*)fwd_kernel, hipFuncAttributeMaxDynamicSharedMemorySize, LDS_BYTES) != hipSuccess) { fprintf(stderr, "kernel_launch: hipFuncSetAttribute failed\n"); grid = -1; return; }
        if (hipOccupancyMaxActiveBlocksPerMultiprocessor(&per_cu, (const void*)fwd_kernel, NWAVES * 64, LDS_BYTES) != hipSuccess || per_cu < 1)
            fprintf(stderr, "kernel_launch: note: occupancy query reports %d workgroups per CU\n", per_cu);
        (void)hipGetLastError();
        grid = cus;
    }
    if (grid < 0) return;
    if (hipMemsetAsync((char*)d_ws + WS_CTL, 0, CTL_ZERO_BYTES, stream) != hipSuccess) return;
    Args a{};
    for (int i = 0; i < 16; ++i) a.in[i] = (const float*)d_in[i];
    a.out = (float*)d_out; a.ws = (unsigned char*)d_ws;
#if MK_SINGLE
    a.ph_lo = 0; a.ph_hi = NPH; a.use_bar = 1;
    hipLaunchKernelGGL(fwd_kernel, dim3(grid), dim3(NWAVES * 64), LDS_BYTES, stream, a);
#else
    for (int p = 0; p < NPH; ++p) { a.ph_lo = p; a.ph_hi = p + 1; a.use_bar = 0;
        hipLaunchKernelGGL(fwd_kernel, dim3(grid), dim3(NWAVES * 64), LDS_BYTES, stream, a); }
#endif
}
```

```cpp
#include <hip/hip_runtime.h>
#include <cstdio>
#ifndef MK_SINGLE
#define MK_SINGLE 1
#endif
#ifndef MIX_GLA
#define MIX_GLA 1
#define MIX_RET 1
#define REP1 0
#define REP2 0
#define REP3 0
#define REP4 0
#define REP6 0
#define DUP 0
#define ABLV 0
#define REP0 0
#define REP5 0
#define REP8 0
#endif
namespace pg8 {
#define PG8_LAS __attribute__((address_space(3)))
typedef unsigned short bf16_t;
typedef short bf16x8 __attribute__((ext_vector_type(8)));
typedef float f32x4 __attribute__((ext_vector_type(4)));
typedef unsigned u32x4 __attribute__((ext_vector_type(4)));
constexpr int BM = 256, BK = 64, HALF = 128, HTB = HALF * BK * 2  , STAGE_BYTES = 8 * HTB, NXCD = 8, WGM = 8;

__host__ __device__ __forceinline__ int lds_byte(int r, int c) { const int st = (r >> 4) * 2 + (c >> 5), rr = r & 15, cc = c & 31, ob = rr * 64 + cc * 2; return st * 1024 + (ob ^ (((ob >> 9) & 1) << 5)); }
__host__ __device__ __forceinline__ void stage_rc(int b, int& R, int& C) { const int st = b / 1024, sb = b % 1024, swz = sb ^ (((sb >> 9) & 1) << 5); R = (st >> 1) * 16 + swz / 64; C = (st & 1) * 32 + (swz % 64) / 2; }
__host__ __device__ __forceinline__ int perm32(int rho) { const int n = rho >> 4, i = rho & 15; return 8 * (i >> 2) + 4 * n + (i & 3); }

struct Unit { int pm, pn; };
struct Gemm { const bf16_t* A; const bf16_t* Bt; int M, N, K, lda; };

struct StaticOrder {
    int nM, nN, nwg, G, c;
    __host__ __device__ void init(int M, int N, int G_, int c_) { nM = M / BM; nN = N / BM; nwg = nM * nN; G = G_; c = c_; }
    __host__ __device__ bool next(int i, Unit& u) const {
        const long L = (long)i * G + c; if (L >= nwg) return false;
        int wgid = (int)L; { const int q = nwg / NXCD, r = nwg % NXCD, xcd = wgid % NXCD, off = wgid / NXCD; wgid = (xcd < r ? xcd * (q + 1) : r * (q + 1) + (xcd - r) * q) + off; }
        const int nig = WGM * nN, gid = wgid / nig, fm = gid * WGM, gsz = (nM - fm) < WGM ? (nM - fm) : WGM;
        u.pm = fm + ((wgid % nig) % gsz); u.pn = (wgid % nig) / gsz; return true;
    }
    __device__ __forceinline__ void a_ready(const Unit&) const {}
    __device__ __forceinline__ void done(const Unit&) const {}
};
struct InProjOrder {
    int x, r;
    __host__ __device__ void init(int c_) { x = c_ & 7; r = c_ >> 3; }
    __host__ __device__ bool next(int i, Unit& u) const {
        if (i >= 21) return false;
        const int gi = i / 7, ri = i % 7;
        if (ri < 6) { u.pm = x * 48 + 16 * gi + 8 * (ri & 1) + (r & 7); u.pn = 4 * (ri >> 1) + (r >> 3); }
        else { u.pm = x * 48 + 16 * gi + (r & 15); u.pn = 12 + (r >> 4); }
        return true;
    }
    __device__ __forceinline__ void a_ready(const Unit&) const {}
    __device__ __forceinline__ void done(const Unit&) const {}
};
__device__ __forceinline__ unsigned cvt_pk_bf16(float lo, float hi) { unsigned r; asm volatile("v_cvt_pk_bf16_f32 %0, %1, %2" : "=v"(r) : "v"(lo), "v"(hi)); return r; }
__device__ __forceinline__ u32x4 pack8(const f32x4& a, const f32x4& b) { u32x4 w; w.x = cvt_pk_bf16(a[0], a[1]); w.y = cvt_pk_bf16(a[2], a[3]); w.z = cvt_pk_bf16(b[0], b[1]); w.w = cvt_pk_bf16(b[2], b[3]); return w; }
constexpr int NPROJ = 3584, DMODEL = 1024, DFF = 4096, MPROMPT = 65536;

constexpr size_t MTOK = 98304;
constexpr size_t PL_GV = 0, PL_RV = PL_GV + 4 * MTOK * 128, PL_GQ = PL_RV + 4 * MTOK * 128, PL_GK = PL_GQ + 4 * MTOK * 64, PL_GG = PL_GK + 4 * MTOK * 64,
                 PL_RQ = PL_GG + 4 * MTOK * 128, PL_RK = PL_RQ + 4 * MTOK * 128, PL_RG = PL_RK + 4 * MTOK * 128, PL_END = PL_RG + 4 * MTOK * 128;
__device__ __forceinline__ void plane_of(int pn, int bj, int wc, size_t& off, int& W, int& col) {
    W = 128; col = 32 * wc; int hh = 2 * (pn & 1) + bj; size_t grp;
    switch (pn >> 1) { case 0: grp = PL_GV; break; case 1: grp = PL_RV; break; case 3: grp = PL_GG; break; case 4: grp = PL_RQ; break; case 5: grp = PL_RK; break; case 6: grp = PL_RG; break;
        default: grp = (pn & 1) ? PL_GK : PL_GQ; W = 64; hh = 2 * bj + (wc >> 1); col = 32 * (wc & 1); break; }
    off = grp + (size_t)hh * MTOK * (size_t)W;
}
struct EpiInProj {
    static constexpr bool PERM = true, AFTER_DRAIN = false;
    bf16_t* P; const float* rstd; const float* rcos; const float* rsin;
    __device__ __forceinline__ void operator()(const f32x4 (&acc)[2][2][4][2], const Unit& u, int wr, int wc, int fr, int fq) const {
        const int row0 = u.pm * BM + wr * 64 + fr;
        const bool rot = (u.pn >= 8) && (u.pn < 12);
        const int i0 = (4 * wc + fq) * 4;
        size_t poff[2]; int W, col;
        plane_of(u.pn, 0, wc, poff[0], W, col); plane_of(u.pn, 1, wc, poff[1], W, col);
        float rs[2][4];
#pragma unroll
        for (int ai = 0; ai < 2; ++ai)
#pragma unroll
            for (int m = 0; m < 4; ++m) rs[ai][m] = rstd[row0 + ai * HALF + m * 16];
#pragma unroll
        for (int ai = 0; ai < 2; ++ai) {
            f32x4 c4[4], s4[4];
#pragma unroll
            for (int m = 0; m < 4; ++m) { c4[m] = (f32x4){1.f, 1.f, 1.f, 1.f}; s4[m] = (f32x4){0.f, 0.f, 0.f, 0.f}; }
            if (rot) {
#pragma unroll
                for (int m = 0; m < 4; ++m) { const int row = row0 + ai * HALF + m * 16; const int pos = row < MPROMPT ? (row & 2047) : (row & 16383);
                    c4[m] = *(const f32x4*)(rcos + pos * 64 + i0); s4[m] = *(const f32x4*)(rsin + pos * 64 + i0); } }
            __builtin_amdgcn_sched_barrier(0);
#pragma unroll
            for (int m = 0; m < 4; ++m) {
                const int row = row0 + ai * HALF + m * 16;
#pragma unroll
                for (int bj = 0; bj < 2; ++bj) {
                    f32x4 v0 = acc[ai][bj][m][0] * rs[ai][m], v1 = acc[ai][bj][m][1] * rs[ai][m];
                    if (rot) { const f32x4 lo = v0 * c4[m] - v1 * s4[m], hi = v0 * s4[m] + v1 * c4[m]; v0 = lo; v1 = hi; }
                    *(u32x4*)(P + poff[bj] + (size_t)row * W + col + 8 * fq) = pack8(v0, v1);
                }
            }
            __builtin_amdgcn_sched_barrier(0);
        }
    }
};
struct EpiResid {
    static constexpr bool PERM = true, AFTER_DRAIN = false;
    const float* xp; const float* xs; float* out; bf16_t* A2; float* sq;
    __device__ __forceinline__ void operator()(const f32x4 (&acc)[2][2][4][2], const Unit& u, int wr, int wc, int fr, int fq) const {
        const int row0 = u.pm * BM + wr * 64 + fr, colb = u.pn * BM + wc * 32 + 8 * fq;
#pragma unroll
        for (int ai = 0; ai < 2; ++ai)
#pragma unroll
            for (int m = 0; m < 4; ++m) {
                const int row = row0 + ai * HALF + m * 16;
                const float* xrow = (row < MPROMPT ? xp + (size_t)row * DMODEL : xs + (size_t)(row - MPROMPT) * DMODEL) + colb;
                float* orow = out + (size_t)row * DMODEL + colb;
                float ss = 0.f;
#pragma unroll
                for (int bj = 0; bj < 2; ++bj) {
                    const f32x4 x0 = *(const f32x4*)(xrow + bj * HALF), x1 = *(const f32x4*)(xrow + bj * HALF + 4);
                    const f32x4 v0 = acc[ai][bj][m][0] + x0, v1 = acc[ai][bj][m][1] + x1;
                    *(f32x4*)(orow + bj * HALF) = v0; *(f32x4*)(orow + bj * HALF + 4) = v1;
                    if (A2) *(u32x4*)(A2 + (size_t)row * DMODEL + colb + bj * HALF) = pack8(v0, v1);
                    ss += (v0[0] * v0[0] + v0[1] * v0[1]) + (v0[2] * v0[2] + v0[3] * v0[3]) + (v1[0] * v1[0] + v1[1] * v1[1]) + (v1[2] * v1[2] + v1[3] * v1[3]);
                }
                ss += __shfl_xor(ss, 16); ss += __shfl_xor(ss, 32);
                if (fq == 0) sq[(size_t)row * 16 + u.pn * 4 + wc] = ss;
            }
    }
};
struct EpiFF1 {
    static constexpr bool PERM = true, AFTER_DRAIN = false;
    bf16_t* H; const float* r2v;
    __device__ __forceinline__ void operator()(const f32x4 (&acc)[2][2][4][2], const Unit& u, int wr, int wc, int fr, int fq) const {
        const int row0 = u.pm * BM + wr * 64 + fr, colb = u.pn * BM + wc * 32 + 8 * fq;
        float r2[2][4];
#pragma unroll
        for (int ai = 0; ai < 2; ++ai)
#pragma unroll
            for (int m = 0; m < 4; ++m) r2[ai][m] = r2v[row0 + ai * HALF + m * 16];
        __builtin_amdgcn_sched_barrier(0);
#pragma unroll
        for (int ai = 0; ai < 2; ++ai)
#pragma unroll
            for (int m = 0; m < 4; ++m) {
                const int row = row0 + ai * HALF + m * 16;
                bf16_t* rowp = H + (size_t)row * DFF + colb;
#pragma unroll
                for (int bj = 0; bj < 2; ++bj) {
                    f32x4 v0 = acc[ai][bj][m][0], v1 = acc[ai][bj][m][1];
#pragma unroll
                    for (int j = 0; j < 4; ++j) { const float a = fmaxf(v0[j], 0.f), b = fmaxf(v1[j], 0.f); v0[j] = a * a * r2[ai][m]; v1[j] = b * b * r2[ai][m]; }
                    *(u32x4*)(rowp + bj * HALF) = pack8(v0, v1);
                }
            }
    }
};

struct EpiPlain {
    static constexpr bool PERM = true, AFTER_DRAIN = false;
    bf16_t* P;
    __device__ __forceinline__ void operator()(const f32x4 (&acc)[2][2][4][2], const Unit& u, int wr, int wc, int fr, int fq) const {
        const int row0 = u.pm * BM + wr * 64 + fr;
        size_t poff[2]; int W, col;
        plane_of(u.pn, 0, wc, poff[0], W, col); plane_of(u.pn, 1, wc, poff[1], W, col);
#pragma unroll
        for (int ai = 0; ai < 2; ++ai)
#pragma unroll
            for (int m = 0; m < 4; ++m) { const int row = row0 + ai * HALF + m * 16;
#pragma unroll
                for (int bj = 0; bj < 2; ++bj) *(u32x4*)(P + poff[bj] + (size_t)row * W + col + 8 * fq) = pack8(acc[ai][bj][m][0], acc[ai][bj][m][1]); }
    }
};

struct EpiResidX {
    static constexpr bool PERM = true, AFTER_DRAIN = false;
    const float* xp; const float* xs; bf16_t* A2; float* sq;
    __device__ __forceinline__ void operator()(const f32x4 (&acc)[2][2][4][2], const Unit& u, int wr, int wc, int fr, int fq) const {
        const int row0 = u.pm * BM + wr * 64 + fr, colb = u.pn * BM + wc * 32 + 8 * fq;
#pragma unroll
        for (int ai = 0; ai < 2; ++ai) {
            f32x4 xv[4][2][2];
#pragma unroll
            for (int m = 0; m < 4; ++m) { const int row = row0 + ai * HALF + m * 16;
                const float* xrow = (row < MPROMPT ? xp + (size_t)row * DMODEL : xs + (size_t)(row - MPROMPT) * DMODEL) + colb;
#pragma unroll
                for (int bj = 0; bj < 2; ++bj) { xv[m][bj][0] = *(const f32x4*)(xrow + bj * HALF); xv[m][bj][1] = *(const f32x4*)(xrow + bj * HALF + 4); } }
            __builtin_amdgcn_sched_barrier(0);
#pragma unroll
            for (int m = 0; m < 4; ++m) {
                const int row = row0 + ai * HALF + m * 16;
                float ss = 0.f;
#pragma unroll
                for (int bj = 0; bj < 2; ++bj) {
                    const f32x4 v0 = acc[ai][bj][m][0] + xv[m][bj][0], v1 = acc[ai][bj][m][1] + xv[m][bj][1];
                    *(u32x4*)(A2 + (size_t)row * DMODEL + colb + bj * HALF) = pack8(v0, v1);
                    ss += (v0[0] * v0[0] + v0[1] * v0[1]) + (v0[2] * v0[2] + v0[3] * v0[3]) + (v1[0] * v1[0] + v1[1] * v1[1]) + (v1[2] * v1[2] + v1[3] * v1[3]);
                }
                ss += __shfl_xor(ss, 16); ss += __shfl_xor(ss, 32);
                if (fq == 0) sq[(size_t)row * 16 + u.pn * 4 + wc] = ss;
            }
            __builtin_amdgcn_sched_barrier(0);
        }
    }
};
struct EpiResidB {
    static constexpr bool PERM = true, AFTER_DRAIN = false;
    bf16_t* A2; float* sq;
    __device__ __forceinline__ void operator()(const f32x4 (&acc)[2][2][4][2], const Unit& u, int wr, int wc, int fr, int fq) const {
        const int row0 = u.pm * BM + wr * 64 + fr, colb = u.pn * BM + wc * 32 + 8 * fq;
        u32x4 xw[2][4][2];
#pragma unroll
        for (int ai = 0; ai < 2; ++ai)
#pragma unroll
            for (int m = 0; m < 4; ++m)
#pragma unroll
                for (int bj = 0; bj < 2; ++bj) xw[ai][m][bj] = *(const u32x4*)(A2 + (size_t)(row0 + ai * HALF + m * 16) * DMODEL + colb + bj * HALF);
        __builtin_amdgcn_sched_barrier(0);
#pragma unroll
        for (int ai = 0; ai < 2; ++ai)
#pragma unroll
            for (int m = 0; m < 4; ++m) {
                const int row = row0 + ai * HALF + m * 16;
                bf16_t* xr = A2 + (size_t)row * DMODEL + colb;
                float ss = 0.f;
#pragma unroll
                for (int bj = 0; bj < 2; ++bj) {
                    const u32x4 w_ = xw[ai][m][bj];
                    const f32x4 x0 = {__uint_as_float(w_.x << 16), __uint_as_float(w_.x & 0xffff0000u), __uint_as_float(w_.y << 16), __uint_as_float(w_.y & 0xffff0000u)};
                    const f32x4 x1 = {__uint_as_float(w_.z << 16), __uint_as_float(w_.z & 0xffff0000u), __uint_as_float(w_.w << 16), __uint_as_float(w_.w & 0xffff0000u)};
                    const f32x4 v0 = acc[ai][bj][m][0] + x0, v1 = acc[ai][bj][m][1] + x1;
                    *(u32x4*)(xr + bj * HALF) = pack8(v0, v1);
                    ss += (v0[0] * v0[0] + v0[1] * v0[1]) + (v0[2] * v0[2] + v0[3] * v0[3]) + (v1[0] * v1[0] + v1[1] * v1[1]) + (v1[2] * v1[2] + v1[3] * v1[3]);
                }
                ss += __shfl_xor(ss, 16); ss += __shfl_xor(ss, 32);
                if (fq == 0) sq[(size_t)row * 16 + u.pn * 4 + wc] = ss;
            }
    }
};
template <class Epi, class Sched, bool ALIGN_EPI = false, bool SP2 = false>
__device__ __forceinline__ void gemm_phase(PG8_LAS unsigned char* lds, const Gemm g, const Sched& S, const Epi& E) {
    const int tid = threadIdx.x, wid = __builtin_amdgcn_readfirstlane(tid >> 6), lane = tid & 63, wr = wid >> 2, wc = wid & 3, fr = lane & 15, fq = lane >> 4;
    const int K = g.K, nt = K / BK;
    unsigned voffA[2], voffB[2];
#pragma unroll
    for (int i = 0; i < 2; ++i) { int R, C; stage_rc(tid * 16 + i * 8192, R, C); const int Rb = Epi::PERM ? ((R & ~31) + perm32(R & 31)) : R;
        voffA[i] = (unsigned)(R * g.lda + C) * 2u; voffB[i] = (unsigned)(Rb * K + C) * 2u; }
    const size_t kstep = (size_t)(BK * 2);
    const size_t hstepB = (size_t)HALF * K * 2, hstepA = (size_t)HALF * g.lda * 2;
    const size_t tstepB = 2 * hstepB, tstepA = 2 * hstepA;
    const unsigned ldsw = (unsigned)wid * 1024u;
    const int aoff = lds_byte(wr * 64 + fr, fq * 8), boff = lds_byte(wc * 32 + fr, fq * 8);
#define PG8_SA(b, h) (((b) * 2 + (h)) * HTB)
#define PG8_SB(b, h) ((4 + (b) * 2 + (h)) * HTB)
#define PG8_STAGE(bufoff, gbase, voff) do { _Pragma("unroll") for (int _i = 0; _i < 2; ++_i) \
        __builtin_amdgcn_global_load_lds((const unsigned*)((const char*)(gbase) + (voff)[_i]), (PG8_LAS unsigned*)(lds + (bufoff) + ldsw + _i * 8192), 16, 0, 0); } while (0)
#define PG8_LDA(dst, b, h) do { _Pragma("unroll") for (int m = 0; m < 4; ++m) _Pragma("unroll") for (int k = 0; k < 2; ++k) dst[m][k] = *(const PG8_LAS bf16x8*)(lds + PG8_SA(b, h) + aoff + m * 2048 + k * 1024); } while (0)
#define PG8_LDB(dst, b, h) do { _Pragma("unroll") for (int n = 0; n < 2; ++n) _Pragma("unroll") for (int k = 0; k < 2; ++k) dst[n][k] = *(const PG8_LAS bf16x8*)(lds + PG8_SB(b, h) + boff + n * 2048 + k * 1024); } while (0)
#define PG8_MMA(ai, bj, At, Bt) do { __builtin_amdgcn_s_setprio(1); _Pragma("unroll") for (int m = 0; m < 4; ++m) _Pragma("unroll") for (int n = 0; n < 2; ++n) _Pragma("unroll") for (int k = 0; k < 2; ++k) \
        acc[ai][bj][m][n] = __builtin_amdgcn_mfma_f32_16x16x32_bf16(Bt[n][k], At[m][k], acc[ai][bj][m][n], 0, 0, 0); __builtin_amdgcn_s_setprio(0); } while (0)
#define PG8_WAIT_V(n) asm volatile("s_waitcnt vmcnt(" #n ")" ::: "memory")
#define PG8_WAIT_L(n) asm volatile("s_waitcnt lgkmcnt(" #n ")" ::: "memory")
#define PG8_BAR __builtin_amdgcn_s_barrier()
#define PG8_SCHED __builtin_amdgcn_sched_barrier(0)
    Unit cur, nxt; int ui = 0;
    if (!S.next(0, cur)) return;
    f32x4 acc[2][2][4][2];
#pragma unroll
    for (int a = 0; a < 2; ++a)
#pragma unroll
        for (int b = 0; b < 2; ++b)
#pragma unroll
            for (int m = 0; m < 4; ++m)
#pragma unroll
                for (int n = 0; n < 2; ++n) acc[a][b][m][n] = (f32x4){0.f, 0.f, 0.f, 0.f};
    bf16x8 At[4][2], B0[2][2], B1[2][2];
    const char* cA = (const char*)g.A + (size_t)cur.pm * tstepA; const char* cB = (const char*)g.Bt + (size_t)cur.pn * tstepB;
    S.a_ready(cur);
    if constexpr (SP2) {
        PG8_STAGE(PG8_SB(0, 0), cB, voffB); PG8_STAGE(PG8_SB(0, 1), cB + hstepB, voffB); PG8_STAGE(PG8_SA(0, 0), cA, voffA); PG8_STAGE(PG8_SA(0, 1), cA + hstepA, voffA);
        if (wr == 1) PG8_BAR;
        PG8_WAIT_V(2); PG8_BAR;
        PG8_STAGE(PG8_SB(1, 0), cB + kstep, voffB); PG8_STAGE(PG8_SA(1, 0), cA + kstep, voffA); PG8_STAGE(PG8_SB(1, 1), cB + hstepB + kstep, voffB);
        PG8_WAIT_V(6); PG8_BAR;
    } else {
        PG8_STAGE(PG8_SB(0, 0), cB, voffB); PG8_STAGE(PG8_SA(0, 0), cA, voffA); PG8_STAGE(PG8_SB(0, 1), cB + hstepB, voffB); PG8_STAGE(PG8_SA(0, 1), cA + hstepA, voffA);
        if (wr == 1) PG8_BAR;
        PG8_WAIT_V(4); PG8_BAR;
        PG8_STAGE(PG8_SB(1, 0), cB + kstep, voffB); PG8_STAGE(PG8_SA(1, 0), cA + kstep, voffA); PG8_STAGE(PG8_SB(1, 1), cB + hstepB + kstep, voffB);
        PG8_WAIT_V(6); PG8_BAR;
    }
    for (;;) {
        const bool has_next = S.next(ui + 1, nxt);
        const char* nA = has_next ? (const char*)g.A + (size_t)nxt.pm * tstepA : cA; const char* nB = has_next ? (const char*)g.Bt + (size_t)nxt.pn * tstepB : cB;
        for (int t = 0; t < nt; t += 2) {
            const bool last = (t == nt - 2);
            const char* a1 = cA + (size_t)(t + 1) * kstep;
            const char* a2 = last ? nA : cA + (size_t)(t + 2) * kstep; const char* b2 = last ? nB : cB + (size_t)(t + 2) * kstep;
            const char* a3 = a2 + kstep; const char* b3 = b2 + kstep;
            if (last && has_next) S.a_ready(nxt);
            if constexpr (SP2) {
            PG8_LDB(B0, 0, 0); PG8_LDB(B1, 0, 1); PG8_SCHED; PG8_LDA(At, 0, 0); PG8_STAGE(PG8_SA(1, 1), a1 + hstepA, voffA);
            PG8_WAIT_V(8); PG8_WAIT_L(0); PG8_BAR; PG8_MMA(0, 0, At, B0); PG8_MMA(0, 1, At, B1); PG8_BAR; PG8_SCHED;
            PG8_LDA(At, 0, 1); PG8_STAGE(PG8_SB(0, 0), b2, voffB); PG8_STAGE(PG8_SB(0, 1), b2 + hstepB, voffB); PG8_STAGE(PG8_SA(0, 0), a2, voffA);
            PG8_WAIT_V(8); PG8_WAIT_L(0); PG8_BAR; PG8_MMA(1, 0, At, B0); PG8_MMA(1, 1, At, B1); PG8_BAR; PG8_SCHED;
            PG8_LDB(B0, 1, 0); PG8_LDB(B1, 1, 1); PG8_SCHED; PG8_LDA(At, 1, 0); PG8_STAGE(PG8_SA(0, 1), a2 + hstepA, voffA);
            PG8_WAIT_V(8); PG8_WAIT_L(0); PG8_BAR; PG8_MMA(0, 0, At, B0); PG8_MMA(0, 1, At, B1); PG8_BAR; PG8_SCHED;
            PG8_LDA(At, 1, 1); PG8_STAGE(PG8_SB(1, 0), b3, voffB); PG8_STAGE(PG8_SB(1, 1), b3 + hstepB, voffB); PG8_STAGE(PG8_SA(1, 0), a3, voffA);
            PG8_WAIT_V(8); PG8_WAIT_L(0); PG8_BAR; PG8_MMA(1, 0, At, B0); PG8_MMA(1, 1, At, B1); PG8_BAR; PG8_SCHED;
            } else {
            PG8_LDB(B0, 0, 0); PG8_SCHED; PG8_LDA(At, 0, 0); PG8_STAGE(PG8_SA(1, 1), a1 + hstepA, voffA);
            PG8_WAIT_L(8); PG8_BAR; PG8_WAIT_L(0); PG8_MMA(0, 0, At, B0); PG8_BAR; PG8_SCHED;
            PG8_LDB(B1, 0, 1); PG8_STAGE(PG8_SB(0, 0), b2, voffB);
            PG8_BAR; PG8_WAIT_L(0); PG8_MMA(0, 1, At, B1); PG8_BAR;
            PG8_LDA(At, 0, 1); PG8_STAGE(PG8_SA(0, 0), a2, voffA);
            PG8_BAR; PG8_WAIT_L(0); PG8_MMA(1, 0, At, B0); PG8_BAR; PG8_SCHED;
            PG8_STAGE(PG8_SB(0, 1), b2 + hstepB, voffB);
            PG8_WAIT_V(6); PG8_BAR; PG8_MMA(1, 1, At, B1); PG8_BAR;
            PG8_LDB(B0, 1, 0); PG8_SCHED; PG8_LDA(At, 1, 0); PG8_STAGE(PG8_SA(0, 1), a2 + hstepA, voffA);
            PG8_WAIT_L(8); PG8_BAR; PG8_WAIT_L(0); PG8_MMA(0, 0, At, B0); PG8_BAR; PG8_SCHED;
            PG8_LDB(B1, 1, 1); PG8_STAGE(PG8_SB(1, 0), b3, voffB);
            PG8_BAR; PG8_WAIT_L(0); PG8_MMA(0, 1, At, B1); PG8_BAR;
            PG8_LDA(At, 1, 1); PG8_STAGE(PG8_SA(1, 0), a3, voffA);
            PG8_BAR; PG8_WAIT_L(0); PG8_MMA(1, 0, At, B0); PG8_BAR; PG8_SCHED;
            PG8_STAGE(PG8_SB(1, 1), b3 + hstepB, voffB);
            PG8_WAIT_V(6); PG8_BAR; PG8_MMA(1, 1, At, B1); PG8_BAR;
            }
        }
        if constexpr (ALIGN_EPI) { if (wr == 0) PG8_BAR; }
        if constexpr (!Epi::AFTER_DRAIN) { E(acc, cur, wr, wc, fr, fq); S.done(cur); }
        if (!has_next) break;
#pragma unroll
        for (int a = 0; a < 2; ++a)
#pragma unroll
            for (int b = 0; b < 2; ++b)
#pragma unroll
                for (int m = 0; m < 4; ++m)
#pragma unroll
                    for (int n = 0; n < 2; ++n) acc[a][b][m][n] = (f32x4){0.f, 0.f, 0.f, 0.f};
        cur = nxt; cA = nA; cB = nB; ++ui;
        if constexpr (ALIGN_EPI) { if (wr == 1) PG8_BAR; }
    }
    PG8_WAIT_V(0);
    if constexpr (!ALIGN_EPI) { if (wr == 0) PG8_BAR; }
    PG8_BAR;
    if constexpr (Epi::AFTER_DRAIN) { E.fused(acc, cur, wr, wc, fr, fq, lds, wid, lane); S.done(cur); }
#undef PG8_SA
#undef PG8_SB
#undef PG8_STAGE
#undef PG8_LDA
#undef PG8_LDB
#undef PG8_MMA
#undef PG8_WAIT_V
#undef PG8_WAIT_L
#undef PG8_BAR
#undef PG8_SCHED
}
}
#define GAS __attribute__((address_space(1)))
#define LAS __attribute__((address_space(3)))
typedef unsigned short bf16;
typedef unsigned v4u __attribute__((ext_vector_type(4)));
typedef float f32x4 __attribute__((ext_vector_type(4)));
typedef short bf16x8 __attribute__((ext_vector_type(8)));
typedef GAS unsigned gu32;
typedef GAS unsigned long long gu64;
#define RLX_AGENT __ATOMIC_RELAXED, __HIP_MEMORY_SCOPE_AGENT
#define LDS_WAIT() asm volatile("s_waitcnt lgkmcnt(0)" ::: "memory")
#define VM_WAIT() asm volatile("s_waitcnt vmcnt(0)" ::: "memory")
__device__ __forceinline__ unsigned long long rt() { return __builtin_amdgcn_s_memrealtime(); }
__device__ __forceinline__ unsigned f2bf(float f) { unsigned u = __builtin_bit_cast(unsigned, f); return (u + 0x7fffu + ((u >> 16) & 1u)) >> 16; }
__device__ __forceinline__ unsigned pk2(float lo, float hi) { return f2bf(lo) | (f2bf(hi) << 16); }

#define XB_TMO      128
#define XB_XCNT(j)  (256  + 64 * (j))
#define XB_XSUB(j)  (1280 + 64 * (j))
#define XB_XGEN(j)  (2304 + 64 * (j))
#define XB_TOP      3328
#define XB_TOPGEN   3392
#define XCD_BAR_WORDS 3456
#define XB_SPIN_CAP (1u << 18)

__device__ __forceinline__ unsigned xb_ld(unsigned* p)              { return __hip_atomic_load(p, __ATOMIC_RELAXED, __HIP_MEMORY_SCOPE_AGENT); }
__device__ __forceinline__ unsigned xb_add(unsigned* p, unsigned v) { return __hip_atomic_fetch_add(p, v, __ATOMIC_RELAXED, __HIP_MEMORY_SCOPE_AGENT); }
__device__ __forceinline__ unsigned xb_xcc_id() { return (unsigned)__builtin_amdgcn_s_getreg((3 << 11) | 20) & 0xFu; }
#define XB_SPIN(cond, bar) do { unsigned _sp = 0; while (cond) { __builtin_amdgcn_s_sleep(1); \
    if ((++_sp & 255u) == 0u) { if (xb_ld(&(bar)[XB_TMO])) break; if (_sp > XB_SPIN_CAP) { atomicAdd(&(bar)[XB_TMO], 1u); break; } } } } while (0)

struct XcdBarrier {
    unsigned* bar; unsigned x;
    volatile LAS unsigned* st;
};

__device__ __forceinline__ XcdBarrier xcd_barrier_post(unsigned* bar, volatile LAS unsigned* st) {
    XcdBarrier b; b.bar = bar; b.x = xb_xcc_id(); b.st = st;
    if (threadIdx.x == 0) (void)xb_add(&bar[XB_XCNT(b.x)], 1u);
    return b;
}
__device__ __forceinline__ void xcd_barrier_complete(unsigned* bar, unsigned x, unsigned& nloc, unsigned& nx) {
    const unsigned G = gridDim.x * gridDim.y * gridDim.z;
    unsigned sum, cnt, mine, sp = 0u;
    for (;;) {
        sum = 0u; cnt = 0u; mine = 0u;
#pragma unroll
        for (unsigned j = 0; j < 16; ++j) { const unsigned c = xb_ld(&bar[XB_XCNT(j)]); sum += c; cnt += (c > 0u) ? 1u : 0u; mine = (j == x) ? c : mine; }
        if (sum == G) break;
        __builtin_amdgcn_s_sleep(1);
        if ((++sp & 255u) == 0u) { if (xb_ld(&bar[XB_TMO])) break; if (sp > XB_SPIN_CAP) { atomicAdd(&bar[XB_TMO], 1u); break; } }
    }
    nloc = mine > 0u ? mine : 1u; nx = cnt > 0u ? cnt : 1u;
}

__device__ __forceinline__ void xcd_barrier(const XcdBarrier& b) {
    asm volatile("s_waitcnt vmcnt(0)" ::: "memory");
    __syncthreads();
    if (threadIdx.x == 0) {
        unsigned* bar = b.bar;
        __builtin_amdgcn_s_waitcnt(0);
        unsigned nloc = b.st[0], nx = b.st[1];
        if (nloc == 0u) { xcd_barrier_complete(bar, b.x, nloc, nx); b.st[0] = nloc; b.st[1] = nx; }
        const unsigned old = xb_add(&bar[XB_XSUB(b.x)], 1u);
        const unsigned gen = old / nloc;
        if (old + 1u == (gen + 1u) * nloc) {
            __builtin_amdgcn_fence(__ATOMIC_RELEASE, "agent");
            asm volatile("s_waitcnt vmcnt(0)" ::: "memory");
            const unsigned og = xb_add(&bar[XB_TOP], 1u);
            const unsigned tg = og / nx;
            if (og + 1u == (tg + 1u) * nx) xb_add(&bar[XB_TOPGEN], 1u);
            else XB_SPIN(xb_ld(&bar[XB_TOPGEN]) == tg, bar);
            __builtin_amdgcn_fence(__ATOMIC_ACQUIRE, "agent");
            xb_add(&bar[XB_XGEN(b.x)], 1u);
            asm volatile("s_waitcnt vmcnt(0)" ::: "memory");
        } else {
            XB_SPIN(xb_ld(&bar[XB_XGEN(b.x)]) == gen, bar);
            __builtin_amdgcn_fence(__ATOMIC_ACQUIRE, "agent");
            asm volatile("s_waitcnt vmcnt(0)" ::: "memory");
        }
    }
    __syncthreads();
}
constexpr int NWAVES = 8;
constexpr int M_TOK = 98304, M_PROMPT = 65536, D = 1024, NP = 3584, NWIN = 3616, FF = 4096;
constexpr int L_PROMPT = 2048, L_SAMPLE = 16384;
constexpr float EPS = 1e-6f;
constexpr size_t MiB = 1u << 20;
constexpr size_t WS_CTL = 0, CTL_ZERO_BYTES = 1 * MiB;
constexpr size_t WS_WIN = 1 * MiB;
constexpr size_t WS_WOUT = 9 * MiB;
constexpr size_t WS_W1 = 11 * MiB;
constexpr size_t WS_W2 = 19 * MiB;
constexpr size_t WS_ROPE = 27 * MiB;
constexpr size_t WS_GA = 35 * MiB;
constexpr size_t WS_RSTD = 47 * MiB;
constexpr size_t WS_SQ1 = 48 * MiB;
constexpr size_t WS_SQ2 = 54 * MiB;
constexpr size_t WS_DEC = 60 * MiB;
constexpr size_t WS_R0 = 64 * MiB;
constexpr size_t WS_R1 = 256 * MiB;
constexpr size_t WS_END = 1024 * MiB;
constexpr int CW_BAR = 4096;
constexpr int RING_OFF = 0, RING_BYTES = 131072;
constexpr int LDSCTL_OFF = 147456 - 1024, MISC_OFF = LDSCTL_OFF + 320;
constexpr int LDS_BYTES = 147456;

struct Frame {
    LAS unsigned char* lds;
    volatile LAS unsigned* MISC;
    int tid, lane, wave, vcu, G;
};
__device__ __forceinline__ float wave_sum(float v) {
#pragma unroll
    for (int o = 1; o < 64; o <<= 1) v += __shfl_xor(v, o);
    return v;
}
__device__ __forceinline__ float bf2f(bf16 b) { return __uint_as_float((unsigned)b << 16); }
__device__ __forceinline__ unsigned cvtpk(float lo, float hi) { unsigned r; asm volatile("v_cvt_pk_bf16_f32 %0, %1, %2" : "=v"(r) : "v"(lo), "v"(hi)); return r; }

__device__ __forceinline__ void win_map(int nd, int& sc, float& cs) {
    cs = 1.f;
    if (nd < 512) sc = 512 + nd;
    else if (nd < 1024) sc = 2592 + (nd - 512);
    else if (nd < 1280) { sc = nd - 1024; cs = 0.125f; }
    else if (nd < 1536) sc = 256 + (nd - 1280);
    else if (nd < 2048) sc = 1024 + (nd - 1536);
    else if (nd < 3072) {
        const bool isq = nd < 2560; const int p = nd - (isq ? 2048 : 2560), h = p >> 7, pp = p & 127, u = pp >> 3, j = pp & 7;
        const int d = (j < 4) ? 4 * u + j : 64 + 4 * u + (j - 4);
        sc = (isq ? 1568 : 2080) + 128 * h + d; if (isq) cs = 0.08838834764831845f; }
    else if (nd < 3584) sc = 3104 + (nd - 3072);
    else sc = 1536 + (nd - 3584);
}
template <bool MAP>
__device__ __forceinline__ void p0_transpose_item(const float* W, int K, int Nsrc, int nblk, const float* ks, bf16* WT, LAS float* scr, int item, int lane) {
    const int kb = item / nblk, nb = item % nblk, k0 = 64 * kb, n0 = 32 * nb;
    int sc = n0 + (lane & 31); float cs = 1.f;
    if (MAP) win_map(n0 + (lane & 31), sc, cs);
#pragma unroll 8
    for (int i = 0; i < 32; ++i) { const int kk = 2 * i + (lane >> 5); float w = W[(size_t)(k0 + kk) * Nsrc + sc] * cs; if (ks) w *= ks[k0 + kk]; scr[kk * 33 + (lane & 31)] = w; }
    LDS_WAIT(); asm volatile("" ::: "memory");
    const int c = lane & 7;
#pragma unroll
    for (int j = 0; j < 4; ++j) { const int n = (lane >> 3) + 8 * j; const LAS float* s = scr + (8 * c) * 33 + n;
        v4u o; o.x = cvtpk(s[0 * 33], s[1 * 33]); o.y = cvtpk(s[2 * 33], s[3 * 33]); o.z = cvtpk(s[4 * 33], s[5 * 33]); o.w = cvtpk(s[6 * 33], s[7 * 33]);
        *(GAS v4u*)(WT + (size_t)(n0 + n) * K + k0 + 8 * c) = o; }
    LDS_WAIT(); asm volatile("" ::: "memory");
}
__device__ __forceinline__ void rope_entry(int e, float* rcos, float* rsin) {
    const int pos = e >> 6, i = e & 63;
    double inv = 1.0, b = 0.8659643233600653;
#pragma unroll
    for (int bit = 0; bit < 6; ++bit) { if ((i >> bit) & 1) inv *= b; b *= b; }
    const double ang = (double)pos * inv;
    const double n = __builtin_rint(ang * 0.6366197723675814);
    double r = __builtin_fma(-n, 1.5707963267948966, ang); r = __builtin_fma(-n, 6.123233995736766e-17, r);
    const double r2 = r * r;
    double s = -1.0 / 1307674368000.0;
    s = s * r2 + 1.0 / 6227020800.0; s = s * r2 - 1.0 / 39916800.0; s = s * r2 + 1.0 / 362880.0; s = s * r2 - 1.0 / 5040.0; s = s * r2 + 1.0 / 120.0; s = s * r2 - 1.0 / 6.0; s = s * r2 * r + r;
    double c = 1.0 / 20922789888000.0;
    c = c * r2 - 1.0 / 87178291200.0; c = c * r2 + 1.0 / 479001600.0; c = c * r2 - 1.0 / 3628800.0; c = c * r2 + 1.0 / 40320.0; c = c * r2 - 1.0 / 720.0; c = c * r2 + 1.0 / 24.0; c = c * r2 - 0.5; c = c * r2 + 1.0;
    const int q = ((int)n) & 3;
    const double cs = (q == 0) ? c : (q == 1) ? -s : (q == 2) ? -c : s;
    const double sn = (q == 0) ? s : (q == 1) ? c : (q == 2) ? -s : -c;
    rcos[e] = (float)cs; rsin[e] = (float)sn;
}
struct P0Args { const float *xp, *xs, *anw, *win, *wout, *mnw, *w1, *w2; bf16 *Win_t, *Wout_t, *W1_t, *W2_t, *Xb; float *rcos, *rsin, *ga, *rstd; };
__device__ __forceinline__ void p0_prologue(Frame& F, const P0Args& a, int parts = 3) {
    LAS float* scr = (LAS float*)(F.lds + RING_OFF + F.wave * 16384);
    const int gw = F.vcu * NWAVES + F.wave, NGW = F.G * NWAVES;
    constexpr int I_IN = (D / 64) * (NWIN / 32), I_O = (D / 64) * (D / 32), I_1 = (D / 64) * (FF / 32), I_2 = (FF / 64) * (D / 32);
    constexpr int NITEMS = I_IN + I_O + I_1 + I_2;
    if (parts & 1) for (int it = gw; it < NITEMS; it += NGW) {
        int r = it;
        if (r < I_IN) { p0_transpose_item<true>(a.win, D, NWIN, NWIN / 32, a.anw, a.Win_t, scr, r, F.lane); continue; } r -= I_IN;
        if (r < I_O) { p0_transpose_item<false>(a.wout, D, D, D / 32, nullptr, a.Wout_t, scr, r, F.lane); continue; } r -= I_O;
        if (r < I_1) { p0_transpose_item<false>(a.w1, D, FF, FF / 32, a.mnw, a.W1_t, scr, r, F.lane); continue; } r -= I_1;
        p0_transpose_item<false>(a.w2, FF, D, D / 32, nullptr, a.W2_t, scr, r, F.lane);
    }
    if (parts & 1) for (int e = (blockIdx.x * NWAVES * 64) + F.tid; e < 16384 * 64; e += F.G * NWAVES * 64) rope_entry(e, a.rcos, a.rsin);
    __syncthreads();
    LAS bf16* wl = (LAS bf16*)(F.lds + RING_OFF);
    for (int e = F.tid; e < 32 * 1024; e += NWAVES * 64) { const int k = e >> 5, c = e & 31; wl[c * 1032 + k] = (bf16)(cvtpk(a.win[(size_t)k * NWIN + 1536 + c] * a.anw[k], 0.f) & 0xffffu); }
    __syncthreads();
    const int r = F.lane & 15, g = F.lane >> 4;
    LAS unsigned char* tl = F.lds + RING_OFF + 66048 + F.wave * 8448;
    if (parts & 2) for (int item = gw; item < M_TOK / 16; item += NGW) {
        const int row0 = item * 16;
        const float* xb0 = (row0 < M_PROMPT ? a.xp + (size_t)row0 * D : a.xs + (size_t)(row0 - M_PROMPT) * D) + 4 * F.lane;
        bf16* xo = a.Xb + (size_t)row0 * D + 4 * F.lane;
        f32x4 acc0 = {0.f, 0.f, 0.f, 0.f}, acc1 = {0.f, 0.f, 0.f, 0.f}; float ss = 0.f;
#pragma unroll 1
        for (int kc = 0; kc < 4; ++kc) {
            f32x4 xv[16];
#pragma unroll
            for (int rr = 0; rr < 16; ++rr) xv[rr] = *(const GAS f32x4*)(xb0 + (size_t)rr * D + 256 * kc);
#pragma unroll
            for (int rr = 0; rr < 16; ++rr) { unsigned long long pk = (unsigned long long)cvtpk(xv[rr][0], xv[rr][1]) | ((unsigned long long)cvtpk(xv[rr][2], xv[rr][3]) << 32);
                *(LAS unsigned long long*)(tl + rr * 528 + F.lane * 8) = pk; *(GAS unsigned long long*)(xo + (size_t)rr * D + 256 * kc) = pk; }
            asm volatile("s_waitcnt lgkmcnt(0)" ::: "memory");
#pragma unroll
            for (int s8 = 0; s8 < 8; ++s8) {
                const bf16x8 af = *(const LAS bf16x8*)(tl + r * 528 + 64 * s8 + 16 * g);
                const int k0 = 256 * kc + 32 * s8 + 8 * g;
                const bf16x8 b0 = *(const LAS bf16x8*)(wl + r * 1032 + k0), b1 = *(const LAS bf16x8*)(wl + (16 + r) * 1032 + k0);
                acc0 = __builtin_amdgcn_mfma_f32_16x16x32_bf16(af, b0, acc0, 0, 0, 0);
                acc1 = __builtin_amdgcn_mfma_f32_16x16x32_bf16(af, b1, acc1, 0, 0, 0);
                const v4u aw = __builtin_bit_cast(v4u, af);
#pragma unroll
                for (int j = 0; j < 4; ++j) { const unsigned u = ((const unsigned*)&aw)[j]; const float lo = __uint_as_float(u << 16), hi = __uint_as_float(u & 0xffff0000u); ss += lo * lo + hi * hi; }
            }
            asm volatile("s_waitcnt lgkmcnt(0)" ::: "memory");
        }
        ss += __shfl_xor(ss, 16); ss += __shfl_xor(ss, 32);
        const float rs = 1.0f / sqrtf(ss * (1.0f / 1024.0f) + EPS);
        if (g == 0) a.rstd[row0 + r] = rs;
#pragma unroll
        for (int q = 0; q < 4; ++q) { const int rr = 4 * g + q; const float rq = __shfl(rs, rr);
            a.ga[(size_t)(row0 + rr) * 32 + r] = acc0[q] * rq; a.ga[(size_t)(row0 + rr) * 32 + 16 + r] = acc1[q] * rq; }
    }
}

__device__ __forceinline__ float log_sigmoid_f(float z) { return fminf(z, 0.f) - log1pf(expf(-fabsf(z))); }
struct MixArgs { bf16* proj; const float* ga; const float *waf, *baf, *wab, *bab; float* of; const float *gnw, *rnw, *rnb; };
constexpr int NTB = 16;
template <int DK, bool GLA, bool BWD>
__device__ __forceinline__ void naive_sweep(Frame& F, const MixArgs& a, int job) {
    const int grp = F.tid >> 7, gt = F.tid & 127;
    int seq, head; if (job < 16) { seq = 32 + (job >> 3); head = job & 7; } else { seq = (job - 16) >> 3; head = (job - 16) & 7; }
    const int L = seq < 32 ? L_PROMPT : L_SAMPLE, row_base = seq < 32 ? seq * L_PROMPT : M_PROMPT + (seq - 32) * L_SAMPLE;
    const int hh = GLA ? head : head - 4;
    const int qcol = GLA ? 1024 + 64 * hh : 2048 + 128 * hh, kcol = GLA ? 1280 + 64 * hh : 2560 + 128 * hh, vcol = 128 * head;
    LAS float* sq = (LAS float*)(F.lds + grp * (3 * NTB * 128 * 4)); LAS float* sk = sq + NTB * DK; LAS float* sa = sk + NTB * DK;
    const float gam = 1.0f - exp2f(-5.0f - (float)hh);
    const float* wal = BWD ? a.wab : a.waf; const float* bal = BWD ? a.bab : a.baf;
    float S[DK];
#pragma unroll
    for (int t = 0; t < DK; ++t) S[t] = 0.f;
    for (int t0 = 0; t0 < L; t0 += NTB) {
        __syncthreads();
        for (int e = gt; e < NTB * DK; e += 128) {
            const int tok = e / DK, t = e % DK, tp = t0 + tok, row = row_base + (BWD ? L - 1 - tp : tp);
            const bf16* pr = a.proj + (size_t)row * NP;
            sq[e] = bf2f(pr[qcol + t]); sk[e] = bf2f(pr[kcol + t]);
            if (GLA) { const float* gar = a.ga + (size_t)row * 32 + (BWD ? 16 : 0); float z = bal[64 * hh + t];
#pragma unroll
                for (int r = 0; r < 16; ++r) z += gar[r] * wal[r * 256 + 64 * hh + t];
                sa[e] = expf(fmaxf(log_sigmoid_f(z) * (1.0f / 16.0f), -1.0f)); }
        }
        __syncthreads();
        for (int tok = 0; tok < NTB; ++tok) {
            const int tp = t0 + tok, row = row_base + (BWD ? L - 1 - tp : tp);
            const float vv = bf2f(a.proj[(size_t)row * NP + vcol + gt]);
            float o = 0.f;
#pragma unroll
            for (int t4 = 0; t4 < DK / 4; ++t4) {
                const f32x4 q = *(const LAS f32x4*)(sq + tok * DK + 4 * t4), k = *(const LAS f32x4*)(sk + tok * DK + 4 * t4);
                f32x4 al = {gam, gam, gam, gam}; if (GLA) al = *(const LAS f32x4*)(sa + tok * DK + 4 * t4);
#pragma unroll
                for (int j = 0; j < 4; ++j) {
                    if (!BWD) { S[4 * t4 + j] = al[j] * S[4 * t4 + j] + k[j] * vv; o += q[j] * S[4 * t4 + j]; }
                    else { S[4 * t4 + j] *= al[j]; o += q[j] * S[4 * t4 + j]; S[4 * t4 + j] += k[j] * vv; }
                }
            }
            float* op = a.of + (size_t)row * D + 128 * head + gt;
            if (!BWD) *op = o; else *op += o;
        }
    }
}
template <bool BWD>
__device__ __forceinline__ void naive_mix_phase(Frame& F, const MixArgs& a) {
    if (blockIdx.x >= 68) return;
    const int job = blockIdx.x * 4 + (F.tid >> 7);
    if ((blockIdx.x & 1) == 0) { if (!MIX_GLA) naive_sweep<64, true, BWD>(F, a, job); } else { if (!MIX_RET) naive_sweep<128, false, BWD>(F, a, job); }
}
__device__ __forceinline__ void naive_combine(Frame& F, const MixArgs& a) {
    const int gw = F.vcu * NWAVES + F.wave, NGW = F.G * NWAVES, c = 2 * F.lane;
    for (int item = gw; item < M_TOK * 8; item += NGW) {
        const int row = item >> 3, head = item & 7;
        if (head < 4 ? MIX_GLA : MIX_RET) continue;
        const float* op = a.of + (size_t)row * D + 128 * head + c;
        float o0 = op[0], o1 = op[1], y0, y1;
        if (head < 4) { const float r = 1.0f / sqrtf(wave_sum(o0 * o0 + o1 * o1) * (1.0f / 128.0f) + EPS); y0 = o0 * r * a.gnw[c]; y1 = o1 * r * a.gnw[c + 1]; }
        else { const float mu = wave_sum(o0 + o1) * (1.0f / 128.0f); o0 -= mu; o1 -= mu; const float r = 1.0f / sqrtf(wave_sum(o0 * o0 + o1 * o1) * (1.0f / 128.0f) + EPS);
            const int cc = 128 * (head - 4) + c; y0 = o0 * r * a.rnw[cc] + a.rnb[cc]; y1 = o1 * r * a.rnw[cc + 1] + a.rnb[cc + 1]; }
        bf16* pr = a.proj + (size_t)row * NP;
        const int gcol = (head < 4 ? 1536 + 128 * head : 3072 + 128 * (head - 4)) + c;
        const unsigned gw2 = *(const unsigned*)(pr + gcol);
        const float g0 = __uint_as_float(gw2 << 16), g1 = __uint_as_float(gw2 & 0xffff0000u);
        y0 *= g0 / (1.0f + expf(-g0)); y1 *= g1 / (1.0f + expf(-g1));
        *(unsigned*)(pr + 128 * head + c) = cvtpk(y0, y1);
    }
}
__device__ __forceinline__ void final_norm(Frame& F, float* out, const bf16* x2b, const float* sq, const float* w) {
    const int gw = F.vcu * NWAVES + F.wave, NGW = F.G * NWAVES;
    for (int row = gw; row < M_TOK; row += NGW) {
        const f32x4* s4 = (const f32x4*)(sq + (size_t)row * 16);
        const f32x4 t = (s4[0] + s4[1]) + (s4[2] + s4[3]);
        const float r = 1.0f / sqrtf(((t[0] + t[1]) + (t[2] + t[3])) * (1.0f / 1024.0f) + EPS);
        const GAS v4u* xi = (const GAS v4u*)(x2b + (size_t)row * D) + F.lane;
        GAS f32x4* o = (GAS f32x4*)(out + (size_t)row * D) + 2 * F.lane; const f32x4* w4 = (const f32x4*)w + 2 * F.lane;
#pragma unroll
        for (int j = 0; j < 2; ++j) { const v4u xw = xi[64 * j];
            const f32x4 x0 = {__uint_as_float(xw.x << 16), __uint_as_float(xw.x & 0xffff0000u), __uint_as_float(xw.y << 16), __uint_as_float(xw.y & 0xffff0000u)};
            const f32x4 x1 = {__uint_as_float(xw.z << 16), __uint_as_float(xw.z & 0xffff0000u), __uint_as_float(xw.w << 16), __uint_as_float(xw.w & 0xffff0000u)};
            o[128 * j] = x0 * r * w4[128 * j]; o[128 * j + 1] = x1 * r * w4[128 * j + 1]; }
    }
}

typedef __bf16 bf16v2 __attribute__((ext_vector_type(2)));
typedef unsigned u32x2 __attribute__((ext_vector_type(2)));
__device__ __forceinline__ unsigned cvtpk_c(float lo, float hi) { bf16v2 v = {(__bf16)lo, (__bf16)hi}; return __builtin_bit_cast(unsigned, v); }
__device__ __forceinline__ float bflo(unsigned w) { return __uint_as_float(w << 16); }
__device__ __forceinline__ float bfhi(unsigned w) { return __uint_as_float(w & 0xffff0000u); }
__device__ __forceinline__ int opaque_i(int x) { asm volatile("" : "+v"(x)); return x; }
typedef short s16x4 __attribute__((ext_vector_type(4)));
#define TRRD(ptr) __builtin_amdgcn_ds_read_tr16_b64_v4i16((LAS s16x4*)(ptr))
constexpr size_t ST_SC_BYTES = 393216;
__device__ __forceinline__ size_t state_off(int sc, bool gla, int hh, int dir) { return (size_t)sc * ST_SC_BYTES + (gla ? (size_t)(hh * 2 + dir) * 16384 : (size_t)131072 + (size_t)(hh * 2 + dir) * 32768); }
struct CMixArgs { bf16* proj; const float* ga; const float *waf, *baf, *wab, *bab; unsigned char* st; float* dec; const float *gnw, *rnw, *rnb; bf16* mo; int mop; unsigned char* sto; unsigned char* ofs; float* bb0; float* bb1; };
constexpr int OB_PITCH = 132;

template <bool GLA> struct RawSet;
template <> struct RawSet<true> { v4u q, k, v0, v1; f32x4 b0, b1, l0, l1; };
template <> struct RawSet<false> { v4u q0, q1, k0, k1, v0, v1; };

template <bool GLA, bool WITH_O>
__device__ __forceinline__ void raw_load(RawSet<GLA>& R, const CMixArgs& a, int p, int s, int w, int lane0) {
    const int lane = opaque_i(lane0), sc = p >> 2, hh = p & 3, dir = s >> 2, c = dir ? 7 - s : s;
    const size_t row = (size_t)(sc * 256 + 64 * c + 8 * w + (lane >> 3)); const int pc = lane & 7;
    if constexpr (GLA) {
        if (WITH_O) R.q = *(const GAS v4u*)(a.proj + pg8::PL_GQ + (hh * pg8::MTOK + row) * 64 + 8 * pc);
        R.k = *(const GAS v4u*)(a.proj + pg8::PL_GK + (hh * pg8::MTOK + row) * 64 + 8 * pc);
        const bf16* pv = a.proj + pg8::PL_GV + (hh * pg8::MTOK + row) * 128 + 8 * pc;
        R.v0 = *(const GAS v4u*)pv; R.v1 = *(const GAS v4u*)(pv + 64);
        const float* bp = (dir ? a.bb1 : a.bb0) + ((size_t)(p * 4 + c) * 64) * 64 + 8 * pc;
        const int ti = 8 * w + (lane >> 3);
        R.b0 = *(const GAS f32x4*)(bp + ti * 64); R.b1 = *(const GAS f32x4*)(bp + ti * 64 + 4);
        R.l0 = *(const GAS f32x4*)(bp + (dir ? 0 : 63) * 64); R.l1 = *(const GAS f32x4*)(bp + (dir ? 0 : 63) * 64 + 4);
    } else {
        if (WITH_O) { const bf16* pq = a.proj + pg8::PL_RQ + (hh * pg8::MTOK + row) * 128 + 8 * pc; R.q0 = *(const GAS v4u*)pq; R.q1 = *(const GAS v4u*)(pq + 64); }
        const bf16* pk = a.proj + pg8::PL_RK + (hh * pg8::MTOK + row) * 128 + 8 * pc; R.k0 = *(const GAS v4u*)pk; R.k1 = *(const GAS v4u*)(pk + 64);
        const bf16* pv = a.proj + pg8::PL_RV + (hh * pg8::MTOK + row) * 128 + 8 * pc; R.v0 = *(const GAS v4u*)pv; R.v1 = *(const GAS v4u*)(pv + 64);
    }
}

template <int DK, bool GLA, bool WITH_O> struct MixLds {
    static constexpr int NT = DK / 16, NS = DK / 32;
    static constexpr int RQ = DK * 2 + 16, RP = 144, RV = 272;
    static constexpr int O_QD = 0, O_KI = 64 * RQ, O_KE = 2 * 64 * RQ, O_PB = 3 * 64 * RQ, O_VB = O_PB + 64 * RP, O_DC = O_VB + 64 * RV, O_WAL = O_DC + DK * 4,
                         O_OB = O_WAL, O_END = O_OB + 64 * OB_PITCH * 4;
    static_assert(O_END <= 146432, "mixer LDS map");
};

template <int DK, bool GLA, bool WITH_O>
__device__ __forceinline__ void mix_step(Frame& F, const CMixArgs& a, int p, int s, int pnext, RawSet<GLA>& R, f32x4 (&S)[DK / 16], float (&dsum)[8], u32x2 (&ofp)[4][4]) {
    typedef MixLds<DK, GLA, WITH_O> ML;
    constexpr int NT = ML::NT, NS = ML::NS, RQ = ML::RQ, RP = ML::RP, RV = ML::RV;
    LAS unsigned char* L = F.lds;
    const int lane0 = F.lane, w = F.wave;
    const int sc = p >> 2, hh = p & 3, dir = s >> 2, c = dir ? 7 - s : s, row0 = sc * 256, head = GLA ? hh : 4 + hh, vcol = 128 * head;
    __syncthreads();
    {
        const int lane = opaque_i(lane0), i = 8 * w + (lane >> 3), pc = lane & 7;
        *(LAS v4u*)(L + ML::O_VB + i * RV + 16 * pc) = R.v0; *(LAS v4u*)(L + ML::O_VB + i * RV + 128 + 16 * pc) = R.v1;
        if constexpr (GLA) {
            const int tk = lane >> 3;
            float q8[8], k8[8], e8[8];
#pragma unroll
            for (int e = 0; e < 8; ++e) { const float b = e < 4 ? R.b0[e & 3] : R.b1[e & 3], bl_ = e < 4 ? R.l0[e & 3] : R.l1[e & 3];
                const unsigned wq = WITH_O ? ((const unsigned*)&R.q)[e >> 1] : 0u, wk = ((const unsigned*)&R.k)[e >> 1];
                const float qv = (e & 1) ? bfhi(wq) : bflo(wq), kv = (e & 1) ? bfhi(wk) : bflo(wk);
                q8[e] = qv * __expf(b); k8[e] = kv * __expf(-b); e8[e] = kv * __expf(bl_ - b);
                if (!WITH_O) dsum[e] += bl_;
                if (w == 0 && tk == 0) ((LAS float*)(L + ML::O_DC))[8 * pc + e] = __expf(bl_); }
            v4u oq, ok, oe;
            oq.x = cvtpk_c(q8[0], q8[1]); oq.y = cvtpk_c(q8[2], q8[3]); oq.z = cvtpk_c(q8[4], q8[5]); oq.w = cvtpk_c(q8[6], q8[7]);
            ok.x = cvtpk_c(k8[0], k8[1]); ok.y = cvtpk_c(k8[2], k8[3]); ok.z = cvtpk_c(k8[4], k8[5]); ok.w = cvtpk_c(k8[6], k8[7]);
            oe.x = cvtpk_c(e8[0], e8[1]); oe.y = cvtpk_c(e8[2], e8[3]); oe.z = cvtpk_c(e8[4], e8[5]); oe.w = cvtpk_c(e8[6], e8[7]);
            if (WITH_O) { *(LAS v4u*)(L + ML::O_QD + i * RQ + 16 * pc) = oq; *(LAS v4u*)(L + ML::O_KI + i * RQ + 16 * pc) = ok; }
            *(LAS v4u*)(L + ML::O_KE + i * RQ + 16 * pc) = oe;
        } else {
            const float l2g = hh == 0 ? -0.045803689613124f : hh == 1 ? -0.022720076500083f : hh == 2 ? -0.011315313227834f : -0.005646563141142f;
            const float nq = dir ? (float)(64 - i) : (float)(i + 1), ne = dir ? (float)i : (float)(63 - i);
            const float eb = exp2f(l2g * nq), ei = exp2f(-l2g * nq), ee = exp2f(l2g * ne);
#pragma unroll
            for (int x = 0; x < 2; ++x) { v4u oq, ok, oe; const v4u rq = x ? R.q1 : R.q0, rk = x ? R.k1 : R.k0;
#pragma unroll
                for (int j = 0; j < 4; ++j) { const unsigned wq = WITH_O ? ((const unsigned*)&rq)[j] : 0u, wk = ((const unsigned*)&rk)[j];
                    ((unsigned*)&oq)[j] = cvtpk_c(bflo(wq) * eb, bfhi(wq) * eb); ((unsigned*)&ok)[j] = cvtpk_c(bflo(wk) * ei, bfhi(wk) * ei); ((unsigned*)&oe)[j] = cvtpk_c(bflo(wk) * ee, bfhi(wk) * ee); }
                if (WITH_O) { *(LAS v4u*)(L + ML::O_QD + i * RQ + 128 * x + 16 * pc) = oq; *(LAS v4u*)(L + ML::O_KI + i * RQ + 128 * x + 16 * pc) = ok; }
                *(LAS v4u*)(L + ML::O_KE + i * RQ + 128 * x + 16 * pc) = oe; }
            if (w == 0 && lane < 32) *(LAS f32x4*)(L + ML::O_DC + lane * 16) = (f32x4){exp2f(l2g * 64.0f), exp2f(l2g * 64.0f), exp2f(l2g * 64.0f), exp2f(l2g * 64.0f)};
        }
    }
    v4u gt0, gt1; f32x4 nw[4], nb[4];
    if (WITH_O) { const int lane = opaque_i(lane0);
        const bf16* gp = a.proj + (GLA ? pg8::PL_GG : pg8::PL_RG) + (dir ? (hh * pg8::MTOK + (size_t)(row0 + 64 * c + 8 * w + (lane >> 3))) * 128 + 16 * (lane & 7) : (size_t)0);
        gt0 = *(const GAS v4u*)gp; gt1 = *(const GAS v4u*)(gp + 8);
        const float* wp = GLA ? a.gnw + 16 * (lane & 7) : a.rnw + 128 * hh + 16 * (lane & 7);
#pragma unroll
        for (int k = 0; k < 4; ++k) { nw[k] = *(const GAS f32x4*)(wp + 4 * k); if (!GLA) nb[k] = *(const GAS f32x4*)(a.rnb + 128 * hh + 16 * (lane & 7) + 4 * k); } }
    raw_load<GLA, WITH_O>(R, a, s < 6 ? p : (pnext < 1536 ? pnext : p), s < 6 ? s + 2 : s - 6, w, lane0);
    __syncthreads();
    if (WITH_O) {
        const int lane = opaque_i(lane0), g = lane >> 4, lr = lane & 15;
        const int mi = w >> 1;
        bf16x8 kf[2][NS], qf2[NS];
#pragma unroll
        for (int s2 = 0; s2 < NS; ++s2) { qf2[s2] = *(const LAS bf16x8*)(L + ML::O_QD + (16 * mi + lr) * RQ + 64 * s2 + 16 * g);
#pragma unroll
            for (int jj = 0; jj < 2; ++jj) kf[jj][s2] = *(const LAS bf16x8*)(L + ML::O_KI + (16 * (2 * (w & 1) + jj) + lr) * RQ + 64 * s2 + 16 * g); }
        __builtin_amdgcn_sched_barrier(0);
#pragma unroll
        for (int jj = 0; jj < 2; ++jj) { const int nj = 2 * (w & 1) + jj;
            f32x4 acc = {0.f, 0.f, 0.f, 0.f};
#pragma unroll
            for (int s2 = 0; s2 < NS; ++s2) acc = __builtin_amdgcn_mfma_f32_16x16x32_bf16(kf[jj][s2], qf2[s2], acc, 0, 0, 0);
            const int ii = 16 * mi + lr;
#pragma unroll
            for (int r = 0; r < 4; ++r) { const int j = 16 * nj + 4 * g + r; const bool keep = dir ? (j > ii) : (j <= ii); acc[r] = keep ? acc[r] : 0.f; }
            u32x2 pk; pk.x = cvtpk_c(acc[0], acc[1]); pk.y = cvtpk_c(acc[2], acc[3]);
            *(LAS u32x2*)(L + ML::O_PB + ii * RP + 32 * nj + 8 * g) = pk; }
        __syncthreads();
    }
    f32x4 o[4];
    {
        const int lane = opaque_i(lane0), g = lane >> 4, lr = lane & 15, q4 = lr >> 2, p4 = lr & 3;
        const LAS unsigned char* vb = L + ML::O_VB + (8 * g + q4) * RV + 32 * w + 8 * p4;
        const bf16x8 vf0 = __builtin_shufflevector(TRRD(vb), TRRD(vb + 4 * RV), 0, 1, 2, 3, 4, 5, 6, 7), vf1 = __builtin_shufflevector(TRRD(vb + 32 * RV), TRRD(vb + 36 * RV), 0, 1, 2, 3, 4, 5, 6, 7);
        if (WITH_O) {
            { bf16x8 pf[4][2];
#pragma unroll
              for (int m = 0; m < 4; ++m) { pf[m][0] = *(const LAS bf16x8*)(L + ML::O_PB + (16 * m + lr) * RP + 16 * g); pf[m][1] = *(const LAS bf16x8*)(L + ML::O_PB + (16 * m + lr) * RP + 64 + 16 * g); }
              __builtin_amdgcn_sched_barrier(0);
#pragma unroll
              for (int m = 0; m < 4; ++m) { o[m] = __builtin_amdgcn_mfma_f32_16x16x32_bf16(pf[m][0], vf0, (f32x4){0.f, 0.f, 0.f, 0.f}, 0, 0, 0); o[m] = __builtin_amdgcn_mfma_f32_16x16x32_bf16(pf[m][1], vf1, o[m], 0, 0, 0); }
              __builtin_amdgcn_sched_barrier(0); }
#pragma unroll
            for (int sh = 0; sh < NS / 2; ++sh) {
                u32x2 ql[2][4][2];
#pragma unroll
                for (int x = 0; x < 2; ++x)
#pragma unroll
                    for (int m = 0; m < 4; ++m) { ql[x][m][0] = *(const LAS u32x2*)(L + ML::O_QD + (16 * m + lr) * RQ + 64 * (2 * sh + x) + 8 * g); ql[x][m][1] = *(const LAS u32x2*)(L + ML::O_QD + (16 * m + lr) * RQ + 64 * (2 * sh + x) + 32 + 8 * g); }
                __builtin_amdgcn_sched_barrier(0);
#pragma unroll
                for (int x = 0; x < 2; ++x) { const int s2 = 2 * sh + x;
                    const bf16x8 sf = __builtin_bit_cast(bf16x8, (v4u){cvtpk_c(S[2 * s2][0], S[2 * s2][1]), cvtpk_c(S[2 * s2][2], S[2 * s2][3]), cvtpk_c(S[2 * s2 + 1][0], S[2 * s2 + 1][1]), cvtpk_c(S[2 * s2 + 1][2], S[2 * s2 + 1][3])});
#pragma unroll
                    for (int m = 0; m < 4; ++m) o[m] = __builtin_amdgcn_mfma_f32_16x16x32_bf16(__builtin_bit_cast(bf16x8, (v4u){ql[x][m][0].x, ql[x][m][0].y, ql[x][m][1].x, ql[x][m][1].y}), sf, o[m], 0, 0, 0); }
                __builtin_amdgcn_sched_barrier(0);
            }
        }
#pragma unroll
        for (int th = 0; th < NT / 4; ++th) {
            f32x4 d4[4]; bf16x8 kf0[4], kf1[4];
#pragma unroll
            for (int x = 0; x < 4; ++x) { const int tt = 4 * th + x;
                d4[x] = *(const LAS f32x4*)(L + ML::O_DC + (16 * tt + 4 * g) * 4);
                const LAS unsigned char* kb = L + ML::O_KE + (8 * g + q4) * RQ + 32 * tt + 8 * p4;
                kf0[x] = __builtin_shufflevector(TRRD(kb), TRRD(kb + 4 * RQ), 0, 1, 2, 3, 4, 5, 6, 7); kf1[x] = __builtin_shufflevector(TRRD(kb + 32 * RQ), TRRD(kb + 36 * RQ), 0, 1, 2, 3, 4, 5, 6, 7); }
            __builtin_amdgcn_sched_barrier(0);
#pragma unroll
            for (int x = 0; x < 4; ++x) { const int tt = 4 * th + x;
                S[tt] = S[tt] * d4[x];
                S[tt] = __builtin_amdgcn_mfma_f32_16x16x32_bf16(kf0[x], vf0, S[tt], 0, 0, 0);
                S[tt] = __builtin_amdgcn_mfma_f32_16x16x32_bf16(kf1[x], vf1, S[tt], 0, 0, 0); }
            __builtin_amdgcn_sched_barrier(0);
        }
    }
    if (WITH_O) {
        const int lane = opaque_i(lane0), g = lane >> 4, lr = lane & 15;
        if (dir == 0) {
#pragma unroll
            for (int cc = 0; cc < 4; ++cc) if (cc == c) {
#pragma unroll
                for (int m = 0; m < 4; ++m) { ofp[cc][m].x = cvtpk_c(o[m][0], o[m][1]); ofp[cc][m].y = cvtpk_c(o[m][2], o[m][3]); } }
        } else {
            u32x2 ofr[4];
#pragma unroll
            for (int cc = 0; cc < 4; ++cc) if (cc == c) {
#pragma unroll
                for (int m = 0; m < 4; ++m) ofr[m] = ofp[cc][m]; }
            LAS float* ob = (LAS float*)(L + ML::O_OB);
#pragma unroll
            for (int m = 0; m < 4; ++m) { const f32x4 t = {o[m][0] + bflo(ofr[m].x), o[m][1] + bfhi(ofr[m].x), o[m][2] + bflo(ofr[m].y), o[m][3] + bfhi(ofr[m].y)};
#pragma unroll
                for (int r = 0; r < 4; ++r) ob[(16 * m + 4 * g + r) * OB_PITCH + 16 * w + lr] = t[r]; }
            __syncthreads();
            const int row = 8 * w + (lane >> 3), pc = lane & 7;
            f32x4 x[4];
#pragma unroll
            for (int k = 0; k < 4; ++k) x[k] = *(const LAS f32x4*)(ob + row * OB_PITCH + 16 * pc + 4 * k);
            float rs;
            if (GLA) { float ss = 0.f;
#pragma unroll
                for (int k = 0; k < 4; ++k) ss += (x[k][0] * x[k][0] + x[k][1] * x[k][1]) + (x[k][2] * x[k][2] + x[k][3] * x[k][3]);
                ss += __shfl_xor(ss, 1); ss += __shfl_xor(ss, 2); ss += __shfl_xor(ss, 4);
                rs = __builtin_amdgcn_rsqf(ss * (1.0f / 128.0f) + EPS); }
            else { float sm = 0.f;
#pragma unroll
                for (int k = 0; k < 4; ++k) sm += (x[k][0] + x[k][1]) + (x[k][2] + x[k][3]);
                sm += __shfl_xor(sm, 1); sm += __shfl_xor(sm, 2); sm += __shfl_xor(sm, 4);
                const float mu = sm * (1.0f / 128.0f); float ss = 0.f;
#pragma unroll
                for (int k = 0; k < 4; ++k) { x[k] = x[k] - mu; ss += (x[k][0] * x[k][0] + x[k][1] * x[k][1]) + (x[k][2] * x[k][2] + x[k][3] * x[k][3]); }
                ss += __shfl_xor(ss, 1); ss += __shfl_xor(ss, 2); ss += __shfl_xor(ss, 4);
                rs = __builtin_amdgcn_rsqf(ss * (1.0f / 128.0f) + EPS); }
            unsigned ow[8];
#pragma unroll
            for (int k = 0; k < 4; ++k) { f32x4 y = x[k] * rs * nw[k];
                if (!GLA) y = y + nb[k];
                const unsigned ga_ = k < 2 ? ((const unsigned*)&gt0)[2 * k] : ((const unsigned*)&gt1)[2 * k - 4], gb_ = k < 2 ? ((const unsigned*)&gt0)[2 * k + 1] : ((const unsigned*)&gt1)[2 * k - 3];
                const float g0 = bflo(ga_), g1 = bfhi(ga_), g2 = bflo(gb_), g3 = bfhi(gb_);
                y[0] *= g0 * __builtin_amdgcn_rcpf(1.0f + __expf(-g0)); y[1] *= g1 * __builtin_amdgcn_rcpf(1.0f + __expf(-g1));
                y[2] *= g2 * __builtin_amdgcn_rcpf(1.0f + __expf(-g2)); y[3] *= g3 * __builtin_amdgcn_rcpf(1.0f + __expf(-g3));
                ow[2 * k] = cvtpk_c(y[0], y[1]); ow[2 * k + 1] = cvtpk_c(y[2], y[3]); }
            bf16* op = a.mo + (size_t)(row0 + 64 * c + row) * a.mop + vcol + 16 * pc;
            *(GAS v4u*)op = (v4u){ow[0], ow[1], ow[2], ow[3]}; *(GAS v4u*)(op + 8) = (v4u){ow[4], ow[5], ow[6], ow[7]};
        }
    }
}


__device__ __forceinline__ void gla_b_stage(Frame& F, const CMixArgs& a, int p) {
    const int sc = p >> 2, hh = p & 3, w = F.wave;
    LAS float* gl = (LAS float*)F.lds;
    __syncthreads();
    { const int tid = opaque_i(F.tid);
#pragma unroll
      for (int x = 0; x < 4; ++x) *(LAS f32x4*)(gl + 4 * (tid + 512 * x)) = *(const GAS f32x4*)(a.ga + (size_t)sc * 256 * 32 + 4 * (tid + 512 * x)); }
    __syncthreads();
    const int t = opaque_i(F.lane), dir = w >> 2, c = w & 3;
    const float* wa = (dir ? a.wab : a.waf) + 64 * hh + t;
    float wv[16];
#pragma unroll
    for (int r = 0; r < 16; ++r) wv[r] = wa[r * 256];
    const float bias = (dir ? a.bab : a.baf)[64 * hh + t];
    float* bp = (dir ? a.bb1 : a.bb0) + ((size_t)(p * 4 + c) * 64) * 64 + t;
    float acc = 0.f;
#pragma unroll 1
    for (int k4 = 0; k4 < 64; k4 += 4) {
        f32x4 gv[4][4];
#pragma unroll
        for (int j = 0; j < 4; ++j) { const int i = dir ? 63 - (k4 + j) : k4 + j; const LAS float* gr = gl + (64 * c + i) * 32 + 16 * dir;
#pragma unroll
            for (int x = 0; x < 4; ++x) gv[j][x] = *(const LAS f32x4*)(gr + 4 * x); }
        __builtin_amdgcn_sched_barrier(0);
#pragma unroll
        for (int j = 0; j < 4; ++j) { const int i = dir ? 63 - (k4 + j) : k4 + j;
            float z = bias;
#pragma unroll
            for (int r = 0; r < 16; ++r) z += gv[j][r >> 2][r & 3] * wv[r];
            const float ls = fminf(z, 0.f) - __logf(1.0f + __expf(-fabsf(z)));
            acc += fmaxf(ls * (1.0f / 16.0f), -1.0f);
            bp[i * 64] = acc; }
    }
}

template <int DK, bool GLA, bool WITH_O>
__device__ __forceinline__ void mix_units(Frame& F, const CMixArgs& a) {
    typedef MixLds<DK, GLA, WITH_O> ML;
    constexpr int NT = DK / 16;
    const int w = F.wave, lane0 = F.lane;
    int p = (int)blockIdx.x;
    if (p >= 1536) return;
    if (GLA && !WITH_O) {
#pragma unroll 1
        for (int pp = p; pp < 1536; pp += F.G) gla_b_stage(F, a, pp);
        asm volatile("s_waitcnt vmcnt(0)" ::: "memory"); __syncthreads(); }
    RawSet<GLA> RA, RB;
    raw_load<GLA, WITH_O>(RA, a, p, 0, w, lane0); raw_load<GLA, WITH_O>(RB, a, p, 1, w, lane0);
    f32x4 S[NT]; float dsum[8]; u32x2 ofp[4][4];
#pragma unroll 1
    for (; p < 1536; p += F.G) {
        const int sc = p >> 2, hh = p & 3, pnext = p + F.G;
#pragma unroll 1
        for (int dir = 0; dir < 2; ++dir) {
            const int lane = opaque_i(lane0);
            unsigned char* sp = a.st + state_off(sc, GLA, hh, dir) + (size_t)(unsigned)(w * NT * 512 + lane * 8);
            if (WITH_O) {
#pragma unroll
                for (int tt = 0; tt < NT; ++tt) { const u32x2 pk = *(const GAS u32x2*)(sp + tt * 512); S[tt] = (f32x4){bflo(pk.x), bfhi(pk.x), bflo(pk.y), bfhi(pk.y)}; } }
            else {
#pragma unroll
                for (int tt = 0; tt < NT; ++tt) S[tt] = (f32x4){0.f, 0.f, 0.f, 0.f};
#pragma unroll
                for (int e = 0; e < 8; ++e) dsum[e] = 0.f; }
#pragma unroll 1
            for (int h2 = 0; h2 < 2; ++h2) {
                mix_step<DK, GLA, WITH_O>(F, a, p, 4 * dir + 2 * h2, pnext, RA, S, dsum, ofp);
                mix_step<DK, GLA, WITH_O>(F, a, p, 4 * dir + 2 * h2 + 1, pnext, RB, S, dsum, ofp);
            }
            if (!WITH_O) {
#pragma unroll
                for (int tt = 0; tt < NT; ++tt) { u32x2 pk; pk.x = cvtpk_c(S[tt][0], S[tt][1]); pk.y = cvtpk_c(S[tt][2], S[tt][3]); *(GAS u32x2*)(sp + tt * 512) = pk; }
                if (GLA && w == 0 && lane < 8) { float* dp = a.dec + (size_t)((sc * 4 + hh) * 2 + dir) * 64 + 8 * lane;
#pragma unroll
                    for (int e = 0; e < 8; ++e) dp[e] = __expf(dsum[e]); }
            }
        }
    }
}
constexpr int RD_SLOT = 32768;
__device__ __forceinline__ void ret_dma_block(Frame& F, const CMixArgs& a, int p, int kb, int slot) {
    const int lane = opaque_i(F.lane), w = F.wave, sc = p >> 2, hh = p & 3;
#pragma unroll
    for (int x = 0; x < 2; ++x) {
        const int r = 4 * (2 * w + x) + (lane >> 4), cp = lane & 15;
        const size_t row = (size_t)(sc * 256 + 64 * kb + r);
        const bf16* gk = a.proj + pg8::PL_RK + (hh * pg8::MTOK + row) * 128 + 8 * (cp ^ (r & 15));
        const bf16* gv = a.proj + pg8::PL_RV + (hh * pg8::MTOK + row) * 128 + 8 * (cp ^ (2 * (r & 7)));
        __builtin_amdgcn_global_load_lds((const unsigned*)gk, (LAS unsigned*)(F.lds + slot * RD_SLOT + (2 * w + x) * 1024), 16, 0, 0);
        __builtin_amdgcn_global_load_lds((const unsigned*)gv, (LAS unsigned*)(F.lds + slot * RD_SLOT + 16384 + (2 * w + x) * 1024), 16, 0, 0);
    }
}
__device__ __forceinline__ void tr_read16(const unsigned (&ad)[8], u32x2 (&r)[16]) {
    asm volatile("ds_read_b64_tr_b16 %0, %16\n\tds_read_b64_tr_b16 %1, %16 offset:4096\n\tds_read_b64_tr_b16 %2, %17\n\tds_read_b64_tr_b16 %3, %17 offset:4096\n\t"
                 "ds_read_b64_tr_b16 %4, %18\n\tds_read_b64_tr_b16 %5, %18 offset:4096\n\tds_read_b64_tr_b16 %6, %19\n\tds_read_b64_tr_b16 %7, %19 offset:4096\n\t"
                 "ds_read_b64_tr_b16 %8, %20\n\tds_read_b64_tr_b16 %9, %20 offset:4096\n\tds_read_b64_tr_b16 %10, %21\n\tds_read_b64_tr_b16 %11, %21 offset:4096\n\t"
                 "ds_read_b64_tr_b16 %12, %22\n\tds_read_b64_tr_b16 %13, %22 offset:4096\n\tds_read_b64_tr_b16 %14, %23\n\tds_read_b64_tr_b16 %15, %23 offset:4096\n\t"
                 "s_waitcnt lgkmcnt(0)"
                 : "=&v"(r[0]), "=&v"(r[1]), "=&v"(r[2]), "=&v"(r[3]), "=&v"(r[4]), "=&v"(r[5]), "=&v"(r[6]), "=&v"(r[7]),
                   "=&v"(r[8]), "=&v"(r[9]), "=&v"(r[10]), "=&v"(r[11]), "=&v"(r[12]), "=&v"(r[13]), "=&v"(r[14]), "=&v"(r[15])
                 : "v"(ad[0]), "v"(ad[1]), "v"(ad[2]), "v"(ad[3]), "v"(ad[4]), "v"(ad[5]), "v"(ad[6]), "v"(ad[7]) : "memory");
}
__device__ __forceinline__ void ret_block(Frame& F, const CMixArgs& a, int p, int kb, int slot, int pnext, const bf16x8 (&Qf)[2][4], f32x4 (&O)[8][2]) {
    LAS unsigned char* L = F.lds;
    const int w = F.wave, hh = p & 3;
    const float l2g = hh == 0 ? -0.045803689613124f : hh == 1 ? -0.022720076500083f : hh == 2 ? -0.011315313227834f : -0.005646563141142f;
    asm volatile("s_waitcnt vmcnt(4)" ::: "memory");
    __builtin_amdgcn_s_barrier();
    asm volatile("" ::: "memory");
    { const int kn = kb + 2, pn2 = kn < 4 ? p : (pnext < 1536 ? pnext : p); ret_dma_block(F, a, pn2, kn & 3, slot == 0 ? 2 : slot - 1); }
    LAS unsigned char* KB = L + slot * RD_SLOT; LAS unsigned char* VB = KB + 16384;
    const int lane = opaque_i(F.lane), g = lane >> 4, lr = lane & 15, q4 = lr >> 2, p4 = lr & 3;
    const int xk16 = (lr ^ (g >> 1)) << 4, xv16 = ((p4 >> 1) ^ (2 * ((4 * g + q4) & 7))) << 4;
#pragma unroll
    for (int sp = 0; sp < 2; ++sp) {
        f32x4 st[2][2];
#pragma unroll
        for (int h = 0; h < 2; ++h)
#pragma unroll
            for (int it = 0; it < 2; ++it) st[h][it] = (f32x4){0.f, 0.f, 0.f, 0.f};
        { bf16x8 kf[2][4];
#pragma unroll
          for (int s = 0; s < 4; ++s)
#pragma unroll
              for (int h = 0; h < 2; ++h) {
                  const LAS unsigned char* kp = KB + (32 * sp + 16 * h + lr) * 256 + 8 * (g & 1);
                  const u32x2 lo = *(const LAS u32x2*)(kp + ((64 * s) ^ xk16)), hi = *(const LAS u32x2*)(kp + ((64 * s + 32) ^ xk16));
                  kf[h][s] = __builtin_bit_cast(bf16x8, (v4u){lo.x, lo.y, hi.x, hi.y}); }
          __builtin_amdgcn_sched_barrier(0);
#pragma unroll
          for (int s = 0; s < 4; ++s)
#pragma unroll
              for (int h = 0; h < 2; ++h)
#pragma unroll
                  for (int it = 0; it < 2; ++it) st[h][it] = __builtin_amdgcn_mfma_f32_16x16x32_bf16(kf[h][s], Qf[it][s], st[h][it], 0, 0, 0);
          __builtin_amdgcn_sched_barrier(0); }
        bf16x8 pf[2];
#pragma unroll
        for (int it = 0; it < 2; ++it) {
            const int i = 32 * w + 16 * it + lr;
            unsigned pw[4];
#pragma unroll
            for (int h = 0; h < 2; ++h) { float e[4];
#pragma unroll
                for (int r = 0; r < 4; ++r) { const int j = 64 * kb + 32 * sp + 16 * h + 4 * g + r; const int d = i - j; e[r] = st[h][it][r] * __builtin_amdgcn_exp2f(l2g * (float)(d < 0 ? -d : d)); }
                pw[2 * h] = cvtpk_c(e[0], e[1]); pw[2 * h + 1] = cvtpk_c(e[2], e[3]); }
            pf[it] = __builtin_bit_cast(bf16x8, (v4u){pw[0], pw[1], pw[2], pw[3]});
        }
        { unsigned ad[8]; u32x2 vr[16];
          const unsigned vb0 = (unsigned)(size_t)(VB + (32 * sp + 4 * g + q4) * 256 + 8 * (p4 & 1));
#pragma unroll
          for (int dt = 0; dt < 8; ++dt) ad[dt] = vb0 + ((32 * dt) ^ xv16);
          tr_read16(ad, vr);
          __builtin_amdgcn_sched_barrier(0);
#pragma unroll
          for (int dt = 0; dt < 8; ++dt) { const bf16x8 vf = __builtin_bit_cast(bf16x8, (v4u){vr[2 * dt].x, vr[2 * dt].y, vr[2 * dt + 1].x, vr[2 * dt + 1].y});
#pragma unroll
              for (int it = 0; it < 2; ++it) O[dt][it] = __builtin_amdgcn_mfma_f32_16x16x32_bf16(vf, pf[it], O[dt][it], 0, 0, 0); }
          __builtin_amdgcn_sched_barrier(0); }
    }
}
__device__ __forceinline__ void ret_q_load(bf16x8 (&Qf)[2][4], const CMixArgs& a, int p, int w, int lane0) {
    const int lane = opaque_i(lane0), g = lane >> 4, lr = lane & 15, sc = p >> 2, hh = p & 3;
#pragma unroll
    for (int it = 0; it < 2; ++it) { const bf16* qp = a.proj + pg8::PL_RQ + (hh * pg8::MTOK + (size_t)(sc * 256 + 32 * w + 16 * it + lr)) * 128 + 4 * g;
#pragma unroll
        for (int s = 0; s < 4; ++s) { const u32x2 lo = *(const GAS u32x2*)(qp + 32 * s), hi = *(const GAS u32x2*)(qp + 32 * s + 16); Qf[it][s] = __builtin_bit_cast(bf16x8, (v4u){lo.x, lo.y, hi.x, hi.y}); } }
}
__device__ __forceinline__ void ret_units_direct(Frame& F, const CMixArgs& a) {
    const int w = F.wave;
    int p = (int)blockIdx.x;
    if (p >= 1536) return;
    bf16x8 Qf[2][4];
    asm volatile("s_waitcnt vmcnt(0)" ::: "memory"); __syncthreads();
    ret_dma_block(F, a, p, 0, 0); ret_dma_block(F, a, p, 1, 1);
    int slot = 0;
    ret_q_load(Qf, a, p, w, F.lane);
#pragma unroll 1
    for (; p < 1536; p += F.G) {
        const int sc = p >> 2, hh = p & 3, pnext = p + F.G;
        const float l2g = hh == 0 ? -0.045803689613124f : hh == 1 ? -0.022720076500083f : hh == 2 ? -0.011315313227834f : -0.005646563141142f;
        f32x4 O[8][2];
#pragma unroll
        for (int dt = 0; dt < 8; ++dt)
#pragma unroll
            for (int it = 0; it < 2; ++it) O[dt][it] = (f32x4){0.f, 0.f, 0.f, 0.f};
#pragma unroll 1
        for (int kb = 0; kb < 4; ++kb) { ret_block(F, a, p, kb, slot, pnext, Qf, O); slot = slot == 2 ? 0 : slot + 1; }
        { const int lane = opaque_i(F.lane), lr = lane & 15;
          const unsigned char* sp0 = a.st + state_off(sc, false, hh, 0) + (size_t)(unsigned)(lane * 8);
          u32x2 cA[16], cB[16];
#define RD_CLOAD(dst, k_) do { const unsigned char* b_ = sp0 + ((k_) >> 2) * 32768 + 2 * ((k_) & 3) * 512; \
              _Pragma("unroll") for (int dt = 0; dt < 8; ++dt) { dst[2 * dt] = *(const GAS u32x2*)(b_ + dt * 4096); dst[2 * dt + 1] = *(const GAS u32x2*)(b_ + dt * 4096 + 512); } } while (0)
#define RD_CMMA(src, k_) do { const int dir_ = (k_) >> 2, s_ = (k_) & 3; bf16x8 qs[2]; \
              _Pragma("unroll") for (int it = 0; it < 2; ++it) { const int i = 32 * w + 16 * it + lr; const float f = __builtin_amdgcn_exp2f(l2g * (float)(dir_ ? 256 - i : i + 1)); \
                  const v4u qw = __builtin_bit_cast(v4u, Qf[it][s_]); v4u o_; \
                  _Pragma("unroll") for (int j = 0; j < 4; ++j) ((unsigned*)&o_)[j] = cvtpk_c(bflo(((const unsigned*)&qw)[j]) * f, bfhi(((const unsigned*)&qw)[j]) * f); \
                  qs[it] = __builtin_bit_cast(bf16x8, o_); } \
              _Pragma("unroll") for (int dt = 0; dt < 8; ++dt) { const bf16x8 cf = __builtin_bit_cast(bf16x8, (v4u){src[2 * dt].x, src[2 * dt].y, src[2 * dt + 1].x, src[2 * dt + 1].y}); \
                  _Pragma("unroll") for (int it = 0; it < 2; ++it) O[dt][it] = __builtin_amdgcn_mfma_f32_16x16x32_bf16(cf, qs[it], O[dt][it], 0, 0, 0); } } while (0)
          RD_CLOAD(cA, 0); RD_CLOAD(cB, 1);
          __builtin_amdgcn_sched_barrier(0);
#pragma unroll
          for (int k = 0; k < 8; k += 2) {
              RD_CMMA(cA, k); if (k + 2 < 8) RD_CLOAD(cA, k + 2);
              __builtin_amdgcn_sched_barrier(0);
              RD_CMMA(cB, k + 1); if (k + 3 < 8) RD_CLOAD(cB, k + 3);
              __builtin_amdgcn_sched_barrier(0);
          }
#undef RD_CLOAD
#undef RD_CMMA
        }
        ret_q_load(Qf, a, pnext < 1536 ? pnext : p, w, F.lane);
        { const int lane = opaque_i(F.lane), g = lane >> 4, lr = lane & 15;
          LAS unsigned char* T = F.lds + 3 * RD_SLOT + w * (16 * 272);
          f32x4 nw[4], nb[4];
#pragma unroll
          for (int k = 0; k < 4; ++k) { nw[k] = *(const GAS f32x4*)(a.rnw + 128 * hh + 16 * (lane & 7) + 4 * k); nb[k] = *(const GAS f32x4*)(a.rnb + 128 * hh + 16 * (lane & 7) + 4 * k); }
#pragma unroll
          for (int it = 0; it < 2; ++it) {
              v4u gt[2][2];
#pragma unroll
              for (int h = 0; h < 2; ++h) { const bf16* gp = a.proj + pg8::PL_RG + (hh * pg8::MTOK + (size_t)(sc * 256 + 32 * w + 16 * it + 8 * h + (lane >> 3))) * 128 + 16 * (lane & 7);
                  gt[h][0] = *(const GAS v4u*)gp; gt[h][1] = *(const GAS v4u*)(gp + 8); }
              float sm = 0.f;
#pragma unroll
              for (int dt = 0; dt < 8; ++dt) sm += (O[dt][it][0] + O[dt][it][1]) + (O[dt][it][2] + O[dt][it][3]);
              sm += __shfl_xor(sm, 16); sm += __shfl_xor(sm, 32);
              const float mu = sm * (1.0f / 128.0f); float ss = 0.f;
#pragma unroll
              for (int dt = 0; dt < 8; ++dt) { O[dt][it] = O[dt][it] - mu; ss += (O[dt][it][0] * O[dt][it][0] + O[dt][it][1] * O[dt][it][1]) + (O[dt][it][2] * O[dt][it][2] + O[dt][it][3] * O[dt][it][3]); }
              ss += __shfl_xor(ss, 16); ss += __shfl_xor(ss, 32);
              const float rs = __builtin_amdgcn_rsqf(ss * (1.0f / 128.0f) + EPS);
#pragma unroll
              for (int dt = 0; dt < 8; ++dt) { const f32x4 y = O[dt][it] * rs;
                  u32x2 pk; pk.x = cvtpk_c(y[0], y[1]); pk.y = cvtpk_c(y[2], y[3]);
                  *(LAS u32x2*)(T + lr * 272 + 32 * dt + 8 * g) = pk; }
              asm volatile("s_waitcnt lgkmcnt(0)" ::: "memory");
#pragma unroll
              for (int h = 0; h < 2; ++h) { const int rr = 8 * h + (lane >> 3);
                  const v4u y0 = *(const LAS v4u*)(T + rr * 272 + 32 * (lane & 7)), y1 = *(const LAS v4u*)(T + rr * 272 + 32 * (lane & 7) + 16);
                  unsigned ow[8];
#pragma unroll
                  for (int k = 0; k < 8; ++k) { const unsigned yw = k < 4 ? ((const unsigned*)&y0)[k] : ((const unsigned*)&y1)[k - 4], gw = k < 4 ? ((const unsigned*)&gt[h][0])[k] : ((const unsigned*)&gt[h][1])[k - 4];
                      const float g0 = bflo(gw), g1 = bfhi(gw);
                      ow[k] = cvtpk_c((bflo(yw) * nw[k >> 1][2 * (k & 1)] + nb[k >> 1][2 * (k & 1)]) * g0 * __builtin_amdgcn_rcpf(1.0f + __expf(-g0)), (bfhi(yw) * nw[k >> 1][2 * (k & 1) + 1] + nb[k >> 1][2 * (k & 1) + 1]) * g1 * __builtin_amdgcn_rcpf(1.0f + __expf(-g1))); }
                  bf16* op = a.mo + (size_t)(sc * 256 + 32 * w + 16 * it + rr) * a.mop + 512 + 128 * hh + 16 * (lane & 7);
                  *(GAS v4u*)op = (v4u){ow[0], ow[1], ow[2], ow[3]}; *(GAS v4u*)(op + 8) = (v4u){ow[4], ow[5], ow[6], ow[7]}; }
              asm volatile("s_waitcnt lgkmcnt(0)" ::: "memory");
          } }
    }
    asm volatile("s_waitcnt vmcnt(0)" ::: "memory"); __syncthreads();
}

template <bool WITH_O>
__device__ __forceinline__ void cmix_phase(Frame& F, const CMixArgs& a, int which = 3) {
#if MIX_GLA
    if (which & 1) { mix_units<64, true, WITH_O>(F, a);
    __syncthreads(); }
#endif
#if MIX_RET
    if (which & 2) { if constexpr (WITH_O) ret_units_direct(F, a); else mix_units<128, false, false>(F, a);
    __syncthreads(); }
#endif
}
__device__ __forceinline__ void scan_phase(Frame& F, const CMixArgs& a) {
    const int nthreads = F.G * NWAVES * 64;
    for (int chain = (int)blockIdx.x * NWAVES * 64 + F.tid; chain < 34 * 49152; chain += nthreads) {
        const int sq = chain / 49152, cidx = chain % 49152;
        const int seq = sq < 2 ? 32 + sq : sq - 2;
        const int sc0 = seq < 32 ? seq * 8 : 256 + (seq - 32) * 64, ns = seq < 32 ? 8 : 64;
        const bool gla = cidx < 16384; const int c2 = gla ? cidx : cidx - 16384;
        const int hd = gla ? (c2 >> 11) : (c2 >> 12), v = gla ? (c2 & 2047) : (c2 & 4095), hh = hd >> 1, dir = hd & 1;
        if ((gla && !MIX_GLA) || (!gla && !MIX_RET)) continue;
        const int t0 = 16 * ((v >> 6) & 3) + 4 * ((v & 63) >> 4);
        const float gret = exp2f(256.0f * log2f(1.0f - exp2f(-5.0f - (float)hh)));
        f32x4 cst = {0.f, 0.f, 0.f, 0.f};
        for (int blk = 0; blk < ns; blk += 8) {
            u32x2 kv[8]; f32x4 d[8];
#pragma unroll
            for (int j = 0; j < 8; ++j) { const int n = dir ? ns - 1 - (blk + j) : blk + j;
                kv[j] = *(const GAS u32x2*)(a.st + state_off(sc0 + n, gla, hh, dir) + (size_t)v * 8);
                d[j] = gla ? *(const GAS f32x4*)(a.dec + (size_t)(((sc0 + n) * 4 + hh) * 2 + dir) * 64 + t0) : (f32x4){gret, gret, gret, gret}; }
#pragma unroll
            for (int j = 0; j < 8; ++j) { const int n = dir ? ns - 1 - (blk + j) : blk + j;
                u32x2 pk; pk.x = cvtpk_c(cst[0], cst[1]); pk.y = cvtpk_c(cst[2], cst[3]);
                *(GAS u32x2*)(a.sto + state_off(sc0 + n, gla, hh, dir) + (size_t)v * 8) = pk;
                cst = d[j] * cst + (f32x4){bflo(kv[j].x), bfhi(kv[j].x), bflo(kv[j].y), bfhi(kv[j].y)}; }
        }
    }
}

#define NAIVE_MIX (!(MIX_GLA && MIX_RET))
constexpr int PB0 = NAIVE_MIX ? 8 : 5, NPH = PB0 + 4;
struct Args { const float* in[16]; float* out; unsigned char* ws; int ph_lo, ph_hi, use_bar, pad; };
__global__ void __launch_bounds__(NWAVES * 64, 2) fwd_kernel(Args args) {
    extern __shared__ __attribute__((aligned(16))) unsigned char lds[];
    Frame F;
    F.lds = (LAS unsigned char*)lds;
    F.MISC = (volatile LAS unsigned*)(F.lds + MISC_OFF);
    F.tid = threadIdx.x; F.lane = F.tid & 63; F.wave = __builtin_amdgcn_readfirstlane(F.tid >> 6);
    F.G = gridDim.x; { const int bx = blockIdx.x; F.vcu = (F.G % 8 == 0) ? (bx % 8) * (F.G / 8) + bx / 8 : bx; }
    unsigned char* ws = args.ws;
    gu32* ctl = (gu32*)(ws + WS_CTL);
    for (int u = F.tid; u < (LDS_BYTES - LDSCTL_OFF) / 4; u += NWAVES * 64) ((LAS unsigned*)(F.lds + LDSCTL_OFF))[u] = 0u;
    __syncthreads();
    XcdBarrier bar; bar.bar = (unsigned*)(ctl + CW_BAR); bar.x = 0; bar.st = nullptr;
    if (args.use_bar) bar = xcd_barrier_post((unsigned*)(ctl + CW_BAR), F.MISC + 8);
    const int lo = args.ph_lo, hi = args.ph_hi;
#define IN(k) (lo <= (k) && (k) < hi)
#define SEAM(k) do { if (IN(k) && IN((k) + 1)) xcd_barrier(bar); } while (0)
    if (IN(0)) { const P0Args pa{args.in[0], args.in[1], args.in[2], args.in[3], args.in[11], args.in[12], args.in[13], args.in[14], (bf16*)(ws + WS_WIN), (bf16*)(ws + WS_WOUT), (bf16*)(ws + WS_W1), (bf16*)(ws + WS_W2),
            (bf16*)(ws + WS_R0), (float*)(ws + WS_ROPE), (float*)(ws + WS_ROPE) + 16384 * 64, (float*)(ws + WS_GA), (float*)(ws + WS_RSTD)};
        p0_prologue(F, pa); __syncthreads();
#if REP0
        p0_prologue(F, pa, REP0); __syncthreads();
#endif
    }
    SEAM(0);
    if (IN(1)) { pg8::Gemm g{(bf16*)(ws + WS_R0), (bf16*)(ws + WS_WIN), M_TOK, NP, D, D}; pg8::StaticOrder S; S.init(M_TOK, NP, F.G, (int)blockIdx.x);
        pg8::EpiInProj E{(bf16*)(ws + WS_R1), (float*)(ws + WS_RSTD), (float*)(ws + WS_ROPE), (float*)(ws + WS_ROPE) + 16384 * 64};
#if REP1 == 2
        { pg8::EpiPlain E2{(bf16*)(ws + WS_R1)}; pg8::gemm_phase<pg8::EpiPlain, pg8::StaticOrder, true, true>(F.lds + RING_OFF, g, S, E2); } __syncthreads();
#endif
        pg8::gemm_phase<pg8::EpiInProj, pg8::StaticOrder, true, true>(F.lds + RING_OFF, g, S, E);
#if REP1 == 1
        __syncthreads(); pg8::gemm_phase<pg8::EpiInProj, pg8::StaticOrder, true, true>(F.lds + RING_OFF, g, S, E);
#endif
    }
    SEAM(1);
    if (IN(2)) { const CMixArgs ca{(bf16*)(ws + WS_R1), (float*)(ws + WS_GA), args.in[4], args.in[5], args.in[6], args.in[7], ws + WS_R0, (float*)(ws + WS_DEC), args.in[8], args.in[9], args.in[10], (bf16*)((unsigned char*)args.out + (size_t)192 * MiB), D, ws + WS_R0, (unsigned char*)args.out, (float*)((unsigned char*)args.out + (size_t)96 * MiB), (float*)(ws + WS_R1 + (size_t)672 * MiB)};
        cmix_phase<false>(F, ca);
#if REP2
        cmix_phase<false>(F, ca, REP2);
#endif
    }
    SEAM(2);
    if (IN(3)) { const CMixArgs ca{(bf16*)(ws + WS_R1), (float*)(ws + WS_GA), args.in[4], args.in[5], args.in[6], args.in[7], ws + WS_R0, (float*)(ws + WS_DEC), args.in[8], args.in[9], args.in[10], (bf16*)((unsigned char*)args.out + (size_t)192 * MiB), D, ws + WS_R0, (unsigned char*)args.out, (float*)((unsigned char*)args.out + (size_t)96 * MiB), (float*)(ws + WS_R1 + (size_t)672 * MiB)};
#if REP3
        { CMixArgs cb = ca; cb.sto = (unsigned char*)args.out + (size_t)224 * MiB; scan_phase(F, cb); }
#endif
        scan_phase(F, ca); }
    SEAM(3);
    if (IN(4)) { const CMixArgs ca{(bf16*)(ws + WS_R1), (float*)(ws + WS_GA), args.in[4], args.in[5], args.in[6], args.in[7], ws + WS_R0, (float*)(ws + WS_DEC), args.in[8], args.in[9], args.in[10], (bf16*)((unsigned char*)args.out + (size_t)192 * MiB), D, ws + WS_R0, (unsigned char*)args.out, (float*)((unsigned char*)args.out + (size_t)96 * MiB), (float*)(ws + WS_R1 + (size_t)672 * MiB)};
#if REP4
        { CMixArgs cb = ca; cmix_phase<true>(F, cb, REP4); }
#endif
        cmix_phase<true>(F, ca); }
    SEAM(4);
#if NAIVE_MIX
    { const MixArgs ma{(bf16*)(ws + WS_R1), (float*)(ws + WS_GA), args.in[4], args.in[5], args.in[6], args.in[7], args.out, args.in[8], args.in[9], args.in[10]};
    if (IN(5)) { naive_mix_phase<false>(F, ma); __syncthreads(); }
    SEAM(5);
    if (IN(6)) { naive_mix_phase<true>(F, ma); __syncthreads(); }
    SEAM(6);
    if (IN(7)) { naive_combine(F, ma); }
    SEAM(7); }
#endif
    if (IN(PB0)) { pg8::Gemm g{(bf16*)((unsigned char*)args.out + (size_t)192 * MiB), (bf16*)(ws + WS_WOUT), M_TOK, D, D, D}; pg8::StaticOrder S; S.init(M_TOK, D, F.G, (int)blockIdx.x);
        pg8::EpiResidX E{args.in[0], args.in[1], (bf16*)(ws + WS_R0), (float*)(ws + WS_SQ1)};
        pg8::gemm_phase<pg8::EpiResidX, pg8::StaticOrder, true, true>(F.lds + RING_OFF, g, S, E);
#if REP5
        __syncthreads(); pg8::gemm_phase<pg8::EpiResidX, pg8::StaticOrder, true, true>(F.lds + RING_OFF, g, S, E);
#endif
    }
    SEAM(PB0);
    if (IN(PB0 + 1)) {
        { const float* sq = (const float*)(ws + WS_SQ1); float* r2v = (float*)(ws + WS_RSTD);
          for (int row = (int)blockIdx.x * NWAVES * 64 + F.tid; row < M_TOK; row += F.G * NWAVES * 64) { const f32x4* s4 = (const f32x4*)(sq + (size_t)row * 16);
              const f32x4 t = (s4[0] + s4[1]) + (s4[2] + s4[3]); r2v[row] = 1.0f / (((t[0] + t[1]) + (t[2] + t[3])) * (1.0f / 1024.0f) + EPS); }
          if (args.use_bar) xcd_barrier(bar); }
        pg8::Gemm g{(bf16*)(ws + WS_R0), (bf16*)(ws + WS_W1), M_TOK, FF, D, D}; pg8::StaticOrder S; S.init(M_TOK, FF, F.G, (int)blockIdx.x);
        pg8::EpiFF1 E{(bf16*)(ws + WS_R1), (float*)(ws + WS_RSTD)};
        pg8::gemm_phase<pg8::EpiFF1, pg8::StaticOrder, true, true>(F.lds + RING_OFF, g, S, E);
#if REP6
        __syncthreads(); pg8::gemm_phase<pg8::EpiFF1, pg8::StaticOrder, true, true>(F.lds + RING_OFF, g, S, E);
#endif
    }
    SEAM(PB0 + 1);
    if (IN(PB0 + 2)) { pg8::Gemm g{(bf16*)(ws + WS_R1), (bf16*)(ws + WS_W2), M_TOK, D, FF, FF}; pg8::StaticOrder S; S.init(M_TOK, D, F.G, (int)blockIdx.x);
        pg8::EpiResidB E{(bf16*)(ws + WS_R0), (float*)(ws + WS_SQ2)};
        pg8::gemm_phase<pg8::EpiResidB, pg8::StaticOrder, true, true>(F.lds + RING_OFF, g, S, E); }
    SEAM(PB0 + 2);
    if (IN(PB0 + 3)) { final_norm(F, args.out, (const bf16*)(ws + WS_R0), (float*)(ws + WS_SQ2), args.in[15]);
#if REP8
        final_norm(F, args.out, (const bf16*)(ws + WS_R0), (float*)(ws + WS_SQ2), args.in[15]);
#endif
    }
#undef IN
#undef SEAM
}

extern "C" void kernel_launch(void* const* d_in, const int* in_sizes, int n_in, void* d_out, int out_size, void* d_ws, size_t ws_size, hipStream_t stream) {
    static int grid = 0;
    if (grid == 0) {
        if (n_in != 16 || in_sizes[0] != M_PROMPT * D || out_size != M_TOK * D || ws_size < WS_END) {
            fprintf(stderr, "kernel_launch: unexpected shapes (n_in %d, in0 %d, out %d, ws %zu); nothing launched\n", n_in, n_in > 0 ? in_sizes[0] : -1, out_size, ws_size); grid = -1; return; }
        int dev = 0, cus = 0, per_cu = 0;
        if (hipGetDevice(&dev) != hipSuccess || hipDeviceGetAttribute(&cus, hipDeviceAttributeMultiprocessorCount, dev) != hipSuccess) { grid = -1; return; }
        if (hipFuncSetAttribute((const void*)fwd_kernel, hipFuncAttributeMaxDynamicSharedMemorySize, LDS_BYTES) != hipSuccess) { fprintf(stderr, "kernel_launch: hipFuncSetAttribute failed\n"); grid = -1; return; }
        if (hipOccupancyMaxActiveBlocksPerMultiprocessor(&per_cu, (const void*)fwd_kernel, NWAVES * 64, LDS_BYTES) != hipSuccess || per_cu < 1)
            fprintf(stderr, "kernel_launch: note: occupancy query reports %d workgroups per CU\n", per_cu);
        (void)hipGetLastError();
        grid = cus;
    }
    if (grid < 0) return;
    if (hipMemsetAsync((char*)d_ws + WS_CTL, 0, CTL_ZERO_BYTES, stream) != hipSuccess) return;
    Args a{};
    for (int i = 0; i < 16; ++i) a.in[i] = (const float*)d_in[i];
    a.out = (float*)d_out; a.ws = (unsigned char*)d_ws;
#if MK_SINGLE
    a.ph_lo = 0; a.ph_hi = NPH; a.use_bar = 1;
    hipLaunchKernelGGL(fwd_kernel, dim3(grid), dim3(NWAVES * 64), LDS_BYTES, stream, a);
#else
    for (int p = 0; p < NPH; ++p) { a.ph_lo = p; a.ph_hi = p + 1; a.use_bar = 0;
        hipLaunchKernelGGL(fwd_kernel, dim3(grid), dim3(NWAVES * 64), LDS_BYTES, stream, a); }
#endif
}
```

```cpp
#include <hip/hip_runtime.h>
#include <cstdio>
#ifndef MK_SINGLE
#define MK_SINGLE 1
#endif
#ifndef MIX_GLA
#define MIX_GLA 1
#define MIX_RET 1
#define REP1 0
#define REP2 0
#define REP3 0
#define REP4 0
#define REP6 0
#define DUP 0
#define ABLV 0
#define REP0 0
#define RELAX_MASK 0
#define STAG_TICKS 0
#define REP5 0
#define REP8 0
#endif
namespace pg8 {
#define PG8_LAS __attribute__((address_space(3)))
typedef unsigned short bf16_t;
typedef short bf16x8 __attribute__((ext_vector_type(8)));
typedef float f32x4 __attribute__((ext_vector_type(4)));
typedef unsigned u32x4 __attribute__((ext_vector_type(4)));
constexpr int BM = 256, BK = 64, HALF = 128, HTB = HALF * BK * 2  , STAGE_BYTES = 8 * HTB, NXCD = 8, WGM = 8;

__host__ __device__ __forceinline__ int lds_byte(int r, int c) { const int st = (r >> 4) * 2 + (c >> 5), rr = r & 15, cc = c & 31, ob = rr * 64 + cc * 2; return st * 1024 + (ob ^ (((ob >> 9) & 1) << 5)); }
__host__ __device__ __forceinline__ void stage_rc(int b, int& R, int& C) { const int st = b / 1024, sb = b % 1024, swz = sb ^ (((sb >> 9) & 1) << 5); R = (st >> 1) * 16 + swz / 64; C = (st & 1) * 32 + (swz % 64) / 2; }
__host__ __device__ __forceinline__ int perm32(int rho) { const int n = rho >> 4, i = rho & 15; return 8 * (i >> 2) + 4 * n + (i & 3); }

struct Unit { int pm, pn; };
struct Gemm { const bf16_t* A; const bf16_t* Bt; int M, N, K, lda; };

struct StaticOrder {
    int nM, nN, nwg, G, c;
    __host__ __device__ void init(int M, int N, int G_, int c_) { nM = M / BM; nN = N / BM; nwg = nM * nN; G = G_; c = c_; }
    __host__ __device__ bool next(int i, Unit& u) const {
        const long L = (long)i * G + c; if (L >= nwg) return false;
        int wgid = (int)L; { const int q = nwg / NXCD, r = nwg % NXCD, xcd = wgid % NXCD, off = wgid / NXCD; wgid = (xcd < r ? xcd * (q + 1) : r * (q + 1) + (xcd - r) * q) + off; }
        const int nig = WGM * nN, gid = wgid / nig, fm = gid * WGM, gsz = (nM - fm) < WGM ? (nM - fm) : WGM;
        u.pm = fm + ((wgid % nig) % gsz); u.pn = (wgid % nig) / gsz; return true;
    }
    __device__ __forceinline__ void a_ready(const Unit&) const {}
    __device__ __forceinline__ void done(const Unit&) const {}
};
struct InProjOrder {
    int x, r;
    __host__ __device__ void init(int c_) { x = c_ & 7; r = c_ >> 3; }
    __host__ __device__ bool next(int i, Unit& u) const {
        if (i >= 21) return false;
        const int gi = i / 7, ri = i % 7;
        if (ri < 6) { u.pm = x * 48 + 16 * gi + 8 * (ri & 1) + (r & 7); u.pn = 4 * (ri >> 1) + (r >> 3); }
        else { u.pm = x * 48 + 16 * gi + (r & 15); u.pn = 12 + (r >> 4); }
        return true;
    }
    __device__ __forceinline__ void a_ready(const Unit&) const {}
    __device__ __forceinline__ void done(const Unit&) const {}
};
__device__ __forceinline__ unsigned cvt_pk_bf16(float lo, float hi) { unsigned r; asm volatile("v_cvt_pk_bf16_f32 %0, %1, %2" : "=v"(r) : "v"(lo), "v"(hi)); return r; }
__device__ __forceinline__ u32x4 pack8(const f32x4& a, const f32x4& b) { u32x4 w; w.x = cvt_pk_bf16(a[0], a[1]); w.y = cvt_pk_bf16(a[2], a[3]); w.z = cvt_pk_bf16(b[0], b[1]); w.w = cvt_pk_bf16(b[2], b[3]); return w; }
#ifndef RELAX_MASK
#define RELAX_MASK 0
#endif
constexpr int NPROJ = 3584, DMODEL = 1024, DFF = 4096, MPROMPT = 65536;

constexpr size_t MTOK = 98304;
constexpr size_t PL_GV = 0, PL_RV = PL_GV + 4 * MTOK * 128, PL_GQ = PL_RV + 4 * MTOK * 128, PL_GK = PL_GQ + 4 * MTOK * 64, PL_GG = PL_GK + 4 * MTOK * 64,
                 PL_RQ = PL_GG + 4 * MTOK * 128, PL_RK = PL_RQ + 4 * MTOK * 128, PL_RG = PL_RK + 4 * MTOK * 128, PL_END = PL_RG + 4 * MTOK * 128;
__device__ __forceinline__ void plane_of(int pn, int bj, int wc, size_t& off, int& W, int& col) {
    W = 128; col = 32 * wc; int hh = 2 * (pn & 1) + bj; size_t grp;
    switch (pn >> 1) { case 0: grp = PL_GV; break; case 1: grp = PL_RV; break; case 3: grp = PL_GG; break; case 4: grp = PL_RQ; break; case 5: grp = PL_RK; break; case 6: grp = PL_RG; break;
        default: grp = (pn & 1) ? PL_GK : PL_GQ; W = 64; hh = 2 * bj + (wc >> 1); col = 32 * (wc & 1); break; }
    off = grp + (size_t)hh * MTOK * (size_t)W;
}
struct EpiInProj {
    static constexpr bool PERM = true, AFTER_DRAIN = false, RELAX = (RELAX_MASK & 1) != 0;
    bf16_t* P; const float* rstd; const float* rcos; const float* rsin;
    __device__ __forceinline__ void operator()(const f32x4 (&acc)[2][2][4][2], const Unit& u, int wr, int wc, int fr_in, int fq_in) const {
        int fr = fr_in, fq = fq_in; asm volatile("" : "+v"(fr), "+v"(fq));
        const int row0 = u.pm * BM + wr * 64 + fr;
        const bool rot = (u.pn >= 8) && (u.pn < 12);
        const int i0 = (4 * wc + fq) * 4;
        size_t poff[2]; int W, col;
        plane_of(u.pn, 0, wc, poff[0], W, col); plane_of(u.pn, 1, wc, poff[1], W, col);
        float rs[2][4];
#pragma unroll
        for (int ai = 0; ai < 2; ++ai)
#pragma unroll
            for (int m = 0; m < 4; ++m) rs[ai][m] = rstd[row0 + ai * HALF + m * 16];
#pragma unroll
        for (int ai = 0; ai < 2; ++ai)
#pragma unroll
            for (int mh = 0; mh < 2; ++mh) {
                f32x4 c4[2], s4[2];
#pragma unroll
                for (int x = 0; x < 2; ++x) { c4[x] = (f32x4){1.f, 1.f, 1.f, 1.f}; s4[x] = (f32x4){0.f, 0.f, 0.f, 0.f}; }
                if (rot) {
#pragma unroll
                    for (int x = 0; x < 2; ++x) { const int row = row0 + ai * HALF + (2 * mh + x) * 16; const int pos = row < MPROMPT ? (row & 2047) : (row & 16383);
                        c4[x] = *(const f32x4*)(rcos + pos * 64 + i0); s4[x] = *(const f32x4*)(rsin + pos * 64 + i0); } }
                __builtin_amdgcn_sched_barrier(0);
#pragma unroll
                for (int x = 0; x < 2; ++x) { const int m = 2 * mh + x;
                    const int row = row0 + ai * HALF + m * 16;
#pragma unroll
                    for (int bj = 0; bj < 2; ++bj) {
                        f32x4 v0 = acc[ai][bj][m][0] * rs[ai][m], v1 = acc[ai][bj][m][1] * rs[ai][m];
                        if (rot) { const f32x4 lo = v0 * c4[x] - v1 * s4[x], hi = v0 * s4[x] + v1 * c4[x]; v0 = lo; v1 = hi; }
                        *(u32x4*)(P + poff[bj] + (size_t)row * W + col + 8 * fq) = pack8(v0, v1);
                    }
                }
                __builtin_amdgcn_sched_barrier(0);
            }
    }
};
struct EpiResid {
    static constexpr bool PERM = true, AFTER_DRAIN = false, RELAX = false;
    const float* xp; const float* xs; float* out; bf16_t* A2; float* sq;
    __device__ __forceinline__ void operator()(const f32x4 (&acc)[2][2][4][2], const Unit& u, int wr, int wc, int fr_in, int fq_in) const {
        int fr = fr_in, fq = fq_in; asm volatile("" : "+v"(fr), "+v"(fq));
        const int row0 = u.pm * BM + wr * 64 + fr, colb = u.pn * BM + wc * 32 + 8 * fq;
#pragma unroll
        for (int ai = 0; ai < 2; ++ai)
#pragma unroll
            for (int m = 0; m < 4; ++m) {
                const int row = row0 + ai * HALF + m * 16;
                const float* xrow = (row < MPROMPT ? xp + (size_t)row * DMODEL : xs + (size_t)(row - MPROMPT) * DMODEL) + colb;
                float* orow = out + (size_t)row * DMODEL + colb;
                float ss = 0.f;
#pragma unroll
                for (int bj = 0; bj < 2; ++bj) {
                    const f32x4 x0 = *(const f32x4*)(xrow + bj * HALF), x1 = *(const f32x4*)(xrow + bj * HALF + 4);
                    const f32x4 v0 = acc[ai][bj][m][0] + x0, v1 = acc[ai][bj][m][1] + x1;
                    *(f32x4*)(orow + bj * HALF) = v0; *(f32x4*)(orow + bj * HALF + 4) = v1;
                    if (A2) *(u32x4*)(A2 + (size_t)row * DMODEL + colb + bj * HALF) = pack8(v0, v1);
                    ss += (v0[0] * v0[0] + v0[1] * v0[1]) + (v0[2] * v0[2] + v0[3] * v0[3]) + (v1[0] * v1[0] + v1[1] * v1[1]) + (v1[2] * v1[2] + v1[3] * v1[3]);
                }
                ss += __shfl_xor(ss, 16); ss += __shfl_xor(ss, 32);
                if (fq == 0) sq[(size_t)row * 16 + u.pn * 4 + wc] = ss;
            }
    }
};
struct EpiFF1 {
    static constexpr bool PERM = true, AFTER_DRAIN = false, RELAX = (RELAX_MASK & 4) != 0;
    bf16_t* H; const float* r2v;
    __device__ __forceinline__ void operator()(const f32x4 (&acc)[2][2][4][2], const Unit& u, int wr, int wc, int fr_in, int fq_in) const {
        int fr = fr_in, fq = fq_in; asm volatile("" : "+v"(fr), "+v"(fq));
        const int row0 = u.pm * BM + wr * 64 + fr, colb = u.pn * BM + wc * 32 + 8 * fq;
        float r2[2][4];
#pragma unroll
        for (int ai = 0; ai < 2; ++ai)
#pragma unroll
            for (int m = 0; m < 4; ++m) r2[ai][m] = r2v[row0 + ai * HALF + m * 16];
        __builtin_amdgcn_sched_barrier(0);
#pragma unroll
        for (int ai = 0; ai < 2; ++ai)
#pragma unroll
            for (int m = 0; m < 4; ++m) {
                const int row = row0 + ai * HALF + m * 16;
                bf16_t* rowp = H + (size_t)row * DFF + colb;
#pragma unroll
                for (int bj = 0; bj < 2; ++bj) {
                    f32x4 v0 = acc[ai][bj][m][0], v1 = acc[ai][bj][m][1];
#pragma unroll
                    for (int j = 0; j < 4; ++j) { const float a = fmaxf(v0[j], 0.f), b = fmaxf(v1[j], 0.f); v0[j] = a * a * r2[ai][m]; v1[j] = b * b * r2[ai][m]; }
                    *(u32x4*)(rowp + bj * HALF) = pack8(v0, v1);
                }
            }
    }
};

struct EpiPlain {
    static constexpr bool PERM = true, AFTER_DRAIN = false, RELAX = false;
    bf16_t* P;
    __device__ __forceinline__ void operator()(const f32x4 (&acc)[2][2][4][2], const Unit& u, int wr, int wc, int fr_in, int fq_in) const {
        int fr = fr_in, fq = fq_in; asm volatile("" : "+v"(fr), "+v"(fq));
        const int row0 = u.pm * BM + wr * 64 + fr;
        size_t poff[2]; int W, col;
        plane_of(u.pn, 0, wc, poff[0], W, col); plane_of(u.pn, 1, wc, poff[1], W, col);
#pragma unroll
        for (int ai = 0; ai < 2; ++ai)
#pragma unroll
            for (int m = 0; m < 4; ++m) { const int row = row0 + ai * HALF + m * 16;
#pragma unroll
                for (int bj = 0; bj < 2; ++bj) *(u32x4*)(P + poff[bj] + (size_t)row * W + col + 8 * fq) = pack8(acc[ai][bj][m][0], acc[ai][bj][m][1]); }
    }
};

struct EpiResidX {
    static constexpr bool PERM = true, AFTER_DRAIN = false, RELAX = (RELAX_MASK & 2) != 0;
    const float* xp; const float* xs; bf16_t* A2; float* sq;
    __device__ __forceinline__ void operator()(const f32x4 (&acc)[2][2][4][2], const Unit& u, int wr, int wc, int fr_in, int fq_in) const {
        int fr = fr_in, fq = fq_in; asm volatile("" : "+v"(fr), "+v"(fq));
        const int row0 = u.pm * BM + wr * 64 + fr, colb = u.pn * BM + wc * 32 + 8 * fq;
#pragma unroll
        for (int ai = 0; ai < 2; ++ai) {
            f32x4 xv[4][2][2];
#pragma unroll
            for (int m = 0; m < 4; ++m) { const int row = row0 + ai * HALF + m * 16;
                const float* xrow = (row < MPROMPT ? xp + (size_t)row * DMODEL : xs + (size_t)(row - MPROMPT) * DMODEL) + colb;
#pragma unroll
                for (int bj = 0; bj < 2; ++bj) { xv[m][bj][0] = *(const f32x4*)(xrow + bj * HALF); xv[m][bj][1] = *(const f32x4*)(xrow + bj * HALF + 4); } }
            __builtin_amdgcn_sched_barrier(0);
#pragma unroll
            for (int m = 0; m < 4; ++m) {
                const int row = row0 + ai * HALF + m * 16;
                float ss = 0.f;
#pragma unroll
                for (int bj = 0; bj < 2; ++bj) {
                    const f32x4 v0 = acc[ai][bj][m][0] + xv[m][bj][0], v1 = acc[ai][bj][m][1] + xv[m][bj][1];
                    *(u32x4*)(A2 + (size_t)row * DMODEL + colb + bj * HALF) = pack8(v0, v1);
                    ss += (v0[0] * v0[0] + v0[1] * v0[1]) + (v0[2] * v0[2] + v0[3] * v0[3]) + (v1[0] * v1[0] + v1[1] * v1[1]) + (v1[2] * v1[2] + v1[3] * v1[3]);
                }
                ss += __shfl_xor(ss, 16); ss += __shfl_xor(ss, 32);
                if (fq == 0) sq[(size_t)row * 16 + u.pn * 4 + wc] = ss;
            }
            __builtin_amdgcn_sched_barrier(0);
        }
    }
};
struct EpiResidB {
    static constexpr bool PERM = true, AFTER_DRAIN = false, RELAX = (RELAX_MASK & 8) != 0;
    bf16_t* A2; float* sq;
    __device__ __forceinline__ void operator()(const f32x4 (&acc)[2][2][4][2], const Unit& u, int wr, int wc, int fr_in, int fq_in) const {
        int fr = fr_in, fq = fq_in; asm volatile("" : "+v"(fr), "+v"(fq));
        const int row0 = u.pm * BM + wr * 64 + fr, colb = u.pn * BM + wc * 32 + 8 * fq;
        u32x4 xw[2][4][2];
#pragma unroll
        for (int ai = 0; ai < 2; ++ai)
#pragma unroll
            for (int m = 0; m < 4; ++m)
#pragma unroll
                for (int bj = 0; bj < 2; ++bj) xw[ai][m][bj] = *(const u32x4*)(A2 + (size_t)(row0 + ai * HALF + m * 16) * DMODEL + colb + bj * HALF);
        __builtin_amdgcn_sched_barrier(0);
#pragma unroll
        for (int ai = 0; ai < 2; ++ai)
#pragma unroll
            for (int m = 0; m < 4; ++m) {
                const int row = row0 + ai * HALF + m * 16;
                bf16_t* xr = A2 + (size_t)row * DMODEL + colb;
                float ss = 0.f;
#pragma unroll
                for (int bj = 0; bj < 2; ++bj) {
                    const u32x4 w_ = xw[ai][m][bj];
                    const f32x4 x0 = {__uint_as_float(w_.x << 16), __uint_as_float(w_.x & 0xffff0000u), __uint_as_float(w_.y << 16), __uint_as_float(w_.y & 0xffff0000u)};
                    const f32x4 x1 = {__uint_as_float(w_.z << 16), __uint_as_float(w_.z & 0xffff0000u), __uint_as_float(w_.w << 16), __uint_as_float(w_.w & 0xffff0000u)};
                    const f32x4 v0 = acc[ai][bj][m][0] + x0, v1 = acc[ai][bj][m][1] + x1;
                    *(u32x4*)(xr + bj * HALF) = pack8(v0, v1);
                    ss += (v0[0] * v0[0] + v0[1] * v0[1]) + (v0[2] * v0[2] + v0[3] * v0[3]) + (v1[0] * v1[0] + v1[1] * v1[1]) + (v1[2] * v1[2] + v1[3] * v1[3]);
                }
                ss += __shfl_xor(ss, 16); ss += __shfl_xor(ss, 32);
                if (fq == 0) sq[(size_t)row * 16 + u.pn * 4 + wc] = ss;
            }
    }
};

struct EpiNull {
    static constexpr bool PERM = true, AFTER_DRAIN = false, RELAX = false;
    __device__ __forceinline__ void operator()(const f32x4 (&acc)[2][2][4][2], const Unit& u, int wr, int wc, int fr_in, int fq_in) const {
        int fr = fr_in, fq = fq_in; asm volatile("" : "+v"(fr), "+v"(fq));
#pragma unroll
        for (int ai = 0; ai < 2; ++ai)
#pragma unroll
            for (int m = 0; m < 4; ++m)
#pragma unroll
                for (int bj = 0; bj < 2; ++bj) asm volatile("" :: "v"(acc[ai][bj][m][0]), "v"(acc[ai][bj][m][1]));
    }
};
template <class Epi, class Sched, bool ALIGN_EPI = false, bool SP2 = false>
__device__ __forceinline__ void gemm_phase(PG8_LAS unsigned char* lds, const Gemm g, const Sched& S, const Epi& E) {
    const int tid = threadIdx.x, wid = __builtin_amdgcn_readfirstlane(tid >> 6), lane = tid & 63, wr = wid >> 2, wc = wid & 3, fr = lane & 15, fq = lane >> 4;
    const int K = g.K, nt = K / BK;
    unsigned voffA[2], voffB[2];
#pragma unroll
    for (int i = 0; i < 2; ++i) { int R, C; stage_rc(tid * 16 + i * 8192, R, C); const int Rb = Epi::PERM ? ((R & ~31) + perm32(R & 31)) : R;
        voffA[i] = (unsigned)(R * g.lda + C) * 2u; voffB[i] = (unsigned)(Rb * K + C) * 2u; }
    const size_t kstep = (size_t)(BK * 2);
    const size_t hstepB = (size_t)HALF * K * 2, hstepA = (size_t)HALF * g.lda * 2;
    const size_t tstepB = 2 * hstepB, tstepA = 2 * hstepA;
    const unsigned ldsw = (unsigned)wid * 1024u;
    const int aoff = lds_byte(wr * 64 + fr, fq * 8), boff = lds_byte(wc * 32 + fr, fq * 8);
#define PG8_SA(b, h) (((b) * 2 + (h)) * HTB)
#define PG8_SB(b, h) ((4 + (b) * 2 + (h)) * HTB)
#define PG8_STAGE(bufoff, gbase, voff) do { _Pragma("unroll") for (int _i = 0; _i < 2; ++_i) \
        __builtin_amdgcn_global_load_lds((const unsigned*)((const char*)(gbase) + (voff)[_i]), (PG8_LAS unsigned*)(lds + (bufoff) + ldsw + _i * 8192), 16, 0, 0); } while (0)
#define PG8_LDA(dst, b, h) do { _Pragma("unroll") for (int m = 0; m < 4; ++m) _Pragma("unroll") for (int k = 0; k < 2; ++k) dst[m][k] = *(const PG8_LAS bf16x8*)(lds + PG8_SA(b, h) + aoff + m * 2048 + k * 1024); } while (0)
#define PG8_LDB(dst, b, h) do { _Pragma("unroll") for (int n = 0; n < 2; ++n) _Pragma("unroll") for (int k = 0; k < 2; ++k) dst[n][k] = *(const PG8_LAS bf16x8*)(lds + PG8_SB(b, h) + boff + n * 2048 + k * 1024); } while (0)
#define PG8_MMA(ai, bj, At, Bt) do { __builtin_amdgcn_s_setprio(1); _Pragma("unroll") for (int m = 0; m < 4; ++m) _Pragma("unroll") for (int n = 0; n < 2; ++n) _Pragma("unroll") for (int k = 0; k < 2; ++k) \
        acc[ai][bj][m][n] = __builtin_amdgcn_mfma_f32_16x16x32_bf16(Bt[n][k], At[m][k], acc[ai][bj][m][n], 0, 0, 0); __builtin_amdgcn_s_setprio(0); } while (0)
#define PG8_WAIT_V(n) asm volatile("s_waitcnt vmcnt(" #n ")" ::: "memory")
#define PG8_WAIT_L(n) asm volatile("s_waitcnt lgkmcnt(" #n ")" ::: "memory")
#define PG8_BAR __builtin_amdgcn_s_barrier()
#define PG8_SCHED __builtin_amdgcn_sched_barrier(0)
    Unit cur, nxt; int ui = 0;
    if (!S.next(0, cur)) return;
    f32x4 acc[2][2][4][2];
#pragma unroll
    for (int a = 0; a < 2; ++a)
#pragma unroll
        for (int b = 0; b < 2; ++b)
#pragma unroll
            for (int m = 0; m < 4; ++m)
#pragma unroll
                for (int n = 0; n < 2; ++n) acc[a][b][m][n] = (f32x4){0.f, 0.f, 0.f, 0.f};
    bf16x8 At[4][2], B0[2][2], B1[2][2];
    const char* cA = (const char*)g.A + (size_t)cur.pm * tstepA; const char* cB = (const char*)g.Bt + (size_t)cur.pn * tstepB;
    S.a_ready(cur);
    if constexpr (SP2) {
        PG8_STAGE(PG8_SB(0, 0), cB, voffB); PG8_STAGE(PG8_SB(0, 1), cB + hstepB, voffB); PG8_STAGE(PG8_SA(0, 0), cA, voffA); PG8_STAGE(PG8_SA(0, 1), cA + hstepA, voffA);
        if (wr == 1) PG8_BAR;
        PG8_WAIT_V(2); PG8_BAR;
        PG8_STAGE(PG8_SB(1, 0), cB + kstep, voffB); PG8_STAGE(PG8_SA(1, 0), cA + kstep, voffA); PG8_STAGE(PG8_SB(1, 1), cB + hstepB + kstep, voffB);
        PG8_WAIT_V(6); PG8_BAR;
    } else {
        PG8_STAGE(PG8_SB(0, 0), cB, voffB); PG8_STAGE(PG8_SA(0, 0), cA, voffA); PG8_STAGE(PG8_SB(0, 1), cB + hstepB, voffB); PG8_STAGE(PG8_SA(0, 1), cA + hstepA, voffA);
        if (wr == 1) PG8_BAR;
        PG8_WAIT_V(4); PG8_BAR;
        PG8_STAGE(PG8_SB(1, 0), cB + kstep, voffB); PG8_STAGE(PG8_SA(1, 0), cA + kstep, voffA); PG8_STAGE(PG8_SB(1, 1), cB + hstepB + kstep, voffB);
        PG8_WAIT_V(6); PG8_BAR;
    }
    for (;;) {
        const bool has_next = S.next(ui + 1, nxt);
        const char* nA = has_next ? (const char*)g.A + (size_t)nxt.pm * tstepA : cA; const char* nB = has_next ? (const char*)g.Bt + (size_t)nxt.pn * tstepB : cB;
        for (int t = 0; t < nt; t += 2) {
            const bool last = (t == nt - 2);
            const char* a1 = cA + (size_t)(t + 1) * kstep;
            const char* a2 = last ? nA : cA + (size_t)(t + 2) * kstep; const char* b2 = last ? nB : cB + (size_t)(t + 2) * kstep;
            const char* a3 = a2 + kstep; const char* b3 = b2 + kstep;
            if (last && has_next) S.a_ready(nxt);
            if constexpr (SP2) {
            PG8_LDB(B0, 0, 0); PG8_LDB(B1, 0, 1); PG8_SCHED; PG8_LDA(At, 0, 0); PG8_STAGE(PG8_SA(1, 1), a1 + hstepA, voffA);
            PG8_WAIT_V(8); PG8_WAIT_L(0); PG8_BAR; PG8_MMA(0, 0, At, B0); PG8_MMA(0, 1, At, B1); PG8_BAR; PG8_SCHED;
            PG8_LDA(At, 0, 1); PG8_STAGE(PG8_SB(0, 0), b2, voffB); PG8_STAGE(PG8_SB(0, 1), b2 + hstepB, voffB); PG8_STAGE(PG8_SA(0, 0), a2, voffA);
            PG8_WAIT_V(8); PG8_WAIT_L(0); PG8_BAR; PG8_MMA(1, 0, At, B0); PG8_MMA(1, 1, At, B1); PG8_BAR; PG8_SCHED;
            PG8_LDB(B0, 1, 0); PG8_LDB(B1, 1, 1); PG8_SCHED; PG8_LDA(At, 1, 0); PG8_STAGE(PG8_SA(0, 1), a2 + hstepA, voffA);
            PG8_WAIT_V(8); PG8_WAIT_L(0); PG8_BAR; PG8_MMA(0, 0, At, B0); PG8_MMA(0, 1, At, B1); PG8_BAR; PG8_SCHED;
            PG8_LDA(At, 1, 1); PG8_STAGE(PG8_SB(1, 0), b3, voffB); PG8_STAGE(PG8_SB(1, 1), b3 + hstepB, voffB); PG8_STAGE(PG8_SA(1, 0), a3, voffA);
            PG8_WAIT_V(8); PG8_WAIT_L(0); PG8_BAR; PG8_MMA(1, 0, At, B0); PG8_MMA(1, 1, At, B1); PG8_BAR; PG8_SCHED;
            } else {
            PG8_LDB(B0, 0, 0); PG8_SCHED; PG8_LDA(At, 0, 0); PG8_STAGE(PG8_SA(1, 1), a1 + hstepA, voffA);
            PG8_WAIT_L(8); PG8_BAR; PG8_WAIT_L(0); PG8_MMA(0, 0, At, B0); PG8_BAR; PG8_SCHED;
            PG8_LDB(B1, 0, 1); PG8_STAGE(PG8_SB(0, 0), b2, voffB);
            PG8_BAR; PG8_WAIT_L(0); PG8_MMA(0, 1, At, B1); PG8_BAR;
            PG8_LDA(At, 0, 1); PG8_STAGE(PG8_SA(0, 0), a2, voffA);
            PG8_BAR; PG8_WAIT_L(0); PG8_MMA(1, 0, At, B0); PG8_BAR; PG8_SCHED;
            PG8_STAGE(PG8_SB(0, 1), b2 + hstepB, voffB);
            PG8_WAIT_V(6); PG8_BAR; PG8_MMA(1, 1, At, B1); PG8_BAR;
            PG8_LDB(B0, 1, 0); PG8_SCHED; PG8_LDA(At, 1, 0); PG8_STAGE(PG8_SA(0, 1), a2 + hstepA, voffA);
            PG8_WAIT_L(8); PG8_BAR; PG8_WAIT_L(0); PG8_MMA(0, 0, At, B0); PG8_BAR; PG8_SCHED;
            PG8_LDB(B1, 1, 1); PG8_STAGE(PG8_SB(1, 0), b3, voffB);
            PG8_BAR; PG8_WAIT_L(0); PG8_MMA(0, 1, At, B1); PG8_BAR;
            PG8_LDA(At, 1, 1); PG8_STAGE(PG8_SA(1, 0), a3, voffA);
            PG8_BAR; PG8_WAIT_L(0); PG8_MMA(1, 0, At, B0); PG8_BAR; PG8_SCHED;
            PG8_STAGE(PG8_SB(1, 1), b3 + hstepB, voffB);
            PG8_WAIT_V(6); PG8_BAR; PG8_MMA(1, 1, At, B1); PG8_BAR;
            }
        }
        if constexpr (ALIGN_EPI) { if (wr == 0) PG8_BAR; }
        if constexpr (!Epi::AFTER_DRAIN) { E(acc, cur, wr, wc, fr, fq); S.done(cur); }
        if (!has_next) break;
#pragma unroll
        for (int a = 0; a < 2; ++a)
#pragma unroll
            for (int b = 0; b < 2; ++b)
#pragma unroll
                for (int m = 0; m < 4; ++m)
#pragma unroll
                    for (int n = 0; n < 2; ++n) acc[a][b][m][n] = (f32x4){0.f, 0.f, 0.f, 0.f};
        cur = nxt; cA = nA; cB = nB; ++ui;
        if constexpr (ALIGN_EPI) { if (wr == 1) PG8_BAR; }
    }
    PG8_WAIT_V(0);
    if constexpr (!ALIGN_EPI) { if (wr == 0) PG8_BAR; }
    PG8_BAR;
    if constexpr (Epi::AFTER_DRAIN) { E.fused(acc, cur, wr, wc, fr, fq, lds, wid, lane); S.done(cur); }
#undef PG8_SA
#undef PG8_SB
#undef PG8_STAGE
#undef PG8_LDA
#undef PG8_LDB
#undef PG8_MMA
#undef PG8_WAIT_V
#undef PG8_WAIT_L
#undef PG8_BAR
#undef PG8_SCHED
}
}
#define GAS __attribute__((address_space(1)))
#define LAS __attribute__((address_space(3)))
typedef unsigned short bf16;
typedef unsigned v4u __attribute__((ext_vector_type(4)));
typedef float f32x4 __attribute__((ext_vector_type(4)));
typedef short bf16x8 __attribute__((ext_vector_type(8)));
typedef GAS unsigned gu32;
typedef GAS unsigned long long gu64;
#define RLX_AGENT __ATOMIC_RELAXED, __HIP_MEMORY_SCOPE_AGENT
#define LDS_WAIT() asm volatile("s_waitcnt lgkmcnt(0)" ::: "memory")
#define VM_WAIT() asm volatile("s_waitcnt vmcnt(0)" ::: "memory")
__device__ __forceinline__ unsigned long long rt() { return __builtin_amdgcn_s_memrealtime(); }
__device__ __forceinline__ unsigned f2bf(float f) { unsigned u = __builtin_bit_cast(unsigned, f); return (u + 0x7fffu + ((u >> 16) & 1u)) >> 16; }
__device__ __forceinline__ unsigned pk2(float lo, float hi) { return f2bf(lo) | (f2bf(hi) << 16); }

#define XB_TMO      128
#define XB_XCNT(j)  (256  + 64 * (j))
#define XB_XSUB(j)  (1280 + 64 * (j))
#define XB_XGEN(j)  (2304 + 64 * (j))
#define XB_TOP      3328
#define XB_TOPGEN   3392
#define XCD_BAR_WORDS 3456
#define XB_SPIN_CAP (1u << 18)

__device__ __forceinline__ unsigned xb_ld(unsigned* p)              { return __hip_atomic_load(p, __ATOMIC_RELAXED, __HIP_MEMORY_SCOPE_AGENT); }
__device__ __forceinline__ unsigned xb_add(unsigned* p, unsigned v) { return __hip_atomic_fetch_add(p, v, __ATOMIC_RELAXED, __HIP_MEMORY_SCOPE_AGENT); }
__device__ __forceinline__ unsigned xb_xcc_id() { return (unsigned)__builtin_amdgcn_s_getreg((3 << 11) | 20) & 0xFu; }
#define XB_SPIN(cond, bar) do { unsigned _sp = 0; while (cond) { __builtin_amdgcn_s_sleep(1); \
    if ((++_sp & 255u) == 0u) { if (xb_ld(&(bar)[XB_TMO])) break; if (_sp > XB_SPIN_CAP) { atomicAdd(&(bar)[XB_TMO], 1u); break; } } } } while (0)

struct XcdBarrier {
    unsigned* bar; unsigned x;
    volatile LAS unsigned* st;
};

__device__ __forceinline__ XcdBarrier xcd_barrier_post(unsigned* bar, volatile LAS unsigned* st) {
    XcdBarrier b; b.bar = bar; b.x = xb_xcc_id(); b.st = st;
    if (threadIdx.x == 0) (void)xb_add(&bar[XB_XCNT(b.x)], 1u);
    return b;
}
__device__ __forceinline__ void xcd_barrier_complete(unsigned* bar, unsigned x, unsigned& nloc, unsigned& nx) {
    const unsigned G = gridDim.x * gridDim.y * gridDim.z;
    unsigned sum, cnt, mine, sp = 0u;
    for (;;) {
        sum = 0u; cnt = 0u; mine = 0u;
#pragma unroll
        for (unsigned j = 0; j < 16; ++j) { const unsigned c = xb_ld(&bar[XB_XCNT(j)]); sum += c; cnt += (c > 0u) ? 1u : 0u; mine = (j == x) ? c : mine; }
        if (sum == G) break;
        __builtin_amdgcn_s_sleep(1);
        if ((++sp & 255u) == 0u) { if (xb_ld(&bar[XB_TMO])) break; if (sp > XB_SPIN_CAP) { atomicAdd(&bar[XB_TMO], 1u); break; } }
    }
    nloc = mine > 0u ? mine : 1u; nx = cnt > 0u ? cnt : 1u;
}

__device__ __forceinline__ void xcd_barrier(const XcdBarrier& b) {
    asm volatile("s_waitcnt vmcnt(0)" ::: "memory");
    __syncthreads();
    if (threadIdx.x == 0) {
        unsigned* bar = b.bar;
        __builtin_amdgcn_s_waitcnt(0);
        unsigned nloc = b.st[0], nx = b.st[1];
        if (nloc == 0u) { xcd_barrier_complete(bar, b.x, nloc, nx); b.st[0] = nloc; b.st[1] = nx; }
        const unsigned old = xb_add(&bar[XB_XSUB(b.x)], 1u);
        const unsigned gen = old / nloc;
        if (old + 1u == (gen + 1u) * nloc) {
            __builtin_amdgcn_fence(__ATOMIC_RELEASE, "agent");
            asm volatile("s_waitcnt vmcnt(0)" ::: "memory");
            const unsigned og = xb_add(&bar[XB_TOP], 1u);
            const unsigned tg = og / nx;
            if (og + 1u == (tg + 1u) * nx) xb_add(&bar[XB_TOPGEN], 1u);
            else XB_SPIN(xb_ld(&bar[XB_TOPGEN]) == tg, bar);
            __builtin_amdgcn_fence(__ATOMIC_ACQUIRE, "agent");
            xb_add(&bar[XB_XGEN(b.x)], 1u);
            asm volatile("s_waitcnt vmcnt(0)" ::: "memory");
        } else {
            XB_SPIN(xb_ld(&bar[XB_XGEN(b.x)]) == gen, bar);
            __builtin_amdgcn_fence(__ATOMIC_ACQUIRE, "agent");
            asm volatile("s_waitcnt vmcnt(0)" ::: "memory");
        }
    }
    __syncthreads();
}
constexpr int NWAVES = 8;
constexpr int M_TOK = 98304, M_PROMPT = 65536, D = 1024, NP = 3584, NWIN = 3616, FF = 4096;
constexpr int L_PROMPT = 2048, L_SAMPLE = 16384;
constexpr float EPS = 1e-6f;
constexpr size_t MiB = 1u << 20;
constexpr size_t WS_CTL = 0, CTL_ZERO_BYTES = 1 * MiB;
constexpr size_t WS_WIN = 1 * MiB;
constexpr size_t WS_WOUT = 9 * MiB;
constexpr size_t WS_W1 = 11 * MiB;
constexpr size_t WS_W2 = 19 * MiB;
constexpr size_t WS_ROPE = 27 * MiB;
constexpr size_t WS_GA = 35 * MiB;
constexpr size_t WS_RSTD = 47 * MiB;
constexpr size_t WS_SQ1 = 48 * MiB;
constexpr size_t WS_SQ2 = 54 * MiB;
constexpr size_t WS_DEC = 60 * MiB;
constexpr size_t WS_R0 = 64 * MiB;
constexpr size_t WS_R1 = 256 * MiB;
constexpr size_t WS_END = 1024 * MiB;
constexpr int CW_BAR = 4096;
constexpr int RING_OFF = 0, RING_BYTES = 131072;
constexpr int LDSCTL_OFF = 147456 - 1024, MISC_OFF = LDSCTL_OFF + 320;
constexpr int LDS_BYTES = 147456;

struct Frame {
    LAS unsigned char* lds;
    volatile LAS unsigned* MISC;
    int tid, lane, wave, vcu, G;
};
__device__ __forceinline__ float wave_sum(float v) {
#pragma unroll
    for (int o = 1; o < 64; o <<= 1) v += __shfl_xor(v, o);
    return v;
}
__device__ __forceinline__ float bf2f(bf16 b) { return __uint_as_float((unsigned)b << 16); }
__device__ __forceinline__ unsigned cvtpk(float lo, float hi) { unsigned r; asm volatile("v_cvt_pk_bf16_f32 %0, %1, %2" : "=v"(r) : "v"(lo), "v"(hi)); return r; }

__device__ __forceinline__ void win_map(int nd, int& sc, float& cs) {
    cs = 1.f;
    if (nd < 512) sc = 512 + nd;
    else if (nd < 1024) sc = 2592 + (nd - 512);
    else if (nd < 1280) { sc = nd - 1024; cs = 0.125f; }
    else if (nd < 1536) sc = 256 + (nd - 1280);
    else if (nd < 2048) sc = 1024 + (nd - 1536);
    else if (nd < 3072) {
        const bool isq = nd < 2560; const int p = nd - (isq ? 2048 : 2560), h = p >> 7, pp = p & 127, u = pp >> 3, j = pp & 7;
        const int d = (j < 4) ? 4 * u + j : 64 + 4 * u + (j - 4);
        sc = (isq ? 1568 : 2080) + 128 * h + d; if (isq) cs = 0.08838834764831845f; }
    else if (nd < 3584) sc = 3104 + (nd - 3072);
    else sc = 1536 + (nd - 3584);
}
template <bool MAP>
__device__ __forceinline__ void p0_transpose_item(const float* W, int K, int Nsrc, int nblk, const float* ks, bf16* WT, LAS float* scr, int item, int lane) {
    const int kb = item / nblk, nb = item % nblk, k0 = 64 * kb, n0 = 32 * nb;
    int sc = n0 + (lane & 31); float cs = 1.f;
    if (MAP) win_map(n0 + (lane & 31), sc, cs);
#pragma unroll 8
    for (int i = 0; i < 32; ++i) { const int kk = 2 * i + (lane >> 5); float w = W[(size_t)(k0 + kk) * Nsrc + sc] * cs; if (ks) w *= ks[k0 + kk]; scr[kk * 33 + (lane & 31)] = w; }
    LDS_WAIT(); asm volatile("" ::: "memory");
    const int c = lane & 7;
#pragma unroll
    for (int j = 0; j < 4; ++j) { const int n = (lane >> 3) + 8 * j; const LAS float* s = scr + (8 * c) * 33 + n;
        v4u o; o.x = cvtpk(s[0 * 33], s[1 * 33]); o.y = cvtpk(s[2 * 33], s[3 * 33]); o.z = cvtpk(s[4 * 33], s[5 * 33]); o.w = cvtpk(s[6 * 33], s[7 * 33]);
        *(GAS v4u*)(WT + (size_t)(n0 + n) * K + k0 + 8 * c) = o; }
    LDS_WAIT(); asm volatile("" ::: "memory");
}
__device__ __forceinline__ void rope_entry(int e, float* rcos, float* rsin) {
    const int pos = e >> 6, i = e & 63;
    double inv = 1.0, b = 0.8659643233600653;
#pragma unroll
    for (int bit = 0; bit < 6; ++bit) { if ((i >> bit) & 1) inv *= b; b *= b; }
    const double ang = (double)pos * inv;
    const double n = __builtin_rint(ang * 0.6366197723675814);
    double r = __builtin_fma(-n, 1.5707963267948966, ang); r = __builtin_fma(-n, 6.123233995736766e-17, r);
    const double r2 = r * r;
    double s = -1.0 / 1307674368000.0;
    s = s * r2 + 1.0 / 6227020800.0; s = s * r2 - 1.0 / 39916800.0; s = s * r2 + 1.0 / 362880.0; s = s * r2 - 1.0 / 5040.0; s = s * r2 + 1.0 / 120.0; s = s * r2 - 1.0 / 6.0; s = s * r2 * r + r;
    double c = 1.0 / 20922789888000.0;
    c = c * r2 - 1.0 / 87178291200.0; c = c * r2 + 1.0 / 479001600.0; c = c * r2 - 1.0 / 3628800.0; c = c * r2 + 1.0 / 40320.0; c = c * r2 - 1.0 / 720.0; c = c * r2 + 1.0 / 24.0; c = c * r2 - 0.5; c = c * r2 + 1.0;
    const int q = ((int)n) & 3;
    const double cs = (q == 0) ? c : (q == 1) ? -s : (q == 2) ? -c : s;
    const double sn = (q == 0) ? s : (q == 1) ? c : (q == 2) ? -s : -c;
    rcos[e] = (float)cs; rsin[e] = (float)sn;
}
struct P0Args { const float *xp, *xs, *anw, *win, *wout, *mnw, *w1, *w2; bf16 *Win_t, *Wout_t, *W1_t, *W2_t, *Xb; float *rcos, *rsin, *ga, *rstd; };
__device__ __forceinline__ void p0_prologue(Frame& F, const P0Args& a, int parts = 3) {
    LAS float* scr = (LAS float*)(F.lds + RING_OFF + F.wave * 16384);
    const int gw = F.vcu * NWAVES + F.wave, NGW = F.G * NWAVES;
    constexpr int I_IN = (D / 64) * (NWIN / 32), I_O = (D / 64) * (D / 32), I_1 = (D / 64) * (FF / 32), I_2 = (FF / 64) * (D / 32);
    constexpr int NITEMS = I_IN + I_O + I_1 + I_2;
    if (parts & 1) for (int it = gw; it < NITEMS; it += NGW) {
        int r = it;
        if (r < I_IN) { p0_transpose_item<true>(a.win, D, NWIN, NWIN / 32, a.anw, a.Win_t, scr, r, F.lane); continue; } r -= I_IN;
        if (r < I_O) { p0_transpose_item<false>(a.wout, D, D, D / 32, nullptr, a.Wout_t, scr, r, F.lane); continue; } r -= I_O;
        if (r < I_1) { p0_transpose_item<false>(a.w1, D, FF, FF / 32, a.mnw, a.W1_t, scr, r, F.lane); continue; } r -= I_1;
        p0_transpose_item<false>(a.w2, FF, D, D / 32, nullptr, a.W2_t, scr, r, F.lane);
    }
    if (parts & 1) for (int e = (blockIdx.x * NWAVES * 64) + F.tid; e < 16384 * 64; e += F.G * NWAVES * 64) rope_entry(e, a.rcos, a.rsin);
    __syncthreads();
    LAS bf16* wl = (LAS bf16*)(F.lds + RING_OFF);
    for (int e = F.tid; e < 32 * 1024; e += NWAVES * 64) { const int k = e >> 5, c = e & 31; wl[c * 1032 + k] = (bf16)(cvtpk(a.win[(size_t)k * NWIN + 1536 + c] * a.anw[k], 0.f) & 0xffffu); }
    __syncthreads();
    const int r = F.lane & 15, g = F.lane >> 4;
    LAS unsigned char* tl = F.lds + RING_OFF + 66048 + F.wave * 8448;
    if (parts & 2) {
        f32x4 xa[16], xb[16];
#define P0_LOAD(dst, it_, kc_) do { const int r0_ = (it_) * 16; const float* xp_ = (r0_ < M_PROMPT ? a.xp + (size_t)r0_ * D : a.xs + (size_t)(r0_ - M_PROMPT) * D) + 4 * F.lane + 256 * (kc_); \
            _Pragma("unroll") for (int rr = 0; rr < 16; ++rr) dst[rr] = *(const GAS f32x4*)(xp_ + (size_t)rr * D); } while (0)
#define P0_PROC(src, kc_) do { \
            _Pragma("unroll") for (int rr = 0; rr < 16; ++rr) { unsigned long long pk = (unsigned long long)cvtpk(src[rr][0], src[rr][1]) | ((unsigned long long)cvtpk(src[rr][2], src[rr][3]) << 32); \
                *(LAS unsigned long long*)(tl + rr * 528 + F.lane * 8) = pk; *(GAS unsigned long long*)(xo + (size_t)rr * D + 256 * (kc_)) = pk; } \
            asm volatile("s_waitcnt lgkmcnt(0)" ::: "memory"); \
            _Pragma("unroll") for (int s8 = 0; s8 < 8; ++s8) { \
                const bf16x8 af = *(const LAS bf16x8*)(tl + r * 528 + 64 * s8 + 16 * g); \
                const int k0 = 256 * (kc_) + 32 * s8 + 8 * g; \
                const bf16x8 b0 = *(const LAS bf16x8*)(wl + r * 1032 + k0), b1 = *(const LAS bf16x8*)(wl + (16 + r) * 1032 + k0); \
                acc0 = __builtin_amdgcn_mfma_f32_16x16x32_bf16(af, b0, acc0, 0, 0, 0); acc1 = __builtin_amdgcn_mfma_f32_16x16x32_bf16(af, b1, acc1, 0, 0, 0); \
                const v4u aw = __builtin_bit_cast(v4u, af); \
                _Pragma("unroll") for (int j = 0; j < 4; ++j) { const unsigned u = ((const unsigned*)&aw)[j]; const float lo = __uint_as_float(u << 16), hi = __uint_as_float(u & 0xffff0000u); ss += lo * lo + hi * hi; } } \
            asm volatile("s_waitcnt lgkmcnt(0)" ::: "memory"); } while (0)
        if (gw < M_TOK / 16) P0_LOAD(xa, gw, 0);
        for (int item = gw; item < M_TOK / 16; item += NGW) {
            const int row0 = item * 16;
            bf16* xo = a.Xb + (size_t)row0 * D + 4 * F.lane;
            f32x4 acc0 = {0.f, 0.f, 0.f, 0.f}, acc1 = {0.f, 0.f, 0.f, 0.f}; float ss = 0.f;
            const int nitem = item + NGW < M_TOK / 16 ? item + NGW : item;
            P0_LOAD(xb, item, 1); __builtin_amdgcn_sched_barrier(0); P0_PROC(xa, 0); __builtin_amdgcn_sched_barrier(0);
            P0_LOAD(xa, item, 2); __builtin_amdgcn_sched_barrier(0); P0_PROC(xb, 1); __builtin_amdgcn_sched_barrier(0);
            P0_LOAD(xb, item, 3); __builtin_amdgcn_sched_barrier(0); P0_PROC(xa, 2); __builtin_amdgcn_sched_barrier(0);
            P0_LOAD(xa, nitem, 0); __builtin_amdgcn_sched_barrier(0); P0_PROC(xb, 3); __builtin_amdgcn_sched_barrier(0);
            ss += __shfl_xor(ss, 16); ss += __shfl_xor(ss, 32);
            const float rs = 1.0f / sqrtf(ss * (1.0f / 1024.0f) + EPS);
            if (g == 0) a.rstd[row0 + r] = rs;
#pragma unroll
            for (int q = 0; q < 4; ++q) { const int rr = 4 * g + q; const float rq = __shfl(rs, rr);
                a.ga[(size_t)(row0 + rr) * 32 + r] = acc0[q] * rq; a.ga[(size_t)(row0 + rr) * 32 + 16 + r] = acc1[q] * rq; }
        }
#undef P0_LOAD
#undef P0_PROC
    }
}

__device__ __forceinline__ float log_sigmoid_f(float z) { return fminf(z, 0.f) - log1pf(expf(-fabsf(z))); }
struct MixArgs { bf16* proj; const float* ga; const float *waf, *baf, *wab, *bab; float* of; const float *gnw, *rnw, *rnb; };
constexpr int NTB = 16;
template <int DK, bool GLA, bool BWD>
__device__ __forceinline__ void naive_sweep(Frame& F, const MixArgs& a, int job) {
    const int grp = F.tid >> 7, gt = F.tid & 127;
    int seq, head; if (job < 16) { seq = 32 + (job >> 3); head = job & 7; } else { seq = (job - 16) >> 3; head = (job - 16) & 7; }
    const int L = seq < 32 ? L_PROMPT : L_SAMPLE, row_base = seq < 32 ? seq * L_PROMPT : M_PROMPT + (seq - 32) * L_SAMPLE;
    const int hh = GLA ? head : head - 4;
    const int qcol = GLA ? 1024 + 64 * hh : 2048 + 128 * hh, kcol = GLA ? 1280 + 64 * hh : 2560 + 128 * hh, vcol = 128 * head;
    LAS float* sq = (LAS float*)(F.lds + grp * (3 * NTB * 128 * 4)); LAS float* sk = sq + NTB * DK; LAS float* sa = sk + NTB * DK;
    const float gam = 1.0f - exp2f(-5.0f - (float)hh);
    const float* wal = BWD ? a.wab : a.waf; const float* bal = BWD ? a.bab : a.baf;
    float S[DK];
#pragma unroll
    for (int t = 0; t < DK; ++t) S[t] = 0.f;
    for (int t0 = 0; t0 < L; t0 += NTB) {
        __syncthreads();
        for (int e = gt; e < NTB * DK; e += 128) {
            const int tok = e / DK, t = e % DK, tp = t0 + tok, row = row_base + (BWD ? L - 1 - tp : tp);
            const bf16* pr = a.proj + (size_t)row * NP;
            sq[e] = bf2f(pr[qcol + t]); sk[e] = bf2f(pr[kcol + t]);
            if (GLA) { const float* gar = a.ga + (size_t)row * 32 + (BWD ? 16 : 0); float z = bal[64 * hh + t];
#pragma unroll
                for (int r = 0; r < 16; ++r) z += gar[r] * wal[r * 256 + 64 * hh + t];
                sa[e] = expf(fmaxf(log_sigmoid_f(z) * (1.0f / 16.0f), -1.0f)); }
        }
        __syncthreads();
        for (int tok = 0; tok < NTB; ++tok) {
            const int tp = t0 + tok, row = row_base + (BWD ? L - 1 - tp : tp);
            const float vv = bf2f(a.proj[(size_t)row * NP + vcol + gt]);
            float o = 0.f;
#pragma unroll
            for (int t4 = 0; t4 < DK / 4; ++t4) {
                const f32x4 q = *(const LAS f32x4*)(sq + tok * DK + 4 * t4), k = *(const LAS f32x4*)(sk + tok * DK + 4 * t4);
                f32x4 al = {gam, gam, gam, gam}; if (GLA) al = *(const LAS f32x4*)(sa + tok * DK + 4 * t4);
#pragma unroll
                for (int j = 0; j < 4; ++j) {
                    if (!BWD) { S[4 * t4 + j] = al[j] * S[4 * t4 + j] + k[j] * vv; o += q[j] * S[4 * t4 + j]; }
                    else { S[4 * t4 + j] *= al[j]; o += q[j] * S[4 * t4 + j]; S[4 * t4 + j] += k[j] * vv; }
                }
            }
            float* op = a.of + (size_t)row * D + 128 * head + gt;
            if (!BWD) *op = o; else *op += o;
        }
    }
}
template <bool BWD>
__device__ __forceinline__ void naive_mix_phase(Frame& F, const MixArgs& a) {
    if (blockIdx.x >= 68) return;
    const int job = blockIdx.x * 4 + (F.tid >> 7);
    if ((blockIdx.x & 1) == 0) { if (!MIX_GLA) naive_sweep<64, true, BWD>(F, a, job); } else { if (!MIX_RET) naive_sweep<128, false, BWD>(F, a, job); }
}
__device__ __forceinline__ void naive_combine(Frame& F, const MixArgs& a) {
    const int gw = F.vcu * NWAVES + F.wave, NGW = F.G * NWAVES, c = 2 * F.lane;
    for (int item = gw; item < M_TOK * 8; item += NGW) {
        const int row = item >> 3, head = item & 7;
        if (head < 4 ? MIX_GLA : MIX_RET) continue;
        const float* op = a.of + (size_t)row * D + 128 * head + c;
        float o0 = op[0], o1 = op[1], y0, y1;
        if (head < 4) { const float r = 1.0f / sqrtf(wave_sum(o0 * o0 + o1 * o1) * (1.0f / 128.0f) + EPS); y0 = o0 * r * a.gnw[c]; y1 = o1 * r * a.gnw[c + 1]; }
        else { const float mu = wave_sum(o0 + o1) * (1.0f / 128.0f); o0 -= mu; o1 -= mu; const float r = 1.0f / sqrtf(wave_sum(o0 * o0 + o1 * o1) * (1.0f / 128.0f) + EPS);
            const int cc = 128 * (head - 4) + c; y0 = o0 * r * a.rnw[cc] + a.rnb[cc]; y1 = o1 * r * a.rnw[cc + 1] + a.rnb[cc + 1]; }
        bf16* pr = a.proj + (size_t)row * NP;
        const int gcol = (head < 4 ? 1536 + 128 * head : 3072 + 128 * (head - 4)) + c;
        const unsigned gw2 = *(const unsigned*)(pr + gcol);
        const float g0 = __uint_as_float(gw2 << 16), g1 = __uint_as_float(gw2 & 0xffff0000u);
        y0 *= g0 / (1.0f + expf(-g0)); y1 *= g1 / (1.0f + expf(-g1));
        *(unsigned*)(pr + 128 * head + c) = cvtpk(y0, y1);
    }
}
__device__ __forceinline__ void final_norm(Frame& F, float* out, const bf16* x2b, const float* sq, const float* w) {
    const int gw = F.vcu * NWAVES + F.wave, NGW = F.G * NWAVES;
    const f32x4* w4 = (const f32x4*)w + 2 * F.lane;
    f32x4 wv[2][2];
#pragma unroll
    for (int j = 0; j < 2; ++j) { wv[j][0] = w4[128 * j]; wv[j][1] = w4[128 * j + 1]; }
    for (int r0 = 4 * gw; r0 < M_TOK; r0 += 4 * NGW) {
        v4u xw[4][2]; f32x4 s4[4];
#pragma unroll
        for (int k = 0; k < 4; ++k) { const int row = r0 + k;
            s4[k] = *(const GAS f32x4*)(sq + (size_t)row * 16 + 4 * (F.lane & 3));
            const GAS v4u* xi = (const GAS v4u*)(x2b + (size_t)row * D) + F.lane;
            xw[k][0] = xi[0]; xw[k][1] = xi[64]; }
#pragma unroll
        for (int k = 0; k < 4; ++k) { const int row = r0 + k;
            float t = (s4[k][0] + s4[k][1]) + (s4[k][2] + s4[k][3]); t += __shfl_xor(t, 1); t += __shfl_xor(t, 2);
            const float r = 1.0f / sqrtf(t * (1.0f / 1024.0f) + EPS);
            GAS f32x4* o = (GAS f32x4*)(out + (size_t)row * D) + 2 * F.lane;
#pragma unroll
            for (int j = 0; j < 2; ++j) { const v4u x = xw[k][j];
                const f32x4 x0 = {__uint_as_float(x.x << 16), __uint_as_float(x.x & 0xffff0000u), __uint_as_float(x.y << 16), __uint_as_float(x.y & 0xffff0000u)};
                const f32x4 x1 = {__uint_as_float(x.z << 16), __uint_as_float(x.z & 0xffff0000u), __uint_as_float(x.w << 16), __uint_as_float(x.w & 0xffff0000u)};
                o[128 * j] = x0 * r * wv[j][0]; o[128 * j + 1] = x1 * r * wv[j][1]; } }
    }
}

typedef __bf16 bf16v2 __attribute__((ext_vector_type(2)));
typedef unsigned u32x2 __attribute__((ext_vector_type(2)));
__device__ __forceinline__ unsigned cvtpk_c(float lo, float hi) { bf16v2 v = {(__bf16)lo, (__bf16)hi}; return __builtin_bit_cast(unsigned, v); }
__device__ __forceinline__ float bflo(unsigned w) { return __uint_as_float(w << 16); }
__device__ __forceinline__ float bfhi(unsigned w) { return __uint_as_float(w & 0xffff0000u); }
__device__ __forceinline__ int opaque_i(int x) { asm volatile("" : "+v"(x)); return x; }
typedef short s16x4 __attribute__((ext_vector_type(4)));
#define TRRD(ptr) __builtin_amdgcn_ds_read_tr16_b64_v4i16((LAS s16x4*)(ptr))
constexpr size_t ST_SC_BYTES = 393216;
__device__ __forceinline__ size_t state_off(int sc, bool gla, int hh, int dir) { return (size_t)sc * ST_SC_BYTES + (gla ? (size_t)(hh * 2 + dir) * 16384 : (size_t)131072 + (size_t)(hh * 2 + dir) * 32768); }
struct CMixArgs { bf16* proj; const float* ga; const float *waf, *baf, *wab, *bab; unsigned char* st; float* dec; const float *gnw, *rnw, *rnb; bf16* mo; int mop; unsigned char* sto; unsigned char* ofs; float* bb0; float* bb1; float* gv; };
constexpr int OB_PITCH = 132;

template <bool GLA> struct RawSet;
template <> struct RawSet<true> { v4u q, k, v0, v1; f32x4 b0, b1, l0, l1; };
template <> struct RawSet<false> { v4u q0, q1, k0, k1, v0, v1; };

template <bool GLA, bool WITH_O>
__device__ __forceinline__ void raw_load(RawSet<GLA>& R, const CMixArgs& a, int p, int s, int w, int lane0) {
    const int lane = opaque_i(lane0), sc = p >> 2, hh = p & 3, dir = s >> 2, c = dir ? 7 - s : s;
    const size_t row = (size_t)(sc * 256 + 64 * c + 8 * w + (lane >> 3)); const int pc = lane & 7;
    if constexpr (GLA) {
        if (WITH_O) R.q = *(const GAS v4u*)(a.proj + pg8::PL_GQ + (hh * pg8::MTOK + row) * 64 + 8 * pc);
        R.k = *(const GAS v4u*)(a.proj + pg8::PL_GK + (hh * pg8::MTOK + row) * 64 + 8 * pc);
        const bf16* pv = a.proj + pg8::PL_GV + (hh * pg8::MTOK + row) * 128 + 8 * pc;
        R.v0 = *(const GAS v4u*)pv; R.v1 = *(const GAS v4u*)(pv + 64);
        const float* bp = (dir ? a.bb1 : a.bb0) + ((size_t)(p * 4 + c) * 64) * 64 + 8 * pc;
        const int ti = 8 * w + (lane >> 3);
        R.b0 = *(const GAS f32x4*)(bp + ti * 64); R.b1 = *(const GAS f32x4*)(bp + ti * 64 + 4);
        R.l0 = *(const GAS f32x4*)(bp + (dir ? 0 : 63) * 64); R.l1 = *(const GAS f32x4*)(bp + (dir ? 0 : 63) * 64 + 4);
    } else {
        if (WITH_O) { const bf16* pq = a.proj + pg8::PL_RQ + (hh * pg8::MTOK + row) * 128 + 8 * pc; R.q0 = *(const GAS v4u*)pq; R.q1 = *(const GAS v4u*)(pq + 64); }
        const bf16* pk = a.proj + pg8::PL_RK + (hh * pg8::MTOK + row) * 128 + 8 * pc; R.k0 = *(const GAS v4u*)pk; R.k1 = *(const GAS v4u*)(pk + 64);
        const bf16* pv = a.proj + pg8::PL_RV + (hh * pg8::MTOK + row) * 128 + 8 * pc; R.v0 = *(const GAS v4u*)pv; R.v1 = *(const GAS v4u*)(pv + 64);
    }
}

template <int DK, bool GLA, bool WITH_O> struct MixLds {
    static constexpr int NT = DK / 16, NS = DK / 32;
    static constexpr int RQ = DK * 2 + 16, RP = 144, RV = 272;
    static constexpr int O_QD = 0, O_KI = 64 * RQ, O_KE = 2 * 64 * RQ, O_PB = 3 * 64 * RQ, O_VB = O_PB + 64 * RP, O_DC = O_VB + 64 * RV, O_WAL = O_DC + DK * 4,
                         O_OB = O_WAL, O_END = O_OB + 64 * OB_PITCH * 4;
    static_assert(O_END <= 146432, "mixer LDS map");
};

template <int DK, bool GLA, bool WITH_O>
__device__ __forceinline__ void mix_step(Frame& F, const CMixArgs& a, int p, int s, int pnext, RawSet<GLA>& R, f32x4 (&S)[DK / 16], float (&dsum)[8], u32x2 (&ofp)[4][4]) {
    typedef MixLds<DK, GLA, WITH_O> ML;
    constexpr int NT = ML::NT, NS = ML::NS, RQ = ML::RQ, RP = ML::RP, RV = ML::RV;
    LAS unsigned char* L = F.lds;
    const int lane0 = F.lane, w = F.wave;
    const int sc = p >> 2, hh = p & 3, dir = s >> 2, c = dir ? 7 - s : s, row0 = sc * 256, head = GLA ? hh : 4 + hh, vcol = 128 * head;
    __syncthreads();
    {
        const int lane = opaque_i(lane0), i = 8 * w + (lane >> 3), pc = lane & 7;
        *(LAS v4u*)(L + ML::O_VB + i * RV + 16 * pc) = R.v0; *(LAS v4u*)(L + ML::O_VB + i * RV + 128 + 16 * pc) = R.v1;
        if constexpr (GLA) {
            const int tk = lane >> 3;
            float q8[8], k8[8], e8[8];
#pragma unroll
            for (int e = 0; e < 8; ++e) { const float b = e < 4 ? R.b0[e & 3] : R.b1[e & 3], bl_ = e < 4 ? R.l0[e & 3] : R.l1[e & 3];
                const unsigned wq = WITH_O ? ((const unsigned*)&R.q)[e >> 1] : 0u, wk = ((const unsigned*)&R.k)[e >> 1];
                const float qv = (e & 1) ? bfhi(wq) : bflo(wq), kv = (e & 1) ? bfhi(wk) : bflo(wk);
                q8[e] = qv * __expf(b); k8[e] = kv * __expf(-b); e8[e] = kv * __expf(bl_ - b);
                if (!WITH_O) dsum[e] += bl_;
                if (w == 0 && tk == 0) ((LAS float*)(L + ML::O_DC))[8 * pc + e] = __expf(bl_); }
            v4u oq, ok, oe;
            oq.x = cvtpk_c(q8[0], q8[1]); oq.y = cvtpk_c(q8[2], q8[3]); oq.z = cvtpk_c(q8[4], q8[5]); oq.w = cvtpk_c(q8[6], q8[7]);
            ok.x = cvtpk_c(k8[0], k8[1]); ok.y = cvtpk_c(k8[2], k8[3]); ok.z = cvtpk_c(k8[4], k8[5]); ok.w = cvtpk_c(k8[6], k8[7]);
            oe.x = cvtpk_c(e8[0], e8[1]); oe.y = cvtpk_c(e8[2], e8[3]); oe.z = cvtpk_c(e8[4], e8[5]); oe.w = cvtpk_c(e8[6], e8[7]);
            if (WITH_O) { *(LAS v4u*)(L + ML::O_QD + i * RQ + 16 * pc) = oq; *(LAS v4u*)(L + ML::O_KI + i * RQ + 16 * pc) = ok; }
            *(LAS v4u*)(L + ML::O_KE + i * RQ + 16 * pc) = oe;
        } else {
            const float l2g = hh == 0 ? -0.045803689613124f : hh == 1 ? -0.022720076500083f : hh == 2 ? -0.011315313227834f : -0.005646563141142f;
            const float nq = dir ? (float)(64 - i) : (float)(i + 1), ne = dir ? (float)i : (float)(63 - i);
            const float eb = exp2f(l2g * nq), ei = exp2f(-l2g * nq), ee = exp2f(l2g * ne);
#pragma unroll
            for (int x = 0; x < 2; ++x) { v4u oq, ok, oe; const v4u rq = x ? R.q1 : R.q0, rk = x ? R.k1 : R.k0;
#pragma unroll
                for (int j = 0; j < 4; ++j) { const unsigned wq = WITH_O ? ((const unsigned*)&rq)[j] : 0u, wk = ((const unsigned*)&rk)[j];
                    ((unsigned*)&oq)[j] = cvtpk_c(bflo(wq) * eb, bfhi(wq) * eb); ((unsigned*)&ok)[j] = cvtpk_c(bflo(wk) * ei, bfhi(wk) * ei); ((unsigned*)&oe)[j] = cvtpk_c(bflo(wk) * ee, bfhi(wk) * ee); }
                if (WITH_O) { *(LAS v4u*)(L + ML::O_QD + i * RQ + 128 * x + 16 * pc) = oq; *(LAS v4u*)(L + ML::O_KI + i * RQ + 128 * x + 16 * pc) = ok; }
                *(LAS v4u*)(L + ML::O_KE + i * RQ + 128 * x + 16 * pc) = oe; }
            if (w == 0 && lane < 32) *(LAS f32x4*)(L + ML::O_DC + lane * 16) = (f32x4){exp2f(l2g * 64.0f), exp2f(l2g * 64.0f), exp2f(l2g * 64.0f), exp2f(l2g * 64.0f)};
        }
    }
    v4u gt0, gt1; f32x4 nw[4], nb[4];
    if (WITH_O) { const int lane = opaque_i(lane0);
        const bf16* gp = a.proj + (GLA ? pg8::PL_GG : pg8::PL_RG) + (dir ? (hh * pg8::MTOK + (size_t)(row0 + 64 * c + 8 * w + (lane >> 3))) * 128 + 16 * (lane & 7) : (size_t)0);
        gt0 = *(const GAS v4u*)gp; gt1 = *(const GAS v4u*)(gp + 8);
        const float* wp = GLA ? a.gnw + 16 * (lane & 7) : a.rnw + 128 * hh + 16 * (lane & 7);
#pragma unroll
        for (int k = 0; k < 4; ++k) { nw[k] = *(const GAS f32x4*)(wp + 4 * k); if (!GLA) nb[k] = *(const GAS f32x4*)(a.rnb + 128 * hh + 16 * (lane & 7) + 4 * k); } }
    raw_load<GLA, WITH_O>(R, a, s < 6 ? p : (pnext < 1536 ? pnext : p), s < 6 ? s + 2 : s - 6, w, lane0);
    __syncthreads();
    if (WITH_O) {
        const int lane = opaque_i(lane0), g = lane >> 4, lr = lane & 15;
        const int mi = w >> 1;
        bf16x8 kf[2][NS], qf2[NS];
#pragma unroll
        for (int s2 = 0; s2 < NS; ++s2) { qf2[s2] = *(const LAS bf16x8*)(L + ML::O_QD + (16 * mi + lr) * RQ + 64 * s2 + 16 * g);
#pragma unroll
            for (int jj = 0; jj < 2; ++jj) kf[jj][s2] = *(const LAS bf16x8*)(L + ML::O_KI + (16 * (2 * (w & 1) + jj) + lr) * RQ + 64 * s2 + 16 * g); }
        __builtin_amdgcn_sched_barrier(0);
#pragma unroll
        for (int jj = 0; jj < 2; ++jj) { const int nj = 2 * (w & 1) + jj;
            f32x4 acc = {0.f, 0.f, 0.f, 0.f};
#pragma unroll
            for (int s2 = 0; s2 < NS; ++s2) acc = __builtin_amdgcn_mfma_f32_16x16x32_bf16(kf[jj][s2], qf2[s2], acc, 0, 0, 0);
            const int ii = 16 * mi + lr;
#pragma unroll
            for (int r = 0; r < 4; ++r) { const int j = 16 * nj + 4 * g + r; const bool keep = dir ? (j > ii) : (j <= ii); acc[r] = keep ? acc[r] : 0.f; }
            u32x2 pk; pk.x = cvtpk_c(acc[0], acc[1]); pk.y = cvtpk_c(acc[2], acc[3]);
            *(LAS u32x2*)(L + ML::O_PB + ii * RP + 32 * nj + 8 * g) = pk; }
        __syncthreads();
    }
    f32x4 o[4];
    {
        const int lane = opaque_i(lane0), g = lane >> 4, lr = lane & 15, q4 = lr >> 2, p4 = lr & 3;
        const LAS unsigned char* vb = L + ML::O_VB + (8 * g + q4) * RV + 32 * w + 8 * p4;
        const bf16x8 vf0 = __builtin_shufflevector(TRRD(vb), TRRD(vb + 4 * RV), 0, 1, 2, 3, 4, 5, 6, 7), vf1 = __builtin_shufflevector(TRRD(vb + 32 * RV), TRRD(vb + 36 * RV), 0, 1, 2, 3, 4, 5, 6, 7);
        if (WITH_O) {
            { bf16x8 pf[4][2];
#pragma unroll
              for (int m = 0; m < 4; ++m) { pf[m][0] = *(const LAS bf16x8*)(L + ML::O_PB + (16 * m + lr) * RP + 16 * g); pf[m][1] = *(const LAS bf16x8*)(L + ML::O_PB + (16 * m + lr) * RP + 64 + 16 * g); }
              __builtin_amdgcn_sched_barrier(0);
#pragma unroll
              for (int m = 0; m < 4; ++m) { o[m] = __builtin_amdgcn_mfma_f32_16x16x32_bf16(pf[m][0], vf0, (f32x4){0.f, 0.f, 0.f, 0.f}, 0, 0, 0); o[m] = __builtin_amdgcn_mfma_f32_16x16x32_bf16(pf[m][1], vf1, o[m], 0, 0, 0); }
              __builtin_amdgcn_sched_barrier(0); }
#pragma unroll
            for (int sh = 0; sh < NS / 2; ++sh) {
                u32x2 ql[2][4][2];
#pragma unroll
                for (int x = 0; x < 2; ++x)
#pragma unroll
                    for (int m = 0; m < 4; ++m) { ql[x][m][0] = *(const LAS u32x2*)(L + ML::O_QD + (16 * m + lr) * RQ + 64 * (2 * sh + x) + 8 * g); ql[x][m][1] = *(const LAS u32x2*)(L + ML::O_QD + (16 * m + lr) * RQ + 64 * (2 * sh + x) + 32 + 8 * g); }
                __builtin_amdgcn_sched_barrier(0);
#pragma unroll
                for (int x = 0; x < 2; ++x) { const int s2 = 2 * sh + x;
                    const bf16x8 sf = __builtin_bit_cast(bf16x8, (v4u){cvtpk_c(S[2 * s2][0], S[2 * s2][1]), cvtpk_c(S[2 * s2][2], S[2 * s2][3]), cvtpk_c(S[2 * s2 + 1][0], S[2 * s2 + 1][1]), cvtpk_c(S[2 * s2 + 1][2], S[2 * s2 + 1][3])});
#pragma unroll
                    for (int m = 0; m < 4; ++m) o[m] = __builtin_amdgcn_mfma_f32_16x16x32_bf16(__builtin_bit_cast(bf16x8, (v4u){ql[x][m][0].x, ql[x][m][0].y, ql[x][m][1].x, ql[x][m][1].y}), sf, o[m], 0, 0, 0); }
                __builtin_amdgcn_sched_barrier(0);
            }
        }
#pragma unroll
        for (int th = 0; th < NT / 4; ++th) {
            f32x4 d4[4]; bf16x8 kf0[4], kf1[4];
#pragma unroll
            for (int x = 0; x < 4; ++x) { const int tt = 4 * th + x;
                d4[x] = *(const LAS f32x4*)(L + ML::O_DC + (16 * tt + 4 * g) * 4);
                const LAS unsigned char* kb = L + ML::O_KE + (8 * g + q4) * RQ + 32 * tt + 8 * p4;
                kf0[x] = __builtin_shufflevector(TRRD(kb), TRRD(kb + 4 * RQ), 0, 1, 2, 3, 4, 5, 6, 7); kf1[x] = __builtin_shufflevector(TRRD(kb + 32 * RQ), TRRD(kb + 36 * RQ), 0, 1, 2, 3, 4, 5, 6, 7); }
            __builtin_amdgcn_sched_barrier(0);
#pragma unroll
            for (int x = 0; x < 4; ++x) { const int tt = 4 * th + x;
                S[tt] = S[tt] * d4[x];
                S[tt] = __builtin_amdgcn_mfma_f32_16x16x32_bf16(kf0[x], vf0, S[tt], 0, 0, 0);
                S[tt] = __builtin_amdgcn_mfma_f32_16x16x32_bf16(kf1[x], vf1, S[tt], 0, 0, 0); }
            __builtin_amdgcn_sched_barrier(0);
        }
    }
    if (WITH_O) {
        const int lane = opaque_i(lane0), g = lane >> 4, lr = lane & 15;
        if (dir == 0) {
#pragma unroll
            for (int cc = 0; cc < 4; ++cc) if (cc == c) {
#pragma unroll
                for (int m = 0; m < 4; ++m) { ofp[cc][m].x = cvtpk_c(o[m][0], o[m][1]); ofp[cc][m].y = cvtpk_c(o[m][2], o[m][3]); } }
        } else {
            u32x2 ofr[4];
#pragma unroll
            for (int cc = 0; cc < 4; ++cc) if (cc == c) {
#pragma unroll
                for (int m = 0; m < 4; ++m) ofr[m] = ofp[cc][m]; }
            LAS float* ob = (LAS float*)(L + ML::O_OB);
#pragma unroll
            for (int m = 0; m < 4; ++m) { const f32x4 t = {o[m][0] + bflo(ofr[m].x), o[m][1] + bfhi(ofr[m].x), o[m][2] + bflo(ofr[m].y), o[m][3] + bfhi(ofr[m].y)};
#pragma unroll
                for (int r = 0; r < 4; ++r) ob[(16 * m + 4 * g + r) * OB_PITCH + 16 * w + lr] = t[r]; }
            __syncthreads();
            const int row = 8 * w + (lane >> 3), pc = lane & 7;
            f32x4 x[4];
#pragma unroll
            for (int k = 0; k < 4; ++k) x[k] = *(const LAS f32x4*)(ob + row * OB_PITCH + 16 * pc + 4 * k);
            float rs;
            if (GLA) { float ss = 0.f;
#pragma unroll
                for (int k = 0; k < 4; ++k) ss += (x[k][0] * x[k][0] + x[k][1] * x[k][1]) + (x[k][2] * x[k][2] + x[k][3] * x[k][3]);
                ss += __shfl_xor(ss, 1); ss += __shfl_xor(ss, 2); ss += __shfl_xor(ss, 4);
                rs = __builtin_amdgcn_rsqf(ss * (1.0f / 128.0f) + EPS); }
            else { float sm = 0.f;
#pragma unroll
                for (int k = 0; k < 4; ++k) sm += (x[k][0] + x[k][1]) + (x[k][2] + x[k][3]);
                sm += __shfl_xor(sm, 1); sm += __shfl_xor(sm, 2); sm += __shfl_xor(sm, 4);
                const float mu = sm * (1.0f / 128.0f); float ss = 0.f;
#pragma unroll
                for (int k = 0; k < 4; ++k) { x[k] = x[k] - mu; ss += (x[k][0] * x[k][0] + x[k][1] * x[k][1]) + (x[k][2] * x[k][2] + x[k][3] * x[k][3]); }
                ss += __shfl_xor(ss, 1); ss += __shfl_xor(ss, 2); ss += __shfl_xor(ss, 4);
                rs = __builtin_amdgcn_rsqf(ss * (1.0f / 128.0f) + EPS); }
            unsigned ow[8];
#pragma unroll
            for (int k = 0; k < 4; ++k) { f32x4 y = x[k] * rs * nw[k];
                if (!GLA) y = y + nb[k];
                const unsigned ga_ = k < 2 ? ((const unsigned*)&gt0)[2 * k] : ((const unsigned*)&gt1)[2 * k - 4], gb_ = k < 2 ? ((const unsigned*)&gt0)[2 * k + 1] : ((const unsigned*)&gt1)[2 * k - 3];
                const float g0 = bflo(ga_), g1 = bfhi(ga_), g2 = bflo(gb_), g3 = bfhi(gb_);
                y[0] *= g0 * __builtin_amdgcn_rcpf(1.0f + __expf(-g0)); y[1] *= g1 * __builtin_amdgcn_rcpf(1.0f + __expf(-g1));
                y[2] *= g2 * __builtin_amdgcn_rcpf(1.0f + __expf(-g2)); y[3] *= g3 * __builtin_amdgcn_rcpf(1.0f + __expf(-g3));
                ow[2 * k] = cvtpk_c(y[0], y[1]); ow[2 * k + 1] = cvtpk_c(y[2], y[3]); }
            bf16* op = a.mo + (size_t)(row0 + 64 * c + row) * a.mop + vcol + 16 * pc;
            *(GAS v4u*)op = (v4u){ow[0], ow[1], ow[2], ow[3]}; *(GAS v4u*)(op + 8) = (v4u){ow[4], ow[5], ow[6], ow[7]};
        }
    }
}


__device__ __forceinline__ void gla_b_stage(Frame& F, const CMixArgs& a, int p) {
    const int sc = p >> 2, hh = p & 3, w = F.wave;
    LAS float* gl = (LAS float*)F.lds;
    __syncthreads();
    { const int tid = opaque_i(F.tid);
#pragma unroll
      for (int x = 0; x < 4; ++x) *(LAS f32x4*)(gl + 4 * (tid + 512 * x)) = *(const GAS f32x4*)(a.ga + (size_t)sc * 256 * 32 + 4 * (tid + 512 * x)); }
    __syncthreads();
    const int t = opaque_i(F.lane), dir = w >> 2, c = w & 3;
    const float* wa = (dir ? a.wab : a.waf) + 64 * hh + t;
    float wv[16];
#pragma unroll
    for (int r = 0; r < 16; ++r) wv[r] = wa[r * 256];
    const float bias = (dir ? a.bab : a.baf)[64 * hh + t];
    float* bp = (dir ? a.bb1 : a.bb0) + ((size_t)(p * 4 + c) * 64) * 64;
    LAS float* tb = gl + 8192 + w * (16 * 68);
    float acc = 0.f;
#pragma unroll 1
    for (int k16 = 0; k16 < 64; k16 += 16) {
#pragma unroll 1
        for (int k4 = k16; k4 < k16 + 16; k4 += 4) {
            f32x4 gv[4][4];
#pragma unroll
            for (int j = 0; j < 4; ++j) { const int i = dir ? 63 - (k4 + j) : k4 + j; const LAS float* gr = gl + (64 * c + i) * 32 + 16 * dir;
#pragma unroll
                for (int x = 0; x < 4; ++x) gv[j][x] = *(const LAS f32x4*)(gr + 4 * x); }
            __builtin_amdgcn_sched_barrier(0);
#pragma unroll
            for (int j = 0; j < 4; ++j) {
                float z = bias;
#pragma unroll
                for (int r = 0; r < 16; ++r) z += gv[j][r >> 2][r & 3] * wv[r];
                const float ls = fminf(z, 0.f) - __logf(1.0f + __expf(-fabsf(z)));
                acc += fmaxf(ls * (1.0f / 16.0f), -1.0f);
                tb[(k4 - k16 + j) * 68 + t] = acc; }
        }
#pragma unroll
        for (int x = 0; x < 4; ++x) { const int kk = 4 * x + (t >> 4), i = dir ? 63 - (k16 + kk) : k16 + kk;
            *(GAS f32x4*)(bp + i * 64 + 4 * (t & 15)) = *(const LAS f32x4*)(tb + kk * 68 + 4 * (t & 15)); }
    }
    LAS float* tot = gl + 8192 + 8 * (16 * 68);
    tot[w * 64 + t] = acc;
    __syncthreads();
    { float gsum = 0.f;
#pragma unroll
      for (int cc = 0; cc < 4; ++cc) { const float v = tot[(dir * 4 + cc) * 64 + t]; if (dir ? (cc <= c) : (cc >= c)) gsum += v; }
      a.gv[((size_t)(p * 2 + dir) * 4 + c) * 64 + t] = gsum;
      if (c == (dir ? 3 : 0)) a.dec[(size_t)((sc * 4 + hh) * 2 + dir) * 64 + t] = __expf(gsum); }
}

template <int DK, bool GLA, bool WITH_O>
__device__ __forceinline__ void mix_units(Frame& F, const CMixArgs& a) {
    typedef MixLds<DK, GLA, WITH_O> ML;
    constexpr int NT = DK / 16;
    const int w = F.wave, lane0 = F.lane;
    int p = (int)blockIdx.x;
    if (p >= 1536) return;
    RawSet<GLA> RA, RB;
    raw_load<GLA, WITH_O>(RA, a, p, 0, w, lane0); raw_load<GLA, WITH_O>(RB, a, p, 1, w, lane0);
    f32x4 S[NT]; float dsum[8]; u32x2 ofp[4][4];
#pragma unroll 1
    for (; p < 1536; p += F.G) {
        const int sc = p >> 2, hh = p & 3, pnext = p + F.G;
#pragma unroll 1
        for (int dir = 0; dir < 2; ++dir) {
            const int lane = opaque_i(lane0);
            unsigned char* sp = a.st + state_off(sc, GLA, hh, dir) + (size_t)(unsigned)(w * NT * 512 + lane * 8);
            if (WITH_O) {
#pragma unroll
                for (int tt = 0; tt < NT; ++tt) { const u32x2 pk = *(const GAS u32x2*)(sp + tt * 512); S[tt] = (f32x4){bflo(pk.x), bfhi(pk.x), bflo(pk.y), bfhi(pk.y)}; } }
            else {
#pragma unroll
                for (int tt = 0; tt < NT; ++tt) S[tt] = (f32x4){0.f, 0.f, 0.f, 0.f};
#pragma unroll
                for (int e = 0; e < 8; ++e) dsum[e] = 0.f; }
#pragma unroll 1
            for (int h2 = 0; h2 < 2; ++h2) {
                mix_step<DK, GLA, WITH_O>(F, a, p, 4 * dir + 2 * h2, pnext, RA, S, dsum, ofp);
                mix_step<DK, GLA, WITH_O>(F, a, p, 4 * dir + 2 * h2 + 1, pnext, RB, S, dsum, ofp);
            }
            if (!WITH_O) {
#pragma unroll
                for (int tt = 0; tt < NT; ++tt) { u32x2 pk; pk.x = cvtpk_c(S[tt][0], S[tt][1]); pk.y = cvtpk_c(S[tt][2], S[tt][3]); *(GAS u32x2*)(sp + tt * 512) = pk; }
                if (GLA && w == 0 && lane < 8) { float* dp = a.dec + (size_t)((sc * 4 + hh) * 2 + dir) * 64 + 8 * lane;
#pragma unroll
                    for (int e = 0; e < 8; ++e) dp[e] = __expf(dsum[e]); }
            }
        }
    }
}

template <bool GLA> struct KvRaw;
template <> struct KvRaw<true> { v4u k, v0, v1; f32x4 bf0, bf1, bb0, bb1, gf0, gf1, gb0, gb1; };
template <> struct KvRaw<false> { v4u k0, k1, v0, v1; };
template <bool GLA>
__device__ __forceinline__ void kv_load(KvRaw<GLA>& R, const CMixArgs& a, int p, int c, int w, int lane0) {
    const int lane = opaque_i(lane0), sc = p >> 2, hh = p & 3, pc = lane & 7, ti = 8 * w + (lane >> 3);
    const size_t row = (size_t)(sc * 256 + 64 * c + ti);
    if constexpr (GLA) {
        R.k = *(const GAS v4u*)(a.proj + pg8::PL_GK + (hh * pg8::MTOK + row) * 64 + 8 * pc);
        const bf16* pv = a.proj + pg8::PL_GV + (hh * pg8::MTOK + row) * 128 + 8 * pc; R.v0 = *(const GAS v4u*)pv; R.v1 = *(const GAS v4u*)(pv + 64);
        const float* b0 = a.bb0 + ((size_t)(p * 4 + c) * 64 + ti) * 64 + 8 * pc; const float* b1 = a.bb1 + ((size_t)(p * 4 + c) * 64 + ti) * 64 + 8 * pc;
        R.bf0 = *(const GAS f32x4*)b0; R.bf1 = *(const GAS f32x4*)(b0 + 4); R.bb0 = *(const GAS f32x4*)b1; R.bb1 = *(const GAS f32x4*)(b1 + 4);
        const float* g0 = a.gv + ((size_t)(p * 2 + 0) * 4 + c) * 64 + 8 * pc; const float* g1 = a.gv + ((size_t)(p * 2 + 1) * 4 + c) * 64 + 8 * pc;
        R.gf0 = *(const GAS f32x4*)g0; R.gf1 = *(const GAS f32x4*)(g0 + 4); R.gb0 = *(const GAS f32x4*)g1; R.gb1 = *(const GAS f32x4*)(g1 + 4);
    } else {
        const bf16* pk = a.proj + pg8::PL_RK + (hh * pg8::MTOK + row) * 128 + 8 * pc; R.k0 = *(const GAS v4u*)pk; R.k1 = *(const GAS v4u*)(pk + 64);
        const bf16* pv = a.proj + pg8::PL_RV + (hh * pg8::MTOK + row) * 128 + 8 * pc; R.v0 = *(const GAS v4u*)pv; R.v1 = *(const GAS v4u*)(pv + 64);
    }
}
template <int DK, bool GLA>
__device__ __forceinline__ void kv_step(Frame& F, const CMixArgs& a, int p, int c, int pnext, KvRaw<GLA>& R, f32x4 (&Sf)[DK / 16], f32x4 (&Sb)[DK / 16]) {
    constexpr int NT = DK / 16, RQ = DK * 2 + 16, RV = 272, O_KF = 0, O_KB = 64 * RQ, O_VB = 2 * 64 * RQ;
    LAS unsigned char* L = F.lds;
    const int lane0 = F.lane, w = F.wave, hh = p & 3;
    __syncthreads();
    { const int lane = opaque_i(lane0), i = 8 * w + (lane >> 3), pc = lane & 7;
      *(LAS v4u*)(L + O_VB + i * RV + 16 * pc) = R.v0; *(LAS v4u*)(L + O_VB + i * RV + 128 + 16 * pc) = R.v1;
      if constexpr (GLA) {
          float f8[8], b8[8];
#pragma unroll
          for (int e = 0; e < 8; ++e) { const unsigned wk = ((const unsigned*)&R.k)[e >> 1]; const float kv = (e & 1) ? bfhi(wk) : bflo(wk);
              const float xf = (e < 4 ? R.gf0[e & 3] : R.gf1[e & 3]) - (e < 4 ? R.bf0[e & 3] : R.bf1[e & 3]), xb = (e < 4 ? R.gb0[e & 3] : R.gb1[e & 3]) - (e < 4 ? R.bb0[e & 3] : R.bb1[e & 3]);
              f8[e] = kv * __expf(xf); b8[e] = kv * __expf(xb); }
          *(LAS v4u*)(L + O_KF + i * RQ + 16 * pc) = (v4u){cvtpk_c(f8[0], f8[1]), cvtpk_c(f8[2], f8[3]), cvtpk_c(f8[4], f8[5]), cvtpk_c(f8[6], f8[7])};
          *(LAS v4u*)(L + O_KB + i * RQ + 16 * pc) = (v4u){cvtpk_c(b8[0], b8[1]), cvtpk_c(b8[2], b8[3]), cvtpk_c(b8[4], b8[5]), cvtpk_c(b8[6], b8[7])};
      } else {
          const float l2g = hh == 0 ? -0.045803689613124f : hh == 1 ? -0.022720076500083f : hh == 2 ? -0.011315313227834f : -0.005646563141142f;
          const float j = (float)(64 * c + i), ef = __builtin_amdgcn_exp2f(l2g * (255.0f - j)), eb = __builtin_amdgcn_exp2f(l2g * j);
#pragma unroll
          for (int x = 0; x < 2; ++x) { const v4u rk = x ? R.k1 : R.k0; v4u of, ob;
#pragma unroll
              for (int q = 0; q < 4; ++q) { const unsigned wk = ((const unsigned*)&rk)[q]; ((unsigned*)&of)[q] = cvtpk_c(bflo(wk) * ef, bfhi(wk) * ef); ((unsigned*)&ob)[q] = cvtpk_c(bflo(wk) * eb, bfhi(wk) * eb); }
              *(LAS v4u*)(L + O_KF + i * RQ + 128 * x + 16 * pc) = of; *(LAS v4u*)(L + O_KB + i * RQ + 128 * x + 16 * pc) = ob; }
      } }
    kv_load<GLA>(R, a, c < 2 ? p : (pnext < 1536 ? pnext : p), (c + 2) & 3, w, lane0);
    __syncthreads();
    { const int lane = opaque_i(lane0), g = lane >> 4, lr = lane & 15, q4 = lr >> 2, p4 = lr & 3;
      const LAS unsigned char* vb = L + O_VB + (8 * g + q4) * RV + 32 * w + 8 * p4;
      const bf16x8 vf0 = __builtin_shufflevector(TRRD(vb), TRRD(vb + 4 * RV), 0, 1, 2, 3, 4, 5, 6, 7), vf1 = __builtin_shufflevector(TRRD(vb + 32 * RV), TRRD(vb + 36 * RV), 0, 1, 2, 3, 4, 5, 6, 7);
#pragma unroll
      for (int th = 0; th < NT / 4; ++th) {
          bf16x8 kf0[4], kf1[4], kb0[4], kb1[4];
#pragma unroll
          for (int x = 0; x < 4; ++x) { const int tt = 4 * th + x;
              const LAS unsigned char* ka = L + O_KF + (8 * g + q4) * RQ + 32 * tt + 8 * p4; const LAS unsigned char* kb = L + O_KB + (8 * g + q4) * RQ + 32 * tt + 8 * p4;
              kf0[x] = __builtin_shufflevector(TRRD(ka), TRRD(ka + 4 * RQ), 0, 1, 2, 3, 4, 5, 6, 7); kf1[x] = __builtin_shufflevector(TRRD(ka + 32 * RQ), TRRD(ka + 36 * RQ), 0, 1, 2, 3, 4, 5, 6, 7);
              kb0[x] = __builtin_shufflevector(TRRD(kb), TRRD(kb + 4 * RQ), 0, 1, 2, 3, 4, 5, 6, 7); kb1[x] = __builtin_shufflevector(TRRD(kb + 32 * RQ), TRRD(kb + 36 * RQ), 0, 1, 2, 3, 4, 5, 6, 7); }
          __builtin_amdgcn_sched_barrier(0);
#pragma unroll
          for (int x = 0; x < 4; ++x) { const int tt = 4 * th + x;
              Sf[tt] = __builtin_amdgcn_mfma_f32_16x16x32_bf16(kf0[x], vf0, Sf[tt], 0, 0, 0); Sf[tt] = __builtin_amdgcn_mfma_f32_16x16x32_bf16(kf1[x], vf1, Sf[tt], 0, 0, 0);
              Sb[tt] = __builtin_amdgcn_mfma_f32_16x16x32_bf16(kb0[x], vf0, Sb[tt], 0, 0, 0); Sb[tt] = __builtin_amdgcn_mfma_f32_16x16x32_bf16(kb1[x], vf1, Sb[tt], 0, 0, 0); }
          __builtin_amdgcn_sched_barrier(0);
      } }
}
template <int DK, bool GLA>
__device__ __forceinline__ void kv_units(Frame& F, const CMixArgs& a) {
    constexpr int NT = DK / 16;
    const int w = F.wave, lane0 = F.lane;
    int p = (int)blockIdx.x;
    if (p >= 1536) return;
    if (GLA) {
#pragma unroll 1
        for (int pp = p; pp < 1536; pp += F.G) gla_b_stage(F, a, pp);
        asm volatile("s_waitcnt vmcnt(0)" ::: "memory"); __syncthreads(); }
    KvRaw<GLA> RA, RB;
    kv_load<GLA>(RA, a, p, 0, w, lane0); kv_load<GLA>(RB, a, p, 1, w, lane0);
#pragma unroll 1
    for (; p < 1536; p += F.G) {
        const int sc = p >> 2, hh = p & 3, pnext = p + F.G;
        f32x4 Sf[NT], Sb[NT];
#pragma unroll
        for (int tt = 0; tt < NT; ++tt) { Sf[tt] = (f32x4){0.f, 0.f, 0.f, 0.f}; Sb[tt] = (f32x4){0.f, 0.f, 0.f, 0.f}; }
        kv_step<DK, GLA>(F, a, p, 0, pnext, RA, Sf, Sb); kv_step<DK, GLA>(F, a, p, 1, pnext, RB, Sf, Sb);
        kv_step<DK, GLA>(F, a, p, 2, pnext, RA, Sf, Sb); kv_step<DK, GLA>(F, a, p, 3, pnext, RB, Sf, Sb);
        const int lane = opaque_i(lane0);
#pragma unroll
        for (int dir = 0; dir < 2; ++dir) { unsigned char* sp = a.st + state_off(sc, GLA, hh, dir) + (size_t)(unsigned)(w * NT * 512 + lane * 8);
#pragma unroll
            for (int tt = 0; tt < NT; ++tt) { const f32x4 s = dir ? Sb[tt] : Sf[tt]; u32x2 pk; pk.x = cvtpk_c(s[0], s[1]); pk.y = cvtpk_c(s[2], s[3]); *(GAS u32x2*)(sp + tt * 512) = pk; } }
    }
}

constexpr int RD_SLOT = 32768;
__device__ __forceinline__ void ret_dma_block(Frame& F, const CMixArgs& a, int p, int kb, int slot) {
    const int lane = opaque_i(F.lane), w = F.wave, sc = p >> 2, hh = p & 3;
#pragma unroll
    for (int x = 0; x < 2; ++x) {
        const int r = 4 * (2 * w + x) + (lane >> 4), cp = lane & 15;
        const size_t row = (size_t)(sc * 256 + 64 * kb + r);
        const bf16* gk = a.proj + pg8::PL_RK + (hh * pg8::MTOK + row) * 128 + 8 * (cp ^ (r & 15));
        const bf16* gv = a.proj + pg8::PL_RV + (hh * pg8::MTOK + row) * 128 + 8 * (cp ^ (2 * (r & 7)));
        __builtin_amdgcn_global_load_lds((const unsigned*)gk, (LAS unsigned*)(F.lds + slot * RD_SLOT + (2 * w + x) * 1024), 16, 0, 0);
        __builtin_amdgcn_global_load_lds((const unsigned*)gv, (LAS unsigned*)(F.lds + slot * RD_SLOT + 16384 + (2 * w + x) * 1024), 16, 0, 0);
    }
}
__device__ __forceinline__ void tr_read16(const unsigned (&ad)[8], u32x2 (&r)[16]) {
    asm volatile("ds_read_b64_tr_b16 %0, %16\n\tds_read_b64_tr_b16 %1, %16 offset:4096\n\tds_read_b64_tr_b16 %2, %17\n\tds_read_b64_tr_b16 %3, %17 offset:4096\n\t"
                 "ds_read_b64_tr_b16 %4, %18\n\tds_read_b64_tr_b16 %5, %18 offset:4096\n\tds_read_b64_tr_b16 %6, %19\n\tds_read_b64_tr_b16 %7, %19 offset:4096\n\t"
                 "ds_read_b64_tr_b16 %8, %20\n\tds_read_b64_tr_b16 %9, %20 offset:4096\n\tds_read_b64_tr_b16 %10, %21\n\tds_read_b64_tr_b16 %11, %21 offset:4096\n\t"
                 "ds_read_b64_tr_b16 %12, %22\n\tds_read_b64_tr_b16 %13, %22 offset:4096\n\tds_read_b64_tr_b16 %14, %23\n\tds_read_b64_tr_b16 %15, %23 offset:4096\n\t"
                 "s_waitcnt lgkmcnt(0)"
                 : "=&v"(r[0]), "=&v"(r[1]), "=&v"(r[2]), "=&v"(r[3]), "=&v"(r[4]), "=&v"(r[5]), "=&v"(r[6]), "=&v"(r[7]),
                   "=&v"(r[8]), "=&v"(r[9]), "=&v"(r[10]), "=&v"(r[11]), "=&v"(r[12]), "=&v"(r[13]), "=&v"(r[14]), "=&v"(r[15])
                 : "v"(ad[0]), "v"(ad[1]), "v"(ad[2]), "v"(ad[3]), "v"(ad[4]), "v"(ad[5]), "v"(ad[6]), "v"(ad[7]) : "memory");
}
__device__ __forceinline__ void ret_block(Frame& F, const CMixArgs& a, int p, int kb, int slot, int pnext, const bf16x8 (&Qf)[2][4], f32x4 (&O)[8][2]) {
    LAS unsigned char* L = F.lds;
    const int w = F.wave, hh = p & 3;
    const float l2g = hh == 0 ? -0.045803689613124f : hh == 1 ? -0.022720076500083f : hh == 2 ? -0.011315313227834f : -0.005646563141142f;
    asm volatile("s_waitcnt vmcnt(4)" ::: "memory");
    __builtin_amdgcn_s_barrier();
    asm volatile("" ::: "memory");
    { const int kn = kb + 2, pn2 = kn < 4 ? p : (pnext < 1536 ? pnext : p); ret_dma_block(F, a, pn2, kn & 3, slot == 0 ? 2 : slot - 1); }
    LAS unsigned char* KB = L + slot * RD_SLOT; LAS unsigned char* VB = KB + 16384;
    const int lane = opaque_i(F.lane), g = lane >> 4, lr = lane & 15, q4 = lr >> 2, p4 = lr & 3;
    const int xk16 = (lr ^ (g >> 1)) << 4, xv16 = ((p4 >> 1) ^ (2 * ((4 * g + q4) & 7))) << 4;
#pragma unroll
    for (int sp = 0; sp < 2; ++sp) {
        f32x4 st[2][2];
#pragma unroll
        for (int h = 0; h < 2; ++h)
#pragma unroll
            for (int it = 0; it < 2; ++it) st[h][it] = (f32x4){0.f, 0.f, 0.f, 0.f};
        { bf16x8 kf[2][4];
#pragma unroll
          for (int s = 0; s < 4; ++s)
#pragma unroll
              for (int h = 0; h < 2; ++h) {
                  const LAS unsigned char* kp = KB + (32 * sp + 16 * h + lr) * 256 + 8 * (g & 1);
                  const u32x2 lo = *(const LAS u32x2*)(kp + ((64 * s) ^ xk16)), hi = *(const LAS u32x2*)(kp + ((64 * s + 32) ^ xk16));
                  kf[h][s] = __builtin_bit_cast(bf16x8, (v4u){lo.x, lo.y, hi.x, hi.y}); }
          __builtin_amdgcn_sched_barrier(0);
#pragma unroll
          for (int s = 0; s < 4; ++s)
#pragma unroll
              for (int h = 0; h < 2; ++h)
#pragma unroll
                  for (int it = 0; it < 2; ++it) st[h][it] = __builtin_amdgcn_mfma_f32_16x16x32_bf16(kf[h][s], Qf[it][s], st[h][it], 0, 0, 0);
          __builtin_amdgcn_sched_barrier(0); }
        bf16x8 pf[2];
#pragma unroll
        for (int it = 0; it < 2; ++it) {
            const int i = 32 * w + 16 * it + lr;
            unsigned pw[4];
#pragma unroll
            for (int h = 0; h < 2; ++h) { float e[4];
#pragma unroll
                for (int r = 0; r < 4; ++r) { const int j = 64 * kb + 32 * sp + 16 * h + 4 * g + r; const int d = i - j; e[r] = st[h][it][r] * __builtin_amdgcn_exp2f(l2g * (float)(d < 0 ? -d : d)); }
                pw[2 * h] = cvtpk_c(e[0], e[1]); pw[2 * h + 1] = cvtpk_c(e[2], e[3]); }
            pf[it] = __builtin_bit_cast(bf16x8, (v4u){pw[0], pw[1], pw[2], pw[3]});
        }
        { unsigned ad[8]; u32x2 vr[16];
          const unsigned vb0 = (unsigned)(size_t)(VB + (32 * sp + 4 * g + q4) * 256 + 8 * (p4 & 1));
#pragma unroll
          for (int dt = 0; dt < 8; ++dt) ad[dt] = vb0 + ((32 * dt) ^ xv16);
          tr_read16(ad, vr);
          __builtin_amdgcn_sched_barrier(0);
#pragma unroll
          for (int dt = 0; dt < 8; ++dt) { const bf16x8 vf = __builtin_bit_cast(bf16x8, (v4u){vr[2 * dt].x, vr[2 * dt].y, vr[2 * dt + 1].x, vr[2 * dt + 1].y});
#pragma unroll
              for (int it = 0; it < 2; ++it) O[dt][it] = __builtin_amdgcn_mfma_f32_16x16x32_bf16(vf, pf[it], O[dt][it], 0, 0, 0); }
          __builtin_amdgcn_sched_barrier(0); }
    }
}
__device__ __forceinline__ void ret_q_load(bf16x8 (&Qf)[2][4], const CMixArgs& a, int p, int w, int lane0) {
    const int lane = opaque_i(lane0), g = lane >> 4, lr = lane & 15, sc = p >> 2, hh = p & 3;
#pragma unroll
    for (int it = 0; it < 2; ++it) { const bf16* qp = a.proj + pg8::PL_RQ + (hh * pg8::MTOK + (size_t)(sc * 256 + 32 * w + 16 * it + lr)) * 128 + 4 * g;
#pragma unroll
        for (int s = 0; s < 4; ++s) { const u32x2 lo = *(const GAS u32x2*)(qp + 32 * s), hi = *(const GAS u32x2*)(qp + 32 * s + 16); Qf[it][s] = __builtin_bit_cast(bf16x8, (v4u){lo.x, lo.y, hi.x, hi.y}); } }
}
__device__ __forceinline__ void ret_units_direct(Frame& F, const CMixArgs& a) {
    const int w = F.wave;
    int p = (int)blockIdx.x;
    if (p >= 1536) return;
    bf16x8 Qf[2][4];
    asm volatile("s_waitcnt vmcnt(0)" ::: "memory"); __syncthreads();
    ret_dma_block(F, a, p, 0, 0); ret_dma_block(F, a, p, 1, 1);
    int slot = 0;
    ret_q_load(Qf, a, p, w, F.lane);
#pragma unroll 1
    for (; p < 1536; p += F.G) {
        const int sc = p >> 2, hh = p & 3, pnext = p + F.G;
        const float l2g = hh == 0 ? -0.045803689613124f : hh == 1 ? -0.022720076500083f : hh == 2 ? -0.011315313227834f : -0.005646563141142f;
        f32x4 O[8][2];
#pragma unroll
        for (int dt = 0; dt < 8; ++dt)
#pragma unroll
            for (int it = 0; it < 2; ++it) O[dt][it] = (f32x4){0.f, 0.f, 0.f, 0.f};
#pragma unroll 1
        for (int kb = 0; kb < 4; ++kb) { ret_block(F, a, p, kb, slot, pnext, Qf, O); slot = slot == 2 ? 0 : slot + 1; }
        { const int lane = opaque_i(F.lane), lr = lane & 15;
          const unsigned char* sp0 = a.st + state_off(sc, false, hh, 0) + (size_t)(unsigned)(lane * 8);
          u32x2 cA[16], cB[16];
#define RD_CLOAD(dst, k_) do { const unsigned char* b_ = sp0 + ((k_) >> 2) * 32768 + 2 * ((k_) & 3) * 512; \
              _Pragma("unroll") for (int dt = 0; dt < 8; ++dt) { dst[2 * dt] = *(const GAS u32x2*)(b_ + dt * 4096); dst[2 * dt + 1] = *(const GAS u32x2*)(b_ + dt * 4096 + 512); } } while (0)
#define RD_CMMA(src, k_) do { const int dir_ = (k_) >> 2, s_ = (k_) & 3; bf16x8 qs[2]; \
              _Pragma("unroll") for (int it = 0; it < 2; ++it) { const int i = 32 * w + 16 * it + lr; const float f = __builtin_amdgcn_exp2f(l2g * (float)(dir_ ? 256 - i : i + 1)); \
                  const v4u qw = __builtin_bit_cast(v4u, Qf[it][s_]); v4u o_; \
                  _Pragma("unroll") for (int j = 0; j < 4; ++j) ((unsigned*)&o_)[j] = cvtpk_c(bflo(((const unsigned*)&qw)[j]) * f, bfhi(((const unsigned*)&qw)[j]) * f); \
                  qs[it] = __builtin_bit_cast(bf16x8, o_); } \
              _Pragma("unroll") for (int dt = 0; dt < 8; ++dt) { const bf16x8 cf = __builtin_bit_cast(bf16x8, (v4u){src[2 * dt].x, src[2 * dt].y, src[2 * dt + 1].x, src[2 * dt + 1].y}); \
                  _Pragma("unroll") for (int it = 0; it < 2; ++it) O[dt][it] = __builtin_amdgcn_mfma_f32_16x16x32_bf16(cf, qs[it], O[dt][it], 0, 0, 0); } } while (0)
          RD_CLOAD(cA, 0); RD_CLOAD(cB, 1);
          __builtin_amdgcn_sched_barrier(0);
#pragma unroll
          for (int k = 0; k < 8; k += 2) {
              RD_CMMA(cA, k); if (k + 2 < 8) RD_CLOAD(cA, k + 2);
              __builtin_amdgcn_sched_barrier(0);
              RD_CMMA(cB, k + 1); if (k + 3 < 8) RD_CLOAD(cB, k + 3);
              __builtin_amdgcn_sched_barrier(0);
          }
#undef RD_CLOAD
#undef RD_CMMA
        }
        ret_q_load(Qf, a, pnext < 1536 ? pnext : p, w, F.lane);
        { const int lane = opaque_i(F.lane), g = lane >> 4, lr = lane & 15;
          LAS unsigned char* T = F.lds + 3 * RD_SLOT + w * (16 * 272);
          f32x4 nw[4], nb[4];
#pragma unroll
          for (int k = 0; k < 4; ++k) { nw[k] = *(const GAS f32x4*)(a.rnw + 128 * hh + 16 * (lane & 7) + 4 * k); nb[k] = *(const GAS f32x4*)(a.rnb + 128 * hh + 16 * (lane & 7) + 4 * k); }
#pragma unroll
          for (int it = 0; it < 2; ++it) {
              v4u gt[2][2];
#pragma unroll
              for (int h = 0; h < 2; ++h) { const bf16* gp = a.proj + pg8::PL_RG + (hh * pg8::MTOK + (size_t)(sc * 256 + 32 * w + 16 * it + 8 * h + (lane >> 3))) * 128 + 16 * (lane & 7);
                  gt[h][0] = *(const GAS v4u*)gp; gt[h][1] = *(const GAS v4u*)(gp + 8); }
              float sm = 0.f;
#pragma unroll
              for (int dt = 0; dt < 8; ++dt) sm += (O[dt][it][0] + O[dt][it][1]) + (O[dt][it][2] + O[dt][it][3]);
              sm += __shfl_xor(sm, 16); sm += __shfl_xor(sm, 32);
              const float mu = sm * (1.0f / 128.0f); float ss = 0.f;
#pragma unroll
              for (int dt = 0; dt < 8; ++dt) { O[dt][it] = O[dt][it] - mu; ss += (O[dt][it][0] * O[dt][it][0] + O[dt][it][1] * O[dt][it][1]) + (O[dt][it][2] * O[dt][it][2] + O[dt][it][3] * O[dt][it][3]); }
              ss += __shfl_xor(ss, 16); ss += __shfl_xor(ss, 32);
              const float rs = __builtin_amdgcn_rsqf(ss * (1.0f / 128.0f) + EPS);
#pragma unroll
              for (int dt = 0; dt < 8; ++dt) { const f32x4 y = O[dt][it] * rs;
                  u32x2 pk; pk.x = cvtpk_c(y[0], y[1]); pk.y = cvtpk_c(y[2], y[3]);
                  *(LAS u32x2*)(T + lr * 272 + 32 * dt + 8 * g) = pk; }
              asm volatile("s_waitcnt lgkmcnt(0)" ::: "memory");
#pragma unroll
              for (int h = 0; h < 2; ++h) { const int rr = 8 * h + (lane >> 3);
                  const v4u y0 = *(const LAS v4u*)(T + rr * 272 + 32 * (lane & 7)), y1 = *(const LAS v4u*)(T + rr * 272 + 32 * (lane & 7) + 16);
                  unsigned ow[8];
#pragma unroll
                  for (int k = 0; k < 8; ++k) { const unsigned yw = k < 4 ? ((const unsigned*)&y0)[k] : ((const unsigned*)&y1)[k - 4], gw = k < 4 ? ((const unsigned*)&gt[h][0])[k] : ((const unsigned*)&gt[h][1])[k - 4];
                      const float g0 = bflo(gw), g1 = bfhi(gw);
                      ow[k] = cvtpk_c((bflo(yw) * nw[k >> 1][2 * (k & 1)] + nb[k >> 1][2 * (k & 1)]) * g0 * __builtin_amdgcn_rcpf(1.0f + __expf(-g0)), (bfhi(yw) * nw[k >> 1][2 * (k & 1) + 1] + nb[k >> 1][2 * (k & 1) + 1]) * g1 * __builtin_amdgcn_rcpf(1.0f + __expf(-g1))); }
                  bf16* op = a.mo + (size_t)(sc * 256 + 32 * w + 16 * it + rr) * a.mop + 512 + 128 * hh + 16 * (lane & 7);
                  *(GAS v4u*)op = (v4u){ow[0], ow[1], ow[2], ow[3]}; *(GAS v4u*)(op + 8) = (v4u){ow[4], ow[5], ow[6], ow[7]}; }
              asm volatile("s_waitcnt lgkmcnt(0)" ::: "memory");
          } }
    }
    asm volatile("s_waitcnt vmcnt(0)" ::: "memory"); __syncthreads();
}

template <bool WITH_O>
__device__ __forceinline__ void cmix_phase(Frame& F, const CMixArgs& a, int which = 3) {
#if MIX_GLA
    if (which & 1) { if constexpr (WITH_O) mix_units<64, true, true>(F, a); else kv_units<64, true>(F, a);
    __syncthreads(); }
#endif
#if MIX_RET
    if (which & 2) { if constexpr (WITH_O) ret_units_direct(F, a); else kv_units<128, false>(F, a);
    __syncthreads(); }
#endif
}
__device__ __forceinline__ void scan_phase(Frame& F, const CMixArgs& a) {
    const int nthreads = F.G * NWAVES * 64;
    for (int chain = (int)blockIdx.x * NWAVES * 64 + F.tid; chain < 34 * 49152; chain += nthreads) {
        const int sq = chain / 49152, cidx = chain % 49152;
        const int seq = sq < 2 ? 32 + sq : sq - 2;
        const int sc0 = seq < 32 ? seq * 8 : 256 + (seq - 32) * 64, ns = seq < 32 ? 8 : 64;
        const bool gla = cidx < 16384; const int c2 = gla ? cidx : cidx - 16384;
        const int hd = gla ? (c2 >> 11) : (c2 >> 12), v = gla ? (c2 & 2047) : (c2 & 4095), hh = hd >> 1, dir = hd & 1;
        if ((gla && !MIX_GLA) || (!gla && !MIX_RET)) continue;
        const int t0 = 16 * ((v >> 6) & 3) + 4 * ((v & 63) >> 4);
        const float gret = exp2f(256.0f * log2f(1.0f - exp2f(-5.0f - (float)hh)));
        f32x4 cst = {0.f, 0.f, 0.f, 0.f};
        for (int blk = 0; blk < ns; blk += 8) {
            u32x2 kv[8]; f32x4 d[8];
#pragma unroll
            for (int j = 0; j < 8; ++j) { const int n = dir ? ns - 1 - (blk + j) : blk + j;
                kv[j] = *(const GAS u32x2*)(a.st + state_off(sc0 + n, gla, hh, dir) + (size_t)v * 8);
                d[j] = gla ? *(const GAS f32x4*)(a.dec + (size_t)(((sc0 + n) * 4 + hh) * 2 + dir) * 64 + t0) : (f32x4){gret, gret, gret, gret}; }
#pragma unroll
            for (int j = 0; j < 8; ++j) { const int n = dir ? ns - 1 - (blk + j) : blk + j;
                u32x2 pk; pk.x = cvtpk_c(cst[0], cst[1]); pk.y = cvtpk_c(cst[2], cst[3]);
                *(GAS u32x2*)(a.sto + state_off(sc0 + n, gla, hh, dir) + (size_t)v * 8) = pk;
                cst = d[j] * cst + (f32x4){bflo(kv[j].x), bfhi(kv[j].x), bflo(kv[j].y), bfhi(kv[j].y)}; }
        }
    }
}

#define NAIVE_MIX (!(MIX_GLA && MIX_RET))
constexpr int PB0 = NAIVE_MIX ? 8 : 5, NPH = PB0 + 4;
struct Args { const float* in[16]; float* out; unsigned char* ws; int ph_lo, ph_hi, use_bar, pad; };
__global__ void __launch_bounds__(NWAVES * 64, 2) fwd_kernel(Args args) {
    extern __shared__ __attribute__((aligned(16))) unsigned char lds[];
    Frame F;
    F.lds = (LAS unsigned char*)lds;
    F.MISC = (volatile LAS unsigned*)(F.lds + MISC_OFF);
    F.tid = threadIdx.x; F.lane = F.tid & 63; F.wave = __builtin_amdgcn_readfirstlane(F.tid >> 6);
    F.G = gridDim.x; { const int bx = blockIdx.x; F.vcu = (F.G % 8 == 0) ? (bx % 8) * (F.G / 8) + bx / 8 : bx; }
    unsigned char* ws = args.ws;
    gu32* ctl = (gu32*)(ws + WS_CTL);
    for (int u = F.tid; u < (LDS_BYTES - LDSCTL_OFF) / 4; u += NWAVES * 64) ((LAS unsigned*)(F.lds + LDSCTL_OFF))[u] = 0u;
    __syncthreads();
    XcdBarrier bar; bar.bar = (unsigned*)(ctl + CW_BAR); bar.x = 0; bar.st = nullptr;
    if (args.use_bar) bar = xcd_barrier_post((unsigned*)(ctl + CW_BAR), F.MISC + 8);
    const int lo = args.ph_lo, hi = args.ph_hi;
#define IN(k) (lo <= (k) && (k) < hi)
#define SEAM(k) do { if (IN(k) && IN((k) + 1)) xcd_barrier(bar); } while (0)
    if (IN(0)) { const P0Args pa{args.in[0], args.in[1], args.in[2], args.in[3], args.in[11], args.in[12], args.in[13], args.in[14], (bf16*)(ws + WS_WIN), (bf16*)(ws + WS_WOUT), (bf16*)(ws + WS_W1), (bf16*)(ws + WS_W2),
            (bf16*)(ws + WS_R0), (float*)(ws + WS_ROPE), (float*)(ws + WS_ROPE) + 16384 * 64, (float*)(ws + WS_GA), (float*)(ws + WS_RSTD)};
        p0_prologue(F, pa); __syncthreads();
#if REP0
        p0_prologue(F, pa, REP0); __syncthreads();
#endif
    }
    SEAM(0);
    if (IN(1)) { pg8::Gemm g{(bf16*)(ws + WS_R0), (bf16*)(ws + WS_WIN), M_TOK, NP, D, D}; pg8::StaticOrder S; S.init(M_TOK, NP, F.G, (int)blockIdx.x);
        pg8::EpiInProj E{(bf16*)(ws + WS_R1), (float*)(ws + WS_RSTD), (float*)(ws + WS_ROPE), (float*)(ws + WS_ROPE) + 16384 * 64};
#if REP1 == 2
        { pg8::EpiPlain E2{(bf16*)(ws + WS_R1)}; pg8::gemm_phase<pg8::EpiPlain, pg8::StaticOrder, true, true>(F.lds + RING_OFF, g, S, E2); } __syncthreads();
#elif REP1 == 3
        { pg8::EpiNull E2{}; pg8::gemm_phase<pg8::EpiNull, pg8::StaticOrder, true, true>(F.lds + RING_OFF, g, S, E2); } __syncthreads();
#endif
        pg8::gemm_phase<pg8::EpiInProj, pg8::StaticOrder, true, true>(F.lds + RING_OFF, g, S, E);
#if REP1 == 1
        __syncthreads(); pg8::gemm_phase<pg8::EpiInProj, pg8::StaticOrder, true, true>(F.lds + RING_OFF, g, S, E);
#endif
    }
    SEAM(1);
    if (IN(2)) { const CMixArgs ca{(bf16*)(ws + WS_R1), (float*)(ws + WS_GA), args.in[4], args.in[5], args.in[6], args.in[7], ws + WS_R0, (float*)(ws + WS_DEC), args.in[8], args.in[9], args.in[10], (bf16*)((unsigned char*)args.out + (size_t)192 * MiB), D, ws + WS_R0, (unsigned char*)args.out, (float*)((unsigned char*)args.out + (size_t)96 * MiB), (float*)(ws + WS_R1 + (size_t)672 * MiB), (float*)(ws + WS_DEC + 786432)};
        cmix_phase<false>(F, ca);
#if REP2
        cmix_phase<false>(F, ca, REP2);
#endif
    }
    SEAM(2);
    if (IN(3)) { const CMixArgs ca{(bf16*)(ws + WS_R1), (float*)(ws + WS_GA), args.in[4], args.in[5], args.in[6], args.in[7], ws + WS_R0, (float*)(ws + WS_DEC), args.in[8], args.in[9], args.in[10], (bf16*)((unsigned char*)args.out + (size_t)192 * MiB), D, ws + WS_R0, (unsigned char*)args.out, (float*)((unsigned char*)args.out + (size_t)96 * MiB), (float*)(ws + WS_R1 + (size_t)672 * MiB), (float*)(ws + WS_DEC + 786432)};
#if REP3
        { CMixArgs cb = ca; cb.sto = (unsigned char*)args.out + (size_t)224 * MiB; scan_phase(F, cb); }
#endif
        scan_phase(F, ca); }
    SEAM(3);
    if (IN(4)) { const CMixArgs ca{(bf16*)(ws + WS_R1), (float*)(ws + WS_GA), args.in[4], args.in[5], args.in[6], args.in[7], ws + WS_R0, (float*)(ws + WS_DEC), args.in[8], args.in[9], args.in[10], (bf16*)((unsigned char*)args.out + (size_t)192 * MiB), D, ws + WS_R0, (unsigned char*)args.out, (float*)((unsigned char*)args.out + (size_t)96 * MiB), (float*)(ws + WS_R1 + (size_t)672 * MiB), (float*)(ws + WS_DEC + 786432)};
#if REP4
        { CMixArgs cb = ca; cmix_phase<true>(F, cb, REP4); }
#endif
        cmix_phase<true>(F, ca); }
    SEAM(4);
#if NAIVE_MIX
    { const MixArgs ma{(bf16*)(ws + WS_R1), (float*)(ws + WS_GA), args.in[4], args.in[5], args.in[6], args.in[7], args.out, args.in[8], args.in[9], args.in[10]};
    if (IN(5)) { naive_mix_phase<false>(F, ma); __syncthreads(); }
    SEAM(5);
    if (IN(6)) { naive_mix_phase<true>(F, ma); __syncthreads(); }
    SEAM(6);
    if (IN(7)) { naive_combine(F, ma); }
    SEAM(7); }
#endif
    if (IN(PB0)) { pg8::Gemm g{(bf16*)((unsigned char*)args.out + (size_t)192 * MiB), (bf16*)(ws + WS_WOUT), M_TOK, D, D, D}; pg8::StaticOrder S; S.init(M_TOK, D, F.G, (int)blockIdx.x);
        pg8::EpiResidX E{args.in[0], args.in[1], (bf16*)(ws + WS_R0), (float*)(ws + WS_SQ1)};
        pg8::gemm_phase<pg8::EpiResidX, pg8::StaticOrder, true, true>(F.lds + RING_OFF, g, S, E);
#if REP5
        __syncthreads(); pg8::gemm_phase<pg8::EpiResidX, pg8::StaticOrder, true, true>(F.lds + RING_OFF, g, S, E);
#endif
    }
    SEAM(PB0);
    if (IN(PB0 + 1)) {
        { const float* sq = (const float*)(ws + WS_SQ1); float* r2v = (float*)(ws + WS_RSTD);
          for (int row = (int)blockIdx.x * NWAVES * 64 + F.tid; row < M_TOK; row += F.G * NWAVES * 64) { const f32x4* s4 = (const f32x4*)(sq + (size_t)row * 16);
              const f32x4 t = (s4[0] + s4[1]) + (s4[2] + s4[3]); r2v[row] = 1.0f / (((t[0] + t[1]) + (t[2] + t[3])) * (1.0f / 1024.0f) + EPS); }
          if (args.use_bar) xcd_barrier(bar); }
        pg8::Gemm g{(bf16*)(ws + WS_R0), (bf16*)(ws + WS_W1), M_TOK, FF, D, D}; pg8::StaticOrder S; S.init(M_TOK, FF, F.G, (int)blockIdx.x);
        pg8::EpiFF1 E{(bf16*)(ws + WS_R1), (float*)(ws + WS_RSTD)};
        pg8::gemm_phase<pg8::EpiFF1, pg8::StaticOrder, true, true>(F.lds + RING_OFF, g, S, E);
#if REP6
        __syncthreads(); pg8::gemm_phase<pg8::EpiFF1, pg8::StaticOrder, true, true>(F.lds + RING_OFF, g, S, E);
#endif
    }
    SEAM(PB0 + 1);
    if (IN(PB0 + 2)) { pg8::Gemm g{(bf16*)(ws + WS_R1), (bf16*)(ws + WS_W2), M_TOK, D, FF, FF}; pg8::StaticOrder S; S.init(M_TOK, D, F.G, (int)blockIdx.x);
        pg8::EpiResidB E{(bf16*)(ws + WS_R0), (float*)(ws + WS_SQ2)};
        pg8::gemm_phase<pg8::EpiResidB, pg8::StaticOrder, true, true>(F.lds + RING_OFF, g, S, E); }
    SEAM(PB0 + 2);
    if (IN(PB0 + 3)) { final_norm(F, args.out, (const bf16*)(ws + WS_R0), (float*)(ws + WS_SQ2), args.in[15]);
#if REP8
        final_norm(F, args.out, (const bf16*)(ws + WS_R0), (float*)(ws + WS_SQ2), args.in[15]);
#endif
    }
#undef IN
#undef SEAM
}

extern "C" void kernel_launch(void* const* d_in, const int* in_sizes, int n_in, void* d_out, int out_size, void* d_ws, size_t ws_size, hipStream_t stream) {
    static int grid = 0;
    if (grid == 0) {
        if (n_in != 16 || in_sizes[0] != M_PROMPT * D || out_size != M_TOK * D || ws_size < WS_END) {
            fprintf(stderr, "kernel_launch: unexpected shapes (n_in %d, in0 %d, out %d, ws %zu); nothing launched\n", n_in, n_in > 0 ? in_sizes[0] : -1, out_size, ws_size); grid = -1; return; }
        int dev = 0, cus = 0, per_cu = 0;
        if (hipGetDevice(&dev) != hipSuccess || hipDeviceGetAttribute(&cus, hipDeviceAttributeMultiprocessorCount, dev) != hipSuccess) { grid = -1; return; }
        if (hipFuncSetAttribute((const void*)fwd_kernel, hipFuncAttributeMaxDynamicSharedMemorySize, LDS_BYTES) != hipSuccess) { fprintf(stderr, "kernel_launch: hipFuncSetAttribute failed\n"); grid = -1; return; }
        if (hipOccupancyMaxActiveBlocksPerMultiprocessor(&per_cu, (const void*)fwd_kernel, NWAVES * 64, LDS_BYTES) != hipSuccess || per_cu < 1)
            fprintf(stderr, "kernel_launch: note: occupancy query reports %d workgroups per CU\n", per_cu);
        (void)hipGetLastError();
        grid = cus;
    }
    if (grid < 0) return;
    if (hipMemsetAsync((char*)d_ws + WS_CTL, 0, CTL_ZERO_BYTES, stream) != hipSuccess) return;
    Args a{};
    for (int i = 0; i < 16; ++i) a.in[i] = (const float*)d_in[i];
    a.out = (float*)d_out; a.ws = (unsigned char*)d_ws;
#if MK_SINGLE
    a.ph_lo = 0; a.ph_hi = NPH; a.use_bar = 1;
    hipLaunchKernelGGL(fwd_kernel, dim3(grid), dim3(NWAVES * 64), LDS_BYTES, stream, a);
#else
    for (int p = 0; p < NPH; ++p) { a.ph_lo = p; a.ph_hi = p + 1; a.use_bar = 0;
        hipLaunchKernelGGL(fwd_kernel, dim3(grid), dim3(NWAVES * 64), LDS_BYTES, stream, a); }
#endif
}
```

```cpp
#include <hip/hip_runtime.h>
#include <cstdio>
#ifndef MK_SINGLE
#define MK_SINGLE 1
#endif
#ifndef MIX_GLA
#define MIX_GLA 1
#define MIX_RET 1
#define REP1 0
#define REP2 0
#define REP3 0
#define REP4 0
#define REP6 0
#define DUP 0
#define ABLV 0
#define REP0 0
#define RELAX_MASK 0
#define STAG_TICKS 0
#define PROF_PHASE -1
#define PROF_A 1
#define PROF_B 2
#define PROF_BLOCK 0
#define PROF_DELAY 0
#define H_TILED 1
#define EPI_PLAIN_VARIANT 0
#define PROF_OA 0ull
#define PROF_OB 0ull
#define PROF_QA 25ull
#define PROF_QB 25ull
#define REP5 0
#define REP8 0
#endif
namespace pg8 {
#define PG8_LAS __attribute__((address_space(3)))
typedef unsigned short bf16_t;
typedef short bf16x8 __attribute__((ext_vector_type(8)));
typedef float f32x4 __attribute__((ext_vector_type(4)));
typedef unsigned u32x4 __attribute__((ext_vector_type(4)));
constexpr int BM = 256, BK = 64, HALF = 128, HTB = HALF * BK * 2  , STAGE_BYTES = 8 * HTB, NXCD = 8, WGM = 8;

__host__ __device__ __forceinline__ int lds_byte(int r, int c) { const int st = (r >> 4) * 2 + (c >> 5), rr = r & 15, cc = c & 31, ob = rr * 64 + cc * 2; return st * 1024 + (ob ^ (((ob >> 9) & 1) << 5)); }
__host__ __device__ __forceinline__ void stage_rc(int b, int& R, int& C) { const int st = b / 1024, sb = b % 1024, swz = sb ^ (((sb >> 9) & 1) << 5); R = (st >> 1) * 16 + swz / 64; C = (st & 1) * 32 + (swz % 64) / 2; }
__host__ __device__ __forceinline__ int perm32(int rho) { const int n = rho >> 4, i = rho & 15; return 8 * (i >> 2) + 4 * n + (i & 3); }

struct Unit { int pm, pn; };
struct Gemm { const bf16_t* A; const bf16_t* Bt; int M, N, K, lda; int ldb, ksA, ksB; long psA, psB; };

struct StaticOrder {
    int nM, nN, nwg, G, c, rev;
    __host__ __device__ void init(int M, int N, int G_, int c_, int rev_ = 0) { nM = M / BM; nN = N / BM; nwg = nM * nN; G = G_; c = c_; rev = rev_; }
    __host__ __device__ bool next(int i, Unit& u) const {
        if ((long)i * G + c >= nwg) return false;
        const long L = (long)(rev ? (nwg - 1 - c) / G - i : i) * G + c;
        int wgid = (int)L; { const int q = nwg / NXCD, r = nwg % NXCD, xcd = wgid % NXCD, off = wgid / NXCD; wgid = (xcd < r ? xcd * (q + 1) : r * (q + 1) + (xcd - r) * q) + off; }
        const int nig = WGM * nN, gid = wgid / nig, fm = gid * WGM, gsz = (nM - fm) < WGM ? (nM - fm) : WGM;
        u.pm = fm + ((wgid % nig) % gsz); u.pn = (wgid % nig) / gsz; return true;
    }
    __device__ __forceinline__ void a_ready(const Unit&) const {}
    __device__ __forceinline__ void done(const Unit&) const {}
};
struct InProjOrder {
    int x, r;
    __host__ __device__ void init(int c_) { x = c_ & 7; r = c_ >> 3; }
    __host__ __device__ bool next(int i, Unit& u) const {
        if (i >= 21) return false;
        const int gi = i / 7, ri = i % 7;
        if (ri < 6) { u.pm = x * 48 + 16 * gi + 8 * (ri & 1) + (r & 7); u.pn = 4 * (ri >> 1) + (r >> 3); }
        else { u.pm = x * 48 + 16 * gi + (r & 15); u.pn = 12 + (r >> 4); }
        return true;
    }
    __device__ __forceinline__ void a_ready(const Unit&) const {}
    __device__ __forceinline__ void done(const Unit&) const {}
};
__device__ __forceinline__ unsigned cvt_pk_bf16(float lo, float hi) { unsigned r; asm volatile("v_cvt_pk_bf16_f32 %0, %1, %2" : "=v"(r) : "v"(lo), "v"(hi)); return r; }
__device__ __forceinline__ u32x4 pack8(const f32x4& a, const f32x4& b) { u32x4 w; w.x = cvt_pk_bf16(a[0], a[1]); w.y = cvt_pk_bf16(a[2], a[3]); w.z = cvt_pk_bf16(b[0], b[1]); w.w = cvt_pk_bf16(b[2], b[3]); return w; }
#ifndef H_TILED
#define H_TILED 0
#endif
#ifndef PLANE_PAD_ROWS
#define PLANE_PAD_ROWS 64
#endif
#ifndef RELAX_MASK
#define RELAX_MASK 0
#endif
constexpr int NPROJ = 3584, DMODEL = 1024, DFF = 4096, MPROMPT = 65536;

constexpr size_t MTOK = 98304 + PLANE_PAD_ROWS;
constexpr size_t PL_GV = 0, PL_RV = PL_GV + 4 * MTOK * 128, PL_GQ = PL_RV + 4 * MTOK * 128, PL_GK = PL_GQ + 4 * MTOK * 64, PL_GG = PL_GK + 4 * MTOK * 64,
                 PL_RQ = PL_GG + 4 * MTOK * 128, PL_RK = PL_RQ + 4 * MTOK * 128, PL_RG = PL_RK + 4 * MTOK * 128, PL_END = PL_RG + 4 * MTOK * 128;
__device__ __forceinline__ void plane_of(int pn, int bj, int wc, size_t& off, int& W, int& col) {
    W = 128; col = 32 * wc; int hh = 2 * (pn & 1) + bj; size_t grp;
    switch (pn >> 1) { case 0: grp = PL_GV; break; case 1: grp = PL_RV; break; case 3: grp = PL_GG; break; case 4: grp = PL_RQ; break; case 5: grp = PL_RK; break; case 6: grp = PL_RG; break;
        default: grp = (pn & 1) ? PL_GK : PL_GQ; W = 64; hh = 2 * bj + (wc >> 1); col = 32 * (wc & 1); break; }
    off = grp + (size_t)hh * MTOK * (size_t)W;
}
struct EpiInProj {
    static constexpr bool PERM = true, AFTER_DRAIN = false, RELAX = (RELAX_MASK & 1) != 0;
    bf16_t* P; const float* rstd; const float* rcos; const float* rsin;
    __device__ __forceinline__ void operator()(const f32x4 (&acc)[2][2][4][2], const Unit& u, int wr, int wc, int fr_in, int fq_in) const {
        int fr = fr_in, fq = fq_in; asm volatile("" : "+v"(fr), "+v"(fq));
        const int row0 = u.pm * BM + wr * 64 + fr;
        const bool rot = (u.pn >= 8) && (u.pn < 12);
        const int i0 = (4 * wc + fq) * 4;
        size_t poff[2]; int W, col;
        plane_of(u.pn, 0, wc, poff[0], W, col); plane_of(u.pn, 1, wc, poff[1], W, col);
        const int pos0 = row0 < MPROMPT ? (row0 & 2047) : (row0 & 16383);
        f32x4 cc = *(const f32x4*)(rcos + pos0 * 64 + i0), ss = *(const f32x4*)(rsin + pos0 * 64 + i0);
        const f32x4 cd16 = *(const f32x4*)(rcos + 16 * 64 + i0), sd16 = *(const f32x4*)(rsin + 16 * 64 + i0), cd80 = *(const f32x4*)(rcos + 80 * 64 + i0), sd80 = *(const f32x4*)(rsin + 80 * 64 + i0);
        float rs[2][4];
#pragma unroll
        for (int ai = 0; ai < 2; ++ai)
#pragma unroll
            for (int m = 0; m < 4; ++m) rs[ai][m] = rstd[row0 + ai * HALF + m * 16];
        __builtin_amdgcn_sched_barrier(0);
#pragma unroll
        for (int ai = 0; ai < 2; ++ai)
#pragma unroll
            for (int m = 0; m < 4; ++m) {
                const int row = row0 + ai * HALF + m * 16;
#pragma unroll
                for (int bj = 0; bj < 2; ++bj) {
                    f32x4 v0 = acc[ai][bj][m][0] * rs[ai][m], v1 = acc[ai][bj][m][1] * rs[ai][m];
                    if (rot) { const f32x4 lo = v0 * cc - v1 * ss, hi = v0 * ss + v1 * cc; v0 = lo; v1 = hi; }
                    *(u32x4*)(P + poff[bj] + (size_t)row * W + col + 8 * fq) = pack8(v0, v1);
                }
                if (rot && !(ai == 1 && m == 3)) { const f32x4 cd = m == 3 ? cd80 : cd16, sd = m == 3 ? sd80 : sd16; const f32x4 nc = cc * cd - ss * sd, ns = ss * cd + cc * sd; cc = nc; ss = ns; }
            }
    }
};
struct EpiResid {
    static constexpr bool PERM = true, AFTER_DRAIN = false, RELAX = false;
    const float* xp; const float* xs; float* out; bf16_t* A2; float* sq;
    __device__ __forceinline__ void operator()(const f32x4 (&acc)[2][2][4][2], const Unit& u, int wr, int wc, int fr_in, int fq_in) const {
        int fr = fr_in, fq = fq_in; asm volatile("" : "+v"(fr), "+v"(fq));
        const int row0 = u.pm * BM + wr * 64 + fr, colb = u.pn * BM + wc * 32 + 8 * fq;
#pragma unroll
        for (int ai = 0; ai < 2; ++ai)
#pragma unroll
            for (int m = 0; m < 4; ++m) {
                const int row = row0 + ai * HALF + m * 16;
                const float* xrow = (row < MPROMPT ? xp + (size_t)row * DMODEL : xs + (size_t)(row - MPROMPT) * DMODEL) + colb;
                float* orow = out + (size_t)row * DMODEL + colb;
                float ss = 0.f;
#pragma unroll
                for (int bj = 0; bj < 2; ++bj) {
                    const f32x4 x0 = *(const f32x4*)(xrow + bj * HALF), x1 = *(const f32x4*)(xrow + bj * HALF + 4);
                    const f32x4 v0 = acc[ai][bj][m][0] + x0, v1 = acc[ai][bj][m][1] + x1;
                    *(f32x4*)(orow + bj * HALF) = v0; *(f32x4*)(orow + bj * HALF + 4) = v1;
                    if (A2) *(u32x4*)(A2 + (size_t)row * DMODEL + colb + bj * HALF) = pack8(v0, v1);
                    ss += (v0[0] * v0[0] + v0[1] * v0[1]) + (v0[2] * v0[2] + v0[3] * v0[3]) + (v1[0] * v1[0] + v1[1] * v1[1]) + (v1[2] * v1[2] + v1[3] * v1[3]);
                }
                ss += __shfl_xor(ss, 16); ss += __shfl_xor(ss, 32);
                if (fq == 0) sq[(size_t)row * 16 + u.pn * 4 + wc] = ss;
            }
    }
};
struct EpiFF1 {
    static constexpr bool PERM = true, AFTER_DRAIN = false, RELAX = (RELAX_MASK & 4) != 0;
    bf16_t* H; const float* r2v;
    __device__ __forceinline__ void operator()(const f32x4 (&acc)[2][2][4][2], const Unit& u, int wr, int wc, int fr_in, int fq_in) const {
        int fr = fr_in, fq = fq_in; asm volatile("" : "+v"(fr), "+v"(fq));
        const int row0 = u.pm * BM + wr * 64 + fr, colb = u.pn * BM + wc * 32 + 8 * fq;
        float r2[2][4];
#pragma unroll
        for (int ai = 0; ai < 2; ++ai)
#pragma unroll
            for (int m = 0; m < 4; ++m) r2[ai][m] = r2v[row0 + ai * HALF + m * 16];
        __builtin_amdgcn_sched_barrier(0);
#pragma unroll
        for (int ai = 0; ai < 2; ++ai)
#pragma unroll
            for (int m = 0; m < 4; ++m) {
                const int row = row0 + ai * HALF + m * 16;
#if H_TILED
                bf16_t* rowp = H + ((size_t)u.pm * (DFF / 64) + (size_t)(u.pn * 4 + (wc >> 1))) * (256 * 64) + (size_t)(wr * 64 + fr + ai * HALF + m * 16) * 64 + (wc & 1) * 32 + 8 * fq;
#else
                bf16_t* rowp = H + (size_t)row * DFF + colb;
#endif
#pragma unroll
                for (int bj = 0; bj < 2; ++bj) {
                    f32x4 v0 = acc[ai][bj][m][0], v1 = acc[ai][bj][m][1];
#pragma unroll
                    for (int j = 0; j < 4; ++j) { const float a = fmaxf(v0[j], 0.f), b = fmaxf(v1[j], 0.f); v0[j] = a * a * r2[ai][m]; v1[j] = b * b * r2[ai][m]; }
                    *(u32x4*)(rowp + bj * (H_TILED ? 2 * 256 * 64 : HALF)) = pack8(v0, v1);
                }
            }
    }
};

struct EpiPlain {
    static constexpr bool PERM = true, AFTER_DRAIN = false, RELAX = false;
    bf16_t* P;
    __device__ __forceinline__ void operator()(const f32x4 (&acc)[2][2][4][2], const Unit& u, int wr, int wc, int fr_in, int fq_in) const {
        int fr = fr_in, fq = fq_in; asm volatile("" : "+v"(fr), "+v"(fq));
        const int row0 = u.pm * BM + wr * 64 + fr;
        size_t poff[2]; int W, col;
        plane_of(u.pn, 0, wc, poff[0], W, col); plane_of(u.pn, 1, wc, poff[1], W, col);
#pragma unroll
        for (int ai = 0; ai < 2; ++ai)
#pragma unroll
            for (int m = 0; m < 4; ++m) { const int row = row0 + ai * HALF + m * 16;
#pragma unroll
                for (int bj = 0; bj < 2; ++bj) *(u32x4*)(P + poff[bj] + (size_t)row * W + col + 8 * fq) = pack8(acc[ai][bj][m][0], acc[ai][bj][m][1]); }
    }
};

struct EpiResidX {
    static constexpr bool PERM = true, AFTER_DRAIN = false, RELAX = (RELAX_MASK & 2) != 0;
    const float* xp; const float* xs; bf16_t* A2; float* sq;
    __device__ __forceinline__ void operator()(const f32x4 (&acc)[2][2][4][2], const Unit& u, int wr, int wc, int fr_in, int fq_in) const {
        int fr = fr_in, fq = fq_in; asm volatile("" : "+v"(fr), "+v"(fq));
        const int row0 = u.pm * BM + wr * 64 + fr, colb = u.pn * BM + wc * 32 + 8 * fq;
#pragma unroll
        for (int ai = 0; ai < 2; ++ai) {
            f32x4 xv[4][2][2];
#pragma unroll
            for (int m = 0; m < 4; ++m) { const int row = row0 + ai * HALF + m * 16;
                const float* xrow = (row < MPROMPT ? xp + (size_t)row * DMODEL : xs + (size_t)(row - MPROMPT) * DMODEL) + colb;
#pragma unroll
                for (int bj = 0; bj < 2; ++bj) { xv[m][bj][0] = *(const f32x4*)(xrow + bj * HALF); xv[m][bj][1] = *(const f32x4*)(xrow + bj * HALF + 4); } }
            __builtin_amdgcn_sched_barrier(0);
#pragma unroll
            for (int m = 0; m < 4; ++m) {
                const int row = row0 + ai * HALF + m * 16;
                float ss = 0.f;
#pragma unroll
                for (int bj = 0; bj < 2; ++bj) {
                    const f32x4 v0 = acc[ai][bj][m][0] + xv[m][bj][0], v1 = acc[ai][bj][m][1] + xv[m][bj][1];
                    *(u32x4*)(A2 + (size_t)row * DMODEL + colb + bj * HALF) = pack8(v0, v1);
                    ss += (v0[0] * v0[0] + v0[1] * v0[1]) + (v0[2] * v0[2] + v0[3] * v0[3]) + (v1[0] * v1[0] + v1[1] * v1[1]) + (v1[2] * v1[2] + v1[3] * v1[3]);
                }
                ss += __shfl_xor(ss, 16); ss += __shfl_xor(ss, 32);
                if (fq == 0) sq[(size_t)row * 16 + u.pn * 4 + wc] = ss;
            }
            __builtin_amdgcn_sched_barrier(0);
        }
    }
};
struct EpiResidB {
    static constexpr bool PERM = true, AFTER_DRAIN = false, RELAX = (RELAX_MASK & 8) != 0;
    bf16_t* A2; float* sq;
    __device__ __forceinline__ void operator()(const f32x4 (&acc)[2][2][4][2], const Unit& u, int wr, int wc, int fr_in, int fq_in) const {
        int fr = fr_in, fq = fq_in; asm volatile("" : "+v"(fr), "+v"(fq));
        const int row0 = u.pm * BM + wr * 64 + fr, colb = u.pn * BM + wc * 32 + 8 * fq;
        u32x4 xw[2][4][2];
#pragma unroll
        for (int ai = 0; ai < 2; ++ai)
#pragma unroll
            for (int m = 0; m < 4; ++m)
#pragma unroll
                for (int bj = 0; bj < 2; ++bj) xw[ai][m][bj] = *(const u32x4*)(A2 + (size_t)(row0 + ai * HALF + m * 16) * DMODEL + colb + bj * HALF);
        __builtin_amdgcn_sched_barrier(0);
#pragma unroll
        for (int ai = 0; ai < 2; ++ai)
#pragma unroll
            for (int m = 0; m < 4; ++m) {
                const int row = row0 + ai * HALF + m * 16;
                bf16_t* xr = A2 + (size_t)row * DMODEL + colb;
                float ss = 0.f;
#pragma unroll
                for (int bj = 0; bj < 2; ++bj) {
                    const u32x4 w_ = xw[ai][m][bj];
                    const f32x4 x0 = {__uint_as_float(w_.x << 16), __uint_as_float(w_.x & 0xffff0000u), __uint_as_float(w_.y << 16), __uint_as_float(w_.y & 0xffff0000u)};
                    const f32x4 x1 = {__uint_as_float(w_.z << 16), __uint_as_float(w_.z & 0xffff0000u), __uint_as_float(w_.w << 16), __uint_as_float(w_.w & 0xffff0000u)};
                    const f32x4 v0 = acc[ai][bj][m][0] + x0, v1 = acc[ai][bj][m][1] + x1;
                    *(u32x4*)(xr + bj * HALF) = pack8(v0, v1);
                    ss += (v0[0] * v0[0] + v0[1] * v0[1]) + (v0[2] * v0[2] + v0[3] * v0[3]) + (v1[0] * v1[0] + v1[1] * v1[1]) + (v1[2] * v1[2] + v1[3] * v1[3]);
                }
                ss += __shfl_xor(ss, 16); ss += __shfl_xor(ss, 32);
                if (fq == 0) sq[(size_t)row * 16 + u.pn * 4 + wc] = ss;
            }
    }
};

struct EpiNull {
    static constexpr bool PERM = true, AFTER_DRAIN = false, RELAX = false;
    __device__ __forceinline__ void operator()(const f32x4 (&acc)[2][2][4][2], const Unit& u, int wr, int wc, int fr_in, int fq_in) const {
        int fr = fr_in, fq = fq_in; asm volatile("" : "+v"(fr), "+v"(fq));
#pragma unroll
        for (int ai = 0; ai < 2; ++ai)
#pragma unroll
            for (int m = 0; m < 4; ++m)
#pragma unroll
                for (int bj = 0; bj < 2; ++bj) asm volatile("" :: "v"(acc[ai][bj][m][0]), "v"(acc[ai][bj][m][1]));
    }
};
template <class Epi, class Sched, bool ALIGN_EPI = false, bool SP2 = false>
__device__ __forceinline__ void gemm_phase(PG8_LAS unsigned char* lds, const Gemm g, const Sched& S, const Epi& E) {
    const int tid = threadIdx.x, wid = __builtin_amdgcn_readfirstlane(tid >> 6), lane = tid & 63, wr = wid >> 2, wc = wid & 3, fr = lane & 15, fq = lane >> 4;
    const int K = g.K, nt = K / BK, ldb = g.ldb ? g.ldb : K;
    unsigned voffA[2], voffB[2];
#pragma unroll
    for (int i = 0; i < 2; ++i) { int R, C; stage_rc(tid * 16 + i * 8192, R, C); const int Rb = Epi::PERM ? ((R & ~31) + perm32(R & 31)) : R;
        voffA[i] = (unsigned)(R * g.lda + C) * 2u; voffB[i] = (unsigned)(Rb * ldb + C) * 2u; }
    const size_t kstepA = g.ksA ? (size_t)g.ksA : (size_t)(BK * 2), kstepB = g.ksB ? (size_t)g.ksB : (size_t)(BK * 2);
    const size_t hstepB = (size_t)HALF * ldb * 2, hstepA = (size_t)HALF * g.lda * 2;
    const size_t tstepB = g.psB ? (size_t)g.psB : 2 * hstepB, tstepA = g.psA ? (size_t)g.psA : 2 * hstepA;
    const unsigned ldsw = (unsigned)wid * 1024u;
    const int aoff = lds_byte(wr * 64 + fr, fq * 8), boff = lds_byte(wc * 32 + fr, fq * 8);
#define PG8_SA(b, h) (((b) * 2 + (h)) * HTB)
#define PG8_SB(b, h) ((4 + (b) * 2 + (h)) * HTB)
#define PG8_STAGE(bufoff, gbase, voff) do { _Pragma("unroll") for (int _i = 0; _i < 2; ++_i) \
        __builtin_amdgcn_global_load_lds((const unsigned*)((const char*)(gbase) + (voff)[_i]), (PG8_LAS unsigned*)(lds + (bufoff) + ldsw + _i * 8192), 16, 0, 0); } while (0)
#define PG8_LDA(dst, b, h) do { _Pragma("unroll") for (int m = 0; m < 4; ++m) _Pragma("unroll") for (int k = 0; k < 2; ++k) dst[m][k] = *(const PG8_LAS bf16x8*)(lds + PG8_SA(b, h) + aoff + m * 2048 + k * 1024); } while (0)
#define PG8_LDB(dst, b, h) do { _Pragma("unroll") for (int n = 0; n < 2; ++n) _Pragma("unroll") for (int k = 0; k < 2; ++k) dst[n][k] = *(const PG8_LAS bf16x8*)(lds + PG8_SB(b, h) + boff + n * 2048 + k * 1024); } while (0)
#define PG8_MMA(ai, bj, At, Bt) do { __builtin_amdgcn_s_setprio(1); _Pragma("unroll") for (int m = 0; m < 4; ++m) _Pragma("unroll") for (int n = 0; n < 2; ++n) _Pragma("unroll") for (int k = 0; k < 2; ++k) \
        acc[ai][bj][m][n] = __builtin_amdgcn_mfma_f32_16x16x32_bf16(Bt[n][k], At[m][k], acc[ai][bj][m][n], 0, 0, 0); __builtin_amdgcn_s_setprio(0); } while (0)
#define PG8_WAIT_V(n) asm volatile("s_waitcnt vmcnt(" #n ")" ::: "memory")
#define PG8_WAIT_L(n) asm volatile("s_waitcnt lgkmcnt(" #n ")" ::: "memory")
#define PG8_WAIT_VF(first, nrel) asm volatile("s_cmp_lg_u32 %0, 0\n\ts_cbranch_scc1 1f\n\ts_waitcnt vmcnt(8)\n\ts_branch 2f\n1:\n\ts_waitcnt vmcnt(" #nrel ")\n2:" :: "s"(first) : "memory", "scc")
#define PG8_BAR __builtin_amdgcn_s_barrier()
#define PG8_SCHED __builtin_amdgcn_sched_barrier(0)
    Unit cur, nxt; int ui = 0;
    if (!S.next(0, cur)) return;
    f32x4 acc[2][2][4][2];
#pragma unroll
    for (int a = 0; a < 2; ++a)
#pragma unroll
        for (int b = 0; b < 2; ++b)
#pragma unroll
            for (int m = 0; m < 4; ++m)
#pragma unroll
                for (int n = 0; n < 2; ++n) acc[a][b][m][n] = (f32x4){0.f, 0.f, 0.f, 0.f};
    bf16x8 At[4][2], B0[2][2], B1[2][2];
    const char* cA = (const char*)g.A + (size_t)cur.pm * tstepA; const char* cB = (const char*)g.Bt + (size_t)cur.pn * tstepB;
    S.a_ready(cur);
    if constexpr (SP2) {
        PG8_STAGE(PG8_SB(0, 0), cB, voffB); PG8_STAGE(PG8_SB(0, 1), cB + hstepB, voffB); PG8_STAGE(PG8_SA(0, 0), cA, voffA); PG8_STAGE(PG8_SA(0, 1), cA + hstepA, voffA);
        if (wr == 1) PG8_BAR;
        PG8_WAIT_V(2); PG8_BAR;
        PG8_STAGE(PG8_SB(1, 0), cB + kstepB, voffB); PG8_STAGE(PG8_SA(1, 0), cA + kstepA, voffA); PG8_STAGE(PG8_SB(1, 1), cB + hstepB + kstepB, voffB); PG8_STAGE(PG8_SA(1, 1), cA + hstepA + kstepA, voffA);
        PG8_WAIT_V(8); PG8_BAR;
    } else {
        PG8_STAGE(PG8_SB(0, 0), cB, voffB); PG8_STAGE(PG8_SA(0, 0), cA, voffA); PG8_STAGE(PG8_SB(0, 1), cB + hstepB, voffB); PG8_STAGE(PG8_SA(0, 1), cA + hstepA, voffA);
        if (wr == 1) PG8_BAR;
        PG8_WAIT_V(4); PG8_BAR;
        PG8_STAGE(PG8_SB(1, 0), cB + kstepB, voffB); PG8_STAGE(PG8_SA(1, 0), cA + kstepA, voffA); PG8_STAGE(PG8_SB(1, 1), cB + hstepB + kstepB, voffB);
        PG8_WAIT_V(6); PG8_BAR;
    }
    for (;;) {
        const bool has_next = S.next(ui + 1, nxt);
        const char* nA = has_next ? (const char*)g.A + (size_t)nxt.pm * tstepA : cA; const char* nB = has_next ? (const char*)g.Bt + (size_t)nxt.pn * tstepB : cB;
        for (int t = 0; t < nt; t += 2) {
            const bool last = (t == nt - 2);
            const char* a1 = cA + (size_t)(t + 1) * kstepA;
            const char* a2 = last ? nA : cA + (size_t)(t + 2) * kstepA; const char* b2 = last ? nB : cB + (size_t)(t + 2) * kstepB;
            const char* a3 = a2 + kstepA; const char* b3 = b2 + kstepB;
            if (last && has_next) S.a_ready(nxt);
            if constexpr (SP2) {
            const int first = __builtin_amdgcn_readfirstlane((t == 0 && ui > 0) ? 1 : 0);
            PG8_LDB(B0, 0, 0); PG8_LDB(B1, 0, 1); PG8_SCHED; PG8_LDA(At, 0, 0);
            PG8_WAIT_VF(first, 16); PG8_WAIT_L(0); PG8_BAR; PG8_MMA(0, 0, At, B0); PG8_MMA(0, 1, At, B1); PG8_BAR; PG8_SCHED;
            PG8_LDA(At, 0, 1); PG8_STAGE(PG8_SB(0, 0), b2, voffB); PG8_STAGE(PG8_SB(0, 1), b2 + hstepB, voffB); PG8_STAGE(PG8_SA(0, 0), a2, voffA);
            PG8_WAIT_VF(first, 22); PG8_WAIT_L(0); PG8_BAR; PG8_MMA(1, 0, At, B0); PG8_MMA(1, 1, At, B1); PG8_BAR; PG8_SCHED;
            PG8_LDB(B0, 1, 0); PG8_LDB(B1, 1, 1); PG8_SCHED; PG8_LDA(At, 1, 0); PG8_STAGE(PG8_SA(0, 1), a2 + hstepA, voffA);
            PG8_WAIT_VF(first, 24); PG8_WAIT_L(0); PG8_BAR; PG8_MMA(0, 0, At, B0); PG8_MMA(0, 1, At, B1); PG8_BAR; PG8_SCHED;
            PG8_LDA(At, 1, 1); PG8_STAGE(PG8_SB(1, 0), b3, voffB); PG8_STAGE(PG8_SB(1, 1), b3 + hstepB, voffB); PG8_STAGE(PG8_SA(1, 0), a3, voffA);
            PG8_WAIT_V(8); PG8_WAIT_L(0); PG8_BAR; PG8_MMA(1, 0, At, B0); PG8_MMA(1, 1, At, B1); PG8_BAR; PG8_SCHED;
            PG8_STAGE(PG8_SA(1, 1), a3 + hstepA, voffA);
            } else {
            PG8_LDB(B0, 0, 0); PG8_SCHED; PG8_LDA(At, 0, 0); PG8_STAGE(PG8_SA(1, 1), a1 + hstepA, voffA);
            PG8_WAIT_L(8); PG8_BAR; PG8_WAIT_L(0); PG8_MMA(0, 0, At, B0); PG8_BAR; PG8_SCHED;
            PG8_LDB(B1, 0, 1); PG8_STAGE(PG8_SB(0, 0), b2, voffB);
            PG8_BAR; PG8_WAIT_L(0); PG8_MMA(0, 1, At, B1); PG8_BAR;
            PG8_LDA(At, 0, 1); PG8_STAGE(PG8_SA(0, 0), a2, voffA);
            PG8_BAR; PG8_WAIT_L(0); PG8_MMA(1, 0, At, B0); PG8_BAR; PG8_SCHED;
            PG8_STAGE(PG8_SB(0, 1), b2 + hstepB, voffB);
            PG8_WAIT_V(6); PG8_BAR; PG8_MMA(1, 1, At, B1); PG8_BAR;
            PG8_LDB(B0, 1, 0); PG8_SCHED; PG8_LDA(At, 1, 0); PG8_STAGE(PG8_SA(0, 1), a2 + hstepA, voffA);
            PG8_WAIT_L(8); PG8_BAR; PG8_WAIT_L(0); PG8_MMA(0, 0, At, B0); PG8_BAR; PG8_SCHED;
            PG8_LDB(B1, 1, 1); PG8_STAGE(PG8_SB(1, 0), b3, voffB);
            PG8_BAR; PG8_WAIT_L(0); PG8_MMA(0, 1, At, B1); PG8_BAR;
            PG8_LDA(At, 1, 1); PG8_STAGE(PG8_SA(1, 0), a3, voffA);
            PG8_BAR; PG8_WAIT_L(0); PG8_MMA(1, 0, At, B0); PG8_BAR; PG8_SCHED;
            PG8_STAGE(PG8_SB(1, 1), b3 + hstepB, voffB);
            PG8_WAIT_V(6); PG8_BAR; PG8_MMA(1, 1, At, B1); PG8_BAR;
            }
        }
        if constexpr (ALIGN_EPI) { if (wr == 0) PG8_BAR; }
        if constexpr (!Epi::AFTER_DRAIN) { E(acc, cur, wr, wc, fr, fq); S.done(cur); }
        if (!has_next) break;
#pragma unroll
        for (int a = 0; a < 2; ++a)
#pragma unroll
            for (int b = 0; b < 2; ++b)
#pragma unroll
                for (int m = 0; m < 4; ++m)
#pragma unroll
                    for (int n = 0; n < 2; ++n) acc[a][b][m][n] = (f32x4){0.f, 0.f, 0.f, 0.f};
        cur = nxt; cA = nA; cB = nB; ++ui;
        if constexpr (ALIGN_EPI) { if (wr == 1) PG8_BAR; }
    }
    PG8_WAIT_V(0);
    if constexpr (!ALIGN_EPI) { if (wr == 0) PG8_BAR; }
    PG8_BAR;
    if constexpr (Epi::AFTER_DRAIN) { E.fused(acc, cur, wr, wc, fr, fq, lds, wid, lane); S.done(cur); }
#undef PG8_SA
#undef PG8_SB
#undef PG8_STAGE
#undef PG8_LDA
#undef PG8_LDB
#undef PG8_MMA
#undef PG8_WAIT_V
#undef PG8_WAIT_L
#undef PG8_WAIT_VF
#undef PG8_BAR
#undef PG8_SCHED
}
}
#define GAS __attribute__((address_space(1)))
#define LAS __attribute__((address_space(3)))
typedef unsigned short bf16;
typedef unsigned v4u __attribute__((ext_vector_type(4)));
typedef float f32x4 __attribute__((ext_vector_type(4)));
typedef short bf16x8 __attribute__((ext_vector_type(8)));
typedef GAS unsigned gu32;
typedef GAS unsigned long long gu64;
#define RLX_AGENT __ATOMIC_RELAXED, __HIP_MEMORY_SCOPE_AGENT
#define LDS_WAIT() asm volatile("s_waitcnt lgkmcnt(0)" ::: "memory")
#define VM_WAIT() asm volatile("s_waitcnt vmcnt(0)" ::: "memory")
__device__ __forceinline__ unsigned long long rt() { return __builtin_amdgcn_s_memrealtime(); }
__device__ __forceinline__ unsigned f2bf(float f) { unsigned u = __builtin_bit_cast(unsigned, f); return (u + 0x7fffu + ((u >> 16) & 1u)) >> 16; }
__device__ __forceinline__ unsigned pk2(float lo, float hi) { return f2bf(lo) | (f2bf(hi) << 16); }

#define XB_TMO      128
#define XB_XCNT(j)  (256  + 64 * (j))
#define XB_XSUB(j)  (1280 + 64 * (j))
#define XB_XGEN(j)  (2304 + 64 * (j))
#define XB_TOP      3328
#define XB_TOPGEN   3392
#define XCD_BAR_WORDS 3456
#define XB_SPIN_CAP (1u << 18)

__device__ __forceinline__ unsigned xb_ld(unsigned* p)              { return __hip_atomic_load(p, __ATOMIC_RELAXED, __HIP_MEMORY_SCOPE_AGENT); }
__device__ __forceinline__ unsigned xb_add(unsigned* p, unsigned v) { return __hip_atomic_fetch_add(p, v, __ATOMIC_RELAXED, __HIP_MEMORY_SCOPE_AGENT); }
__device__ __forceinline__ unsigned xb_xcc_id() { return (unsigned)__builtin_amdgcn_s_getreg((3 << 11) | 20) & 0xFu; }
#define XB_SPIN(cond, bar) do { unsigned _sp = 0; while (cond) { __builtin_amdgcn_s_sleep(1); \
    if ((++_sp & 255u) == 0u) { if (xb_ld(&(bar)[XB_TMO])) break; if (_sp > XB_SPIN_CAP) { atomicAdd(&(bar)[XB_TMO], 1u); break; } } } } while (0)

struct XcdBarrier {
    unsigned* bar; unsigned x;
    volatile LAS unsigned* st;
};

__device__ __forceinline__ XcdBarrier xcd_barrier_post(unsigned* bar, volatile LAS unsigned* st) {
    XcdBarrier b; b.bar = bar; b.x = xb_xcc_id(); b.st = st;
    if (threadIdx.x == 0) (void)xb_add(&bar[XB_XCNT(b.x)], 1u);
    return b;
}
__device__ __forceinline__ void xcd_barrier_complete(unsigned* bar, unsigned x, unsigned& nloc, unsigned& nx) {
    const unsigned G = gridDim.x * gridDim.y * gridDim.z;
    unsigned sum, cnt, mine, sp = 0u;
    for (;;) {
        sum = 0u; cnt = 0u; mine = 0u;
#pragma unroll
        for (unsigned j = 0; j < 16; ++j) { const unsigned c = xb_ld(&bar[XB_XCNT(j)]); sum += c; cnt += (c > 0u) ? 1u : 0u; mine = (j == x) ? c : mine; }
        if (sum == G) break;
        __builtin_amdgcn_s_sleep(1);
        if ((++sp & 255u) == 0u) { if (xb_ld(&bar[XB_TMO])) break; if (sp > XB_SPIN_CAP) { atomicAdd(&bar[XB_TMO], 1u); break; } }
    }
    nloc = mine > 0u ? mine : 1u; nx = cnt > 0u ? cnt : 1u;
}

__device__ __forceinline__ void xcd_barrier(const XcdBarrier& b) {
    asm volatile("s_waitcnt vmcnt(0)" ::: "memory");
    __syncthreads();
    if (threadIdx.x == 0) {
        unsigned* bar = b.bar;
        __builtin_amdgcn_s_waitcnt(0);
        unsigned nloc = b.st[0], nx = b.st[1];
        if (nloc == 0u) { xcd_barrier_complete(bar, b.x, nloc, nx); b.st[0] = nloc; b.st[1] = nx; }
        const unsigned old = xb_add(&bar[XB_XSUB(b.x)], 1u);
        const unsigned gen = old / nloc;
        if (old + 1u == (gen + 1u) * nloc) {
            __builtin_amdgcn_fence(__ATOMIC_RELEASE, "agent");
            asm volatile("s_waitcnt vmcnt(0)" ::: "memory");
            const unsigned og = xb_add(&bar[XB_TOP], 1u);
            const unsigned tg = og / nx;
            if (og + 1u == (tg + 1u) * nx) xb_add(&bar[XB_TOPGEN], 1u);
            else XB_SPIN(xb_ld(&bar[XB_TOPGEN]) == tg, bar);
            __builtin_amdgcn_fence(__ATOMIC_ACQUIRE, "agent");
            xb_add(&bar[XB_XGEN(b.x)], 1u);
            asm volatile("s_waitcnt vmcnt(0)" ::: "memory");
        } else {
            XB_SPIN(xb_ld(&bar[XB_XGEN(b.x)]) == gen, bar);
            __builtin_amdgcn_fence(__ATOMIC_ACQUIRE, "agent");
            asm volatile("s_waitcnt vmcnt(0)" ::: "memory");
        }
    }
    __syncthreads();
}
#ifndef FF2_REV
#define FF2_REV 1
#endif
#ifndef W2_TILED
#define W2_TILED 1
#endif
constexpr int NWAVES = 8;
constexpr int M_TOK = 98304, M_PROMPT = 65536, D = 1024, NP = 3584, NWIN = 3616, FF = 4096;
constexpr int L_PROMPT = 2048, L_SAMPLE = 16384;
constexpr float EPS = 1e-6f;
constexpr size_t MiB = 1u << 20;
constexpr size_t WS_CTL = 0, CTL_ZERO_BYTES = 1 * MiB;
constexpr size_t WS_WIN = 1 * MiB;
constexpr size_t WS_WOUT = 9 * MiB;
constexpr size_t WS_W1 = 11 * MiB;
constexpr size_t WS_W2 = 19 * MiB;
constexpr size_t WS_ROPE = 27 * MiB;
constexpr size_t WS_GA = 35 * MiB;
constexpr size_t WS_RSTD = 47 * MiB;
constexpr size_t WS_SQ1 = 48 * MiB;
constexpr size_t WS_SQ2 = 54 * MiB;
constexpr size_t WS_DEC = 60 * MiB;
constexpr size_t WS_R0 = 64 * MiB;
constexpr size_t WS_R1 = 256 * MiB;
constexpr size_t WS_END = 1024 * MiB;
constexpr int CW_BAR = 4096;
constexpr int RING_OFF = 0, RING_BYTES = 131072;
constexpr int LDSCTL_OFF = 147456 - 1024, MISC_OFF = LDSCTL_OFF + 320;
constexpr int LDS_BYTES = 147456;

struct Frame {
    LAS unsigned char* lds;
    volatile LAS unsigned* MISC;
    int tid, lane, wave, vcu, G;
};
__device__ __forceinline__ float wave_sum(float v) {
#pragma unroll
    for (int o = 1; o < 64; o <<= 1) v += __shfl_xor(v, o);
    return v;
}
__device__ __forceinline__ float bf2f(bf16 b) { return __uint_as_float((unsigned)b << 16); }
__device__ __forceinline__ unsigned cvtpk(float lo, float hi) { unsigned r; asm volatile("v_cvt_pk_bf16_f32 %0, %1, %2" : "=v"(r) : "v"(lo), "v"(hi)); return r; }

__device__ __forceinline__ void win_map(int nd, int& sc, float& cs) {
    cs = 1.f;
    if (nd < 512) sc = 512 + nd;
    else if (nd < 1024) sc = 2592 + (nd - 512);
    else if (nd < 1280) { sc = nd - 1024; cs = 0.125f; }
    else if (nd < 1536) sc = 256 + (nd - 1280);
    else if (nd < 2048) sc = 1024 + (nd - 1536);
    else if (nd < 3072) {
        const bool isq = nd < 2560; const int p = nd - (isq ? 2048 : 2560), h = p >> 7, pp = p & 127, u = pp >> 3, j = pp & 7;
        const int d = (j < 4) ? 4 * u + j : 64 + 4 * u + (j - 4);
        sc = (isq ? 1568 : 2080) + 128 * h + d; if (isq) cs = 0.08838834764831845f; }
    else if (nd < 3584) sc = 3104 + (nd - 3072);
    else sc = 1536 + (nd - 3584);
}
template <bool MAP, bool TILED = false>
__device__ __forceinline__ void p0_transpose_item(const float* W, int K, int Nsrc, int nblk, const float* ks, bf16* WT, LAS float* scr, int item, int lane) {
    const int kb = item / nblk, nb = item % nblk, k0 = 64 * kb, n0 = 32 * nb;
    int sc = n0 + (lane & 31); float cs = 1.f;
    if (MAP) win_map(n0 + (lane & 31), sc, cs);
#pragma unroll 8
    for (int i = 0; i < 32; ++i) { const int kk = 2 * i + (lane >> 5); float w = W[(size_t)(k0 + kk) * Nsrc + sc] * cs; if (ks) w *= ks[k0 + kk]; scr[kk * 33 + (lane & 31)] = w; }
    LDS_WAIT(); asm volatile("" ::: "memory");
    const int c = lane & 7;
#pragma unroll
    for (int j = 0; j < 4; ++j) { const int n = (lane >> 3) + 8 * j; const LAS float* s = scr + (8 * c) * 33 + n;
        v4u o; o.x = cvtpk(s[0 * 33], s[1 * 33]); o.y = cvtpk(s[2 * 33], s[3 * 33]); o.z = cvtpk(s[4 * 33], s[5 * 33]); o.w = cvtpk(s[6 * 33], s[7 * 33]);
        if (TILED) { const int nn = n0 + n; *(GAS v4u*)(WT + (((size_t)(nn >> 8) * (K >> 6) + (k0 >> 6)) * 256 + (nn & 255)) * 64 + 8 * c) = o; }
        else *(GAS v4u*)(WT + (size_t)(n0 + n) * K + k0 + 8 * c) = o; }
    LDS_WAIT(); asm volatile("" ::: "memory");
}
__device__ __forceinline__ void rope_entry(int e, float* rcos, float* rsin) {
    const int pos = e >> 6, i = e & 63;
    double inv = 1.0, b = 0.8659643233600653;
#pragma unroll
    for (int bit = 0; bit < 6; ++bit) { if ((i >> bit) & 1) inv *= b; b *= b; }
    const double ang = (double)pos * inv;
    const double n = __builtin_rint(ang * 0.6366197723675814);
    double r = __builtin_fma(-n, 1.5707963267948966, ang); r = __builtin_fma(-n, 6.123233995736766e-17, r);
    const double r2 = r * r;
    double s = -1.0 / 1307674368000.0;
    s = s * r2 + 1.0 / 6227020800.0; s = s * r2 - 1.0 / 39916800.0; s = s * r2 + 1.0 / 362880.0; s = s * r2 - 1.0 / 5040.0; s = s * r2 + 1.0 / 120.0; s = s * r2 - 1.0 / 6.0; s = s * r2 * r + r;
    double c = 1.0 / 20922789888000.0;
    c = c * r2 - 1.0 / 87178291200.0; c = c * r2 + 1.0 / 479001600.0; c = c * r2 - 1.0 / 3628800.0; c = c * r2 + 1.0 / 40320.0; c = c * r2 - 1.0 / 720.0; c = c * r2 + 1.0 / 24.0; c = c * r2 - 0.5; c = c * r2 + 1.0;
    const int q = ((int)n) & 3;
    const double cs = (q == 0) ? c : (q == 1) ? -s : (q == 2) ? -c : s;
    const double sn = (q == 0) ? s : (q == 1) ? c : (q == 2) ? -s : -c;
    rcos[e] = (float)cs; rsin[e] = (float)sn;
}
struct P0Args { const float *xp, *xs, *anw, *win, *wout, *mnw, *w1, *w2; bf16 *Win_t, *Wout_t, *W1_t, *W2_t, *Xb; float *rcos, *rsin, *ga, *rstd; };
__device__ __forceinline__ void p0_prologue(Frame& F, const P0Args& a, int parts = 3) {
    LAS float* scr = (LAS float*)(F.lds + RING_OFF + F.wave * 16384);
    const int gw = F.vcu * NWAVES + F.wave, NGW = F.G * NWAVES;
    constexpr int I_IN = (D / 64) * (NWIN / 32), I_O = (D / 64) * (D / 32), I_1 = (D / 64) * (FF / 32), I_2 = (FF / 64) * (D / 32);
    constexpr int NITEMS = I_IN + I_O + I_1 + I_2;
    if (parts & 1) for (int it = gw; it < NITEMS; it += NGW) {
        int r = it;
        if (r < I_IN) { p0_transpose_item<true>(a.win, D, NWIN, NWIN / 32, a.anw, a.Win_t, scr, r, F.lane); continue; } r -= I_IN;
        if (r < I_O) { p0_transpose_item<false>(a.wout, D, D, D / 32, nullptr, a.Wout_t, scr, r, F.lane); continue; } r -= I_O;
        if (r < I_1) { p0_transpose_item<false>(a.w1, D, FF, FF / 32, a.mnw, a.W1_t, scr, r, F.lane); continue; } r -= I_1;
        p0_transpose_item<false, W2_TILED != 0>(a.w2, FF, D, D / 32, nullptr, a.W2_t, scr, r, F.lane);
    }
    if (parts & 1) for (int e = (blockIdx.x * NWAVES * 64) + F.tid; e < 16384 * 64; e += F.G * NWAVES * 64) rope_entry(e, a.rcos, a.rsin);
    __syncthreads();
    LAS bf16* wl = (LAS bf16*)(F.lds + RING_OFF);
    for (int e = F.tid; e < 32 * 1024; e += NWAVES * 64) { const int k = e >> 5, c = e & 31; wl[c * 1032 + k] = (bf16)(cvtpk(a.win[(size_t)k * NWIN + 1536 + c] * a.anw[k], 0.f) & 0xffffu); }
    __syncthreads();
    const int r = F.lane & 15, g = F.lane >> 4;
    LAS unsigned char* tl = F.lds + RING_OFF + 66048 + F.wave * 8448;
    if (parts & 2) {
        f32x4 xa[16], xb[16];
#define P0_LOAD(dst, it_, kc_) do { const int r0_ = (it_) * 16; const float* xp_ = (r0_ < M_PROMPT ? a.xp + (size_t)r0_ * D : a.xs + (size_t)(r0_ - M_PROMPT) * D) + 4 * F.lane + 256 * (kc_); \
            _Pragma("unroll") for (int rr = 0; rr < 16; ++rr) dst[rr] = *(const GAS f32x4*)(xp_ + (size_t)rr * D); } while (0)
#define P0_PROC(src, kc_) do { \
            _Pragma("unroll") for (int rr = 0; rr < 16; ++rr) { unsigned long long pk = (unsigned long long)cvtpk(src[rr][0], src[rr][1]) | ((unsigned long long)cvtpk(src[rr][2], src[rr][3]) << 32); \
                *(LAS unsigned long long*)(tl + rr * 528 + F.lane * 8) = pk; *(GAS unsigned long long*)(xo + (size_t)rr * D + 256 * (kc_)) = pk; } \
            asm volatile("s_waitcnt lgkmcnt(0)" ::: "memory"); \
            _Pragma("unroll") for (int s8 = 0; s8 < 8; ++s8) { \
                const bf16x8 af = *(const LAS bf16x8*)(tl + r * 528 + 64 * s8 + 16 * g); \
                const int k0 = 256 * (kc_) + 32 * s8 + 8 * g; \
                const bf16x8 b0 = *(const LAS bf16x8*)(wl + r * 1032 + k0), b1 = *(const LAS bf16x8*)(wl + (16 + r) * 1032 + k0); \
                acc0 = __builtin_amdgcn_mfma_f32_16x16x32_bf16(af, b0, acc0, 0, 0, 0); acc1 = __builtin_amdgcn_mfma_f32_16x16x32_bf16(af, b1, acc1, 0, 0, 0); \
                const v4u aw = __builtin_bit_cast(v4u, af); \
                _Pragma("unroll") for (int j = 0; j < 4; ++j) { const unsigned u = ((const unsigned*)&aw)[j]; const float lo = __uint_as_float(u << 16), hi = __uint_as_float(u & 0xffff0000u); ss += lo * lo + hi * hi; } } \
            asm volatile("s_waitcnt lgkmcnt(0)" ::: "memory"); } while (0)
        if (gw < M_TOK / 16) P0_LOAD(xa, gw, 0);
        for (int item = gw; item < M_TOK / 16; item += NGW) {
            const int row0 = item * 16;
            bf16* xo = a.Xb + (size_t)row0 * D + 4 * F.lane;
            f32x4 acc0 = {0.f, 0.f, 0.f, 0.f}, acc1 = {0.f, 0.f, 0.f, 0.f}; float ss = 0.f;
            const int nitem = item + NGW < M_TOK / 16 ? item + NGW : item;
            P0_LOAD(xb, item, 1); __builtin_amdgcn_sched_barrier(0); P0_PROC(xa, 0); __builtin_amdgcn_sched_barrier(0);
            P0_LOAD(xa, item, 2); __builtin_amdgcn_sched_barrier(0); P0_PROC(xb, 1); __builtin_amdgcn_sched_barrier(0);
            P0_LOAD(xb, item, 3); __builtin_amdgcn_sched_barrier(0); P0_PROC(xa, 2); __builtin_amdgcn_sched_barrier(0);
            P0_LOAD(xa, nitem, 0); __builtin_amdgcn_sched_barrier(0); P0_PROC(xb, 3); __builtin_amdgcn_sched_barrier(0);
            ss += __shfl_xor(ss, 16); ss += __shfl_xor(ss, 32);
            const float rs = 1.0f / sqrtf(ss * (1.0f / 1024.0f) + EPS);
            if (g == 0) a.rstd[row0 + r] = rs;
#pragma unroll
            for (int q = 0; q < 4; ++q) { const int rr = 4 * g + q; const float rq = __shfl(rs, rr);
                a.ga[(size_t)(row0 + rr) * 32 + r] = acc0[q] * rq; a.ga[(size_t)(row0 + rr) * 32 + 16 + r] = acc1[q] * rq; }
        }
#undef P0_LOAD
#undef P0_PROC
    }
}

__device__ __forceinline__ float log_sigmoid_f(float z) { return fminf(z, 0.f) - log1pf(expf(-fabsf(z))); }
struct MixArgs { bf16* proj; const float* ga; const float *waf, *baf, *wab, *bab; float* of; const float *gnw, *rnw, *rnb; };
constexpr int NTB = 16;
template <int DK, bool GLA, bool BWD>
__device__ __forceinline__ void naive_sweep(Frame& F, const MixArgs& a, int job) {
    const int grp = F.tid >> 7, gt = F.tid & 127;
    int seq, head; if (job < 16) { seq = 32 + (job >> 3); head = job & 7; } else { seq = (job - 16) >> 3; head = (job - 16) & 7; }
    const int L = seq < 32 ? L_PROMPT : L_SAMPLE, row_base = seq < 32 ? seq * L_PROMPT : M_PROMPT + (seq - 32) * L_SAMPLE;
    const int hh = GLA ? head : head - 4;
    const int qcol = GLA ? 1024 + 64 * hh : 2048 + 128 * hh, kcol = GLA ? 1280 + 64 * hh : 2560 + 128 * hh, vcol = 128 * head;
    LAS float* sq = (LAS float*)(F.lds + grp * (3 * NTB * 128 * 4)); LAS float* sk = sq + NTB * DK; LAS float* sa = sk + NTB * DK;
    const float gam = 1.0f - exp2f(-5.0f - (float)hh);
    const float* wal = BWD ? a.wab : a.waf; const float* bal = BWD ? a.bab : a.baf;
    float S[DK];
#pragma unroll
    for (int t = 0; t < DK; ++t) S[t] = 0.f;
    for (int t0 = 0; t0 < L; t0 += NTB) {
        __syncthreads();
        for (int e = gt; e < NTB * DK; e += 128) {
            const int tok = e / DK, t = e % DK, tp = t0 + tok, row = row_base + (BWD ? L - 1 - tp : tp);
            const bf16* pr = a.proj + (size_t)row * NP;
            sq[e] = bf2f(pr[qcol + t]); sk[e] = bf2f(pr[kcol + t]);
            if (GLA) { const float* gar = a.ga + (size_t)row * 32 + (BWD ? 16 : 0); float z = bal[64 * hh + t];
#pragma unroll
                for (int r = 0; r < 16; ++r) z += gar[r] * wal[r * 256 + 64 * hh + t];
                sa[e] = expf(fmaxf(log_sigmoid_f(z) * (1.0f / 16.0f), -1.0f)); }
        }
        __syncthreads();
        for (int tok = 0; tok < NTB; ++tok) {
            const int tp = t0 + tok, row = row_base + (BWD ? L - 1 - tp : tp);
            const float vv = bf2f(a.proj[(size_t)row * NP + vcol + gt]);
            float o = 0.f;
#pragma unroll
            for (int t4 = 0; t4 < DK / 4; ++t4) {
                const f32x4 q = *(const LAS f32x4*)(sq + tok * DK + 4 * t4), k = *(const LAS f32x4*)(sk + tok * DK + 4 * t4);
                f32x4 al = {gam, gam, gam, gam}; if (GLA) al = *(const LAS f32x4*)(sa + tok * DK + 4 * t4);
#pragma unroll
                for (int j = 0; j < 4; ++j) {
                    if (!BWD) { S[4 * t4 + j] = al[j] * S[4 * t4 + j] + k[j] * vv; o += q[j] * S[4 * t4 + j]; }
                    else { S[4 * t4 + j] *= al[j]; o += q[j] * S[4 * t4 + j]; S[4 * t4 + j] += k[j] * vv; }
                }
            }
            float* op = a.of + (size_t)row * D + 128 * head + gt;
            if (!BWD) *op = o; else *op += o;
        }
    }
}
template <bool BWD>
__device__ __forceinline__ void naive_mix_phase(Frame& F, const MixArgs& a) {
    if (blockIdx.x >= 68) return;
    const int job = blockIdx.x * 4 + (F.tid >> 7);
    if ((blockIdx.x & 1) == 0) { if (!MIX_GLA) naive_sweep<64, true, BWD>(F, a, job); } else { if (!MIX_RET) naive_sweep<128, false, BWD>(F, a, job); }
}
__device__ __forceinline__ void naive_combine(Frame& F, const MixArgs& a) {
    const int gw = F.vcu * NWAVES + F.wave, NGW = F.G * NWAVES, c = 2 * F.lane;
    for (int item = gw; item < M_TOK * 8; item += NGW) {
        const int row = item >> 3, head = item & 7;
        if (head < 4 ? MIX_GLA : MIX_RET) continue;
        const float* op = a.of + (size_t)row * D + 128 * head + c;
        float o0 = op[0], o1 = op[1], y0, y1;
        if (head < 4) { const float r = 1.0f / sqrtf(wave_sum(o0 * o0 + o1 * o1) * (1.0f / 128.0f) + EPS); y0 = o0 * r * a.gnw[c]; y1 = o1 * r * a.gnw[c + 1]; }
        else { const float mu = wave_sum(o0 + o1) * (1.0f / 128.0f); o0 -= mu; o1 -= mu; const float r = 1.0f / sqrtf(wave_sum(o0 * o0 + o1 * o1) * (1.0f / 128.0f) + EPS);
            const int cc = 128 * (head - 4) + c; y0 = o0 * r * a.rnw[cc] + a.rnb[cc]; y1 = o1 * r * a.rnw[cc + 1] + a.rnb[cc + 1]; }
        bf16* pr = a.proj + (size_t)row * NP;
        const int gcol = (head < 4 ? 1536 + 128 * head : 3072 + 128 * (head - 4)) + c;
        const unsigned gw2 = *(const unsigned*)(pr + gcol);
        const float g0 = __uint_as_float(gw2 << 16), g1 = __uint_as_float(gw2 & 0xffff0000u);
        y0 *= g0 / (1.0f + expf(-g0)); y1 *= g1 / (1.0f + expf(-g1));
        *(unsigned*)(pr + 128 * head + c) = cvtpk(y0, y1);
    }
}
__device__ __forceinline__ void final_norm(Frame& F, float* out, const bf16* x2b, const float* sq, const float* w) {
    const int gw = F.vcu * NWAVES + F.wave, NGW = F.G * NWAVES;
    const f32x4* w4 = (const f32x4*)w + 2 * F.lane;
    f32x4 wv[2][2];
#pragma unroll
    for (int j = 0; j < 2; ++j) { wv[j][0] = w4[128 * j]; wv[j][1] = w4[128 * j + 1]; }
    for (int r0 = 4 * gw; r0 < M_TOK; r0 += 4 * NGW) {
        v4u xw[4][2]; f32x4 s4[4];
#pragma unroll
        for (int k = 0; k < 4; ++k) { const int row = r0 + k;
            s4[k] = *(const GAS f32x4*)(sq + (size_t)row * 16 + 4 * (F.lane & 3));
            const GAS v4u* xi = (const GAS v4u*)(x2b + (size_t)row * D) + F.lane;
            xw[k][0] = xi[0]; xw[k][1] = xi[64]; }
#pragma unroll
        for (int k = 0; k < 4; ++k) { const int row = r0 + k;
            float t = (s4[k][0] + s4[k][1]) + (s4[k][2] + s4[k][3]); t += __shfl_xor(t, 1); t += __shfl_xor(t, 2);
            const float r = 1.0f / sqrtf(t * (1.0f / 1024.0f) + EPS);
            GAS f32x4* o = (GAS f32x4*)(out + (size_t)row * D) + 2 * F.lane;
#pragma unroll
            for (int j = 0; j < 2; ++j) { const v4u x = xw[k][j];
                const f32x4 x0 = {__uint_as_float(x.x << 16), __uint_as_float(x.x & 0xffff0000u), __uint_as_float(x.y << 16), __uint_as_float(x.y & 0xffff0000u)};
                const f32x4 x1 = {__uint_as_float(x.z << 16), __uint_as_float(x.z & 0xffff0000u), __uint_as_float(x.w << 16), __uint_as_float(x.w & 0xffff0000u)};
                o[128 * j] = x0 * r * wv[j][0]; o[128 * j + 1] = x1 * r * wv[j][1]; } }
    }
}

typedef __bf16 bf16v2 __attribute__((ext_vector_type(2)));
typedef unsigned u32x2 __attribute__((ext_vector_type(2)));
__device__ __forceinline__ unsigned cvtpk_c(float lo, float hi) { bf16v2 v = {(__bf16)lo, (__bf16)hi}; return __builtin_bit_cast(unsigned, v); }
__device__ __forceinline__ float bflo(unsigned w) { return __uint_as_float(w << 16); }
__device__ __forceinline__ float bfhi(unsigned w) { return __uint_as_float(w & 0xffff0000u); }
__device__ __forceinline__ int opaque_i(int x) { asm volatile("" : "+v"(x)); return x; }
typedef short s16x4 __attribute__((ext_vector_type(4)));
#define TRRD(ptr) __builtin_amdgcn_ds_read_tr16_b64_v4i16((LAS s16x4*)(ptr))
constexpr size_t ST_SC_BYTES = 393216;
__device__ __forceinline__ size_t state_off(int sc, bool gla, int hh, int dir) { return (size_t)sc * ST_SC_BYTES + (gla ? (size_t)(hh * 2 + dir) * 16384 : (size_t)131072 + (size_t)(hh * 2 + dir) * 32768); }
struct CMixArgs { bf16* proj; const float* ga; const float *waf, *baf, *wab, *bab; unsigned char* st; float* dec; const float *gnw, *rnw, *rnb; bf16* mo; int mop; unsigned char* sto; unsigned char* ofs; float* bb0; float* bb1; float* gv; };
constexpr int OB_PITCH = 132;

template <bool GLA> struct RawSet;
template <> struct RawSet<true> { v4u q, k, v0, v1; f32x4 b0, b1, l0, l1; };
template <> struct RawSet<false> { v4u q0, q1, k0, k1, v0, v1; };

template <bool GLA, bool WITH_O>
__device__ __forceinline__ void raw_load(RawSet<GLA>& R, const CMixArgs& a, int p, int s, int w, int lane0) {
    const int lane = opaque_i(lane0), sc = p >> 2, hh = p & 3, dir = s >> 2, c = dir ? 7 - s : s;
    const size_t row = (size_t)(sc * 256 + 64 * c + 8 * w + (lane >> 3)); const int pc = lane & 7;
    if constexpr (GLA) {
        if (WITH_O) R.q = *(const GAS v4u*)(a.proj + pg8::PL_GQ + (hh * pg8::MTOK + row) * 64 + 8 * pc);
        R.k = *(const GAS v4u*)(a.proj + pg8::PL_GK + (hh * pg8::MTOK + row) * 64 + 8 * pc);
        const bf16* pv = a.proj + pg8::PL_GV + (hh * pg8::MTOK + row) * 128 + 8 * pc;
        R.v0 = *(const GAS v4u*)pv; R.v1 = *(const GAS v4u*)(pv + 64);
        const float* bp = (dir ? a.bb1 : a.bb0) + ((size_t)(p * 4 + c) * 64) * 64 + 8 * pc;
        const int ti = 8 * w + (lane >> 3);
        R.b0 = *(const GAS f32x4*)(bp + ti * 64); R.b1 = *(const GAS f32x4*)(bp + ti * 64 + 4);
        R.l0 = *(const GAS f32x4*)(bp + (dir ? 0 : 63) * 64); R.l1 = *(const GAS f32x4*)(bp + (dir ? 0 : 63) * 64 + 4);
    } else {
        if (WITH_O) { const bf16* pq = a.proj + pg8::PL_RQ + (hh * pg8::MTOK + row) * 128 + 8 * pc; R.q0 = *(const GAS v4u*)pq; R.q1 = *(const GAS v4u*)(pq + 64); }
        const bf16* pk = a.proj + pg8::PL_RK + (hh * pg8::MTOK + row) * 128 + 8 * pc; R.k0 = *(const GAS v4u*)pk; R.k1 = *(const GAS v4u*)(pk + 64);
        const bf16* pv = a.proj + pg8::PL_RV + (hh * pg8::MTOK + row) * 128 + 8 * pc; R.v0 = *(const GAS v4u*)pv; R.v1 = *(const GAS v4u*)(pv + 64);
    }
}

template <int DK, bool GLA, bool WITH_O> struct MixLds {
    static constexpr int NT = DK / 16, NS = DK / 32;
    static constexpr int RQ = DK * 2 + 16, RP = 144, RV = 272;
    static constexpr int O_QD = 0, O_KI = 64 * RQ, O_KE = 2 * 64 * RQ, O_PB = 3 * 64 * RQ, O_VB = O_PB + 64 * RP, O_DC = O_VB + 64 * RV, O_WAL = O_DC + DK * 4,
                         O_OB = O_WAL, O_END = O_OB + 64 * OB_PITCH * 4;
    static_assert(O_END <= 146432, "mixer LDS map");
};

template <int DK, bool GLA, bool WITH_O>
__device__ __forceinline__ void mix_step(Frame& F, const CMixArgs& a, int p, int s, int pnext, RawSet<GLA>& R, f32x4 (&S)[DK / 16], float (&dsum)[8], u32x2 (&ofp)[4][4]) {
    typedef MixLds<DK, GLA, WITH_O> ML;
    constexpr int NT = ML::NT, NS = ML::NS, RQ = ML::RQ, RP = ML::RP, RV = ML::RV;
    LAS unsigned char* L = F.lds;
    const int lane0 = F.lane, w = F.wave;
    const int sc = p >> 2, hh = p & 3, dir = s >> 2, c = dir ? 7 - s : s, row0 = sc * 256, head = GLA ? hh : 4 + hh, vcol = 128 * head;
    __syncthreads();
    {
        const int lane = opaque_i(lane0), i = 8 * w + (lane >> 3), pc = lane & 7;
        *(LAS v4u*)(L + ML::O_VB + i * RV + 16 * pc) = R.v0; *(LAS v4u*)(L + ML::O_VB + i * RV + 128 + 16 * pc) = R.v1;
        if constexpr (GLA) {
            const int tk = lane >> 3;
            float q8[8], k8[8], e8[8];
#pragma unroll
            for (int e = 0; e < 8; ++e) { const float b = e < 4 ? R.b0[e & 3] : R.b1[e & 3], bl_ = e < 4 ? R.l0[e & 3] : R.l1[e & 3];
                const unsigned wq = WITH_O ? ((const unsigned*)&R.q)[e >> 1] : 0u, wk = ((const unsigned*)&R.k)[e >> 1];
                const float qv = (e & 1) ? bfhi(wq) : bflo(wq), kv = (e & 1) ? bfhi(wk) : bflo(wk);
                q8[e] = qv * __expf(b); k8[e] = kv * __expf(-b); e8[e] = kv * __expf(bl_ - b);
                if (!WITH_O) dsum[e] += bl_;
                if (w == 0 && tk == 0) ((LAS float*)(L + ML::O_DC))[8 * pc + e] = __expf(bl_); }
            v4u oq, ok, oe;
            oq.x = cvtpk_c(q8[0], q8[1]); oq.y = cvtpk_c(q8[2], q8[3]); oq.z = cvtpk_c(q8[4], q8[5]); oq.w = cvtpk_c(q8[6], q8[7]);
            ok.x = cvtpk_c(k8[0], k8[1]); ok.y = cvtpk_c(k8[2], k8[3]); ok.z = cvtpk_c(k8[4], k8[5]); ok.w = cvtpk_c(k8[6], k8[7]);
            oe.x = cvtpk_c(e8[0], e8[1]); oe.y = cvtpk_c(e8[2], e8[3]); oe.z = cvtpk_c(e8[4], e8[5]); oe.w = cvtpk_c(e8[6], e8[7]);
            if (WITH_O) { *(LAS v4u*)(L + ML::O_QD + i * RQ + 16 * pc) = oq; *(LAS v4u*)(L + ML::O_KI + i * RQ + 16 * pc) = ok; }
            *(LAS v4u*)(L + ML::O_KE + i * RQ + 16 * pc) = oe;
        } else {
            const float l2g = hh == 0 ? -0.045803689613124f : hh == 1 ? -0.022720076500083f : hh == 2 ? -0.011315313227834f : -0.005646563141142f;
            const float nq = dir ? (float)(64 - i) : (float)(i + 1), ne = dir ? (float)i : (float)(63 - i);
            const float eb = exp2f(l2g * nq), ei = exp2f(-l2g * nq), ee = exp2f(l2g * ne);
#pragma unroll
            for (int x = 0; x < 2; ++x) { v4u oq, ok, oe; const v4u rq = x ? R.q1 : R.q0, rk = x ? R.k1 : R.k0;
#pragma unroll
                for (int j = 0; j < 4; ++j) { const unsigned wq = WITH_O ? ((const unsigned*)&rq)[j] : 0u, wk = ((const unsigned*)&rk)[j];
                    ((unsigned*)&oq)[j] = cvtpk_c(bflo(wq) * eb, bfhi(wq) * eb); ((unsigned*)&ok)[j] = cvtpk_c(bflo(wk) * ei, bfhi(wk) * ei); ((unsigned*)&oe)[j] = cvtpk_c(bflo(wk) * ee, bfhi(wk) * ee); }
                if (WITH_O) { *(LAS v4u*)(L + ML::O_QD + i * RQ + 128 * x + 16 * pc) = oq; *(LAS v4u*)(L + ML::O_KI + i * RQ + 128 * x + 16 * pc) = ok; }
                *(LAS v4u*)(L + ML::O_KE + i * RQ + 128 * x + 16 * pc) = oe; }
            if (w == 0 && lane < 32) *(LAS f32x4*)(L + ML::O_DC + lane * 16) = (f32x4){exp2f(l2g * 64.0f), exp2f(l2g * 64.0f), exp2f(l2g * 64.0f), exp2f(l2g * 64.0f)};
        }
    }
    v4u gt0, gt1; f32x4 nw[4], nb[4];
    if (WITH_O) { const int lane = opaque_i(lane0);
        const bf16* gp = a.proj + (GLA ? pg8::PL_GG : pg8::PL_RG) + (dir ? (hh * pg8::MTOK + (size_t)(row0 + 64 * c + 8 * w + (lane >> 3))) * 128 + 16 * (lane & 7) : (size_t)0);
        gt0 = *(const GAS v4u*)gp; gt1 = *(const GAS v4u*)(gp + 8);
        const float* wp = GLA ? a.gnw + 16 * (lane & 7) : a.rnw + 128 * hh + 16 * (lane & 7);
#pragma unroll
        for (int k = 0; k < 4; ++k) { nw[k] = *(const GAS f32x4*)(wp + 4 * k); if (!GLA) nb[k] = *(const GAS f32x4*)(a.rnb + 128 * hh + 16 * (lane & 7) + 4 * k); } }
    raw_load<GLA, WITH_O>(R, a, s < 6 ? p : (pnext < 1536 ? pnext : p), s < 6 ? s + 2 : s - 6, w, lane0);
    __syncthreads();
    if (WITH_O) {
        const int lane = opaque_i(lane0), g = lane >> 4, lr = lane & 15;
        const int mi = w >> 1;
        bf16x8 kf[2][NS], qf2[NS];
#pragma unroll
        for (int s2 = 0; s2 < NS; ++s2) { qf2[s2] = *(const LAS bf16x8*)(L + ML::O_QD + (16 * mi + lr) * RQ + 64 * s2 + 16 * g);
#pragma unroll
            for (int jj = 0; jj < 2; ++jj) kf[jj][s2] = *(const LAS bf16x8*)(L + ML::O_KI + (16 * (2 * (w & 1) + jj) + lr) * RQ + 64 * s2 + 16 * g); }
        __builtin_amdgcn_sched_barrier(0);
#pragma unroll
        for (int jj = 0; jj < 2; ++jj) { const int nj = 2 * (w & 1) + jj;
            f32x4 acc = {0.f, 0.f, 0.f, 0.f};
#pragma unroll
            for (int s2 = 0; s2 < NS; ++s2) acc = __builtin_amdgcn_mfma_f32_16x16x32_bf16(kf[jj][s2], qf2[s2], acc, 0, 0, 0);
            const int ii = 16 * mi + lr;
#pragma unroll
            for (int r = 0; r < 4; ++r) { const int j = 16 * nj + 4 * g + r; const bool keep = dir ? (j > ii) : (j <= ii); acc[r] = keep ? acc[r] : 0.f; }
            u32x2 pk; pk.x = cvtpk_c(acc[0], acc[1]); pk.y = cvtpk_c(acc[2], acc[3]);
            *(LAS u32x2*)(L + ML::O_PB + ii * RP + 32 * nj + 8 * g) = pk; }
        __syncthreads();
    }
    f32x4 o[4];
    {
        const int lane = opaque_i(lane0), g = lane >> 4, lr = lane & 15, q4 = lr >> 2, p4 = lr & 3;
        const LAS unsigned char* vb = L + ML::O_VB + (8 * g + q4) * RV + 32 * w + 8 * p4;
        const bf16x8 vf0 = __builtin_shufflevector(TRRD(vb), TRRD(vb + 4 * RV), 0, 1, 2, 3, 4, 5, 6, 7), vf1 = __builtin_shufflevector(TRRD(vb + 32 * RV), TRRD(vb + 36 * RV), 0, 1, 2, 3, 4, 5, 6, 7);
        if (WITH_O) {
            { bf16x8 pf[4][2];
#pragma unroll
              for (int m = 0; m < 4; ++m) { pf[m][0] = *(const LAS bf16x8*)(L + ML::O_PB + (16 * m + lr) * RP + 16 * g); pf[m][1] = *(const LAS bf16x8*)(L + ML::O_PB + (16 * m + lr) * RP + 64 + 16 * g); }
              __builtin_amdgcn_sched_barrier(0);
#pragma unroll
              for (int m = 0; m < 4; ++m) { o[m] = __builtin_amdgcn_mfma_f32_16x16x32_bf16(pf[m][0], vf0, (f32x4){0.f, 0.f, 0.f, 0.f}, 0, 0, 0); o[m] = __builtin_amdgcn_mfma_f32_16x16x32_bf16(pf[m][1], vf1, o[m], 0, 0, 0); }
              __builtin_amdgcn_sched_barrier(0); }
#pragma unroll
            for (int sh = 0; sh < NS / 2; ++sh) {
                u32x2 ql[2][4][2];
#pragma unroll
                for (int x = 0; x < 2; ++x)
#pragma unroll
                    for (int m = 0; m < 4; ++m) { ql[x][m][0] = *(const LAS u32x2*)(L + ML::O_QD + (16 * m + lr) * RQ + 64 * (2 * sh + x) + 8 * g); ql[x][m][1] = *(const LAS u32x2*)(L + ML::O_QD + (16 * m + lr) * RQ + 64 * (2 * sh + x) + 32 + 8 * g); }
                __builtin_amdgcn_sched_barrier(0);
#pragma unroll
                for (int x = 0; x < 2; ++x) { const int s2 = 2 * sh + x;
                    const bf16x8 sf = __builtin_bit_cast(bf16x8, (v4u){cvtpk_c(S[2 * s2][0], S[2 * s2][1]), cvtpk_c(S[2 * s2][2], S[2 * s2][3]), cvtpk_c(S[2 * s2 + 1][0], S[2 * s2 + 1][1]), cvtpk_c(S[2 * s2 + 1][2], S[2 * s2 + 1][3])});
#pragma unroll
                    for (int m = 0; m < 4; ++m) o[m] = __builtin_amdgcn_mfma_f32_16x16x32_bf16(__builtin_bit_cast(bf16x8, (v4u){ql[x][m][0].x, ql[x][m][0].y, ql[x][m][1].x, ql[x][m][1].y}), sf, o[m], 0, 0, 0); }
                __builtin_amdgcn_sched_barrier(0);
            }
        }
#pragma unroll
        for (int th = 0; th < NT / 4; ++th) {
            f32x4 d4[4]; bf16x8 kf0[4], kf1[4];
#pragma unroll
            for (int x = 0; x < 4; ++x) { const int tt = 4 * th + x;
                d4[x] = *(const LAS f32x4*)(L + ML::O_DC + (16 * tt + 4 * g) * 4);
                const LAS unsigned char* kb = L + ML::O_KE + (8 * g + q4) * RQ + 32 * tt + 8 * p4;
                kf0[x] = __builtin_shufflevector(TRRD(kb), TRRD(kb + 4 * RQ), 0, 1, 2, 3, 4, 5, 6, 7); kf1[x] = __builtin_shufflevector(TRRD(kb + 32 * RQ), TRRD(kb + 36 * RQ), 0, 1, 2, 3, 4, 5, 6, 7); }
            __builtin_amdgcn_sched_barrier(0);
#pragma unroll
            for (int x = 0; x < 4; ++x) { const int tt = 4 * th + x;
                S[tt] = S[tt] * d4[x];
                S[tt] = __builtin_amdgcn_mfma_f32_16x16x32_bf16(kf0[x], vf0, S[tt], 0, 0, 0);
                S[tt] = __builtin_amdgcn_mfma_f32_16x16x32_bf16(kf1[x], vf1, S[tt], 0, 0, 0); }
            __builtin_amdgcn_sched_barrier(0);
        }
    }
    if (WITH_O) {
        const int lane = opaque_i(lane0), g = lane >> 4, lr = lane & 15;
        if (dir == 0) {
#pragma unroll
            for (int cc = 0; cc < 4; ++cc) if (cc == c) {
#pragma unroll
                for (int m = 0; m < 4; ++m) { ofp[cc][m].x = cvtpk_c(o[m][0], o[m][1]); ofp[cc][m].y = cvtpk_c(o[m][2], o[m][3]); } }
        } else {
            u32x2 ofr[4];
#pragma unroll
            for (int cc = 0; cc < 4; ++cc) if (cc == c) {
#pragma unroll
                for (int m = 0; m < 4; ++m) ofr[m] = ofp[cc][m]; }
            LAS float* ob = (LAS float*)(L + ML::O_OB);
#pragma unroll
            for (int m = 0; m < 4; ++m) { const f32x4 t = {o[m][0] + bflo(ofr[m].x), o[m][1] + bfhi(ofr[m].x), o[m][2] + bflo(ofr[m].y), o[m][3] + bfhi(ofr[m].y)};
#pragma unroll
                for (int r = 0; r < 4; ++r) ob[(16 * m + 4 * g + r) * OB_PITCH + 16 * w + lr] = t[r]; }
            __syncthreads();
            const int row = 8 * w + (lane >> 3), pc = lane & 7;
            f32x4 x[4];
#pragma unroll
            for (int k = 0; k < 4; ++k) x[k] = *(const LAS f32x4*)(ob + row * OB_PITCH + 16 * pc + 4 * k);
            float rs;
            if (GLA) { float ss = 0.f;
#pragma unroll
                for (int k = 0; k < 4; ++k) ss += (x[k][0] * x[k][0] + x[k][1] * x[k][1]) + (x[k][2] * x[k][2] + x[k][3] * x[k][3]);
                ss += __shfl_xor(ss, 1); ss += __shfl_xor(ss, 2); ss += __shfl_xor(ss, 4);
                rs = __builtin_amdgcn_rsqf(ss * (1.0f / 128.0f) + EPS); }
            else { float sm = 0.f;
#pragma unroll
                for (int k = 0; k < 4; ++k) sm += (x[k][0] + x[k][1]) + (x[k][2] + x[k][3]);
                sm += __shfl_xor(sm, 1); sm += __shfl_xor(sm, 2); sm += __shfl_xor(sm, 4);
                const float mu = sm * (1.0f / 128.0f); float ss = 0.f;
#pragma unroll
                for (int k = 0; k < 4; ++k) { x[k] = x[k] - mu; ss += (x[k][0] * x[k][0] + x[k][1] * x[k][1]) + (x[k][2] * x[k][2] + x[k][3] * x[k][3]); }
                ss += __shfl_xor(ss, 1); ss += __shfl_xor(ss, 2); ss += __shfl_xor(ss, 4);
                rs = __builtin_amdgcn_rsqf(ss * (1.0f / 128.0f) + EPS); }
            unsigned ow[8];
#pragma unroll
            for (int k = 0; k < 4; ++k) { f32x4 y = x[k] * rs * nw[k];
                if (!GLA) y = y + nb[k];
                const unsigned ga_ = k < 2 ? ((const unsigned*)&gt0)[2 * k] : ((const unsigned*)&gt1)[2 * k - 4], gb_ = k < 2 ? ((const unsigned*)&gt0)[2 * k + 1] : ((const unsigned*)&gt1)[2 * k - 3];
                const float g0 = bflo(ga_), g1 = bfhi(ga_), g2 = bflo(gb_), g3 = bfhi(gb_);
                y[0] *= g0 * __builtin_amdgcn_rcpf(1.0f + __expf(-g0)); y[1] *= g1 * __builtin_amdgcn_rcpf(1.0f + __expf(-g1));
                y[2] *= g2 * __builtin_amdgcn_rcpf(1.0f + __expf(-g2)); y[3] *= g3 * __builtin_amdgcn_rcpf(1.0f + __expf(-g3));
                ow[2 * k] = cvtpk_c(y[0], y[1]); ow[2 * k + 1] = cvtpk_c(y[2], y[3]); }
            bf16* op = a.mo + (size_t)(row0 + 64 * c + row) * a.mop + vcol + 16 * pc;
            *(GAS v4u*)op = (v4u){ow[0], ow[1], ow[2], ow[3]}; *(GAS v4u*)(op + 8) = (v4u){ow[4], ow[5], ow[6], ow[7]};
        }
    }
}


__device__ __forceinline__ void gla_b_stage(Frame& F, const CMixArgs& a, int p) {
    const int sc = p >> 2, hh = p & 3, w = F.wave;
    LAS float* gl = (LAS float*)F.lds;
    __syncthreads();
    { const int tid = opaque_i(F.tid);
#pragma unroll
      for (int x = 0; x < 4; ++x) *(LAS f32x4*)(gl + 4 * (tid + 512 * x)) = *(const GAS f32x4*)(a.ga + (size_t)sc * 256 * 32 + 4 * (tid + 512 * x)); }
    __syncthreads();
    const int t = opaque_i(F.lane), dir = w >> 2, c = w & 3;
    const float* wa = (dir ? a.wab : a.waf) + 64 * hh + t;
    float wv[16];
#pragma unroll
    for (int r = 0; r < 16; ++r) wv[r] = wa[r * 256];
    const float bias = (dir ? a.bab : a.baf)[64 * hh + t];
    float* bp = (dir ? a.bb1 : a.bb0) + ((size_t)(p * 4 + c) * 64) * 64;
    LAS float* tb = gl + 8192 + w * (16 * 68);
    float acc = 0.f;
#pragma unroll 1
    for (int k16 = 0; k16 < 64; k16 += 16) {
#pragma unroll 1
        for (int k4 = k16; k4 < k16 + 16; k4 += 4) {
            f32x4 gv[4][4];
#pragma unroll
            for (int j = 0; j < 4; ++j) { const int i = dir ? 63 - (k4 + j) : k4 + j; const LAS float* gr = gl + (64 * c + i) * 32 + 16 * dir;
#pragma unroll
                for (int x = 0; x < 4; ++x) gv[j][x] = *(const LAS f32x4*)(gr + 4 * x); }
            __builtin_amdgcn_sched_barrier(0);
#pragma unroll
            for (int j = 0; j < 4; ++j) {
                float z = bias;
#pragma unroll
                for (int r = 0; r < 16; ++r) z += gv[j][r >> 2][r & 3] * wv[r];
                const float ls = fminf(z, 0.f) - __logf(1.0f + __expf(-fabsf(z)));
                acc += fmaxf(ls * (1.0f / 16.0f), -1.0f);
                tb[(k4 - k16 + j) * 68 + t] = acc; }
        }
#pragma unroll
        for (int x = 0; x < 4; ++x) { const int kk = 4 * x + (t >> 4), i = dir ? 63 - (k16 + kk) : k16 + kk;
            *(GAS f32x4*)(bp + i * 64 + 4 * (t & 15)) = *(const LAS f32x4*)(tb + kk * 68 + 4 * (t & 15)); }
    }
    LAS float* tot = gl + 8192 + 8 * (16 * 68);
    tot[w * 64 + t] = acc;
    __syncthreads();
    { float gsum = 0.f;
#pragma unroll
      for (int cc = 0; cc < 4; ++cc) { const float v = tot[(dir * 4 + cc) * 64 + t]; if (dir ? (cc <= c) : (cc >= c)) gsum += v; }
      a.gv[((size_t)(p * 2 + dir) * 4 + c) * 64 + t] = gsum;
      if (c == (dir ? 3 : 0)) a.dec[(size_t)((sc * 4 + hh) * 2 + dir) * 64 + t] = __expf(gsum); }
}

template <int DK, bool GLA, bool WITH_O>
__device__ __forceinline__ void mix_units(Frame& F, const CMixArgs& a) {
    typedef MixLds<DK, GLA, WITH_O> ML;
    constexpr int NT = DK / 16;
    const int w = F.wave, lane0 = F.lane;
    int p = (int)blockIdx.x;
    if (p >= 1536) return;
    RawSet<GLA> RA, RB;
    raw_load<GLA, WITH_O>(RA, a, p, 0, w, lane0); raw_load<GLA, WITH_O>(RB, a, p, 1, w, lane0);
    f32x4 S[NT]; float dsum[8]; u32x2 ofp[4][4];
#pragma unroll 1
    for (; p < 1536; p += F.G) {
        const int sc = p >> 2, hh = p & 3, pnext = p + F.G;
#pragma unroll 1
        for (int dir = 0; dir < 2; ++dir) {
            const int lane = opaque_i(lane0);
            unsigned char* sp = a.st + state_off(sc, GLA, hh, dir) + (size_t)(unsigned)(w * NT * 512 + lane * 8);
            if (WITH_O) {
#pragma unroll
                for (int tt = 0; tt < NT; ++tt) { const u32x2 pk = *(const GAS u32x2*)(sp + tt * 512); S[tt] = (f32x4){bflo(pk.x), bfhi(pk.x), bflo(pk.y), bfhi(pk.y)}; } }
            else {
#pragma unroll
                for (int tt = 0; tt < NT; ++tt) S[tt] = (f32x4){0.f, 0.f, 0.f, 0.f};
#pragma unroll
                for (int e = 0; e < 8; ++e) dsum[e] = 0.f; }
#pragma unroll 1
            for (int h2 = 0; h2 < 2; ++h2) {
                mix_step<DK, GLA, WITH_O>(F, a, p, 4 * dir + 2 * h2, pnext, RA, S, dsum, ofp);
                mix_step<DK, GLA, WITH_O>(F, a, p, 4 * dir + 2 * h2 + 1, pnext, RB, S, dsum, ofp);
            }
            if (!WITH_O) {
#pragma unroll
                for (int tt = 0; tt < NT; ++tt) { u32x2 pk; pk.x = cvtpk_c(S[tt][0], S[tt][1]); pk.y = cvtpk_c(S[tt][2], S[tt][3]); *(GAS u32x2*)(sp + tt * 512) = pk; }
                if (GLA && w == 0 && lane < 8) { float* dp = a.dec + (size_t)((sc * 4 + hh) * 2 + dir) * 64 + 8 * lane;
#pragma unroll
                    for (int e = 0; e < 8; ++e) dp[e] = __expf(dsum[e]); }
            }
        }
    }
}

template <bool GLA> struct KvRaw;
template <> struct KvRaw<true> { v4u k, v0, v1; f32x4 bf0, bf1, bb0, bb1, gf0, gf1, gb0, gb1; };
template <> struct KvRaw<false> { v4u k0, k1, v0, v1; };
template <bool GLA>
__device__ __forceinline__ void kv_load(KvRaw<GLA>& R, const CMixArgs& a, int p, int c, int w, int lane0) {
    const int lane = opaque_i(lane0), sc = p >> 2, hh = p & 3, pc = lane & 7, ti = 8 * w + (lane >> 3);
    const size_t row = (size_t)(sc * 256 + 64 * c + ti);
    if constexpr (GLA) {
        R.k = *(const GAS v4u*)(a.proj + pg8::PL_GK + (hh * pg8::MTOK + row) * 64 + 8 * pc);
        const bf16* pv = a.proj + pg8::PL_GV + (hh * pg8::MTOK + row) * 128 + 8 * pc; R.v0 = *(const GAS v4u*)pv; R.v1 = *(const GAS v4u*)(pv + 64);
        const float* b0 = a.bb0 + ((size_t)(p * 4 + c) * 64 + ti) * 64 + 8 * pc; const float* b1 = a.bb1 + ((size_t)(p * 4 + c) * 64 + ti) * 64 + 8 * pc;
        R.bf0 = *(const GAS f32x4*)b0; R.bf1 = *(const GAS f32x4*)(b0 + 4); R.bb0 = *(const GAS f32x4*)b1; R.bb1 = *(const GAS f32x4*)(b1 + 4);
        const float* g0 = a.gv + ((size_t)(p * 2 + 0) * 4 + c) * 64 + 8 * pc; const float* g1 = a.gv + ((size_t)(p * 2 + 1) * 4 + c) * 64 + 8 * pc;
        R.gf0 = *(const GAS f32x4*)g0; R.gf1 = *(const GAS f32x4*)(g0 + 4); R.gb0 = *(const GAS f32x4*)g1; R.gb1 = *(const GAS f32x4*)(g1 + 4);
    } else {
        const bf16* pk = a.proj + pg8::PL_RK + (hh * pg8::MTOK + row) * 128 + 8 * pc; R.k0 = *(const GAS v4u*)pk; R.k1 = *(const GAS v4u*)(pk + 64);
        const bf16* pv = a.proj + pg8::PL_RV + (hh * pg8::MTOK + row) * 128 + 8 * pc; R.v0 = *(const GAS v4u*)pv; R.v1 = *(const GAS v4u*)(pv + 64);
    }
}
template <int DK, bool GLA>
__device__ __forceinline__ void kv_step(Frame& F, const CMixArgs& a, int p, int c, int pnext, KvRaw<GLA>& R, f32x4 (&Sf)[DK / 16], f32x4 (&Sb)[DK / 16]) {
    constexpr int NT = DK / 16, RQ = DK * 2 + 16, RV = 272, O_KF = 0, O_KB = 64 * RQ, O_VB = 2 * 64 * RQ;
    LAS unsigned char* L = F.lds;
    const int lane0 = F.lane, w = F.wave, hh = p & 3;
    __syncthreads();
    { const int lane = opaque_i(lane0), i = 8 * w + (lane >> 3), pc = lane & 7;
      *(LAS v4u*)(L + O_VB + i * RV + 16 * pc) = R.v0; *(LAS v4u*)(L + O_VB + i * RV + 128 + 16 * pc) = R.v1;
      if constexpr (GLA) {
          float f8[8], b8[8];
#pragma unroll
          for (int e = 0; e < 8; ++e) { const unsigned wk = ((const unsigned*)&R.k)[e >> 1]; const float kv = (e & 1) ? bfhi(wk) : bflo(wk);
              const float xf = (e < 4 ? R.gf0[e & 3] : R.gf1[e & 3]) - (e < 4 ? R.bf0[e & 3] : R.bf1[e & 3]), xb = (e < 4 ? R.gb0[e & 3] : R.gb1[e & 3]) - (e < 4 ? R.bb0[e & 3] : R.bb1[e & 3]);
              f8[e] = kv * __expf(xf); b8[e] = kv * __expf(xb); }
          *(LAS v4u*)(L + O_KF + i * RQ + 16 * pc) = (v4u){cvtpk_c(f8[0], f8[1]), cvtpk_c(f8[2], f8[3]), cvtpk_c(f8[4], f8[5]), cvtpk_c(f8[6], f8[7])};
          *(LAS v4u*)(L + O_KB + i * RQ + 16 * pc) = (v4u){cvtpk_c(b8[0], b8[1]), cvtpk_c(b8[2], b8[3]), cvtpk_c(b8[4], b8[5]), cvtpk_c(b8[6], b8[7])};
      } else {
          const float l2g = hh == 0 ? -0.045803689613124f : hh == 1 ? -0.022720076500083f : hh == 2 ? -0.011315313227834f : -0.005646563141142f;
          const float j = (float)(64 * c + i), ef = __builtin_amdgcn_exp2f(l2g * (255.0f - j)), eb = __builtin_amdgcn_exp2f(l2g * j);
#pragma unroll
          for (int x = 0; x < 2; ++x) { const v4u rk = x ? R.k1 : R.k0; v4u of, ob;
#pragma unroll
              for (int q = 0; q < 4; ++q) { const unsigned wk = ((const unsigned*)&rk)[q]; ((unsigned*)&of)[q] = cvtpk_c(bflo(wk) * ef, bfhi(wk) * ef); ((unsigned*)&ob)[q] = cvtpk_c(bflo(wk) * eb, bfhi(wk) * eb); }
              *(LAS v4u*)(L + O_KF + i * RQ + 128 * x + 16 * pc) = of; *(LAS v4u*)(L + O_KB + i * RQ + 128 * x + 16 * pc) = ob; }
      } }
    kv_load<GLA>(R, a, c < 2 ? p : (pnext < 1536 ? pnext : p), (c + 2) & 3, w, lane0);
    __syncthreads();
    { const int lane = opaque_i(lane0), g = lane >> 4, lr = lane & 15, q4 = lr >> 2, p4 = lr & 3;
      const LAS unsigned char* vb = L + O_VB + (8 * g + q4) * RV + 32 * w + 8 * p4;
      const bf16x8 vf0 = __builtin_shufflevector(TRRD(vb), TRRD(vb + 4 * RV), 0, 1, 2, 3, 4, 5, 6, 7), vf1 = __builtin_shufflevector(TRRD(vb + 32 * RV), TRRD(vb + 36 * RV), 0, 1, 2, 3, 4, 5, 6, 7);
#pragma unroll
      for (int th = 0; th < NT / 4; ++th) {
          bf16x8 kf0[4], kf1[4], kb0[4], kb1[4];
#pragma unroll
          for (int x = 0; x < 4; ++x) { const int tt = 4 * th + x;
              const LAS unsigned char* ka = L + O_KF + (8 * g + q4) * RQ + 32 * tt + 8 * p4; const LAS unsigned char* kb = L + O_KB + (8 * g + q4) * RQ + 32 * tt + 8 * p4;
              kf0[x] = __builtin_shufflevector(TRRD(ka), TRRD(ka + 4 * RQ), 0, 1, 2, 3, 4, 5, 6, 7); kf1[x] = __builtin_shufflevector(TRRD(ka + 32 * RQ), TRRD(ka + 36 * RQ), 0, 1, 2, 3, 4, 5, 6, 7);
              kb0[x] = __builtin_shufflevector(TRRD(kb), TRRD(kb + 4 * RQ), 0, 1, 2, 3, 4, 5, 6, 7); kb1[x] = __builtin_shufflevector(TRRD(kb + 32 * RQ), TRRD(kb + 36 * RQ), 0, 1, 2, 3, 4, 5, 6, 7); }
          __builtin_amdgcn_sched_barrier(0);
#pragma unroll
          for (int x = 0; x < 4; ++x) { const int tt = 4 * th + x;
              Sf[tt] = __builtin_amdgcn_mfma_f32_16x16x32_bf16(kf0[x], vf0, Sf[tt], 0, 0, 0); Sf[tt] = __builtin_amdgcn_mfma_f32_16x16x32_bf16(kf1[x], vf1, Sf[tt], 0, 0, 0);
              Sb[tt] = __builtin_amdgcn_mfma_f32_16x16x32_bf16(kb0[x], vf0, Sb[tt], 0, 0, 0); Sb[tt] = __builtin_amdgcn_mfma_f32_16x16x32_bf16(kb1[x], vf1, Sb[tt], 0, 0, 0); }
          __builtin_amdgcn_sched_barrier(0);
      } }
}
template <int DK, bool GLA>
__device__ __forceinline__ void kv_units(Frame& F, const CMixArgs& a) {
    constexpr int NT = DK / 16;
    const int w = F.wave, lane0 = F.lane;
    int p = (int)blockIdx.x;
    if (p >= 1536) return;
    if (GLA) {
#pragma unroll 1
        for (int pp = p; pp < 1536; pp += F.G) gla_b_stage(F, a, pp);
        asm volatile("s_waitcnt vmcnt(0)" ::: "memory"); __syncthreads(); }
    KvRaw<GLA> RA, RB;
    kv_load<GLA>(RA, a, p, 0, w, lane0); kv_load<GLA>(RB, a, p, 1, w, lane0);
#pragma unroll 1
    for (; p < 1536; p += F.G) {
        const int sc = p >> 2, hh = p & 3, pnext = p + F.G;
        f32x4 Sf[NT], Sb[NT];
#pragma unroll
        for (int tt = 0; tt < NT; ++tt) { Sf[tt] = (f32x4){0.f, 0.f, 0.f, 0.f}; Sb[tt] = (f32x4){0.f, 0.f, 0.f, 0.f}; }
        kv_step<DK, GLA>(F, a, p, 0, pnext, RA, Sf, Sb); kv_step<DK, GLA>(F, a, p, 1, pnext, RB, Sf, Sb);
        kv_step<DK, GLA>(F, a, p, 2, pnext, RA, Sf, Sb); kv_step<DK, GLA>(F, a, p, 3, pnext, RB, Sf, Sb);
        const int lane = opaque_i(lane0);
#pragma unroll
        for (int dir = 0; dir < 2; ++dir) { unsigned char* sp = a.st + state_off(sc, GLA, hh, dir) + (size_t)(unsigned)(w * NT * 512 + lane * 8);
#pragma unroll
            for (int tt = 0; tt < NT; ++tt) { const f32x4 s = dir ? Sb[tt] : Sf[tt]; u32x2 pk; pk.x = cvtpk_c(s[0], s[1]); pk.y = cvtpk_c(s[2], s[3]); *(GAS u32x2*)(sp + tt * 512) = pk; } }
    }
}

constexpr int RD_SLOT = 32768;
__device__ __forceinline__ void ret_dma_block(Frame& F, const CMixArgs& a, int p, int kb, int slot) {
    const int lane = opaque_i(F.lane), w = F.wave, sc = p >> 2, hh = p & 3;
#pragma unroll
    for (int x = 0; x < 2; ++x) {
        const int r = 4 * (2 * w + x) + (lane >> 4), cp = lane & 15;
        const size_t row = (size_t)(sc * 256 + 64 * kb + r);
        const bf16* gk = a.proj + pg8::PL_RK + (hh * pg8::MTOK + row) * 128 + 8 * (cp ^ (r & 15));
        const bf16* gv = a.proj + pg8::PL_RV + (hh * pg8::MTOK + row) * 128 + 8 * (cp ^ (2 * (r & 7)));
        __builtin_amdgcn_global_load_lds((const unsigned*)gk, (LAS unsigned*)(F.lds + slot * RD_SLOT + (2 * w + x) * 1024), 16, 0, 0);
        __builtin_amdgcn_global_load_lds((const unsigned*)gv, (LAS unsigned*)(F.lds + slot * RD_SLOT + 16384 + (2 * w + x) * 1024), 16, 0, 0);
    }
}
__device__ __forceinline__ void tr_read16(const unsigned (&ad)[8], u32x2 (&r)[16]) {
    asm volatile("ds_read_b64_tr_b16 %0, %16\n\tds_read_b64_tr_b16 %1, %16 offset:4096\n\tds_read_b64_tr_b16 %2, %17\n\tds_read_b64_tr_b16 %3, %17 offset:4096\n\t"
                 "ds_read_b64_tr_b16 %4, %18\n\tds_read_b64_tr_b16 %5, %18 offset:4096\n\tds_read_b64_tr_b16 %6, %19\n\tds_read_b64_tr_b16 %7, %19 offset:4096\n\t"
                 "ds_read_b64_tr_b16 %8, %20\n\tds_read_b64_tr_b16 %9, %20 offset:4096\n\tds_read_b64_tr_b16 %10, %21\n\tds_read_b64_tr_b16 %11, %21 offset:4096\n\t"
                 "ds_read_b64_tr_b16 %12, %22\n\tds_read_b64_tr_b16 %13, %22 offset:4096\n\tds_read_b64_tr_b16 %14, %23\n\tds_read_b64_tr_b16 %15, %23 offset:4096\n\t"
                 "s_waitcnt lgkmcnt(0)"
                 : "=&v"(r[0]), "=&v"(r[1]), "=&v"(r[2]), "=&v"(r[3]), "=&v"(r[4]), "=&v"(r[5]), "=&v"(r[6]), "=&v"(r[7]),
                   "=&v"(r[8]), "=&v"(r[9]), "=&v"(r[10]), "=&v"(r[11]), "=&v"(r[12]), "=&v"(r[13]), "=&v"(r[14]), "=&v"(r[15])
                 : "v"(ad[0]), "v"(ad[1]), "v"(ad[2]), "v"(ad[3]), "v"(ad[4]), "v"(ad[5]), "v"(ad[6]), "v"(ad[7]) : "memory");
}
__device__ __forceinline__ void ret_block(Frame& F, const CMixArgs& a, int p, int kb, int slot, int pnext, const bf16x8 (&Qf)[2][4], f32x4 (&O)[8][2]) {
    LAS unsigned char* L = F.lds;
    const int w = F.wave, hh = p & 3;
    const float l2g = hh == 0 ? -0.045803689613124f : hh == 1 ? -0.022720076500083f : hh == 2 ? -0.011315313227834f : -0.005646563141142f;
    asm volatile("s_waitcnt vmcnt(4)" ::: "memory");
    __builtin_amdgcn_s_barrier();
    asm volatile("" ::: "memory");
    { const int kn = kb + 2, pn2 = kn < 4 ? p : (pnext < 1536 ? pnext : p); ret_dma_block(F, a, pn2, kn & 3, slot == 0 ? 2 : slot - 1); }
    LAS unsigned char* KB = L + slot * RD_SLOT; LAS unsigned char* VB = KB + 16384;
    const int lane = opaque_i(F.lane), g = lane >> 4, lr = lane & 15, q4 = lr >> 2, p4 = lr & 3;
    const int xk16 = (lr ^ (g >> 1)) << 4, xv16 = ((p4 >> 1) ^ (2 * ((4 * g + q4) & 7))) << 4;
#pragma unroll
    for (int sp = 0; sp < 2; ++sp) {
        f32x4 st[2][2];
#pragma unroll
        for (int h = 0; h < 2; ++h)
#pragma unroll
            for (int it = 0; it < 2; ++it) st[h][it] = (f32x4){0.f, 0.f, 0.f, 0.f};
        { bf16x8 kf[2][4];
#pragma unroll
          for (int s = 0; s < 4; ++s)
#pragma unroll
              for (int h = 0; h < 2; ++h) {
                  const LAS unsigned char* kp = KB + (32 * sp + 16 * h + lr) * 256 + 8 * (g & 1);
                  const u32x2 lo = *(const LAS u32x2*)(kp + ((64 * s) ^ xk16)), hi = *(const LAS u32x2*)(kp + ((64 * s + 32) ^ xk16));
                  kf[h][s] = __builtin_bit_cast(bf16x8, (v4u){lo.x, lo.y, hi.x, hi.y}); }
          __builtin_amdgcn_sched_barrier(0);
#pragma unroll
          for (int s = 0; s < 4; ++s)
#pragma unroll
              for (int h = 0; h < 2; ++h)
#pragma unroll
                  for (int it = 0; it < 2; ++it) st[h][it] = __builtin_amdgcn_mfma_f32_16x16x32_bf16(kf[h][s], Qf[it][s], st[h][it], 0, 0, 0);
          __builtin_amdgcn_sched_barrier(0); }
        bf16x8 pf[2];
#pragma unroll
        for (int it = 0; it < 2; ++it) {
            const int i = 32 * w + 16 * it + lr;
            unsigned pw[4];
#pragma unroll
            for (int h = 0; h < 2; ++h) { float e[4];
#pragma unroll
                for (int r = 0; r < 4; ++r) { const int j = 64 * kb + 32 * sp + 16 * h + 4 * g + r; const int d = i - j; e[r] = st[h][it][r] * __builtin_amdgcn_exp2f(l2g * (float)(d < 0 ? -d : d)); }
                pw[2 * h] = cvtpk_c(e[0], e[1]); pw[2 * h + 1] = cvtpk_c(e[2], e[3]); }
            pf[it] = __builtin_bit_cast(bf16x8, (v4u){pw[0], pw[1], pw[2], pw[3]});
        }
        { unsigned ad[8]; u32x2 vr[16];
          const unsigned vb0 = (unsigned)(size_t)(VB + (32 * sp + 4 * g + q4) * 256 + 8 * (p4 & 1));
#pragma unroll
          for (int dt = 0; dt < 8; ++dt) ad[dt] = vb0 + ((32 * dt) ^ xv16);
          tr_read16(ad, vr);
          __builtin_amdgcn_sched_barrier(0);
#pragma unroll
          for (int dt = 0; dt < 8; ++dt) { const bf16x8 vf = __builtin_bit_cast(bf16x8, (v4u){vr[2 * dt].x, vr[2 * dt].y, vr[2 * dt + 1].x, vr[2 * dt + 1].y});
#pragma unroll
              for (int it = 0; it < 2; ++it) O[dt][it] = __builtin_amdgcn_mfma_f32_16x16x32_bf16(vf, pf[it], O[dt][it], 0, 0, 0); }
          __builtin_amdgcn_sched_barrier(0); }
    }
}
__device__ __forceinline__ void ret_q_load(bf16x8 (&Qf)[2][4], const CMixArgs& a, int p, int w, int lane0) {
    const int lane = opaque_i(lane0), g = lane >> 4, lr = lane & 15, sc = p >> 2, hh = p & 3;
#pragma unroll
    for (int it = 0; it < 2; ++it) { const bf16* qp = a.proj + pg8::PL_RQ + (hh * pg8::MTOK + (size_t)(sc * 256 + 32 * w + 16 * it + lr)) * 128 + 4 * g;
#pragma unroll
        for (int s = 0; s < 4; ++s) { const u32x2 lo = *(const GAS u32x2*)(qp + 32 * s), hi = *(const GAS u32x2*)(qp + 32 * s + 16); Qf[it][s] = __builtin_bit_cast(bf16x8, (v4u){lo.x, lo.y, hi.x, hi.y}); } }
}
__device__ __forceinline__ void ret_units_direct(Frame& F, const CMixArgs& a) {
    const int w = F.wave;
    int p = (int)blockIdx.x;
    if (p >= 1536) return;
    bf16x8 Qf[2][4];
    asm volatile("s_waitcnt vmcnt(0)" ::: "memory"); __syncthreads();
    ret_dma_block(F, a, p, 0, 0); ret_dma_block(F, a, p, 1, 1);
    int slot = 0;
    ret_q_load(Qf, a, p, w, F.lane);
#pragma unroll 1
    for (; p < 1536; p += F.G) {
        const int sc = p >> 2, hh = p & 3, pnext = p + F.G;
        const float l2g = hh == 0 ? -0.045803689613124f : hh == 1 ? -0.022720076500083f : hh == 2 ? -0.011315313227834f : -0.005646563141142f;
        f32x4 O[8][2];
#pragma unroll
        for (int dt = 0; dt < 8; ++dt)
#pragma unroll
            for (int it = 0; it < 2; ++it) O[dt][it] = (f32x4){0.f, 0.f, 0.f, 0.f};
#pragma unroll 1
        for (int kb = 0; kb < 4; ++kb) { ret_block(F, a, p, kb, slot, pnext, Qf, O); slot = slot == 2 ? 0 : slot + 1; }
        { const int lane = opaque_i(F.lane), lr = lane & 15;
          const unsigned char* sp0 = a.st + state_off(sc, false, hh, 0) + (size_t)(unsigned)(lane * 8);
          u32x2 cA[16], cB[16];
#define RD_CLOAD(dst, k_) do { const unsigned char* b_ = sp0 + ((k_) >> 2) * 32768 + 2 * ((k_) & 3) * 512; \
              _Pragma("unroll") for (int dt = 0; dt < 8; ++dt) { dst[2 * dt] = *(const GAS u32x2*)(b_ + dt * 4096); dst[2 * dt + 1] = *(const GAS u32x2*)(b_ + dt * 4096 + 512); } } while (0)
#define RD_CMMA(src, k_) do { const int dir_ = (k_) >> 2, s_ = (k_) & 3; bf16x8 qs[2]; \
              _Pragma("unroll") for (int it = 0; it < 2; ++it) { const int i = 32 * w + 16 * it + lr; const float f = __builtin_amdgcn_exp2f(l2g * (float)(dir_ ? 256 - i : i + 1)); \
                  const v4u qw = __builtin_bit_cast(v4u, Qf[it][s_]); v4u o_; \
                  _Pragma("unroll") for (int j = 0; j < 4; ++j) ((unsigned*)&o_)[j] = cvtpk_c(bflo(((const unsigned*)&qw)[j]) * f, bfhi(((const unsigned*)&qw)[j]) * f); \
                  qs[it] = __builtin_bit_cast(bf16x8, o_); } \
              _Pragma("unroll") for (int dt = 0; dt < 8; ++dt) { const bf16x8 cf = __builtin_bit_cast(bf16x8, (v4u){src[2 * dt].x, src[2 * dt].y, src[2 * dt + 1].x, src[2 * dt + 1].y}); \
                  _Pragma("unroll") for (int it = 0; it < 2; ++it) O[dt][it] = __builtin_amdgcn_mfma_f32_16x16x32_bf16(cf, qs[it], O[dt][it], 0, 0, 0); } } while (0)
          RD_CLOAD(cA, 0); RD_CLOAD(cB, 1);
          __builtin_amdgcn_sched_barrier(0);
#pragma unroll
          for (int k = 0; k < 8; k += 2) {
              RD_CMMA(cA, k); if (k + 2 < 8) RD_CLOAD(cA, k + 2);
              __builtin_amdgcn_sched_barrier(0);
              RD_CMMA(cB, k + 1); if (k + 3 < 8) RD_CLOAD(cB, k + 3);
              __builtin_amdgcn_sched_barrier(0);
          }
#undef RD_CLOAD
#undef RD_CMMA
        }
        ret_q_load(Qf, a, pnext < 1536 ? pnext : p, w, F.lane);
        { const int lane = opaque_i(F.lane), g = lane >> 4, lr = lane & 15;
          LAS unsigned char* T = F.lds + 3 * RD_SLOT + w * (16 * 272);
          f32x4 nw[4], nb[4];
#pragma unroll
          for (int k = 0; k < 4; ++k) { nw[k] = *(const GAS f32x4*)(a.rnw + 128 * hh + 16 * (lane & 7) + 4 * k); nb[k] = *(const GAS f32x4*)(a.rnb + 128 * hh + 16 * (lane & 7) + 4 * k); }
#pragma unroll
          for (int it = 0; it < 2; ++it) {
              v4u gt[2][2];
#pragma unroll
              for (int h = 0; h < 2; ++h) { const bf16* gp = a.proj + pg8::PL_RG + (hh * pg8::MTOK + (size_t)(sc * 256 + 32 * w + 16 * it + 8 * h + (lane >> 3))) * 128 + 16 * (lane & 7);
                  gt[h][0] = *(const GAS v4u*)gp; gt[h][1] = *(const GAS v4u*)(gp + 8); }
              float sm = 0.f;
#pragma unroll
              for (int dt = 0; dt < 8; ++dt) sm += (O[dt][it][0] + O[dt][it][1]) + (O[dt][it][2] + O[dt][it][3]);
              sm += __shfl_xor(sm, 16); sm += __shfl_xor(sm, 32);
              const float mu = sm * (1.0f / 128.0f); float ss = 0.f;
#pragma unroll
              for (int dt = 0; dt < 8; ++dt) { O[dt][it] = O[dt][it] - mu; ss += (O[dt][it][0] * O[dt][it][0] + O[dt][it][1] * O[dt][it][1]) + (O[dt][it][2] * O[dt][it][2] + O[dt][it][3] * O[dt][it][3]); }
              ss += __shfl_xor(ss, 16); ss += __shfl_xor(ss, 32);
              const float rs = __builtin_amdgcn_rsqf(ss * (1.0f / 128.0f) + EPS);
#pragma unroll
              for (int dt = 0; dt < 8; ++dt) { const f32x4 y = O[dt][it] * rs;
                  u32x2 pk; pk.x = cvtpk_c(y[0], y[1]); pk.y = cvtpk_c(y[2], y[3]);
                  *(LAS u32x2*)(T + lr * 272 + 32 * dt + 8 * g) = pk; }
              asm volatile("s_waitcnt lgkmcnt(0)" ::: "memory");
#pragma unroll
              for (int h = 0; h < 2; ++h) { const int rr = 8 * h + (lane >> 3);
                  const v4u y0 = *(const LAS v4u*)(T + rr * 272 + 32 * (lane & 7)), y1 = *(const LAS v4u*)(T + rr * 272 + 32 * (lane & 7) + 16);
                  unsigned ow[8];
#pragma unroll
                  for (int k = 0; k < 8; ++k) { const unsigned yw = k < 4 ? ((const unsigned*)&y0)[k] : ((const unsigned*)&y1)[k - 4], gw = k < 4 ? ((const unsigned*)&gt[h][0])[k] : ((const unsigned*)&gt[h][1])[k - 4];
                      const float g0 = bflo(gw), g1 = bfhi(gw);
                      ow[k] = cvtpk_c((bflo(yw) * nw[k >> 1][2 * (k & 1)] + nb[k >> 1][2 * (k & 1)]) * g0 * __builtin_amdgcn_rcpf(1.0f + __expf(-g0)), (bfhi(yw) * nw[k >> 1][2 * (k & 1) + 1] + nb[k >> 1][2 * (k & 1) + 1]) * g1 * __builtin_amdgcn_rcpf(1.0f + __expf(-g1))); }
                  bf16* op = a.mo + (size_t)(sc * 256 + 32 * w + 16 * it + rr) * a.mop + 512 + 128 * hh + 16 * (lane & 7);
                  *(GAS v4u*)op = (v4u){ow[0], ow[1], ow[2], ow[3]}; *(GAS v4u*)(op + 8) = (v4u){ow[4], ow[5], ow[6], ow[7]}; }
              asm volatile("s_waitcnt lgkmcnt(0)" ::: "memory");
          } }
    }
    asm volatile("s_waitcnt vmcnt(0)" ::: "memory"); __syncthreads();
}

template <bool WITH_O>
__device__ __forceinline__ void cmix_phase(Frame& F, const CMixArgs& a, int which = 3) {
#if MIX_GLA
    if (which & 1) { if constexpr (WITH_O) mix_units<64, true, true>(F, a); else kv_units<64, true>(F, a);
    __syncthreads(); }
#endif
#if MIX_RET
    if (which & 2) { if constexpr (WITH_O) ret_units_direct(F, a); else kv_units<128, false>(F, a);
    __syncthreads(); }
#endif
}
__device__ __forceinline__ void scan_phase(Frame& F, const CMixArgs& a) {
    const int nthreads = F.G * NWAVES * 64;
    for (int chain = (int)blockIdx.x * NWAVES * 64 + F.tid; chain < 34 * 49152; chain += nthreads) {
        const int sq = chain / 49152, cidx = chain % 49152;
        const int seq = sq < 2 ? 32 + sq : sq - 2;
        const int sc0 = seq < 32 ? seq * 8 : 256 + (seq - 32) * 64, ns = seq < 32 ? 8 : 64;
        const bool gla = cidx < 16384; const int c2 = gla ? cidx : cidx - 16384;
        const int hd = gla ? (c2 >> 11) : (c2 >> 12), v = gla ? (c2 & 2047) : (c2 & 4095), hh = hd >> 1, dir = hd & 1;
        if ((gla && !MIX_GLA) || (!gla && !MIX_RET)) continue;
        const int t0 = 16 * ((v >> 6) & 3) + 4 * ((v & 63) >> 4);
        const float gret = exp2f(256.0f * log2f(1.0f - exp2f(-5.0f - (float)hh)));
        f32x4 cst = {0.f, 0.f, 0.f, 0.f};
        for (int blk = 0; blk < ns; blk += 8) {
            u32x2 kv[8]; f32x4 d[8];
#pragma unroll
            for (int j = 0; j < 8; ++j) { const int n = dir ? ns - 1 - (blk + j) : blk + j;
                kv[j] = *(const GAS u32x2*)(a.st + state_off(sc0 + n, gla, hh, dir) + (size_t)v * 8);
                d[j] = gla ? *(const GAS f32x4*)(a.dec + (size_t)(((sc0 + n) * 4 + hh) * 2 + dir) * 64 + t0) : (f32x4){gret, gret, gret, gret}; }
#pragma unroll
            for (int j = 0; j < 8; ++j) { const int n = dir ? ns - 1 - (blk + j) : blk + j;
                u32x2 pk; pk.x = cvtpk_c(cst[0], cst[1]); pk.y = cvtpk_c(cst[2], cst[3]);
                *(GAS u32x2*)(a.sto + state_off(sc0 + n, gla, hh, dir) + (size_t)v * 8) = pk;
                cst = d[j] * cst + (f32x4){bflo(kv[j].x), bfhi(kv[j].x), bflo(kv[j].y), bfhi(kv[j].y)}; }
        }
    }
}

#ifndef W2_TILED
#define W2_TILED 1
#endif
#define NAIVE_MIX (!(MIX_GLA && MIX_RET))
constexpr int PB0 = NAIVE_MIX ? 8 : 5, NPH = PB0 + 4;
struct Args { const float* in[16]; float* out; unsigned char* ws; int ph_lo, ph_hi, use_bar, pad; };
__global__ void __launch_bounds__(NWAVES * 64, 2) fwd_kernel(Args args) {
    extern __shared__ __attribute__((aligned(16))) unsigned char lds[];
    Frame F;
    F.lds = (LAS unsigned char*)lds;
    F.MISC = (volatile LAS unsigned*)(F.lds + MISC_OFF);
    F.tid = threadIdx.x; F.lane = F.tid & 63; F.wave = __builtin_amdgcn_readfirstlane(F.tid >> 6);
    F.G = gridDim.x; { const int bx = blockIdx.x; F.vcu = (F.G % 8 == 0) ? (bx % 8) * (F.G / 8) + bx / 8 : bx; }
    unsigned char* ws = args.ws;
    gu32* ctl = (gu32*)(ws + WS_CTL);
    for (int u = F.tid; u < (LDS_BYTES - LDSCTL_OFF) / 4; u += NWAVES * 64) ((LAS unsigned*)(F.lds + LDSCTL_OFF))[u] = 0u;
    __syncthreads();
    XcdBarrier bar; bar.bar = (unsigned*)(ctl + CW_BAR); bar.x = 0; bar.st = nullptr;
    if (args.use_bar) bar = xcd_barrier_post((unsigned*)(ctl + CW_BAR), F.MISC + 8);
    const int lo = args.ph_lo, hi = args.ph_hi;
#define IN(k) (lo <= (k) && (k) < hi)
#define SEAM(k) do { if (IN(k) && IN((k) + 1)) xcd_barrier(bar); } while (0)
    if (IN(0)) { const P0Args pa{args.in[0], args.in[1], args.in[2], args.in[3], args.in[11], args.in[12], args.in[13], args.in[14], (bf16*)(ws + WS_WIN), (bf16*)(ws + WS_WOUT), (bf16*)(ws + WS_W1), (bf16*)(ws + WS_W2),
            (bf16*)(ws + WS_R0), (float*)(ws + WS_ROPE), (float*)(ws + WS_ROPE) + 16384 * 64, (float*)(ws + WS_GA), (float*)(ws + WS_RSTD)};
        p0_prologue(F, pa); __syncthreads();
#if REP0
        p0_prologue(F, pa, REP0); __syncthreads();
#endif
    }
    SEAM(0);
    if (IN(1)) { pg8::Gemm g{(bf16*)(ws + WS_R0), (bf16*)(ws + WS_WIN), M_TOK, NP, D, D}; pg8::StaticOrder S; S.init(M_TOK, NP, F.G, (int)blockIdx.x);
        pg8::EpiInProj E{(bf16*)(ws + WS_R1), (float*)(ws + WS_RSTD), (float*)(ws + WS_ROPE), (float*)(ws + WS_ROPE) + 16384 * 64};
#if REP1 == 2
        { pg8::EpiPlain E2{(bf16*)(ws + WS_R1)}; pg8::gemm_phase<pg8::EpiPlain, pg8::StaticOrder, true, true>(F.lds + RING_OFF, g, S, E2); } __syncthreads();
#elif REP1 == 3
        { pg8::EpiNull E2{}; pg8::gemm_phase<pg8::EpiNull, pg8::StaticOrder, true, true>(F.lds + RING_OFF, g, S, E2); } __syncthreads();
#endif
        pg8::gemm_phase<pg8::EpiInProj, pg8::StaticOrder, true, true>(F.lds + RING_OFF, g, S, E);
#if REP1 == 1
        __syncthreads(); pg8::gemm_phase<pg8::EpiInProj, pg8::StaticOrder, true, true>(F.lds + RING_OFF, g, S, E);
#endif
    }
    SEAM(1);
    if (IN(2)) { const CMixArgs ca{(bf16*)(ws + WS_R1), (float*)(ws + WS_GA), args.in[4], args.in[5], args.in[6], args.in[7], ws + WS_R0, (float*)(ws + WS_DEC), args.in[8], args.in[9], args.in[10], (bf16*)((unsigned char*)args.out + (size_t)192 * MiB), D, ws + WS_R0, (unsigned char*)args.out, (float*)((unsigned char*)args.out + (size_t)96 * MiB), (float*)args.out, (float*)(ws + WS_DEC + 786432)};
        cmix_phase<false>(F, ca);
#if REP2
        cmix_phase<false>(F, ca, REP2);
#endif
    }
    SEAM(2);
    if (IN(3)) { const CMixArgs ca{(bf16*)(ws + WS_R1), (float*)(ws + WS_GA), args.in[4], args.in[5], args.in[6], args.in[7], ws + WS_R0, (float*)(ws + WS_DEC), args.in[8], args.in[9], args.in[10], (bf16*)((unsigned char*)args.out + (size_t)192 * MiB), D, ws + WS_R0, (unsigned char*)args.out, (float*)((unsigned char*)args.out + (size_t)96 * MiB), (float*)args.out, (float*)(ws + WS_DEC + 786432)};
#if REP3
        { CMixArgs cb = ca; cb.sto = (unsigned char*)args.out + (size_t)224 * MiB; scan_phase(F, cb); }
#endif
        scan_phase(F, ca); }
    SEAM(3);
    if (IN(4)) { const CMixArgs ca{(bf16*)(ws + WS_R1), (float*)(ws + WS_GA), args.in[4], args.in[5], args.in[6], args.in[7], ws + WS_R0, (float*)(ws + WS_DEC), args.in[8], args.in[9], args.in[10], (bf16*)((unsigned char*)args.out + (size_t)192 * MiB), D, ws + WS_R0, (unsigned char*)args.out, (float*)((unsigned char*)args.out + (size_t)96 * MiB), (float*)args.out, (float*)(ws + WS_DEC + 786432)};
#if REP4
        { CMixArgs cb = ca; cmix_phase<true>(F, cb, REP4); }
#endif
        cmix_phase<true>(F, ca); }
    SEAM(4);
#if NAIVE_MIX
    { const MixArgs ma{(bf16*)(ws + WS_R1), (float*)(ws + WS_GA), args.in[4], args.in[5], args.in[6], args.in[7], args.out, args.in[8], args.in[9], args.in[10]};
    if (IN(5)) { naive_mix_phase<false>(F, ma); __syncthreads(); }
    SEAM(5);
    if (IN(6)) { naive_mix_phase<true>(F, ma); __syncthreads(); }
    SEAM(6);
    if (IN(7)) { naive_combine(F, ma); }
    SEAM(7); }
#endif
    if (IN(PB0)) { pg8::Gemm g{(bf16*)((unsigned char*)args.out + (size_t)192 * MiB), (bf16*)(ws + WS_WOUT), M_TOK, D, D, D}; pg8::StaticOrder S; S.init(M_TOK, D, F.G, (int)blockIdx.x);
        pg8::EpiResidX E{args.in[0], args.in[1], (bf16*)(ws + WS_R0), (float*)(ws + WS_SQ1)};
        pg8::gemm_phase<pg8::EpiResidX, pg8::StaticOrder, true, true>(F.lds + RING_OFF, g, S, E);
#if REP5
        __syncthreads(); pg8::gemm_phase<pg8::EpiResidX, pg8::StaticOrder, true, true>(F.lds + RING_OFF, g, S, E);
#endif
    }
    SEAM(PB0);
    if (IN(PB0 + 1)) {
        { const float* sq = (const float*)(ws + WS_SQ1); float* r2v = (float*)(ws + WS_RSTD);
          for (int row = (int)blockIdx.x * NWAVES * 64 + F.tid; row < M_TOK; row += F.G * NWAVES * 64) { const f32x4* s4 = (const f32x4*)(sq + (size_t)row * 16);
              const f32x4 t = (s4[0] + s4[1]) + (s4[2] + s4[3]); r2v[row] = 1.0f / (((t[0] + t[1]) + (t[2] + t[3])) * (1.0f / 1024.0f) + EPS); }
          if (args.use_bar) xcd_barrier(bar); }
        pg8::Gemm g{(bf16*)(ws + WS_R0), (bf16*)(ws + WS_W1), M_TOK, FF, D, D}; pg8::StaticOrder S; S.init(M_TOK, FF, F.G, (int)blockIdx.x);
        pg8::EpiFF1 E{(bf16*)(ws + WS_R1), (float*)(ws + WS_RSTD)};
        pg8::gemm_phase<pg8::EpiFF1, pg8::StaticOrder, true, true>(F.lds + RING_OFF, g, S, E);
#if REP6
        __syncthreads(); pg8::gemm_phase<pg8::EpiFF1, pg8::StaticOrder, true, true>(F.lds + RING_OFF, g, S, E);
#endif
    }
    SEAM(PB0 + 1);
#if H_TILED
    if (IN(PB0 + 2)) { pg8::Gemm g{(bf16*)(ws + WS_R1), (bf16*)(ws + WS_W2), M_TOK, D, FF, 64, W2_TILED ? 64 : 0, 32768, W2_TILED ? 32768 : 0, (long)FF * 512, W2_TILED ? (long)FF * 512 : 0};
#else
    if (IN(PB0 + 2)) { pg8::Gemm g{(bf16*)(ws + WS_R1), (bf16*)(ws + WS_W2), M_TOK, D, FF, FF, W2_TILED ? 64 : 0, 0, W2_TILED ? 32768 : 0, 0, W2_TILED ? (long)FF * 512 : 0};
#endif
        pg8::StaticOrder S; S.init(M_TOK, D, F.G, (int)blockIdx.x, FF2_REV);
        pg8::EpiResidB E{(bf16*)(ws + WS_R0), (float*)(ws + WS_SQ2)};
        pg8::gemm_phase<pg8::EpiResidB, pg8::StaticOrder, true, true>(F.lds + RING_OFF, g, S, E); }
    SEAM(PB0 + 2);
    if (IN(PB0 + 3)) { final_norm(F, args.out, (const bf16*)(ws + WS_R0), (float*)(ws + WS_SQ2), args.in[15]);
#if REP8
        final_norm(F, args.out, (const bf16*)(ws + WS_R0), (float*)(ws + WS_SQ2), args.in[15]);
#endif
    }
#undef IN
#undef SEAM
}

extern "C" void kernel_launch(void* const* d_in, const int* in_sizes, int n_in, void* d_out, int out_size, void* d_ws, size_t ws_size, hipStream_t stream) {
    static int grid = 0;
    if (grid == 0) {
        if (n_in != 16 || in_sizes[0] != M_PROMPT * D || out_size != M_TOK * D || ws_size < WS_END) {
            fprintf(stderr, "kernel_launch: unexpected shapes (n_in %d, in0 %d, out %d, ws %zu); nothing launched\n", n_in, n_in > 0 ? in_sizes[0] : -1, out_size, ws_size); grid = -1; return; }
        int dev = 0, cus = 0, per_cu = 0;
        if (hipGetDevice(&dev) != hipSuccess || hipDeviceGetAttribute(&cus, hipDeviceAttributeMultiprocessorCount, dev) != hipSuccess) { grid = -1; return; }
        if (hipFuncSetAttribute((const void*)fwd_kernel, hipFuncAttributeMaxDynamicSharedMemorySize, LDS_BYTES) != hipSuccess) { fprintf(stderr, "kernel_launch: hipFuncSetAttribute failed\n"); grid = -1; return; }
        if (hipOccupancyMaxActiveBlocksPerMultiprocessor(&per_cu, (const void*)fwd_kernel, NWAVES * 64, LDS_BYTES) != hipSuccess || per_cu < 1)
            fprintf(stderr, "kernel_launch: note: occupancy query reports %d workgroups per CU\n", per_cu);
        (void)hipGetLastError();
        grid = cus;
    }
    if (grid < 0) return;
    if (hipMemsetAsync((char*)d_ws + WS_CTL, 0, CTL_ZERO_BYTES, stream) != hipSuccess) return;
    Args a{};
    for (int i = 0; i < 16; ++i) a.in[i] = (const float*)d_in[i];
    a.out = (float*)d_out; a.ws = (unsigned char*)d_ws;
#if MK_SINGLE
    a.ph_lo = 0; a.ph_hi = NPH; a.use_bar = 1;
    hipLaunchKernelGGL(fwd_kernel, dim3(grid), dim3(NWAVES * 64), LDS_BYTES, stream, a);
#else
    for (int p = 0; p < NPH; ++p) { a.ph_lo = p; a.ph_hi = p + 1; a.use_bar = 0;
        hipLaunchKernelGGL(fwd_kernel, dim3(grid), dim3(NWAVES * 64), LDS_BYTES, stream, a); }
#endif
}
```

```cpp
#include <hip/hip_runtime.h>
#include <cstdio>
#ifndef MK_SINGLE
#define MK_SINGLE 1
#endif
#ifndef MIX_GLA
#define MIX_GLA 1
#define MIX_RET 1
#define REP1 0
#define REP2 0
#define REP3 0
#define REP4 0
#define REP6 0
#define DUP 0
#define ABLV 0
#define REP0 0
#define RELAX_MASK 0
#define STAG_TICKS 0
#define PROF_PHASE -1
#define PROF_A 1
#define PROF_B 2
#define PROF_BLOCK 0
#define PROF_DELAY 0
#define PROJ_ROWMAJOR 0
#define H_TILED 1
#define EPI_PLAIN_VARIANT 0
#define PROF_OA 0ull
#define PROF_OB 0ull
#define PROF_QA 25ull
#define PROF_QB 25ull
#define REP5 0
#define REP8 0
#endif
namespace pg8 {
#define PG8_LAS __attribute__((address_space(3)))
typedef unsigned short bf16_t;
typedef short bf16x8 __attribute__((ext_vector_type(8)));
typedef float f32x4 __attribute__((ext_vector_type(4)));
typedef unsigned u32x4 __attribute__((ext_vector_type(4)));
constexpr int BM = 256, BK = 64, HALF = 128, HTB = HALF * BK * 2  , STAGE_BYTES = 8 * HTB, NXCD = 8, WGM = 8;

__host__ __device__ __forceinline__ int lds_byte(int r, int c) { const int st = (r >> 4) * 2 + (c >> 5), rr = r & 15, cc = c & 31, ob = rr * 64 + cc * 2; return st * 1024 + (ob ^ (((ob >> 9) & 1) << 5)); }
__host__ __device__ __forceinline__ void stage_rc(int b, int& R, int& C) { const int st = b / 1024, sb = b % 1024, swz = sb ^ (((sb >> 9) & 1) << 5); R = (st >> 1) * 16 + swz / 64; C = (st & 1) * 32 + (swz % 64) / 2; }
__host__ __device__ __forceinline__ int perm32(int rho) { const int n = rho >> 4, i = rho & 15; return 8 * (i >> 2) + 4 * n + (i & 3); }

struct Unit { int pm, pn; };
struct Gemm { const bf16_t* A; const bf16_t* Bt; int M, N, K, lda; int ldb, ksA, ksB; long psA, psB; };

struct StaticOrder {
    int nM, nN, nwg, G, c, rev;
    __host__ __device__ void init(int M, int N, int G_, int c_, int rev_ = 0) { nM = M / BM; nN = N / BM; nwg = nM * nN; G = G_; c = c_; rev = rev_; }
    __host__ __device__ bool next(int i, Unit& u) const {
        if ((long)i * G + c >= nwg) return false;
        const long L = (long)(rev ? (nwg - 1 - c) / G - i : i) * G + c;
        int wgid = (int)L; { const int q = nwg / NXCD, r = nwg % NXCD, xcd = wgid % NXCD, off = wgid / NXCD; wgid = (xcd < r ? xcd * (q + 1) : r * (q + 1) + (xcd - r) * q) + off; }
        const int nig = WGM * nN, gid = wgid / nig, fm = gid * WGM, gsz = (nM - fm) < WGM ? (nM - fm) : WGM;
        u.pm = fm + ((wgid % nig) % gsz); u.pn = (wgid % nig) / gsz; return true;
    }
    __device__ __forceinline__ void a_ready(const Unit&) const {}
    __device__ __forceinline__ void done(const Unit&) const {}
};
struct InProjOrder {
    int x, r;
    __host__ __device__ void init(int c_) { x = c_ & 7; r = c_ >> 3; }
    __host__ __device__ bool next(int i, Unit& u) const {
        if (i >= 21) return false;
        const int gi = i / 7, ri = i % 7;
        if (ri < 6) { u.pm = x * 48 + 16 * gi + 8 * (ri & 1) + (r & 7); u.pn = 4 * (ri >> 1) + (r >> 3); }
        else { u.pm = x * 48 + 16 * gi + (r & 15); u.pn = 12 + (r >> 4); }
        return true;
    }
    __device__ __forceinline__ void a_ready(const Unit&) const {}
    __device__ __forceinline__ void done(const Unit&) const {}
};
__device__ __forceinline__ unsigned cvt_pk_bf16(float lo, float hi) { unsigned r; asm volatile("v_cvt_pk_bf16_f32 %0, %1, %2" : "=v"(r) : "v"(lo), "v"(hi)); return r; }
__device__ __forceinline__ u32x4 pack8(const f32x4& a, const f32x4& b) { u32x4 w; w.x = cvt_pk_bf16(a[0], a[1]); w.y = cvt_pk_bf16(a[2], a[3]); w.z = cvt_pk_bf16(b[0], b[1]); w.w = cvt_pk_bf16(b[2], b[3]); return w; }
#ifndef H_TILED
#define H_TILED 0
#endif
#ifndef PLANE_PAD_ROWS
#define PLANE_PAD_ROWS 64
#endif
#ifndef PROJ_ROWMAJOR
#define PROJ_ROWMAJOR 0
#endif
#ifndef RELAX_MASK
#define RELAX_MASK 0
#endif
constexpr int NPROJ = 3584, DMODEL = 1024, DFF = 4096, MPROMPT = 65536;

constexpr size_t MTOK = 98304 + PLANE_PAD_ROWS;
#if PROJ_ROWMAJOR
constexpr size_t PL_GV = 0, PL_RV = 512, PL_GQ = 1024, PL_GK = 1280, PL_GG = 1536, PL_RQ = 2048, PL_RK = 2560, PL_RG = 3072, PL_END = (size_t)98304 * 4096;
__device__ __forceinline__ size_t pl(size_t grp, int hh, size_t row, int W) { return row * 4096 + grp + (size_t)(hh * W); }
#else
constexpr size_t PL_GV = 0, PL_RV = PL_GV + 4 * MTOK * 128, PL_GQ = PL_RV + 4 * MTOK * 128, PL_GK = PL_GQ + 4 * MTOK * 64, PL_GG = PL_GK + 4 * MTOK * 64,
                 PL_RQ = PL_GG + 4 * MTOK * 128, PL_RK = PL_RQ + 4 * MTOK * 128, PL_RG = PL_RK + 4 * MTOK * 128, PL_END = PL_RG + 4 * MTOK * 128;
__device__ __forceinline__ size_t pl(size_t grp, int hh, size_t row, int W) { return grp + ((size_t)hh * MTOK + row) * (size_t)W; }
#endif
__device__ __forceinline__ void plane_of(int pn, int bj, int wc, size_t& grp, int& hh, int& W, int& col) {
    W = 128; col = 32 * wc; hh = 2 * (pn & 1) + bj;
    switch (pn >> 1) { case 0: grp = PL_GV; break; case 1: grp = PL_RV; break; case 3: grp = PL_GG; break; case 4: grp = PL_RQ; break; case 5: grp = PL_RK; break; case 6: grp = PL_RG; break;
        default: grp = (pn & 1) ? PL_GK : PL_GQ; W = 64; hh = 2 * bj + (wc >> 1); col = 32 * (wc & 1); break; }
}
struct EpiInProj {
    static constexpr bool PERM = true, AFTER_DRAIN = false, RELAX = (RELAX_MASK & 1) != 0;
    bf16_t* P; const float* rstd; const float* rcos; const float* rsin;
    __device__ __forceinline__ void operator()(const f32x4 (&acc)[2][2][4][2], const Unit& u, int wr, int wc, int fr_in, int fq_in) const {
        int fr = fr_in, fq = fq_in; asm volatile("" : "+v"(fr), "+v"(fq));
        const int row0 = u.pm * BM + wr * 64 + fr;
        const bool rot = (u.pn >= 8) && (u.pn < 12);
        const int i0 = (4 * wc + fq) * 4;
        size_t pgrp[2]; int phh[2]; int W, col;
        plane_of(u.pn, 0, wc, pgrp[0], phh[0], W, col); plane_of(u.pn, 1, wc, pgrp[1], phh[1], W, col);
        const int pos0 = row0 < MPROMPT ? (row0 & 2047) : (row0 & 16383);
        f32x4 cc = (f32x4){1.f, 1.f, 1.f, 1.f}, ss = (f32x4){0.f, 0.f, 0.f, 0.f}, cd16 = cc, sd16 = ss, cd80 = cc, sd80 = ss;
        if (rot) {
            cc = *(const f32x4*)(rcos + pos0 * 64 + i0); ss = *(const f32x4*)(rsin + pos0 * 64 + i0);
            cd16 = *(const f32x4*)(rcos + 16 * 64 + i0); sd16 = *(const f32x4*)(rsin + 16 * 64 + i0); cd80 = *(const f32x4*)(rcos + 80 * 64 + i0); sd80 = *(const f32x4*)(rsin + 80 * 64 + i0); }
        float rs[2][4];
#pragma unroll
        for (int ai = 0; ai < 2; ++ai)
#pragma unroll
            for (int m = 0; m < 4; ++m) rs[ai][m] = rstd[row0 + ai * HALF + m * 16];
        __builtin_amdgcn_sched_barrier(0);
#pragma unroll
        for (int ai = 0; ai < 2; ++ai)
#pragma unroll
            for (int m = 0; m < 4; ++m) {
                const int row = row0 + ai * HALF + m * 16;
#pragma unroll
                for (int bj = 0; bj < 2; ++bj) {
                    f32x4 v0 = acc[ai][bj][m][0] * rs[ai][m], v1 = acc[ai][bj][m][1] * rs[ai][m];
                    if (rot) { const f32x4 lo = v0 * cc - v1 * ss, hi = v0 * ss + v1 * cc; v0 = lo; v1 = hi; }
                    *(u32x4*)(P + pl(pgrp[bj], phh[bj], (size_t)row, W) + col + 8 * fq) = pack8(v0, v1);
                }
                if (rot && !(ai == 1 && m == 3)) { const f32x4 cd = m == 3 ? cd80 : cd16, sd = m == 3 ? sd80 : sd16; const f32x4 nc = cc * cd - ss * sd, ns = ss * cd + cc * sd; cc = nc; ss = ns; }
            }
    }
};
struct EpiResid {
    static constexpr bool PERM = true, AFTER_DRAIN = false, RELAX = false;
    const float* xp; const float* xs; float* out; bf16_t* A2; float* sq;
    __device__ __forceinline__ void operator()(const f32x4 (&acc)[2][2][4][2], const Unit& u, int wr, int wc, int fr_in, int fq_in) const {
        int fr = fr_in, fq = fq_in; asm volatile("" : "+v"(fr), "+v"(fq));
        const int row0 = u.pm * BM + wr * 64 + fr, colb = u.pn * BM + wc * 32 + 8 * fq;
#pragma unroll
        for (int ai = 0; ai < 2; ++ai)
#pragma unroll
            for (int m = 0; m < 4; ++m) {
                const int row = row0 + ai * HALF + m * 16;
                const float* xrow = (row < MPROMPT ? xp + (size_t)row * DMODEL : xs + (size_t)(row - MPROMPT) * DMODEL) + colb;
                float* orow = out + (size_t)row * DMODEL + colb;
                float ss = 0.f;
#pragma unroll
                for (int bj = 0; bj < 2; ++bj) {
                    const f32x4 x0 = *(const f32x4*)(xrow + bj * HALF), x1 = *(const f32x4*)(xrow + bj * HALF + 4);
                    const f32x4 v0 = acc[ai][bj][m][0] + x0, v1 = acc[ai][bj][m][1] + x1;
                    *(f32x4*)(orow + bj * HALF) = v0; *(f32x4*)(orow + bj * HALF + 4) = v1;
                    if (A2) *(u32x4*)(A2 + (size_t)row * DMODEL + colb + bj * HALF) = pack8(v0, v1);
                    ss += (v0[0] * v0[0] + v0[1] * v0[1]) + (v0[2] * v0[2] + v0[3] * v0[3]) + (v1[0] * v1[0] + v1[1] * v1[1]) + (v1[2] * v1[2] + v1[3] * v1[3]);
                }
                ss += __shfl_xor(ss, 16); ss += __shfl_xor(ss, 32);
                if (fq == 0) sq[(size_t)row * 16 + u.pn * 4 + wc] = ss;
            }
    }
};
struct EpiFF1 {
    static constexpr bool PERM = true, AFTER_DRAIN = false, RELAX = (RELAX_MASK & 4) != 0;
    bf16_t* H; const float* r2v;
    __device__ __forceinline__ void operator()(const f32x4 (&acc)[2][2][4][2], const Unit& u, int wr, int wc, int fr_in, int fq_in) const {
        int fr = fr_in, fq = fq_in; asm volatile("" : "+v"(fr), "+v"(fq));
        const int row0 = u.pm * BM + wr * 64 + fr, colb = u.pn * BM + wc * 32 + 8 * fq;
        float r2[2][4];
#pragma unroll
        for (int ai = 0; ai < 2; ++ai)
#pragma unroll
            for (int m = 0; m < 4; ++m) r2[ai][m] = r2v[row0 + ai * HALF + m * 16];
        __builtin_amdgcn_sched_barrier(0);
#pragma unroll
        for (int ai = 0; ai < 2; ++ai)
#pragma unroll
            for (int m = 0; m < 4; ++m) {
                const int row = row0 + ai * HALF + m * 16;
#if H_TILED
                bf16_t* rowp = H + ((size_t)u.pm * (DFF / 64) + (size_t)(u.pn * 4 + (wc >> 1))) * (256 * 64) + (size_t)(wr * 64 + fr + ai * HALF + m * 16) * 64 + (wc & 1) * 32 + 8 * fq;
#else
                bf16_t* rowp = H + (size_t)row * DFF + colb;
#endif
#pragma unroll
                for (int bj = 0; bj < 2; ++bj) {
                    f32x4 v0 = acc[ai][bj][m][0], v1 = acc[ai][bj][m][1];
#pragma unroll
                    for (int j = 0; j < 4; ++j) { const float a = fmaxf(v0[j], 0.f), b = fmaxf(v1[j], 0.f); v0[j] = a * a * r2[ai][m]; v1[j] = b * b * r2[ai][m]; }
                    *(u32x4*)(rowp + bj * (H_TILED ? 2 * 256 * 64 : HALF)) = pack8(v0, v1);
                }
            }
    }
};

struct EpiPlain {
    static constexpr bool PERM = true, AFTER_DRAIN = false, RELAX = false;
    bf16_t* P;
    __device__ __forceinline__ void operator()(const f32x4 (&acc)[2][2][4][2], const Unit& u, int wr, int wc, int fr_in, int fq_in) const {
        int fr = fr_in, fq = fq_in; asm volatile("" : "+v"(fr), "+v"(fq));
        const int row0 = u.pm * BM + wr * 64 + fr;
        size_t pgrp[2]; int phh[2]; int W, col;
        plane_of(u.pn, 0, wc, pgrp[0], phh[0], W, col); plane_of(u.pn, 1, wc, pgrp[1], phh[1], W, col);
#pragma unroll
        for (int ai = 0; ai < 2; ++ai)
#pragma unroll
            for (int m = 0; m < 4; ++m) { const int row = row0 + ai * HALF + m * 16;
#pragma unroll
                for (int bj = 0; bj < 2; ++bj) *(u32x4*)(P + pl(pgrp[bj], phh[bj], (size_t)row, W) + col + 8 * fq) = pack8(acc[ai][bj][m][0], acc[ai][bj][m][1]); }
    }
};

struct EpiResidX {
    static constexpr bool PERM = true, AFTER_DRAIN = false, RELAX = (RELAX_MASK & 2) != 0;
    const float* xp; const float* xs; bf16_t* A2; float* sq;
    __device__ __forceinline__ void operator()(const f32x4 (&acc)[2][2][4][2], const Unit& u, int wr, int wc, int fr_in, int fq_in) const {
        int fr = fr_in, fq = fq_in; asm volatile("" : "+v"(fr), "+v"(fq));
        const int row0 = u.pm * BM + wr * 64 + fr, colb = u.pn * BM + wc * 32 + 8 * fq;
#pragma unroll
        for (int ai = 0; ai < 2; ++ai) {
            f32x4 xv[4][2][2];
#pragma unroll
            for (int m = 0; m < 4; ++m) { const int row = row0 + ai * HALF + m * 16;
                const float* xrow = (row < MPROMPT ? xp + (size_t)row * DMODEL : xs + (size_t)(row - MPROMPT) * DMODEL) + colb;
#pragma unroll
                for (int bj = 0; bj < 2; ++bj) { xv[m][bj][0] = *(const f32x4*)(xrow + bj * HALF); xv[m][bj][1] = *(const f32x4*)(xrow + bj * HALF + 4); } }
            __builtin_amdgcn_sched_barrier(0);
#pragma unroll
            for (int m = 0; m < 4; ++m) {
                const int row = row0 + ai * HALF + m * 16;
                float ss = 0.f;
#pragma unroll
                for (int bj = 0; bj < 2; ++bj) {
                    const f32x4 v0 = acc[ai][bj][m][0] + xv[m][bj][0], v1 = acc[ai][bj][m][1] + xv[m][bj][1];
                    *(u32x4*)(A2 + (size_t)row * DMODEL + colb + bj * HALF) = pack8(v0, v1);
                    ss += (v0[0] * v0[0] + v0[1] * v0[1]) + (v0[2] * v0[2] + v0[3] * v0[3]) + (v1[0] * v1[0] + v1[1] * v1[1]) + (v1[2] * v1[2] + v1[3] * v1[3]);
                }
                ss += __shfl_xor(ss, 16); ss += __shfl_xor(ss, 32);
                if (fq == 0) sq[(size_t)row * 16 + u.pn * 4 + wc] = ss;
            }
            __builtin_amdgcn_sched_barrier(0);
        }
    }
};
struct EpiResidB {
    static constexpr bool PERM = true, AFTER_DRAIN = false, RELAX = (RELAX_MASK & 8) != 0;
    bf16_t* A2; float* sq;
    __device__ __forceinline__ void operator()(const f32x4 (&acc)[2][2][4][2], const Unit& u, int wr, int wc, int fr_in, int fq_in) const {
        int fr = fr_in, fq = fq_in; asm volatile("" : "+v"(fr), "+v"(fq));
        const int row0 = u.pm * BM + wr * 64 + fr, colb = u.pn * BM + wc * 32 + 8 * fq;
        u32x4 xw[2][4][2];
#pragma unroll
        for (int ai = 0; ai < 2; ++ai)
#pragma unroll
            for (int m = 0; m < 4; ++m)
#pragma unroll
                for (int bj = 0; bj < 2; ++bj) xw[ai][m][bj] = *(const u32x4*)(A2 + (size_t)(row0 + ai * HALF + m * 16) * DMODEL + colb + bj * HALF);
        __builtin_amdgcn_sched_barrier(0);
#pragma unroll
        for (int ai = 0; ai < 2; ++ai)
#pragma unroll
            for (int m = 0; m < 4; ++m) {
                const int row = row0 + ai * HALF + m * 16;
                bf16_t* xr = A2 + (size_t)row * DMODEL + colb;
                float ss = 0.f;
#pragma unroll
                for (int bj = 0; bj < 2; ++bj) {
                    const u32x4 w_ = xw[ai][m][bj];
                    const f32x4 x0 = {__uint_as_float(w_.x << 16), __uint_as_float(w_.x & 0xffff0000u), __uint_as_float(w_.y << 16), __uint_as_float(w_.y & 0xffff0000u)};
                    const f32x4 x1 = {__uint_as_float(w_.z << 16), __uint_as_float(w_.z & 0xffff0000u), __uint_as_float(w_.w << 16), __uint_as_float(w_.w & 0xffff0000u)};
                    const f32x4 v0 = acc[ai][bj][m][0] + x0, v1 = acc[ai][bj][m][1] + x1;
                    *(u32x4*)(xr + bj * HALF) = pack8(v0, v1);
                    ss += (v0[0] * v0[0] + v0[1] * v0[1]) + (v0[2] * v0[2] + v0[3] * v0[3]) + (v1[0] * v1[0] + v1[1] * v1[1]) + (v1[2] * v1[2] + v1[3] * v1[3]);
                }
                ss += __shfl_xor(ss, 16); ss += __shfl_xor(ss, 32);
                if (fq == 0) sq[(size_t)row * 16 + u.pn * 4 + wc] = ss;
            }
    }
};

struct EpiNull {
    static constexpr bool PERM = true, AFTER_DRAIN = false, RELAX = false;
    __device__ __forceinline__ void operator()(const f32x4 (&acc)[2][2][4][2], const Unit& u, int wr, int wc, int fr_in, int fq_in) const {
        int fr = fr_in, fq = fq_in; asm volatile("" : "+v"(fr), "+v"(fq));
#pragma unroll
        for (int ai = 0; ai < 2; ++ai)
#pragma unroll
            for (int m = 0; m < 4; ++m)
#pragma unroll
                for (int bj = 0; bj < 2; ++bj) asm volatile("" :: "v"(acc[ai][bj][m][0]), "v"(acc[ai][bj][m][1]));
    }
};
template <class Epi, class Sched, bool ALIGN_EPI = false, bool SP2 = false>
__device__ __forceinline__ void gemm_phase(PG8_LAS unsigned char* lds, const Gemm g, const Sched& S, const Epi& E) {
    const int tid = threadIdx.x, wid = __builtin_amdgcn_readfirstlane(tid >> 6), lane = tid & 63, wr = wid >> 2, wc = wid & 3, fr = lane & 15, fq = lane >> 4;
    const int K = g.K, nt = K / BK, ldb = g.ldb ? g.ldb : K;
    unsigned voffA[2], voffB[2];
#pragma unroll
    for (int i = 0; i < 2; ++i) { int R, C; stage_rc(tid * 16 + i * 8192, R, C); const int Rb = Epi::PERM ? ((R & ~31) + perm32(R & 31)) : R;
        voffA[i] = (unsigned)(R * g.lda + C) * 2u; voffB[i] = (unsigned)(Rb * ldb + C) * 2u; }
    const size_t kstepA = g.ksA ? (size_t)g.ksA : (size_t)(BK * 2), kstepB = g.ksB ? (size_t)g.ksB : (size_t)(BK * 2);
    const size_t hstepB = (size_t)HALF * ldb * 2, hstepA = (size_t)HALF * g.lda * 2;
    const size_t tstepB = g.psB ? (size_t)g.psB : 2 * hstepB, tstepA = g.psA ? (size_t)g.psA : 2 * hstepA;
    const unsigned ldsw = (unsigned)wid * 1024u;
    const int aoff = lds_byte(wr * 64 + fr, fq * 8), boff = lds_byte(wc * 32 + fr, fq * 8);
#define PG8_SA(b, h) (((b) * 2 + (h)) * HTB)
#define PG8_SB(b, h) ((4 + (b) * 2 + (h)) * HTB)
#define PG8_STAGE(bufoff, gbase, voff) do { _Pragma("unroll") for (int _i = 0; _i < 2; ++_i) \
        __builtin_amdgcn_global_load_lds((const unsigned*)((const char*)(gbase) + (voff)[_i]), (PG8_LAS unsigned*)(lds + (bufoff) + ldsw + _i * 8192), 16, 0, 0); } while (0)
#define PG8_LDA(dst, b, h) do { _Pragma("unroll") for (int m = 0; m < 4; ++m) _Pragma("unroll") for (int k = 0; k < 2; ++k) dst[m][k] = *(const PG8_LAS bf16x8*)(lds + PG8_SA(b, h) + aoff + m * 2048 + k * 1024); } while (0)
#define PG8_LDB(dst, b, h) do { _Pragma("unroll") for (int n = 0; n < 2; ++n) _Pragma("unroll") for (int k = 0; k < 2; ++k) dst[n][k] = *(const PG8_LAS bf16x8*)(lds + PG8_SB(b, h) + boff + n * 2048 + k * 1024); } while (0)
#define PG8_MMA(ai, bj, At, Bt) do { __builtin_amdgcn_s_setprio(1); _Pragma("unroll") for (int m = 0; m < 4; ++m) _Pragma("unroll") for (int n = 0; n < 2; ++n) _Pragma("unroll") for (int k = 0; k < 2; ++k) \
        acc[ai][bj][m][n] = __builtin_amdgcn_mfma_f32_16x16x32_bf16(Bt[n][k], At[m][k], acc[ai][bj][m][n], 0, 0, 0); __builtin_amdgcn_s_setprio(0); } while (0)
#define PG8_WAIT_V(n) asm volatile("s_waitcnt vmcnt(" #n ")" ::: "memory")
#define PG8_WAIT_L(n) asm volatile("s_waitcnt lgkmcnt(" #n ")" ::: "memory")
#define PG8_WAIT_VF(first, nrel) asm volatile("s_cmp_lg_u32 %0, 0\n\ts_cbranch_scc1 1f\n\ts_waitcnt vmcnt(8)\n\ts_branch 2f\n1:\n\ts_waitcnt vmcnt(" #nrel ")\n2:" :: "s"(first) : "memory", "scc")
#define PG8_BAR __builtin_amdgcn_s_barrier()
#define PG8_SCHED __builtin_amdgcn_sched_barrier(0)
    Unit cur, nxt; int ui = 0;
    if (!S.next(0, cur)) return;
    f32x4 acc[2][2][4][2];
#pragma unroll
    for (int a = 0; a < 2; ++a)
#pragma unroll
        for (int b = 0; b < 2; ++b)
#pragma unroll
            for (int m = 0; m < 4; ++m)
#pragma unroll
                for (int n = 0; n < 2; ++n) acc[a][b][m][n] = (f32x4){0.f, 0.f, 0.f, 0.f};
    bf16x8 At[4][2], B0[2][2], B1[2][2];
    const char* cA = (const char*)g.A + (size_t)cur.pm * tstepA; const char* cB = (const char*)g.Bt + (size_t)cur.pn * tstepB;
    S.a_ready(cur);
    if constexpr (SP2) {
        PG8_STAGE(PG8_SB(0, 0), cB, voffB); PG8_STAGE(PG8_SB(0, 1), cB + hstepB, voffB); PG8_STAGE(PG8_SA(0, 0), cA, voffA); PG8_STAGE(PG8_SA(0, 1), cA + hstepA, voffA);
        if (wr == 1) PG8_BAR;
        PG8_WAIT_V(2); PG8_BAR;
        PG8_STAGE(PG8_SB(1, 0), cB + kstepB, voffB); PG8_STAGE(PG8_SA(1, 0), cA + kstepA, voffA); PG8_STAGE(PG8_SB(1, 1), cB + hstepB + kstepB, voffB); PG8_STAGE(PG8_SA(1, 1), cA + hstepA + kstepA, voffA);
        PG8_WAIT_V(8); PG8_BAR;
    } else {
        PG8_STAGE(PG8_SB(0, 0), cB, voffB); PG8_STAGE(PG8_SA(0, 0), cA, voffA); PG8_STAGE(PG8_SB(0, 1), cB + hstepB, voffB); PG8_STAGE(PG8_SA(0, 1), cA + hstepA, voffA);
        if (wr == 1) PG8_BAR;
        PG8_WAIT_V(4); PG8_BAR;
        PG8_STAGE(PG8_SB(1, 0), cB + kstepB, voffB); PG8_STAGE(PG8_SA(1, 0), cA + kstepA, voffA); PG8_STAGE(PG8_SB(1, 1), cB + hstepB + kstepB, voffB);
        PG8_WAIT_V(6); PG8_BAR;
    }
    for (;;) {
        const bool has_next = S.next(ui + 1, nxt);
        const char* nA = has_next ? (const char*)g.A + (size_t)nxt.pm * tstepA : cA; const char* nB = has_next ? (const char*)g.Bt + (size_t)nxt.pn * tstepB : cB;
        for (int t = 0; t < nt; t += 2) {
            const bool last = (t == nt - 2);
            const char* a1 = cA + (size_t)(t + 1) * kstepA;
            const char* a2 = last ? nA : cA + (size_t)(t + 2) * kstepA; const char* b2 = last ? nB : cB + (size_t)(t + 2) * kstepB;
            const char* a3 = a2 + kstepA; const char* b3 = b2 + kstepB;
            if (last && has_next) S.a_ready(nxt);
            if constexpr (SP2) {
            const int first = __builtin_amdgcn_readfirstlane((t == 0 && ui > 0) ? 1 : 0);
            PG8_LDB(B0, 0, 0); PG8_LDB(B1, 0, 1); PG8_SCHED; PG8_LDA(At, 0, 0);
            PG8_WAIT_VF(first, 16); PG8_WAIT_L(0); PG8_BAR; PG8_MMA(0, 0, At, B0); PG8_MMA(0, 1, At, B1); PG8_BAR; PG8_SCHED;
            PG8_LDA(At, 0, 1); PG8_STAGE(PG8_SB(0, 0), b2, voffB); PG8_STAGE(PG8_SB(0, 1), b2 + hstepB, voffB); PG8_STAGE(PG8_SA(0, 0), a2, voffA);
            PG8_WAIT_VF(first, 22); PG8_WAIT_L(0); PG8_BAR; PG8_MMA(1, 0, At, B0); PG8_MMA(1, 1, At, B1); PG8_BAR; PG8_SCHED;
            PG8_LDB(B0, 1, 0); PG8_LDB(B1, 1, 1); PG8_SCHED; PG8_LDA(At, 1, 0); PG8_STAGE(PG8_SA(0, 1), a2 + hstepA, voffA);
            PG8_WAIT_VF(first, 24); PG8_WAIT_L(0); PG8_BAR; PG8_MMA(0, 0, At, B0); PG8_MMA(0, 1, At, B1); PG8_BAR; PG8_SCHED;
            PG8_LDA(At, 1, 1); PG8_STAGE(PG8_SB(1, 0), b3, voffB); PG8_STAGE(PG8_SB(1, 1), b3 + hstepB, voffB); PG8_STAGE(PG8_SA(1, 0), a3, voffA);
            PG8_WAIT_V(8); PG8_WAIT_L(0); PG8_BAR; PG8_MMA(1, 0, At, B0); PG8_MMA(1, 1, At, B1); PG8_BAR; PG8_SCHED;
            PG8_STAGE(PG8_SA(1, 1), a3 + hstepA, voffA);
            } else {
            PG8_LDB(B0, 0, 0); PG8_SCHED; PG8_LDA(At, 0, 0); PG8_STAGE(PG8_SA(1, 1), a1 + hstepA, voffA);
            PG8_WAIT_L(8); PG8_BAR; PG8_WAIT_L(0); PG8_MMA(0, 0, At, B0); PG8_BAR; PG8_SCHED;
            PG8_LDB(B1, 0, 1); PG8_STAGE(PG8_SB(0, 0), b2, voffB);
            PG8_BAR; PG8_WAIT_L(0); PG8_MMA(0, 1, At, B1); PG8_BAR;
            PG8_LDA(At, 0, 1); PG8_STAGE(PG8_SA(0, 0), a2, voffA);
            PG8_BAR; PG8_WAIT_L(0); PG8_MMA(1, 0, At, B0); PG8_BAR; PG8_SCHED;
            PG8_STAGE(PG8_SB(0, 1), b2 + hstepB, voffB);
            PG8_WAIT_V(6); PG8_BAR; PG8_MMA(1, 1, At, B1); PG8_BAR;
            PG8_LDB(B0, 1, 0); PG8_SCHED; PG8_LDA(At, 1, 0); PG8_STAGE(PG8_SA(0, 1), a2 + hstepA, voffA);
            PG8_WAIT_L(8); PG8_BAR; PG8_WAIT_L(0); PG8_MMA(0, 0, At, B0); PG8_BAR; PG8_SCHED;
            PG8_LDB(B1, 1, 1); PG8_STAGE(PG8_SB(1, 0), b3, voffB);
            PG8_BAR; PG8_WAIT_L(0); PG8_MMA(0, 1, At, B1); PG8_BAR;
            PG8_LDA(At, 1, 1); PG8_STAGE(PG8_SA(1, 0), a3, voffA);
            PG8_BAR; PG8_WAIT_L(0); PG8_MMA(1, 0, At, B0); PG8_BAR; PG8_SCHED;
            PG8_STAGE(PG8_SB(1, 1), b3 + hstepB, voffB);
            PG8_WAIT_V(6); PG8_BAR; PG8_MMA(1, 1, At, B1); PG8_BAR;
            }
        }
        if constexpr (ALIGN_EPI) { if (wr == 0) PG8_BAR; }
        if constexpr (!Epi::AFTER_DRAIN) { E(acc, cur, wr, wc, fr, fq); S.done(cur); }
        if (!has_next) break;
#pragma unroll
        for (int a = 0; a < 2; ++a)
#pragma unroll
            for (int b = 0; b < 2; ++b)
#pragma unroll
                for (int m = 0; m < 4; ++m)
#pragma unroll
                    for (int n = 0; n < 2; ++n) acc[a][b][m][n] = (f32x4){0.f, 0.f, 0.f, 0.f};
        cur = nxt; cA = nA; cB = nB; ++ui;
        if constexpr (ALIGN_EPI) { if (wr == 1) PG8_BAR; }
    }
    PG8_WAIT_V(0);
    if constexpr (!ALIGN_EPI) { if (wr == 0) PG8_BAR; }
    PG8_BAR;
    if constexpr (Epi::AFTER_DRAIN) { E.fused(acc, cur, wr, wc, fr, fq, lds, wid, lane); S.done(cur); }
#undef PG8_SA
#undef PG8_SB
#undef PG8_STAGE
#undef PG8_LDA
#undef PG8_LDB
#undef PG8_MMA
#undef PG8_WAIT_V
#undef PG8_WAIT_L
#undef PG8_WAIT_VF
#undef PG8_BAR
#undef PG8_SCHED
}
}
#define GAS __attribute__((address_space(1)))
#define LAS __attribute__((address_space(3)))
typedef unsigned short bf16;
typedef unsigned v4u __attribute__((ext_vector_type(4)));
typedef float f32x4 __attribute__((ext_vector_type(4)));
typedef short bf16x8 __attribute__((ext_vector_type(8)));
typedef GAS unsigned gu32;
typedef GAS unsigned long long gu64;
#define RLX_AGENT __ATOMIC_RELAXED, __HIP_MEMORY_SCOPE_AGENT
#define LDS_WAIT() asm volatile("s_waitcnt lgkmcnt(0)" ::: "memory")
#define VM_WAIT() asm volatile("s_waitcnt vmcnt(0)" ::: "memory")
__device__ __forceinline__ unsigned long long rt() { return __builtin_amdgcn_s_memrealtime(); }
__device__ __forceinline__ unsigned f2bf(float f) { unsigned u = __builtin_bit_cast(unsigned, f); return (u + 0x7fffu + ((u >> 16) & 1u)) >> 16; }
__device__ __forceinline__ unsigned pk2(float lo, float hi) { return f2bf(lo) | (f2bf(hi) << 16); }

#define XB_TMO      128
#define XB_XCNT(j)  (256  + 64 * (j))
#define XB_XSUB(j)  (1280 + 64 * (j))
#define XB_XGEN(j)  (2304 + 64 * (j))
#define XB_TOP      3328
#define XB_TOPGEN   3392
#define XCD_BAR_WORDS 3456
#define XB_SPIN_CAP (1u << 18)

__device__ __forceinline__ unsigned xb_ld(unsigned* p)              { return __hip_atomic_load(p, __ATOMIC_RELAXED, __HIP_MEMORY_SCOPE_AGENT); }
__device__ __forceinline__ unsigned xb_add(unsigned* p, unsigned v) { return __hip_atomic_fetch_add(p, v, __ATOMIC_RELAXED, __HIP_MEMORY_SCOPE_AGENT); }
__device__ __forceinline__ unsigned xb_xcc_id() { return (unsigned)__builtin_amdgcn_s_getreg((3 << 11) | 20) & 0xFu; }
#define XB_SPIN(cond, bar) do { unsigned _sp = 0; while (cond) { __builtin_amdgcn_s_sleep(1); \
    if ((++_sp & 255u) == 0u) { if (xb_ld(&(bar)[XB_TMO])) break; if (_sp > XB_SPIN_CAP) { atomicAdd(&(bar)[XB_TMO], 1u); break; } } } } while (0)

struct XcdBarrier {
    unsigned* bar; unsigned x;
    volatile LAS unsigned* st;
};

__device__ __forceinline__ XcdBarrier xcd_barrier_post(unsigned* bar, volatile LAS unsigned* st) {
    XcdBarrier b; b.bar = bar; b.x = xb_xcc_id(); b.st = st;
    if (threadIdx.x == 0) (void)xb_add(&bar[XB_XCNT(b.x)], 1u);
    return b;
}
__device__ __forceinline__ void xcd_barrier_complete(unsigned* bar, unsigned x, unsigned& nloc, unsigned& nx) {
    const unsigned G = gridDim.x * gridDim.y * gridDim.z;
    unsigned sum, cnt, mine, sp = 0u;
    for (;;) {
        sum = 0u; cnt = 0u; mine = 0u;
#pragma unroll
        for (unsigned j = 0; j < 16; ++j) { const unsigned c = xb_ld(&bar[XB_XCNT(j)]); sum += c; cnt += (c > 0u) ? 1u : 0u; mine = (j == x) ? c : mine; }
        if (sum == G) break;
        __builtin_amdgcn_s_sleep(1);
        if ((++sp & 255u) == 0u) { if (xb_ld(&bar[XB_TMO])) break; if (sp > XB_SPIN_CAP) { atomicAdd(&bar[XB_TMO], 1u); break; } }
    }
    nloc = mine > 0u ? mine : 1u; nx = cnt > 0u ? cnt : 1u;
}

__device__ __forceinline__ void xcd_barrier(const XcdBarrier& b) {
    asm volatile("s_waitcnt vmcnt(0)" ::: "memory");
    __syncthreads();
    if (threadIdx.x == 0) {
        unsigned* bar = b.bar;
        __builtin_amdgcn_s_waitcnt(0);
        unsigned nloc = b.st[0], nx = b.st[1];
        if (nloc == 0u) { xcd_barrier_complete(bar, b.x, nloc, nx); b.st[0] = nloc; b.st[1] = nx; }
        const unsigned old = xb_add(&bar[XB_XSUB(b.x)], 1u);
        const unsigned gen = old / nloc;
        if (old + 1u == (gen + 1u) * nloc) {
            __builtin_amdgcn_fence(__ATOMIC_RELEASE, "agent");
            asm volatile("s_waitcnt vmcnt(0)" ::: "memory");
            const unsigned og = xb_add(&bar[XB_TOP], 1u);
            const unsigned tg = og / nx;
            if (og + 1u == (tg + 1u) * nx) xb_add(&bar[XB_TOPGEN], 1u);
            else XB_SPIN(xb_ld(&bar[XB_TOPGEN]) == tg, bar);
            __builtin_amdgcn_fence(__ATOMIC_ACQUIRE, "agent");
            xb_add(&bar[XB_XGEN(b.x)], 1u);
            asm volatile("s_waitcnt vmcnt(0)" ::: "memory");
        } else {
            XB_SPIN(xb_ld(&bar[XB_XGEN(b.x)]) == gen, bar);
            __builtin_amdgcn_fence(__ATOMIC_ACQUIRE, "agent");
            asm volatile("s_waitcnt vmcnt(0)" ::: "memory");
        }
    }
    __syncthreads();
}
#ifndef FF2_REV
#define FF2_REV 1
#endif
#ifndef W2_TILED
#define W2_TILED 1
#endif
constexpr int NWAVES = 8;
constexpr int M_TOK = 98304, M_PROMPT = 65536, D = 1024, NP = 3584, NWIN = 3616, FF = 4096;
constexpr int L_PROMPT = 2048, L_SAMPLE = 16384;
constexpr float EPS = 1e-6f;
constexpr size_t MiB = 1u << 20;
constexpr size_t WS_CTL = 0, CTL_ZERO_BYTES = 1 * MiB;
constexpr size_t WS_WIN = 1 * MiB;
constexpr size_t WS_WOUT = 9 * MiB;
constexpr size_t WS_W1 = 11 * MiB;
constexpr size_t WS_W2 = 19 * MiB;
constexpr size_t WS_ROPE = 27 * MiB;
constexpr size_t WS_GA = 35 * MiB;
constexpr size_t WS_RSTD = 47 * MiB;
constexpr size_t WS_SQ1 = 48 * MiB;
constexpr size_t WS_SQ2 = 54 * MiB;
constexpr size_t WS_DEC = 60 * MiB;
constexpr size_t WS_R0 = 64 * MiB;
constexpr size_t WS_R1 = 256 * MiB;
constexpr size_t WS_END = 1024 * MiB;
constexpr int CW_BAR = 4096;
constexpr int RING_OFF = 0, RING_BYTES = 131072;
constexpr int LDSCTL_OFF = 147456 - 1024, MISC_OFF = LDSCTL_OFF + 320;
constexpr int LDS_BYTES = 147456;

struct Frame {
    LAS unsigned char* lds;
    volatile LAS unsigned* MISC;
    int tid, lane, wave, vcu, G;
};
__device__ __forceinline__ float wave_sum(float v) {
#pragma unroll
    for (int o = 1; o < 64; o <<= 1) v += __shfl_xor(v, o);
    return v;
}
__device__ __forceinline__ float bf2f(bf16 b) { return __uint_as_float((unsigned)b << 16); }
__device__ __forceinline__ unsigned cvtpk(float lo, float hi) { unsigned r; asm volatile("v_cvt_pk_bf16_f32 %0, %1, %2" : "=v"(r) : "v"(lo), "v"(hi)); return r; }

__device__ __forceinline__ void win_map(int nd, int& sc, float& cs) {
    cs = 1.f;
    if (nd < 512) sc = 512 + nd;
    else if (nd < 1024) sc = 2592 + (nd - 512);
    else if (nd < 1280) { sc = nd - 1024; cs = 0.125f; }
    else if (nd < 1536) sc = 256 + (nd - 1280);
    else if (nd < 2048) sc = 1024 + (nd - 1536);
    else if (nd < 3072) {
        const bool isq = nd < 2560; const int p = nd - (isq ? 2048 : 2560), h = p >> 7, pp = p & 127, u = pp >> 3, j = pp & 7;
        const int d = (j < 4) ? 4 * u + j : 64 + 4 * u + (j - 4);
        sc = (isq ? 1568 : 2080) + 128 * h + d; if (isq) cs = 0.08838834764831845f; }
    else if (nd < 3584) sc = 3104 + (nd - 3072);
    else sc = 1536 + (nd - 3584);
}
template <bool MAP, bool TILED = false>
__device__ __forceinline__ void p0_transpose_item(const float* W, int K, int Nsrc, int nblk, const float* ks, bf16* WT, LAS float* scr, int item, int lane) {
    const int kb = item / nblk, nb = item % nblk, k0 = 64 * kb, n0 = 32 * nb;
    int sc = n0 + (lane & 31); float cs = 1.f;
    if (MAP) win_map(n0 + (lane & 31), sc, cs);
#pragma unroll 8
    for (int i = 0; i < 32; ++i) { const int kk = 2 * i + (lane >> 5); float w = W[(size_t)(k0 + kk) * Nsrc + sc] * cs; if (ks) w *= ks[k0 + kk]; scr[kk * 33 + (lane & 31)] = w; }
    LDS_WAIT(); asm volatile("" ::: "memory");
    const int c = lane & 7;
#pragma unroll
    for (int j = 0; j < 4; ++j) { const int n = (lane >> 3) + 8 * j; const LAS float* s = scr + (8 * c) * 33 + n;
        v4u o; o.x = cvtpk(s[0 * 33], s[1 * 33]); o.y = cvtpk(s[2 * 33], s[3 * 33]); o.z = cvtpk(s[4 * 33], s[5 * 33]); o.w = cvtpk(s[6 * 33], s[7 * 33]);
        if (TILED) { const int nn = n0 + n; *(GAS v4u*)(WT + (((size_t)(nn >> 8) * (K >> 6) + (k0 >> 6)) * 256 + (nn & 255)) * 64 + 8 * c) = o; }
        else *(GAS v4u*)(WT + (size_t)(n0 + n) * K + k0 + 8 * c) = o; }
    LDS_WAIT(); asm volatile("" ::: "memory");
}
__device__ __forceinline__ void rope_entry(int e, float* rcos, float* rsin) {
    const int pos = e >> 6, i = e & 63;
    double inv = 1.0, b = 0.8659643233600653;
#pragma unroll
    for (int bit = 0; bit < 6; ++bit) { if ((i >> bit) & 1) inv *= b; b *= b; }
    const double ang = (double)pos * inv;
    const double n = __builtin_rint(ang * 0.6366197723675814);
    double r = __builtin_fma(-n, 1.5707963267948966, ang); r = __builtin_fma(-n, 6.123233995736766e-17, r);
    const double r2 = r * r;
    double s = -1.0 / 1307674368000.0;
    s = s * r2 + 1.0 / 6227020800.0; s = s * r2 - 1.0 / 39916800.0; s = s * r2 + 1.0 / 362880.0; s = s * r2 - 1.0 / 5040.0; s = s * r2 + 1.0 / 120.0; s = s * r2 - 1.0 / 6.0; s = s * r2 * r + r;
    double c = 1.0 / 20922789888000.0;
    c = c * r2 - 1.0 / 87178291200.0; c = c * r2 + 1.0 / 479001600.0; c = c * r2 - 1.0 / 3628800.0; c = c * r2 + 1.0 / 40320.0; c = c * r2 - 1.0 / 720.0; c = c * r2 + 1.0 / 24.0; c = c * r2 - 0.5; c = c * r2 + 1.0;
    const int q = ((int)n) & 3;
    const double cs = (q == 0) ? c : (q == 1) ? -s : (q == 2) ? -c : s;
    const double sn = (q == 0) ? s : (q == 1) ? c : (q == 2) ? -s : -c;
    rcos[e] = (float)cs; rsin[e] = (float)sn;
}
struct P0Args { const float *xp, *xs, *anw, *win, *wout, *mnw, *w1, *w2; bf16 *Win_t, *Wout_t, *W1_t, *W2_t, *Xb; float *rcos, *rsin, *ga, *rstd; };
__device__ __forceinline__ void p0_prologue(Frame& F, const P0Args& a, int parts = 3) {
    LAS float* scr = (LAS float*)(F.lds + RING_OFF + F.wave * 16384);
    const int gw = F.vcu * NWAVES + F.wave, NGW = F.G * NWAVES;
    constexpr int I_IN = (D / 64) * (NWIN / 32), I_O = (D / 64) * (D / 32), I_1 = (D / 64) * (FF / 32), I_2 = (FF / 64) * (D / 32);
    constexpr int NITEMS = I_IN + I_O + I_1 + I_2;
    if (parts & 1) for (int it = gw; it < NITEMS; it += NGW) {
        int r = it;
        if (r < I_IN) { p0_transpose_item<true>(a.win, D, NWIN, NWIN / 32, a.anw, a.Win_t, scr, r, F.lane); continue; } r -= I_IN;
        if (r < I_O) { p0_transpose_item<false>(a.wout, D, D, D / 32, nullptr, a.Wout_t, scr, r, F.lane); continue; } r -= I_O;
        if (r < I_1) { p0_transpose_item<false>(a.w1, D, FF, FF / 32, a.mnw, a.W1_t, scr, r, F.lane); continue; } r -= I_1;
        p0_transpose_item<false, W2_TILED != 0>(a.w2, FF, D, D / 32, nullptr, a.W2_t, scr, r, F.lane);
    }
    if (parts & 1) for (int e = (blockIdx.x * NWAVES * 64) + F.tid; e < 16384 * 64; e += F.G * NWAVES * 64) rope_entry(e, a.rcos, a.rsin);
    __syncthreads();
    LAS bf16* wl = (LAS bf16*)(F.lds + RING_OFF);
    for (int e = F.tid; e < 32 * 1024; e += NWAVES * 64) { const int k = e >> 5, c = e & 31; wl[c * 1032 + k] = (bf16)(cvtpk(a.win[(size_t)k * NWIN + 1536 + c] * a.anw[k], 0.f) & 0xffffu); }
    __syncthreads();
    const int r = F.lane & 15, g = F.lane >> 4;
    LAS unsigned char* tl = F.lds + RING_OFF + 66048 + F.wave * 8448;
    if (parts & 2) {
        f32x4 xa[16], xb[16];
#define P0_LOAD(dst, it_, kc_) do { const int r0_ = (it_) * 16; const float* xp_ = (r0_ < M_PROMPT ? a.xp + (size_t)r0_ * D : a.xs + (size_t)(r0_ - M_PROMPT) * D) + 4 * F.lane + 256 * (kc_); \
            _Pragma("unroll") for (int rr = 0; rr < 16; ++rr) dst[rr] = *(const GAS f32x4*)(xp_ + (size_t)rr * D); } while (0)
#define P0_PROC(src, kc_) do { \
            _Pragma("unroll") for (int rr = 0; rr < 16; ++rr) { unsigned long long pk = (unsigned long long)cvtpk(src[rr][0], src[rr][1]) | ((unsigned long long)cvtpk(src[rr][2], src[rr][3]) << 32); \
                *(LAS unsigned long long*)(tl + rr * 528 + F.lane * 8) = pk; *(GAS unsigned long long*)(xo + (size_t)rr * D + 256 * (kc_)) = pk; } \
            asm volatile("s_waitcnt lgkmcnt(0)" ::: "memory"); \
            _Pragma("unroll") for (int s8 = 0; s8 < 8; ++s8) { \
                const bf16x8 af = *(const LAS bf16x8*)(tl + r * 528 + 64 * s8 + 16 * g); \
                const int k0 = 256 * (kc_) + 32 * s8 + 8 * g; \
                const bf16x8 b0 = *(const LAS bf16x8*)(wl + r * 1032 + k0), b1 = *(const LAS bf16x8*)(wl + (16 + r) * 1032 + k0); \
                acc0 = __builtin_amdgcn_mfma_f32_16x16x32_bf16(af, b0, acc0, 0, 0, 0); acc1 = __builtin_amdgcn_mfma_f32_16x16x32_bf16(af, b1, acc1, 0, 0, 0); \
                const v4u aw = __builtin_bit_cast(v4u, af); \
                _Pragma("unroll") for (int j = 0; j < 4; ++j) { const unsigned u = ((const unsigned*)&aw)[j]; const float lo = __uint_as_float(u << 16), hi = __uint_as_float(u & 0xffff0000u); ss += lo * lo + hi * hi; } } \
            asm volatile("s_waitcnt lgkmcnt(0)" ::: "memory"); } while (0)
        if (gw < M_TOK / 16) P0_LOAD(xa, gw, 0);
        for (int item = gw; item < M_TOK / 16; item += NGW) {
            const int row0 = item * 16;
            bf16* xo = a.Xb + (size_t)row0 * D + 4 * F.lane;
            f32x4 acc0 = {0.f, 0.f, 0.f, 0.f}, acc1 = {0.f, 0.f, 0.f, 0.f}; float ss = 0.f;
            const int nitem = item + NGW < M_TOK / 16 ? item + NGW : item;
            P0_LOAD(xb, item, 1); __builtin_amdgcn_sched_barrier(0); P0_PROC(xa, 0); __builtin_amdgcn_sched_barrier(0);
            P0_LOAD(xa, item, 2); __builtin_amdgcn_sched_barrier(0); P0_PROC(xb, 1); __builtin_amdgcn_sched_barrier(0);
            P0_LOAD(xb, item, 3); __builtin_amdgcn_sched_barrier(0); P0_PROC(xa, 2); __builtin_amdgcn_sched_barrier(0);
            P0_LOAD(xa, nitem, 0); __builtin_amdgcn_sched_barrier(0); P0_PROC(xb, 3); __builtin_amdgcn_sched_barrier(0);
            ss += __shfl_xor(ss, 16); ss += __shfl_xor(ss, 32);
            const float rs = 1.0f / sqrtf(ss * (1.0f / 1024.0f) + EPS);
            if (g == 0) a.rstd[row0 + r] = rs;
#pragma unroll
            for (int q = 0; q < 4; ++q) { const int rr = 4 * g + q; const float rq = __shfl(rs, rr);
                a.ga[(size_t)(row0 + rr) * 32 + r] = acc0[q] * rq; a.ga[(size_t)(row0 + rr) * 32 + 16 + r] = acc1[q] * rq; }
        }
#undef P0_LOAD
#undef P0_PROC
    }
}

__device__ __forceinline__ float log_sigmoid_f(float z) { return fminf(z, 0.f) - log1pf(expf(-fabsf(z))); }
struct MixArgs { bf16* proj; const float* ga; const float *waf, *baf, *wab, *bab; float* of; const float *gnw, *rnw, *rnb; };
constexpr int NTB = 16;
template <int DK, bool GLA, bool BWD>
__device__ __forceinline__ void naive_sweep(Frame& F, const MixArgs& a, int job) {
    const int grp = F.tid >> 7, gt = F.tid & 127;
    int seq, head; if (job < 16) { seq = 32 + (job >> 3); head = job & 7; } else { seq = (job - 16) >> 3; head = (job - 16) & 7; }
    const int L = seq < 32 ? L_PROMPT : L_SAMPLE, row_base = seq < 32 ? seq * L_PROMPT : M_PROMPT + (seq - 32) * L_SAMPLE;
    const int hh = GLA ? head : head - 4;
    const int qcol = GLA ? 1024 + 64 * hh : 2048 + 128 * hh, kcol = GLA ? 1280 + 64 * hh : 2560 + 128 * hh, vcol = 128 * head;
    LAS float* sq = (LAS float*)(F.lds + grp * (3 * NTB * 128 * 4)); LAS float* sk = sq + NTB * DK; LAS float* sa = sk + NTB * DK;
    const float gam = 1.0f - exp2f(-5.0f - (float)hh);
    const float* wal = BWD ? a.wab : a.waf; const float* bal = BWD ? a.bab : a.baf;
    float S[DK];
#pragma unroll
    for (int t = 0; t < DK; ++t) S[t] = 0.f;
    for (int t0 = 0; t0 < L; t0 += NTB) {
        __syncthreads();
        for (int e = gt; e < NTB * DK; e += 128) {
            const int tok = e / DK, t = e % DK, tp = t0 + tok, row = row_base + (BWD ? L - 1 - tp : tp);
            const bf16* pr = a.proj + (size_t)row * NP;
            sq[e] = bf2f(pr[qcol + t]); sk[e] = bf2f(pr[kcol + t]);
            if (GLA) { const float* gar = a.ga + (size_t)row * 32 + (BWD ? 16 : 0); float z = bal[64 * hh + t];
#pragma unroll
                for (int r = 0; r < 16; ++r) z += gar[r] * wal[r * 256 + 64 * hh + t];
                sa[e] = expf(fmaxf(log_sigmoid_f(z) * (1.0f / 16.0f), -1.0f)); }
        }
        __syncthreads();
        for (int tok = 0; tok < NTB; ++tok) {
            const int tp = t0 + tok, row = row_base + (BWD ? L - 1 - tp : tp);
            const float vv = bf2f(a.proj[(size_t)row * NP + vcol + gt]);
            float o = 0.f;
#pragma unroll
            for (int t4 = 0; t4 < DK / 4; ++t4) {
                const f32x4 q = *(const LAS f32x4*)(sq + tok * DK + 4 * t4), k = *(const LAS f32x4*)(sk + tok * DK + 4 * t4);
                f32x4 al = {gam, gam, gam, gam}; if (GLA) al = *(const LAS f32x4*)(sa + tok * DK + 4 * t4);
#pragma unroll
                for (int j = 0; j < 4; ++j) {
                    if (!BWD) { S[4 * t4 + j] = al[j] * S[4 * t4 + j] + k[j] * vv; o += q[j] * S[4 * t4 + j]; }
                    else { S[4 * t4 + j] *= al[j]; o += q[j] * S[4 * t4 + j]; S[4 * t4 + j] += k[j] * vv; }
                }
            }
            float* op = a.of + (size_t)row * D + 128 * head + gt;
            if (!BWD) *op = o; else *op += o;
        }
    }
}
template <bool BWD>
__device__ __forceinline__ void naive_mix_phase(Frame& F, const MixArgs& a) {
    if (blockIdx.x >= 68) return;
    const int job = blockIdx.x * 4 + (F.tid >> 7);
    if ((blockIdx.x & 1) == 0) { if (!MIX_GLA) naive_sweep<64, true, BWD>(F, a, job); } else { if (!MIX_RET) naive_sweep<128, false, BWD>(F, a, job); }
}
__device__ __forceinline__ void naive_combine(Frame& F, const MixArgs& a) {
    const int gw = F.vcu * NWAVES + F.wave, NGW = F.G * NWAVES, c = 2 * F.lane;
    for (int item = gw; item < M_TOK * 8; item += NGW) {
        const int row = item >> 3, head = item & 7;
        if (head < 4 ? MIX_GLA : MIX_RET) continue;
        const float* op = a.of + (size_t)row * D + 128 * head + c;
        float o0 = op[0], o1 = op[1], y0, y1;
        if (head < 4) { const float r = 1.0f / sqrtf(wave_sum(o0 * o0 + o1 * o1) * (1.0f / 128.0f) + EPS); y0 = o0 * r * a.gnw[c]; y1 = o1 * r * a.gnw[c + 1]; }
        else { const float mu = wave_sum(o0 + o1) * (1.0f / 128.0f); o0 -= mu; o1 -= mu; const float r = 1.0f / sqrtf(wave_sum(o0 * o0 + o1 * o1) * (1.0f / 128.0f) + EPS);
            const int cc = 128 * (head - 4) + c; y0 = o0 * r * a.rnw[cc] + a.rnb[cc]; y1 = o1 * r * a.rnw[cc + 1] + a.rnb[cc + 1]; }
        bf16* pr = a.proj + (size_t)row * NP;
        const int gcol = (head < 4 ? 1536 + 128 * head : 3072 + 128 * (head - 4)) + c;
        const unsigned gw2 = *(const unsigned*)(pr + gcol);
        const float g0 = __uint_as_float(gw2 << 16), g1 = __uint_as_float(gw2 & 0xffff0000u);
        y0 *= g0 / (1.0f + expf(-g0)); y1 *= g1 / (1.0f + expf(-g1));
        *(unsigned*)(pr + 128 * head + c) = cvtpk(y0, y1);
    }
}
__device__ __forceinline__ void final_norm(Frame& F, float* out, const bf16* x2b, const float* sq, const float* w) {
    const int gw = F.vcu * NWAVES + F.wave, NGW = F.G * NWAVES;
    const f32x4* w4 = (const f32x4*)w + 2 * F.lane;
    f32x4 wv[2][2];
#pragma unroll
    for (int j = 0; j < 2; ++j) { wv[j][0] = w4[128 * j]; wv[j][1] = w4[128 * j + 1]; }
    for (int r0 = 4 * gw; r0 < M_TOK; r0 += 4 * NGW) {
        v4u xw[4][2]; f32x4 s4[4];
#pragma unroll
        for (int k = 0; k < 4; ++k) { const int row = r0 + k;
            s4[k] = *(const GAS f32x4*)(sq + (size_t)row * 16 + 4 * (F.lane & 3));
            const GAS v4u* xi = (const GAS v4u*)(x2b + (size_t)row * D) + F.lane;
            xw[k][0] = xi[0]; xw[k][1] = xi[64]; }
#pragma unroll
        for (int k = 0; k < 4; ++k) { const int row = r0 + k;
            float t = (s4[k][0] + s4[k][1]) + (s4[k][2] + s4[k][3]); t += __shfl_xor(t, 1); t += __shfl_xor(t, 2);
            const float r = 1.0f / sqrtf(t * (1.0f / 1024.0f) + EPS);
            GAS f32x4* o = (GAS f32x4*)(out + (size_t)row * D) + 2 * F.lane;
#pragma unroll
            for (int j = 0; j < 2; ++j) { const v4u x = xw[k][j];
                const f32x4 x0 = {__uint_as_float(x.x << 16), __uint_as_float(x.x & 0xffff0000u), __uint_as_float(x.y << 16), __uint_as_float(x.y & 0xffff0000u)};
                const f32x4 x1 = {__uint_as_float(x.z << 16), __uint_as_float(x.z & 0xffff0000u), __uint_as_float(x.w << 16), __uint_as_float(x.w & 0xffff0000u)};
                o[128 * j] = x0 * r * wv[j][0]; o[128 * j + 1] = x1 * r * wv[j][1]; } }
    }
}

typedef __bf16 bf16v2 __attribute__((ext_vector_type(2)));
typedef unsigned u32x2 __attribute__((ext_vector_type(2)));
__device__ __forceinline__ unsigned cvtpk_c(float lo, float hi) { bf16v2 v = {(__bf16)lo, (__bf16)hi}; return __builtin_bit_cast(unsigned, v); }
__device__ __forceinline__ float bflo(unsigned w) { return __uint_as_float(w << 16); }
__device__ __forceinline__ float bfhi(unsigned w) { return __uint_as_float(w & 0xffff0000u); }
__device__ __forceinline__ int opaque_i(int x) { asm volatile("" : "+v"(x)); return x; }
typedef short s16x4 __attribute__((ext_vector_type(4)));
#define TRRD(ptr) __builtin_amdgcn_ds_read_tr16_b64_v4i16((LAS s16x4*)(ptr))
constexpr size_t ST_SC_BYTES = 393216;
__device__ __forceinline__ size_t state_off(int sc, bool gla, int hh, int dir) { return (size_t)sc * ST_SC_BYTES + (gla ? (size_t)(hh * 2 + dir) * 16384 : (size_t)131072 + (size_t)(hh * 2 + dir) * 32768); }
typedef _Float16 bh16;
__device__ __forceinline__ float h2f(unsigned w, int hi) { return (float)__builtin_bit_cast(bh16, (unsigned short)(hi ? (w >> 16) : (w & 0xffffu))); }
struct CMixArgs { bf16* proj; const float* ga; const float *waf, *baf, *wab, *bab; unsigned char* st; float* dec; const float *gnw, *rnw, *rnb; bf16* mo; int mop; unsigned char* sto; unsigned char* ofs; bh16* bb0; bh16* bb1; float* gv; };
constexpr int OB_PITCH = 132;

template <bool GLA> struct RawSet;
template <> struct RawSet<true> { v4u q, k, v0, v1, bh, lh; };
template <> struct RawSet<false> { v4u q0, q1, k0, k1, v0, v1; };

template <bool GLA, bool WITH_O>
__device__ __forceinline__ void raw_load(RawSet<GLA>& R, const CMixArgs& a, int p, int s, int w, int lane0) {
    const int lane = opaque_i(lane0), sc = p >> 2, hh = p & 3, dir = s >> 2, c = dir ? 7 - s : s;
    const size_t row = (size_t)(sc * 256 + 64 * c + 8 * w + (lane >> 3)); const int pc = lane & 7;
    if constexpr (GLA) {
        if (WITH_O) R.q = *(const GAS v4u*)(a.proj + pg8::pl(pg8::PL_GQ, hh, row, 64) + 8 * pc);
        R.k = *(const GAS v4u*)(a.proj + pg8::pl(pg8::PL_GK, hh, row, 64) + 8 * pc);
        const bf16* pv = a.proj + pg8::pl(pg8::PL_GV, hh, row, 128) + 8 * pc;
        R.v0 = *(const GAS v4u*)pv; R.v1 = *(const GAS v4u*)(pv + 64);
        const bh16* bp = (dir ? a.bb1 : a.bb0) + ((size_t)(p * 4 + c) * 64) * 64 + 8 * pc;
        const int ti = 8 * w + (lane >> 3);
        R.bh = *(const GAS v4u*)(bp + ti * 64); R.lh = *(const GAS v4u*)(bp + (dir ? 0 : 63) * 64);
    } else {
        if (WITH_O) { const bf16* pq = a.proj + pg8::pl(pg8::PL_RQ, hh, row, 128) + 8 * pc; R.q0 = *(const GAS v4u*)pq; R.q1 = *(const GAS v4u*)(pq + 64); }
        const bf16* pk = a.proj + pg8::pl(pg8::PL_RK, hh, row, 128) + 8 * pc; R.k0 = *(const GAS v4u*)pk; R.k1 = *(const GAS v4u*)(pk + 64);
        const bf16* pv = a.proj + pg8::pl(pg8::PL_RV, hh, row, 128) + 8 * pc; R.v0 = *(const GAS v4u*)pv; R.v1 = *(const GAS v4u*)(pv + 64);
    }
}

template <int DK, bool GLA, bool WITH_O> struct MixLds {
    static constexpr int NT = DK / 16, NS = DK / 32;
    static constexpr int RQ = DK * 2 + 16, RP = 144, RV = 272;
    static constexpr int O_QD = 0, O_KI = 64 * RQ, O_KE = 2 * 64 * RQ, O_PB = 3 * 64 * RQ, O_VB = O_PB + 64 * RP, O_DC = O_VB + 64 * RV, O_WAL = O_DC + DK * 4,
                         O_OB = O_WAL, O_END = O_OB + 64 * OB_PITCH * 4;
    static_assert(O_END <= 146432, "mixer LDS map");
};

template <int DK, bool GLA, bool WITH_O>
__device__ __forceinline__ void mix_step(Frame& F, const CMixArgs& a, int p, int s, int pnext, RawSet<GLA>& R, f32x4 (&S)[DK / 16], float (&dsum)[8], u32x2 (&ofp)[4][4]) {
    typedef MixLds<DK, GLA, WITH_O> ML;
    constexpr int NT = ML::NT, NS = ML::NS, RQ = ML::RQ, RP = ML::RP, RV = ML::RV;
    LAS unsigned char* L = F.lds;
    const int lane0 = F.lane, w = F.wave;
    const int sc = p >> 2, hh = p & 3, dir = s >> 2, c = dir ? 7 - s : s, row0 = sc * 256, head = GLA ? hh : 4 + hh, vcol = 128 * head;
    __syncthreads();
    {
        const int lane = opaque_i(lane0), i = 8 * w + (lane >> 3), pc = lane & 7;
        *(LAS v4u*)(L + ML::O_VB + i * RV + 16 * pc) = R.v0; *(LAS v4u*)(L + ML::O_VB + i * RV + 128 + 16 * pc) = R.v1;
        if constexpr (GLA) {
            const int tk = lane >> 3;
            float q8[8], k8[8], e8[8];
#pragma unroll
            for (int e = 0; e < 8; ++e) { const float b = h2f(((const unsigned*)&R.bh)[e >> 1], e & 1), bl_ = h2f(((const unsigned*)&R.lh)[e >> 1], e & 1);
                const unsigned wq = WITH_O ? ((const unsigned*)&R.q)[e >> 1] : 0u, wk = ((const unsigned*)&R.k)[e >> 1];
                const float qv = (e & 1) ? bfhi(wq) : bflo(wq), kv = (e & 1) ? bfhi(wk) : bflo(wk);
                q8[e] = qv * __expf(b); k8[e] = kv * __expf(-b); e8[e] = kv * __expf(bl_ - b);
                if (!WITH_O) dsum[e] += bl_;
                if (w == 0 && tk == 0) ((LAS float*)(L + ML::O_DC))[8 * pc + e] = __expf(bl_); }
            v4u oq, ok, oe;
            oq.x = cvtpk_c(q8[0], q8[1]); oq.y = cvtpk_c(q8[2], q8[3]); oq.z = cvtpk_c(q8[4], q8[5]); oq.w = cvtpk_c(q8[6], q8[7]);
            ok.x = cvtpk_c(k8[0], k8[1]); ok.y = cvtpk_c(k8[2], k8[3]); ok.z = cvtpk_c(k8[4], k8[5]); ok.w = cvtpk_c(k8[6], k8[7]);
            oe.x = cvtpk_c(e8[0], e8[1]); oe.y = cvtpk_c(e8[2], e8[3]); oe.z = cvtpk_c(e8[4], e8[5]); oe.w = cvtpk_c(e8[6], e8[7]);
            if (WITH_O) { *(LAS v4u*)(L + ML::O_QD + i * RQ + 16 * pc) = oq; *(LAS v4u*)(L + ML::O_KI + i * RQ + 16 * pc) = ok; }
            *(LAS v4u*)(L + ML::O_KE + i * RQ + 16 * pc) = oe;
        } else {
            const float l2g = hh == 0 ? -0.045803689613124f : hh == 1 ? -0.022720076500083f : hh == 2 ? -0.011315313227834f : -0.005646563141142f;
            const float nq = dir ? (float)(64 - i) : (float)(i + 1), ne = dir ? (float)i : (float)(63 - i);
            const float eb = exp2f(l2g * nq), ei = exp2f(-l2g * nq), ee = exp2f(l2g * ne);
#pragma unroll
            for (int x = 0; x < 2; ++x) { v4u oq, ok, oe; const v4u rq = x ? R.q1 : R.q0, rk = x ? R.k1 : R.k0;
#pragma unroll
                for (int j = 0; j < 4; ++j) { const unsigned wq = WITH_O ? ((const unsigned*)&rq)[j] : 0u, wk = ((const unsigned*)&rk)[j];
                    ((unsigned*)&oq)[j] = cvtpk_c(bflo(wq) * eb, bfhi(wq) * eb); ((unsigned*)&ok)[j] = cvtpk_c(bflo(wk) * ei, bfhi(wk) * ei); ((unsigned*)&oe)[j] = cvtpk_c(bflo(wk) * ee, bfhi(wk) * ee); }
                if (WITH_O) { *(LAS v4u*)(L + ML::O_QD + i * RQ + 128 * x + 16 * pc) = oq; *(LAS v4u*)(L + ML::O_KI + i * RQ + 128 * x + 16 * pc) = ok; }
                *(LAS v4u*)(L + ML::O_KE + i * RQ + 128 * x + 16 * pc) = oe; }
            if (w == 0 && lane < 32) *(LAS f32x4*)(L + ML::O_DC + lane * 16) = (f32x4){exp2f(l2g * 64.0f), exp2f(l2g * 64.0f), exp2f(l2g * 64.0f), exp2f(l2g * 64.0f)};
        }
    }
    v4u gt0, gt1; f32x4 nw[4], nb[4];
    if (WITH_O) { const int lane = opaque_i(lane0);
        const bf16* gp = a.proj + (dir ? pg8::pl(GLA ? pg8::PL_GG : pg8::PL_RG, hh, (size_t)(row0 + 64 * c + 8 * w + (lane >> 3)), 128) + 16 * (lane & 7) : pg8::pl(GLA ? pg8::PL_GG : pg8::PL_RG, 0, (size_t)0, 128));
        gt0 = *(const GAS v4u*)gp; gt1 = *(const GAS v4u*)(gp + 8);
        const float* wp = GLA ? a.gnw + 16 * (lane & 7) : a.rnw + 128 * hh + 16 * (lane & 7);
#pragma unroll
        for (int k = 0; k < 4; ++k) { nw[k] = *(const GAS f32x4*)(wp + 4 * k); if (!GLA) nb[k] = *(const GAS f32x4*)(a.rnb + 128 * hh + 16 * (lane & 7) + 4 * k); } }
    raw_load<GLA, WITH_O>(R, a, s < 6 ? p : (pnext < 1536 ? pnext : p), s < 6 ? s + 2 : s - 6, w, lane0);
    __syncthreads();
    if (WITH_O) {
        const int lane = opaque_i(lane0), g = lane >> 4, lr = lane & 15;
        const int mi = w >> 1;
        bf16x8 kf[2][NS], qf2[NS];
#pragma unroll
        for (int s2 = 0; s2 < NS; ++s2) { qf2[s2] = *(const LAS bf16x8*)(L + ML::O_QD + (16 * mi + lr) * RQ + 64 * s2 + 16 * g);
#pragma unroll
            for (int jj = 0; jj < 2; ++jj) kf[jj][s2] = *(const LAS bf16x8*)(L + ML::O_KI + (16 * (2 * (w & 1) + jj) + lr) * RQ + 64 * s2 + 16 * g); }
        __builtin_amdgcn_sched_barrier(0);
#pragma unroll
        for (int jj = 0; jj < 2; ++jj) { const int nj = 2 * (w & 1) + jj;
            f32x4 acc = {0.f, 0.f, 0.f, 0.f};
#pragma unroll
            for (int s2 = 0; s2 < NS; ++s2) acc = __builtin_amdgcn_mfma_f32_16x16x32_bf16(kf[jj][s2], qf2[s2], acc, 0, 0, 0);
            const int ii = 16 * mi + lr;
#pragma unroll
            for (int r = 0; r < 4; ++r) { const int j = 16 * nj + 4 * g + r; const bool keep = dir ? (j > ii) : (j <= ii); acc[r] = keep ? acc[r] : 0.f; }
            u32x2 pk; pk.x = cvtpk_c(acc[0], acc[1]); pk.y = cvtpk_c(acc[2], acc[3]);
            *(LAS u32x2*)(L + ML::O_PB + ii * RP + 32 * nj + 8 * g) = pk; }
        __syncthreads();
    }
    f32x4 o[4];
    {
        const int lane = opaque_i(lane0), g = lane >> 4, lr = lane & 15, q4 = lr >> 2, p4 = lr & 3;
        const LAS unsigned char* vb = L + ML::O_VB + (8 * g + q4) * RV + 32 * w + 8 * p4;
        const bf16x8 vf0 = __builtin_shufflevector(TRRD(vb), TRRD(vb + 4 * RV), 0, 1, 2, 3, 4, 5, 6, 7), vf1 = __builtin_shufflevector(TRRD(vb + 32 * RV), TRRD(vb + 36 * RV), 0, 1, 2, 3, 4, 5, 6, 7);
        if (WITH_O) {
            { bf16x8 pf[4][2];
#pragma unroll
              for (int m = 0; m < 4; ++m) { pf[m][0] = *(const LAS bf16x8*)(L + ML::O_PB + (16 * m + lr) * RP + 16 * g); pf[m][1] = *(const LAS bf16x8*)(L + ML::O_PB + (16 * m + lr) * RP + 64 + 16 * g); }
              __builtin_amdgcn_sched_barrier(0);
#pragma unroll
              for (int m = 0; m < 4; ++m) { o[m] = __builtin_amdgcn_mfma_f32_16x16x32_bf16(pf[m][0], vf0, (f32x4){0.f, 0.f, 0.f, 0.f}, 0, 0, 0); o[m] = __builtin_amdgcn_mfma_f32_16x16x32_bf16(pf[m][1], vf1, o[m], 0, 0, 0); }
              __builtin_amdgcn_sched_barrier(0); }
#pragma unroll
            for (int sh = 0; sh < NS / 2; ++sh) {
                u32x2 ql[2][4][2];
#pragma unroll
                for (int x = 0; x < 2; ++x)
#pragma unroll
                    for (int m = 0; m < 4; ++m) { ql[x][m][0] = *(const LAS u32x2*)(L + ML::O_QD + (16 * m + lr) * RQ + 64 * (2 * sh + x) + 8 * g); ql[x][m][1] = *(const LAS u32x2*)(L + ML::O_QD + (16 * m + lr) * RQ + 64 * (2 * sh + x) + 32 + 8 * g); }
                __builtin_amdgcn_sched_barrier(0);
#pragma unroll
                for (int x = 0; x < 2; ++x) { const int s2 = 2 * sh + x;
                    const bf16x8 sf = __builtin_bit_cast(bf16x8, (v4u){cvtpk_c(S[2 * s2][0], S[2 * s2][1]), cvtpk_c(S[2 * s2][2], S[2 * s2][3]), cvtpk_c(S[2 * s2 + 1][0], S[2 * s2 + 1][1]), cvtpk_c(S[2 * s2 + 1][2], S[2 * s2 + 1][3])});
#pragma unroll
                    for (int m = 0; m < 4; ++m) o[m] = __builtin_amdgcn_mfma_f32_16x16x32_bf16(__builtin_bit_cast(bf16x8, (v4u){ql[x][m][0].x, ql[x][m][0].y, ql[x][m][1].x, ql[x][m][1].y}), sf, o[m], 0, 0, 0); }
                __builtin_amdgcn_sched_barrier(0);
            }
        }
#pragma unroll
        for (int th = 0; th < NT / 4; ++th) {
            f32x4 d4[4]; bf16x8 kf0[4], kf1[4];
#pragma unroll
            for (int x = 0; x < 4; ++x) { const int tt = 4 * th + x;
                d4[x] = *(const LAS f32x4*)(L + ML::O_DC + (16 * tt + 4 * g) * 4);
                const LAS unsigned char* kb = L + ML::O_KE + (8 * g + q4) * RQ + 32 * tt + 8 * p4;
                kf0[x] = __builtin_shufflevector(TRRD(kb), TRRD(kb + 4 * RQ), 0, 1, 2, 3, 4, 5, 6, 7); kf1[x] = __builtin_shufflevector(TRRD(kb + 32 * RQ), TRRD(kb + 36 * RQ), 0, 1, 2, 3, 4, 5, 6, 7); }
            __builtin_amdgcn_sched_barrier(0);
#pragma unroll
            for (int x = 0; x < 4; ++x) { const int tt = 4 * th + x;
                S[tt] = S[tt] * d4[x];
                S[tt] = __builtin_amdgcn_mfma_f32_16x16x32_bf16(kf0[x], vf0, S[tt], 0, 0, 0);
                S[tt] = __builtin_amdgcn_mfma_f32_16x16x32_bf16(kf1[x], vf1, S[tt], 0, 0, 0); }
            __builtin_amdgcn_sched_barrier(0);
        }
    }
    if (WITH_O) {
        const int lane = opaque_i(lane0), g = lane >> 4, lr = lane & 15;
        if (dir == 0) {
#pragma unroll
            for (int cc = 0; cc < 4; ++cc) if (cc == c) {
#pragma unroll
                for (int m = 0; m < 4; ++m) { ofp[cc][m].x = cvtpk_c(o[m][0], o[m][1]); ofp[cc][m].y = cvtpk_c(o[m][2], o[m][3]); } }
        } else {
            u32x2 ofr[4];
#pragma unroll
            for (int cc = 0; cc < 4; ++cc) if (cc == c) {
#pragma unroll
                for (int m = 0; m < 4; ++m) ofr[m] = ofp[cc][m]; }
            LAS float* ob = (LAS float*)(L + ML::O_OB);
#pragma unroll
            for (int m = 0; m < 4; ++m) { const f32x4 t = {o[m][0] + bflo(ofr[m].x), o[m][1] + bfhi(ofr[m].x), o[m][2] + bflo(ofr[m].y), o[m][3] + bfhi(ofr[m].y)};
#pragma unroll
                for (int r = 0; r < 4; ++r) ob[(16 * m + 4 * g + r) * OB_PITCH + 16 * w + lr] = t[r]; }
            __syncthreads();
            const int row = 8 * w + (lane >> 3), pc = lane & 7;
            f32x4 x[4];
#pragma unroll
            for (int k = 0; k < 4; ++k) x[k] = *(const LAS f32x4*)(ob + row * OB_PITCH + 16 * pc + 4 * k);
            float rs;
            if (GLA) { float ss = 0.f;
#pragma unroll
                for (int k = 0; k < 4; ++k) ss += (x[k][0] * x[k][0] + x[k][1] * x[k][1]) + (x[k][2] * x[k][2] + x[k][3] * x[k][3]);
                ss += __shfl_xor(ss, 1); ss += __shfl_xor(ss, 2); ss += __shfl_xor(ss, 4);
                rs = __builtin_amdgcn_rsqf(ss * (1.0f / 128.0f) + EPS); }
            else { float sm = 0.f;
#pragma unroll
                for (int k = 0; k < 4; ++k) sm += (x[k][0] + x[k][1]) + (x[k][2] + x[k][3]);
                sm += __shfl_xor(sm, 1); sm += __shfl_xor(sm, 2); sm += __shfl_xor(sm, 4);
                const float mu = sm * (1.0f / 128.0f); float ss = 0.f;
#pragma unroll
                for (int k = 0; k < 4; ++k) { x[k] = x[k] - mu; ss += (x[k][0] * x[k][0] + x[k][1] * x[k][1]) + (x[k][2] * x[k][2] + x[k][3] * x[k][3]); }
                ss += __shfl_xor(ss, 1); ss += __shfl_xor(ss, 2); ss += __shfl_xor(ss, 4);
                rs = __builtin_amdgcn_rsqf(ss * (1.0f / 128.0f) + EPS); }
            unsigned ow[8];
#pragma unroll
            for (int k = 0; k < 4; ++k) { f32x4 y = x[k] * rs * nw[k];
                if (!GLA) y = y + nb[k];
                const unsigned ga_ = k < 2 ? ((const unsigned*)&gt0)[2 * k] : ((const unsigned*)&gt1)[2 * k - 4], gb_ = k < 2 ? ((const unsigned*)&gt0)[2 * k + 1] : ((const unsigned*)&gt1)[2 * k - 3];
                const float g0 = bflo(ga_), g1 = bfhi(ga_), g2 = bflo(gb_), g3 = bfhi(gb_);
                y[0] *= g0 * __builtin_amdgcn_rcpf(1.0f + __expf(-g0)); y[1] *= g1 * __builtin_amdgcn_rcpf(1.0f + __expf(-g1));
                y[2] *= g2 * __builtin_amdgcn_rcpf(1.0f + __expf(-g2)); y[3] *= g3 * __builtin_amdgcn_rcpf(1.0f + __expf(-g3));
                ow[2 * k] = cvtpk_c(y[0], y[1]); ow[2 * k + 1] = cvtpk_c(y[2], y[3]); }
            bf16* op = a.mo + (size_t)(row0 + 64 * c + row) * a.mop + vcol + 16 * pc;
            *(GAS v4u*)op = (v4u){ow[0], ow[1], ow[2], ow[3]}; *(GAS v4u*)(op + 8) = (v4u){ow[4], ow[5], ow[6], ow[7]};
        }
    }
}


__device__ __forceinline__ void gla_b_stage(Frame& F, const CMixArgs& a, int p) {
    const int sc = p >> 2, hh = p & 3, w = F.wave;
    LAS float* gl = (LAS float*)F.lds;
    __syncthreads();
    { const int tid = opaque_i(F.tid);
#pragma unroll
      for (int x = 0; x < 4; ++x) *(LAS f32x4*)(gl + 4 * (tid + 512 * x)) = *(const GAS f32x4*)(a.ga + (size_t)sc * 256 * 32 + 4 * (tid + 512 * x)); }
    __syncthreads();
    const int t = opaque_i(F.lane), dir = w >> 2, c = w & 3;
    const float* wa = (dir ? a.wab : a.waf) + 64 * hh + t;
    float wv[16];
#pragma unroll
    for (int r = 0; r < 16; ++r) wv[r] = wa[r * 256];
    const float bias = (dir ? a.bab : a.baf)[64 * hh + t];
    bh16* bp = (dir ? a.bb1 : a.bb0) + ((size_t)(p * 4 + c) * 64) * 64;
    LAS float* tb = gl + 8192 + w * (16 * 68);
    float acc = 0.f;
#pragma unroll 1
    for (int k16 = 0; k16 < 64; k16 += 16) {
#pragma unroll 1
        for (int k4 = k16; k4 < k16 + 16; k4 += 4) {
            f32x4 gv[4][4];
#pragma unroll
            for (int j = 0; j < 4; ++j) { const int i = dir ? 63 - (k4 + j) : k4 + j; const LAS float* gr = gl + (64 * c + i) * 32 + 16 * dir;
#pragma unroll
                for (int x = 0; x < 4; ++x) gv[j][x] = *(const LAS f32x4*)(gr + 4 * x); }
            __builtin_amdgcn_sched_barrier(0);
#pragma unroll
            for (int j = 0; j < 4; ++j) {
                float z = bias;
#pragma unroll
                for (int r = 0; r < 16; ++r) z += gv[j][r >> 2][r & 3] * wv[r];
                const float ls = fminf(z, 0.f) - __logf(1.0f + __expf(-fabsf(z)));
                acc += fmaxf(ls * (1.0f / 16.0f), -1.0f);
                tb[(k4 - k16 + j) * 68 + t] = acc; }
        }
#pragma unroll
        for (int x = 0; x < 2; ++x) { const int kk = 8 * x + (t >> 3), i = dir ? 63 - (k16 + kk) : k16 + kk;
            const f32x4 lo = *(const LAS f32x4*)(tb + kk * 68 + 8 * (t & 7)), hi = *(const LAS f32x4*)(tb + kk * 68 + 8 * (t & 7) + 4);
            v4u o;
#pragma unroll
            for (int q = 0; q < 2; ++q) { ((unsigned*)&o)[q] = (unsigned)__builtin_bit_cast(unsigned short, (bh16)lo[2 * q]) | ((unsigned)__builtin_bit_cast(unsigned short, (bh16)lo[2 * q + 1]) << 16);
                ((unsigned*)&o)[2 + q] = (unsigned)__builtin_bit_cast(unsigned short, (bh16)hi[2 * q]) | ((unsigned)__builtin_bit_cast(unsigned short, (bh16)hi[2 * q + 1]) << 16); }
            *(GAS v4u*)(bp + i * 64 + 8 * (t & 7)) = o; }
    }
    LAS float* tot = gl + 8192 + 8 * (16 * 68);
    tot[w * 64 + t] = acc;
    __syncthreads();
    { float gsum = 0.f;
#pragma unroll
      for (int cc = 0; cc < 4; ++cc) { const float v = tot[(dir * 4 + cc) * 64 + t]; if (dir ? (cc <= c) : (cc >= c)) gsum += v; }
      a.gv[((size_t)(p * 2 + dir) * 4 + c) * 64 + t] = gsum;
      if (c == (dir ? 3 : 0)) a.dec[(size_t)((sc * 4 + hh) * 2 + dir) * 64 + t] = __expf(gsum); }
}

template <int DK, bool GLA, bool WITH_O>
__device__ __forceinline__ void mix_units(Frame& F, const CMixArgs& a) {
    typedef MixLds<DK, GLA, WITH_O> ML;
    constexpr int NT = DK / 16;
    const int w = F.wave, lane0 = F.lane;
    int p = (int)blockIdx.x;
    if (p >= 1536) return;
    RawSet<GLA> RA, RB;
    raw_load<GLA, WITH_O>(RA, a, p, 0, w, lane0); raw_load<GLA, WITH_O>(RB, a, p, 1, w, lane0);
    f32x4 S[NT]; float dsum[8]; u32x2 ofp[4][4];
#pragma unroll 1
    for (; p < 1536; p += F.G) {
        const int sc = p >> 2, hh = p & 3, pnext = p + F.G;
#pragma unroll 1
        for (int dir = 0; dir < 2; ++dir) {
            const int lane = opaque_i(lane0);
            unsigned char* sp = a.st + state_off(sc, GLA, hh, dir) + (size_t)(unsigned)(w * NT * 512 + lane * 8);
            if (WITH_O) {
#pragma unroll
                for (int tt = 0; tt < NT; ++tt) { const u32x2 pk = *(const GAS u32x2*)(sp + tt * 512); S[tt] = (f32x4){bflo(pk.x), bfhi(pk.x), bflo(pk.y), bfhi(pk.y)}; } }
            else {
#pragma unroll
                for (int tt = 0; tt < NT; ++tt) S[tt] = (f32x4){0.f, 0.f, 0.f, 0.f};
#pragma unroll
                for (int e = 0; e < 8; ++e) dsum[e] = 0.f; }
#pragma unroll 1
            for (int h2 = 0; h2 < 2; ++h2) {
                mix_step<DK, GLA, WITH_O>(F, a, p, 4 * dir + 2 * h2, pnext, RA, S, dsum, ofp);
                mix_step<DK, GLA, WITH_O>(F, a, p, 4 * dir + 2 * h2 + 1, pnext, RB, S, dsum, ofp);
            }
            if (!WITH_O) {
#pragma unroll
                for (int tt = 0; tt < NT; ++tt) { u32x2 pk; pk.x = cvtpk_c(S[tt][0], S[tt][1]); pk.y = cvtpk_c(S[tt][2], S[tt][3]); *(GAS u32x2*)(sp + tt * 512) = pk; }
                if (GLA && w == 0 && lane < 8) { float* dp = a.dec + (size_t)((sc * 4 + hh) * 2 + dir) * 64 + 8 * lane;
#pragma unroll
                    for (int e = 0; e < 8; ++e) dp[e] = __expf(dsum[e]); }
            }
        }
    }
}

template <bool GLA> struct KvRaw;
template <> struct KvRaw<true> { v4u k, v0, v1, bfh, bbh; f32x4 gf0, gf1, gb0, gb1; };
template <> struct KvRaw<false> { v4u k0, k1, v0, v1; };
template <bool GLA>
__device__ __forceinline__ void kv_load(KvRaw<GLA>& R, const CMixArgs& a, int p, int c, int w, int lane0) {
    const int lane = opaque_i(lane0), sc = p >> 2, hh = p & 3, pc = lane & 7, ti = 8 * w + (lane >> 3);
    const size_t row = (size_t)(sc * 256 + 64 * c + ti);
    if constexpr (GLA) {
        R.k = *(const GAS v4u*)(a.proj + pg8::pl(pg8::PL_GK, hh, row, 64) + 8 * pc);
        const bf16* pv = a.proj + pg8::pl(pg8::PL_GV, hh, row, 128) + 8 * pc; R.v0 = *(const GAS v4u*)pv; R.v1 = *(const GAS v4u*)(pv + 64);
        R.bfh = *(const GAS v4u*)(a.bb0 + ((size_t)(p * 4 + c) * 64 + ti) * 64 + 8 * pc); R.bbh = *(const GAS v4u*)(a.bb1 + ((size_t)(p * 4 + c) * 64 + ti) * 64 + 8 * pc);
        const float* g0 = a.gv + ((size_t)(p * 2 + 0) * 4 + c) * 64 + 8 * pc; const float* g1 = a.gv + ((size_t)(p * 2 + 1) * 4 + c) * 64 + 8 * pc;
        R.gf0 = *(const GAS f32x4*)g0; R.gf1 = *(const GAS f32x4*)(g0 + 4); R.gb0 = *(const GAS f32x4*)g1; R.gb1 = *(const GAS f32x4*)(g1 + 4);
    } else {
        const bf16* pk = a.proj + pg8::pl(pg8::PL_RK, hh, row, 128) + 8 * pc; R.k0 = *(const GAS v4u*)pk; R.k1 = *(const GAS v4u*)(pk + 64);
        const bf16* pv = a.proj + pg8::pl(pg8::PL_RV, hh, row, 128) + 8 * pc; R.v0 = *(const GAS v4u*)pv; R.v1 = *(const GAS v4u*)(pv + 64);
    }
}
template <int DK, bool GLA>
__device__ __forceinline__ void kv_step(Frame& F, const CMixArgs& a, int p, int c, int pnext, KvRaw<GLA>& R, f32x4 (&Sf)[DK / 16], f32x4 (&Sb)[DK / 16]) {
    constexpr int NT = DK / 16, RQ = DK * 2 + 16, RV = 272, O_KF = 0, O_KB = 64 * RQ, O_VB = 2 * 64 * RQ;
    LAS unsigned char* L = F.lds;
    const int lane0 = F.lane, w = F.wave, hh = p & 3;
    __syncthreads();
    { const int lane = opaque_i(lane0), i = 8 * w + (lane >> 3), pc = lane & 7;
      *(LAS v4u*)(L + O_VB + i * RV + 16 * pc) = R.v0; *(LAS v4u*)(L + O_VB + i * RV + 128 + 16 * pc) = R.v1;
      if constexpr (GLA) {
          float f8[8], b8[8];
#pragma unroll
          for (int e = 0; e < 8; ++e) { const unsigned wk = ((const unsigned*)&R.k)[e >> 1]; const float kv = (e & 1) ? bfhi(wk) : bflo(wk);
              const float xf = (e < 4 ? R.gf0[e & 3] : R.gf1[e & 3]) - h2f(((const unsigned*)&R.bfh)[e >> 1], e & 1), xb = (e < 4 ? R.gb0[e & 3] : R.gb1[e & 3]) - h2f(((const unsigned*)&R.bbh)[e >> 1], e & 1);
              f8[e] = kv * __expf(xf); b8[e] = kv * __expf(xb); }
          *(LAS v4u*)(L + O_KF + i * RQ + 16 * pc) = (v4u){cvtpk_c(f8[0], f8[1]), cvtpk_c(f8[2], f8[3]), cvtpk_c(f8[4], f8[5]), cvtpk_c(f8[6], f8[7])};
          *(LAS v4u*)(L + O_KB + i * RQ + 16 * pc) = (v4u){cvtpk_c(b8[0], b8[1]), cvtpk_c(b8[2], b8[3]), cvtpk_c(b8[4], b8[5]), cvtpk_c(b8[6], b8[7])};
      } else {
          const float l2g = hh == 0 ? -0.045803689613124f : hh == 1 ? -0.022720076500083f : hh == 2 ? -0.011315313227834f : -0.005646563141142f;
          const float j = (float)(64 * c + i), ef = __builtin_amdgcn_exp2f(l2g * (255.0f - j)), eb = __builtin_amdgcn_exp2f(l2g * j);
#pragma unroll
          for (int x = 0; x < 2; ++x) { const v4u rk = x ? R.k1 : R.k0; v4u of, ob;
#pragma unroll
              for (int q = 0; q < 4; ++q) { const unsigned wk = ((const unsigned*)&rk)[q]; ((unsigned*)&of)[q] = cvtpk_c(bflo(wk) * ef, bfhi(wk) * ef); ((unsigned*)&ob)[q] = cvtpk_c(bflo(wk) * eb, bfhi(wk) * eb); }
              *(LAS v4u*)(L + O_KF + i * RQ + 128 * x + 16 * pc) = of; *(LAS v4u*)(L + O_KB + i * RQ + 128 * x + 16 * pc) = ob; }
      } }
    kv_load<GLA>(R, a, c < 2 ? p : (pnext < 1536 ? pnext : p), (c + 2) & 3, w, lane0);
    __syncthreads();
    { const int lane = opaque_i(lane0), g = lane >> 4, lr = lane & 15, q4 = lr >> 2, p4 = lr & 3;
      const LAS unsigned char* vb = L + O_VB + (8 * g + q4) * RV + 32 * w + 8 * p4;
      const bf16x8 vf0 = __builtin_shufflevector(TRRD(vb), TRRD(vb + 4 * RV), 0, 1, 2, 3, 4, 5, 6, 7), vf1 = __builtin_shufflevector(TRRD(vb + 32 * RV), TRRD(vb + 36 * RV), 0, 1, 2, 3, 4, 5, 6, 7);
#pragma unroll
      for (int th = 0; th < NT / 4; ++th) {
          bf16x8 kf0[4], kf1[4], kb0[4], kb1[4];
#pragma unroll
          for (int x = 0; x < 4; ++x) { const int tt = 4 * th + x;
              const LAS unsigned char* ka = L + O_KF + (8 * g + q4) * RQ + 32 * tt + 8 * p4; const LAS unsigned char* kb = L + O_KB + (8 * g + q4) * RQ + 32 * tt + 8 * p4;
              kf0[x] = __builtin_shufflevector(TRRD(ka), TRRD(ka + 4 * RQ), 0, 1, 2, 3, 4, 5, 6, 7); kf1[x] = __builtin_shufflevector(TRRD(ka + 32 * RQ), TRRD(ka + 36 * RQ), 0, 1, 2, 3, 4, 5, 6, 7);
              kb0[x] = __builtin_shufflevector(TRRD(kb), TRRD(kb + 4 * RQ), 0, 1, 2, 3, 4, 5, 6, 7); kb1[x] = __builtin_shufflevector(TRRD(kb + 32 * RQ), TRRD(kb + 36 * RQ), 0, 1, 2, 3, 4, 5, 6, 7); }
          __builtin_amdgcn_sched_barrier(0);
#pragma unroll
          for (int x = 0; x < 4; ++x) { const int tt = 4 * th + x;
              Sf[tt] = __builtin_amdgcn_mfma_f32_16x16x32_bf16(kf0[x], vf0, Sf[tt], 0, 0, 0); Sf[tt] = __builtin_amdgcn_mfma_f32_16x16x32_bf16(kf1[x], vf1, Sf[tt], 0, 0, 0);
              Sb[tt] = __builtin_amdgcn_mfma_f32_16x16x32_bf16(kb0[x], vf0, Sb[tt], 0, 0, 0); Sb[tt] = __builtin_amdgcn_mfma_f32_16x16x32_bf16(kb1[x], vf1, Sb[tt], 0, 0, 0); }
          __builtin_amdgcn_sched_barrier(0);
      } }
}
template <int DK, bool GLA>
__device__ __forceinline__ void kv_units(Frame& F, const CMixArgs& a) {
    constexpr int NT = DK / 16;
    const int w = F.wave, lane0 = F.lane;
    int p = (int)blockIdx.x;
    if (p >= 1536) return;
    if (GLA) {
#pragma unroll 1
        for (int pp = p; pp < 1536; pp += F.G) gla_b_stage(F, a, pp);
        asm volatile("s_waitcnt vmcnt(0)" ::: "memory"); __syncthreads(); }
    KvRaw<GLA> RA, RB;
    kv_load<GLA>(RA, a, p, 0, w, lane0); kv_load<GLA>(RB, a, p, 1, w, lane0);
#pragma unroll 1
    for (; p < 1536; p += F.G) {
        const int sc = p >> 2, hh = p & 3, pnext = p + F.G;
        f32x4 Sf[NT], Sb[NT];
#pragma unroll
        for (int tt = 0; tt < NT; ++tt) { Sf[tt] = (f32x4){0.f, 0.f, 0.f, 0.f}; Sb[tt] = (f32x4){0.f, 0.f, 0.f, 0.f}; }
        kv_step<DK, GLA>(F, a, p, 0, pnext, RA, Sf, Sb); kv_step<DK, GLA>(F, a, p, 1, pnext, RB, Sf, Sb);
        kv_step<DK, GLA>(F, a, p, 2, pnext, RA, Sf, Sb); kv_step<DK, GLA>(F, a, p, 3, pnext, RB, Sf, Sb);
        const int lane = opaque_i(lane0);
#pragma unroll
        for (int dir = 0; dir < 2; ++dir) { unsigned char* sp = a.st + state_off(sc, GLA, hh, dir) + (size_t)(unsigned)(w * NT * 512 + lane * 8);
#pragma unroll
            for (int tt = 0; tt < NT; ++tt) { const f32x4 s = dir ? Sb[tt] : Sf[tt]; u32x2 pk; pk.x = cvtpk_c(s[0], s[1]); pk.y = cvtpk_c(s[2], s[3]); *(GAS u32x2*)(sp + tt * 512) = pk; } }
    }
}

constexpr int RD_SLOT = 32768;
__device__ __forceinline__ void ret_dma_block(Frame& F, const CMixArgs& a, int p, int kb, int slot) {
    const int lane = opaque_i(F.lane), w = F.wave, sc = p >> 2, hh = p & 3;
#pragma unroll
    for (int x = 0; x < 2; ++x) {
        const int r = 4 * (2 * w + x) + (lane >> 4), cp = lane & 15;
        const size_t row = (size_t)(sc * 256 + 64 * kb + r);
        const bf16* gk = a.proj + pg8::pl(pg8::PL_RK, hh, row, 128) + 8 * (cp ^ (r & 15));
        const bf16* gv = a.proj + pg8::pl(pg8::PL_RV, hh, row, 128) + 8 * (cp ^ (2 * (r & 7)));
        __builtin_amdgcn_global_load_lds((const unsigned*)gk, (LAS unsigned*)(F.lds + slot * RD_SLOT + (2 * w + x) * 1024), 16, 0, 0);
        __builtin_amdgcn_global_load_lds((const unsigned*)gv, (LAS unsigned*)(F.lds + slot * RD_SLOT + 16384 + (2 * w + x) * 1024), 16, 0, 0);
    }
}
__device__ __forceinline__ void tr_read16(const unsigned (&ad)[8], u32x2 (&r)[16]) {
    asm volatile("ds_read_b64_tr_b16 %0, %16\n\tds_read_b64_tr_b16 %1, %16 offset:4096\n\tds_read_b64_tr_b16 %2, %17\n\tds_read_b64_tr_b16 %3, %17 offset:4096\n\t"
                 "ds_read_b64_tr_b16 %4, %18\n\tds_read_b64_tr_b16 %5, %18 offset:4096\n\tds_read_b64_tr_b16 %6, %19\n\tds_read_b64_tr_b16 %7, %19 offset:4096\n\t"
                 "ds_read_b64_tr_b16 %8, %20\n\tds_read_b64_tr_b16 %9, %20 offset:4096\n\tds_read_b64_tr_b16 %10, %21\n\tds_read_b64_tr_b16 %11, %21 offset:4096\n\t"
                 "ds_read_b64_tr_b16 %12, %22\n\tds_read_b64_tr_b16 %13, %22 offset:4096\n\tds_read_b64_tr_b16 %14, %23\n\tds_read_b64_tr_b16 %15, %23 offset:4096\n\t"
                 "s_waitcnt lgkmcnt(0)"
                 : "=&v"(r[0]), "=&v"(r[1]), "=&v"(r[2]), "=&v"(r[3]), "=&v"(r[4]), "=&v"(r[5]), "=&v"(r[6]), "=&v"(r[7]),
                   "=&v"(r[8]), "=&v"(r[9]), "=&v"(r[10]), "=&v"(r[11]), "=&v"(r[12]), "=&v"(r[13]), "=&v"(r[14]), "=&v"(r[15])
                 : "v"(ad[0]), "v"(ad[1]), "v"(ad[2]), "v"(ad[3]), "v"(ad[4]), "v"(ad[5]), "v"(ad[6]), "v"(ad[7]) : "memory");
}
__device__ __forceinline__ void ret_block(Frame& F, const CMixArgs& a, int p, int kb, int slot, int pnext, const bf16x8 (&Qf)[2][4], f32x4 (&O)[8][2]) {
    LAS unsigned char* L = F.lds;
    const int w = F.wave, hh = p & 3;
    const float l2g = hh == 0 ? -0.045803689613124f : hh == 1 ? -0.022720076500083f : hh == 2 ? -0.011315313227834f : -0.005646563141142f;
    asm volatile("s_waitcnt vmcnt(4)" ::: "memory");
    __builtin_amdgcn_s_barrier();
    asm volatile("" ::: "memory");
    { const int kn = kb + 2, pn2 = kn < 4 ? p : (pnext < 1536 ? pnext : p); ret_dma_block(F, a, pn2, kn & 3, slot == 0 ? 2 : slot - 1); }
    LAS unsigned char* KB = L + slot * RD_SLOT; LAS unsigned char* VB = KB + 16384;
    const int lane = opaque_i(F.lane), g = lane >> 4, lr = lane & 15, q4 = lr >> 2, p4 = lr & 3;
    const int xk16 = (lr ^ (g >> 1)) << 4, xv16 = ((p4 >> 1) ^ (2 * ((4 * g + q4) & 7))) << 4;
#pragma unroll
    for (int sp = 0; sp < 2; ++sp) {
        f32x4 st[2][2];
#pragma unroll
        for (int h = 0; h < 2; ++h)
#pragma unroll
            for (int it = 0; it < 2; ++it) st[h][it] = (f32x4){0.f, 0.f, 0.f, 0.f};
        { bf16x8 kf[2][4];
#pragma unroll
          for (int s = 0; s < 4; ++s)
#pragma unroll
              for (int h = 0; h < 2; ++h) {
                  const LAS unsigned char* kp = KB + (32 * sp + 16 * h + lr) * 256 + 8 * (g & 1);
                  const u32x2 lo = *(const LAS u32x2*)(kp + ((64 * s) ^ xk16)), hi = *(const LAS u32x2*)(kp + ((64 * s + 32) ^ xk16));
                  kf[h][s] = __builtin_bit_cast(bf16x8, (v4u){lo.x, lo.y, hi.x, hi.y}); }
          __builtin_amdgcn_sched_barrier(0);
#pragma unroll
          for (int s = 0; s < 4; ++s)
#pragma unroll
              for (int h = 0; h < 2; ++h)
#pragma unroll
                  for (int it = 0; it < 2; ++it) st[h][it] = __builtin_amdgcn_mfma_f32_16x16x32_bf16(kf[h][s], Qf[it][s], st[h][it], 0, 0, 0);
          __builtin_amdgcn_sched_barrier(0); }
        bf16x8 pf[2];
#pragma unroll
        for (int it = 0; it < 2; ++it) {
            const int i = 32 * w + 16 * it + lr;
            unsigned pw[4];
#pragma unroll
            for (int h = 0; h < 2; ++h) { float e[4];
#pragma unroll
                for (int r = 0; r < 4; ++r) { const int j = 64 * kb + 32 * sp + 16 * h + 4 * g + r; const int d = i - j; e[r] = st[h][it][r] * __builtin_amdgcn_exp2f(l2g * (float)(d < 0 ? -d : d)); }
                pw[2 * h] = cvtpk_c(e[0], e[1]); pw[2 * h + 1] = cvtpk_c(e[2], e[3]); }
            pf[it] = __builtin_bit_cast(bf16x8, (v4u){pw[0], pw[1], pw[2], pw[3]});
        }
        { unsigned ad[8]; u32x2 vr[16];
          const unsigned vb0 = (unsigned)(size_t)(VB + (32 * sp + 4 * g + q4) * 256 + 8 * (p4 & 1));
#pragma unroll
          for (int dt = 0; dt < 8; ++dt) ad[dt] = vb0 + ((32 * dt) ^ xv16);
          tr_read16(ad, vr);
          __builtin_amdgcn_sched_barrier(0);
#pragma unroll
          for (int dt = 0; dt < 8; ++dt) { const bf16x8 vf = __builtin_bit_cast(bf16x8, (v4u){vr[2 * dt].x, vr[2 * dt].y, vr[2 * dt + 1].x, vr[2 * dt + 1].y});
#pragma unroll
              for (int it = 0; it < 2; ++it) O[dt][it] = __builtin_amdgcn_mfma_f32_16x16x32_bf16(vf, pf[it], O[dt][it], 0, 0, 0); }
          __builtin_amdgcn_sched_barrier(0); }
    }
}
__device__ __forceinline__ void ret_q_load(bf16x8 (&Qf)[2][4], const CMixArgs& a, int p, int w, int lane0) {
    const int lane = opaque_i(lane0), g = lane >> 4, lr = lane & 15, sc = p >> 2, hh = p & 3;
#pragma unroll
    for (int it = 0; it < 2; ++it) { const bf16* qp = a.proj + pg8::pl(pg8::PL_RQ, hh, (size_t)(sc * 256 + 32 * w + 16 * it + lr), 128) + 4 * g;
#pragma unroll
        for (int s = 0; s < 4; ++s) { const u32x2 lo = *(const GAS u32x2*)(qp + 32 * s), hi = *(const GAS u32x2*)(qp + 32 * s + 16); Qf[it][s] = __builtin_bit_cast(bf16x8, (v4u){lo.x, lo.y, hi.x, hi.y}); } }
}
__device__ __forceinline__ void ret_units_direct(Frame& F, const CMixArgs& a) {
    const int w = F.wave;
    int p = (int)blockIdx.x;
    if (p >= 1536) return;
    bf16x8 Qf[2][4];
    asm volatile("s_waitcnt vmcnt(0)" ::: "memory"); __syncthreads();
    ret_dma_block(F, a, p, 0, 0); ret_dma_block(F, a, p, 1, 1);
    int slot = 0;
    ret_q_load(Qf, a, p, w, F.lane);
#pragma unroll 1
    for (; p < 1536; p += F.G) {
        const int sc = p >> 2, hh = p & 3, pnext = p + F.G;
        const float l2g = hh == 0 ? -0.045803689613124f : hh == 1 ? -0.022720076500083f : hh == 2 ? -0.011315313227834f : -0.005646563141142f;
        f32x4 O[8][2];
#pragma unroll
        for (int dt = 0; dt < 8; ++dt)
#pragma unroll
            for (int it = 0; it < 2; ++it) O[dt][it] = (f32x4){0.f, 0.f, 0.f, 0.f};
#pragma unroll 1
        for (int kb = 0; kb < 4; ++kb) { ret_block(F, a, p, kb, slot, pnext, Qf, O); slot = slot == 2 ? 0 : slot + 1; }
        { const int lane = opaque_i(F.lane), lr = lane & 15;
          const unsigned char* sp0 = a.st + state_off(sc, false, hh, 0) + (size_t)(unsigned)(lane * 8);
          u32x2 cA[16], cB[16];
#define RD_CLOAD(dst, k_) do { const unsigned char* b_ = sp0 + ((k_) >> 2) * 32768 + 2 * ((k_) & 3) * 512; \
              _Pragma("unroll") for (int dt = 0; dt < 8; ++dt) { dst[2 * dt] = *(const GAS u32x2*)(b_ + dt * 4096); dst[2 * dt + 1] = *(const GAS u32x2*)(b_ + dt * 4096 + 512); } } while (0)
#define RD_CMMA(src, k_) do { const int dir_ = (k_) >> 2, s_ = (k_) & 3; bf16x8 qs[2]; \
              _Pragma("unroll") for (int it = 0; it < 2; ++it) { const int i = 32 * w + 16 * it + lr; const float f = __builtin_amdgcn_exp2f(l2g * (float)(dir_ ? 256 - i : i + 1)); \
                  const v4u qw = __builtin_bit_cast(v4u, Qf[it][s_]); v4u o_; \
                  _Pragma("unroll") for (int j = 0; j < 4; ++j) ((unsigned*)&o_)[j] = cvtpk_c(bflo(((const unsigned*)&qw)[j]) * f, bfhi(((const unsigned*)&qw)[j]) * f); \
                  qs[it] = __builtin_bit_cast(bf16x8, o_); } \
              _Pragma("unroll") for (int dt = 0; dt < 8; ++dt) { const bf16x8 cf = __builtin_bit_cast(bf16x8, (v4u){src[2 * dt].x, src[2 * dt].y, src[2 * dt + 1].x, src[2 * dt + 1].y}); \
                  _Pragma("unroll") for (int it = 0; it < 2; ++it) O[dt][it] = __builtin_amdgcn_mfma_f32_16x16x32_bf16(cf, qs[it], O[dt][it], 0, 0, 0); } } while (0)
          RD_CLOAD(cA, 0); RD_CLOAD(cB, 1);
          __builtin_amdgcn_sched_barrier(0);
#pragma unroll
          for (int k = 0; k < 8; k += 2) {
              RD_CMMA(cA, k); if (k + 2 < 8) RD_CLOAD(cA, k + 2);
              __builtin_amdgcn_sched_barrier(0);
              RD_CMMA(cB, k + 1); if (k + 3 < 8) RD_CLOAD(cB, k + 3);
              __builtin_amdgcn_sched_barrier(0);
          }
#undef RD_CLOAD
#undef RD_CMMA
        }
        ret_q_load(Qf, a, pnext < 1536 ? pnext : p, w, F.lane);
        { const int lane = opaque_i(F.lane), g = lane >> 4, lr = lane & 15;
          LAS unsigned char* T = F.lds + 3 * RD_SLOT + w * (16 * 272);
          f32x4 nw[4], nb[4];
#pragma unroll
          for (int k = 0; k < 4; ++k) { nw[k] = *(const GAS f32x4*)(a.rnw + 128 * hh + 16 * (lane & 7) + 4 * k); nb[k] = *(const GAS f32x4*)(a.rnb + 128 * hh + 16 * (lane & 7) + 4 * k); }
#pragma unroll
          for (int it = 0; it < 2; ++it) {
              v4u gt[2][2];
#pragma unroll
              for (int h = 0; h < 2; ++h) { const bf16* gp = a.proj + pg8::pl(pg8::PL_RG, hh, (size_t)(sc * 256 + 32 * w + 16 * it + 8 * h + (lane >> 3)), 128) + 16 * (lane & 7);
                  gt[h][0] = *(const GAS v4u*)gp; gt[h][1] = *(const GAS v4u*)(gp + 8); }
              float sm = 0.f;
#pragma unroll
              for (int dt = 0; dt < 8; ++dt) sm += (O[dt][it][0] + O[dt][it][1]) + (O[dt][it][2] + O[dt][it][3]);
              sm += __shfl_xor(sm, 16); sm += __shfl_xor(sm, 32);
              const float mu = sm * (1.0f / 128.0f); float ss = 0.f;
#pragma unroll
              for (int dt = 0; dt < 8; ++dt) { O[dt][it] = O[dt][it] - mu; ss += (O[dt][it][0] * O[dt][it][0] + O[dt][it][1] * O[dt][it][1]) + (O[dt][it][2] * O[dt][it][2] + O[dt][it][3] * O[dt][it][3]); }
              ss += __shfl_xor(ss, 16); ss += __shfl_xor(ss, 32);
              const float rs = __builtin_amdgcn_rsqf(ss * (1.0f / 128.0f) + EPS);
#pragma unroll
              for (int dt = 0; dt < 8; ++dt) { const f32x4 y = O[dt][it] * rs;
                  u32x2 pk; pk.x = cvtpk_c(y[0], y[1]); pk.y = cvtpk_c(y[2], y[3]);
                  *(LAS u32x2*)(T + lr * 272 + 32 * dt + 8 * g) = pk; }
              asm volatile("s_waitcnt lgkmcnt(0)" ::: "memory");
#pragma unroll
              for (int h = 0; h < 2; ++h) { const int rr = 8 * h + (lane >> 3);
                  const v4u y0 = *(const LAS v4u*)(T + rr * 272 + 32 * (lane & 7)), y1 = *(const LAS v4u*)(T + rr * 272 + 32 * (lane & 7) + 16);
                  unsigned ow[8];
#pragma unroll
                  for (int k = 0; k < 8; ++k) { const unsigned yw = k < 4 ? ((const unsigned*)&y0)[k] : ((const unsigned*)&y1)[k - 4], gw = k < 4 ? ((const unsigned*)&gt[h][0])[k] : ((const unsigned*)&gt[h][1])[k - 4];
                      const float g0 = bflo(gw), g1 = bfhi(gw);
                      ow[k] = cvtpk_c((bflo(yw) * nw[k >> 1][2 * (k & 1)] + nb[k >> 1][2 * (k & 1)]) * g0 * __builtin_amdgcn_rcpf(1.0f + __expf(-g0)), (bfhi(yw) * nw[k >> 1][2 * (k & 1) + 1] + nb[k >> 1][2 * (k & 1) + 1]) * g1 * __builtin_amdgcn_rcpf(1.0f + __expf(-g1))); }
                  bf16* op = a.mo + (size_t)(sc * 256 + 32 * w + 16 * it + rr) * a.mop + 512 + 128 * hh + 16 * (lane & 7);
                  *(GAS v4u*)op = (v4u){ow[0], ow[1], ow[2], ow[3]}; *(GAS v4u*)(op + 8) = (v4u){ow[4], ow[5], ow[6], ow[7]}; }
              asm volatile("s_waitcnt lgkmcnt(0)" ::: "memory");
          } }
    }
    asm volatile("s_waitcnt vmcnt(0)" ::: "memory"); __syncthreads();
}

template <bool WITH_O>
__device__ __forceinline__ void cmix_phase(Frame& F, const CMixArgs& a, int which = 3) {
#if MIX_GLA
    if (which & 1) { if constexpr (WITH_O) mix_units<64, true, true>(F, a); else kv_units<64, true>(F, a);
    __syncthreads(); }
#endif
#if MIX_RET
    if (which & 2) { if constexpr (WITH_O) ret_units_direct(F, a); else kv_units<128, false>(F, a);
    __syncthreads(); }
#endif
}
__device__ __forceinline__ void scan_phase(Frame& F, const CMixArgs& a) {
    const int nthreads = F.G * NWAVES * 64;
    for (int chain = (int)blockIdx.x * NWAVES * 64 + F.tid; chain < 34 * 49152; chain += nthreads) {
        const int sq = chain / 49152, cidx = chain % 49152;
        const int seq = sq < 2 ? 32 + sq : sq - 2;
        const int sc0 = seq < 32 ? seq * 8 : 256 + (seq - 32) * 64, ns = seq < 32 ? 8 : 64;
        const bool gla = cidx < 16384; const int c2 = gla ? cidx : cidx - 16384;
        const int hd = gla ? (c2 >> 11) : (c2 >> 12), v = gla ? (c2 & 2047) : (c2 & 4095), hh = hd >> 1, dir = hd & 1;
        if ((gla && !MIX_GLA) || (!gla && !MIX_RET)) continue;
        const int t0 = 16 * ((v >> 6) & 3) + 4 * ((v & 63) >> 4);
        const float gret = exp2f(256.0f * log2f(1.0f - exp2f(-5.0f - (float)hh)));
        f32x4 cst = {0.f, 0.f, 0.f, 0.f};
        for (int blk = 0; blk < ns; blk += 8) {
            u32x2 kv[8]; f32x4 d[8];
#pragma unroll
            for (int j = 0; j < 8; ++j) { const int n = dir ? ns - 1 - (blk + j) : blk + j;
                kv[j] = *(const GAS u32x2*)(a.st + state_off(sc0 + n, gla, hh, dir) + (size_t)v * 8);
                d[j] = gla ? *(const GAS f32x4*)(a.dec + (size_t)(((sc0 + n) * 4 + hh) * 2 + dir) * 64 + t0) : (f32x4){gret, gret, gret, gret}; }
#pragma unroll
            for (int j = 0; j < 8; ++j) { const int n = dir ? ns - 1 - (blk + j) : blk + j;
                u32x2 pk; pk.x = cvtpk_c(cst[0], cst[1]); pk.y = cvtpk_c(cst[2], cst[3]);
                *(GAS u32x2*)(a.sto + state_off(sc0 + n, gla, hh, dir) + (size_t)v * 8) = pk;
                cst = d[j] * cst + (f32x4){bflo(kv[j].x), bfhi(kv[j].x), bflo(kv[j].y), bfhi(kv[j].y)}; }
        }
    }
}

#ifndef W2_TILED
#define W2_TILED 1
#endif
#define NAIVE_MIX (!(MIX_GLA && MIX_RET))
constexpr int PB0 = NAIVE_MIX ? 8 : 5, NPH = PB0 + 4;
struct Args { const float* in[16]; float* out; unsigned char* ws; int ph_lo, ph_hi, use_bar, pad; };
__global__ void __launch_bounds__(NWAVES * 64, 2) fwd_kernel(Args args) {
    extern __shared__ __attribute__((aligned(16))) unsigned char lds[];
    Frame F;
    F.lds = (LAS unsigned char*)lds;
    F.MISC = (volatile LAS unsigned*)(F.lds + MISC_OFF);
    F.tid = threadIdx.x; F.lane = F.tid & 63; F.wave = __builtin_amdgcn_readfirstlane(F.tid >> 6);
    F.G = gridDim.x; { const int bx = blockIdx.x; F.vcu = (F.G % 8 == 0) ? (bx % 8) * (F.G / 8) + bx / 8 : bx; }
    unsigned char* ws = args.ws;
    gu32* ctl = (gu32*)(ws + WS_CTL);
    for (int u = F.tid; u < (LDS_BYTES - LDSCTL_OFF) / 4; u += NWAVES * 64) ((LAS unsigned*)(F.lds + LDSCTL_OFF))[u] = 0u;
    __syncthreads();
    XcdBarrier bar; bar.bar = (unsigned*)(ctl + CW_BAR); bar.x = 0; bar.st = nullptr;
    if (args.use_bar) bar = xcd_barrier_post((unsigned*)(ctl + CW_BAR), F.MISC + 8);
    const int lo = args.ph_lo, hi = args.ph_hi;
#define IN(k) (lo <= (k) && (k) < hi)
#define SEAM(k) do { if (IN(k) && IN((k) + 1)) xcd_barrier(bar); } while (0)
    if (IN(0)) { const P0Args pa{args.in[0], args.in[1], args.in[2], args.in[3], args.in[11], args.in[12], args.in[13], args.in[14], (bf16*)(ws + WS_WIN), (bf16*)(ws + WS_WOUT), (bf16*)(ws + WS_W1), (bf16*)(ws + WS_W2),
            (bf16*)(ws + WS_R0), (float*)(ws + WS_ROPE), (float*)(ws + WS_ROPE) + 16384 * 64, (float*)(ws + WS_GA), (float*)(ws + WS_RSTD)};
        p0_prologue(F, pa); __syncthreads();
#if REP0
        p0_prologue(F, pa, REP0); __syncthreads();
#endif
    }
    SEAM(0);
    if (IN(1)) { pg8::Gemm g{(bf16*)(ws + WS_R0), (bf16*)(ws + WS_WIN), M_TOK, NP, D, D}; pg8::StaticOrder S; S.init(M_TOK, NP, F.G, (int)blockIdx.x);
        pg8::EpiInProj E{(bf16*)(ws + WS_R1), (float*)(ws + WS_RSTD), (float*)(ws + WS_ROPE), (float*)(ws + WS_ROPE) + 16384 * 64};
#if REP1 == 2
        { pg8::EpiPlain E2{(bf16*)(ws + WS_R1)}; pg8::gemm_phase<pg8::EpiPlain, pg8::StaticOrder, true, true>(F.lds + RING_OFF, g, S, E2); } __syncthreads();
#elif REP1 == 3
        { pg8::EpiNull E2{}; pg8::gemm_phase<pg8::EpiNull, pg8::StaticOrder, true, true>(F.lds + RING_OFF, g, S, E2); } __syncthreads();
#endif
        pg8::gemm_phase<pg8::EpiInProj, pg8::StaticOrder, true, true>(F.lds + RING_OFF, g, S, E);
#if REP1 == 1
        __syncthreads(); pg8::gemm_phase<pg8::EpiInProj, pg8::StaticOrder, true, true>(F.lds + RING_OFF, g, S, E);
#endif
    }
    SEAM(1);
    if (IN(2)) { const CMixArgs ca{(bf16*)(ws + WS_R1), (float*)(ws + WS_GA), args.in[4], args.in[5], args.in[6], args.in[7], ws + WS_R0, (float*)(ws + WS_DEC), args.in[8], args.in[9], args.in[10], (bf16*)((unsigned char*)args.out + (size_t)192 * MiB), D, ws + WS_R0, (unsigned char*)args.out, (bh16*)((unsigned char*)args.out + (size_t)96 * MiB), (bh16*)args.out, (float*)(ws + WS_DEC + 786432)};
        cmix_phase<false>(F, ca);
#if REP2
        cmix_phase<false>(F, ca, REP2);
#endif
    }
    SEAM(2);
    if (IN(3)) { const CMixArgs ca{(bf16*)(ws + WS_R1), (float*)(ws + WS_GA), args.in[4], args.in[5], args.in[6], args.in[7], ws + WS_R0, (float*)(ws + WS_DEC), args.in[8], args.in[9], args.in[10], (bf16*)((unsigned char*)args.out + (size_t)192 * MiB), D, ws + WS_R0, (unsigned char*)args.out, (bh16*)((unsigned char*)args.out + (size_t)96 * MiB), (bh16*)args.out, (float*)(ws + WS_DEC + 786432)};
#if REP3
        { CMixArgs cb = ca; cb.sto = (unsigned char*)args.out + (size_t)224 * MiB; scan_phase(F, cb); }
#endif
        scan_phase(F, ca); }
    SEAM(3);
    if (IN(4)) { const CMixArgs ca{(bf16*)(ws + WS_R1), (float*)(ws + WS_GA), args.in[4], args.in[5], args.in[6], args.in[7], ws + WS_R0, (float*)(ws + WS_DEC), args.in[8], args.in[9], args.in[10], (bf16*)((unsigned char*)args.out + (size_t)192 * MiB), D, ws + WS_R0, (unsigned char*)args.out, (bh16*)((unsigned char*)args.out + (size_t)96 * MiB), (bh16*)args.out, (float*)(ws + WS_DEC + 786432)};
#if REP4
        { CMixArgs cb = ca; cmix_phase<true>(F, cb, REP4); }
#endif
        cmix_phase<true>(F, ca); }
    SEAM(4);
#if NAIVE_MIX
    { const MixArgs ma{(bf16*)(ws + WS_R1), (float*)(ws + WS_GA), args.in[4], args.in[5], args.in[6], args.in[7], args.out, args.in[8], args.in[9], args.in[10]};
    if (IN(5)) { naive_mix_phase<false>(F, ma); __syncthreads(); }
    SEAM(5);
    if (IN(6)) { naive_mix_phase<true>(F, ma); __syncthreads(); }
    SEAM(6);
    if (IN(7)) { naive_combine(F, ma); }
    SEAM(7); }
#endif
    if (IN(PB0)) { pg8::Gemm g{(bf16*)((unsigned char*)args.out + (size_t)192 * MiB), (bf16*)(ws + WS_WOUT), M_TOK, D, D, D}; pg8::StaticOrder S; S.init(M_TOK, D, F.G, (int)blockIdx.x);
        pg8::EpiResidX E{args.in[0], args.in[1], (bf16*)(ws + WS_R0), (float*)(ws + WS_SQ1)};
        pg8::gemm_phase<pg8::EpiResidX, pg8::StaticOrder, true, true>(F.lds + RING_OFF, g, S, E);
#if REP5
        __syncthreads(); pg8::gemm_phase<pg8::EpiResidX, pg8::StaticOrder, true, true>(F.lds + RING_OFF, g, S, E);
#endif
    }
    SEAM(PB0);
    if (IN(PB0 + 1)) {
        { const float* sq = (const float*)(ws + WS_SQ1); float* r2v = (float*)(ws + WS_RSTD);
          for (int row = (int)blockIdx.x * NWAVES * 64 + F.tid; row < M_TOK; row += F.G * NWAVES * 64) { const f32x4* s4 = (const f32x4*)(sq + (size_t)row * 16);
              const f32x4 t = (s4[0] + s4[1]) + (s4[2] + s4[3]); r2v[row] = 1.0f / (((t[0] + t[1]) + (t[2] + t[3])) * (1.0f / 1024.0f) + EPS); }
          if (args.use_bar) xcd_barrier(bar); }
        pg8::Gemm g{(bf16*)(ws + WS_R0), (bf16*)(ws + WS_W1), M_TOK, FF, D, D}; pg8::StaticOrder S; S.init(M_TOK, FF, F.G, (int)blockIdx.x);
        pg8::EpiFF1 E{(bf16*)(ws + WS_R1), (float*)(ws + WS_RSTD)};
        pg8::gemm_phase<pg8::EpiFF1, pg8::StaticOrder, true, true>(F.lds + RING_OFF, g, S, E);
#if REP6
        __syncthreads(); pg8::gemm_phase<pg8::EpiFF1, pg8::StaticOrder, true, true>(F.lds + RING_OFF, g, S, E);
#endif
    }
    SEAM(PB0 + 1);
#if H_TILED
    if (IN(PB0 + 2)) { pg8::Gemm g{(bf16*)(ws + WS_R1), (bf16*)(ws + WS_W2), M_TOK, D, FF, 64, W2_TILED ? 64 : 0, 32768, W2_TILED ? 32768 : 0, (long)FF * 512, W2_TILED ? (long)FF * 512 : 0};
#else
    if (IN(PB0 + 2)) { pg8::Gemm g{(bf16*)(ws + WS_R1), (bf16*)(ws + WS_W2), M_TOK, D, FF, FF, W2_TILED ? 64 : 0, 0, W2_TILED ? 32768 : 0, 0, W2_TILED ? (long)FF * 512 : 0};
#endif
        pg8::StaticOrder S; S.init(M_TOK, D, F.G, (int)blockIdx.x, FF2_REV);
        pg8::EpiResidB E{(bf16*)(ws + WS_R0), (float*)(ws + WS_SQ2)};
        pg8::gemm_phase<pg8::EpiResidB, pg8::StaticOrder, true, true>(F.lds + RING_OFF, g, S, E); }
    SEAM(PB0 + 2);
    if (IN(PB0 + 3)) { final_norm(F, args.out, (const bf16*)(ws + WS_R0), (float*)(ws + WS_SQ2), args.in[15]);
#if REP8
        final_norm(F, args.out, (const bf16*)(ws + WS_R0), (float*)(ws + WS_SQ2), args.in[15]);
#endif
    }
#undef IN
#undef SEAM
}

extern "C" void kernel_launch(void* const* d_in, const int* in_sizes, int n_in, void* d_out, int out_size, void* d_ws, size_t ws_size, hipStream_t stream) {
    static int grid = 0;
    if (grid == 0) {
        if (n_in != 16 || in_sizes[0] != M_PROMPT * D || out_size != M_TOK * D || ws_size < WS_END) {
            fprintf(stderr, "kernel_launch: unexpected shapes (n_in %d, in0 %d, out %d, ws %zu); nothing launched\n", n_in, n_in > 0 ? in_sizes[0] : -1, out_size, ws_size); grid = -1; return; }
        int dev = 0, cus = 0, per_cu = 0;
        if (hipGetDevice(&dev) != hipSuccess || hipDeviceGetAttribute(&cus, hipDeviceAttributeMultiprocessorCount, dev) != hipSuccess) { grid = -1; return; }
        if (hipFuncSetAttribute((const void*)fwd_kernel, hipFuncAttributeMaxDynamicSharedMemorySize, LDS_BYTES) != hipSuccess) { fprintf(stderr, "kernel_launch: hipFuncSetAttribute failed\n"); grid = -1; return; }
        if (hipOccupancyMaxActiveBlocksPerMultiprocessor(&per_cu, (const void*)fwd_kernel, NWAVES * 64, LDS_BYTES) != hipSuccess || per_cu < 1)
            fprintf(stderr, "kernel_launch: note: occupancy query reports %d workgroups per CU\n", per_cu);
        (void)hipGetLastError();
        grid = cus;
    }
    if (grid < 0) return;
    if (hipMemsetAsync((char*)d_ws + WS_CTL, 0, CTL_ZERO_BYTES, stream) != hipSuccess) return;
    Args a{};
    for (int i = 0; i < 16; ++i) a.in[i] = (const float*)d_in[i];
    a.out = (float*)d_out; a.ws = (unsigned char*)d_ws;
#if MK_SINGLE
    a.ph_lo = 0; a.ph_hi = NPH; a.use_bar = 1;
    hipLaunchKernelGGL(fwd_kernel, dim3(grid), dim3(NWAVES * 64), LDS_BYTES, stream, a);
#else
    for (int p = 0; p < NPH; ++p) { a.ph_lo = p; a.ph_hi = p + 1; a.use_bar = 0;
        hipLaunchKernelGGL(fwd_kernel, dim3(grid), dim3(NWAVES * 64), LDS_BYTES, stream, a); }
#endif
}
```

```cpp
#include <hip/hip_runtime.h>
#include <cstdio>
#ifndef MK_SINGLE
#define MK_SINGLE 1
#endif
#ifndef MIX_GLA
#define MIX_GLA 1
#define MIX_RET 1
#define REP1 0
#define REP2 0
#define REP3 0
#define REP4 0
#define REP6 0
#define DUP 0
#define ABLV 0
#define REP0 0
#define RELAX_MASK 0
#define STAG_TICKS 0
#define PROF_PHASE -1
#define PROF_A 1
#define PROF_B 2
#define PROF_BLOCK 0
#define PROF_DELAY 0
#define LEAD_FF2 1
#define LEAD_IN 0
#define LEAD_OUT 0
#define LEAD_FF1 0
#define PROJ_ROWMAJOR 0
#define H_TILED 1
#define EPI_PLAIN_VARIANT 0
#define PROF_OA 0ull
#define PROF_OB 0ull
#define PROF_QA 25ull
#define PROF_QB 25ull
#define REP5 0
#define REP8 0
#endif
namespace pg8 {
#define PG8_LAS __attribute__((address_space(3)))
typedef unsigned short bf16_t;
typedef short bf16x8 __attribute__((ext_vector_type(8)));
typedef float f32x4 __attribute__((ext_vector_type(4)));
typedef unsigned u32x4 __attribute__((ext_vector_type(4)));
constexpr int BM = 256, BK = 64, HALF = 128, HTB = HALF * BK * 2  , STAGE_BYTES = 8 * HTB, NXCD = 8, WGM = 8;

__host__ __device__ __forceinline__ int lds_byte(int r, int c) { const int st = (r >> 4) * 2 + (c >> 5), rr = r & 15, cc = c & 31, ob = rr * 64 + cc * 2; return st * 1024 + (ob ^ (((ob >> 9) & 1) << 5)); }
__host__ __device__ __forceinline__ void stage_rc(int b, int& R, int& C) { const int st = b / 1024, sb = b % 1024, swz = sb ^ (((sb >> 9) & 1) << 5); R = (st >> 1) * 16 + swz / 64; C = (st & 1) * 32 + (swz % 64) / 2; }
__host__ __device__ __forceinline__ int perm32(int rho) { const int n = rho >> 4, i = rho & 15; return 8 * (i >> 2) + 4 * n + (i & 3); }

struct Unit { int pm, pn; };
struct Gemm { const bf16_t* A; const bf16_t* Bt; int M, N, K, lda; int ldb, ksA, ksB; long psA, psB; };

struct StaticOrder {
    int nM, nN, nwg, G, c, rev;
    __host__ __device__ void init(int M, int N, int G_, int c_, int rev_ = 0) { nM = M / BM; nN = N / BM; nwg = nM * nN; G = G_; c = c_; rev = rev_; }
    __host__ __device__ bool next(int i, Unit& u) const {
        if ((long)i * G + c >= nwg) return false;
        const long L = (long)(rev ? (nwg - 1 - c) / G - i : i) * G + c;
        int wgid = (int)L; { const int q = nwg / NXCD, r = nwg % NXCD, xcd = wgid % NXCD, off = wgid / NXCD; wgid = (xcd < r ? xcd * (q + 1) : r * (q + 1) + (xcd - r) * q) + off; }
        const int nig = WGM * nN, gid = wgid / nig, fm = gid * WGM, gsz = (nM - fm) < WGM ? (nM - fm) : WGM;
        u.pm = fm + ((wgid % nig) % gsz); u.pn = (wgid % nig) / gsz; return true;
    }
    __device__ __forceinline__ void a_ready(const Unit&) const {}
    __device__ __forceinline__ void done(const Unit&) const {}
};
struct InProjOrder {
    int x, r;
    __host__ __device__ void init(int c_) { x = c_ & 7; r = c_ >> 3; }
    __host__ __device__ bool next(int i, Unit& u) const {
        if (i >= 21) return false;
        const int gi = i / 7, ri = i % 7;
        if (ri < 6) { u.pm = x * 48 + 16 * gi + 8 * (ri & 1) + (r & 7); u.pn = 4 * (ri >> 1) + (r >> 3); }
        else { u.pm = x * 48 + 16 * gi + (r & 15); u.pn = 12 + (r >> 4); }
        return true;
    }
    __device__ __forceinline__ void a_ready(const Unit&) const {}
    __device__ __forceinline__ void done(const Unit&) const {}
};
__device__ __forceinline__ unsigned cvt_pk_bf16(float lo, float hi) { unsigned r; asm volatile("v_cvt_pk_bf16_f32 %0, %1, %2" : "=v"(r) : "v"(lo), "v"(hi)); return r; }
__device__ __forceinline__ u32x4 pack8(const f32x4& a, const f32x4& b) { u32x4 w; w.x = cvt_pk_bf16(a[0], a[1]); w.y = cvt_pk_bf16(a[2], a[3]); w.z = cvt_pk_bf16(b[0], b[1]); w.w = cvt_pk_bf16(b[2], b[3]); return w; }
#ifndef H_TILED
#define H_TILED 0
#endif
#ifndef PLANE_PAD_ROWS
#define PLANE_PAD_ROWS 64
#endif
#ifndef PROJ_ROWMAJOR
#define PROJ_ROWMAJOR 0
#endif
#ifndef RELAX_MASK
#define RELAX_MASK 0
#endif
constexpr int NPROJ = 3584, DMODEL = 1024, DFF = 4096, MPROMPT = 65536;

constexpr size_t MTOK = 98304 + PLANE_PAD_ROWS;
#if PROJ_ROWMAJOR
constexpr size_t PL_GV = 0, PL_RV = 512, PL_GQ = 1024, PL_GK = 1280, PL_GG = 1536, PL_RQ = 2048, PL_RK = 2560, PL_RG = 3072, PL_END = (size_t)98304 * 4096;
__device__ __forceinline__ size_t pl(size_t grp, int hh, size_t row, int W) { return row * 4096 + grp + (size_t)(hh * W); }
#else
constexpr size_t PL_GV = 0, PL_RV = PL_GV + 4 * MTOK * 128, PL_GQ = PL_RV + 4 * MTOK * 128, PL_GK = PL_GQ + 4 * MTOK * 64, PL_GG = PL_GK + 4 * MTOK * 64,
                 PL_RQ = PL_GG + 4 * MTOK * 128, PL_RK = PL_RQ + 4 * MTOK * 128, PL_RG = PL_RK + 4 * MTOK * 128, PL_END = PL_RG + 4 * MTOK * 128;
__device__ __forceinline__ size_t pl(size_t grp, int hh, size_t row, int W) { return grp + ((size_t)hh * MTOK + row) * (size_t)W; }
#endif
__device__ __forceinline__ void plane_of(int pn, int bj, int wc, size_t& grp, int& hh, int& W, int& col) {
    W = 128; col = 32 * wc; hh = 2 * (pn & 1) + bj;
    switch (pn >> 1) { case 0: grp = PL_GV; break; case 1: grp = PL_RV; break; case 3: grp = PL_GG; break; case 4: grp = PL_RQ; break; case 5: grp = PL_RK; break; case 6: grp = PL_RG; break;
        default: grp = (pn & 1) ? PL_GK : PL_GQ; W = 64; hh = 2 * bj + (wc >> 1); col = 32 * (wc & 1); break; }
}
struct EpiInProj {
    static constexpr bool PERM = true, AFTER_DRAIN = false, RELAX = (RELAX_MASK & 1) != 0;
    bf16_t* P; const float* rstd; const float* rcos; const float* rsin;
    __device__ __forceinline__ void operator()(const f32x4 (&acc)[2][2][4][2], const Unit& u, int wr, int wc, int fr_in, int fq_in) const {
        int fr = fr_in, fq = fq_in; asm volatile("" : "+v"(fr), "+v"(fq));
        const int row0 = u.pm * BM + wr * 64 + fr;
        const bool rot = (u.pn >= 8) && (u.pn < 12);
        const int i0 = (4 * wc + fq) * 4;
        size_t pgrp[2]; int phh[2]; int W, col;
        plane_of(u.pn, 0, wc, pgrp[0], phh[0], W, col); plane_of(u.pn, 1, wc, pgrp[1], phh[1], W, col);
        const int pos0 = row0 < MPROMPT ? (row0 & 2047) : (row0 & 16383);
        f32x4 cc = (f32x4){1.f, 1.f, 1.f, 1.f}, ss = (f32x4){0.f, 0.f, 0.f, 0.f}, cd16 = cc, sd16 = ss, cd80 = cc, sd80 = ss;
        if (rot) {
            cc = *(const f32x4*)(rcos + pos0 * 64 + i0); ss = *(const f32x4*)(rsin + pos0 * 64 + i0);
            cd16 = *(const f32x4*)(rcos + 16 * 64 + i0); sd16 = *(const f32x4*)(rsin + 16 * 64 + i0); cd80 = *(const f32x4*)(rcos + 80 * 64 + i0); sd80 = *(const f32x4*)(rsin + 80 * 64 + i0); }
        float rs[2][4];
#pragma unroll
        for (int ai = 0; ai < 2; ++ai)
#pragma unroll
            for (int m = 0; m < 4; ++m) rs[ai][m] = rstd[row0 + ai * HALF + m * 16];
        __builtin_amdgcn_sched_barrier(0);
        const f32x4 cc0 = cc, ss0 = ss;
#pragma unroll
        for (int bj = 0; bj < 2; ++bj) {
            cc = cc0; ss = ss0;
#pragma unroll
            for (int ai = 0; ai < 2; ++ai)
#pragma unroll
                for (int m = 0; m < 4; ++m) {
                    const int row = row0 + ai * HALF + m * 16;
                    f32x4 v0 = acc[ai][bj][m][0] * rs[ai][m], v1 = acc[ai][bj][m][1] * rs[ai][m];
                    if (rot) { const f32x4 lo = v0 * cc - v1 * ss, hi = v0 * ss + v1 * cc; v0 = lo; v1 = hi; }
                    *(u32x4*)(P + pl(pgrp[bj], phh[bj], (size_t)row, W) + col + 8 * fq) = pack8(v0, v1);
                    if (rot && !(ai == 1 && m == 3)) { const f32x4 cd = m == 3 ? cd80 : cd16, sd = m == 3 ? sd80 : sd16; const f32x4 nc = cc * cd - ss * sd, ns = ss * cd + cc * sd; cc = nc; ss = ns; }
                }
        }
    }
};
struct EpiResid {
    static constexpr bool PERM = true, AFTER_DRAIN = false, RELAX = false;
    const float* xp; const float* xs; float* out; bf16_t* A2; float* sq;
    __device__ __forceinline__ void operator()(const f32x4 (&acc)[2][2][4][2], const Unit& u, int wr, int wc, int fr_in, int fq_in) const {
        int fr = fr_in, fq = fq_in; asm volatile("" : "+v"(fr), "+v"(fq));
        const int row0 = u.pm * BM + wr * 64 + fr, colb = u.pn * BM + wc * 32 + 8 * fq;
#pragma unroll
        for (int ai = 0; ai < 2; ++ai)
#pragma unroll
            for (int m = 0; m < 4; ++m) {
                const int row = row0 + ai * HALF + m * 16;
                const float* xrow = (row < MPROMPT ? xp + (size_t)row * DMODEL : xs + (size_t)(row - MPROMPT) * DMODEL) + colb;
                float* orow = out + (size_t)row * DMODEL + colb;
                float ss = 0.f;
#pragma unroll
                for (int bj = 0; bj < 2; ++bj) {
                    const f32x4 x0 = *(const f32x4*)(xrow + bj * HALF), x1 = *(const f32x4*)(xrow + bj * HALF + 4);
                    const f32x4 v0 = acc[ai][bj][m][0] + x0, v1 = acc[ai][bj][m][1] + x1;
                    *(f32x4*)(orow + bj * HALF) = v0; *(f32x4*)(orow + bj * HALF + 4) = v1;
                    if (A2) *(u32x4*)(A2 + (size_t)row * DMODEL + colb + bj * HALF) = pack8(v0, v1);
                    ss += (v0[0] * v0[0] + v0[1] * v0[1]) + (v0[2] * v0[2] + v0[3] * v0[3]) + (v1[0] * v1[0] + v1[1] * v1[1]) + (v1[2] * v1[2] + v1[3] * v1[3]);
                }
                ss += __shfl_xor(ss, 16); ss += __shfl_xor(ss, 32);
                if (fq == 0) sq[(size_t)row * 16 + u.pn * 4 + wc] = ss;
            }
    }
};
struct EpiFF1 {
    static constexpr bool PERM = true, AFTER_DRAIN = false, RELAX = (RELAX_MASK & 4) != 0;
    bf16_t* H; const float* r2v;
    __device__ __forceinline__ void operator()(const f32x4 (&acc)[2][2][4][2], const Unit& u, int wr, int wc, int fr_in, int fq_in) const {
        int fr = fr_in, fq = fq_in; asm volatile("" : "+v"(fr), "+v"(fq));
        const int row0 = u.pm * BM + wr * 64 + fr, colb = u.pn * BM + wc * 32 + 8 * fq;
        float r2[2][4];
#pragma unroll
        for (int ai = 0; ai < 2; ++ai)
#pragma unroll
            for (int m = 0; m < 4; ++m) r2[ai][m] = r2v[row0 + ai * HALF + m * 16];
        __builtin_amdgcn_sched_barrier(0);
#pragma unroll
        for (int ai = 0; ai < 2; ++ai)
#pragma unroll
            for (int m = 0; m < 4; ++m) {
                const int row = row0 + ai * HALF + m * 16;
#if H_TILED
                bf16_t* rowp = H + ((size_t)u.pm * (DFF / 64) + (size_t)(u.pn * 4 + (wc >> 1))) * (256 * 64) + (size_t)(wr * 64 + fr + ai * HALF + m * 16) * 64 + (wc & 1) * 32 + 8 * fq;
#else
                bf16_t* rowp = H + (size_t)row * DFF + colb;
#endif
#pragma unroll
                for (int bj = 0; bj < 2; ++bj) {
                    f32x4 v0 = acc[ai][bj][m][0], v1 = acc[ai][bj][m][1];
#pragma unroll
                    for (int j = 0; j < 4; ++j) { const float a = fmaxf(v0[j], 0.f), b = fmaxf(v1[j], 0.f); v0[j] = a * a * r2[ai][m]; v1[j] = b * b * r2[ai][m]; }
                    *(u32x4*)(rowp + bj * (H_TILED ? 2 * 256 * 64 : HALF)) = pack8(v0, v1);
                }
            }
    }
};

struct EpiPlain {
    static constexpr bool PERM = true, AFTER_DRAIN = false, RELAX = false;
    bf16_t* P;
    __device__ __forceinline__ void operator()(const f32x4 (&acc)[2][2][4][2], const Unit& u, int wr, int wc, int fr_in, int fq_in) const {
        int fr = fr_in, fq = fq_in; asm volatile("" : "+v"(fr), "+v"(fq));
        const int row0 = u.pm * BM + wr * 64 + fr;
        size_t pgrp[2]; int phh[2]; int W, col;
        plane_of(u.pn, 0, wc, pgrp[0], phh[0], W, col); plane_of(u.pn, 1, wc, pgrp[1], phh[1], W, col);
#pragma unroll
        for (int ai = 0; ai < 2; ++ai)
#pragma unroll
            for (int m = 0; m < 4; ++m) { const int row = row0 + ai * HALF + m * 16;
#pragma unroll
                for (int bj = 0; bj < 2; ++bj) *(u32x4*)(P + pl(pgrp[bj], phh[bj], (size_t)row, W) + col + 8 * fq) = pack8(acc[ai][bj][m][0], acc[ai][bj][m][1]); }
    }
};

struct EpiResidX {
    static constexpr bool PERM = true, AFTER_DRAIN = false, RELAX = (RELAX_MASK & 2) != 0;
    const float* xp; const float* xs; bf16_t* A2; float* sq;
    __device__ __forceinline__ void operator()(const f32x4 (&acc)[2][2][4][2], const Unit& u, int wr, int wc, int fr_in, int fq_in) const {
        int fr = fr_in, fq = fq_in; asm volatile("" : "+v"(fr), "+v"(fq));
        const int row0 = u.pm * BM + wr * 64 + fr, colb = u.pn * BM + wc * 32 + 8 * fq;
#pragma unroll
        for (int ai = 0; ai < 2; ++ai) {
            f32x4 xv[4][2][2];
#pragma unroll
            for (int m = 0; m < 4; ++m) { const int row = row0 + ai * HALF + m * 16;
                const float* xrow = (row < MPROMPT ? xp + (size_t)row * DMODEL : xs + (size_t)(row - MPROMPT) * DMODEL) + colb;
#pragma unroll
                for (int bj = 0; bj < 2; ++bj) { xv[m][bj][0] = *(const f32x4*)(xrow + bj * HALF); xv[m][bj][1] = *(const f32x4*)(xrow + bj * HALF + 4); } }
            __builtin_amdgcn_sched_barrier(0);
#pragma unroll
            for (int m = 0; m < 4; ++m) {
                const int row = row0 + ai * HALF + m * 16;
                float ss = 0.f;
#pragma unroll
                for (int bj = 0; bj < 2; ++bj) {
                    const f32x4 v0 = acc[ai][bj][m][0] + xv[m][bj][0], v1 = acc[ai][bj][m][1] + xv[m][bj][1];
                    *(u32x4*)(A2 + (size_t)row * DMODEL + colb + bj * HALF) = pack8(v0, v1);
                    ss += (v0[0] * v0[0] + v0[1] * v0[1]) + (v0[2] * v0[2] + v0[3] * v0[3]) + (v1[0] * v1[0] + v1[1] * v1[1]) + (v1[2] * v1[2] + v1[3] * v1[3]);
                }
                ss += __shfl_xor(ss, 16); ss += __shfl_xor(ss, 32);
                if (fq == 0) sq[(size_t)row * 16 + u.pn * 4 + wc] = ss;
            }
            __builtin_amdgcn_sched_barrier(0);
        }
    }
};
struct EpiResidB {
    static constexpr bool PERM = true, AFTER_DRAIN = false, RELAX = (RELAX_MASK & 8) != 0;
    bf16_t* A2; float* sq;
    __device__ __forceinline__ void operator()(const f32x4 (&acc)[2][2][4][2], const Unit& u, int wr, int wc, int fr_in, int fq_in) const {
        int fr = fr_in, fq = fq_in; asm volatile("" : "+v"(fr), "+v"(fq));
        const int row0 = u.pm * BM + wr * 64 + fr, colb = u.pn * BM + wc * 32 + 8 * fq;
        u32x4 xw[2][4][2];
#pragma unroll
        for (int ai = 0; ai < 2; ++ai)
#pragma unroll
            for (int m = 0; m < 4; ++m)
#pragma unroll
                for (int bj = 0; bj < 2; ++bj) xw[ai][m][bj] = *(const u32x4*)(A2 + (size_t)(row0 + ai * HALF + m * 16) * DMODEL + colb + bj * HALF);
        __builtin_amdgcn_sched_barrier(0);
#pragma unroll
        for (int ai = 0; ai < 2; ++ai)
#pragma unroll
            for (int m = 0; m < 4; ++m) {
                const int row = row0 + ai * HALF + m * 16;
                bf16_t* xr = A2 + (size_t)row * DMODEL + colb;
                float ss = 0.f;
#pragma unroll
                for (int bj = 0; bj < 2; ++bj) {
                    const u32x4 w_ = xw[ai][m][bj];
                    const f32x4 x0 = {__uint_as_float(w_.x << 16), __uint_as_float(w_.x & 0xffff0000u), __uint_as_float(w_.y << 16), __uint_as_float(w_.y & 0xffff0000u)};
                    const f32x4 x1 = {__uint_as_float(w_.z << 16), __uint_as_float(w_.z & 0xffff0000u), __uint_as_float(w_.w << 16), __uint_as_float(w_.w & 0xffff0000u)};
                    const f32x4 v0 = acc[ai][bj][m][0] + x0, v1 = acc[ai][bj][m][1] + x1;
                    *(u32x4*)(xr + bj * HALF) = pack8(v0, v1);
                    ss += (v0[0] * v0[0] + v0[1] * v0[1]) + (v0[2] * v0[2] + v0[3] * v0[3]) + (v1[0] * v1[0] + v1[1] * v1[1]) + (v1[2] * v1[2] + v1[3] * v1[3]);
                }
                ss += __shfl_xor(ss, 16); ss += __shfl_xor(ss, 32);
                if (fq == 0) sq[(size_t)row * 16 + u.pn * 4 + wc] = ss;
            }
    }
};

struct EpiResidB2 {
    static constexpr bool PERM = true, AFTER_DRAIN = false, RELAX = (RELAX_MASK & 8) != 0;
    const bf16_t* X; bf16_t* A2; float* sq;
    __device__ __forceinline__ void operator()(const f32x4 (&acc)[2][2][4][2], const Unit& u, int wr, int wc, int fr_in, int fq_in) const {
        int fr = fr_in, fq = fq_in; asm volatile("" : "+v"(fr), "+v"(fq));
        const int row0 = u.pm * BM + wr * 64 + fr, colb = u.pn * BM + wc * 32 + 8 * fq;
        u32x4 xw[2][4][2];
#pragma unroll
        for (int ai = 0; ai < 2; ++ai)
#pragma unroll
            for (int m = 0; m < 4; ++m)
#pragma unroll
                for (int bj = 0; bj < 2; ++bj) xw[ai][m][bj] = *(const u32x4*)(X + (size_t)(row0 + ai * HALF + m * 16) * DMODEL + colb + bj * HALF);
        __builtin_amdgcn_sched_barrier(0);
#pragma unroll
        for (int ai = 0; ai < 2; ++ai)
#pragma unroll
            for (int m = 0; m < 4; ++m) {
                const int row = row0 + ai * HALF + m * 16;
                bf16_t* xr = A2 + (size_t)row * DMODEL + colb;
                float ss = 0.f;
#pragma unroll
                for (int bj = 0; bj < 2; ++bj) {
                    const u32x4 w_ = xw[ai][m][bj];
                    const f32x4 x0 = {__uint_as_float(w_.x << 16), __uint_as_float(w_.x & 0xffff0000u), __uint_as_float(w_.y << 16), __uint_as_float(w_.y & 0xffff0000u)};
                    const f32x4 x1 = {__uint_as_float(w_.z << 16), __uint_as_float(w_.z & 0xffff0000u), __uint_as_float(w_.w << 16), __uint_as_float(w_.w & 0xffff0000u)};
                    const f32x4 v0 = acc[ai][bj][m][0] + x0, v1 = acc[ai][bj][m][1] + x1;
                    *(u32x4*)(xr + bj * HALF) = pack8(v0, v1);
                    ss += (v0[0] * v0[0] + v0[1] * v0[1]) + (v0[2] * v0[2] + v0[3] * v0[3]) + (v1[0] * v1[0] + v1[1] * v1[1]) + (v1[2] * v1[2] + v1[3] * v1[3]);
                }
                ss += __shfl_xor(ss, 16); ss += __shfl_xor(ss, 32);
                if (fq == 0) sq[(size_t)row * 16 + u.pn * 4 + wc] = ss;
            }
    }
};

struct EpiNull {
    static constexpr bool PERM = true, AFTER_DRAIN = false, RELAX = false;
    __device__ __forceinline__ void operator()(const f32x4 (&acc)[2][2][4][2], const Unit& u, int wr, int wc, int fr_in, int fq_in) const {
        int fr = fr_in, fq = fq_in; asm volatile("" : "+v"(fr), "+v"(fq));
#pragma unroll
        for (int ai = 0; ai < 2; ++ai)
#pragma unroll
            for (int m = 0; m < 4; ++m)
#pragma unroll
                for (int bj = 0; bj < 2; ++bj) asm volatile("" :: "v"(acc[ai][bj][m][0]), "v"(acc[ai][bj][m][1]));
    }
};
template <class Epi, class Sched, bool ALIGN_EPI = false, bool SP2 = false>
__device__ __forceinline__ void gemm_phase(PG8_LAS unsigned char* lds, const Gemm g, const Sched& S, const Epi& E) {
    const int tid = threadIdx.x, wid = __builtin_amdgcn_readfirstlane(tid >> 6), lane = tid & 63, wr = wid >> 2, wc = wid & 3, fr = lane & 15, fq = lane >> 4;
    const int K = g.K, nt = K / BK, ldb = g.ldb ? g.ldb : K;
    unsigned voffA[2], voffB[2];
#pragma unroll
    for (int i = 0; i < 2; ++i) { int R, C; stage_rc(tid * 16 + i * 8192, R, C); const int Rb = Epi::PERM ? ((R & ~31) + perm32(R & 31)) : R;
        voffA[i] = (unsigned)(R * g.lda + C) * 2u; voffB[i] = (unsigned)(Rb * ldb + C) * 2u; }
    const size_t kstepA = g.ksA ? (size_t)g.ksA : (size_t)(BK * 2), kstepB = g.ksB ? (size_t)g.ksB : (size_t)(BK * 2);
    const size_t hstepB = (size_t)HALF * ldb * 2, hstepA = (size_t)HALF * g.lda * 2;
    const size_t tstepB = g.psB ? (size_t)g.psB : 2 * hstepB, tstepA = g.psA ? (size_t)g.psA : 2 * hstepA;
    const unsigned ldsw = (unsigned)wid * 1024u;
    const int aoff = lds_byte(wr * 64 + fr, fq * 8), boff = lds_byte(wc * 32 + fr, fq * 8);
#define PG8_SA(b, h) (((b) * 2 + (h)) * HTB)
#define PG8_SB(b, h) ((4 + (b) * 2 + (h)) * HTB)
#define PG8_STAGE(bufoff, gbase, voff) do { _Pragma("unroll") for (int _i = 0; _i < 2; ++_i) \
        __builtin_amdgcn_global_load_lds((const unsigned*)((const char*)(gbase) + (voff)[_i]), (PG8_LAS unsigned*)(lds + (bufoff) + ldsw + _i * 8192), 16, 0, 0); } while (0)
#define PG8_LDA(dst, b, h) do { _Pragma("unroll") for (int m = 0; m < 4; ++m) _Pragma("unroll") for (int k = 0; k < 2; ++k) dst[m][k] = *(const PG8_LAS bf16x8*)(lds + PG8_SA(b, h) + aoff + m * 2048 + k * 1024); } while (0)
#define PG8_LDB(dst, b, h) do { _Pragma("unroll") for (int n = 0; n < 2; ++n) _Pragma("unroll") for (int k = 0; k < 2; ++k) dst[n][k] = *(const PG8_LAS bf16x8*)(lds + PG8_SB(b, h) + boff + n * 2048 + k * 1024); } while (0)
#define PG8_MMA(ai, bj, At, Bt) do { __builtin_amdgcn_s_setprio(1); _Pragma("unroll") for (int m = 0; m < 4; ++m) _Pragma("unroll") for (int n = 0; n < 2; ++n) _Pragma("unroll") for (int k = 0; k < 2; ++k) \
        acc[ai][bj][m][n] = __builtin_amdgcn_mfma_f32_16x16x32_bf16(Bt[n][k], At[m][k], acc[ai][bj][m][n], 0, 0, 0); __builtin_amdgcn_s_setprio(0); } while (0)
#define PG8_WAIT_V(n) asm volatile("s_waitcnt vmcnt(" #n ")" ::: "memory")
#define PG8_WAIT_L(n) asm volatile("s_waitcnt lgkmcnt(" #n ")" ::: "memory")
#define PG8_WAIT_VF(first, nrel) asm volatile("s_cmp_lg_u32 %0, 0\n\ts_cbranch_scc1 1f\n\ts_waitcnt vmcnt(8)\n\ts_branch 2f\n1:\n\ts_waitcnt vmcnt(" #nrel ")\n2:" :: "s"(first) : "memory", "scc")
#define PG8_BAR __builtin_amdgcn_s_barrier()
#define PG8_SCHED __builtin_amdgcn_sched_barrier(0)
    Unit cur, nxt; int ui = 0;
    if (!S.next(0, cur)) return;
    f32x4 acc[2][2][4][2];
#pragma unroll
    for (int a = 0; a < 2; ++a)
#pragma unroll
        for (int b = 0; b < 2; ++b)
#pragma unroll
            for (int m = 0; m < 4; ++m)
#pragma unroll
                for (int n = 0; n < 2; ++n) acc[a][b][m][n] = (f32x4){0.f, 0.f, 0.f, 0.f};
    bf16x8 At[4][2], B0[2][2], B1[2][2];
    const char* cA = (const char*)g.A + (size_t)cur.pm * tstepA; const char* cB = (const char*)g.Bt + (size_t)cur.pn * tstepB;
    S.a_ready(cur);
    if constexpr (SP2) {
        PG8_STAGE(PG8_SB(0, 0), cB, voffB); PG8_STAGE(PG8_SB(0, 1), cB + hstepB, voffB); PG8_STAGE(PG8_SA(0, 0), cA, voffA); PG8_STAGE(PG8_SA(0, 1), cA + hstepA, voffA);
        if (wr == 1) PG8_BAR;
        PG8_WAIT_V(2); PG8_BAR;
        PG8_STAGE(PG8_SB(1, 0), cB + kstepB, voffB); PG8_STAGE(PG8_SA(1, 0), cA + kstepA, voffA); PG8_STAGE(PG8_SB(1, 1), cB + hstepB + kstepB, voffB); PG8_STAGE(PG8_SA(1, 1), cA + hstepA + kstepA, voffA);
        PG8_WAIT_V(8); PG8_BAR;
    } else {
        PG8_STAGE(PG8_SB(0, 0), cB, voffB); PG8_STAGE(PG8_SA(0, 0), cA, voffA); PG8_STAGE(PG8_SB(0, 1), cB + hstepB, voffB); PG8_STAGE(PG8_SA(0, 1), cA + hstepA, voffA);
        if (wr == 1) PG8_BAR;
        PG8_WAIT_V(4); PG8_BAR;
        PG8_STAGE(PG8_SB(1, 0), cB + kstepB, voffB); PG8_STAGE(PG8_SA(1, 0), cA + kstepA, voffA); PG8_STAGE(PG8_SB(1, 1), cB + hstepB + kstepB, voffB);
        PG8_WAIT_V(6); PG8_BAR;
    }
    for (;;) {
        const bool has_next = S.next(ui + 1, nxt);
        const char* nA = has_next ? (const char*)g.A + (size_t)nxt.pm * tstepA : cA; const char* nB = has_next ? (const char*)g.Bt + (size_t)nxt.pn * tstepB : cB;
        for (int t = 0; t < nt; t += 2) {
            const bool last = (t == nt - 2);
            const char* a1 = cA + (size_t)(t + 1) * kstepA;
            const char* a2 = last ? nA : cA + (size_t)(t + 2) * kstepA; const char* b2 = last ? nB : cB + (size_t)(t + 2) * kstepB;
            const char* a3 = a2 + kstepA; const char* b3 = b2 + kstepB;
            if (last && has_next) S.a_ready(nxt);
            if constexpr (SP2) {
            const int first = __builtin_amdgcn_readfirstlane((t == 0 && ui > 0) ? 1 : 0);
            PG8_LDB(B0, 0, 0); PG8_LDB(B1, 0, 1); PG8_SCHED; PG8_LDA(At, 0, 0);
            PG8_WAIT_VF(first, 16); PG8_WAIT_L(0); PG8_BAR; PG8_MMA(0, 0, At, B0); PG8_MMA(0, 1, At, B1); PG8_BAR; PG8_SCHED;
            PG8_LDA(At, 0, 1); PG8_STAGE(PG8_SB(0, 0), b2, voffB); PG8_STAGE(PG8_SB(0, 1), b2 + hstepB, voffB); PG8_STAGE(PG8_SA(0, 0), a2, voffA);
            PG8_WAIT_VF(first, 22); PG8_WAIT_L(0); PG8_BAR; PG8_MMA(1, 0, At, B0); PG8_MMA(1, 1, At, B1); PG8_BAR; PG8_SCHED;
            PG8_LDB(B0, 1, 0); PG8_LDB(B1, 1, 1); PG8_SCHED; PG8_LDA(At, 1, 0); PG8_STAGE(PG8_SA(0, 1), a2 + hstepA, voffA);
            PG8_WAIT_VF(first, 24); PG8_WAIT_L(0); PG8_BAR; PG8_MMA(0, 0, At, B0); PG8_MMA(0, 1, At, B1); PG8_BAR; PG8_SCHED;
            PG8_LDA(At, 1, 1); PG8_STAGE(PG8_SB(1, 0), b3, voffB); PG8_STAGE(PG8_SB(1, 1), b3 + hstepB, voffB); PG8_STAGE(PG8_SA(1, 0), a3, voffA);
            PG8_WAIT_V(8); PG8_WAIT_L(0); PG8_BAR; PG8_MMA(1, 0, At, B0); PG8_MMA(1, 1, At, B1); PG8_BAR; PG8_SCHED;
            PG8_STAGE(PG8_SA(1, 1), a3 + hstepA, voffA);
            } else {
            PG8_LDB(B0, 0, 0); PG8_SCHED; PG8_LDA(At, 0, 0); PG8_STAGE(PG8_SA(1, 1), a1 + hstepA, voffA);
            PG8_WAIT_L(8); PG8_BAR; PG8_WAIT_L(0); PG8_MMA(0, 0, At, B0); PG8_BAR; PG8_SCHED;
            PG8_LDB(B1, 0, 1); PG8_STAGE(PG8_SB(0, 0), b2, voffB);
            PG8_BAR; PG8_WAIT_L(0); PG8_MMA(0, 1, At, B1); PG8_BAR;
            PG8_LDA(At, 0, 1); PG8_STAGE(PG8_SA(0, 0), a2, voffA);
            PG8_BAR; PG8_WAIT_L(0); PG8_MMA(1, 0, At, B0); PG8_BAR; PG8_SCHED;
            PG8_STAGE(PG8_SB(0, 1), b2 + hstepB, voffB);
            PG8_WAIT_V(6); PG8_BAR; PG8_MMA(1, 1, At, B1); PG8_BAR;
            PG8_LDB(B0, 1, 0); PG8_SCHED; PG8_LDA(At, 1, 0); PG8_STAGE(PG8_SA(0, 1), a2 + hstepA, voffA);
            PG8_WAIT_L(8); PG8_BAR; PG8_WAIT_L(0); PG8_MMA(0, 0, At, B0); PG8_BAR; PG8_SCHED;
            PG8_LDB(B1, 1, 1); PG8_STAGE(PG8_SB(1, 0), b3, voffB);
            PG8_BAR; PG8_WAIT_L(0); PG8_MMA(0, 1, At, B1); PG8_BAR;
            PG8_LDA(At, 1, 1); PG8_STAGE(PG8_SA(1, 0), a3, voffA);
            PG8_BAR; PG8_WAIT_L(0); PG8_MMA(1, 0, At, B0); PG8_BAR; PG8_SCHED;
            PG8_STAGE(PG8_SB(1, 1), b3 + hstepB, voffB);
            PG8_WAIT_V(6); PG8_BAR; PG8_MMA(1, 1, At, B1); PG8_BAR;
            }
        }
        if constexpr (ALIGN_EPI) { if (wr == 0) PG8_BAR; }
        if constexpr (!Epi::AFTER_DRAIN) { E(acc, cur, wr, wc, fr, fq); S.done(cur); }
        if (!has_next) break;
#pragma unroll
        for (int a = 0; a < 2; ++a)
#pragma unroll
            for (int b = 0; b < 2; ++b)
#pragma unroll
                for (int m = 0; m < 4; ++m)
#pragma unroll
                    for (int n = 0; n < 2; ++n) acc[a][b][m][n] = (f32x4){0.f, 0.f, 0.f, 0.f};
        cur = nxt; cA = nA; cB = nB; ++ui;
        if constexpr (ALIGN_EPI) { if (wr == 1) PG8_BAR; }
    }
    PG8_WAIT_V(0);
    if constexpr (!ALIGN_EPI) { if (wr == 0) PG8_BAR; }
    PG8_BAR;
    if constexpr (Epi::AFTER_DRAIN) { E.fused(acc, cur, wr, wc, fr, fq, lds, wid, lane); S.done(cur); }
#undef PG8_SA
#undef PG8_SB
#undef PG8_STAGE
#undef PG8_LDA
#undef PG8_LDB
#undef PG8_MMA
#undef PG8_WAIT_V
#undef PG8_WAIT_L
#undef PG8_WAIT_VF
#undef PG8_BAR
#undef PG8_SCHED
}

template <class Epi, class Sched>
__device__ __forceinline__ void gemm_phase_r5(PG8_LAS unsigned char* lds, const Gemm g, const Sched& S, const Epi& E) {
    const int tid = threadIdx.x, wid = __builtin_amdgcn_readfirstlane(tid >> 6), lane = tid & 63, wr = wid >> 2, wc = wid & 3, fr = lane & 15, fq = lane >> 4;
    const int K = g.K, nt = K / BK, ldb = g.ldb ? g.ldb : K;
    unsigned voffA[2], voffB[2];
#pragma unroll
    for (int i = 0; i < 2; ++i) { int R, C; stage_rc(tid * 16 + i * 8192, R, C); const int Rb = Epi::PERM ? ((R & ~31) + perm32(R & 31)) : R;
        voffA[i] = (unsigned)(R * g.lda + C) * 2u; voffB[i] = (unsigned)(Rb * ldb + C) * 2u; }
    const size_t kstepA = g.ksA ? (size_t)g.ksA : (size_t)(BK * 2), kstepB = g.ksB ? (size_t)g.ksB : (size_t)(BK * 2);
    const size_t hstepB = (size_t)HALF * ldb * 2, hstepA = (size_t)HALF * g.lda * 2;
    const size_t tstepB = g.psB ? (size_t)g.psB : 2 * hstepB, tstepA = g.psA ? (size_t)g.psA : 2 * hstepA;
    const unsigned ldsw = (unsigned)wid * 1024u;
    const int aoff = lds_byte(wr * 64 + fr, fq * 8), boff = lds_byte(wc * 32 + fr, fq * 8);
#define R5_SB(b, h) ((5 + (b) * 2 + (h)) * HTB)
#define R5_STAGE_B(bufoff, gbase) do { _Pragma("unroll") for (int _i = 0; _i < 2; ++_i) \
        __builtin_amdgcn_global_load_lds((const unsigned*)((const char*)(gbase) + voffB[_i]), (PG8_LAS unsigned*)(lds + (bufoff) + ldsw + _i * 8192), 16, 0, 0); } while (0)
#define R5_STAGE_A(slotoff, gbase) do { _Pragma("unroll") for (int _i = 0; _i < 2; ++_i) \
        __builtin_amdgcn_global_load_lds((const unsigned*)((const char*)(gbase) + voffA[_i]), (PG8_LAS unsigned*)(lds + (slotoff) + ldsw + _i * 8192), 16, 0, 0); } while (0)
#define R5_LDA(dst, slotoff) do { const PG8_LAS unsigned char* _ab = lds + (slotoff) + aoff; _Pragma("unroll") for (int m = 0; m < 4; ++m) _Pragma("unroll") for (int k = 0; k < 2; ++k) dst[m][k] = *(const PG8_LAS bf16x8*)(_ab + m * 2048 + k * 1024); } while (0)
#define R5_LDB(dst, b, h) do { _Pragma("unroll") for (int n = 0; n < 2; ++n) _Pragma("unroll") for (int k = 0; k < 2; ++k) dst[n][k] = *(const PG8_LAS bf16x8*)(lds + R5_SB(b, h) + boff + n * 2048 + k * 1024); } while (0)
#define R5_MMA(ai, bj, At, Bt) do { __builtin_amdgcn_s_setprio(1); _Pragma("unroll") for (int m = 0; m < 4; ++m) _Pragma("unroll") for (int n = 0; n < 2; ++n) _Pragma("unroll") for (int k = 0; k < 2; ++k) \
        acc[ai][bj][m][n] = __builtin_amdgcn_mfma_f32_16x16x32_bf16(Bt[n][k], At[m][k], acc[ai][bj][m][n], 0, 0, 0); __builtin_amdgcn_s_setprio(0); } while (0)
#define R5_WAIT_V(n) asm volatile("s_waitcnt vmcnt(" #n ")" ::: "memory")
#define R5_WAIT_L(n) asm volatile("s_waitcnt lgkmcnt(" #n ")" ::: "memory")
#define R5_WAIT_VF(first, nrel) asm volatile("s_cmp_lg_u32 %0, 0\n\ts_cbranch_scc1 1f\n\ts_waitcnt vmcnt(10)\n\ts_branch 2f\n1:\n\ts_waitcnt vmcnt(" #nrel ")\n2:" :: "s"(first) : "memory", "scc")
#define R5_BAR __builtin_amdgcn_s_barrier()
#define R5_SCHED __builtin_amdgcn_sched_barrier(0)
    Unit cur, nxt; int ui = 0;
    if (!S.next(0, cur)) return;
    f32x4 acc[2][2][4][2];
#pragma unroll
    for (int a = 0; a < 2; ++a)
#pragma unroll
        for (int b = 0; b < 2; ++b)
#pragma unroll
            for (int m = 0; m < 4; ++m)
#pragma unroll
                for (int n = 0; n < 2; ++n) acc[a][b][m][n] = (f32x4){0.f, 0.f, 0.f, 0.f};
    bf16x8 At[4][2], B0[2][2], B1[2][2];
    const char* cA = (const char*)g.A + (size_t)cur.pm * tstepA; const char* cB = (const char*)g.Bt + (size_t)cur.pn * tstepB;
    S.a_ready(cur);
    R5_STAGE_B(R5_SB(0, 0), cB); R5_STAGE_B(R5_SB(0, 1), cB + hstepB); R5_STAGE_A(0 * HTB, cA); R5_STAGE_A(1 * HTB, cA + hstepA);
    if (wr == 1) R5_BAR;
    R5_WAIT_V(2); R5_BAR;
    R5_STAGE_B(R5_SB(1, 0), cB + kstepB); R5_STAGE_A(2 * HTB, cA + kstepA); R5_STAGE_B(R5_SB(1, 1), cB + hstepB + kstepB); R5_STAGE_A(3 * HTB, cA + hstepA + kstepA);
    R5_WAIT_V(8); R5_BAR;
    int r = 0;
    for (;;) {
        const bool has_next = S.next(ui + 1, nxt);
        const char* nA = has_next ? (const char*)g.A + (size_t)nxt.pm * tstepA : cA; const char* nB = has_next ? (const char*)g.Bt + (size_t)nxt.pn * tstepB : cB;
        for (int t = 0; t < nt; t += 2) {
            const bool last = (t == nt - 2);
            const char* a2 = last ? nA : cA + (size_t)(t + 2) * kstepA; const char* b2 = last ? nB : cB + (size_t)(t + 2) * kstepB;
            const char* a3 = a2 + kstepA; const char* b3 = b2 + kstepB;
            if (last && has_next) S.a_ready(nxt);
            const int s0 = r * HTB, s1 = (r + 1 >= 5 ? r - 4 : r + 1) * HTB, s2 = (r + 2 >= 5 ? r - 3 : r + 2) * HTB, s3 = (r + 3 >= 5 ? r - 2 : r + 3) * HTB, s4 = (r + 4 >= 5 ? r - 1 : r + 4) * HTB;
            R5_LDB(B0, 0, 0); R5_LDB(B1, 0, 1); R5_SCHED; R5_LDA(At, s0); R5_STAGE_A(s4, a2);
            R5_WAIT_VF(__builtin_amdgcn_readfirstlane((t == 0 && ui > 0) ? 1 : 0), 18); R5_WAIT_L(0); R5_BAR; R5_MMA(0, 0, At, B0); R5_MMA(0, 1, At, B1); R5_BAR; R5_SCHED;
            R5_LDA(At, s1); R5_STAGE_B(R5_SB(0, 0), b2); R5_STAGE_B(R5_SB(0, 1), b2 + hstepB); R5_STAGE_A(s0, a2 + hstepA);
            R5_WAIT_VF(__builtin_amdgcn_readfirstlane((t == 0 && ui > 0) ? 1 : 0), 24); R5_WAIT_L(0); R5_BAR; R5_MMA(1, 0, At, B0); R5_MMA(1, 1, At, B1); R5_BAR; R5_SCHED;
            R5_LDB(B0, 1, 0); R5_LDB(B1, 1, 1); R5_SCHED; R5_LDA(At, s2); R5_STAGE_A(s1, a3);
            R5_WAIT_VF(__builtin_amdgcn_readfirstlane((t == 0 && ui > 0) ? 1 : 0), 26); R5_WAIT_L(0); R5_BAR; R5_MMA(0, 0, At, B0); R5_MMA(0, 1, At, B1); R5_BAR; R5_SCHED;
            R5_LDA(At, s3); R5_STAGE_B(R5_SB(1, 0), b3); R5_STAGE_B(R5_SB(1, 1), b3 + hstepB); R5_STAGE_A(s2, a3 + hstepA);
            R5_WAIT_V(10); R5_WAIT_L(0); R5_BAR; R5_MMA(1, 0, At, B0); R5_MMA(1, 1, At, B1); R5_BAR; R5_SCHED;
            r = r + 4 >= 5 ? r - 1 : r + 4;
        }
        if (wr == 0) R5_BAR;
        E(acc, cur, wr, wc, fr, fq); S.done(cur);
        if (!has_next) break;
#pragma unroll
        for (int a = 0; a < 2; ++a)
#pragma unroll
            for (int b = 0; b < 2; ++b)
#pragma unroll
                for (int m = 0; m < 4; ++m)
#pragma unroll
                    for (int n = 0; n < 2; ++n) acc[a][b][m][n] = (f32x4){0.f, 0.f, 0.f, 0.f};
        cur = nxt; cA = nA; cB = nB; ++ui;
        if (wr == 1) R5_BAR;
    }
    R5_WAIT_V(0);
    R5_BAR;
#undef R5_SB
#undef R5_STAGE_A
#undef R5_STAGE_B
#undef R5_LDA
#undef R5_LDB
#undef R5_MMA
#undef R5_WAIT_V
#undef R5_WAIT_L
#undef R5_WAIT_VF
#undef R5_BAR
#undef R5_SCHED
}
}
#define GAS __attribute__((address_space(1)))
#define LAS __attribute__((address_space(3)))
typedef unsigned short bf16;
typedef unsigned v4u __attribute__((ext_vector_type(4)));
typedef float f32x4 __attribute__((ext_vector_type(4)));
typedef short bf16x8 __attribute__((ext_vector_type(8)));
typedef GAS unsigned gu32;
typedef GAS unsigned long long gu64;
#define RLX_AGENT __ATOMIC_RELAXED, __HIP_MEMORY_SCOPE_AGENT
#define LDS_WAIT() asm volatile("s_waitcnt lgkmcnt(0)" ::: "memory")
#define VM_WAIT() asm volatile("s_waitcnt vmcnt(0)" ::: "memory")
__device__ __forceinline__ unsigned long long rt() { return __builtin_amdgcn_s_memrealtime(); }
__device__ __forceinline__ unsigned f2bf(float f) { unsigned u = __builtin_bit_cast(unsigned, f); return (u + 0x7fffu + ((u >> 16) & 1u)) >> 16; }
__device__ __forceinline__ unsigned pk2(float lo, float hi) { return f2bf(lo) | (f2bf(hi) << 16); }

#define XB_TMO      128
#define XB_XCNT(j)  (256  + 64 * (j))
#define XB_XSUB(j)  (1280 + 64 * (j))
#define XB_XGEN(j)  (2304 + 64 * (j))
#define XB_TOP      3328
#define XB_TOPGEN   3392
#define XCD_BAR_WORDS 3456
#define XB_SPIN_CAP (1u << 18)

__device__ __forceinline__ unsigned xb_ld(unsigned* p)              { return __hip_atomic_load(p, __ATOMIC_RELAXED, __HIP_MEMORY_SCOPE_AGENT); }
__device__ __forceinline__ unsigned xb_add(unsigned* p, unsigned v) { return __hip_atomic_fetch_add(p, v, __ATOMIC_RELAXED, __HIP_MEMORY_SCOPE_AGENT); }
__device__ __forceinline__ unsigned xb_xcc_id() { return (unsigned)__builtin_amdgcn_s_getreg((3 << 11) | 20) & 0xFu; }
#define XB_SPIN(cond, bar) do { unsigned _sp = 0; while (cond) { __builtin_amdgcn_s_sleep(1); \
    if ((++_sp & 255u) == 0u) { if (xb_ld(&(bar)[XB_TMO])) break; if (_sp > XB_SPIN_CAP) { atomicAdd(&(bar)[XB_TMO], 1u); break; } } } } while (0)

struct XcdBarrier {
    unsigned* bar; unsigned x;
    volatile LAS unsigned* st;
};

__device__ __forceinline__ XcdBarrier xcd_barrier_post(unsigned* bar, volatile LAS unsigned* st) {
    XcdBarrier b; b.bar = bar; b.x = xb_xcc_id(); b.st = st;
    if (threadIdx.x == 0) (void)xb_add(&bar[XB_XCNT(b.x)], 1u);
    return b;
}
__device__ __forceinline__ void xcd_barrier_complete(unsigned* bar, unsigned x, unsigned& nloc, unsigned& nx) {
    const unsigned G = gridDim.x * gridDim.y * gridDim.z;
    unsigned sum, cnt, mine, sp = 0u;
    for (;;) {
        sum = 0u; cnt = 0u; mine = 0u;
#pragma unroll
        for (unsigned j = 0; j < 16; ++j) { const unsigned c = xb_ld(&bar[XB_XCNT(j)]); sum += c; cnt += (c > 0u) ? 1u : 0u; mine = (j == x) ? c : mine; }
        if (sum == G) break;
        __builtin_amdgcn_s_sleep(1);
        if ((++sp & 255u) == 0u) { if (xb_ld(&bar[XB_TMO])) break; if (sp > XB_SPIN_CAP) { atomicAdd(&bar[XB_TMO], 1u); break; } }
    }
    nloc = mine > 0u ? mine : 1u; nx = cnt > 0u ? cnt : 1u;
}

__device__ __forceinline__ void xcd_barrier(const XcdBarrier& b) {
    asm volatile("s_waitcnt vmcnt(0)" ::: "memory");
    __syncthreads();
    if (threadIdx.x == 0) {
        unsigned* bar = b.bar;
        __builtin_amdgcn_s_waitcnt(0);
        unsigned nloc = b.st[0], nx = b.st[1];
        if (nloc == 0u) { xcd_barrier_complete(bar, b.x, nloc, nx); b.st[0] = nloc; b.st[1] = nx; }
        const unsigned old = xb_add(&bar[XB_XSUB(b.x)], 1u);
        const unsigned gen = old / nloc;
        if (old + 1u == (gen + 1u) * nloc) {
            __builtin_amdgcn_fence(__ATOMIC_RELEASE, "agent");
            asm volatile("s_waitcnt vmcnt(0)" ::: "memory");
            const unsigned og = xb_add(&bar[XB_TOP], 1u);
            const unsigned tg = og / nx;
            if (og + 1u == (tg + 1u) * nx) xb_add(&bar[XB_TOPGEN], 1u);
            else XB_SPIN(xb_ld(&bar[XB_TOPGEN]) == tg, bar);
            __builtin_amdgcn_fence(__ATOMIC_ACQUIRE, "agent");
            xb_add(&bar[XB_XGEN(b.x)], 1u);
            asm volatile("s_waitcnt vmcnt(0)" ::: "memory");
        } else {
            XB_SPIN(xb_ld(&bar[XB_XGEN(b.x)]) == gen, bar);
            __builtin_amdgcn_fence(__ATOMIC_ACQUIRE, "agent");
            asm volatile("s_waitcnt vmcnt(0)" ::: "memory");
        }
    }
    __syncthreads();
}
#ifndef FF2_RING5
#define FF2_RING5 1
#endif
#ifndef FF2_REV
#define FF2_REV 1
#endif
#ifndef W2_TILED
#define W2_TILED 1
#endif
constexpr int NWAVES = 8;
constexpr int M_TOK = 98304, M_PROMPT = 65536, D = 1024, NP = 3584, NWIN = 3616, FF = 4096;
constexpr int L_PROMPT = 2048, L_SAMPLE = 16384;
constexpr float EPS = 1e-6f;
constexpr size_t MiB = 1u << 20;
constexpr size_t WS_CTL = 0, CTL_ZERO_BYTES = 1 * MiB;
constexpr size_t WS_WIN = 1 * MiB;
constexpr size_t WS_WOUT = 9 * MiB;
constexpr size_t WS_W1 = 11 * MiB;
constexpr size_t WS_W2 = 19 * MiB;
constexpr size_t WS_ROPE = 27 * MiB;
constexpr size_t WS_GA = 35 * MiB;
constexpr size_t WS_RSTD = 47 * MiB;
constexpr size_t WS_SQ1 = 48 * MiB;
constexpr size_t WS_SQ2 = 54 * MiB;
constexpr size_t WS_DEC = 60 * MiB;
constexpr size_t WS_R0 = 64 * MiB;
constexpr size_t WS_R1 = 256 * MiB;
constexpr size_t WS_ST = 1024 * MiB;
constexpr size_t WS_A2 = 1216 * MiB;
constexpr size_t WS_END = 1408 * MiB;
constexpr int CW_BAR = 4096;
constexpr int RING_OFF = 0, RING_BYTES = 131072;
constexpr int LDSCTL_OFF = 147456, MISC_OFF = LDSCTL_OFF + 320;
constexpr int LDS_BYTES = 147456 + 1024;

struct Frame {
    LAS unsigned char* lds;
    volatile LAS unsigned* MISC;
    int tid, lane, wave, vcu, G;
};
__device__ __forceinline__ float wave_sum(float v) {
#pragma unroll
    for (int o = 1; o < 64; o <<= 1) v += __shfl_xor(v, o);
    return v;
}
__device__ __forceinline__ float bf2f(bf16 b) { return __uint_as_float((unsigned)b << 16); }
__device__ __forceinline__ unsigned cvtpk(float lo, float hi) { unsigned r; asm volatile("v_cvt_pk_bf16_f32 %0, %1, %2" : "=v"(r) : "v"(lo), "v"(hi)); return r; }

__device__ __forceinline__ void win_map(int nd, int& sc, float& cs) {
    cs = 1.f;
    if (nd < 512) sc = 512 + nd;
    else if (nd < 1024) sc = 2592 + (nd - 512);
    else if (nd < 1280) { sc = nd - 1024; cs = 0.125f; }
    else if (nd < 1536) sc = 256 + (nd - 1280);
    else if (nd < 2048) sc = 1024 + (nd - 1536);
    else if (nd < 3072) {
        const bool isq = nd < 2560; const int p = nd - (isq ? 2048 : 2560), h = p >> 7, pp = p & 127, u = pp >> 3, j = pp & 7;
        const int d = (j < 4) ? 4 * u + j : 64 + 4 * u + (j - 4);
        sc = (isq ? 1568 : 2080) + 128 * h + d; if (isq) cs = 0.08838834764831845f; }
    else if (nd < 3584) sc = 3104 + (nd - 3072);
    else sc = 1536 + (nd - 3584);
}
template <bool MAP, bool TILED = false>
__device__ __forceinline__ void p0_transpose_item(const float* W, int K, int Nsrc, int nblk, const float* ks, bf16* WT, LAS float* scr, int item, int lane) {
    const int kb = item / nblk, nb = item % nblk, k0 = 64 * kb, n0 = 32 * nb;
    int sc = n0 + (lane & 31); float cs = 1.f;
    if (MAP) win_map(n0 + (lane & 31), sc, cs);
#pragma unroll 8
    for (int i = 0; i < 32; ++i) { const int kk = 2 * i + (lane >> 5); float w = W[(size_t)(k0 + kk) * Nsrc + sc] * cs; if (ks) w *= ks[k0 + kk]; scr[kk * 33 + (lane & 31)] = w; }
    LDS_WAIT(); asm volatile("" ::: "memory");
    const int c = lane & 7;
#pragma unroll
    for (int j = 0; j < 4; ++j) { const int n = (lane >> 3) + 8 * j; const LAS float* s = scr + (8 * c) * 33 + n;
        v4u o; o.x = cvtpk(s[0 * 33], s[1 * 33]); o.y = cvtpk(s[2 * 33], s[3 * 33]); o.z = cvtpk(s[4 * 33], s[5 * 33]); o.w = cvtpk(s[6 * 33], s[7 * 33]);
        if (TILED) { const int nn = n0 + n; *(GAS v4u*)(WT + (((size_t)(nn >> 8) * (K >> 6) + (k0 >> 6)) * 256 + (nn & 255)) * 64 + 8 * c) = o; }
        else *(GAS v4u*)(WT + (size_t)(n0 + n) * K + k0 + 8 * c) = o; }
    LDS_WAIT(); asm volatile("" ::: "memory");
}
__device__ __forceinline__ void rope_entry(int e, float* rcos, float* rsin) {
    const int pos = e >> 6, i = e & 63;
    double inv = 1.0, b = 0.8659643233600653;
#pragma unroll
    for (int bit = 0; bit < 6; ++bit) { if ((i >> bit) & 1) inv *= b; b *= b; }
    const double ang = (double)pos * inv;
    const double n = __builtin_rint(ang * 0.6366197723675814);
    double r = __builtin_fma(-n, 1.5707963267948966, ang); r = __builtin_fma(-n, 6.123233995736766e-17, r);
    const double r2 = r * r;
    double s = -1.0 / 1307674368000.0;
    s = s * r2 + 1.0 / 6227020800.0; s = s * r2 - 1.0 / 39916800.0; s = s * r2 + 1.0 / 362880.0; s = s * r2 - 1.0 / 5040.0; s = s * r2 + 1.0 / 120.0; s = s * r2 - 1.0 / 6.0; s = s * r2 * r + r;
    double c = 1.0 / 20922789888000.0;
    c = c * r2 - 1.0 / 87178291200.0; c = c * r2 + 1.0 / 479001600.0; c = c * r2 - 1.0 / 3628800.0; c = c * r2 + 1.0 / 40320.0; c = c * r2 - 1.0 / 720.0; c = c * r2 + 1.0 / 24.0; c = c * r2 - 0.5; c = c * r2 + 1.0;
    const int q = ((int)n) & 3;
    const double cs = (q == 0) ? c : (q == 1) ? -s : (q == 2) ? -c : s;
    const double sn = (q == 0) ? s : (q == 1) ? c : (q == 2) ? -s : -c;
    rcos[e] = (float)cs; rsin[e] = (float)sn;
}
struct P0Args { const float *xp, *xs, *anw, *win, *wout, *mnw, *w1, *w2; bf16 *Win_t, *Wout_t, *W1_t, *W2_t, *Xb; float *rcos, *rsin, *ga, *rstd; };
__device__ __forceinline__ void p0_prologue(Frame& F, const P0Args& a, int parts = 3) {
    LAS float* scr = (LAS float*)(F.lds + RING_OFF + F.wave * 16384);
    const int gw = F.vcu * NWAVES + F.wave, NGW = F.G * NWAVES;
    constexpr int I_IN = (D / 64) * (NWIN / 32), I_O = (D / 64) * (D / 32), I_1 = (D / 64) * (FF / 32), I_2 = (FF / 64) * (D / 32);
    constexpr int NITEMS = I_IN + I_O + I_1 + I_2;
    if (parts & 1) for (int it = gw; it < NITEMS; it += NGW) {
        int r = it;
        if (r < I_IN) { p0_transpose_item<true>(a.win, D, NWIN, NWIN / 32, a.anw, a.Win_t, scr, r, F.lane); continue; } r -= I_IN;
        if (r < I_O) { p0_transpose_item<false>(a.wout, D, D, D / 32, nullptr, a.Wout_t, scr, r, F.lane); continue; } r -= I_O;
        if (r < I_1) { p0_transpose_item<false>(a.w1, D, FF, FF / 32, a.mnw, a.W1_t, scr, r, F.lane); continue; } r -= I_1;
        p0_transpose_item<false, W2_TILED != 0>(a.w2, FF, D, D / 32, nullptr, a.W2_t, scr, r, F.lane);
    }
    if (parts & 1) for (int e = (blockIdx.x * NWAVES * 64) + F.tid; e < 16384 * 64; e += F.G * NWAVES * 64) rope_entry(e, a.rcos, a.rsin);
    __syncthreads();
    LAS bf16* wl = (LAS bf16*)(F.lds + RING_OFF);
    { const int c = F.tid & 31, kb = F.tid >> 5;
#pragma unroll 1
      for (int b = 0; b < 4; ++b) { float wv[16], av[16];
#pragma unroll
          for (int j = 0; j < 16; ++j) { const int k = kb + 16 * (16 * b + j); wv[j] = a.win[(size_t)k * NWIN + 1536 + c]; av[j] = a.anw[k]; }
          __builtin_amdgcn_sched_barrier(0);
#pragma unroll
          for (int j = 0; j < 16; ++j) { const int k = kb + 16 * (16 * b + j); wl[c * 1032 + k] = (bf16)(cvtpk(wv[j] * av[j], 0.f) & 0xffffu); } } }
    __syncthreads();
    const int r = F.lane & 15, g = F.lane >> 4;
    LAS unsigned char* tl = F.lds + RING_OFF + 66048 + F.wave * 8448;
    if (parts & 2) {
        f32x4 xa[16], xb[16];
#define P0_LOAD(dst, it_, kc_) do { const int r0_ = (it_) * 16; const float* xp_ = (r0_ < M_PROMPT ? a.xp + (size_t)r0_ * D : a.xs + (size_t)(r0_ - M_PROMPT) * D) + 4 * F.lane + 256 * (kc_); \
            _Pragma("unroll") for (int rr = 0; rr < 16; ++rr) dst[rr] = *(const GAS f32x4*)(xp_ + (size_t)rr * D); } while (0)
#define P0_PROC(src, kc_) do { \
            _Pragma("unroll") for (int rr = 0; rr < 16; ++rr) { unsigned long long pk = (unsigned long long)cvtpk(src[rr][0], src[rr][1]) | ((unsigned long long)cvtpk(src[rr][2], src[rr][3]) << 32); \
                *(LAS unsigned long long*)(tl + rr * 528 + F.lane * 8) = pk; *(GAS unsigned long long*)(xo + (size_t)rr * D + 256 * (kc_)) = pk; } \
            asm volatile("s_waitcnt lgkmcnt(0)" ::: "memory"); \
            _Pragma("unroll") for (int s8 = 0; s8 < 8; ++s8) { \
                const bf16x8 af = *(const LAS bf16x8*)(tl + r * 528 + 64 * s8 + 16 * g); \
                const int k0 = 256 * (kc_) + 32 * s8 + 8 * g; \
                const bf16x8 b0 = *(const LAS bf16x8*)(wl + r * 1032 + k0), b1 = *(const LAS bf16x8*)(wl + (16 + r) * 1032 + k0); \
                acc0 = __builtin_amdgcn_mfma_f32_16x16x32_bf16(af, b0, acc0, 0, 0, 0); acc1 = __builtin_amdgcn_mfma_f32_16x16x32_bf16(af, b1, acc1, 0, 0, 0); \
                const v4u aw = __builtin_bit_cast(v4u, af); \
                _Pragma("unroll") for (int j = 0; j < 4; ++j) { const unsigned u = ((const unsigned*)&aw)[j]; const float lo = __uint_as_float(u << 16), hi = __uint_as_float(u & 0xffff0000u); ss += lo * lo + hi * hi; } } \
            asm volatile("s_waitcnt lgkmcnt(0)" ::: "memory"); } while (0)
        if (gw < M_TOK / 16) P0_LOAD(xa, gw, 0);
        for (int item = gw; item < M_TOK / 16; item += NGW) {
            const int row0 = item * 16;
            bf16* xo = a.Xb + (size_t)row0 * D + 4 * F.lane;
            f32x4 acc0 = {0.f, 0.f, 0.f, 0.f}, acc1 = {0.f, 0.f, 0.f, 0.f}; float ss = 0.f;
            const int nitem = item + NGW < M_TOK / 16 ? item + NGW : item;
            P0_LOAD(xb, item, 1); __builtin_amdgcn_sched_barrier(0); P0_PROC(xa, 0); __builtin_amdgcn_sched_barrier(0);
            P0_LOAD(xa, item, 2); __builtin_amdgcn_sched_barrier(0); P0_PROC(xb, 1); __builtin_amdgcn_sched_barrier(0);
            P0_LOAD(xb, item, 3); __builtin_amdgcn_sched_barrier(0); P0_PROC(xa, 2); __builtin_amdgcn_sched_barrier(0);
            P0_LOAD(xa, nitem, 0); __builtin_amdgcn_sched_barrier(0); P0_PROC(xb, 3); __builtin_amdgcn_sched_barrier(0);
            ss += __shfl_xor(ss, 16); ss += __shfl_xor(ss, 32);
            const float rs = 1.0f / sqrtf(ss * (1.0f / 1024.0f) + EPS);
            if (g == 0) a.rstd[row0 + r] = rs;
#pragma unroll
            for (int q = 0; q < 4; ++q) { const int rr = 4 * g + q; const float rq = __shfl(rs, rr);
                a.ga[(size_t)(row0 + rr) * 32 + r] = acc0[q] * rq; a.ga[(size_t)(row0 + rr) * 32 + 16 + r] = acc1[q] * rq; }
        }
#undef P0_LOAD
#undef P0_PROC
    }
}

__device__ __forceinline__ float log_sigmoid_f(float z) { return fminf(z, 0.f) - log1pf(expf(-fabsf(z))); }
struct MixArgs { bf16* proj; const float* ga; const float *waf, *baf, *wab, *bab; float* of; const float *gnw, *rnw, *rnb; };
constexpr int NTB = 16;
template <int DK, bool GLA, bool BWD>
__device__ __forceinline__ void naive_sweep(Frame& F, const MixArgs& a, int job) {
    const int grp = F.tid >> 7, gt = F.tid & 127;
    int seq, head; if (job < 16) { seq = 32 + (job >> 3); head = job & 7; } else { seq = (job - 16) >> 3; head = (job - 16) & 7; }
    const int L = seq < 32 ? L_PROMPT : L_SAMPLE, row_base = seq < 32 ? seq * L_PROMPT : M_PROMPT + (seq - 32) * L_SAMPLE;
    const int hh = GLA ? head : head - 4;
    const int qcol = GLA ? 1024 + 64 * hh : 2048 + 128 * hh, kcol = GLA ? 1280 + 64 * hh : 2560 + 128 * hh, vcol = 128 * head;
    LAS float* sq = (LAS float*)(F.lds + grp * (3 * NTB * 128 * 4)); LAS float* sk = sq + NTB * DK; LAS float* sa = sk + NTB * DK;
    const float gam = 1.0f - exp2f(-5.0f - (float)hh);
    const float* wal = BWD ? a.wab : a.waf; const float* bal = BWD ? a.bab : a.baf;
    float S[DK];
#pragma unroll
    for (int t = 0; t < DK; ++t) S[t] = 0.f;
    for (int t0 = 0; t0 < L; t0 += NTB) {
        __syncthreads();
        for (int e = gt; e < NTB * DK; e += 128) {
            const int tok = e / DK, t = e % DK, tp = t0 + tok, row = row_base + (BWD ? L - 1 - tp : tp);
            const bf16* pr = a.proj + (size_t)row * NP;
            sq[e] = bf2f(pr[qcol + t]); sk[e] = bf2f(pr[kcol + t]);
            if (GLA) { const float* gar = a.ga + (size_t)row * 32 + (BWD ? 16 : 0); float z = bal[64 * hh + t];
#pragma unroll
                for (int r = 0; r < 16; ++r) z += gar[r] * wal[r * 256 + 64 * hh + t];
                sa[e] = expf(fmaxf(log_sigmoid_f(z) * (1.0f / 16.0f), -1.0f)); }
        }
        __syncthreads();
        for (int tok = 0; tok < NTB; ++tok) {
            const int tp = t0 + tok, row = row_base + (BWD ? L - 1 - tp : tp);
            const float vv = bf2f(a.proj[(size_t)row * NP + vcol + gt]);
            float o = 0.f;
#pragma unroll
            for (int t4 = 0; t4 < DK / 4; ++t4) {
                const f32x4 q = *(const LAS f32x4*)(sq + tok * DK + 4 * t4), k = *(const LAS f32x4*)(sk + tok * DK + 4 * t4);
                f32x4 al = {gam, gam, gam, gam}; if (GLA) al = *(const LAS f32x4*)(sa + tok * DK + 4 * t4);
#pragma unroll
                for (int j = 0; j < 4; ++j) {
                    if (!BWD) { S[4 * t4 + j] = al[j] * S[4 * t4 + j] + k[j] * vv; o += q[j] * S[4 * t4 + j]; }
                    else { S[4 * t4 + j] *= al[j]; o += q[j] * S[4 * t4 + j]; S[4 * t4 + j] += k[j] * vv; }
                }
            }
            float* op = a.of + (size_t)row * D + 128 * head + gt;
            if (!BWD) *op = o; else *op += o;
        }
    }
}
template <bool BWD>
__device__ __forceinline__ void naive_mix_phase(Frame& F, const MixArgs& a) {
    if (blockIdx.x >= 68) return;
    const int job = blockIdx.x * 4 + (F.tid >> 7);
    if ((blockIdx.x & 1) == 0) { if (!MIX_GLA) naive_sweep<64, true, BWD>(F, a, job); } else { if (!MIX_RET) naive_sweep<128, false, BWD>(F, a, job); }
}
__device__ __forceinline__ void naive_combine(Frame& F, const MixArgs& a) {
    const int gw = F.vcu * NWAVES + F.wave, NGW = F.G * NWAVES, c = 2 * F.lane;
    for (int item = gw; item < M_TOK * 8; item += NGW) {
        const int row = item >> 3, head = item & 7;
        if (head < 4 ? MIX_GLA : MIX_RET) continue;
        const float* op = a.of + (size_t)row * D + 128 * head + c;
        float o0 = op[0], o1 = op[1], y0, y1;
        if (head < 4) { const float r = 1.0f / sqrtf(wave_sum(o0 * o0 + o1 * o1) * (1.0f / 128.0f) + EPS); y0 = o0 * r * a.gnw[c]; y1 = o1 * r * a.gnw[c + 1]; }
        else { const float mu = wave_sum(o0 + o1) * (1.0f / 128.0f); o0 -= mu; o1 -= mu; const float r = 1.0f / sqrtf(wave_sum(o0 * o0 + o1 * o1) * (1.0f / 128.0f) + EPS);
            const int cc = 128 * (head - 4) + c; y0 = o0 * r * a.rnw[cc] + a.rnb[cc]; y1 = o1 * r * a.rnw[cc + 1] + a.rnb[cc + 1]; }
        bf16* pr = a.proj + (size_t)row * NP;
        const int gcol = (head < 4 ? 1536 + 128 * head : 3072 + 128 * (head - 4)) + c;
        const unsigned gw2 = *(const unsigned*)(pr + gcol);
        const float g0 = __uint_as_float(gw2 << 16), g1 = __uint_as_float(gw2 & 0xffff0000u);
        y0 *= g0 / (1.0f + expf(-g0)); y1 *= g1 / (1.0f + expf(-g1));
        *(unsigned*)(pr + 128 * head + c) = cvtpk(y0, y1);
    }
}
__device__ __forceinline__ void final_norm(Frame& F, float* out, const bf16* x2b, const float* sq, const float* w) {
    const int gw = F.vcu * NWAVES + F.wave, NGW = F.G * NWAVES;
    const f32x4* w4 = (const f32x4*)w + 2 * F.lane;
    f32x4 wv[2][2];
#pragma unroll
    for (int j = 0; j < 2; ++j) { wv[j][0] = w4[128 * j]; wv[j][1] = w4[128 * j + 1]; }
    for (int r0 = 4 * gw; r0 < M_TOK; r0 += 4 * NGW) {
        v4u xw[4][2]; f32x4 s4[4];
#pragma unroll
        for (int k = 0; k < 4; ++k) { const int row = r0 + k;
            s4[k] = *(const GAS f32x4*)(sq + (size_t)row * 16 + 4 * (F.lane & 3));
            const GAS v4u* xi = (const GAS v4u*)(x2b + (size_t)row * D) + F.lane;
            xw[k][0] = xi[0]; xw[k][1] = xi[64]; }
#pragma unroll
        for (int k = 0; k < 4; ++k) { const int row = r0 + k;
            float t = (s4[k][0] + s4[k][1]) + (s4[k][2] + s4[k][3]); t += __shfl_xor(t, 1); t += __shfl_xor(t, 2);
            const float r = 1.0f / sqrtf(t * (1.0f / 1024.0f) + EPS);
            GAS f32x4* o = (GAS f32x4*)(out + (size_t)row * D) + 2 * F.lane;
#pragma unroll
            for (int j = 0; j < 2; ++j) { const v4u x = xw[k][j];
                const f32x4 x0 = {__uint_as_float(x.x << 16), __uint_as_float(x.x & 0xffff0000u), __uint_as_float(x.y << 16), __uint_as_float(x.y & 0xffff0000u)};
                const f32x4 x1 = {__uint_as_float(x.z << 16), __uint_as_float(x.z & 0xffff0000u), __uint_as_float(x.w << 16), __uint_as_float(x.w & 0xffff0000u)};
                o[128 * j] = x0 * r * wv[j][0]; o[128 * j + 1] = x1 * r * wv[j][1]; } }
    }
}

typedef __bf16 bf16v2 __attribute__((ext_vector_type(2)));
typedef unsigned u32x2 __attribute__((ext_vector_type(2)));
__device__ __forceinline__ unsigned cvtpk_c(float lo, float hi) { bf16v2 v = {(__bf16)lo, (__bf16)hi}; return __builtin_bit_cast(unsigned, v); }
__device__ __forceinline__ float bflo(unsigned w) { return __uint_as_float(w << 16); }
__device__ __forceinline__ float bfhi(unsigned w) { return __uint_as_float(w & 0xffff0000u); }
__device__ __forceinline__ int opaque_i(int x) { asm volatile("" : "+v"(x)); return x; }
typedef short s16x4 __attribute__((ext_vector_type(4)));
#define TRRD(ptr) __builtin_amdgcn_ds_read_tr16_b64_v4i16((LAS s16x4*)(ptr))
constexpr size_t ST_SC_BYTES = 393216;
__device__ __forceinline__ size_t state_off(int sc, bool gla, int hh, int dir) { return (size_t)sc * ST_SC_BYTES + (gla ? (size_t)(hh * 2 + dir) * 16384 : (size_t)131072 + (size_t)(hh * 2 + dir) * 32768); }
typedef _Float16 bh16;
__device__ __forceinline__ float h2f(unsigned w, int hi) { return (float)__builtin_bit_cast(bh16, (unsigned short)(hi ? (w >> 16) : (w & 0xffffu))); }
struct CMixArgs { bf16* proj; const float* ga; const float *waf, *baf, *wab, *bab; unsigned char* st; float* dec; const float *gnw, *rnw, *rnb; bf16* mo; int mop; unsigned char* sto; unsigned char* ofs; bh16* bb0; bh16* bb1; float* gv; };
constexpr int OB_PITCH = 132;

template <bool GLA> struct RawSet;
template <> struct RawSet<true> { v4u q, k, v0, v1, bh, lh; };
template <> struct RawSet<false> { v4u q0, q1, k0, k1, v0, v1; };

template <bool GLA, bool WITH_O>
__device__ __forceinline__ void raw_load(RawSet<GLA>& R, const CMixArgs& a, int p, int s, int w, int lane0) {
    const int lane = opaque_i(lane0), sc = p >> 2, hh = p & 3, dir = s >> 2, c = dir ? 7 - s : s;
    const size_t row = (size_t)(sc * 256 + 64 * c + 8 * w + (lane >> 3)); const int pc = lane & 7;
    if constexpr (GLA) {
        if (WITH_O) R.q = *(const GAS v4u*)(a.proj + pg8::pl(pg8::PL_GQ, hh, row, 64) + 8 * pc);
        R.k = *(const GAS v4u*)(a.proj + pg8::pl(pg8::PL_GK, hh, row, 64) + 8 * pc);
        const bf16* pv = a.proj + pg8::pl(pg8::PL_GV, hh, row, 128) + 8 * pc;
        R.v0 = *(const GAS v4u*)pv; R.v1 = *(const GAS v4u*)(pv + 64);
        const bh16* bp = (dir ? a.bb1 : a.bb0) + ((size_t)(p * 4 + c) * 64) * 64 + 8 * pc;
        const int ti = 8 * w + (lane >> 3);
        R.bh = *(const GAS v4u*)(bp + ti * 64); R.lh = *(const GAS v4u*)(bp + (dir ? 0 : 63) * 64);
    } else {
        if (WITH_O) { const bf16* pq = a.proj + pg8::pl(pg8::PL_RQ, hh, row, 128) + 8 * pc; R.q0 = *(const GAS v4u*)pq; R.q1 = *(const GAS v4u*)(pq + 64); }
        const bf16* pk = a.proj + pg8::pl(pg8::PL_RK, hh, row, 128) + 8 * pc; R.k0 = *(const GAS v4u*)pk; R.k1 = *(const GAS v4u*)(pk + 64);
        const bf16* pv = a.proj + pg8::pl(pg8::PL_RV, hh, row, 128) + 8 * pc; R.v0 = *(const GAS v4u*)pv; R.v1 = *(const GAS v4u*)(pv + 64);
    }
}

template <int DK, bool GLA, bool WITH_O> struct MixLds {
    static constexpr int NT = DK / 16, NS = DK / 32;
    static constexpr int RQ = DK * 2 + 16, RP = 144, RV = 272;
    static constexpr int O_QD = 0, O_KI = 64 * RQ, O_KE = 2 * 64 * RQ, O_PB = 3 * 64 * RQ, O_VB = O_PB + 64 * RP, O_DC = O_VB + 64 * RV, O_WAL = O_DC + DK * 4,
                         O_OB = O_WAL, O_END = O_OB + 64 * OB_PITCH * 4;
    static_assert(O_END <= 146432, "mixer LDS map");
};

template <int DK, bool GLA, bool WITH_O>
__device__ __forceinline__ void mix_step(Frame& F, const CMixArgs& a, int p, int s, int pnext, RawSet<GLA>& R, f32x4 (&S)[DK / 16], float (&dsum)[8], u32x2 (&ofp)[4][4]) {
    typedef MixLds<DK, GLA, WITH_O> ML;
    constexpr int NT = ML::NT, NS = ML::NS, RQ = ML::RQ, RP = ML::RP, RV = ML::RV;
    LAS unsigned char* L = F.lds;
    const int lane0 = F.lane, w = F.wave;
    const int sc = p >> 2, hh = p & 3, dir = s >> 2, c = dir ? 7 - s : s, row0 = sc * 256, head = GLA ? hh : 4 + hh, vcol = 128 * head;
    __syncthreads();
    {
        const int lane = opaque_i(lane0), i = 8 * w + (lane >> 3), pc = lane & 7;
        *(LAS v4u*)(L + ML::O_VB + i * RV + 16 * pc) = R.v0; *(LAS v4u*)(L + ML::O_VB + i * RV + 128 + 16 * pc) = R.v1;
        if constexpr (GLA) {
            const int tk = lane >> 3;
            float q8[8], k8[8], e8[8];
#pragma unroll
            for (int e = 0; e < 8; ++e) { const float b = h2f(((const unsigned*)&R.bh)[e >> 1], e & 1), bl_ = h2f(((const unsigned*)&R.lh)[e >> 1], e & 1);
                const unsigned wq = WITH_O ? ((const unsigned*)&R.q)[e >> 1] : 0u, wk = ((const unsigned*)&R.k)[e >> 1];
                const float qv = (e & 1) ? bfhi(wq) : bflo(wq), kv = (e & 1) ? bfhi(wk) : bflo(wk);
                q8[e] = qv * __expf(b); k8[e] = kv * __expf(-b); e8[e] = kv * __expf(bl_ - b);
                if (!WITH_O) dsum[e] += bl_;
                if (w == 0 && tk == 0) ((LAS float*)(L + ML::O_DC))[8 * pc + e] = __expf(bl_); }
            v4u oq, ok, oe;
            oq.x = cvtpk_c(q8[0], q8[1]); oq.y = cvtpk_c(q8[2], q8[3]); oq.z = cvtpk_c(q8[4], q8[5]); oq.w = cvtpk_c(q8[6], q8[7]);
            ok.x = cvtpk_c(k8[0], k8[1]); ok.y = cvtpk_c(k8[2], k8[3]); ok.z = cvtpk_c(k8[4], k8[5]); ok.w = cvtpk_c(k8[6], k8[7]);
            oe.x = cvtpk_c(e8[0], e8[1]); oe.y = cvtpk_c(e8[2], e8[3]); oe.z = cvtpk_c(e8[4], e8[5]); oe.w = cvtpk_c(e8[6], e8[7]);
            if (WITH_O) { *(LAS v4u*)(L + ML::O_QD + i * RQ + 16 * pc) = oq; *(LAS v4u*)(L + ML::O_KI + i * RQ + 16 * pc) = ok; }
            *(LAS v4u*)(L + ML::O_KE + i * RQ + 16 * pc) = oe;
        } else {
            const float l2g = hh == 0 ? -0.045803689613124f : hh == 1 ? -0.022720076500083f : hh == 2 ? -0.011315313227834f : -0.005646563141142f;
            const float nq = dir ? (float)(64 - i) : (float)(i + 1), ne = dir ? (float)i : (float)(63 - i);
            const float eb = exp2f(l2g * nq), ei = exp2f(-l2g * nq), ee = exp2f(l2g * ne);
#pragma unroll
            for (int x = 0; x < 2; ++x) { v4u oq, ok, oe; const v4u rq = x ? R.q1 : R.q0, rk = x ? R.k1 : R.k0;
#pragma unroll
                for (int j = 0; j < 4; ++j) { const unsigned wq = WITH_O ? ((const unsigned*)&rq)[j] : 0u, wk = ((const unsigned*)&rk)[j];
                    ((unsigned*)&oq)[j] = cvtpk_c(bflo(wq) * eb, bfhi(wq) * eb); ((unsigned*)&ok)[j] = cvtpk_c(bflo(wk) * ei, bfhi(wk) * ei); ((unsigned*)&oe)[j] = cvtpk_c(bflo(wk) * ee, bfhi(wk) * ee); }
                if (WITH_O) { *(LAS v4u*)(L + ML::O_QD + i * RQ + 128 * x + 16 * pc) = oq; *(LAS v4u*)(L + ML::O_KI + i * RQ + 128 * x + 16 * pc) = ok; }
                *(LAS v4u*)(L + ML::O_KE + i * RQ + 128 * x + 16 * pc) = oe; }
            if (w == 0 && lane < 32) *(LAS f32x4*)(L + ML::O_DC + lane * 16) = (f32x4){exp2f(l2g * 64.0f), exp2f(l2g * 64.0f), exp2f(l2g * 64.0f), exp2f(l2g * 64.0f)};
        }
    }
    v4u gt0, gt1; f32x4 nw[4], nb[4];
    if (WITH_O) { const int lane = opaque_i(lane0);
        const bf16* gp = a.proj + (dir ? pg8::pl(GLA ? pg8::PL_GG : pg8::PL_RG, hh, (size_t)(row0 + 64 * c + 8 * w + (lane >> 3)), 128) + 16 * (lane & 7) : pg8::pl(GLA ? pg8::PL_GG : pg8::PL_RG, 0, (size_t)0, 128));
        gt0 = *(const GAS v4u*)gp; gt1 = *(const GAS v4u*)(gp + 8);
        const float* wp = GLA ? a.gnw + 16 * (lane & 7) : a.rnw + 128 * hh + 16 * (lane & 7);
#pragma unroll
        for (int k = 0; k < 4; ++k) { nw[k] = *(const GAS f32x4*)(wp + 4 * k); if (!GLA) nb[k] = *(const GAS f32x4*)(a.rnb + 128 * hh + 16 * (lane & 7) + 4 * k); } }
    raw_load<GLA, WITH_O>(R, a, s < 6 ? p : (pnext < 1536 ? pnext : p), s < 6 ? s + 2 : s - 6, w, lane0);
    __syncthreads();
    if (WITH_O) {
        const int lane = opaque_i(lane0), g = lane >> 4, lr = lane & 15;
        const int mi = w >> 1;
        bf16x8 kf[2][NS], qf2[NS];
#pragma unroll
        for (int s2 = 0; s2 < NS; ++s2) { qf2[s2] = *(const LAS bf16x8*)(L + ML::O_QD + (16 * mi + lr) * RQ + 64 * s2 + 16 * g);
#pragma unroll
            for (int jj = 0; jj < 2; ++jj) kf[jj][s2] = *(const LAS bf16x8*)(L + ML::O_KI + (16 * (2 * (w & 1) + jj) + lr) * RQ + 64 * s2 + 16 * g); }
        __builtin_amdgcn_sched_barrier(0);
#pragma unroll
        for (int jj = 0; jj < 2; ++jj) { const int nj = 2 * (w & 1) + jj;
            f32x4 acc = {0.f, 0.f, 0.f, 0.f};
#pragma unroll
            for (int s2 = 0; s2 < NS; ++s2) acc = __builtin_amdgcn_mfma_f32_16x16x32_bf16(kf[jj][s2], qf2[s2], acc, 0, 0, 0);
            const int ii = 16 * mi + lr;
#pragma unroll
            for (int r = 0; r < 4; ++r) { const int j = 16 * nj + 4 * g + r; const bool keep = dir ? (j > ii) : (j <= ii); acc[r] = keep ? acc[r] : 0.f; }
            u32x2 pk; pk.x = cvtpk_c(acc[0], acc[1]); pk.y = cvtpk_c(acc[2], acc[3]);
            *(LAS u32x2*)(L + ML::O_PB + ii * RP + 32 * nj + 8 * g) = pk; }
        __syncthreads();
    }
    f32x4 o[4];
    {
        const int lane = opaque_i(lane0), g = lane >> 4, lr = lane & 15, q4 = lr >> 2, p4 = lr & 3;
        const LAS unsigned char* vb = L + ML::O_VB + (8 * g + q4) * RV + 32 * w + 8 * p4;
        const bf16x8 vf0 = __builtin_shufflevector(TRRD(vb), TRRD(vb + 4 * RV), 0, 1, 2, 3, 4, 5, 6, 7), vf1 = __builtin_shufflevector(TRRD(vb + 32 * RV), TRRD(vb + 36 * RV), 0, 1, 2, 3, 4, 5, 6, 7);
        if (WITH_O) {
            { bf16x8 pf[4][2];
#pragma unroll
              for (int m = 0; m < 4; ++m) { pf[m][0] = *(const LAS bf16x8*)(L + ML::O_PB + (16 * m + lr) * RP + 16 * g); pf[m][1] = *(const LAS bf16x8*)(L + ML::O_PB + (16 * m + lr) * RP + 64 + 16 * g); }
              __builtin_amdgcn_sched_barrier(0);
#pragma unroll
              for (int m = 0; m < 4; ++m) { o[m] = __builtin_amdgcn_mfma_f32_16x16x32_bf16(pf[m][0], vf0, (f32x4){0.f, 0.f, 0.f, 0.f}, 0, 0, 0); o[m] = __builtin_amdgcn_mfma_f32_16x16x32_bf16(pf[m][1], vf1, o[m], 0, 0, 0); }
              __builtin_amdgcn_sched_barrier(0); }
#pragma unroll
            for (int sh = 0; sh < NS / 2; ++sh) {
                u32x2 ql[2][4][2];
#pragma unroll
                for (int x = 0; x < 2; ++x)
#pragma unroll
                    for (int m = 0; m < 4; ++m) { ql[x][m][0] = *(const LAS u32x2*)(L + ML::O_QD + (16 * m + lr) * RQ + 64 * (2 * sh + x) + 8 * g); ql[x][m][1] = *(const LAS u32x2*)(L + ML::O_QD + (16 * m + lr) * RQ + 64 * (2 * sh + x) + 32 + 8 * g); }
                __builtin_amdgcn_sched_barrier(0);
#pragma unroll
                for (int x = 0; x < 2; ++x) { const int s2 = 2 * sh + x;
                    const bf16x8 sf = __builtin_bit_cast(bf16x8, (v4u){cvtpk_c(S[2 * s2][0], S[2 * s2][1]), cvtpk_c(S[2 * s2][2], S[2 * s2][3]), cvtpk_c(S[2 * s2 + 1][0], S[2 * s2 + 1][1]), cvtpk_c(S[2 * s2 + 1][2], S[2 * s2 + 1][3])});
#pragma unroll
                    for (int m = 0; m < 4; ++m) o[m] = __builtin_amdgcn_mfma_f32_16x16x32_bf16(__builtin_bit_cast(bf16x8, (v4u){ql[x][m][0].x, ql[x][m][0].y, ql[x][m][1].x, ql[x][m][1].y}), sf, o[m], 0, 0, 0); }
                __builtin_amdgcn_sched_barrier(0);
            }
        }
#pragma unroll
        for (int th = 0; th < NT / 4; ++th) {
            f32x4 d4[4]; bf16x8 kf0[4], kf1[4];
#pragma unroll
            for (int x = 0; x < 4; ++x) { const int tt = 4 * th + x;
                d4[x] = *(const LAS f32x4*)(L + ML::O_DC + (16 * tt + 4 * g) * 4);
                const LAS unsigned char* kb = L + ML::O_KE + (8 * g + q4) * RQ + 32 * tt + 8 * p4;
                kf0[x] = __builtin_shufflevector(TRRD(kb), TRRD(kb + 4 * RQ), 0, 1, 2, 3, 4, 5, 6, 7); kf1[x] = __builtin_shufflevector(TRRD(kb + 32 * RQ), TRRD(kb + 36 * RQ), 0, 1, 2, 3, 4, 5, 6, 7); }
            __builtin_amdgcn_sched_barrier(0);
#pragma unroll
            for (int x = 0; x < 4; ++x) { const int tt = 4 * th + x;
                S[tt] = S[tt] * d4[x];
                S[tt] = __builtin_amdgcn_mfma_f32_16x16x32_bf16(kf0[x], vf0, S[tt], 0, 0, 0);
                S[tt] = __builtin_amdgcn_mfma_f32_16x16x32_bf16(kf1[x], vf1, S[tt], 0, 0, 0); }
            __builtin_amdgcn_sched_barrier(0);
        }
    }
    if (WITH_O) {
        const int lane = opaque_i(lane0), g = lane >> 4, lr = lane & 15;
        if (dir == 0) {
#pragma unroll
            for (int cc = 0; cc < 4; ++cc) if (cc == c) {
#pragma unroll
                for (int m = 0; m < 4; ++m) { ofp[cc][m].x = cvtpk_c(o[m][0], o[m][1]); ofp[cc][m].y = cvtpk_c(o[m][2], o[m][3]); } }
        } else {
            u32x2 ofr[4];
#pragma unroll
            for (int cc = 0; cc < 4; ++cc) if (cc == c) {
#pragma unroll
                for (int m = 0; m < 4; ++m) ofr[m] = ofp[cc][m]; }
            LAS float* ob = (LAS float*)(L + ML::O_OB);
#pragma unroll
            for (int m = 0; m < 4; ++m) { const f32x4 t = {o[m][0] + bflo(ofr[m].x), o[m][1] + bfhi(ofr[m].x), o[m][2] + bflo(ofr[m].y), o[m][3] + bfhi(ofr[m].y)};
#pragma unroll
                for (int r = 0; r < 4; ++r) ob[(16 * m + 4 * g + r) * OB_PITCH + 16 * w + lr] = t[r]; }
            __syncthreads();
            const int row = 8 * w + (lane >> 3), pc = lane & 7;
            f32x4 x[4];
#pragma unroll
            for (int k = 0; k < 4; ++k) x[k] = *(const LAS f32x4*)(ob + row * OB_PITCH + 16 * pc + 4 * k);
            float rs;
            if (GLA) { float ss = 0.f;
#pragma unroll
                for (int k = 0; k < 4; ++k) ss += (x[k][0] * x[k][0] + x[k][1] * x[k][1]) + (x[k][2] * x[k][2] + x[k][3] * x[k][3]);
                ss += __shfl_xor(ss, 1); ss += __shfl_xor(ss, 2); ss += __shfl_xor(ss, 4);
                rs = __builtin_amdgcn_rsqf(ss * (1.0f / 128.0f) + EPS); }
            else { float sm = 0.f;
#pragma unroll
                for (int k = 0; k < 4; ++k) sm += (x[k][0] + x[k][1]) + (x[k][2] + x[k][3]);
                sm += __shfl_xor(sm, 1); sm += __shfl_xor(sm, 2); sm += __shfl_xor(sm, 4);
                const float mu = sm * (1.0f / 128.0f); float ss = 0.f;
#pragma unroll
                for (int k = 0; k < 4; ++k) { x[k] = x[k] - mu; ss += (x[k][0] * x[k][0] + x[k][1] * x[k][1]) + (x[k][2] * x[k][2] + x[k][3] * x[k][3]); }
                ss += __shfl_xor(ss, 1); ss += __shfl_xor(ss, 2); ss += __shfl_xor(ss, 4);
                rs = __builtin_amdgcn_rsqf(ss * (1.0f / 128.0f) + EPS); }
            unsigned ow[8];
#pragma unroll
            for (int k = 0; k < 4; ++k) { f32x4 y = x[k] * rs * nw[k];
                if (!GLA) y = y + nb[k];
                const unsigned ga_ = k < 2 ? ((const unsigned*)&gt0)[2 * k] : ((const unsigned*)&gt1)[2 * k - 4], gb_ = k < 2 ? ((const unsigned*)&gt0)[2 * k + 1] : ((const unsigned*)&gt1)[2 * k - 3];
                const float g0 = bflo(ga_), g1 = bfhi(ga_), g2 = bflo(gb_), g3 = bfhi(gb_);
                y[0] *= g0 * __builtin_amdgcn_rcpf(1.0f + __expf(-g0)); y[1] *= g1 * __builtin_amdgcn_rcpf(1.0f + __expf(-g1));
                y[2] *= g2 * __builtin_amdgcn_rcpf(1.0f + __expf(-g2)); y[3] *= g3 * __builtin_amdgcn_rcpf(1.0f + __expf(-g3));
                ow[2 * k] = cvtpk_c(y[0], y[1]); ow[2 * k + 1] = cvtpk_c(y[2], y[3]); }
            bf16* op = a.mo + (size_t)(row0 + 64 * c + row) * a.mop + vcol + 16 * pc;
            *(GAS v4u*)op = (v4u){ow[0], ow[1], ow[2], ow[3]}; *(GAS v4u*)(op + 8) = (v4u){ow[4], ow[5], ow[6], ow[7]};
        }
    }
}


__device__ __forceinline__ void gla_b_stage(Frame& F, const CMixArgs& a, int p) {
    const int sc = p >> 2, hh = p & 3, w = F.wave;
    LAS float* gl = (LAS float*)F.lds;
    __syncthreads();
    { const int tid = opaque_i(F.tid);
#pragma unroll
      for (int x = 0; x < 4; ++x) *(LAS f32x4*)(gl + 4 * (tid + 512 * x)) = *(const GAS f32x4*)(a.ga + (size_t)sc * 256 * 32 + 4 * (tid + 512 * x)); }
    __syncthreads();
    const int t = opaque_i(F.lane), dir = w >> 2, c = w & 3;
    const float* wa = (dir ? a.wab : a.waf) + 64 * hh + t;
    float wv[16];
#pragma unroll
    for (int r = 0; r < 16; ++r) wv[r] = wa[r * 256];
    const float bias = (dir ? a.bab : a.baf)[64 * hh + t];
    bh16* bp = (dir ? a.bb1 : a.bb0) + ((size_t)(p * 4 + c) * 64) * 64;
    LAS float* tb = gl + 8192 + w * (16 * 68);
    float acc = 0.f;
#pragma unroll 1
    for (int k16 = 0; k16 < 64; k16 += 16) {
#pragma unroll 1
        for (int k4 = k16; k4 < k16 + 16; k4 += 4) {
            f32x4 gv[4][4];
#pragma unroll
            for (int j = 0; j < 4; ++j) { const int i = dir ? 63 - (k4 + j) : k4 + j; const LAS float* gr = gl + (64 * c + i) * 32 + 16 * dir;
#pragma unroll
                for (int x = 0; x < 4; ++x) gv[j][x] = *(const LAS f32x4*)(gr + 4 * x); }
            __builtin_amdgcn_sched_barrier(0);
#pragma unroll
            for (int j = 0; j < 4; ++j) {
                float z = bias;
#pragma unroll
                for (int r = 0; r < 16; ++r) z += gv[j][r >> 2][r & 3] * wv[r];
                const float ls = fminf(z, 0.f) - __logf(1.0f + __expf(-fabsf(z)));
                acc += fmaxf(ls * (1.0f / 16.0f), -1.0f);
                tb[(k4 - k16 + j) * 68 + t] = acc; }
        }
#pragma unroll
        for (int x = 0; x < 2; ++x) { const int kk = 8 * x + (t >> 3), i = dir ? 63 - (k16 + kk) : k16 + kk;
            const f32x4 lo = *(const LAS f32x4*)(tb + kk * 68 + 8 * (t & 7)), hi = *(const LAS f32x4*)(tb + kk * 68 + 8 * (t & 7) + 4);
            v4u o;
#pragma unroll
            for (int q = 0; q < 2; ++q) { ((unsigned*)&o)[q] = (unsigned)__builtin_bit_cast(unsigned short, (bh16)lo[2 * q]) | ((unsigned)__builtin_bit_cast(unsigned short, (bh16)lo[2 * q + 1]) << 16);
                ((unsigned*)&o)[2 + q] = (unsigned)__builtin_bit_cast(unsigned short, (bh16)hi[2 * q]) | ((unsigned)__builtin_bit_cast(unsigned short, (bh16)hi[2 * q + 1]) << 16); }
            *(GAS v4u*)(bp + i * 64 + 8 * (t & 7)) = o; }
    }
    LAS float* tot = gl + 8192 + 8 * (16 * 68);
    tot[w * 64 + t] = acc;
    __syncthreads();
    { float gsum = 0.f;
#pragma unroll
      for (int cc = 0; cc < 4; ++cc) { const float v = tot[(dir * 4 + cc) * 64 + t]; if (dir ? (cc <= c) : (cc >= c)) gsum += v; }
      a.gv[((size_t)(p * 2 + dir) * 4 + c) * 64 + t] = gsum;
      if (c == (dir ? 3 : 0)) a.dec[(size_t)((sc * 4 + hh) * 2 + dir) * 64 + t] = __expf(gsum); }
}

template <int DK, bool GLA, bool WITH_O>
__device__ __forceinline__ void mix_units(Frame& F, const CMixArgs& a) {
    typedef MixLds<DK, GLA, WITH_O> ML;
    constexpr int NT = DK / 16;
    const int w = F.wave, lane0 = F.lane;
    int p = (int)blockIdx.x;
    if (p >= 1536) return;
    RawSet<GLA> RA, RB;
    raw_load<GLA, WITH_O>(RA, a, p, 0, w, lane0); raw_load<GLA, WITH_O>(RB, a, p, 1, w, lane0);
    f32x4 S[NT]; float dsum[8]; u32x2 ofp[4][4];
#pragma unroll 1
    for (; p < 1536; p += F.G) {
        const int sc = p >> 2, hh = p & 3, pnext = p + F.G;
#pragma unroll 1
        for (int dir = 0; dir < 2; ++dir) {
            const int lane = opaque_i(lane0);
            unsigned char* sp = a.st + state_off(sc, GLA, hh, dir) + (size_t)(unsigned)(w * NT * 512 + lane * 8);
            if (WITH_O) {
#pragma unroll
                for (int tt = 0; tt < NT; ++tt) { const u32x2 pk = *(const GAS u32x2*)(sp + tt * 512); S[tt] = (f32x4){bflo(pk.x), bfhi(pk.x), bflo(pk.y), bfhi(pk.y)}; } }
            else {
#pragma unroll
                for (int tt = 0; tt < NT; ++tt) S[tt] = (f32x4){0.f, 0.f, 0.f, 0.f};
#pragma unroll
                for (int e = 0; e < 8; ++e) dsum[e] = 0.f; }
#pragma unroll 1
            for (int h2 = 0; h2 < 2; ++h2) {
                mix_step<DK, GLA, WITH_O>(F, a, p, 4 * dir + 2 * h2, pnext, RA, S, dsum, ofp);
                mix_step<DK, GLA, WITH_O>(F, a, p, 4 * dir + 2 * h2 + 1, pnext, RB, S, dsum, ofp);
            }
            if (!WITH_O) {
#pragma unroll
                for (int tt = 0; tt < NT; ++tt) { u32x2 pk; pk.x = cvtpk_c(S[tt][0], S[tt][1]); pk.y = cvtpk_c(S[tt][2], S[tt][3]); *(GAS u32x2*)(sp + tt * 512) = pk; }
                if (GLA && w == 0 && lane < 8) { float* dp = a.dec + (size_t)((sc * 4 + hh) * 2 + dir) * 64 + 8 * lane;
#pragma unroll
                    for (int e = 0; e < 8; ++e) dp[e] = __expf(dsum[e]); }
            }
        }
    }
}

template <bool GLA> struct KvRaw;
template <> struct KvRaw<true> { v4u k, v0, v1, bfh, bbh; f32x4 gf0, gf1, gb0, gb1; };
template <> struct KvRaw<false> { v4u k0, k1, v0, v1; };
template <bool GLA>
__device__ __forceinline__ void kv_load(KvRaw<GLA>& R, const CMixArgs& a, int p, int c, int w, int lane0) {
    const int lane = opaque_i(lane0), sc = p >> 2, hh = p & 3, pc = lane & 7, ti = 8 * w + (lane >> 3);
    const size_t row = (size_t)(sc * 256 + 64 * c + ti);
    if constexpr (GLA) {
        R.k = *(const GAS v4u*)(a.proj + pg8::pl(pg8::PL_GK, hh, row, 64) + 8 * pc);
        const bf16* pv = a.proj + pg8::pl(pg8::PL_GV, hh, row, 128) + 8 * pc; R.v0 = *(const GAS v4u*)pv; R.v1 = *(const GAS v4u*)(pv + 64);
        R.bfh = *(const GAS v4u*)(a.bb0 + ((size_t)(p * 4 + c) * 64 + ti) * 64 + 8 * pc); R.bbh = *(const GAS v4u*)(a.bb1 + ((size_t)(p * 4 + c) * 64 + ti) * 64 + 8 * pc);
        const float* g0 = a.gv + ((size_t)(p * 2 + 0) * 4 + c) * 64 + 8 * pc; const float* g1 = a.gv + ((size_t)(p * 2 + 1) * 4 + c) * 64 + 8 * pc;
        R.gf0 = *(const GAS f32x4*)g0; R.gf1 = *(const GAS f32x4*)(g0 + 4); R.gb0 = *(const GAS f32x4*)g1; R.gb1 = *(const GAS f32x4*)(g1 + 4);
    } else {
        const bf16* pk = a.proj + pg8::pl(pg8::PL_RK, hh, row, 128) + 8 * pc; R.k0 = *(const GAS v4u*)pk; R.k1 = *(const GAS v4u*)(pk + 64);
        const bf16* pv = a.proj + pg8::pl(pg8::PL_RV, hh, row, 128) + 8 * pc; R.v0 = *(const GAS v4u*)pv; R.v1 = *(const GAS v4u*)(pv + 64);
    }
}
template <int DK, bool GLA>
__device__ __forceinline__ void kv_step(Frame& F, const CMixArgs& a, int p, int c, int pnext, KvRaw<GLA>& R, f32x4 (&Sf)[DK / 16], f32x4 (&Sb)[DK / 16]) {
    constexpr int NT = DK / 16, RQ = DK * 2 + 16, RV = 272, O_KF = 0, O_KB = 64 * RQ, O_VB = 2 * 64 * RQ;
    LAS unsigned char* L = F.lds;
    const int lane0 = F.lane, w = F.wave, hh = p & 3;
    __syncthreads();
    { const int lane = opaque_i(lane0), i = 8 * w + (lane >> 3), pc = lane & 7;
      *(LAS v4u*)(L + O_VB + i * RV + 16 * pc) = R.v0; *(LAS v4u*)(L + O_VB + i * RV + 128 + 16 * pc) = R.v1;
      if constexpr (GLA) {
          float f8[8], b8[8];
#pragma unroll
          for (int e = 0; e < 8; ++e) { const unsigned wk = ((const unsigned*)&R.k)[e >> 1]; const float kv = (e & 1) ? bfhi(wk) : bflo(wk);
              const float xf = (e < 4 ? R.gf0[e & 3] : R.gf1[e & 3]) - h2f(((const unsigned*)&R.bfh)[e >> 1], e & 1), xb = (e < 4 ? R.gb0[e & 3] : R.gb1[e & 3]) - h2f(((const unsigned*)&R.bbh)[e >> 1], e & 1);
              f8[e] = kv * __expf(xf); b8[e] = kv * __expf(xb); }
          *(LAS v4u*)(L + O_KF + i * RQ + 16 * pc) = (v4u){cvtpk_c(f8[0], f8[1]), cvtpk_c(f8[2], f8[3]), cvtpk_c(f8[4], f8[5]), cvtpk_c(f8[6], f8[7])};
          *(LAS v4u*)(L + O_KB + i * RQ + 16 * pc) = (v4u){cvtpk_c(b8[0], b8[1]), cvtpk_c(b8[2], b8[3]), cvtpk_c(b8[4], b8[5]), cvtpk_c(b8[6], b8[7])};
      } else {
          const float l2g = hh == 0 ? -0.045803689613124f : hh == 1 ? -0.022720076500083f : hh == 2 ? -0.011315313227834f : -0.005646563141142f;
          const float j = (float)(64 * c + i), ef = __builtin_amdgcn_exp2f(l2g * (255.0f - j)), eb = __builtin_amdgcn_exp2f(l2g * j);
#pragma unroll
          for (int x = 0; x < 2; ++x) { const v4u rk = x ? R.k1 : R.k0; v4u of, ob;
#pragma unroll
              for (int q = 0; q < 4; ++q) { const unsigned wk = ((const unsigned*)&rk)[q]; ((unsigned*)&of)[q] = cvtpk_c(bflo(wk) * ef, bfhi(wk) * ef); ((unsigned*)&ob)[q] = cvtpk_c(bflo(wk) * eb, bfhi(wk) * eb); }
              *(LAS v4u*)(L + O_KF + i * RQ + 128 * x + 16 * pc) = of; *(LAS v4u*)(L + O_KB + i * RQ + 128 * x + 16 * pc) = ob; }
      } }
    kv_load<GLA>(R, a, c < 2 ? p : (pnext < 1536 ? pnext : p), (c + 2) & 3, w, lane0);
    __syncthreads();
    { const int lane = opaque_i(lane0), g = lane >> 4, lr = lane & 15, q4 = lr >> 2, p4 = lr & 3;
      const LAS unsigned char* vb = L + O_VB + (8 * g + q4) * RV + 32 * w + 8 * p4;
      const bf16x8 vf0 = __builtin_shufflevector(TRRD(vb), TRRD(vb + 4 * RV), 0, 1, 2, 3, 4, 5, 6, 7), vf1 = __builtin_shufflevector(TRRD(vb + 32 * RV), TRRD(vb + 36 * RV), 0, 1, 2, 3, 4, 5, 6, 7);
#pragma unroll
      for (int th = 0; th < NT / 4; ++th) {
          bf16x8 kf0[4], kf1[4], kb0[4], kb1[4];
#pragma unroll
          for (int x = 0; x < 4; ++x) { const int tt = 4 * th + x;
              const LAS unsigned char* ka = L + O_KF + (8 * g + q4) * RQ + 32 * tt + 8 * p4; const LAS unsigned char* kb = L + O_KB + (8 * g + q4) * RQ + 32 * tt + 8 * p4;
              kf0[x] = __builtin_shufflevector(TRRD(ka), TRRD(ka + 4 * RQ), 0, 1, 2, 3, 4, 5, 6, 7); kf1[x] = __builtin_shufflevector(TRRD(ka + 32 * RQ), TRRD(ka + 36 * RQ), 0, 1, 2, 3, 4, 5, 6, 7);
              kb0[x] = __builtin_shufflevector(TRRD(kb), TRRD(kb + 4 * RQ), 0, 1, 2, 3, 4, 5, 6, 7); kb1[x] = __builtin_shufflevector(TRRD(kb + 32 * RQ), TRRD(kb + 36 * RQ), 0, 1, 2, 3, 4, 5, 6, 7); }
          __builtin_amdgcn_sched_barrier(0);
#pragma unroll
          for (int x = 0; x < 4; ++x) { const int tt = 4 * th + x;
              Sf[tt] = __builtin_amdgcn_mfma_f32_16x16x32_bf16(kf0[x], vf0, Sf[tt], 0, 0, 0); Sf[tt] = __builtin_amdgcn_mfma_f32_16x16x32_bf16(kf1[x], vf1, Sf[tt], 0, 0, 0);
              Sb[tt] = __builtin_amdgcn_mfma_f32_16x16x32_bf16(kb0[x], vf0, Sb[tt], 0, 0, 0); Sb[tt] = __builtin_amdgcn_mfma_f32_16x16x32_bf16(kb1[x], vf1, Sb[tt], 0, 0, 0); }
          __builtin_amdgcn_sched_barrier(0);
      } }
}
template <int DK, bool GLA>
__device__ __forceinline__ void kv_units(Frame& F, const CMixArgs& a) {
    constexpr int NT = DK / 16;
    const int w = F.wave, lane0 = F.lane;
    int p = (int)blockIdx.x;
    if (p >= 1536) return;
    if (GLA) {
#pragma unroll 1
        for (int pp = p; pp < 1536; pp += F.G) gla_b_stage(F, a, pp);
        asm volatile("s_waitcnt vmcnt(0)" ::: "memory"); __syncthreads(); }
    KvRaw<GLA> RA, RB;
    kv_load<GLA>(RA, a, p, 0, w, lane0); kv_load<GLA>(RB, a, p, 1, w, lane0);
#pragma unroll 1
    for (; p < 1536; p += F.G) {
        const int sc = p >> 2, hh = p & 3, pnext = p + F.G;
        f32x4 Sf[NT], Sb[NT];
#pragma unroll
        for (int tt = 0; tt < NT; ++tt) { Sf[tt] = (f32x4){0.f, 0.f, 0.f, 0.f}; Sb[tt] = (f32x4){0.f, 0.f, 0.f, 0.f}; }
        kv_step<DK, GLA>(F, a, p, 0, pnext, RA, Sf, Sb); kv_step<DK, GLA>(F, a, p, 1, pnext, RB, Sf, Sb);
        kv_step<DK, GLA>(F, a, p, 2, pnext, RA, Sf, Sb); kv_step<DK, GLA>(F, a, p, 3, pnext, RB, Sf, Sb);
        const int lane = opaque_i(lane0);
#pragma unroll
        for (int dir = 0; dir < 2; ++dir) { unsigned char* sp = a.st + state_off(sc, GLA, hh, dir) + (size_t)(unsigned)(w * NT * 512 + lane * 8);
#pragma unroll
            for (int tt = 0; tt < NT; ++tt) { const f32x4 s = dir ? Sb[tt] : Sf[tt]; u32x2 pk; pk.x = cvtpk_c(s[0], s[1]); pk.y = cvtpk_c(s[2], s[3]); *(GAS u32x2*)(sp + tt * 512) = pk; } }
    }
}

constexpr int RD_SLOT = 32768;
__device__ __forceinline__ void ret_dma_block(Frame& F, const CMixArgs& a, int p, int kb, int slot) {
    const int lane = opaque_i(F.lane), w = F.wave, sc = p >> 2, hh = p & 3;
#pragma unroll
    for (int x = 0; x < 2; ++x) {
        const int r = 4 * (2 * w + x) + (lane >> 4), cp = lane & 15;
        const size_t row = (size_t)(sc * 256 + 64 * kb + r);
        const bf16* gk = a.proj + pg8::pl(pg8::PL_RK, hh, row, 128) + 8 * (cp ^ (r & 15));
        const bf16* gv = a.proj + pg8::pl(pg8::PL_RV, hh, row, 128) + 8 * (cp ^ (2 * (r & 7)));
        __builtin_amdgcn_global_load_lds((const unsigned*)gk, (LAS unsigned*)(F.lds + slot * RD_SLOT + (2 * w + x) * 1024), 16, 0, 0);
        __builtin_amdgcn_global_load_lds((const unsigned*)gv, (LAS unsigned*)(F.lds + slot * RD_SLOT + 16384 + (2 * w + x) * 1024), 16, 0, 0);
    }
}
__device__ __forceinline__ void tr_read16(const unsigned (&ad)[8], u32x2 (&r)[16]) {
    asm volatile("ds_read_b64_tr_b16 %0, %16\n\tds_read_b64_tr_b16 %1, %16 offset:4096\n\tds_read_b64_tr_b16 %2, %17\n\tds_read_b64_tr_b16 %3, %17 offset:4096\n\t"
                 "ds_read_b64_tr_b16 %4, %18\n\tds_read_b64_tr_b16 %5, %18 offset:4096\n\tds_read_b64_tr_b16 %6, %19\n\tds_read_b64_tr_b16 %7, %19 offset:4096\n\t"
                 "ds_read_b64_tr_b16 %8, %20\n\tds_read_b64_tr_b16 %9, %20 offset:4096\n\tds_read_b64_tr_b16 %10, %21\n\tds_read_b64_tr_b16 %11, %21 offset:4096\n\t"
                 "ds_read_b64_tr_b16 %12, %22\n\tds_read_b64_tr_b16 %13, %22 offset:4096\n\tds_read_b64_tr_b16 %14, %23\n\tds_read_b64_tr_b16 %15, %23 offset:4096\n\t"
                 "s_waitcnt lgkmcnt(0)"
                 : "=&v"(r[0]), "=&v"(r[1]), "=&v"(r[2]), "=&v"(r[3]), "=&v"(r[4]), "=&v"(r[5]), "=&v"(r[6]), "=&v"(r[7]),
                   "=&v"(r[8]), "=&v"(r[9]), "=&v"(r[10]), "=&v"(r[11]), "=&v"(r[12]), "=&v"(r[13]), "=&v"(r[14]), "=&v"(r[15])
                 : "v"(ad[0]), "v"(ad[1]), "v"(ad[2]), "v"(ad[3]), "v"(ad[4]), "v"(ad[5]), "v"(ad[6]), "v"(ad[7]) : "memory");
}
__device__ __forceinline__ void ret_block(Frame& F, const CMixArgs& a, int p, int kb, int slot, int pnext, const bf16x8 (&Qf)[2][4], f32x4 (&O)[8][2]) {
    LAS unsigned char* L = F.lds;
    const int w = F.wave, hh = p & 3;
    const float l2g = hh == 0 ? -0.045803689613124f : hh == 1 ? -0.022720076500083f : hh == 2 ? -0.011315313227834f : -0.005646563141142f;
    asm volatile("s_waitcnt vmcnt(4)" ::: "memory");
    __builtin_amdgcn_s_barrier();
    asm volatile("" ::: "memory");
    { const int kn = kb + 2, pn2 = kn < 4 ? p : (pnext < 1536 ? pnext : p); ret_dma_block(F, a, pn2, kn & 3, slot == 0 ? 2 : slot - 1); }
    LAS unsigned char* KB = L + slot * RD_SLOT; LAS unsigned char* VB = KB + 16384;
    const int lane = opaque_i(F.lane), g = lane >> 4, lr = lane & 15, q4 = lr >> 2, p4 = lr & 3;
    const int xk16 = (lr ^ (g >> 1)) << 4, xv16 = ((p4 >> 1) ^ (2 * ((4 * g + q4) & 7))) << 4;
#pragma unroll
    for (int sp = 0; sp < 2; ++sp) {
        f32x4 st[2][2];
#pragma unroll
        for (int h = 0; h < 2; ++h)
#pragma unroll
            for (int it = 0; it < 2; ++it) st[h][it] = (f32x4){0.f, 0.f, 0.f, 0.f};
        { bf16x8 kf[2][4];
#pragma unroll
          for (int s = 0; s < 4; ++s)
#pragma unroll
              for (int h = 0; h < 2; ++h) {
                  const LAS unsigned char* kp = KB + (32 * sp + 16 * h + lr) * 256 + 8 * (g & 1);
                  const u32x2 lo = *(const LAS u32x2*)(kp + ((64 * s) ^ xk16)), hi = *(const LAS u32x2*)(kp + ((64 * s + 32) ^ xk16));
                  kf[h][s] = __builtin_bit_cast(bf16x8, (v4u){lo.x, lo.y, hi.x, hi.y}); }
          __builtin_amdgcn_sched_barrier(0);
#pragma unroll
          for (int s = 0; s < 4; ++s)
#pragma unroll
              for (int h = 0; h < 2; ++h)
#pragma unroll
                  for (int it = 0; it < 2; ++it) st[h][it] = __builtin_amdgcn_mfma_f32_16x16x32_bf16(kf[h][s], Qf[it][s], st[h][it], 0, 0, 0);
          __builtin_amdgcn_sched_barrier(0); }
        bf16x8 pf[2];
#pragma unroll
        for (int it = 0; it < 2; ++it) {
            const int i = 32 * w + 16 * it + lr;
            unsigned pw[4];
#pragma unroll
            for (int h = 0; h < 2; ++h) { float e[4];
#pragma unroll
                for (int r = 0; r < 4; ++r) { const int j = 64 * kb + 32 * sp + 16 * h + 4 * g + r; const int d = i - j; e[r] = st[h][it][r] * __builtin_amdgcn_exp2f(l2g * (float)(d < 0 ? -d : d)); }
                pw[2 * h] = cvtpk_c(e[0], e[1]); pw[2 * h + 1] = cvtpk_c(e[2], e[3]); }
            pf[it] = __builtin_bit_cast(bf16x8, (v4u){pw[0], pw[1], pw[2], pw[3]});
        }
        { unsigned ad[8]; u32x2 vr[16];
          const unsigned vb0 = (unsigned)(size_t)(VB + (32 * sp + 4 * g + q4) * 256 + 8 * (p4 & 1));
#pragma unroll
          for (int dt = 0; dt < 8; ++dt) ad[dt] = vb0 + ((32 * dt) ^ xv16);
          tr_read16(ad, vr);
          __builtin_amdgcn_sched_barrier(0);
#pragma unroll
          for (int dt = 0; dt < 8; ++dt) { const bf16x8 vf = __builtin_bit_cast(bf16x8, (v4u){vr[2 * dt].x, vr[2 * dt].y, vr[2 * dt + 1].x, vr[2 * dt + 1].y});
#pragma unroll
              for (int it = 0; it < 2; ++it) O[dt][it] = __builtin_amdgcn_mfma_f32_16x16x32_bf16(vf, pf[it], O[dt][it], 0, 0, 0); }
          __builtin_amdgcn_sched_barrier(0); }
    }
}
__device__ __forceinline__ void ret_q_load(bf16x8 (&Qf)[2][4], const CMixArgs& a, int p, int w, int lane0) {
    const int lane = opaque_i(lane0), g = lane >> 4, lr = lane & 15, sc = p >> 2, hh = p & 3;
#pragma unroll
    for (int it = 0; it < 2; ++it) { const bf16* qp = a.proj + pg8::pl(pg8::PL_RQ, hh, (size_t)(sc * 256 + 32 * w + 16 * it + lr), 128) + 4 * g;
#pragma unroll
        for (int s = 0; s < 4; ++s) { const u32x2 lo = *(const GAS u32x2*)(qp + 32 * s), hi = *(const GAS u32x2*)(qp + 32 * s + 16); Qf[it][s] = __builtin_bit_cast(bf16x8, (v4u){lo.x, lo.y, hi.x, hi.y}); } }
}
__device__ __forceinline__ void ret_units_direct(Frame& F, const CMixArgs& a) {
    const int w = F.wave;
    int p = (int)blockIdx.x;
    if (p >= 1536) return;
    bf16x8 Qf[2][4];
    asm volatile("s_waitcnt vmcnt(0)" ::: "memory"); __syncthreads();
    ret_dma_block(F, a, p, 0, 0); ret_dma_block(F, a, p, 1, 1);
    int slot = 0;
    ret_q_load(Qf, a, p, w, F.lane);
#pragma unroll 1
    for (; p < 1536; p += F.G) {
        const int sc = p >> 2, hh = p & 3, pnext = p + F.G;
        const float l2g = hh == 0 ? -0.045803689613124f : hh == 1 ? -0.022720076500083f : hh == 2 ? -0.011315313227834f : -0.005646563141142f;
        f32x4 O[8][2];
#pragma unroll
        for (int dt = 0; dt < 8; ++dt)
#pragma unroll
            for (int it = 0; it < 2; ++it) O[dt][it] = (f32x4){0.f, 0.f, 0.f, 0.f};
#pragma unroll 1
        for (int kb = 0; kb < 4; ++kb) { ret_block(F, a, p, kb, slot, pnext, Qf, O); slot = slot == 2 ? 0 : slot + 1; }
        { const int lane = opaque_i(F.lane), lr = lane & 15;
          const unsigned char* sp0 = a.st + state_off(sc, false, hh, 0) + (size_t)(unsigned)(lane * 8);
          u32x2 cA[16], cB[16];
#define RD_CLOAD(dst, k_) do { const unsigned char* b_ = sp0 + ((k_) >> 2) * 32768 + 2 * ((k_) & 3) * 512; \
              _Pragma("unroll") for (int dt = 0; dt < 8; ++dt) { dst[2 * dt] = *(const GAS u32x2*)(b_ + dt * 4096); dst[2 * dt + 1] = *(const GAS u32x2*)(b_ + dt * 4096 + 512); } } while (0)
#define RD_CMMA(src, k_) do { const int dir_ = (k_) >> 2, s_ = (k_) & 3; bf16x8 qs[2]; \
              _Pragma("unroll") for (int it = 0; it < 2; ++it) { const int i = 32 * w + 16 * it + lr; const float f = __builtin_amdgcn_exp2f(l2g * (float)(dir_ ? 256 - i : i + 1)); \
                  const v4u qw = __builtin_bit_cast(v4u, Qf[it][s_]); v4u o_; \
                  _Pragma("unroll") for (int j = 0; j < 4; ++j) ((unsigned*)&o_)[j] = cvtpk_c(bflo(((const unsigned*)&qw)[j]) * f, bfhi(((const unsigned*)&qw)[j]) * f); \
                  qs[it] = __builtin_bit_cast(bf16x8, o_); } \
              _Pragma("unroll") for (int dt = 0; dt < 8; ++dt) { const bf16x8 cf = __builtin_bit_cast(bf16x8, (v4u){src[2 * dt].x, src[2 * dt].y, src[2 * dt + 1].x, src[2 * dt + 1].y}); \
                  _Pragma("unroll") for (int it = 0; it < 2; ++it) O[dt][it] = __builtin_amdgcn_mfma_f32_16x16x32_bf16(cf, qs[it], O[dt][it], 0, 0, 0); } } while (0)
          RD_CLOAD(cA, 0); RD_CLOAD(cB, 1);
          __builtin_amdgcn_sched_barrier(0);
#pragma unroll
          for (int k = 0; k < 8; k += 2) {
              RD_CMMA(cA, k); if (k + 2 < 8) RD_CLOAD(cA, k + 2);
              __builtin_amdgcn_sched_barrier(0);
              RD_CMMA(cB, k + 1); if (k + 3 < 8) RD_CLOAD(cB, k + 3);
              __builtin_amdgcn_sched_barrier(0);
          }
#undef RD_CLOAD
#undef RD_CMMA
        }
        ret_q_load(Qf, a, pnext < 1536 ? pnext : p, w, F.lane);
        { const int lane = opaque_i(F.lane), g = lane >> 4, lr = lane & 15;
          LAS unsigned char* T = F.lds + 3 * RD_SLOT + w * (16 * 272);
          f32x4 nw[4], nb[4];
#pragma unroll
          for (int k = 0; k < 4; ++k) { nw[k] = *(const GAS f32x4*)(a.rnw + 128 * hh + 16 * (lane & 7) + 4 * k); nb[k] = *(const GAS f32x4*)(a.rnb + 128 * hh + 16 * (lane & 7) + 4 * k); }
#pragma unroll
          for (int it = 0; it < 2; ++it) {
              v4u gt[2][2];
#pragma unroll
              for (int h = 0; h < 2; ++h) { const bf16* gp = a.proj + pg8::pl(pg8::PL_RG, hh, (size_t)(sc * 256 + 32 * w + 16 * it + 8 * h + (lane >> 3)), 128) + 16 * (lane & 7);
                  gt[h][0] = *(const GAS v4u*)gp; gt[h][1] = *(const GAS v4u*)(gp + 8); }
              float sm = 0.f;
#pragma unroll
              for (int dt = 0; dt < 8; ++dt) sm += (O[dt][it][0] + O[dt][it][1]) + (O[dt][it][2] + O[dt][it][3]);
              sm += __shfl_xor(sm, 16); sm += __shfl_xor(sm, 32);
              const float mu = sm * (1.0f / 128.0f); float ss = 0.f;
#pragma unroll
              for (int dt = 0; dt < 8; ++dt) { O[dt][it] = O[dt][it] - mu; ss += (O[dt][it][0] * O[dt][it][0] + O[dt][it][1] * O[dt][it][1]) + (O[dt][it][2] * O[dt][it][2] + O[dt][it][3] * O[dt][it][3]); }
              ss += __shfl_xor(ss, 16); ss += __shfl_xor(ss, 32);
              const float rs = __builtin_amdgcn_rsqf(ss * (1.0f / 128.0f) + EPS);
#pragma unroll
              for (int dt = 0; dt < 8; ++dt) { const f32x4 y = O[dt][it] * rs;
                  u32x2 pk; pk.x = cvtpk_c(y[0], y[1]); pk.y = cvtpk_c(y[2], y[3]);
                  *(LAS u32x2*)(T + lr * 272 + 32 * dt + 8 * g) = pk; }
              asm volatile("s_waitcnt lgkmcnt(0)" ::: "memory");
#pragma unroll
              for (int h = 0; h < 2; ++h) { const int rr = 8 * h + (lane >> 3);
                  const v4u y0 = *(const LAS v4u*)(T + rr * 272 + 32 * (lane & 7)), y1 = *(const LAS v4u*)(T + rr * 272 + 32 * (lane & 7) + 16);
                  unsigned ow[8];
#pragma unroll
                  for (int k = 0; k < 8; ++k) { const unsigned yw = k < 4 ? ((const unsigned*)&y0)[k] : ((const unsigned*)&y1)[k - 4], gw = k < 4 ? ((const unsigned*)&gt[h][0])[k] : ((const unsigned*)&gt[h][1])[k - 4];
                      const float g0 = bflo(gw), g1 = bfhi(gw);
                      ow[k] = cvtpk_c((bflo(yw) * nw[k >> 1][2 * (k & 1)] + nb[k >> 1][2 * (k & 1)]) * g0 * __builtin_amdgcn_rcpf(1.0f + __expf(-g0)), (bfhi(yw) * nw[k >> 1][2 * (k & 1) + 1] + nb[k >> 1][2 * (k & 1) + 1]) * g1 * __builtin_amdgcn_rcpf(1.0f + __expf(-g1))); }
                  bf16* op = a.mo + (size_t)(sc * 256 + 32 * w + 16 * it + rr) * a.mop + 512 + 128 * hh + 16 * (lane & 7);
                  *(GAS v4u*)op = (v4u){ow[0], ow[1], ow[2], ow[3]}; *(GAS v4u*)(op + 8) = (v4u){ow[4], ow[5], ow[6], ow[7]}; }
              asm volatile("s_waitcnt lgkmcnt(0)" ::: "memory");
          } }
    }
    asm volatile("s_waitcnt vmcnt(0)" ::: "memory"); __syncthreads();
}

template <bool WITH_O>
__device__ __forceinline__ void cmix_phase(Frame& F, const CMixArgs& a, int which = 3) {
#if MIX_GLA
    if (which & 1) { if constexpr (WITH_O) mix_units<64, true, true>(F, a); else kv_units<64, true>(F, a);
    __syncthreads(); }
#endif
#if MIX_RET
    if (which & 2) { if constexpr (WITH_O) ret_units_direct(F, a); else kv_units<128, false>(F, a);
    __syncthreads(); }
#endif
}
__device__ __forceinline__ void scan_phase(Frame& F, const CMixArgs& a) {
    const int nthreads = F.G * NWAVES * 64;
    for (int chain = (int)blockIdx.x * NWAVES * 64 + F.tid; chain < 34 * 49152; chain += nthreads) {
        const int sq = chain / 49152, cidx = chain % 49152;
        const int seq = sq < 2 ? 32 + sq : sq - 2;
        const int sc0 = seq < 32 ? seq * 8 : 256 + (seq - 32) * 64, ns = seq < 32 ? 8 : 64;
        const bool gla = cidx < 16384; const int c2 = gla ? cidx : cidx - 16384;
        const int hd = gla ? (c2 >> 11) : (c2 >> 12), v = gla ? (c2 & 2047) : (c2 & 4095), hh = hd >> 1, dir = hd & 1;
        if ((gla && !MIX_GLA) || (!gla && !MIX_RET)) continue;
        const int t0 = 16 * ((v >> 6) & 3) + 4 * ((v & 63) >> 4);
        const float gret = exp2f(256.0f * log2f(1.0f - exp2f(-5.0f - (float)hh)));
        f32x4 cst = {0.f, 0.f, 0.f, 0.f};
        for (int blk = 0; blk < ns; blk += 8) {
            u32x2 kv[8]; f32x4 d[8];
#pragma unroll
            for (int j = 0; j < 8; ++j) { const int n = dir ? ns - 1 - (blk + j) : blk + j;
                kv[j] = *(const GAS u32x2*)(a.st + state_off(sc0 + n, gla, hh, dir) + (size_t)v * 8);
                d[j] = gla ? *(const GAS f32x4*)(a.dec + (size_t)(((sc0 + n) * 4 + hh) * 2 + dir) * 64 + t0) : (f32x4){gret, gret, gret, gret}; }
#pragma unroll
            for (int j = 0; j < 8; ++j) { const int n = dir ? ns - 1 - (blk + j) : blk + j;
                u32x2 pk; pk.x = cvtpk_c(cst[0], cst[1]); pk.y = cvtpk_c(cst[2], cst[3]);
                *(GAS u32x2*)(a.sto + state_off(sc0 + n, gla, hh, dir) + (size_t)v * 8) = pk;
                cst = d[j] * cst + (f32x4){bflo(kv[j].x), bfhi(kv[j].x), bflo(kv[j].y), bfhi(kv[j].y)}; }
        }
    }
}

#ifndef W2_TILED
#define W2_TILED 1
#endif
#define NAIVE_MIX (!(MIX_GLA && MIX_RET))
constexpr int PB0 = NAIVE_MIX ? 8 : 5, NPH = PB0 + 4;
struct Args { const float* in[16]; float* out; unsigned char* ws; int ph_lo, ph_hi, use_bar, pad; };
__global__ void __launch_bounds__(NWAVES * 64, 2) fwd_kernel(Args args) {
    extern __shared__ __attribute__((aligned(16))) unsigned char lds[];
    Frame F;
    F.lds = (LAS unsigned char*)lds;
    F.MISC = (volatile LAS unsigned*)(F.lds + MISC_OFF);
    F.tid = threadIdx.x; F.lane = F.tid & 63; F.wave = __builtin_amdgcn_readfirstlane(F.tid >> 6);
    F.G = gridDim.x; { const int bx = blockIdx.x; F.vcu = (F.G % 8 == 0) ? (bx % 8) * (F.G / 8) + bx / 8 : bx; }
    unsigned char* ws = args.ws;
    gu32* ctl = (gu32*)(ws + WS_CTL);
    for (int u = F.tid; u < (LDS_BYTES - LDSCTL_OFF) / 4; u += NWAVES * 64) ((LAS unsigned*)(F.lds + LDSCTL_OFF))[u] = 0u;
    __syncthreads();
    XcdBarrier bar; bar.bar = (unsigned*)(ctl + CW_BAR); bar.x = 0; bar.st = nullptr;
    if (args.use_bar) bar = xcd_barrier_post((unsigned*)(ctl + CW_BAR), F.MISC + 8);
    const int lo = args.ph_lo, hi = args.ph_hi;
#define IN(k) (lo <= (k) && (k) < hi)
#define SEAM(k) do { if (IN(k) && IN((k) + 1)) xcd_barrier(bar); } while (0)
    if (IN(0)) { const P0Args pa{args.in[0], args.in[1], args.in[2], args.in[3], args.in[11], args.in[12], args.in[13], args.in[14], (bf16*)(ws + WS_WIN), (bf16*)(ws + WS_WOUT), (bf16*)(ws + WS_W1), (bf16*)(ws + WS_W2),
            (bf16*)(ws + WS_R0), (float*)(ws + WS_ROPE), (float*)(ws + WS_ROPE) + 16384 * 64, (float*)(ws + WS_GA), (float*)(ws + WS_RSTD)};
        p0_prologue(F, pa); __syncthreads();
#if REP0
        p0_prologue(F, pa, REP0); __syncthreads();
#endif
    }
    SEAM(0);
    if (IN(1)) { pg8::Gemm g{(bf16*)(ws + WS_R0), (bf16*)(ws + WS_WIN), M_TOK, NP, D, D}; pg8::StaticOrder S; S.init(M_TOK, NP, F.G, (int)blockIdx.x);
        pg8::EpiInProj E{(bf16*)(ws + WS_R1), (float*)(ws + WS_RSTD), (float*)(ws + WS_ROPE), (float*)(ws + WS_ROPE) + 16384 * 64};
#if REP1 == 2
        { pg8::EpiPlain E2{(bf16*)(ws + WS_R1)}; pg8::gemm_phase<pg8::EpiPlain, pg8::StaticOrder, true, true>(F.lds + RING_OFF, g, S, E2); } __syncthreads();
#elif REP1 == 3
        { pg8::EpiNull E2{}; pg8::gemm_phase<pg8::EpiNull, pg8::StaticOrder, true, true>(F.lds + RING_OFF, g, S, E2); } __syncthreads();
#endif
        pg8::gemm_phase<pg8::EpiInProj, pg8::StaticOrder, true, true>(F.lds + RING_OFF, g, S, E);
#if REP1 == 1
        __syncthreads(); pg8::gemm_phase<pg8::EpiInProj, pg8::StaticOrder, true, true>(F.lds + RING_OFF, g, S, E);
#endif
    }
    SEAM(1);
    if (IN(2)) { const CMixArgs ca{(bf16*)(ws + WS_R1), (float*)(ws + WS_GA), args.in[4], args.in[5], args.in[6], args.in[7], ws + WS_ST, (float*)(ws + WS_DEC), args.in[8], args.in[9], args.in[10], (bf16*)((unsigned char*)args.out + (size_t)192 * MiB), D, ws + WS_ST, (unsigned char*)args.out, (bh16*)((unsigned char*)args.out + (size_t)96 * MiB), (bh16*)args.out, (float*)(ws + WS_DEC + 786432)};
        cmix_phase<false>(F, ca);
#if REP2
        cmix_phase<false>(F, ca, REP2);
#endif
    }
    SEAM(2);
    if (IN(3)) { const CMixArgs ca{(bf16*)(ws + WS_R1), (float*)(ws + WS_GA), args.in[4], args.in[5], args.in[6], args.in[7], ws + WS_ST, (float*)(ws + WS_DEC), args.in[8], args.in[9], args.in[10], (bf16*)((unsigned char*)args.out + (size_t)192 * MiB), D, ws + WS_ST, (unsigned char*)args.out, (bh16*)((unsigned char*)args.out + (size_t)96 * MiB), (bh16*)args.out, (float*)(ws + WS_DEC + 786432)};
#if REP3
        { CMixArgs cb = ca; cb.sto = (unsigned char*)args.out + (size_t)224 * MiB; scan_phase(F, cb); }
#endif
        scan_phase(F, ca); }
    SEAM(3);
    if (IN(4)) { const CMixArgs ca{(bf16*)(ws + WS_R1), (float*)(ws + WS_GA), args.in[4], args.in[5], args.in[6], args.in[7], ws + WS_ST, (float*)(ws + WS_DEC), args.in[8], args.in[9], args.in[10], (bf16*)((unsigned char*)args.out + (size_t)192 * MiB), D, ws + WS_ST, (unsigned char*)args.out, (bh16*)((unsigned char*)args.out + (size_t)96 * MiB), (bh16*)args.out, (float*)(ws + WS_DEC + 786432)};
#if REP4
        { CMixArgs cb = ca; cmix_phase<true>(F, cb, REP4); }
#endif
        cmix_phase<true>(F, ca); }
    SEAM(4);
#if NAIVE_MIX
    { const MixArgs ma{(bf16*)(ws + WS_R1), (float*)(ws + WS_GA), args.in[4], args.in[5], args.in[6], args.in[7], args.out, args.in[8], args.in[9], args.in[10]};
    if (IN(5)) { naive_mix_phase<false>(F, ma); __syncthreads(); }
    SEAM(5);
    if (IN(6)) { naive_mix_phase<true>(F, ma); __syncthreads(); }
    SEAM(6);
    if (IN(7)) { naive_combine(F, ma); }
    SEAM(7); }
#endif
    if (IN(PB0)) { pg8::Gemm g{(bf16*)((unsigned char*)args.out + (size_t)192 * MiB), (bf16*)(ws + WS_WOUT), M_TOK, D, D, D}; pg8::StaticOrder S; S.init(M_TOK, D, F.G, (int)blockIdx.x);
        pg8::EpiResidB2 E{(const bf16*)(ws + WS_R0), (bf16*)(ws + WS_A2), (float*)(ws + WS_SQ1)};
        pg8::gemm_phase<pg8::EpiResidB2, pg8::StaticOrder, true, true>(F.lds + RING_OFF, g, S, E);
#if REP5
        __syncthreads(); pg8::gemm_phase<pg8::EpiResidB2, pg8::StaticOrder, true, true>(F.lds + RING_OFF, g, S, E);
#endif
    }
    SEAM(PB0);
    if (IN(PB0 + 1)) {
        { const float* sq = (const float*)(ws + WS_SQ1); float* r2v = (float*)(ws + WS_RSTD);
          for (int row = (int)blockIdx.x * NWAVES * 64 + F.tid; row < M_TOK; row += F.G * NWAVES * 64) { const f32x4* s4 = (const f32x4*)(sq + (size_t)row * 16);
              const f32x4 t = (s4[0] + s4[1]) + (s4[2] + s4[3]); r2v[row] = 1.0f / (((t[0] + t[1]) + (t[2] + t[3])) * (1.0f / 1024.0f) + EPS); }
          if (args.use_bar) xcd_barrier(bar); }
        pg8::Gemm g{(bf16*)(ws + WS_A2), (bf16*)(ws + WS_W1), M_TOK, FF, D, D}; pg8::StaticOrder S; S.init(M_TOK, FF, F.G, (int)blockIdx.x);
        pg8::EpiFF1 E{(bf16*)(ws + WS_R1), (float*)(ws + WS_RSTD)};
        pg8::gemm_phase<pg8::EpiFF1, pg8::StaticOrder, true, true>(F.lds + RING_OFF, g, S, E);
#if REP6
        __syncthreads(); pg8::gemm_phase<pg8::EpiFF1, pg8::StaticOrder, true, true>(F.lds + RING_OFF, g, S, E);
#endif
    }
    SEAM(PB0 + 1);
#if H_TILED
    if (IN(PB0 + 2)) { pg8::Gemm g{(bf16*)(ws + WS_R1), (bf16*)(ws + WS_W2), M_TOK, D, FF, 64, W2_TILED ? 64 : 0, 32768, W2_TILED ? 32768 : 0, (long)FF * 512, W2_TILED ? (long)FF * 512 : 0};
#else
    if (IN(PB0 + 2)) { pg8::Gemm g{(bf16*)(ws + WS_R1), (bf16*)(ws + WS_W2), M_TOK, D, FF, FF, W2_TILED ? 64 : 0, 0, W2_TILED ? 32768 : 0, 0, W2_TILED ? (long)FF * 512 : 0};
#endif
        pg8::StaticOrder S; S.init(M_TOK, D, F.G, (int)blockIdx.x, FF2_REV);
        pg8::EpiResidB E{(bf16*)(ws + WS_A2), (float*)(ws + WS_SQ2)};
#if FF2_RING5
        pg8::gemm_phase_r5<pg8::EpiResidB, pg8::StaticOrder>(F.lds + RING_OFF, g, S, E); }
#else
        pg8::gemm_phase<pg8::EpiResidB, pg8::StaticOrder, true, true>(F.lds + RING_OFF, g, S, E); }
#endif
    SEAM(PB0 + 2);
    if (IN(PB0 + 3)) { final_norm(F, args.out, (const bf16*)(ws + WS_A2), (float*)(ws + WS_SQ2), args.in[15]);
#if REP8
        final_norm(F, args.out, (const bf16*)(ws + WS_A2), (float*)(ws + WS_SQ2), args.in[15]);
#endif
    }
#undef IN
#undef SEAM
}

extern "C" void kernel_launch(void* const* d_in, const int* in_sizes, int n_in, void* d_out, int out_size, void* d_ws, size_t ws_size, hipStream_t stream) {
    static int grid = 0;
    if (grid == 0) {
        if (n_in != 16 || in_sizes[0] != M_PROMPT * D || out_size != M_TOK * D || ws_size < WS_END) {
            fprintf(stderr, "kernel_launch: unexpected shapes (n_in %d, in0 %d, out %d, ws %zu); nothing launched\n", n_in, n_in > 0 ? in_sizes[0] : -1, out_size, ws_size); grid = -1; return; }
        int dev = 0, cus = 0, per_cu = 0;
        if (hipGetDevice(&dev) != hipSuccess || hipDeviceGetAttribute(&cus, hipDeviceAttributeMultiprocessorCount, dev) != hipSuccess) { grid = -1; return; }
        if (hipFuncSetAttribute((const void*)fwd_kernel, hipFuncAttributeMaxDynamicSharedMemorySize, LDS_BYTES) != hipSuccess) { fprintf(stderr, "kernel_launch: hipFuncSetAttribute failed\n"); grid = -1; return; }
        if (hipOccupancyMaxActiveBlocksPerMultiprocessor(&per_cu, (const void*)fwd_kernel, NWAVES * 64, LDS_BYTES) != hipSuccess || per_cu < 1)
            fprintf(stderr, "kernel_launch: note: occupancy query reports %d workgroups per CU\n", per_cu);
        (void)hipGetLastError();
        grid = cus;
    }
    if (grid < 0) return;
    if (hipMemsetAsync((char*)d_ws + WS_CTL, 0, CTL_ZERO_BYTES, stream) != hipSuccess) return;
    Args a{};
    for (int i = 0; i < 16; ++i) a.in[i] = (const float*)d_in[i];
    a.out = (float*)d_out; a.ws = (unsigned char*)d_ws;
#if MK_SINGLE
    a.ph_lo = 0; a.ph_hi = NPH; a.use_bar = 1;
    hipLaunchKernelGGL(fwd_kernel, dim3(grid), dim3(NWAVES * 64), LDS_BYTES, stream, a);
#else
    for (int p = 0; p < NPH; ++p) { a.ph_lo = p; a.ph_hi = p + 1; a.use_bar = 0;
        hipLaunchKernelGGL(fwd_kernel, dim3(grid), dim3(NWAVES * 64), LDS_BYTES, stream, a); }
#endif
}
```

```cpp
#include <hip/hip_runtime.h>
#include <cstdio>
#ifndef MK_SINGLE
#define MK_SINGLE 1
#endif
#ifndef MIX_GLA
#define MIX_GLA 1
#define MIX_RET 1
#define REP1 0
#define REP2 0
#define REP3 0
#define REP4 0
#define REP6 0
#define DUP 0
#define ABLV 0
#define REP0 0
#define RELAX_MASK 0
#define STAG_TICKS 0
#define PROF_PHASE -1
#define PROF_A 1
#define PROF_B 2
#define PROF_BLOCK 0
#define PROF_DELAY 0
#define FF2X 0
#define LEAD_FF2 1
#define LEAD_IN 0
#define LEAD_OUT 0
#define LEAD_FF1 0
#define PROJ_ROWMAJOR 0
#define H_TILED 1
#define EPI_PLAIN_VARIANT 0
#define PROF_OA 0ull
#define PROF_OB 0ull
#define PROF_QA 25ull
#define PROF_QB 25ull
#define REP5 0
#define REP8 0
#endif
namespace pg8 {
#define PG8_LAS __attribute__((address_space(3)))
typedef unsigned short bf16_t;
typedef short bf16x8 __attribute__((ext_vector_type(8)));
typedef float f32x4 __attribute__((ext_vector_type(4)));
typedef unsigned u32x4 __attribute__((ext_vector_type(4)));
constexpr int BM = 256, BK = 64, HALF = 128, HTB = HALF * BK * 2  , STAGE_BYTES = 8 * HTB, NXCD = 8, WGM = 8;

__host__ __device__ __forceinline__ int lds_byte(int r, int c) { const int st = (r >> 4) * 2 + (c >> 5), rr = r & 15, cc = c & 31, ob = rr * 64 + cc * 2; return st * 1024 + (ob ^ (((ob >> 9) & 1) << 5)); }
__host__ __device__ __forceinline__ void stage_rc(int b, int& R, int& C) { const int st = b / 1024, sb = b % 1024, swz = sb ^ (((sb >> 9) & 1) << 5); R = (st >> 1) * 16 + swz / 64; C = (st & 1) * 32 + (swz % 64) / 2; }
__host__ __device__ __forceinline__ int perm32(int rho) { const int n = rho >> 4, i = rho & 15; return 8 * (i >> 2) + 4 * n + (i & 3); }

struct Unit { int pm, pn; };
struct Gemm { const bf16_t* A; const bf16_t* Bt; int M, N, K, lda; int ldb, ksA, ksB; long psA, psB; };

struct StaticOrder {
    int nM, nN, nwg, G, c, rev;
    __host__ __device__ void init(int M, int N, int G_, int c_, int rev_ = 0) { nM = M / BM; nN = N / BM; nwg = nM * nN; G = G_; c = c_; rev = rev_; }
    __host__ __device__ bool next(int i, Unit& u) const {
        if ((long)i * G + c >= nwg) return false;
        const long L = (long)(rev ? (nwg - 1 - c) / G - i : i) * G + c;
        int wgid = (int)L; { const int q = nwg / NXCD, r = nwg % NXCD, xcd = wgid % NXCD, off = wgid / NXCD; wgid = (xcd < r ? xcd * (q + 1) : r * (q + 1) + (xcd - r) * q) + off; }
        const int nig = WGM * nN, gid = wgid / nig, fm = gid * WGM, gsz = (nM - fm) < WGM ? (nM - fm) : WGM;
        u.pm = fm + ((wgid % nig) % gsz); u.pn = (wgid % nig) / gsz; return true;
    }
    __device__ __forceinline__ void a_ready(const Unit&) const {}
    __device__ __forceinline__ void done(const Unit&) const {}
};
struct InProjOrder {
    int x, r;
    __host__ __device__ void init(int c_) { x = c_ & 7; r = c_ >> 3; }
    __host__ __device__ bool next(int i, Unit& u) const {
        if (i >= 21) return false;
        const int gi = i / 7, ri = i % 7;
        if (ri < 6) { u.pm = x * 48 + 16 * gi + 8 * (ri & 1) + (r & 7); u.pn = 4 * (ri >> 1) + (r >> 3); }
        else { u.pm = x * 48 + 16 * gi + (r & 15); u.pn = 12 + (r >> 4); }
        return true;
    }
    __device__ __forceinline__ void a_ready(const Unit&) const {}
    __device__ __forceinline__ void done(const Unit&) const {}
};
__device__ __forceinline__ unsigned cvt_pk_bf16(float lo, float hi) { unsigned r; asm volatile("v_cvt_pk_bf16_f32 %0, %1, %2" : "=v"(r) : "v"(lo), "v"(hi)); return r; }
__device__ __forceinline__ u32x4 pack8(const f32x4& a, const f32x4& b) { u32x4 w; w.x = cvt_pk_bf16(a[0], a[1]); w.y = cvt_pk_bf16(a[2], a[3]); w.z = cvt_pk_bf16(b[0], b[1]); w.w = cvt_pk_bf16(b[2], b[3]); return w; }
#ifndef H_TILED
#define H_TILED 0
#endif
#ifndef PLANE_PAD_ROWS
#define PLANE_PAD_ROWS 64
#endif
#ifndef PROJ_ROWMAJOR
#define PROJ_ROWMAJOR 0
#endif
#ifndef RELAX_MASK
#define RELAX_MASK 0
#endif
constexpr int NPROJ = 3584, DMODEL = 1024, DFF = 4096, MPROMPT = 65536;

constexpr size_t MTOK = 98304 + PLANE_PAD_ROWS;
#if PROJ_ROWMAJOR
constexpr size_t PL_GV = 0, PL_RV = 512, PL_GQ = 1024, PL_GK = 1280, PL_GG = 1536, PL_RQ = 2048, PL_RK = 2560, PL_RG = 3072, PL_END = (size_t)98304 * 4096;
__device__ __forceinline__ size_t pl(size_t grp, int hh, size_t row, int W) { return row * 4096 + grp + (size_t)(hh * W); }
#else
constexpr size_t PL_GV = 0, PL_RV = PL_GV + 4 * MTOK * 128, PL_GQ = PL_RV + 4 * MTOK * 128, PL_GK = PL_GQ + 4 * MTOK * 64, PL_GG = PL_GK + 4 * MTOK * 64,
                 PL_RQ = PL_GG + 4 * MTOK * 128, PL_RK = PL_RQ + 4 * MTOK * 128, PL_RG = PL_RK + 4 * MTOK * 128, PL_END = PL_RG + 4 * MTOK * 128;
__device__ __forceinline__ size_t pl(size_t grp, int hh, size_t row, int W) { return grp + ((size_t)hh * MTOK + row) * (size_t)W; }
#endif
__device__ __forceinline__ void plane_of(int pn, int bj, int wc, size_t& grp, int& hh, int& W, int& col) {
    W = 128; col = 32 * wc; hh = 2 * (pn & 1) + bj;
    switch (pn >> 1) { case 0: grp = PL_GV; break; case 1: grp = PL_RV; break; case 3: grp = PL_GG; break; case 4: grp = PL_RQ; break; case 5: grp = PL_RK; break; case 6: grp = PL_RG; break;
        default: grp = (pn & 1) ? PL_GK : PL_GQ; W = 64; hh = 2 * bj + (wc >> 1); col = 32 * (wc & 1); break; }
}
struct EpiInProj {
    static constexpr bool PERM = true, AFTER_DRAIN = false, RELAX = (RELAX_MASK & 1) != 0;
    bf16_t* P; const float* rstd; const float* rcos; const float* rsin;
    __device__ __forceinline__ void operator()(const f32x4 (&acc)[2][2][4][2], const Unit& u, int wr, int wc, int fr_in, int fq_in) const {
        int fr = fr_in, fq = fq_in; asm volatile("" : "+v"(fr), "+v"(fq));
        const int row0 = u.pm * BM + wr * 64 + fr;
        const bool rot = (u.pn >= 8) && (u.pn < 12);
        const int i0 = (4 * wc + fq) * 4;
        size_t pgrp[2]; int phh[2]; int W, col;
        plane_of(u.pn, 0, wc, pgrp[0], phh[0], W, col); plane_of(u.pn, 1, wc, pgrp[1], phh[1], W, col);
        const int pos0 = row0 < MPROMPT ? (row0 & 2047) : (row0 & 16383);
        f32x4 cc = (f32x4){1.f, 1.f, 1.f, 1.f}, ss = (f32x4){0.f, 0.f, 0.f, 0.f}, cd16 = cc, sd16 = ss, cd80 = cc, sd80 = ss;
        if (rot) {
            cc = *(const f32x4*)(rcos + pos0 * 64 + i0); ss = *(const f32x4*)(rsin + pos0 * 64 + i0);
            cd16 = *(const f32x4*)(rcos + 16 * 64 + i0); sd16 = *(const f32x4*)(rsin + 16 * 64 + i0); cd80 = *(const f32x4*)(rcos + 80 * 64 + i0); sd80 = *(const f32x4*)(rsin + 80 * 64 + i0); }
        float rs[2][4];
#pragma unroll
        for (int ai = 0; ai < 2; ++ai)
#pragma unroll
            for (int m = 0; m < 4; ++m) rs[ai][m] = rstd[row0 + ai * HALF + m * 16];
        __builtin_amdgcn_sched_barrier(0);
        const f32x4 cc0 = cc, ss0 = ss;
#pragma unroll
        for (int bj = 0; bj < 2; ++bj) {
            cc = cc0; ss = ss0;
#pragma unroll
            for (int ai = 0; ai < 2; ++ai)
#pragma unroll
                for (int m = 0; m < 4; ++m) {
                    const int row = row0 + ai * HALF + m * 16;
                    f32x4 v0 = acc[ai][bj][m][0] * rs[ai][m], v1 = acc[ai][bj][m][1] * rs[ai][m];
                    if (rot) { const f32x4 lo = v0 * cc - v1 * ss, hi = v0 * ss + v1 * cc; v0 = lo; v1 = hi; }
                    *(u32x4*)(P + pl(pgrp[bj], phh[bj], (size_t)row, W) + col + 8 * fq) = pack8(v0, v1);
                    if (rot && !(ai == 1 && m == 3)) { const f32x4 cd = m == 3 ? cd80 : cd16, sd = m == 3 ? sd80 : sd16; const f32x4 nc = cc * cd - ss * sd, ns = ss * cd + cc * sd; cc = nc; ss = ns; }
                }
        }
    }
};
struct EpiResid {
    static constexpr bool PERM = true, AFTER_DRAIN = false, RELAX = false;
    const float* xp; const float* xs; float* out; bf16_t* A2; float* sq;
    __device__ __forceinline__ void operator()(const f32x4 (&acc)[2][2][4][2], const Unit& u, int wr, int wc, int fr_in, int fq_in) const {
        int fr = fr_in, fq = fq_in; asm volatile("" : "+v"(fr), "+v"(fq));
        const int row0 = u.pm * BM + wr * 64 + fr, colb = u.pn * BM + wc * 32 + 8 * fq;
#pragma unroll
        for (int ai = 0; ai < 2; ++ai)
#pragma unroll
            for (int m = 0; m < 4; ++m) {
                const int row = row0 + ai * HALF + m * 16;
                const float* xrow = (row < MPROMPT ? xp + (size_t)row * DMODEL : xs + (size_t)(row - MPROMPT) * DMODEL) + colb;
                float* orow = out + (size_t)row * DMODEL + colb;
                float ss = 0.f;
#pragma unroll
                for (int bj = 0; bj < 2; ++bj) {
                    const f32x4 x0 = *(const f32x4*)(xrow + bj * HALF), x1 = *(const f32x4*)(xrow + bj * HALF + 4);
                    const f32x4 v0 = acc[ai][bj][m][0] + x0, v1 = acc[ai][bj][m][1] + x1;
                    *(f32x4*)(orow + bj * HALF) = v0; *(f32x4*)(orow + bj * HALF + 4) = v1;
                    if (A2) *(u32x4*)(A2 + (size_t)row * DMODEL + colb + bj * HALF) = pack8(v0, v1);
                    ss += (v0[0] * v0[0] + v0[1] * v0[1]) + (v0[2] * v0[2] + v0[3] * v0[3]) + (v1[0] * v1[0] + v1[1] * v1[1]) + (v1[2] * v1[2] + v1[3] * v1[3]);
                }
                ss += __shfl_xor(ss, 16); ss += __shfl_xor(ss, 32);
                if (fq == 0) sq[(size_t)row * 16 + u.pn * 4 + wc] = ss;
            }
    }
};
struct EpiFF1 {
    static constexpr bool PERM = true, AFTER_DRAIN = false, RELAX = (RELAX_MASK & 4) != 0;
    bf16_t* H; const float* r2v;
    __device__ __forceinline__ void operator()(const f32x4 (&acc)[2][2][4][2], const Unit& u, int wr, int wc, int fr_in, int fq_in) const {
        int fr = fr_in, fq = fq_in; asm volatile("" : "+v"(fr), "+v"(fq));
        const int row0 = u.pm * BM + wr * 64 + fr, colb = u.pn * BM + wc * 32 + 8 * fq;
        float r2[2][4];
#pragma unroll
        for (int ai = 0; ai < 2; ++ai)
#pragma unroll
            for (int m = 0; m < 4; ++m) r2[ai][m] = r2v[row0 + ai * HALF + m * 16];
        __builtin_amdgcn_sched_barrier(0);
#pragma unroll
        for (int ai = 0; ai < 2; ++ai)
#pragma unroll
            for (int m = 0; m < 4; ++m) {
                const int row = row0 + ai * HALF + m * 16;
#if H_TILED
                bf16_t* rowp = H + ((size_t)u.pm * (DFF / 64) + (size_t)(u.pn * 4 + (wc >> 1))) * (256 * 64) + (size_t)(wr * 64 + fr + ai * HALF + m * 16) * 64 + (wc & 1) * 32 + 8 * fq;
#else
                bf16_t* rowp = H + (size_t)row * DFF + colb;
#endif
#pragma unroll
                for (int bj = 0; bj < 2; ++bj) {
                    f32x4 v0 = acc[ai][bj][m][0], v1 = acc[ai][bj][m][1];
#pragma unroll
                    for (int j = 0; j < 4; ++j) { const float a = fmaxf(v0[j], 0.f), b = fmaxf(v1[j], 0.f); v0[j] = a * a * r2[ai][m]; v1[j] = b * b * r2[ai][m]; }
                    *(u32x4*)(rowp + bj * (H_TILED ? 2 * 256 * 64 : HALF)) = pack8(v0, v1);
                }
            }
    }
};

struct EpiPlain {
    static constexpr bool PERM = true, AFTER_DRAIN = false, RELAX = false;
    bf16_t* P;
    __device__ __forceinline__ void operator()(const f32x4 (&acc)[2][2][4][2], const Unit& u, int wr, int wc, int fr_in, int fq_in) const {
        int fr = fr_in, fq = fq_in; asm volatile("" : "+v"(fr), "+v"(fq));
        const int row0 = u.pm * BM + wr * 64 + fr;
        size_t pgrp[2]; int phh[2]; int W, col;
        plane_of(u.pn, 0, wc, pgrp[0], phh[0], W, col); plane_of(u.pn, 1, wc, pgrp[1], phh[1], W, col);
#pragma unroll
        for (int ai = 0; ai < 2; ++ai)
#pragma unroll
            for (int m = 0; m < 4; ++m) { const int row = row0 + ai * HALF + m * 16;
#pragma unroll
                for (int bj = 0; bj < 2; ++bj) *(u32x4*)(P + pl(pgrp[bj], phh[bj], (size_t)row, W) + col + 8 * fq) = pack8(acc[ai][bj][m][0], acc[ai][bj][m][1]); }
    }
};

struct EpiResidX {
    static constexpr bool PERM = true, AFTER_DRAIN = false, RELAX = (RELAX_MASK & 2) != 0;
    const float* xp; const float* xs; bf16_t* A2; float* sq;
    __device__ __forceinline__ void operator()(const f32x4 (&acc)[2][2][4][2], const Unit& u, int wr, int wc, int fr_in, int fq_in) const {
        int fr = fr_in, fq = fq_in; asm volatile("" : "+v"(fr), "+v"(fq));
        const int row0 = u.pm * BM + wr * 64 + fr, colb = u.pn * BM + wc * 32 + 8 * fq;
#pragma unroll
        for (int ai = 0; ai < 2; ++ai) {
            f32x4 xv[4][2][2];
#pragma unroll
            for (int m = 0; m < 4; ++m) { const int row = row0 + ai * HALF + m * 16;
                const float* xrow = (row < MPROMPT ? xp + (size_t)row * DMODEL : xs + (size_t)(row - MPROMPT) * DMODEL) + colb;
#pragma unroll
                for (int bj = 0; bj < 2; ++bj) { xv[m][bj][0] = *(const f32x4*)(xrow + bj * HALF); xv[m][bj][1] = *(const f32x4*)(xrow + bj * HALF + 4); } }
            __builtin_amdgcn_sched_barrier(0);
#pragma unroll
            for (int m = 0; m < 4; ++m) {
                const int row = row0 + ai * HALF + m * 16;
                float ss = 0.f;
#pragma unroll
                for (int bj = 0; bj < 2; ++bj) {
                    const f32x4 v0 = acc[ai][bj][m][0] + xv[m][bj][0], v1 = acc[ai][bj][m][1] + xv[m][bj][1];
                    *(u32x4*)(A2 + (size_t)row * DMODEL + colb + bj * HALF) = pack8(v0, v1);
                    ss += (v0[0] * v0[0] + v0[1] * v0[1]) + (v0[2] * v0[2] + v0[3] * v0[3]) + (v1[0] * v1[0] + v1[1] * v1[1]) + (v1[2] * v1[2] + v1[3] * v1[3]);
                }
                ss += __shfl_xor(ss, 16); ss += __shfl_xor(ss, 32);
                if (fq == 0) sq[(size_t)row * 16 + u.pn * 4 + wc] = ss;
            }
            __builtin_amdgcn_sched_barrier(0);
        }
    }
};
struct EpiResidB {
    static constexpr bool PERM = true, AFTER_DRAIN = false, RELAX = (RELAX_MASK & 8) != 0;
    bf16_t* A2; float* sq;
    __device__ __forceinline__ void operator()(const f32x4 (&acc)[2][2][4][2], const Unit& u, int wr, int wc, int fr_in, int fq_in) const {
        int fr = fr_in, fq = fq_in; asm volatile("" : "+v"(fr), "+v"(fq));
        const int row0 = u.pm * BM + wr * 64 + fr, colb = u.pn * BM + wc * 32 + 8 * fq;
        u32x4 xw[2][4][2];
#pragma unroll
        for (int ai = 0; ai < 2; ++ai)
#pragma unroll
            for (int m = 0; m < 4; ++m)
#pragma unroll
                for (int bj = 0; bj < 2; ++bj) xw[ai][m][bj] = *(const u32x4*)(A2 + (size_t)(row0 + ai * HALF + m * 16) * DMODEL + colb + bj * HALF);
        __builtin_amdgcn_sched_barrier(0);
#pragma unroll
        for (int ai = 0; ai < 2; ++ai)
#pragma unroll
            for (int m = 0; m < 4; ++m) {
                const int row = row0 + ai * HALF + m * 16;
                bf16_t* xr = A2 + (size_t)row * DMODEL + colb;
                float ss = 0.f;
#pragma unroll
                for (int bj = 0; bj < 2; ++bj) {
                    const u32x4 w_ = xw[ai][m][bj];
                    const f32x4 x0 = {__uint_as_float(w_.x << 16), __uint_as_float(w_.x & 0xffff0000u), __uint_as_float(w_.y << 16), __uint_as_float(w_.y & 0xffff0000u)};
                    const f32x4 x1 = {__uint_as_float(w_.z << 16), __uint_as_float(w_.z & 0xffff0000u), __uint_as_float(w_.w << 16), __uint_as_float(w_.w & 0xffff0000u)};
                    const f32x4 v0 = acc[ai][bj][m][0] + x0, v1 = acc[ai][bj][m][1] + x1;
                    *(u32x4*)(xr + bj * HALF) = pack8(v0, v1);
                    ss += (v0[0] * v0[0] + v0[1] * v0[1]) + (v0[2] * v0[2] + v0[3] * v0[3]) + (v1[0] * v1[0] + v1[1] * v1[1]) + (v1[2] * v1[2] + v1[3] * v1[3]);
                }
                ss += __shfl_xor(ss, 16); ss += __shfl_xor(ss, 32);
                if (fq == 0) sq[(size_t)row * 16 + u.pn * 4 + wc] = ss;
            }
    }
};

struct EpiResidB2 {
    static constexpr bool PERM = true, AFTER_DRAIN = false, RELAX = (RELAX_MASK & 8) != 0;
    const bf16_t* X; bf16_t* A2; float* sq;
    __device__ __forceinline__ void operator()(const f32x4 (&acc)[2][2][4][2], const Unit& u, int wr, int wc, int fr_in, int fq_in) const {
        int fr = fr_in, fq = fq_in; asm volatile("" : "+v"(fr), "+v"(fq));
        const int row0 = u.pm * BM + wr * 64 + fr, colb = u.pn * BM + wc * 32 + 8 * fq;
        u32x4 xw[2][4][2];
#pragma unroll
        for (int ai = 0; ai < 2; ++ai)
#pragma unroll
            for (int m = 0; m < 4; ++m)
#pragma unroll
                for (int bj = 0; bj < 2; ++bj) xw[ai][m][bj] = *(const u32x4*)(X + (size_t)(row0 + ai * HALF + m * 16) * DMODEL + colb + bj * HALF);
        __builtin_amdgcn_sched_barrier(0);
#pragma unroll
        for (int ai = 0; ai < 2; ++ai)
#pragma unroll
            for (int m = 0; m < 4; ++m) {
                const int row = row0 + ai * HALF + m * 16;
                bf16_t* xr = A2 + (size_t)row * DMODEL + colb;
                float ss = 0.f;
#pragma unroll
                for (int bj = 0; bj < 2; ++bj) {
                    const u32x4 w_ = xw[ai][m][bj];
                    const f32x4 x0 = {__uint_as_float(w_.x << 16), __uint_as_float(w_.x & 0xffff0000u), __uint_as_float(w_.y << 16), __uint_as_float(w_.y & 0xffff0000u)};
                    const f32x4 x1 = {__uint_as_float(w_.z << 16), __uint_as_float(w_.z & 0xffff0000u), __uint_as_float(w_.w << 16), __uint_as_float(w_.w & 0xffff0000u)};
                    const f32x4 v0 = acc[ai][bj][m][0] + x0, v1 = acc[ai][bj][m][1] + x1;
                    *(u32x4*)(xr + bj * HALF) = pack8(v0, v1);
                    ss += (v0[0] * v0[0] + v0[1] * v0[1]) + (v0[2] * v0[2] + v0[3] * v0[3]) + (v1[0] * v1[0] + v1[1] * v1[1]) + (v1[2] * v1[2] + v1[3] * v1[3]);
                }
                ss += __shfl_xor(ss, 16); ss += __shfl_xor(ss, 32);
                if (fq == 0) sq[(size_t)row * 16 + u.pn * 4 + wc] = ss;
            }
    }
};

struct EpiNull {
    static constexpr bool PERM = true, AFTER_DRAIN = false, RELAX = false;
    __device__ __forceinline__ void operator()(const f32x4 (&acc)[2][2][4][2], const Unit& u, int wr, int wc, int fr_in, int fq_in) const {
        int fr = fr_in, fq = fq_in; asm volatile("" : "+v"(fr), "+v"(fq));
#pragma unroll
        for (int ai = 0; ai < 2; ++ai)
#pragma unroll
            for (int m = 0; m < 4; ++m)
#pragma unroll
                for (int bj = 0; bj < 2; ++bj) asm volatile("" :: "v"(acc[ai][bj][m][0]), "v"(acc[ai][bj][m][1]));
    }
};
template <class Epi, class Sched, bool ALIGN_EPI = false, bool SP2 = false, bool PROF = false, int TOUCH = 0>
__device__ __forceinline__ void gemm_phase(PG8_LAS unsigned char* lds, const Gemm g, const Sched& S, const Epi& E) {
    const int tid = threadIdx.x, wid = __builtin_amdgcn_readfirstlane(tid >> 6), lane = tid & 63, wr = wid >> 2, wc = wid & 3, fr = lane & 15, fq = lane >> 4;
    const int K = g.K, nt = K / BK, ldb = g.ldb ? g.ldb : K;
    unsigned voffA[2], voffB[2];
#pragma unroll
    for (int i = 0; i < 2; ++i) { int R, C; stage_rc(tid * 16 + i * 8192, R, C); const int Rb = Epi::PERM ? ((R & ~31) + perm32(R & 31)) : R;
        voffA[i] = (unsigned)(R * g.lda + C) * 2u; voffB[i] = (unsigned)(Rb * ldb + C) * 2u; }
    const size_t kstepA = g.ksA ? (size_t)g.ksA : (size_t)(BK * 2), kstepB = g.ksB ? (size_t)g.ksB : (size_t)(BK * 2);
    const size_t hstepB = (size_t)HALF * ldb * 2, hstepA = (size_t)HALF * g.lda * 2;
    const size_t tstepB = g.psB ? (size_t)g.psB : 2 * hstepB, tstepA = g.psA ? (size_t)g.psA : 2 * hstepA;
    const unsigned ldsw = (unsigned)wid * 1024u;
    const int aoff = lds_byte(wr * 64 + fr, fq * 8), boff = lds_byte(wc * 32 + fr, fq * 8);
#define PG8_SA(b, h) (((b) * 2 + (h)) * HTB)
#define PG8_SB(b, h) ((4 + (b) * 2 + (h)) * HTB)
#define PG8_STAGE(bufoff, gbase, voff) do { _Pragma("unroll") for (int _i = 0; _i < 2; ++_i) \
        __builtin_amdgcn_global_load_lds((const unsigned*)((const char*)(gbase) + (voff)[_i]), (PG8_LAS unsigned*)(lds + (bufoff) + ldsw + _i * 8192), 16, 0, 0); } while (0)
#define PG8_LDA(dst, b, h) do { _Pragma("unroll") for (int m = 0; m < 4; ++m) _Pragma("unroll") for (int k = 0; k < 2; ++k) dst[m][k] = *(const PG8_LAS bf16x8*)(lds + PG8_SA(b, h) + aoff + m * 2048 + k * 1024); } while (0)
#define PG8_LDB(dst, b, h) do { _Pragma("unroll") for (int n = 0; n < 2; ++n) _Pragma("unroll") for (int k = 0; k < 2; ++k) dst[n][k] = *(const PG8_LAS bf16x8*)(lds + PG8_SB(b, h) + boff + n * 2048 + k * 1024); } while (0)
#define PG8_MMA(ai, bj, At, Bt) do { __builtin_amdgcn_s_setprio(1); _Pragma("unroll") for (int m = 0; m < 4; ++m) _Pragma("unroll") for (int n = 0; n < 2; ++n) _Pragma("unroll") for (int k = 0; k < 2; ++k) \
        acc[ai][bj][m][n] = __builtin_amdgcn_mfma_f32_16x16x32_bf16(Bt[n][k], At[m][k], acc[ai][bj][m][n], 0, 0, 0); __builtin_amdgcn_s_setprio(0); } while (0)
#define PG8_WAIT_V(n) asm volatile("s_waitcnt vmcnt(" #n ")" ::: "memory")
#define PG8_WAIT_L(n) asm volatile("s_waitcnt lgkmcnt(" #n ")" ::: "memory")
#define PG8_WAIT_VF(first, nrel) asm volatile("s_cmp_lg_u32 %0, 0\n\ts_cbranch_scc1 1f\n\ts_waitcnt vmcnt(8)\n\ts_branch 2f\n1:\n\ts_waitcnt vmcnt(" #nrel ")\n2:" :: "s"(first) : "memory", "scc")
#define PG8_BAR __builtin_amdgcn_s_barrier()
#define PG8_SCHED __builtin_amdgcn_sched_barrier(0)
    Unit cur, nxt; int ui = 0;
    if (!S.next(0, cur)) return;
    f32x4 acc[2][2][4][2];
#pragma unroll
    for (int a = 0; a < 2; ++a)
#pragma unroll
        for (int b = 0; b < 2; ++b)
#pragma unroll
            for (int m = 0; m < 4; ++m)
#pragma unroll
                for (int n = 0; n < 2; ++n) acc[a][b][m][n] = (f32x4){0.f, 0.f, 0.f, 0.f};
    bf16x8 At[4][2], B0[2][2], B1[2][2];
    const char* cA = (const char*)g.A + (size_t)cur.pm * tstepA; const char* cB = (const char*)g.Bt + (size_t)cur.pn * tstepB;
    S.a_ready(cur);
    if constexpr (SP2) {
        PG8_STAGE(PG8_SB(0, 0), cB, voffB); PG8_STAGE(PG8_SB(0, 1), cB + hstepB, voffB); PG8_STAGE(PG8_SA(0, 0), cA, voffA); PG8_STAGE(PG8_SA(0, 1), cA + hstepA, voffA);
        if (wr == 1) PG8_BAR;
        PG8_WAIT_V(2); PG8_BAR;
        PG8_STAGE(PG8_SB(1, 0), cB + kstepB, voffB); PG8_STAGE(PG8_SA(1, 0), cA + kstepA, voffA); PG8_STAGE(PG8_SB(1, 1), cB + hstepB + kstepB, voffB); PG8_STAGE(PG8_SA(1, 1), cA + hstepA + kstepA, voffA);
        PG8_WAIT_V(8); PG8_BAR;
    } else {
        PG8_STAGE(PG8_SB(0, 0), cB, voffB); PG8_STAGE(PG8_SA(0, 0), cA, voffA); PG8_STAGE(PG8_SB(0, 1), cB + hstepB, voffB); PG8_STAGE(PG8_SA(0, 1), cA + hstepA, voffA);
        if (wr == 1) PG8_BAR;
        PG8_WAIT_V(4); PG8_BAR;
        PG8_STAGE(PG8_SB(1, 0), cB + kstepB, voffB); PG8_STAGE(PG8_SA(1, 0), cA + kstepA, voffA); PG8_STAGE(PG8_SB(1, 1), cB + hstepB + kstepB, voffB);
        PG8_WAIT_V(6); PG8_BAR;
    }
    for (;;) {
        const bool has_next = S.next(ui + 1, nxt);
        const char* nA = has_next ? (const char*)g.A + (size_t)nxt.pm * tstepA : cA; const char* nB = has_next ? (const char*)g.Bt + (size_t)nxt.pn * tstepB : cB;
        for (int t = 0; t < nt; t += 2) {
            const bool last = (t == nt - 2);
            const char* a1 = cA + (size_t)(t + 1) * kstepA;
            const char* a2 = last ? nA : cA + (size_t)(t + 2) * kstepA; const char* b2 = last ? nB : cB + (size_t)(t + 2) * kstepB;
            const char* a3 = a2 + kstepA; const char* b3 = b2 + kstepB;
            if (last && has_next) S.a_ready(nxt);
            if constexpr (SP2) {
            const int first = __builtin_amdgcn_readfirstlane((t == 0 && ui > 0) ? 1 : 0);
            PG8_LDB(B0, 0, 0); PG8_LDB(B1, 0, 1); PG8_SCHED; PG8_LDA(At, 0, 0);
            PG8_WAIT_VF(first, 16); PG8_WAIT_L(0); PG8_BAR; PG8_MMA(0, 0, At, B0); PG8_MMA(0, 1, At, B1); PG8_BAR; PG8_SCHED;
            PG8_LDA(At, 0, 1); PG8_STAGE(PG8_SB(0, 0), b2, voffB); PG8_STAGE(PG8_SB(0, 1), b2 + hstepB, voffB); PG8_STAGE(PG8_SA(0, 0), a2, voffA);
            PG8_WAIT_VF(first, 22); PG8_WAIT_L(0); PG8_BAR; PG8_MMA(1, 0, At, B0); PG8_MMA(1, 1, At, B1); PG8_BAR; PG8_SCHED;
            PG8_LDB(B0, 1, 0); PG8_LDB(B1, 1, 1); PG8_SCHED; PG8_LDA(At, 1, 0); PG8_STAGE(PG8_SA(0, 1), a2 + hstepA, voffA);
            PG8_WAIT_VF(first, 24); PG8_WAIT_L(0); PG8_BAR; PG8_MMA(0, 0, At, B0); PG8_MMA(0, 1, At, B1); PG8_BAR; PG8_SCHED;
            PG8_LDA(At, 1, 1); PG8_STAGE(PG8_SB(1, 0), b3, voffB); PG8_STAGE(PG8_SB(1, 1), b3 + hstepB, voffB); PG8_STAGE(PG8_SA(1, 0), a3, voffA);
            PG8_WAIT_V(8); PG8_WAIT_L(0); PG8_BAR; PG8_MMA(1, 0, At, B0); PG8_MMA(1, 1, At, B1); PG8_BAR; PG8_SCHED;
            PG8_STAGE(PG8_SA(1, 1), a3 + hstepA, voffA);
            if constexpr (TOUCH != 0) { if (t == 0 && has_next) {
                __builtin_amdgcn_global_load_lds((const unsigned*)(nA + ((size_t)tid << 12) % tstepA), (PG8_LAS unsigned*)(lds + STAGE_BYTES + wid * 256), 4, 0, 0);
                if (TOUCH > 1) __builtin_amdgcn_global_load_lds((const unsigned*)(nB + ((size_t)tid << 12) % tstepB), (PG8_LAS unsigned*)(lds + STAGE_BYTES + 2048 + wid * 256), 4, 0, 0); } }
            } else {
            PG8_LDB(B0, 0, 0); PG8_SCHED; PG8_LDA(At, 0, 0); PG8_STAGE(PG8_SA(1, 1), a1 + hstepA, voffA);
            PG8_WAIT_L(8); PG8_BAR; PG8_WAIT_L(0); PG8_MMA(0, 0, At, B0); PG8_BAR; PG8_SCHED;
            PG8_LDB(B1, 0, 1); PG8_STAGE(PG8_SB(0, 0), b2, voffB);
            PG8_BAR; PG8_WAIT_L(0); PG8_MMA(0, 1, At, B1); PG8_BAR;
            PG8_LDA(At, 0, 1); PG8_STAGE(PG8_SA(0, 0), a2, voffA);
            PG8_BAR; PG8_WAIT_L(0); PG8_MMA(1, 0, At, B0); PG8_BAR; PG8_SCHED;
            PG8_STAGE(PG8_SB(0, 1), b2 + hstepB, voffB);
            PG8_WAIT_V(6); PG8_BAR; PG8_MMA(1, 1, At, B1); PG8_BAR;
            PG8_LDB(B0, 1, 0); PG8_SCHED; PG8_LDA(At, 1, 0); PG8_STAGE(PG8_SA(0, 1), a2 + hstepA, voffA);
            PG8_WAIT_L(8); PG8_BAR; PG8_WAIT_L(0); PG8_MMA(0, 0, At, B0); PG8_BAR; PG8_SCHED;
            PG8_LDB(B1, 1, 1); PG8_STAGE(PG8_SB(1, 0), b3, voffB);
            PG8_BAR; PG8_WAIT_L(0); PG8_MMA(0, 1, At, B1); PG8_BAR;
            PG8_LDA(At, 1, 1); PG8_STAGE(PG8_SA(1, 0), a3, voffA);
            PG8_BAR; PG8_WAIT_L(0); PG8_MMA(1, 0, At, B0); PG8_BAR; PG8_SCHED;
            PG8_STAGE(PG8_SB(1, 1), b3 + hstepB, voffB);
            PG8_WAIT_V(6); PG8_BAR; PG8_MMA(1, 1, At, B1); PG8_BAR;
            }
        }
        if constexpr (ALIGN_EPI) { if (wr == 0) PG8_BAR; }
        if constexpr (!Epi::AFTER_DRAIN) { E(acc, cur, wr, wc, fr, fq); S.done(cur); }
        if (!has_next) break;
#pragma unroll
        for (int a = 0; a < 2; ++a)
#pragma unroll
            for (int b = 0; b < 2; ++b)
#pragma unroll
                for (int m = 0; m < 4; ++m)
#pragma unroll
                    for (int n = 0; n < 2; ++n) acc[a][b][m][n] = (f32x4){0.f, 0.f, 0.f, 0.f};
        cur = nxt; cA = nA; cB = nB; ++ui;
        if constexpr (ALIGN_EPI) { if (wr == 1) PG8_BAR; }
    }
    PG8_WAIT_V(0);
    if constexpr (!ALIGN_EPI) { if (wr == 0) PG8_BAR; }
    PG8_BAR;
    if constexpr (Epi::AFTER_DRAIN) { E.fused(acc, cur, wr, wc, fr, fq, lds, wid, lane); S.done(cur); }
#undef PG8_SA
#undef PG8_SB
#undef PG8_STAGE
#undef PG8_LDA
#undef PG8_LDB
#undef PG8_MMA
#undef PG8_WAIT_V
#undef PG8_WAIT_L
#undef PG8_WAIT_VF
#undef PG8_BAR
#undef PG8_SCHED
}
}
#define GAS __attribute__((address_space(1)))
#define LAS __attribute__((address_space(3)))
typedef unsigned short bf16;
typedef unsigned v4u __attribute__((ext_vector_type(4)));
typedef float f32x4 __attribute__((ext_vector_type(4)));
typedef short bf16x8 __attribute__((ext_vector_type(8)));
typedef GAS unsigned gu32;
typedef GAS unsigned long long gu64;
#define RLX_AGENT __ATOMIC_RELAXED, __HIP_MEMORY_SCOPE_AGENT
#define LDS_WAIT() asm volatile("s_waitcnt lgkmcnt(0)" ::: "memory")
#define VM_WAIT() asm volatile("s_waitcnt vmcnt(0)" ::: "memory")
__device__ __forceinline__ unsigned long long rt() { return __builtin_amdgcn_s_memrealtime(); }
__device__ __forceinline__ unsigned f2bf(float f) { unsigned u = __builtin_bit_cast(unsigned, f); return (u + 0x7fffu + ((u >> 16) & 1u)) >> 16; }
__device__ __forceinline__ unsigned pk2(float lo, float hi) { return f2bf(lo) | (f2bf(hi) << 16); }

#define XB_TMO      128
#define XB_XCNT(j)  (256  + 64 * (j))
#define XB_XSUB(j)  (1280 + 64 * (j))
#define XB_XGEN(j)  (2304 + 64 * (j))
#define XB_TOP      3328
#define XB_TOPGEN   3392
#define XCD_BAR_WORDS 3456
#define XB_SPIN_CAP (1u << 18)

__device__ __forceinline__ unsigned xb_ld(unsigned* p)              { return __hip_atomic_load(p, __ATOMIC_RELAXED, __HIP_MEMORY_SCOPE_AGENT); }
__device__ __forceinline__ unsigned xb_add(unsigned* p, unsigned v) { return __hip_atomic_fetch_add(p, v, __ATOMIC_RELAXED, __HIP_MEMORY_SCOPE_AGENT); }
__device__ __forceinline__ unsigned xb_xcc_id() { return (unsigned)__builtin_amdgcn_s_getreg((3 << 11) | 20) & 0xFu; }
#define XB_SPIN(cond, bar) do { unsigned _sp = 0; while (cond) { __builtin_amdgcn_s_sleep(1); \
    if ((++_sp & 255u) == 0u) { if (xb_ld(&(bar)[XB_TMO])) break; if (_sp > XB_SPIN_CAP) { atomicAdd(&(bar)[XB_TMO], 1u); break; } } } } while (0)

struct XcdBarrier {
    unsigned* bar; unsigned x;
    volatile LAS unsigned* st;
};

__device__ __forceinline__ XcdBarrier xcd_barrier_post(unsigned* bar, volatile LAS unsigned* st) {
    XcdBarrier b; b.bar = bar; b.x = xb_xcc_id(); b.st = st;
    if (threadIdx.x == 0) (void)xb_add(&bar[XB_XCNT(b.x)], 1u);
    return b;
}
__device__ __forceinline__ void xcd_barrier_complete(unsigned* bar, unsigned x, unsigned& nloc, unsigned& nx) {
    const unsigned G = gridDim.x * gridDim.y * gridDim.z;
    unsigned sum, cnt, mine, sp = 0u;
    for (;;) {
        sum = 0u; cnt = 0u; mine = 0u;
#pragma unroll
        for (unsigned j = 0; j < 16; ++j) { const unsigned c = xb_ld(&bar[XB_XCNT(j)]); sum += c; cnt += (c > 0u) ? 1u : 0u; mine = (j == x) ? c : mine; }
        if (sum == G) break;
        __builtin_amdgcn_s_sleep(1);
        if ((++sp & 255u) == 0u) { if (xb_ld(&bar[XB_TMO])) break; if (sp > XB_SPIN_CAP) { atomicAdd(&bar[XB_TMO], 1u); break; } }
    }
    nloc = mine > 0u ? mine : 1u; nx = cnt > 0u ? cnt : 1u;
}

__device__ __forceinline__ void xcd_barrier(const XcdBarrier& b) {
    asm volatile("s_waitcnt vmcnt(0)" ::: "memory");
    __syncthreads();
    if (threadIdx.x == 0) {
        unsigned* bar = b.bar;
        __builtin_amdgcn_s_waitcnt(0);
        unsigned nloc = b.st[0], nx = b.st[1];
        if (nloc == 0u) { xcd_barrier_complete(bar, b.x, nloc, nx); b.st[0] = nloc; b.st[1] = nx; }
        const unsigned old = xb_add(&bar[XB_XSUB(b.x)], 1u);
        const unsigned gen = old / nloc;
        if (old + 1u == (gen + 1u) * nloc) {
            __builtin_amdgcn_fence(__ATOMIC_RELEASE, "agent");
            asm volatile("s_waitcnt vmcnt(0)" ::: "memory");
            const unsigned og = xb_add(&bar[XB_TOP], 1u);
            const unsigned tg = og / nx;
            if (og + 1u == (tg + 1u) * nx) xb_add(&bar[XB_TOPGEN], 1u);
            else XB_SPIN(xb_ld(&bar[XB_TOPGEN]) == tg, bar);
            __builtin_amdgcn_fence(__ATOMIC_ACQUIRE, "agent");
            xb_add(&bar[XB_XGEN(b.x)], 1u);
            asm volatile("s_waitcnt vmcnt(0)" ::: "memory");
        } else {
            XB_SPIN(xb_ld(&bar[XB_XGEN(b.x)]) == gen, bar);
            __builtin_amdgcn_fence(__ATOMIC_ACQUIRE, "agent");
            asm volatile("s_waitcnt vmcnt(0)" ::: "memory");
        }
    }
    __syncthreads();
}
#ifndef FF2_TOUCH
#define FF2_TOUCH 2
#endif
#ifndef FF2_REV
#define FF2_REV 1
#endif
#ifndef W2_TILED
#define W2_TILED 1
#endif
constexpr int NWAVES = 8;
constexpr int M_TOK = 98304, M_PROMPT = 65536, D = 1024, NP = 3584, NWIN = 3616, FF = 4096;
constexpr int L_PROMPT = 2048, L_SAMPLE = 16384;
constexpr float EPS = 1e-6f;
constexpr size_t MiB = 1u << 20;
constexpr size_t WS_CTL = 0, CTL_ZERO_BYTES = 1 * MiB;
constexpr size_t WS_WIN = 1 * MiB;
constexpr size_t WS_WOUT = 9 * MiB;
constexpr size_t WS_W1 = 11 * MiB;
constexpr size_t WS_W2 = 19 * MiB;
constexpr size_t WS_ROPE = 27 * MiB;
constexpr size_t WS_GA = 35 * MiB;
constexpr size_t WS_RSTD = 47 * MiB;
constexpr size_t WS_SQ1 = 48 * MiB;
constexpr size_t WS_SQ2 = 54 * MiB;
constexpr size_t WS_DEC = 60 * MiB;
constexpr size_t WS_R0 = 64 * MiB;
constexpr size_t WS_R1 = 256 * MiB;
constexpr size_t WS_ST = 1024 * MiB;
constexpr size_t WS_A2 = 1216 * MiB;
constexpr size_t WS_END = 1408 * MiB;
constexpr int CW_BAR = 4096;
constexpr int RING_OFF = 0, RING_BYTES = 131072;
constexpr int LDSCTL_OFF = 147456 - 1024, MISC_OFF = LDSCTL_OFF + 320;
constexpr int LDS_BYTES = 147456;

struct Frame {
    LAS unsigned char* lds;
    volatile LAS unsigned* MISC;
    int tid, lane, wave, vcu, G;
};
__device__ __forceinline__ float wave_sum(float v) {
#pragma unroll
    for (int o = 1; o < 64; o <<= 1) v += __shfl_xor(v, o);
    return v;
}
__device__ __forceinline__ float bf2f(bf16 b) { return __uint_as_float((unsigned)b << 16); }
__device__ __forceinline__ unsigned cvtpk(float lo, float hi) { unsigned r; asm volatile("v_cvt_pk_bf16_f32 %0, %1, %2" : "=v"(r) : "v"(lo), "v"(hi)); return r; }

__device__ __forceinline__ void win_map(int nd, int& sc, float& cs) {
    cs = 1.f;
    if (nd < 512) sc = 512 + nd;
    else if (nd < 1024) sc = 2592 + (nd - 512);
    else if (nd < 1280) { sc = nd - 1024; cs = 0.125f; }
    else if (nd < 1536) sc = 256 + (nd - 1280);
    else if (nd < 2048) sc = 1024 + (nd - 1536);
    else if (nd < 3072) {
        const bool isq = nd < 2560; const int p = nd - (isq ? 2048 : 2560), h = p >> 7, pp = p & 127, u = pp >> 3, j = pp & 7;
        const int d = (j < 4) ? 4 * u + j : 64 + 4 * u + (j - 4);
        sc = (isq ? 1568 : 2080) + 128 * h + d; if (isq) cs = 0.08838834764831845f; }
    else if (nd < 3584) sc = 3104 + (nd - 3072);
    else sc = 1536 + (nd - 3584);
}
template <bool MAP, bool TILED = false>
__device__ __forceinline__ void p0_transpose_item(const float* W, int K, int Nsrc, int nblk, const float* ks, bf16* WT, LAS float* scr, int item, int lane) {
    const int kb = item / nblk, nb = item % nblk, k0 = 64 * kb, n0 = 32 * nb;
    int sc = n0 + (lane & 31); float cs = 1.f;
    if (MAP) win_map(n0 + (lane & 31), sc, cs);
    { float wv[32];
#pragma unroll
      for (int i = 0; i < 32; ++i) wv[i] = W[(size_t)(k0 + 2 * i + (lane >> 5)) * Nsrc + sc];
      float kv[32];
#pragma unroll
      for (int i = 0; i < 32; ++i) kv[i] = ks ? ks[k0 + 2 * i + (lane >> 5)] : 1.0f;
      __builtin_amdgcn_sched_barrier(0);
#pragma unroll
      for (int i = 0; i < 32; ++i) { const int kk = 2 * i + (lane >> 5); scr[kk * 33 + (lane & 31)] = wv[i] * cs * kv[i]; } }
    LDS_WAIT(); asm volatile("" ::: "memory");
    const int c = lane & 7;
#pragma unroll
    for (int j = 0; j < 4; ++j) { const int n = (lane >> 3) + 8 * j; const LAS float* s = scr + (8 * c) * 33 + n;
        v4u o; o.x = cvtpk(s[0 * 33], s[1 * 33]); o.y = cvtpk(s[2 * 33], s[3 * 33]); o.z = cvtpk(s[4 * 33], s[5 * 33]); o.w = cvtpk(s[6 * 33], s[7 * 33]);
        if (TILED) { const int nn = n0 + n; *(GAS v4u*)(WT + (((size_t)(nn >> 8) * (K >> 6) + (k0 >> 6)) * 256 + (nn & 255)) * 64 + 8 * c) = o; }
        else *(GAS v4u*)(WT + (size_t)(n0 + n) * K + k0 + 8 * c) = o; }
    LDS_WAIT(); asm volatile("" ::: "memory");
}
__device__ __forceinline__ void rope_entry(int e, float* rcos, float* rsin) {
    const int pos = e >> 6, i = e & 63;
    double inv = 1.0, b = 0.8659643233600653;
#pragma unroll
    for (int bit = 0; bit < 6; ++bit) { if ((i >> bit) & 1) inv *= b; b *= b; }
    const double ang = (double)pos * inv;
    const double n = __builtin_rint(ang * 0.6366197723675814);
    double r = __builtin_fma(-n, 1.5707963267948966, ang); r = __builtin_fma(-n, 6.123233995736766e-17, r);
    const double r2 = r * r;
    double s = -1.0 / 1307674368000.0;
    s = s * r2 + 1.0 / 6227020800.0; s = s * r2 - 1.0 / 39916800.0; s = s * r2 + 1.0 / 362880.0; s = s * r2 - 1.0 / 5040.0; s = s * r2 + 1.0 / 120.0; s = s * r2 - 1.0 / 6.0; s = s * r2 * r + r;
    double c = 1.0 / 20922789888000.0;
    c = c * r2 - 1.0 / 87178291200.0; c = c * r2 + 1.0 / 479001600.0; c = c * r2 - 1.0 / 3628800.0; c = c * r2 + 1.0 / 40320.0; c = c * r2 - 1.0 / 720.0; c = c * r2 + 1.0 / 24.0; c = c * r2 - 0.5; c = c * r2 + 1.0;
    const int q = ((int)n) & 3;
    const double cs = (q == 0) ? c : (q == 1) ? -s : (q == 2) ? -c : s;
    const double sn = (q == 0) ? s : (q == 1) ? c : (q == 2) ? -s : -c;
    rcos[e] = (float)cs; rsin[e] = (float)sn;
}
struct P0Args { const float *xp, *xs, *anw, *win, *wout, *mnw, *w1, *w2; bf16 *Win_t, *Wout_t, *W1_t, *W2_t, *Xb; float *rcos, *rsin, *ga, *rstd; };
__device__ __forceinline__ void p0_prologue(Frame& F, const P0Args& a, int parts = 3) {
    LAS float* scr = (LAS float*)(F.lds + RING_OFF + F.wave * 16384);
    const int gw = F.vcu * NWAVES + F.wave, NGW = F.G * NWAVES;
    constexpr int I_IN = (D / 64) * (NWIN / 32), I_O = (D / 64) * (D / 32), I_1 = (D / 64) * (FF / 32), I_2 = (FF / 64) * (D / 32);
    constexpr int NITEMS = I_IN + I_O + I_1 + I_2;
    if (parts & 1) for (int it = gw; it < NITEMS; it += NGW) {
        int r = it;
        if (r < I_IN) { p0_transpose_item<true>(a.win, D, NWIN, NWIN / 32, a.anw, a.Win_t, scr, r, F.lane); continue; } r -= I_IN;
        if (r < I_O) { p0_transpose_item<false>(a.wout, D, D, D / 32, nullptr, a.Wout_t, scr, r, F.lane); continue; } r -= I_O;
        if (r < I_1) { p0_transpose_item<false>(a.w1, D, FF, FF / 32, a.mnw, a.W1_t, scr, r, F.lane); continue; } r -= I_1;
        p0_transpose_item<false, W2_TILED != 0>(a.w2, FF, D, D / 32, nullptr, a.W2_t, scr, r, F.lane);
    }
    if (parts & 1) for (int e = (blockIdx.x * NWAVES * 64) + F.tid; e < 16384 * 64; e += F.G * NWAVES * 64) rope_entry(e, a.rcos, a.rsin);
    __syncthreads();
    LAS bf16* wl = (LAS bf16*)(F.lds + RING_OFF);
    { const int c = F.tid & 31, kb = F.tid >> 5;
#pragma unroll 1
      for (int b = 0; b < 4; ++b) { float wv[16], av[16];
#pragma unroll
          for (int j = 0; j < 16; ++j) { const int k = kb + 16 * (16 * b + j); wv[j] = a.win[(size_t)k * NWIN + 1536 + c]; av[j] = a.anw[k]; }
          __builtin_amdgcn_sched_barrier(0);
#pragma unroll
          for (int j = 0; j < 16; ++j) { const int k = kb + 16 * (16 * b + j); wl[c * 1032 + k] = (bf16)(cvtpk(wv[j] * av[j], 0.f) & 0xffffu); } } }
    __syncthreads();
    const int r = F.lane & 15, g = F.lane >> 4;
    LAS unsigned char* tl = F.lds + RING_OFF + 66048 + F.wave * 8448;
    if (parts & 2) {
        f32x4 xa[16], xb[16];
#define P0_LOAD(dst, it_, kc_) do { const int r0_ = (it_) * 16; const float* xp_ = (r0_ < M_PROMPT ? a.xp + (size_t)r0_ * D : a.xs + (size_t)(r0_ - M_PROMPT) * D) + 4 * F.lane + 256 * (kc_); \
            _Pragma("unroll") for (int rr = 0; rr < 16; ++rr) dst[rr] = *(const GAS f32x4*)(xp_ + (size_t)rr * D); } while (0)
#define P0_PROC(src, kc_) do { \
            _Pragma("unroll") for (int rr = 0; rr < 16; ++rr) { unsigned long long pk = (unsigned long long)cvtpk(src[rr][0], src[rr][1]) | ((unsigned long long)cvtpk(src[rr][2], src[rr][3]) << 32); \
                *(LAS unsigned long long*)(tl + rr * 528 + F.lane * 8) = pk; *(GAS unsigned long long*)(xo + (size_t)rr * D + 256 * (kc_)) = pk; } \
            asm volatile("s_waitcnt lgkmcnt(0)" ::: "memory"); \
            _Pragma("unroll") for (int s8 = 0; s8 < 8; ++s8) { \
                const bf16x8 af = *(const LAS bf16x8*)(tl + r * 528 + 64 * s8 + 16 * g); \
                const int k0 = 256 * (kc_) + 32 * s8 + 8 * g; \
                const bf16x8 b0 = *(const LAS bf16x8*)(wl + r * 1032 + k0), b1 = *(const LAS bf16x8*)(wl + (16 + r) * 1032 + k0); \
                acc0 = __builtin_amdgcn_mfma_f32_16x16x32_bf16(af, b0, acc0, 0, 0, 0); acc1 = __builtin_amdgcn_mfma_f32_16x16x32_bf16(af, b1, acc1, 0, 0, 0); \
                const v4u aw = __builtin_bit_cast(v4u, af); \
                _Pragma("unroll") for (int j = 0; j < 4; ++j) { const unsigned u = ((const unsigned*)&aw)[j]; const float lo = __uint_as_float(u << 16), hi = __uint_as_float(u & 0xffff0000u); ss += lo * lo + hi * hi; } } \
            asm volatile("s_waitcnt lgkmcnt(0)" ::: "memory"); } while (0)
        if (gw < M_TOK / 16) P0_LOAD(xa, gw, 0);
        for (int item = gw; item < M_TOK / 16; item += NGW) {
            const int row0 = item * 16;
            bf16* xo = a.Xb + (size_t)row0 * D + 4 * F.lane;
            f32x4 acc0 = {0.f, 0.f, 0.f, 0.f}, acc1 = {0.f, 0.f, 0.f, 0.f}; float ss = 0.f;
            const int nitem = item + NGW < M_TOK / 16 ? item + NGW : item;
            P0_LOAD(xb, item, 1); __builtin_amdgcn_sched_barrier(0); P0_PROC(xa, 0); __builtin_amdgcn_sched_barrier(0);
            P0_LOAD(xa, item, 2); __builtin_amdgcn_sched_barrier(0); P0_PROC(xb, 1); __builtin_amdgcn_sched_barrier(0);
            P0_LOAD(xb, item, 3); __builtin_amdgcn_sched_barrier(0); P0_PROC(xa, 2); __builtin_amdgcn_sched_barrier(0);
            P0_LOAD(xa, nitem, 0); __builtin_amdgcn_sched_barrier(0); P0_PROC(xb, 3); __builtin_amdgcn_sched_barrier(0);
            ss += __shfl_xor(ss, 16); ss += __shfl_xor(ss, 32);
            const float rs = 1.0f / sqrtf(ss * (1.0f / 1024.0f) + EPS);
            if (g == 0) a.rstd[row0 + r] = rs;
#pragma unroll
            for (int q = 0; q < 4; ++q) { const int rr = 4 * g + q; const float rq = __shfl(rs, rr);
                a.ga[(size_t)(row0 + rr) * 32 + r] = acc0[q] * rq; a.ga[(size_t)(row0 + rr) * 32 + 16 + r] = acc1[q] * rq; }
        }
#undef P0_LOAD
#undef P0_PROC
    }
}

__device__ __forceinline__ float log_sigmoid_f(float z) { return fminf(z, 0.f) - log1pf(expf(-fabsf(z))); }
struct MixArgs { bf16* proj; const float* ga; const float *waf, *baf, *wab, *bab; float* of; const float *gnw, *rnw, *rnb; };
constexpr int NTB = 16;
template <int DK, bool GLA, bool BWD>
__device__ __forceinline__ void naive_sweep(Frame& F, const MixArgs& a, int job) {
    const int grp = F.tid >> 7, gt = F.tid & 127;
    int seq, head; if (job < 16) { seq = 32 + (job >> 3); head = job & 7; } else { seq = (job - 16) >> 3; head = (job - 16) & 7; }
    const int L = seq < 32 ? L_PROMPT : L_SAMPLE, row_base = seq < 32 ? seq * L_PROMPT : M_PROMPT + (seq - 32) * L_SAMPLE;
    const int hh = GLA ? head : head - 4;
    const int qcol = GLA ? 1024 + 64 * hh : 2048 + 128 * hh, kcol = GLA ? 1280 + 64 * hh : 2560 + 128 * hh, vcol = 128 * head;
    LAS float* sq = (LAS float*)(F.lds + grp * (3 * NTB * 128 * 4)); LAS float* sk = sq + NTB * DK; LAS float* sa = sk + NTB * DK;
    const float gam = 1.0f - exp2f(-5.0f - (float)hh);
    const float* wal = BWD ? a.wab : a.waf; const float* bal = BWD ? a.bab : a.baf;
    float S[DK];
#pragma unroll
    for (int t = 0; t < DK; ++t) S[t] = 0.f;
    for (int t0 = 0; t0 < L; t0 += NTB) {
        __syncthreads();
        for (int e = gt; e < NTB * DK; e += 128) {
            const int tok = e / DK, t = e % DK, tp = t0 + tok, row = row_base + (BWD ? L - 1 - tp : tp);
            const bf16* pr = a.proj + (size_t)row * NP;
            sq[e] = bf2f(pr[qcol + t]); sk[e] = bf2f(pr[kcol + t]);
            if (GLA) { const float* gar = a.ga + (size_t)row * 32 + (BWD ? 16 : 0); float z = bal[64 * hh + t];
#pragma unroll
                for (int r = 0; r < 16; ++r) z += gar[r] * wal[r * 256 + 64 * hh + t];
                sa[e] = expf(fmaxf(log_sigmoid_f(z) * (1.0f / 16.0f), -1.0f)); }
        }
        __syncthreads();
        for (int tok = 0; tok < NTB; ++tok) {
            const int tp = t0 + tok, row = row_base + (BWD ? L - 1 - tp : tp);
            const float vv = bf2f(a.proj[(size_t)row * NP + vcol + gt]);
            float o = 0.f;
#pragma unroll
            for (int t4 = 0; t4 < DK / 4; ++t4) {
                const f32x4 q = *(const LAS f32x4*)(sq + tok * DK + 4 * t4), k = *(const LAS f32x4*)(sk + tok * DK + 4 * t4);
                f32x4 al = {gam, gam, gam, gam}; if (GLA) al = *(const LAS f32x4*)(sa + tok * DK + 4 * t4);
#pragma unroll
                for (int j = 0; j < 4; ++j) {
                    if (!BWD) { S[4 * t4 + j] = al[j] * S[4 * t4 + j] + k[j] * vv; o += q[j] * S[4 * t4 + j]; }
                    else { S[4 * t4 + j] *= al[j]; o += q[j] * S[4 * t4 + j]; S[4 * t4 + j] += k[j] * vv; }
                }
            }
            float* op = a.of + (size_t)row * D + 128 * head + gt;
            if (!BWD) *op = o; else *op += o;
        }
    }
}
template <bool BWD>
__device__ __forceinline__ void naive_mix_phase(Frame& F, const MixArgs& a) {
    if (blockIdx.x >= 68) return;
    const int job = blockIdx.x * 4 + (F.tid >> 7);
    if ((blockIdx.x & 1) == 0) { if (!MIX_GLA) naive_sweep<64, true, BWD>(F, a, job); } else { if (!MIX_RET) naive_sweep<128, false, BWD>(F, a, job); }
}
__device__ __forceinline__ void naive_combine(Frame& F, const MixArgs& a) {
    const int gw = F.vcu * NWAVES + F.wave, NGW = F.G * NWAVES, c = 2 * F.lane;
    for (int item = gw; item < M_TOK * 8; item += NGW) {
        const int row = item >> 3, head = item & 7;
        if (head < 4 ? MIX_GLA : MIX_RET) continue;
        const float* op = a.of + (size_t)row * D + 128 * head + c;
        float o0 = op[0], o1 = op[1], y0, y1;
        if (head < 4) { const float r = 1.0f / sqrtf(wave_sum(o0 * o0 + o1 * o1) * (1.0f / 128.0f) + EPS); y0 = o0 * r * a.gnw[c]; y1 = o1 * r * a.gnw[c + 1]; }
        else { const float mu = wave_sum(o0 + o1) * (1.0f / 128.0f); o0 -= mu; o1 -= mu; const float r = 1.0f / sqrtf(wave_sum(o0 * o0 + o1 * o1) * (1.0f / 128.0f) + EPS);
            const int cc = 128 * (head - 4) + c; y0 = o0 * r * a.rnw[cc] + a.rnb[cc]; y1 = o1 * r * a.rnw[cc + 1] + a.rnb[cc + 1]; }
        bf16* pr = a.proj + (size_t)row * NP;
        const int gcol = (head < 4 ? 1536 + 128 * head : 3072 + 128 * (head - 4)) + c;
        const unsigned gw2 = *(const unsigned*)(pr + gcol);
        const float g0 = __uint_as_float(gw2 << 16), g1 = __uint_as_float(gw2 & 0xffff0000u);
        y0 *= g0 / (1.0f + expf(-g0)); y1 *= g1 / (1.0f + expf(-g1));
        *(unsigned*)(pr + 128 * head + c) = cvtpk(y0, y1);
    }
}
__device__ __forceinline__ void final_norm(Frame& F, float* out, const bf16* x2b, const float* sq, const float* w) {
    const int gw = F.vcu * NWAVES + F.wave, NGW = F.G * NWAVES;
    const f32x4* w4 = (const f32x4*)w + 2 * F.lane;
    f32x4 wv[2][2];
#pragma unroll
    for (int j = 0; j < 2; ++j) { wv[j][0] = w4[128 * j]; wv[j][1] = w4[128 * j + 1]; }
    for (int r0 = 4 * gw; r0 < M_TOK; r0 += 4 * NGW) {
        v4u xw[4][2]; f32x4 s4[4];
#pragma unroll
        for (int k = 0; k < 4; ++k) { const int row = r0 + k;
            s4[k] = *(const GAS f32x4*)(sq + (size_t)row * 16 + 4 * (F.lane & 3));
            const GAS v4u* xi = (const GAS v4u*)(x2b + (size_t)row * D) + F.lane;
            xw[k][0] = xi[0]; xw[k][1] = xi[64]; }
#pragma unroll
        for (int k = 0; k < 4; ++k) { const int row = r0 + k;
            float t = (s4[k][0] + s4[k][1]) + (s4[k][2] + s4[k][3]); t += __shfl_xor(t, 1); t += __shfl_xor(t, 2);
            const float r = 1.0f / sqrtf(t * (1.0f / 1024.0f) + EPS);
            GAS f32x4* o = (GAS f32x4*)(out + (size_t)row * D) + 2 * F.lane;
#pragma unroll
            for (int j = 0; j < 2; ++j) { const v4u x = xw[k][j];
                const f32x4 x0 = {__uint_as_float(x.x << 16), __uint_as_float(x.x & 0xffff0000u), __uint_as_float(x.y << 16), __uint_as_float(x.y & 0xffff0000u)};
                const f32x4 x1 = {__uint_as_float(x.z << 16), __uint_as_float(x.z & 0xffff0000u), __uint_as_float(x.w << 16), __uint_as_float(x.w & 0xffff0000u)};
                o[128 * j] = x0 * r * wv[j][0]; o[128 * j + 1] = x1 * r * wv[j][1]; } }
    }
}

typedef __bf16 bf16v2 __attribute__((ext_vector_type(2)));
typedef unsigned u32x2 __attribute__((ext_vector_type(2)));
__device__ __forceinline__ unsigned cvtpk_c(float lo, float hi) { bf16v2 v = {(__bf16)lo, (__bf16)hi}; return __builtin_bit_cast(unsigned, v); }
__device__ __forceinline__ float bflo(unsigned w) { return __uint_as_float(w << 16); }
__device__ __forceinline__ float bfhi(unsigned w) { return __uint_as_float(w & 0xffff0000u); }
__device__ __forceinline__ int opaque_i(int x) { asm volatile("" : "+v"(x)); return x; }
typedef short s16x4 __attribute__((ext_vector_type(4)));
#define TRRD(ptr) __builtin_amdgcn_ds_read_tr16_b64_v4i16((LAS s16x4*)(ptr))
constexpr size_t ST_SC_BYTES = 393216;
__device__ __forceinline__ size_t state_off(int sc, bool gla, int hh, int dir) { return (size_t)sc * ST_SC_BYTES + (gla ? (size_t)(hh * 2 + dir) * 16384 : (size_t)131072 + (size_t)(hh * 2 + dir) * 32768); }
typedef _Float16 bh16;
__device__ __forceinline__ float h2f(unsigned w, int hi) { return (float)__builtin_bit_cast(bh16, (unsigned short)(hi ? (w >> 16) : (w & 0xffffu))); }
struct CMixArgs { bf16* proj; const float* ga; const float *waf, *baf, *wab, *bab; unsigned char* st; float* dec; const float *gnw, *rnw, *rnb; bf16* mo; int mop; unsigned char* sto; unsigned char* ofs; bh16* bb0; bh16* bb1; float* gv; };
constexpr int OB_PITCH = 132;

template <bool GLA> struct RawSet;
template <> struct RawSet<true> { v4u q, k, v0, v1, bh, lh; };
template <> struct RawSet<false> { v4u q0, q1, k0, k1, v0, v1; };

template <bool GLA, bool WITH_O>
__device__ __forceinline__ void raw_load(RawSet<GLA>& R, const CMixArgs& a, int p, int s, int w, int lane0) {
    const int lane = opaque_i(lane0), sc = p >> 2, hh = p & 3, dir = s >> 2, c = dir ? 7 - s : s;
    const size_t row = (size_t)(sc * 256 + 64 * c + 8 * w + (lane >> 3)); const int pc = lane & 7;
    if constexpr (GLA) {
        if (WITH_O) R.q = *(const GAS v4u*)(a.proj + pg8::pl(pg8::PL_GQ, hh, row, 64) + 8 * pc);
        R.k = *(const GAS v4u*)(a.proj + pg8::pl(pg8::PL_GK, hh, row, 64) + 8 * pc);
        const bf16* pv = a.proj + pg8::pl(pg8::PL_GV, hh, row, 128) + 8 * pc;
        R.v0 = *(const GAS v4u*)pv; R.v1 = *(const GAS v4u*)(pv + 64);
        const bh16* bp = (dir ? a.bb1 : a.bb0) + ((size_t)(p * 4 + c) * 64) * 64 + 8 * pc;
        const int ti = 8 * w + (lane >> 3);
        R.bh = *(const GAS v4u*)(bp + ti * 64); R.lh = *(const GAS v4u*)(bp + (dir ? 0 : 63) * 64);
    } else {
        if (WITH_O) { const bf16* pq = a.proj + pg8::pl(pg8::PL_RQ, hh, row, 128) + 8 * pc; R.q0 = *(const GAS v4u*)pq; R.q1 = *(const GAS v4u*)(pq + 64); }
        const bf16* pk = a.proj + pg8::pl(pg8::PL_RK, hh, row, 128) + 8 * pc; R.k0 = *(const GAS v4u*)pk; R.k1 = *(const GAS v4u*)(pk + 64);
        const bf16* pv = a.proj + pg8::pl(pg8::PL_RV, hh, row, 128) + 8 * pc; R.v0 = *(const GAS v4u*)pv; R.v1 = *(const GAS v4u*)(pv + 64);
    }
}

template <int DK, bool GLA, bool WITH_O> struct MixLds {
    static constexpr int NT = DK / 16, NS = DK / 32;
    static constexpr int RQ = DK * 2 + 16, RP = 144, RV = 272;
    static constexpr int O_QD = 0, O_KI = 64 * RQ, O_KE = 2 * 64 * RQ, O_PB = 3 * 64 * RQ, O_VB = O_PB + 64 * RP, O_DC = O_VB + 64 * RV, O_WAL = O_DC + DK * 4,
                         O_OB = O_WAL, O_END = O_OB + 64 * OB_PITCH * 4;
    static_assert(O_END <= 146432, "mixer LDS map");
};

template <int DK, bool GLA, bool WITH_O>
__device__ __forceinline__ void mix_step(Frame& F, const CMixArgs& a, int p, int s, int pnext, RawSet<GLA>& R, f32x4 (&S)[DK / 16], float (&dsum)[8], u32x2 (&ofp)[4][4]) {
    typedef MixLds<DK, GLA, WITH_O> ML;
    constexpr int NT = ML::NT, NS = ML::NS, RQ = ML::RQ, RP = ML::RP, RV = ML::RV;
    LAS unsigned char* L = F.lds;
    const int lane0 = F.lane, w = F.wave;
    const int sc = p >> 2, hh = p & 3, dir = s >> 2, c = dir ? 7 - s : s, row0 = sc * 256, head = GLA ? hh : 4 + hh, vcol = 128 * head;
    __syncthreads();
    {
        const int lane = opaque_i(lane0), i = 8 * w + (lane >> 3), pc = lane & 7;
        *(LAS v4u*)(L + ML::O_VB + i * RV + 16 * pc) = R.v0; *(LAS v4u*)(L + ML::O_VB + i * RV + 128 + 16 * pc) = R.v1;
        if constexpr (GLA) {
            const int tk = lane >> 3;
            float q8[8], k8[8], e8[8];
#pragma unroll
            for (int e = 0; e < 8; ++e) { const float b = h2f(((const unsigned*)&R.bh)[e >> 1], e & 1), bl_ = h2f(((const unsigned*)&R.lh)[e >> 1], e & 1);
                const unsigned wq = WITH_O ? ((const unsigned*)&R.q)[e >> 1] : 0u, wk = ((const unsigned*)&R.k)[e >> 1];
                const float qv = (e & 1) ? bfhi(wq) : bflo(wq), kv = (e & 1) ? bfhi(wk) : bflo(wk);
                q8[e] = qv * __expf(b); k8[e] = kv * __expf(-b); e8[e] = kv * __expf(bl_ - b);
                if (!WITH_O) dsum[e] += bl_;
                if (w == 0 && tk == 0) ((LAS float*)(L + ML::O_DC))[8 * pc + e] = __expf(bl_); }
            v4u oq, ok, oe;
            oq.x = cvtpk_c(q8[0], q8[1]); oq.y = cvtpk_c(q8[2], q8[3]); oq.z = cvtpk_c(q8[4], q8[5]); oq.w = cvtpk_c(q8[6], q8[7]);
            ok.x = cvtpk_c(k8[0], k8[1]); ok.y = cvtpk_c(k8[2], k8[3]); ok.z = cvtpk_c(k8[4], k8[5]); ok.w = cvtpk_c(k8[6], k8[7]);
            oe.x = cvtpk_c(e8[0], e8[1]); oe.y = cvtpk_c(e8[2], e8[3]); oe.z = cvtpk_c(e8[4], e8[5]); oe.w = cvtpk_c(e8[6], e8[7]);
            if (WITH_O) { *(LAS v4u*)(L + ML::O_QD + i * RQ + 16 * pc) = oq; *(LAS v4u*)(L + ML::O_KI + i * RQ + 16 * pc) = ok; }
            *(LAS v4u*)(L + ML::O_KE + i * RQ + 16 * pc) = oe;
        } else {
            const float l2g = hh == 0 ? -0.045803689613124f : hh == 1 ? -0.022720076500083f : hh == 2 ? -0.011315313227834f : -0.005646563141142f;
            const float nq = dir ? (float)(64 - i) : (float)(i + 1), ne = dir ? (float)i : (float)(63 - i);
            const float eb = exp2f(l2g * nq), ei = exp2f(-l2g * nq), ee = exp2f(l2g * ne);
#pragma unroll
            for (int x = 0; x < 2; ++x) { v4u oq, ok, oe; const v4u rq = x ? R.q1 : R.q0, rk = x ? R.k1 : R.k0;
#pragma unroll
                for (int j = 0; j < 4; ++j) { const unsigned wq = WITH_O ? ((const unsigned*)&rq)[j] : 0u, wk = ((const unsigned*)&rk)[j];
                    ((unsigned*)&oq)[j] = cvtpk_c(bflo(wq) * eb, bfhi(wq) * eb); ((unsigned*)&ok)[j] = cvtpk_c(bflo(wk) * ei, bfhi(wk) * ei); ((unsigned*)&oe)[j] = cvtpk_c(bflo(wk) * ee, bfhi(wk) * ee); }
                if (WITH_O) { *(LAS v4u*)(L + ML::O_QD + i * RQ + 128 * x + 16 * pc) = oq; *(LAS v4u*)(L + ML::O_KI + i * RQ + 128 * x + 16 * pc) = ok; }
                *(LAS v4u*)(L + ML::O_KE + i * RQ + 128 * x + 16 * pc) = oe; }
            if (w == 0 && lane < 32) *(LAS f32x4*)(L + ML::O_DC + lane * 16) = (f32x4){exp2f(l2g * 64.0f), exp2f(l2g * 64.0f), exp2f(l2g * 64.0f), exp2f(l2g * 64.0f)};
        }
    }
    v4u gt0, gt1; f32x4 nw[4], nb[4];
    if (WITH_O) { const int lane = opaque_i(lane0);
        const bf16* gp = a.proj + (dir ? pg8::pl(GLA ? pg8::PL_GG : pg8::PL_RG, hh, (size_t)(row0 + 64 * c + 8 * w + (lane >> 3)), 128) + 16 * (lane & 7) : pg8::pl(GLA ? pg8::PL_GG : pg8::PL_RG, 0, (size_t)0, 128));
        gt0 = *(const GAS v4u*)gp; gt1 = *(const GAS v4u*)(gp + 8);
        const float* wp = GLA ? a.gnw + 16 * (lane & 7) : a.rnw + 128 * hh + 16 * (lane & 7);
#pragma unroll
        for (int k = 0; k < 4; ++k) { nw[k] = *(const GAS f32x4*)(wp + 4 * k); if (!GLA) nb[k] = *(const GAS f32x4*)(a.rnb + 128 * hh + 16 * (lane & 7) + 4 * k); } }
    raw_load<GLA, WITH_O>(R, a, s < 6 ? p : (pnext < 1536 ? pnext : p), s < 6 ? s + 2 : s - 6, w, lane0);
    __syncthreads();
    if (WITH_O) {
        const int lane = opaque_i(lane0), g = lane >> 4, lr = lane & 15;
        const int mi = w >> 1;
        bf16x8 kf[2][NS], qf2[NS];
#pragma unroll
        for (int s2 = 0; s2 < NS; ++s2) { qf2[s2] = *(const LAS bf16x8*)(L + ML::O_QD + (16 * mi + lr) * RQ + 64 * s2 + 16 * g);
#pragma unroll
            for (int jj = 0; jj < 2; ++jj) kf[jj][s2] = *(const LAS bf16x8*)(L + ML::O_KI + (16 * (2 * (w & 1) + jj) + lr) * RQ + 64 * s2 + 16 * g); }
        __builtin_amdgcn_sched_barrier(0);
#pragma unroll
        for (int jj = 0; jj < 2; ++jj) { const int nj = 2 * (w & 1) + jj;
            f32x4 acc = {0.f, 0.f, 0.f, 0.f};
#pragma unroll
            for (int s2 = 0; s2 < NS; ++s2) acc = __builtin_amdgcn_mfma_f32_16x16x32_bf16(kf[jj][s2], qf2[s2], acc, 0, 0, 0);
            const int ii = 16 * mi + lr;
#pragma unroll
            for (int r = 0; r < 4; ++r) { const int j = 16 * nj + 4 * g + r; const bool keep = dir ? (j > ii) : (j <= ii); acc[r] = keep ? acc[r] : 0.f; }
            u32x2 pk; pk.x = cvtpk_c(acc[0], acc[1]); pk.y = cvtpk_c(acc[2], acc[3]);
            *(LAS u32x2*)(L + ML::O_PB + ii * RP + 32 * nj + 8 * g) = pk; }
        __syncthreads();
    }
    f32x4 o[4];
    {
        const int lane = opaque_i(lane0), g = lane >> 4, lr = lane & 15, q4 = lr >> 2, p4 = lr & 3;
        const LAS unsigned char* vb = L + ML::O_VB + (8 * g + q4) * RV + 32 * w + 8 * p4;
        const bf16x8 vf0 = __builtin_shufflevector(TRRD(vb), TRRD(vb + 4 * RV), 0, 1, 2, 3, 4, 5, 6, 7), vf1 = __builtin_shufflevector(TRRD(vb + 32 * RV), TRRD(vb + 36 * RV), 0, 1, 2, 3, 4, 5, 6, 7);
        if (WITH_O) {
            { bf16x8 pf[4][2];
#pragma unroll
              for (int m = 0; m < 4; ++m) { pf[m][0] = *(const LAS bf16x8*)(L + ML::O_PB + (16 * m + lr) * RP + 16 * g); pf[m][1] = *(const LAS bf16x8*)(L + ML::O_PB + (16 * m + lr) * RP + 64 + 16 * g); }
              __builtin_amdgcn_sched_barrier(0);
#pragma unroll
              for (int m = 0; m < 4; ++m) { o[m] = __builtin_amdgcn_mfma_f32_16x16x32_bf16(pf[m][0], vf0, (f32x4){0.f, 0.f, 0.f, 0.f}, 0, 0, 0); o[m] = __builtin_amdgcn_mfma_f32_16x16x32_bf16(pf[m][1], vf1, o[m], 0, 0, 0); }
              __builtin_amdgcn_sched_barrier(0); }
#pragma unroll
            for (int sh = 0; sh < NS / 2; ++sh) {
                u32x2 ql[2][4][2];
#pragma unroll
                for (int x = 0; x < 2; ++x)
#pragma unroll
                    for (int m = 0; m < 4; ++m) { ql[x][m][0] = *(const LAS u32x2*)(L + ML::O_QD + (16 * m + lr) * RQ + 64 * (2 * sh + x) + 8 * g); ql[x][m][1] = *(const LAS u32x2*)(L + ML::O_QD + (16 * m + lr) * RQ + 64 * (2 * sh + x) + 32 + 8 * g); }
                __builtin_amdgcn_sched_barrier(0);
#pragma unroll
                for (int x = 0; x < 2; ++x) { const int s2 = 2 * sh + x;
                    const bf16x8 sf = __builtin_bit_cast(bf16x8, (v4u){cvtpk_c(S[2 * s2][0], S[2 * s2][1]), cvtpk_c(S[2 * s2][2], S[2 * s2][3]), cvtpk_c(S[2 * s2 + 1][0], S[2 * s2 + 1][1]), cvtpk_c(S[2 * s2 + 1][2], S[2 * s2 + 1][3])});
#pragma unroll
                    for (int m = 0; m < 4; ++m) o[m] = __builtin_amdgcn_mfma_f32_16x16x32_bf16(__builtin_bit_cast(bf16x8, (v4u){ql[x][m][0].x, ql[x][m][0].y, ql[x][m][1].x, ql[x][m][1].y}), sf, o[m], 0, 0, 0); }
                __builtin_amdgcn_sched_barrier(0);
            }
        }
#pragma unroll
        for (int th = 0; th < NT / 4; ++th) {
            f32x4 d4[4]; bf16x8 kf0[4], kf1[4];
#pragma unroll
            for (int x = 0; x < 4; ++x) { const int tt = 4 * th + x;
                d4[x] = *(const LAS f32x4*)(L + ML::O_DC + (16 * tt + 4 * g) * 4);
                const LAS unsigned char* kb = L + ML::O_KE + (8 * g + q4) * RQ + 32 * tt + 8 * p4;
                kf0[x] = __builtin_shufflevector(TRRD(kb), TRRD(kb + 4 * RQ), 0, 1, 2, 3, 4, 5, 6, 7); kf1[x] = __builtin_shufflevector(TRRD(kb + 32 * RQ), TRRD(kb + 36 * RQ), 0, 1, 2, 3, 4, 5, 6, 7); }
            __builtin_amdgcn_sched_barrier(0);
#pragma unroll
            for (int x = 0; x < 4; ++x) { const int tt = 4 * th + x;
                S[tt] = S[tt] * d4[x];
                S[tt] = __builtin_amdgcn_mfma_f32_16x16x32_bf16(kf0[x], vf0, S[tt], 0, 0, 0);
                S[tt] = __builtin_amdgcn_mfma_f32_16x16x32_bf16(kf1[x], vf1, S[tt], 0, 0, 0); }
            __builtin_amdgcn_sched_barrier(0);
        }
    }
    if (WITH_O) {
        const int lane = opaque_i(lane0), g = lane >> 4, lr = lane & 15;
        if (dir == 0) {
#pragma unroll
            for (int cc = 0; cc < 4; ++cc) if (cc == c) {
#pragma unroll
                for (int m = 0; m < 4; ++m) { ofp[cc][m].x = cvtpk_c(o[m][0], o[m][1]); ofp[cc][m].y = cvtpk_c(o[m][2], o[m][3]); } }
        } else {
            u32x2 ofr[4];
#pragma unroll
            for (int cc = 0; cc < 4; ++cc) if (cc == c) {
#pragma unroll
                for (int m = 0; m < 4; ++m) ofr[m] = ofp[cc][m]; }
            LAS float* ob = (LAS float*)(L + ML::O_OB);
#pragma unroll
            for (int m = 0; m < 4; ++m) { const f32x4 t = {o[m][0] + bflo(ofr[m].x), o[m][1] + bfhi(ofr[m].x), o[m][2] + bflo(ofr[m].y), o[m][3] + bfhi(ofr[m].y)};
#pragma unroll
                for (int r = 0; r < 4; ++r) ob[(16 * m + 4 * g + r) * OB_PITCH + 16 * w + lr] = t[r]; }
            __syncthreads();
            const int row = 8 * w + (lane >> 3), pc = lane & 7;
            f32x4 x[4];
#pragma unroll
            for (int k = 0; k < 4; ++k) x[k] = *(const LAS f32x4*)(ob + row * OB_PITCH + 16 * pc + 4 * k);
            float rs;
            if (GLA) { float ss = 0.f;
#pragma unroll
                for (int k = 0; k < 4; ++k) ss += (x[k][0] * x[k][0] + x[k][1] * x[k][1]) + (x[k][2] * x[k][2] + x[k][3] * x[k][3]);
                ss += __shfl_xor(ss, 1); ss += __shfl_xor(ss, 2); ss += __shfl_xor(ss, 4);
                rs = __builtin_amdgcn_rsqf(ss * (1.0f / 128.0f) + EPS); }
            else { float sm = 0.f;
#pragma unroll
                for (int k = 0; k < 4; ++k) sm += (x[k][0] + x[k][1]) + (x[k][2] + x[k][3]);
                sm += __shfl_xor(sm, 1); sm += __shfl_xor(sm, 2); sm += __shfl_xor(sm, 4);
                const float mu = sm * (1.0f / 128.0f); float ss = 0.f;
#pragma unroll
                for (int k = 0; k < 4; ++k) { x[k] = x[k] - mu; ss += (x[k][0] * x[k][0] + x[k][1] * x[k][1]) + (x[k][2] * x[k][2] + x[k][3] * x[k][3]); }
                ss += __shfl_xor(ss, 1); ss += __shfl_xor(ss, 2); ss += __shfl_xor(ss, 4);
                rs = __builtin_amdgcn_rsqf(ss * (1.0f / 128.0f) + EPS); }
            unsigned ow[8];
#pragma unroll
            for (int k = 0; k < 4; ++k) { f32x4 y = x[k] * rs * nw[k];
                if (!GLA) y = y + nb[k];
                const unsigned ga_ = k < 2 ? ((const unsigned*)&gt0)[2 * k] : ((const unsigned*)&gt1)[2 * k - 4], gb_ = k < 2 ? ((const unsigned*)&gt0)[2 * k + 1] : ((const unsigned*)&gt1)[2 * k - 3];
                const float g0 = bflo(ga_), g1 = bfhi(ga_), g2 = bflo(gb_), g3 = bfhi(gb_);
                y[0] *= g0 * __builtin_amdgcn_rcpf(1.0f + __expf(-g0)); y[1] *= g1 * __builtin_amdgcn_rcpf(1.0f + __expf(-g1));
                y[2] *= g2 * __builtin_amdgcn_rcpf(1.0f + __expf(-g2)); y[3] *= g3 * __builtin_amdgcn_rcpf(1.0f + __expf(-g3));
                ow[2 * k] = cvtpk_c(y[0], y[1]); ow[2 * k + 1] = cvtpk_c(y[2], y[3]); }
            bf16* op = a.mo + (size_t)(row0 + 64 * c + row) * a.mop + vcol + 16 * pc;
            *(GAS v4u*)op = (v4u){ow[0], ow[1], ow[2], ow[3]}; *(GAS v4u*)(op + 8) = (v4u){ow[4], ow[5], ow[6], ow[7]};
        }
    }
}


__device__ __forceinline__ void gla_b_stage(Frame& F, const CMixArgs& a, int p) {
    const int sc = p >> 2, hh = p & 3, w = F.wave;
    LAS float* gl = (LAS float*)F.lds;
    __syncthreads();
    { const int tid = opaque_i(F.tid);
#pragma unroll
      for (int x = 0; x < 4; ++x) *(LAS f32x4*)(gl + 4 * (tid + 512 * x)) = *(const GAS f32x4*)(a.ga + (size_t)sc * 256 * 32 + 4 * (tid + 512 * x)); }
    __syncthreads();
    const int t = opaque_i(F.lane), dir = w >> 2, c = w & 3;
    const float* wa = (dir ? a.wab : a.waf) + 64 * hh + t;
    float wv[16];
#pragma unroll
    for (int r = 0; r < 16; ++r) wv[r] = wa[r * 256];
    const float bias = (dir ? a.bab : a.baf)[64 * hh + t];
    bh16* bp = (dir ? a.bb1 : a.bb0) + ((size_t)(p * 4 + c) * 64) * 64;
    LAS float* tb = gl + 8192 + w * (16 * 68);
    float acc = 0.f;
#pragma unroll 1
    for (int k16 = 0; k16 < 64; k16 += 16) {
#pragma unroll 1
        for (int k4 = k16; k4 < k16 + 16; k4 += 4) {
            f32x4 gv[4][4];
#pragma unroll
            for (int j = 0; j < 4; ++j) { const int i = dir ? 63 - (k4 + j) : k4 + j; const LAS float* gr = gl + (64 * c + i) * 32 + 16 * dir;
#pragma unroll
                for (int x = 0; x < 4; ++x) gv[j][x] = *(const LAS f32x4*)(gr + 4 * x); }
            __builtin_amdgcn_sched_barrier(0);
#pragma unroll
            for (int j = 0; j < 4; ++j) {
                float z = bias;
#pragma unroll
                for (int r = 0; r < 16; ++r) z += gv[j][r >> 2][r & 3] * wv[r];
                const float ls = fminf(z, 0.f) - __logf(1.0f + __expf(-fabsf(z)));
                acc += fmaxf(ls * (1.0f / 16.0f), -1.0f);
                tb[(k4 - k16 + j) * 68 + t] = acc; }
        }
#pragma unroll
        for (int x = 0; x < 2; ++x) { const int kk = 8 * x + (t >> 3), i = dir ? 63 - (k16 + kk) : k16 + kk;
            const f32x4 lo = *(const LAS f32x4*)(tb + kk * 68 + 8 * (t & 7)), hi = *(const LAS f32x4*)(tb + kk * 68 + 8 * (t & 7) + 4);
            v4u o;
#pragma unroll
            for (int q = 0; q < 2; ++q) { ((unsigned*)&o)[q] = (unsigned)__builtin_bit_cast(unsigned short, (bh16)lo[2 * q]) | ((unsigned)__builtin_bit_cast(unsigned short, (bh16)lo[2 * q + 1]) << 16);
                ((unsigned*)&o)[2 + q] = (unsigned)__builtin_bit_cast(unsigned short, (bh16)hi[2 * q]) | ((unsigned)__builtin_bit_cast(unsigned short, (bh16)hi[2 * q + 1]) << 16); }
            *(GAS v4u*)(bp + i * 64 + 8 * (t & 7)) = o; }
    }
    LAS float* tot = gl + 8192 + 8 * (16 * 68);
    tot[w * 64 + t] = acc;
    __syncthreads();
    { float gsum = 0.f;
#pragma unroll
      for (int cc = 0; cc < 4; ++cc) { const float v = tot[(dir * 4 + cc) * 64 + t]; if (dir ? (cc <= c) : (cc >= c)) gsum += v; }
      a.gv[((size_t)(p * 2 + dir) * 4 + c) * 64 + t] = gsum;
      if (c == (dir ? 3 : 0)) a.dec[(size_t)((sc * 4 + hh) * 2 + dir) * 64 + t] = __expf(gsum); }
}

template <int DK, bool GLA, bool WITH_O>
__device__ __forceinline__ void mix_units(Frame& F, const CMixArgs& a) {
    typedef MixLds<DK, GLA, WITH_O> ML;
    constexpr int NT = DK / 16;
    const int w = F.wave, lane0 = F.lane;
    int p = (int)blockIdx.x;
    if (p >= 1536) return;
    RawSet<GLA> RA, RB;
    raw_load<GLA, WITH_O>(RA, a, p, 0, w, lane0); raw_load<GLA, WITH_O>(RB, a, p, 1, w, lane0);
    f32x4 S[NT]; float dsum[8]; u32x2 ofp[4][4];
#pragma unroll 1
    for (; p < 1536; p += F.G) {
        const int sc = p >> 2, hh = p & 3, pnext = p + F.G;
#pragma unroll 1
        for (int dir = 0; dir < 2; ++dir) {
            const int lane = opaque_i(lane0);
            unsigned char* sp = a.st + state_off(sc, GLA, hh, dir) + (size_t)(unsigned)(w * NT * 512 + lane * 8);
            if (WITH_O) {
#pragma unroll
                for (int tt = 0; tt < NT; ++tt) { const u32x2 pk = *(const GAS u32x2*)(sp + tt * 512); S[tt] = (f32x4){bflo(pk.x), bfhi(pk.x), bflo(pk.y), bfhi(pk.y)}; } }
            else {
#pragma unroll
                for (int tt = 0; tt < NT; ++tt) S[tt] = (f32x4){0.f, 0.f, 0.f, 0.f};
#pragma unroll
                for (int e = 0; e < 8; ++e) dsum[e] = 0.f; }
#pragma unroll 1
            for (int h2 = 0; h2 < 2; ++h2) {
                mix_step<DK, GLA, WITH_O>(F, a, p, 4 * dir + 2 * h2, pnext, RA, S, dsum, ofp);
                mix_step<DK, GLA, WITH_O>(F, a, p, 4 * dir + 2 * h2 + 1, pnext, RB, S, dsum, ofp);
            }
            if (!WITH_O) {
#pragma unroll
                for (int tt = 0; tt < NT; ++tt) { u32x2 pk; pk.x = cvtpk_c(S[tt][0], S[tt][1]); pk.y = cvtpk_c(S[tt][2], S[tt][3]); *(GAS u32x2*)(sp + tt * 512) = pk; }
                if (GLA && w == 0 && lane < 8) { float* dp = a.dec + (size_t)((sc * 4 + hh) * 2 + dir) * 64 + 8 * lane;
#pragma unroll
                    for (int e = 0; e < 8; ++e) dp[e] = __expf(dsum[e]); }
            }
        }
    }
}

template <bool GLA> struct KvRaw;
template <> struct KvRaw<true> { v4u k, v0, v1, bfh, bbh; f32x4 gf0, gf1, gb0, gb1; };
template <> struct KvRaw<false> { v4u k0, k1, v0, v1; };
template <bool GLA>
__device__ __forceinline__ void kv_load(KvRaw<GLA>& R, const CMixArgs& a, int p, int c, int w, int lane0) {
    const int lane = opaque_i(lane0), sc = p >> 2, hh = p & 3, pc = lane & 7, ti = 8 * w + (lane >> 3);
    const size_t row = (size_t)(sc * 256 + 64 * c + ti);
    if constexpr (GLA) {
        R.k = *(const GAS v4u*)(a.proj + pg8::pl(pg8::PL_GK, hh, row, 64) + 8 * pc);
        const bf16* pv = a.proj + pg8::pl(pg8::PL_GV, hh, row, 128) + 8 * pc; R.v0 = *(const GAS v4u*)pv; R.v1 = *(const GAS v4u*)(pv + 64);
        R.bfh = *(const GAS v4u*)(a.bb0 + ((size_t)(p * 4 + c) * 64 + ti) * 64 + 8 * pc); R.bbh = *(const GAS v4u*)(a.bb1 + ((size_t)(p * 4 + c) * 64 + ti) * 64 + 8 * pc);
        const float* g0 = a.gv + ((size_t)(p * 2 + 0) * 4 + c) * 64 + 8 * pc; const float* g1 = a.gv + ((size_t)(p * 2 + 1) * 4 + c) * 64 + 8 * pc;
        R.gf0 = *(const GAS f32x4*)g0; R.gf1 = *(const GAS f32x4*)(g0 + 4); R.gb0 = *(const GAS f32x4*)g1; R.gb1 = *(const GAS f32x4*)(g1 + 4);
    } else {
        const bf16* pk = a.proj + pg8::pl(pg8::PL_RK, hh, row, 128) + 8 * pc; R.k0 = *(const GAS v4u*)pk; R.k1 = *(const GAS v4u*)(pk + 64);
        const bf16* pv = a.proj + pg8::pl(pg8::PL_RV, hh, row, 128) + 8 * pc; R.v0 = *(const GAS v4u*)pv; R.v1 = *(const GAS v4u*)(pv + 64);
    }
}
template <int DK, bool GLA>
__device__ __forceinline__ void kv_step(Frame& F, const CMixArgs& a, int p, int c, int pnext, KvRaw<GLA>& R, f32x4 (&Sf)[DK / 16], f32x4 (&Sb)[DK / 16]) {
    constexpr int NT = DK / 16, RQ = DK * 2 + 16, RV = 272, O_KF = 0, O_KB = 64 * RQ, O_VB = 2 * 64 * RQ;
    LAS unsigned char* L = F.lds;
    const int lane0 = F.lane, w = F.wave, hh = p & 3;
    __syncthreads();
    { const int lane = opaque_i(lane0), i = 8 * w + (lane >> 3), pc = lane & 7;
      *(LAS v4u*)(L + O_VB + i * RV + 16 * pc) = R.v0; *(LAS v4u*)(L + O_VB + i * RV + 128 + 16 * pc) = R.v1;
      if constexpr (GLA) {
          float f8[8], b8[8];
#pragma unroll
          for (int e = 0; e < 8; ++e) { const unsigned wk = ((const unsigned*)&R.k)[e >> 1]; const float kv = (e & 1) ? bfhi(wk) : bflo(wk);
              const float xf = (e < 4 ? R.gf0[e & 3] : R.gf1[e & 3]) - h2f(((const unsigned*)&R.bfh)[e >> 1], e & 1), xb = (e < 4 ? R.gb0[e & 3] : R.gb1[e & 3]) - h2f(((const unsigned*)&R.bbh)[e >> 1], e & 1);
              f8[e] = kv * __expf(xf); b8[e] = kv * __expf(xb); }
          *(LAS v4u*)(L + O_KF + i * RQ + 16 * pc) = (v4u){cvtpk_c(f8[0], f8[1]), cvtpk_c(f8[2], f8[3]), cvtpk_c(f8[4], f8[5]), cvtpk_c(f8[6], f8[7])};
          *(LAS v4u*)(L + O_KB + i * RQ + 16 * pc) = (v4u){cvtpk_c(b8[0], b8[1]), cvtpk_c(b8[2], b8[3]), cvtpk_c(b8[4], b8[5]), cvtpk_c(b8[6], b8[7])};
      } else {
          const float l2g = hh == 0 ? -0.045803689613124f : hh == 1 ? -0.022720076500083f : hh == 2 ? -0.011315313227834f : -0.005646563141142f;
          const float j = (float)(64 * c + i), ef = __builtin_amdgcn_exp2f(l2g * (255.0f - j)), eb = __builtin_amdgcn_exp2f(l2g * j);
#pragma unroll
          for (int x = 0; x < 2; ++x) { const v4u rk = x ? R.k1 : R.k0; v4u of, ob;
#pragma unroll
              for (int q = 0; q < 4; ++q) { const unsigned wk = ((const unsigned*)&rk)[q]; ((unsigned*)&of)[q] = cvtpk_c(bflo(wk) * ef, bfhi(wk) * ef); ((unsigned*)&ob)[q] = cvtpk_c(bflo(wk) * eb, bfhi(wk) * eb); }
              *(LAS v4u*)(L + O_KF + i * RQ + 128 * x + 16 * pc) = of; *(LAS v4u*)(L + O_KB + i * RQ + 128 * x + 16 * pc) = ob; }
      } }
    kv_load<GLA>(R, a, c < 2 ? p : (pnext < 1536 ? pnext : p), (c + 2) & 3, w, lane0);
    __syncthreads();
    { const int lane = opaque_i(lane0), g = lane >> 4, lr = lane & 15, q4 = lr >> 2, p4 = lr & 3;
      const LAS unsigned char* vb = L + O_VB + (8 * g + q4) * RV + 32 * w + 8 * p4;
      const bf16x8 vf0 = __builtin_shufflevector(TRRD(vb), TRRD(vb + 4 * RV), 0, 1, 2, 3, 4, 5, 6, 7), vf1 = __builtin_shufflevector(TRRD(vb + 32 * RV), TRRD(vb + 36 * RV), 0, 1, 2, 3, 4, 5, 6, 7);
#pragma unroll
      for (int th = 0; th < NT / 4; ++th) {
          bf16x8 kf0[4], kf1[4], kb0[4], kb1[4];
#pragma unroll
          for (int x = 0; x < 4; ++x) { const int tt = 4 * th + x;
              const LAS unsigned char* ka = L + O_KF + (8 * g + q4) * RQ + 32 * tt + 8 * p4; const LAS unsigned char* kb = L + O_KB + (8 * g + q4) * RQ + 32 * tt + 8 * p4;
              kf0[x] = __builtin_shufflevector(TRRD(ka), TRRD(ka + 4 * RQ), 0, 1, 2, 3, 4, 5, 6, 7); kf1[x] = __builtin_shufflevector(TRRD(ka + 32 * RQ), TRRD(ka + 36 * RQ), 0, 1, 2, 3, 4, 5, 6, 7);
              kb0[x] = __builtin_shufflevector(TRRD(kb), TRRD(kb + 4 * RQ), 0, 1, 2, 3, 4, 5, 6, 7); kb1[x] = __builtin_shufflevector(TRRD(kb + 32 * RQ), TRRD(kb + 36 * RQ), 0, 1, 2, 3, 4, 5, 6, 7); }
          __builtin_amdgcn_sched_barrier(0);
#pragma unroll
          for (int x = 0; x < 4; ++x) { const int tt = 4 * th + x;
              Sf[tt] = __builtin_amdgcn_mfma_f32_16x16x32_bf16(kf0[x], vf0, Sf[tt], 0, 0, 0); Sf[tt] = __builtin_amdgcn_mfma_f32_16x16x32_bf16(kf1[x], vf1, Sf[tt], 0, 0, 0);
              Sb[tt] = __builtin_amdgcn_mfma_f32_16x16x32_bf16(kb0[x], vf0, Sb[tt], 0, 0, 0); Sb[tt] = __builtin_amdgcn_mfma_f32_16x16x32_bf16(kb1[x], vf1, Sb[tt], 0, 0, 0); }
          __builtin_amdgcn_sched_barrier(0);
      } }
}
template <int DK, bool GLA>
__device__ __forceinline__ void kv_units(Frame& F, const CMixArgs& a) {
    constexpr int NT = DK / 16;
    const int w = F.wave, lane0 = F.lane;
    int p = (int)blockIdx.x;
    if (p >= 1536) return;
    if (GLA) {
#pragma unroll 1
        for (int pp = p; pp < 1536; pp += F.G) gla_b_stage(F, a, pp);
        asm volatile("s_waitcnt vmcnt(0)" ::: "memory"); __syncthreads(); }
    KvRaw<GLA> RA, RB;
    kv_load<GLA>(RA, a, p, 0, w, lane0); kv_load<GLA>(RB, a, p, 1, w, lane0);
#pragma unroll 1
    for (; p < 1536; p += F.G) {
        const int sc = p >> 2, hh = p & 3, pnext = p + F.G;
        f32x4 Sf[NT], Sb[NT];
#pragma unroll
        for (int tt = 0; tt < NT; ++tt) { Sf[tt] = (f32x4){0.f, 0.f, 0.f, 0.f}; Sb[tt] = (f32x4){0.f, 0.f, 0.f, 0.f}; }
        kv_step<DK, GLA>(F, a, p, 0, pnext, RA, Sf, Sb); kv_step<DK, GLA>(F, a, p, 1, pnext, RB, Sf, Sb);
        kv_step<DK, GLA>(F, a, p, 2, pnext, RA, Sf, Sb); kv_step<DK, GLA>(F, a, p, 3, pnext, RB, Sf, Sb);
        const int lane = opaque_i(lane0);
#pragma unroll
        for (int dir = 0; dir < 2; ++dir) { unsigned char* sp = a.st + state_off(sc, GLA, hh, dir) + (size_t)(unsigned)(w * NT * 512 + lane * 8);
#pragma unroll
            for (int tt = 0; tt < NT; ++tt) { const f32x4 s = dir ? Sb[tt] : Sf[tt]; u32x2 pk; pk.x = cvtpk_c(s[0], s[1]); pk.y = cvtpk_c(s[2], s[3]); *(GAS u32x2*)(sp + tt * 512) = pk; } }
    }
}

constexpr int RD_SLOT = 32768;
__device__ __forceinline__ void ret_dma_block(Frame& F, const CMixArgs& a, int p, int kb, int slot) {
    const int lane = opaque_i(F.lane), w = F.wave, sc = p >> 2, hh = p & 3;
#pragma unroll
    for (int x = 0; x < 2; ++x) {
        const int r = 4 * (2 * w + x) + (lane >> 4), cp = lane & 15;
        const size_t row = (size_t)(sc * 256 + 64 * kb + r);
        const bf16* gk = a.proj + pg8::pl(pg8::PL_RK, hh, row, 128) + 8 * (cp ^ (r & 15));
        const bf16* gv = a.proj + pg8::pl(pg8::PL_RV, hh, row, 128) + 8 * (cp ^ (2 * (r & 7)));
        __builtin_amdgcn_global_load_lds((const unsigned*)gk, (LAS unsigned*)(F.lds + slot * RD_SLOT + (2 * w + x) * 1024), 16, 0, 0);
        __builtin_amdgcn_global_load_lds((const unsigned*)gv, (LAS unsigned*)(F.lds + slot * RD_SLOT + 16384 + (2 * w + x) * 1024), 16, 0, 0);
    }
}
__device__ __forceinline__ void tr_read16(const unsigned (&ad)[8], u32x2 (&r)[16]) {
    asm volatile("ds_read_b64_tr_b16 %0, %16\n\tds_read_b64_tr_b16 %1, %16 offset:4096\n\tds_read_b64_tr_b16 %2, %17\n\tds_read_b64_tr_b16 %3, %17 offset:4096\n\t"
                 "ds_read_b64_tr_b16 %4, %18\n\tds_read_b64_tr_b16 %5, %18 offset:4096\n\tds_read_b64_tr_b16 %6, %19\n\tds_read_b64_tr_b16 %7, %19 offset:4096\n\t"
                 "ds_read_b64_tr_b16 %8, %20\n\tds_read_b64_tr_b16 %9, %20 offset:4096\n\tds_read_b64_tr_b16 %10, %21\n\tds_read_b64_tr_b16 %11, %21 offset:4096\n\t"
                 "ds_read_b64_tr_b16 %12, %22\n\tds_read_b64_tr_b16 %13, %22 offset:4096\n\tds_read_b64_tr_b16 %14, %23\n\tds_read_b64_tr_b16 %15, %23 offset:4096\n\t"
                 "s_waitcnt lgkmcnt(0)"
                 : "=&v"(r[0]), "=&v"(r[1]), "=&v"(r[2]), "=&v"(r[3]), "=&v"(r[4]), "=&v"(r[5]), "=&v"(r[6]), "=&v"(r[7]),
                   "=&v"(r[8]), "=&v"(r[9]), "=&v"(r[10]), "=&v"(r[11]), "=&v"(r[12]), "=&v"(r[13]), "=&v"(r[14]), "=&v"(r[15])
                 : "v"(ad[0]), "v"(ad[1]), "v"(ad[2]), "v"(ad[3]), "v"(ad[4]), "v"(ad[5]), "v"(ad[6]), "v"(ad[7]) : "memory");
}
__device__ __forceinline__ void ret_block(Frame& F, const CMixArgs& a, int p, int kb, int slot, int pnext, const bf16x8 (&Qf)[2][4], f32x4 (&O)[8][2]) {
    LAS unsigned char* L = F.lds;
    const int w = F.wave, hh = p & 3;
    const float l2g = hh == 0 ? -0.045803689613124f : hh == 1 ? -0.022720076500083f : hh == 2 ? -0.011315313227834f : -0.005646563141142f;
    asm volatile("s_waitcnt vmcnt(4)" ::: "memory");
    __builtin_amdgcn_s_barrier();
    asm volatile("" ::: "memory");
    { const int kn = kb + 2, pn2 = kn < 4 ? p : (pnext < 1536 ? pnext : p); ret_dma_block(F, a, pn2, kn & 3, slot == 0 ? 2 : slot - 1); }
    LAS unsigned char* KB = L + slot * RD_SLOT; LAS unsigned char* VB = KB + 16384;
    const int lane = opaque_i(F.lane), g = lane >> 4, lr = lane & 15, q4 = lr >> 2, p4 = lr & 3;
    const int xk16 = (lr ^ (g >> 1)) << 4, xv16 = ((p4 >> 1) ^ (2 * ((4 * g + q4) & 7))) << 4;
#pragma unroll
    for (int sp = 0; sp < 2; ++sp) {
        f32x4 st[2][2];
#pragma unroll
        for (int h = 0; h < 2; ++h)
#pragma unroll
            for (int it = 0; it < 2; ++it) st[h][it] = (f32x4){0.f, 0.f, 0.f, 0.f};
        { bf16x8 kf[2][4];
#pragma unroll
          for (int s = 0; s < 4; ++s)
#pragma unroll
              for (int h = 0; h < 2; ++h) {
                  const LAS unsigned char* kp = KB + (32 * sp + 16 * h + lr) * 256 + 8 * (g & 1);
                  const u32x2 lo = *(const LAS u32x2*)(kp + ((64 * s) ^ xk16)), hi = *(const LAS u32x2*)(kp + ((64 * s + 32) ^ xk16));
                  kf[h][s] = __builtin_bit_cast(bf16x8, (v4u){lo.x, lo.y, hi.x, hi.y}); }
          __builtin_amdgcn_sched_barrier(0);
#pragma unroll
          for (int s = 0; s < 4; ++s)
#pragma unroll
              for (int h = 0; h < 2; ++h)
#pragma unroll
                  for (int it = 0; it < 2; ++it) st[h][it] = __builtin_amdgcn_mfma_f32_16x16x32_bf16(kf[h][s], Qf[it][s], st[h][it], 0, 0, 0);
          __builtin_amdgcn_sched_barrier(0); }
        bf16x8 pf[2];
#pragma unroll
        for (int it = 0; it < 2; ++it) {
            const int i = 32 * w + 16 * it + lr;
            unsigned pw[4];
#pragma unroll
            for (int h = 0; h < 2; ++h) { float e[4];
#pragma unroll
                for (int r = 0; r < 4; ++r) { const int j = 64 * kb + 32 * sp + 16 * h + 4 * g + r; const int d = i - j; e[r] = st[h][it][r] * __builtin_amdgcn_exp2f(l2g * (float)(d < 0 ? -d : d)); }
                pw[2 * h] = cvtpk_c(e[0], e[1]); pw[2 * h + 1] = cvtpk_c(e[2], e[3]); }
            pf[it] = __builtin_bit_cast(bf16x8, (v4u){pw[0], pw[1], pw[2], pw[3]});
        }
        { unsigned ad[8]; u32x2 vr[16];
          const unsigned vb0 = (unsigned)(size_t)(VB + (32 * sp + 4 * g + q4) * 256 + 8 * (p4 & 1));
#pragma unroll
          for (int dt = 0; dt < 8; ++dt) ad[dt] = vb0 + ((32 * dt) ^ xv16);
          tr_read16(ad, vr);
          __builtin_amdgcn_sched_barrier(0);
#pragma unroll
          for (int dt = 0; dt < 8; ++dt) { const bf16x8 vf = __builtin_bit_cast(bf16x8, (v4u){vr[2 * dt].x, vr[2 * dt].y, vr[2 * dt + 1].x, vr[2 * dt + 1].y});
#pragma unroll
              for (int it = 0; it < 2; ++it) O[dt][it] = __builtin_amdgcn_mfma_f32_16x16x32_bf16(vf, pf[it], O[dt][it], 0, 0, 0); }
          __builtin_amdgcn_sched_barrier(0); }
    }
}
__device__ __forceinline__ void ret_q_load(bf16x8 (&Qf)[2][4], const CMixArgs& a, int p, int w, int lane0) {
    const int lane = opaque_i(lane0), g = lane >> 4, lr = lane & 15, sc = p >> 2, hh = p & 3;
#pragma unroll
    for (int it = 0; it < 2; ++it) { const bf16* qp = a.proj + pg8::pl(pg8::PL_RQ, hh, (size_t)(sc * 256 + 32 * w + 16 * it + lr), 128) + 4 * g;
#pragma unroll
        for (int s = 0; s < 4; ++s) { const u32x2 lo = *(const GAS u32x2*)(qp + 32 * s), hi = *(const GAS u32x2*)(qp + 32 * s + 16); Qf[it][s] = __builtin_bit_cast(bf16x8, (v4u){lo.x, lo.y, hi.x, hi.y}); } }
}
__device__ __forceinline__ void ret_units_direct(Frame& F, const CMixArgs& a) {
    const int w = F.wave;
    int p = (int)blockIdx.x;
    if (p >= 1536) return;
    bf16x8 Qf[2][4];
    asm volatile("s_waitcnt vmcnt(0)" ::: "memory"); __syncthreads();
    ret_dma_block(F, a, p, 0, 0); ret_dma_block(F, a, p, 1, 1);
    int slot = 0;
    ret_q_load(Qf, a, p, w, F.lane);
#pragma unroll 1
    for (; p < 1536; p += F.G) {
        const int sc = p >> 2, hh = p & 3, pnext = p + F.G;
        const float l2g = hh == 0 ? -0.045803689613124f : hh == 1 ? -0.022720076500083f : hh == 2 ? -0.011315313227834f : -0.005646563141142f;
        f32x4 O[8][2];
#pragma unroll
        for (int dt = 0; dt < 8; ++dt)
#pragma unroll
            for (int it = 0; it < 2; ++it) O[dt][it] = (f32x4){0.f, 0.f, 0.f, 0.f};
#pragma unroll 1
        for (int kb = 0; kb < 4; ++kb) { ret_block(F, a, p, kb, slot, pnext, Qf, O); slot = slot == 2 ? 0 : slot + 1; }
        { const int lane = opaque_i(F.lane), lr = lane & 15;
          const unsigned char* sp0 = a.st + state_off(sc, false, hh, 0) + (size_t)(unsigned)(lane * 8);
          u32x2 cA[16], cB[16];
#define RD_CLOAD(dst, k_) do { const unsigned char* b_ = sp0 + ((k_) >> 2) * 32768 + 2 * ((k_) & 3) * 512; \
              _Pragma("unroll") for (int dt = 0; dt < 8; ++dt) { dst[2 * dt] = *(const GAS u32x2*)(b_ + dt * 4096); dst[2 * dt + 1] = *(const GAS u32x2*)(b_ + dt * 4096 + 512); } } while (0)
#define RD_CMMA(src, k_) do { const int dir_ = (k_) >> 2, s_ = (k_) & 3; bf16x8 qs[2]; \
              _Pragma("unroll") for (int it = 0; it < 2; ++it) { const int i = 32 * w + 16 * it + lr; const float f = __builtin_amdgcn_exp2f(l2g * (float)(dir_ ? 256 - i : i + 1)); \
                  const v4u qw = __builtin_bit_cast(v4u, Qf[it][s_]); v4u o_; \
                  _Pragma("unroll") for (int j = 0; j < 4; ++j) ((unsigned*)&o_)[j] = cvtpk_c(bflo(((const unsigned*)&qw)[j]) * f, bfhi(((const unsigned*)&qw)[j]) * f); \
                  qs[it] = __builtin_bit_cast(bf16x8, o_); } \
              _Pragma("unroll") for (int dt = 0; dt < 8; ++dt) { const bf16x8 cf = __builtin_bit_cast(bf16x8, (v4u){src[2 * dt].x, src[2 * dt].y, src[2 * dt + 1].x, src[2 * dt + 1].y}); \
                  _Pragma("unroll") for (int it = 0; it < 2; ++it) O[dt][it] = __builtin_amdgcn_mfma_f32_16x16x32_bf16(cf, qs[it], O[dt][it], 0, 0, 0); } } while (0)
          RD_CLOAD(cA, 0); RD_CLOAD(cB, 1);
          __builtin_amdgcn_sched_barrier(0);
#pragma unroll
          for (int k = 0; k < 8; k += 2) {
              RD_CMMA(cA, k); if (k + 2 < 8) RD_CLOAD(cA, k + 2);
              __builtin_amdgcn_sched_barrier(0);
              RD_CMMA(cB, k + 1); if (k + 3 < 8) RD_CLOAD(cB, k + 3);
              __builtin_amdgcn_sched_barrier(0);
          }
#undef RD_CLOAD
#undef RD_CMMA
        }
        ret_q_load(Qf, a, pnext < 1536 ? pnext : p, w, F.lane);
        { const int lane = opaque_i(F.lane), g = lane >> 4, lr = lane & 15;
          LAS unsigned char* T = F.lds + 3 * RD_SLOT + w * (16 * 272);
          f32x4 nw[4], nb[4];
#pragma unroll
          for (int k = 0; k < 4; ++k) { nw[k] = *(const GAS f32x4*)(a.rnw + 128 * hh + 16 * (lane & 7) + 4 * k); nb[k] = *(const GAS f32x4*)(a.rnb + 128 * hh + 16 * (lane & 7) + 4 * k); }
#pragma unroll
          for (int it = 0; it < 2; ++it) {
              v4u gt[2][2];
#pragma unroll
              for (int h = 0; h < 2; ++h) { const bf16* gp = a.proj + pg8::pl(pg8::PL_RG, hh, (size_t)(sc * 256 + 32 * w + 16 * it + 8 * h + (lane >> 3)), 128) + 16 * (lane & 7);
                  gt[h][0] = *(const GAS v4u*)gp; gt[h][1] = *(const GAS v4u*)(gp + 8); }
              float sm = 0.f;
#pragma unroll
              for (int dt = 0; dt < 8; ++dt) sm += (O[dt][it][0] + O[dt][it][1]) + (O[dt][it][2] + O[dt][it][3]);
              sm += __shfl_xor(sm, 16); sm += __shfl_xor(sm, 32);
              const float mu = sm * (1.0f / 128.0f); float ss = 0.f;
#pragma unroll
              for (int dt = 0; dt < 8; ++dt) { O[dt][it] = O[dt][it] - mu; ss += (O[dt][it][0] * O[dt][it][0] + O[dt][it][1] * O[dt][it][1]) + (O[dt][it][2] * O[dt][it][2] + O[dt][it][3] * O[dt][it][3]); }
              ss += __shfl_xor(ss, 16); ss += __shfl_xor(ss, 32);
              const float rs = __builtin_amdgcn_rsqf(ss * (1.0f / 128.0f) + EPS);
#pragma unroll
              for (int dt = 0; dt < 8; ++dt) { const f32x4 y = O[dt][it] * rs;
                  u32x2 pk; pk.x = cvtpk_c(y[0], y[1]); pk.y = cvtpk_c(y[2], y[3]);
                  *(LAS u32x2*)(T + lr * 272 + 32 * dt + 8 * g) = pk; }
              asm volatile("s_waitcnt lgkmcnt(0)" ::: "memory");
#pragma unroll
              for (int h = 0; h < 2; ++h) { const int rr = 8 * h + (lane >> 3);
                  const v4u y0 = *(const LAS v4u*)(T + rr * 272 + 32 * (lane & 7)), y1 = *(const LAS v4u*)(T + rr * 272 + 32 * (lane & 7) + 16);
                  unsigned ow[8];
#pragma unroll
                  for (int k = 0; k < 8; ++k) { const unsigned yw = k < 4 ? ((const unsigned*)&y0)[k] : ((const unsigned*)&y1)[k - 4], gw = k < 4 ? ((const unsigned*)&gt[h][0])[k] : ((const unsigned*)&gt[h][1])[k - 4];
                      const float g0 = bflo(gw), g1 = bfhi(gw);
                      ow[k] = cvtpk_c((bflo(yw) * nw[k >> 1][2 * (k & 1)] + nb[k >> 1][2 * (k & 1)]) * g0 * __builtin_amdgcn_rcpf(1.0f + __expf(-g0)), (bfhi(yw) * nw[k >> 1][2 * (k & 1) + 1] + nb[k >> 1][2 * (k & 1) + 1]) * g1 * __builtin_amdgcn_rcpf(1.0f + __expf(-g1))); }
                  bf16* op = a.mo + (size_t)(sc * 256 + 32 * w + 16 * it + rr) * a.mop + 512 + 128 * hh + 16 * (lane & 7);
                  *(GAS v4u*)op = (v4u){ow[0], ow[1], ow[2], ow[3]}; *(GAS v4u*)(op + 8) = (v4u){ow[4], ow[5], ow[6], ow[7]}; }
              asm volatile("s_waitcnt lgkmcnt(0)" ::: "memory");
          } }
    }
    asm volatile("s_waitcnt vmcnt(0)" ::: "memory"); __syncthreads();
}

template <bool WITH_O>
__device__ __forceinline__ void cmix_phase(Frame& F, const CMixArgs& a, int which = 3) {
#if MIX_GLA
    if (which & 1) { if constexpr (WITH_O) mix_units<64, true, true>(F, a); else kv_units<64, true>(F, a);
    __syncthreads(); }
#endif
#if MIX_RET
    if (which & 2) { if constexpr (WITH_O) ret_units_direct(F, a); else kv_units<128, false>(F, a);
    __syncthreads(); }
#endif
}
__device__ __forceinline__ void scan_phase(Frame& F, const CMixArgs& a) {
    const int nthreads = F.G * NWAVES * 64;
    for (int chain = (int)blockIdx.x * NWAVES * 64 + F.tid; chain < 34 * 49152; chain += nthreads) {
        const int sq = chain / 49152, cidx = chain % 49152;
        const int seq = sq < 2 ? 32 + sq : sq - 2;
        const int sc0 = seq < 32 ? seq * 8 : 256 + (seq - 32) * 64, ns = seq < 32 ? 8 : 64;
        const bool gla = cidx < 16384; const int c2 = gla ? cidx : cidx - 16384;
        const int hd = gla ? (c2 >> 11) : (c2 >> 12), v = gla ? (c2 & 2047) : (c2 & 4095), hh = hd >> 1, dir = hd & 1;
        if ((gla && !MIX_GLA) || (!gla && !MIX_RET)) continue;
        const int t0 = 16 * ((v >> 6) & 3) + 4 * ((v & 63) >> 4);
        const float gret = exp2f(256.0f * log2f(1.0f - exp2f(-5.0f - (float)hh)));
        f32x4 cst = {0.f, 0.f, 0.f, 0.f};
        for (int blk = 0; blk < ns; blk += 8) {
            u32x2 kv[8]; f32x4 d[8];
#pragma unroll
            for (int j = 0; j < 8; ++j) { const int n = dir ? ns - 1 - (blk + j) : blk + j;
                kv[j] = *(const GAS u32x2*)(a.st + state_off(sc0 + n, gla, hh, dir) + (size_t)v * 8);
                d[j] = gla ? *(const GAS f32x4*)(a.dec + (size_t)(((sc0 + n) * 4 + hh) * 2 + dir) * 64 + t0) : (f32x4){gret, gret, gret, gret}; }
#pragma unroll
            for (int j = 0; j < 8; ++j) { const int n = dir ? ns - 1 - (blk + j) : blk + j;
                u32x2 pk; pk.x = cvtpk_c(cst[0], cst[1]); pk.y = cvtpk_c(cst[2], cst[3]);
                *(GAS u32x2*)(a.sto + state_off(sc0 + n, gla, hh, dir) + (size_t)v * 8) = pk;
                cst = d[j] * cst + (f32x4){bflo(kv[j].x), bfhi(kv[j].x), bflo(kv[j].y), bfhi(kv[j].y)}; }
        }
    }
}

#ifndef W2_TILED
#define W2_TILED 1
#endif
#define NAIVE_MIX (!(MIX_GLA && MIX_RET))
constexpr int PB0 = NAIVE_MIX ? 8 : 5, NPH = PB0 + 4;
struct Args { const float* in[16]; float* out; unsigned char* ws; int ph_lo, ph_hi, use_bar, pad; };
__global__ void __launch_bounds__(NWAVES * 64, 2) fwd_kernel(Args args) {
    extern __shared__ __attribute__((aligned(16))) unsigned char lds[];
    Frame F;
    F.lds = (LAS unsigned char*)lds;
    F.MISC = (volatile LAS unsigned*)(F.lds + MISC_OFF);
    F.tid = threadIdx.x; F.lane = F.tid & 63; F.wave = __builtin_amdgcn_readfirstlane(F.tid >> 6);
    F.G = gridDim.x; { const int bx = blockIdx.x; F.vcu = (F.G % 8 == 0) ? (bx % 8) * (F.G / 8) + bx / 8 : bx; }
    unsigned char* ws = args.ws;
    gu32* ctl = (gu32*)(ws + WS_CTL);
    for (int u = F.tid; u < (LDS_BYTES - LDSCTL_OFF) / 4; u += NWAVES * 64) ((LAS unsigned*)(F.lds + LDSCTL_OFF))[u] = 0u;
    __syncthreads();
    XcdBarrier bar; bar.bar = (unsigned*)(ctl + CW_BAR); bar.x = 0; bar.st = nullptr;
    if (args.use_bar) bar = xcd_barrier_post((unsigned*)(ctl + CW_BAR), F.MISC + 8);
    const int lo = args.ph_lo, hi = args.ph_hi;
#define IN(k) (lo <= (k) && (k) < hi)
#define SEAM(k) do { if (IN(k) && IN((k) + 1)) xcd_barrier(bar); } while (0)
    if (IN(0)) { const P0Args pa{args.in[0], args.in[1], args.in[2], args.in[3], args.in[11], args.in[12], args.in[13], args.in[14], (bf16*)(ws + WS_WIN), (bf16*)(ws + WS_WOUT), (bf16*)(ws + WS_W1), (bf16*)(ws + WS_W2),
            (bf16*)(ws + WS_R0), (float*)(ws + WS_ROPE), (float*)(ws + WS_ROPE) + 16384 * 64, (float*)(ws + WS_GA), (float*)(ws + WS_RSTD)};
        p0_prologue(F, pa); __syncthreads();
#if REP0
        p0_prologue(F, pa, REP0); __syncthreads();
#endif
    }
    SEAM(0);
    if (IN(1)) { pg8::Gemm g{(bf16*)(ws + WS_R0), (bf16*)(ws + WS_WIN), M_TOK, NP, D, D}; pg8::StaticOrder S; S.init(M_TOK, NP, F.G, (int)blockIdx.x);
        pg8::EpiInProj E{(bf16*)(ws + WS_R1), (float*)(ws + WS_RSTD), (float*)(ws + WS_ROPE), (float*)(ws + WS_ROPE) + 16384 * 64};
#if REP1 == 2
        { pg8::EpiPlain E2{(bf16*)(ws + WS_R1)}; pg8::gemm_phase<pg8::EpiPlain, pg8::StaticOrder, true, true>(F.lds + RING_OFF, g, S, E2); } __syncthreads();
#elif REP1 == 3
        { pg8::EpiNull E2{}; pg8::gemm_phase<pg8::EpiNull, pg8::StaticOrder, true, true>(F.lds + RING_OFF, g, S, E2); } __syncthreads();
#endif
        pg8::gemm_phase<pg8::EpiInProj, pg8::StaticOrder, true, true>(F.lds + RING_OFF, g, S, E);
#if REP1 == 1
        __syncthreads(); pg8::gemm_phase<pg8::EpiInProj, pg8::StaticOrder, true, true>(F.lds + RING_OFF, g, S, E);
#endif
    }
    SEAM(1);
    if (IN(2)) { const CMixArgs ca{(bf16*)(ws + WS_R1), (float*)(ws + WS_GA), args.in[4], args.in[5], args.in[6], args.in[7], ws + WS_ST, (float*)(ws + WS_DEC), args.in[8], args.in[9], args.in[10], (bf16*)((unsigned char*)args.out + (size_t)192 * MiB), D, ws + WS_ST, (unsigned char*)args.out, (bh16*)((unsigned char*)args.out + (size_t)96 * MiB), (bh16*)args.out, (float*)(ws + WS_DEC + 786432)};
        cmix_phase<false>(F, ca);
#if REP2
        cmix_phase<false>(F, ca, REP2);
#endif
    }
    SEAM(2);
    if (IN(3)) { const CMixArgs ca{(bf16*)(ws + WS_R1), (float*)(ws + WS_GA), args.in[4], args.in[5], args.in[6], args.in[7], ws + WS_ST, (float*)(ws + WS_DEC), args.in[8], args.in[9], args.in[10], (bf16*)((unsigned char*)args.out + (size_t)192 * MiB), D, ws + WS_ST, (unsigned char*)args.out, (bh16*)((unsigned char*)args.out + (size_t)96 * MiB), (bh16*)args.out, (float*)(ws + WS_DEC + 786432)};
#if REP3
        { CMixArgs cb = ca; cb.sto = (unsigned char*)args.out + (size_t)224 * MiB; scan_phase(F, cb); }
#endif
        scan_phase(F, ca); }
    SEAM(3);
    if (IN(4)) { const CMixArgs ca{(bf16*)(ws + WS_R1), (float*)(ws + WS_GA), args.in[4], args.in[5], args.in[6], args.in[7], ws + WS_ST, (float*)(ws + WS_DEC), args.in[8], args.in[9], args.in[10], (bf16*)((unsigned char*)args.out + (size_t)192 * MiB), D, ws + WS_ST, (unsigned char*)args.out, (bh16*)((unsigned char*)args.out + (size_t)96 * MiB), (bh16*)args.out, (float*)(ws + WS_DEC + 786432)};
#if REP4
        { CMixArgs cb = ca; cmix_phase<true>(F, cb, REP4); }
#endif
        cmix_phase<true>(F, ca); }
    SEAM(4);
#if NAIVE_MIX
    { const MixArgs ma{(bf16*)(ws + WS_R1), (float*)(ws + WS_GA), args.in[4], args.in[5], args.in[6], args.in[7], args.out, args.in[8], args.in[9], args.in[10]};
    if (IN(5)) { naive_mix_phase<false>(F, ma); __syncthreads(); }
    SEAM(5);
    if (IN(6)) { naive_mix_phase<true>(F, ma); __syncthreads(); }
    SEAM(6);
    if (IN(7)) { naive_combine(F, ma); }
    SEAM(7); }
#endif
    if (IN(PB0)) { pg8::Gemm g{(bf16*)((unsigned char*)args.out + (size_t)192 * MiB), (bf16*)(ws + WS_WOUT), M_TOK, D, D, D}; pg8::StaticOrder S; S.init(M_TOK, D, F.G, (int)blockIdx.x);
        pg8::EpiResidB2 E{(const bf16*)(ws + WS_R0), (bf16*)(ws + WS_A2), (float*)(ws + WS_SQ1)};
        pg8::gemm_phase<pg8::EpiResidB2, pg8::StaticOrder, true, true>(F.lds + RING_OFF, g, S, E);
#if REP5
        __syncthreads(); pg8::gemm_phase<pg8::EpiResidB2, pg8::StaticOrder, true, true>(F.lds + RING_OFF, g, S, E);
#endif
    }
    SEAM(PB0);
    if (IN(PB0 + 1)) {
        { const float* sq = (const float*)(ws + WS_SQ1); float* r2v = (float*)(ws + WS_RSTD);
          for (int row = (int)blockIdx.x * NWAVES * 64 + F.tid; row < M_TOK; row += F.G * NWAVES * 64) { const f32x4* s4 = (const f32x4*)(sq + (size_t)row * 16);
              const f32x4 t = (s4[0] + s4[1]) + (s4[2] + s4[3]); r2v[row] = 1.0f / (((t[0] + t[1]) + (t[2] + t[3])) * (1.0f / 1024.0f) + EPS); }
          if (args.use_bar) xcd_barrier(bar); }
        pg8::Gemm g{(bf16*)(ws + WS_A2), (bf16*)(ws + WS_W1), M_TOK, FF, D, D}; pg8::StaticOrder S; S.init(M_TOK, FF, F.G, (int)blockIdx.x);
        pg8::EpiFF1 E{(bf16*)(ws + WS_R1), (float*)(ws + WS_RSTD)};
        pg8::gemm_phase<pg8::EpiFF1, pg8::StaticOrder, true, true>(F.lds + RING_OFF, g, S, E);
#if REP6
        __syncthreads(); pg8::gemm_phase<pg8::EpiFF1, pg8::StaticOrder, true, true>(F.lds + RING_OFF, g, S, E);
#endif
    }
    SEAM(PB0 + 1);
#if H_TILED
    if (IN(PB0 + 2)) { pg8::Gemm g{(bf16*)(ws + WS_R1), (bf16*)(ws + WS_W2), M_TOK, D, FF, 64, W2_TILED ? 64 : 0, 32768, W2_TILED ? 32768 : 0, (long)FF * 512, W2_TILED ? (long)FF * 512 : 0};
#else
    if (IN(PB0 + 2)) { pg8::Gemm g{(bf16*)(ws + WS_R1), (bf16*)(ws + WS_W2), M_TOK, D, FF, FF, W2_TILED ? 64 : 0, 0, W2_TILED ? 32768 : 0, 0, W2_TILED ? (long)FF * 512 : 0};
#endif
        pg8::StaticOrder S; S.init(M_TOK, D, F.G, (int)blockIdx.x, FF2_REV);
        pg8::EpiResidB E{(bf16*)(ws + WS_A2), (float*)(ws + WS_SQ2)};
        pg8::gemm_phase<pg8::EpiResidB, pg8::StaticOrder, true, true, false, FF2_TOUCH>(F.lds + RING_OFF, g, S, E); }
    SEAM(PB0 + 2);
    if (IN(PB0 + 3)) { final_norm(F, args.out, (const bf16*)(ws + WS_A2), (float*)(ws + WS_SQ2), args.in[15]);
#if REP8
        final_norm(F, args.out, (const bf16*)(ws + WS_A2), (float*)(ws + WS_SQ2), args.in[15]);
#endif
    }
#undef IN
#undef SEAM
}

extern "C" void kernel_launch(void* const* d_in, const int* in_sizes, int n_in, void* d_out, int out_size, void* d_ws, size_t ws_size, hipStream_t stream) {
    static int grid = 0;
    if (grid == 0) {
        if (n_in != 16 || in_sizes[0] != M_PROMPT * D || out_size != M_TOK * D || ws_size < WS_END) {
            fprintf(stderr, "kernel_launch: unexpected shapes (n_in %d, in0 %d, out %d, ws %zu); nothing launched\n", n_in, n_in > 0 ? in_sizes[0] : -1, out_size, ws_size); grid = -1; return; }
        int dev = 0, cus = 0, per_cu = 0;
        if (hipGetDevice(&dev) != hipSuccess || hipDeviceGetAttribute(&cus, hipDeviceAttributeMultiprocessorCount, dev) != hipSuccess) { grid = -1; return; }
        if (hipFuncSetAttribute((const void*)fwd_kernel, hipFuncAttributeMaxDynamicSharedMemorySize, LDS_BYTES) != hipSuccess) { fprintf(stderr, "kernel_launch: hipFuncSetAttribute failed\n"); grid = -1; return; }
        if (hipOccupancyMaxActiveBlocksPerMultiprocessor(&per_cu, (const void*)fwd_kernel, NWAVES * 64, LDS_BYTES) != hipSuccess || per_cu < 1)
            fprintf(stderr, "kernel_launch: note: occupancy query reports %d workgroups per CU\n", per_cu);
        (void)hipGetLastError();
        grid = cus;
    }
    if (grid < 0) return;
    if (hipMemsetAsync((char*)d_ws + WS_CTL, 0, CTL_ZERO_BYTES, stream) != hipSuccess) return;
    Args a{};
    for (int i = 0; i < 16; ++i) a.in[i] = (const float*)d_in[i];
    a.out = (float*)d_out; a.ws = (unsigned char*)d_ws;
#if MK_SINGLE
    a.ph_lo = 0; a.ph_hi = NPH; a.use_bar = 1;
    hipLaunchKernelGGL(fwd_kernel, dim3(grid), dim3(NWAVES * 64), LDS_BYTES, stream, a);
#else
    for (int p = 0; p < NPH; ++p) { a.ph_lo = p; a.ph_hi = p + 1; a.use_bar = 0;
        hipLaunchKernelGGL(fwd_kernel, dim3(grid), dim3(NWAVES * 64), LDS_BYTES, stream, a); }
#endif
}
```

```cpp
#include <hip/hip_runtime.h>
#include <cstdio>
#ifndef MK_SINGLE
#define MK_SINGLE 1
#endif
#ifndef MIX_GLA
#define MIX_GLA 1
#define MIX_RET 1
#define REP1 0
#define REP2 0
#define REP3 0
#define REP4 0
#define REP6 0
#define DUP 0
#define ABLV 0
#define REP0 0
#define RELAX_MASK 0
#define STAG_TICKS 0
#define PROF_PHASE -1
#define PROF_A 1
#define PROF_B 2
#define PROF_BLOCK 0
#define PROF_DELAY 0
#define FF2X 0
#define LEAD_FF2 1
#define LEAD_IN 0
#define LEAD_OUT 0
#define LEAD_FF1 0
#define PROJ_ROWMAJOR 0
#define H_TILED 1
#define EPI_PLAIN_VARIANT 0
#define PROF_OA 0ull
#define PROF_OB 0ull
#define PROF_QA 25ull
#define PROF_QB 25ull
#define REP5 0
#define REP8 0
#endif
namespace pg8 {
#define PG8_LAS __attribute__((address_space(3)))
typedef unsigned short bf16_t;
typedef short bf16x8 __attribute__((ext_vector_type(8)));
typedef float f32x4 __attribute__((ext_vector_type(4)));
typedef unsigned u32x4 __attribute__((ext_vector_type(4)));
constexpr int BM = 256, BK = 64, HALF = 128, HTB = HALF * BK * 2  , STAGE_BYTES = 8 * HTB, NXCD = 8, WGM = 8;

__host__ __device__ __forceinline__ int lds_byte(int r, int c) { const int st = (r >> 4) * 2 + (c >> 5), rr = r & 15, cc = c & 31, ob = rr * 64 + cc * 2; return st * 1024 + (ob ^ (((ob >> 9) & 1) << 5)); }
__host__ __device__ __forceinline__ void stage_rc(int b, int& R, int& C) { const int st = b / 1024, sb = b % 1024, swz = sb ^ (((sb >> 9) & 1) << 5); R = (st >> 1) * 16 + swz / 64; C = (st & 1) * 32 + (swz % 64) / 2; }
__host__ __device__ __forceinline__ int perm32(int rho) { const int n = rho >> 4, i = rho & 15; return 8 * (i >> 2) + 4 * n + (i & 3); }

struct Unit { int pm, pn; };
struct Gemm { const bf16_t* A; const bf16_t* Bt; int M, N, K, lda; int ldb, ksA, ksB; long psA, psB; };

struct StaticOrder {
    int nM, nN, nwg, G, c, rev;
    __host__ __device__ void init(int M, int N, int G_, int c_, int rev_ = 0) { nM = M / BM; nN = N / BM; nwg = nM * nN; G = G_; c = c_; rev = rev_; }
    __host__ __device__ bool next(int i, Unit& u) const {
        if ((long)i * G + c >= nwg) return false;
        const long L = (long)(rev ? (nwg - 1 - c) / G - i : i) * G + c;
        int wgid = (int)L; { const int q = nwg / NXCD, r = nwg % NXCD, xcd = wgid % NXCD, off = wgid / NXCD; wgid = (xcd < r ? xcd * (q + 1) : r * (q + 1) + (xcd - r) * q) + off; }
        const int nig = WGM * nN, gid = wgid / nig, fm = gid * WGM, gsz = (nM - fm) < WGM ? (nM - fm) : WGM;
        u.pm = fm + ((wgid % nig) % gsz); u.pn = (wgid % nig) / gsz; return true;
    }
    __device__ __forceinline__ void a_ready(const Unit&) const {}
    __device__ __forceinline__ void done(const Unit&) const {}
};
struct InProjOrder {
    int x, r;
    __host__ __device__ void init(int c_) { x = c_ & 7; r = c_ >> 3; }
    __host__ __device__ bool next(int i, Unit& u) const {
        if (i >= 21) return false;
        const int gi = i / 7, ri = i % 7;
        if (ri < 6) { u.pm = x * 48 + 16 * gi + 8 * (ri & 1) + (r & 7); u.pn = 4 * (ri >> 1) + (r >> 3); }
        else { u.pm = x * 48 + 16 * gi + (r & 15); u.pn = 12 + (r >> 4); }
        return true;
    }
    __device__ __forceinline__ void a_ready(const Unit&) const {}
    __device__ __forceinline__ void done(const Unit&) const {}
};
__device__ __forceinline__ unsigned cvt_pk_bf16(float lo, float hi) { unsigned r; asm volatile("v_cvt_pk_bf16_f32 %0, %1, %2" : "=v"(r) : "v"(lo), "v"(hi)); return r; }
__device__ __forceinline__ u32x4 pack8(const f32x4& a, const f32x4& b) { u32x4 w; w.x = cvt_pk_bf16(a[0], a[1]); w.y = cvt_pk_bf16(a[2], a[3]); w.z = cvt_pk_bf16(b[0], b[1]); w.w = cvt_pk_bf16(b[2], b[3]); return w; }
#ifndef H_TILED
#define H_TILED 0
#endif
#ifndef PLANE_PAD_ROWS
#define PLANE_PAD_ROWS 64
#endif
#ifndef PROJ_ROWMAJOR
#define PROJ_ROWMAJOR 0
#endif
#ifndef RELAX_MASK
#define RELAX_MASK 0
#endif
constexpr int NPROJ = 3584, DMODEL = 1024, DFF = 4096, MPROMPT = 65536;

constexpr size_t MTOK = 98304 + PLANE_PAD_ROWS;
#if PROJ_ROWMAJOR
constexpr size_t PL_GV = 0, PL_RV = 512, PL_GQ = 1024, PL_GK = 1280, PL_GG = 1536, PL_RQ = 2048, PL_RK = 2560, PL_RG = 3072, PL_END = (size_t)98304 * 4096;
__device__ __forceinline__ size_t pl(size_t grp, int hh, size_t row, int W) { return row * 4096 + grp + (size_t)(hh * W); }
#else
constexpr size_t PL_GV = 0, PL_RV = PL_GV + 4 * MTOK * 128, PL_GQ = PL_RV + 4 * MTOK * 128, PL_GK = PL_GQ + 4 * MTOK * 64, PL_GG = PL_GK + 4 * MTOK * 64,
                 PL_RQ = PL_GG + 4 * MTOK * 128, PL_RK = PL_RQ + 4 * MTOK * 128, PL_RG = PL_RK + 4 * MTOK * 128, PL_END = PL_RG + 4 * MTOK * 128;
__device__ __forceinline__ size_t pl(size_t grp, int hh, size_t row, int W) { return grp + ((size_t)hh * MTOK + row) * (size_t)W; }
#endif
__device__ __forceinline__ void plane_of(int pn, int bj, int wc, size_t& grp, int& hh, int& W, int& col) {
    W = 128; col = 32 * wc; hh = 2 * (pn & 1) + bj;
    switch (pn >> 1) { case 0: grp = PL_GV; break; case 1: grp = PL_RV; break; case 3: grp = PL_GG; break; case 4: grp = PL_RQ; break; case 5: grp = PL_RK; break; case 6: grp = PL_RG; break;
        default: grp = (pn & 1) ? PL_GK : PL_GQ; W = 64; hh = 2 * bj + (wc >> 1); col = 32 * (wc & 1); break; }
}
struct EpiInProj {
    static constexpr bool PERM = true, AFTER_DRAIN = false, RELAX = (RELAX_MASK & 1) != 0;
    bf16_t* P; const float* rstd; const float* rcos; const float* rsin;
    __device__ __forceinline__ void operator()(const f32x4 (&acc)[2][2][4][2], const Unit& u, int wr, int wc, int fr_in, int fq_in) const {
        int fr = fr_in, fq = fq_in; asm volatile("" : "+v"(fr), "+v"(fq));
        const int row0 = u.pm * BM + wr * 64 + fr;
        const bool rot = (u.pn >= 8) && (u.pn < 12);
        const int i0 = (4 * wc + fq) * 4;
        size_t pgrp[2]; int phh[2]; int W, col;
        plane_of(u.pn, 0, wc, pgrp[0], phh[0], W, col); plane_of(u.pn, 1, wc, pgrp[1], phh[1], W, col);
        const int pos0 = row0 < MPROMPT ? (row0 & 2047) : (row0 & 16383);
        f32x4 cc = (f32x4){1.f, 1.f, 1.f, 1.f}, ss = (f32x4){0.f, 0.f, 0.f, 0.f}, cd16 = cc, sd16 = ss, cd80 = cc, sd80 = ss;
        if (rot) {
            cc = *(const f32x4*)(rcos + pos0 * 64 + i0); ss = *(const f32x4*)(rsin + pos0 * 64 + i0);
            cd16 = *(const f32x4*)(rcos + 16 * 64 + i0); sd16 = *(const f32x4*)(rsin + 16 * 64 + i0); cd80 = *(const f32x4*)(rcos + 80 * 64 + i0); sd80 = *(const f32x4*)(rsin + 80 * 64 + i0); }
        float rs[2][4];
#pragma unroll
        for (int ai = 0; ai < 2; ++ai)
#pragma unroll
            for (int m = 0; m < 4; ++m) rs[ai][m] = rstd[row0 + ai * HALF + m * 16];
        __builtin_amdgcn_sched_barrier(0);
        const f32x4 cc0 = cc, ss0 = ss;
#pragma unroll
        for (int bj = 0; bj < 2; ++bj) {
            cc = cc0; ss = ss0;
#pragma unroll
            for (int ai = 0; ai < 2; ++ai)
#pragma unroll
                for (int m = 0; m < 4; ++m) {
                    const int row = row0 + ai * HALF + m * 16;
                    f32x4 v0 = acc[ai][bj][m][0] * rs[ai][m], v1 = acc[ai][bj][m][1] * rs[ai][m];
                    if (rot) { const f32x4 lo = v0 * cc - v1 * ss, hi = v0 * ss + v1 * cc; v0 = lo; v1 = hi; }
                    *(u32x4*)(P + pl(pgrp[bj], phh[bj], (size_t)row, W) + col + 8 * fq) = pack8(v0, v1);
                    if (rot && !(ai == 1 && m == 3)) { const f32x4 cd = m == 3 ? cd80 : cd16, sd = m == 3 ? sd80 : sd16; const f32x4 nc = cc * cd - ss * sd, ns = ss * cd + cc * sd; cc = nc; ss = ns; }
                }
        }
    }
};
struct EpiResid {
    static constexpr bool PERM = true, AFTER_DRAIN = false, RELAX = false;
    const float* xp; const float* xs; float* out; bf16_t* A2; float* sq;
    __device__ __forceinline__ void operator()(const f32x4 (&acc)[2][2][4][2], const Unit& u, int wr, int wc, int fr_in, int fq_in) const {
        int fr = fr_in, fq = fq_in; asm volatile("" : "+v"(fr), "+v"(fq));
        const int row0 = u.pm * BM + wr * 64 + fr, colb = u.pn * BM + wc * 32 + 8 * fq;
#pragma unroll
        for (int ai = 0; ai < 2; ++ai)
#pragma unroll
            for (int m = 0; m < 4; ++m) {
                const int row = row0 + ai * HALF + m * 16;
                const float* xrow = (row < MPROMPT ? xp + (size_t)row * DMODEL : xs + (size_t)(row - MPROMPT) * DMODEL) + colb;
                float* orow = out + (size_t)row * DMODEL + colb;
                float ss = 0.f;
#pragma unroll
                for (int bj = 0; bj < 2; ++bj) {
                    const f32x4 x0 = *(const f32x4*)(xrow + bj * HALF), x1 = *(const f32x4*)(xrow + bj * HALF + 4);
                    const f32x4 v0 = acc[ai][bj][m][0] + x0, v1 = acc[ai][bj][m][1] + x1;
                    *(f32x4*)(orow + bj * HALF) = v0; *(f32x4*)(orow + bj * HALF + 4) = v1;
                    if (A2) *(u32x4*)(A2 + (size_t)row * DMODEL + colb + bj * HALF) = pack8(v0, v1);
                    ss += (v0[0] * v0[0] + v0[1] * v0[1]) + (v0[2] * v0[2] + v0[3] * v0[3]) + (v1[0] * v1[0] + v1[1] * v1[1]) + (v1[2] * v1[2] + v1[3] * v1[3]);
                }
                ss += __shfl_xor(ss, 16); ss += __shfl_xor(ss, 32);
                if (fq == 0) sq[(size_t)row * 16 + u.pn * 4 + wc] = ss;
            }
    }
};
struct EpiFF1 {
    static constexpr bool PERM = true, AFTER_DRAIN = false, RELAX = (RELAX_MASK & 4) != 0;
    bf16_t* H; const float* r2v;
    __device__ __forceinline__ void operator()(const f32x4 (&acc)[2][2][4][2], const Unit& u, int wr, int wc, int fr_in, int fq_in) const {
        int fr = fr_in, fq = fq_in; asm volatile("" : "+v"(fr), "+v"(fq));
        const int row0 = u.pm * BM + wr * 64 + fr, colb = u.pn * BM + wc * 32 + 8 * fq;
        float r2[2][4];
#pragma unroll
        for (int ai = 0; ai < 2; ++ai)
#pragma unroll
            for (int m = 0; m < 4; ++m) r2[ai][m] = r2v[row0 + ai * HALF + m * 16];
        __builtin_amdgcn_sched_barrier(0);
#pragma unroll
        for (int ai = 0; ai < 2; ++ai)
#pragma unroll
            for (int m = 0; m < 4; ++m) {
                const int row = row0 + ai * HALF + m * 16;
#if H_TILED
                bf16_t* rowp = H + ((size_t)u.pm * (DFF / 64) + (size_t)(u.pn * 4 + (wc >> 1))) * (256 * 64) + (size_t)(wr * 64 + fr + ai * HALF + m * 16) * 64 + (wc & 1) * 32 + 8 * fq;
#else
                bf16_t* rowp = H + (size_t)row * DFF + colb;
#endif
#pragma unroll
                for (int bj = 0; bj < 2; ++bj) {
                    f32x4 v0 = acc[ai][bj][m][0], v1 = acc[ai][bj][m][1];
#pragma unroll
                    for (int j = 0; j < 4; ++j) { const float a = fmaxf(v0[j], 0.f), b = fmaxf(v1[j], 0.f); v0[j] = a * a * r2[ai][m]; v1[j] = b * b * r2[ai][m]; }
                    *(u32x4*)(rowp + bj * (H_TILED ? 2 * 256 * 64 : HALF)) = pack8(v0, v1);
                }
            }
    }
};

struct EpiPlain {
    static constexpr bool PERM = true, AFTER_DRAIN = false, RELAX = false;
    bf16_t* P;
    __device__ __forceinline__ void operator()(const f32x4 (&acc)[2][2][4][2], const Unit& u, int wr, int wc, int fr_in, int fq_in) const {
        int fr = fr_in, fq = fq_in; asm volatile("" : "+v"(fr), "+v"(fq));
        const int row0 = u.pm * BM + wr * 64 + fr;
        size_t pgrp[2]; int phh[2]; int W, col;
        plane_of(u.pn, 0, wc, pgrp[0], phh[0], W, col); plane_of(u.pn, 1, wc, pgrp[1], phh[1], W, col);
#pragma unroll
        for (int ai = 0; ai < 2; ++ai)
#pragma unroll
            for (int m = 0; m < 4; ++m) { const int row = row0 + ai * HALF + m * 16;
#pragma unroll
                for (int bj = 0; bj < 2; ++bj) *(u32x4*)(P + pl(pgrp[bj], phh[bj], (size_t)row, W) + col + 8 * fq) = pack8(acc[ai][bj][m][0], acc[ai][bj][m][1]); }
    }
};

struct EpiResidX {
    static constexpr bool PERM = true, AFTER_DRAIN = false, RELAX = (RELAX_MASK & 2) != 0;
    const float* xp; const float* xs; bf16_t* A2; float* sq;
    __device__ __forceinline__ void operator()(const f32x4 (&acc)[2][2][4][2], const Unit& u, int wr, int wc, int fr_in, int fq_in) const {
        int fr = fr_in, fq = fq_in; asm volatile("" : "+v"(fr), "+v"(fq));
        const int row0 = u.pm * BM + wr * 64 + fr, colb = u.pn * BM + wc * 32 + 8 * fq;
#pragma unroll
        for (int ai = 0; ai < 2; ++ai) {
            f32x4 xv[4][2][2];
#pragma unroll
            for (int m = 0; m < 4; ++m) { const int row = row0 + ai * HALF + m * 16;
                const float* xrow = (row < MPROMPT ? xp + (size_t)row * DMODEL : xs + (size_t)(row - MPROMPT) * DMODEL) + colb;
#pragma unroll
                for (int bj = 0; bj < 2; ++bj) { xv[m][bj][0] = *(const f32x4*)(xrow + bj * HALF); xv[m][bj][1] = *(const f32x4*)(xrow + bj * HALF + 4); } }
            __builtin_amdgcn_sched_barrier(0);
#pragma unroll
            for (int m = 0; m < 4; ++m) {
                const int row = row0 + ai * HALF + m * 16;
                float ss = 0.f;
#pragma unroll
                for (int bj = 0; bj < 2; ++bj) {
                    const f32x4 v0 = acc[ai][bj][m][0] + xv[m][bj][0], v1 = acc[ai][bj][m][1] + xv[m][bj][1];
                    *(u32x4*)(A2 + (size_t)row * DMODEL + colb + bj * HALF) = pack8(v0, v1);
                    ss += (v0[0] * v0[0] + v0[1] * v0[1]) + (v0[2] * v0[2] + v0[3] * v0[3]) + (v1[0] * v1[0] + v1[1] * v1[1]) + (v1[2] * v1[2] + v1[3] * v1[3]);
                }
                ss += __shfl_xor(ss, 16); ss += __shfl_xor(ss, 32);
                if (fq == 0) sq[(size_t)row * 16 + u.pn * 4 + wc] = ss;
            }
            __builtin_amdgcn_sched_barrier(0);
        }
    }
};
struct EpiResidB {
    static constexpr bool PERM = true, AFTER_DRAIN = false, RELAX = (RELAX_MASK & 8) != 0;
    bf16_t* A2; float* sq;
    __device__ __forceinline__ void operator()(const f32x4 (&acc)[2][2][4][2], const Unit& u, int wr, int wc, int fr_in, int fq_in) const {
        int fr = fr_in, fq = fq_in; asm volatile("" : "+v"(fr), "+v"(fq));
        const int row0 = u.pm * BM + wr * 64 + fr, colb = u.pn * BM + wc * 32 + 8 * fq;
        u32x4 xw[2][4][2];
#pragma unroll
        for (int ai = 0; ai < 2; ++ai)
#pragma unroll
            for (int m = 0; m < 4; ++m)
#pragma unroll
                for (int bj = 0; bj < 2; ++bj) xw[ai][m][bj] = *(const u32x4*)(A2 + (size_t)(row0 + ai * HALF + m * 16) * DMODEL + colb + bj * HALF);
        __builtin_amdgcn_sched_barrier(0);
#pragma unroll
        for (int ai = 0; ai < 2; ++ai)
#pragma unroll
            for (int m = 0; m < 4; ++m) {
                const int row = row0 + ai * HALF + m * 16;
                bf16_t* xr = A2 + (size_t)row * DMODEL + colb;
                float ss = 0.f;
#pragma unroll
                for (int bj = 0; bj < 2; ++bj) {
                    const u32x4 w_ = xw[ai][m][bj];
                    const f32x4 x0 = {__uint_as_float(w_.x << 16), __uint_as_float(w_.x & 0xffff0000u), __uint_as_float(w_.y << 16), __uint_as_float(w_.y & 0xffff0000u)};
                    const f32x4 x1 = {__uint_as_float(w_.z << 16), __uint_as_float(w_.z & 0xffff0000u), __uint_as_float(w_.w << 16), __uint_as_float(w_.w & 0xffff0000u)};
                    const f32x4 v0 = acc[ai][bj][m][0] + x0, v1 = acc[ai][bj][m][1] + x1;
                    *(u32x4*)(xr + bj * HALF) = pack8(v0, v1);
                    ss += (v0[0] * v0[0] + v0[1] * v0[1]) + (v0[2] * v0[2] + v0[3] * v0[3]) + (v1[0] * v1[0] + v1[1] * v1[1]) + (v1[2] * v1[2] + v1[3] * v1[3]);
                }
                ss += __shfl_xor(ss, 16); ss += __shfl_xor(ss, 32);
                if (fq == 0) sq[(size_t)row * 16 + u.pn * 4 + wc] = ss;
            }
    }
};

struct EpiResidB2 {
    static constexpr bool PERM = true, AFTER_DRAIN = false, RELAX = (RELAX_MASK & 8) != 0;
    const bf16_t* X; bf16_t* A2; float* sq;
    __device__ __forceinline__ void operator()(const f32x4 (&acc)[2][2][4][2], const Unit& u, int wr, int wc, int fr_in, int fq_in) const {
        int fr = fr_in, fq = fq_in; asm volatile("" : "+v"(fr), "+v"(fq));
        const int row0 = u.pm * BM + wr * 64 + fr, colb = u.pn * BM + wc * 32 + 8 * fq;
        u32x4 xw[2][4][2];
#pragma unroll
        for (int ai = 0; ai < 2; ++ai)
#pragma unroll
            for (int m = 0; m < 4; ++m)
#pragma unroll
                for (int bj = 0; bj < 2; ++bj) xw[ai][m][bj] = *(const u32x4*)(X + (size_t)(row0 + ai * HALF + m * 16) * DMODEL + colb + bj * HALF);
        __builtin_amdgcn_sched_barrier(0);
#pragma unroll
        for (int ai = 0; ai < 2; ++ai)
#pragma unroll
            for (int m = 0; m < 4; ++m) {
                const int row = row0 + ai * HALF + m * 16;
                bf16_t* xr = A2 + (size_t)row * DMODEL + colb;
                float ss = 0.f;
#pragma unroll
                for (int bj = 0; bj < 2; ++bj) {
                    const u32x4 w_ = xw[ai][m][bj];
                    const f32x4 x0 = {__uint_as_float(w_.x << 16), __uint_as_float(w_.x & 0xffff0000u), __uint_as_float(w_.y << 16), __uint_as_float(w_.y & 0xffff0000u)};
                    const f32x4 x1 = {__uint_as_float(w_.z << 16), __uint_as_float(w_.z & 0xffff0000u), __uint_as_float(w_.w << 16), __uint_as_float(w_.w & 0xffff0000u)};
                    const f32x4 v0 = acc[ai][bj][m][0] + x0, v1 = acc[ai][bj][m][1] + x1;
                    *(u32x4*)(xr + bj * HALF) = pack8(v0, v1);
                    ss += (v0[0] * v0[0] + v0[1] * v0[1]) + (v0[2] * v0[2] + v0[3] * v0[3]) + (v1[0] * v1[0] + v1[1] * v1[1]) + (v1[2] * v1[2] + v1[3] * v1[3]);
                }
                ss += __shfl_xor(ss, 16); ss += __shfl_xor(ss, 32);
                if (fq == 0) sq[(size_t)row * 16 + u.pn * 4 + wc] = ss;
            }
    }
};

struct EpiNull {
    static constexpr bool PERM = true, AFTER_DRAIN = false, RELAX = false;
    __device__ __forceinline__ void operator()(const f32x4 (&acc)[2][2][4][2], const Unit& u, int wr, int wc, int fr_in, int fq_in) const {
        int fr = fr_in, fq = fq_in; asm volatile("" : "+v"(fr), "+v"(fq));
#pragma unroll
        for (int ai = 0; ai < 2; ++ai)
#pragma unroll
            for (int m = 0; m < 4; ++m)
#pragma unroll
                for (int bj = 0; bj < 2; ++bj) asm volatile("" :: "v"(acc[ai][bj][m][0]), "v"(acc[ai][bj][m][1]));
    }
};
template <class Epi, class Sched, bool ALIGN_EPI = false, bool SP2 = false, bool PROF = false, int TOUCH = 0>
__device__ __forceinline__ void gemm_phase(PG8_LAS unsigned char* lds, const Gemm g, const Sched& S, const Epi& E) {
    const int tid = threadIdx.x, wid = __builtin_amdgcn_readfirstlane(tid >> 6), lane = tid & 63, wr = wid >> 2, wc = wid & 3, fr = lane & 15, fq = lane >> 4;
    const int K = g.K, nt = K / BK, ldb = g.ldb ? g.ldb : K;
    unsigned voffA[2], voffB[2];
#pragma unroll
    for (int i = 0; i < 2; ++i) { int R, C; stage_rc(tid * 16 + i * 8192, R, C); const int Rb = Epi::PERM ? ((R & ~31) + perm32(R & 31)) : R;
        voffA[i] = (unsigned)(R * g.lda + C) * 2u; voffB[i] = (unsigned)(Rb * ldb + C) * 2u; }
    const size_t kstepA = g.ksA ? (size_t)g.ksA : (size_t)(BK * 2), kstepB = g.ksB ? (size_t)g.ksB : (size_t)(BK * 2);
    const size_t hstepB = (size_t)HALF * ldb * 2, hstepA = (size_t)HALF * g.lda * 2;
    const size_t tstepB = g.psB ? (size_t)g.psB : 2 * hstepB, tstepA = g.psA ? (size_t)g.psA : 2 * hstepA;
    const unsigned ldsw = (unsigned)wid * 1024u;
    const int aoff = lds_byte(wr * 64 + fr, fq * 8), boff = lds_byte(wc * 32 + fr, fq * 8);
#define PG8_SA(b, h) (((b) * 2 + (h)) * HTB)
#define PG8_SB(b, h) ((4 + (b) * 2 + (h)) * HTB)
#define PG8_STAGE(bufoff, gbase, voff) do { _Pragma("unroll") for (int _i = 0; _i < 2; ++_i) \
        __builtin_amdgcn_global_load_lds((const unsigned*)((const char*)(gbase) + (voff)[_i]), (PG8_LAS unsigned*)(lds + (bufoff) + ldsw + _i * 8192), 16, 0, 0); } while (0)
#define PG8_LDA(dst, b, h) do { _Pragma("unroll") for (int m = 0; m < 4; ++m) _Pragma("unroll") for (int k = 0; k < 2; ++k) dst[m][k] = *(const PG8_LAS bf16x8*)(lds + PG8_SA(b, h) + aoff + m * 2048 + k * 1024); } while (0)
#define PG8_LDB(dst, b, h) do { _Pragma("unroll") for (int n = 0; n < 2; ++n) _Pragma("unroll") for (int k = 0; k < 2; ++k) dst[n][k] = *(const PG8_LAS bf16x8*)(lds + PG8_SB(b, h) + boff + n * 2048 + k * 1024); } while (0)
#define PG8_MMA(ai, bj, At, Bt) do { __builtin_amdgcn_s_setprio(1); _Pragma("unroll") for (int m = 0; m < 4; ++m) _Pragma("unroll") for (int n = 0; n < 2; ++n) _Pragma("unroll") for (int k = 0; k < 2; ++k) \
        acc[ai][bj][m][n] = __builtin_amdgcn_mfma_f32_16x16x32_bf16(Bt[n][k], At[m][k], acc[ai][bj][m][n], 0, 0, 0); __builtin_amdgcn_s_setprio(0); } while (0)
#define PG8_WAIT_V(n) asm volatile("s_waitcnt vmcnt(" #n ")" ::: "memory")
#define PG8_WAIT_L(n) asm volatile("s_waitcnt lgkmcnt(" #n ")" ::: "memory")
#define PG8_WAIT_VF(first, nrel) asm volatile("s_cmp_lg_u32 %0, 0\n\ts_cbranch_scc1 1f\n\ts_waitcnt vmcnt(8)\n\ts_branch 2f\n1:\n\ts_waitcnt vmcnt(" #nrel ")\n2:" :: "s"(first) : "memory", "scc")
#define PG8_BAR __builtin_amdgcn_s_barrier()
#define PG8_SCHED __builtin_amdgcn_sched_barrier(0)
    Unit cur, nxt; int ui = 0;
    if (!S.next(0, cur)) return;
    f32x4 acc[2][2][4][2];
#pragma unroll
    for (int a = 0; a < 2; ++a)
#pragma unroll
        for (int b = 0; b < 2; ++b)
#pragma unroll
            for (int m = 0; m < 4; ++m)
#pragma unroll
                for (int n = 0; n < 2; ++n) acc[a][b][m][n] = (f32x4){0.f, 0.f, 0.f, 0.f};
    bf16x8 At[4][2], B0[2][2], B1[2][2];
    const char* cA = (const char*)g.A + (size_t)cur.pm * tstepA; const char* cB = (const char*)g.Bt + (size_t)cur.pn * tstepB;
    S.a_ready(cur);
    if constexpr (SP2) {
        PG8_STAGE(PG8_SB(0, 0), cB, voffB); PG8_STAGE(PG8_SB(0, 1), cB + hstepB, voffB); PG8_STAGE(PG8_SA(0, 0), cA, voffA); PG8_STAGE(PG8_SA(0, 1), cA + hstepA, voffA);
        if (wr == 1) PG8_BAR;
        PG8_WAIT_V(2); PG8_BAR;
        PG8_STAGE(PG8_SB(1, 0), cB + kstepB, voffB); PG8_STAGE(PG8_SA(1, 0), cA + kstepA, voffA); PG8_STAGE(PG8_SB(1, 1), cB + hstepB + kstepB, voffB); PG8_STAGE(PG8_SA(1, 1), cA + hstepA + kstepA, voffA);
        PG8_WAIT_V(8); PG8_BAR;
    } else {
        PG8_STAGE(PG8_SB(0, 0), cB, voffB); PG8_STAGE(PG8_SA(0, 0), cA, voffA); PG8_STAGE(PG8_SB(0, 1), cB + hstepB, voffB); PG8_STAGE(PG8_SA(0, 1), cA + hstepA, voffA);
        if (wr == 1) PG8_BAR;
        PG8_WAIT_V(4); PG8_BAR;
        PG8_STAGE(PG8_SB(1, 0), cB + kstepB, voffB); PG8_STAGE(PG8_SA(1, 0), cA + kstepA, voffA); PG8_STAGE(PG8_SB(1, 1), cB + hstepB + kstepB, voffB);
        PG8_WAIT_V(6); PG8_BAR;
    }
    for (;;) {
        const bool has_next = S.next(ui + 1, nxt);
        const char* nA = has_next ? (const char*)g.A + (size_t)nxt.pm * tstepA : cA; const char* nB = has_next ? (const char*)g.Bt + (size_t)nxt.pn * tstepB : cB;
        for (int t = 0; t < nt; t += 2) {
            const bool last = (t == nt - 2);
            const char* a1 = cA + (size_t)(t + 1) * kstepA;
            const char* a2 = last ? nA : cA + (size_t)(t + 2) * kstepA; const char* b2 = last ? nB : cB + (size_t)(t + 2) * kstepB;
            const char* a3 = a2 + kstepA; const char* b3 = b2 + kstepB;
            if (last && has_next) S.a_ready(nxt);
            if constexpr (SP2) {
            const int first = __builtin_amdgcn_readfirstlane((t == 0 && ui > 0) ? 1 : 0);
            PG8_LDB(B0, 0, 0); PG8_LDB(B1, 0, 1); PG8_SCHED; PG8_LDA(At, 0, 0);
            PG8_WAIT_VF(first, 16); PG8_WAIT_L(0); PG8_BAR; PG8_MMA(0, 0, At, B0); PG8_MMA(0, 1, At, B1); PG8_BAR; PG8_SCHED;
            PG8_LDA(At, 0, 1); PG8_STAGE(PG8_SB(0, 0), b2, voffB); PG8_STAGE(PG8_SB(0, 1), b2 + hstepB, voffB); PG8_STAGE(PG8_SA(0, 0), a2, voffA);
            PG8_WAIT_VF(first, 22); PG8_WAIT_L(0); PG8_BAR; PG8_MMA(1, 0, At, B0); PG8_MMA(1, 1, At, B1); PG8_BAR; PG8_SCHED;
            PG8_LDB(B0, 1, 0); PG8_LDB(B1, 1, 1); PG8_SCHED; PG8_LDA(At, 1, 0); PG8_STAGE(PG8_SA(0, 1), a2 + hstepA, voffA);
            PG8_WAIT_VF(first, 24); PG8_WAIT_L(0); PG8_BAR; PG8_MMA(0, 0, At, B0); PG8_MMA(0, 1, At, B1); PG8_BAR; PG8_SCHED;
            PG8_LDA(At, 1, 1); PG8_STAGE(PG8_SB(1, 0), b3, voffB); PG8_STAGE(PG8_SB(1, 1), b3 + hstepB, voffB); PG8_STAGE(PG8_SA(1, 0), a3, voffA);
            PG8_WAIT_V(8); PG8_WAIT_L(0); PG8_BAR; PG8_MMA(1, 0, At, B0); PG8_MMA(1, 1, At, B1); PG8_BAR; PG8_SCHED;
            PG8_STAGE(PG8_SA(1, 1), a3 + hstepA, voffA);
            if constexpr (TOUCH != 0) { if (t == 0 && has_next) {
                __builtin_amdgcn_global_load_lds((const unsigned*)(nA + ((size_t)tid << 12) % tstepA), (PG8_LAS unsigned*)(lds + STAGE_BYTES + wid * 256), 4, 0, 0);
                if (TOUCH > 1) __builtin_amdgcn_global_load_lds((const unsigned*)(nB + ((size_t)tid << 12) % tstepB), (PG8_LAS unsigned*)(lds + STAGE_BYTES + 2048 + wid * 256), 4, 0, 0); } }
            } else {
            PG8_LDB(B0, 0, 0); PG8_SCHED; PG8_LDA(At, 0, 0); PG8_STAGE(PG8_SA(1, 1), a1 + hstepA, voffA);
            PG8_WAIT_L(8); PG8_BAR; PG8_WAIT_L(0); PG8_MMA(0, 0, At, B0); PG8_BAR; PG8_SCHED;
            PG8_LDB(B1, 0, 1); PG8_STAGE(PG8_SB(0, 0), b2, voffB);
            PG8_BAR; PG8_WAIT_L(0); PG8_MMA(0, 1, At, B1); PG8_BAR;
            PG8_LDA(At, 0, 1); PG8_STAGE(PG8_SA(0, 0), a2, voffA);
            PG8_BAR; PG8_WAIT_L(0); PG8_MMA(1, 0, At, B0); PG8_BAR; PG8_SCHED;
            PG8_STAGE(PG8_SB(0, 1), b2 + hstepB, voffB);
            PG8_WAIT_V(6); PG8_BAR; PG8_MMA(1, 1, At, B1); PG8_BAR;
            PG8_LDB(B0, 1, 0); PG8_SCHED; PG8_LDA(At, 1, 0); PG8_STAGE(PG8_SA(0, 1), a2 + hstepA, voffA);
            PG8_WAIT_L(8); PG8_BAR; PG8_WAIT_L(0); PG8_MMA(0, 0, At, B0); PG8_BAR; PG8_SCHED;
            PG8_LDB(B1, 1, 1); PG8_STAGE(PG8_SB(1, 0), b3, voffB);
            PG8_BAR; PG8_WAIT_L(0); PG8_MMA(0, 1, At, B1); PG8_BAR;
            PG8_LDA(At, 1, 1); PG8_STAGE(PG8_SA(1, 0), a3, voffA);
            PG8_BAR; PG8_WAIT_L(0); PG8_MMA(1, 0, At, B0); PG8_BAR; PG8_SCHED;
            PG8_STAGE(PG8_SB(1, 1), b3 + hstepB, voffB);
            PG8_WAIT_V(6); PG8_BAR; PG8_MMA(1, 1, At, B1); PG8_BAR;
            }
        }
        if constexpr (ALIGN_EPI) { if (wr == 0) PG8_BAR; }
        if constexpr (!Epi::AFTER_DRAIN) { E(acc, cur, wr, wc, fr, fq); S.done(cur); }
        if (!has_next) break;
#pragma unroll
        for (int a = 0; a < 2; ++a)
#pragma unroll
            for (int b = 0; b < 2; ++b)
#pragma unroll
                for (int m = 0; m < 4; ++m)
#pragma unroll
                    for (int n = 0; n < 2; ++n) acc[a][b][m][n] = (f32x4){0.f, 0.f, 0.f, 0.f};
        cur = nxt; cA = nA; cB = nB; ++ui;
        if constexpr (ALIGN_EPI) { if (wr == 1) PG8_BAR; }
    }
    PG8_WAIT_V(0);
    if constexpr (!ALIGN_EPI) { if (wr == 0) PG8_BAR; }
    PG8_BAR;
    if constexpr (Epi::AFTER_DRAIN) { E.fused(acc, cur, wr, wc, fr, fq, lds, wid, lane); S.done(cur); }
#undef PG8_SA
#undef PG8_SB
#undef PG8_STAGE
#undef PG8_LDA
#undef PG8_LDB
#undef PG8_MMA
#undef PG8_WAIT_V
#undef PG8_WAIT_L
#undef PG8_WAIT_VF
#undef PG8_BAR
#undef PG8_SCHED
}
}
#define GAS __attribute__((address_space(1)))
#define LAS __attribute__((address_space(3)))
typedef unsigned short bf16;
typedef unsigned v4u __attribute__((ext_vector_type(4)));
typedef float f32x4 __attribute__((ext_vector_type(4)));
typedef short bf16x8 __attribute__((ext_vector_type(8)));
typedef GAS unsigned gu32;
typedef GAS unsigned long long gu64;
#define RLX_AGENT __ATOMIC_RELAXED, __HIP_MEMORY_SCOPE_AGENT
#define LDS_WAIT() asm volatile("s_waitcnt lgkmcnt(0)" ::: "memory")
#define VM_WAIT() asm volatile("s_waitcnt vmcnt(0)" ::: "memory")
__device__ __forceinline__ unsigned long long rt() { return __builtin_amdgcn_s_memrealtime(); }
__device__ __forceinline__ unsigned f2bf(float f) { unsigned u = __builtin_bit_cast(unsigned, f); return (u + 0x7fffu + ((u >> 16) & 1u)) >> 16; }
__device__ __forceinline__ unsigned pk2(float lo, float hi) { return f2bf(lo) | (f2bf(hi) << 16); }

#define XB_TMO      128
#define XB_XCNT(j)  (256  + 64 * (j))
#define XB_XSUB(j)  (1280 + 64 * (j))
#define XB_XGEN(j)  (2304 + 64 * (j))
#define XB_TOP      3328
#define XB_TOPGEN   3392
#define XCD_BAR_WORDS 3456
#define XB_SPIN_CAP (1u << 18)

__device__ __forceinline__ unsigned xb_ld(unsigned* p)              { return __hip_atomic_load(p, __ATOMIC_RELAXED, __HIP_MEMORY_SCOPE_AGENT); }
__device__ __forceinline__ unsigned xb_add(unsigned* p, unsigned v) { return __hip_atomic_fetch_add(p, v, __ATOMIC_RELAXED, __HIP_MEMORY_SCOPE_AGENT); }
__device__ __forceinline__ unsigned xb_xcc_id() { return (unsigned)__builtin_amdgcn_s_getreg((3 << 11) | 20) & 0xFu; }
#define XB_SPIN(cond, bar) do { unsigned _sp = 0; while (cond) { __builtin_amdgcn_s_sleep(1); \
    if ((++_sp & 255u) == 0u) { if (xb_ld(&(bar)[XB_TMO])) break; if (_sp > XB_SPIN_CAP) { atomicAdd(&(bar)[XB_TMO], 1u); break; } } } } while (0)

struct XcdBarrier {
    unsigned* bar; unsigned x;
    volatile LAS unsigned* st;
};

__device__ __forceinline__ XcdBarrier xcd_barrier_post(unsigned* bar, volatile LAS unsigned* st) {
    XcdBarrier b; b.bar = bar; b.x = xb_xcc_id(); b.st = st;
    if (threadIdx.x == 0) (void)xb_add(&bar[XB_XCNT(b.x)], 1u);
    return b;
}
__device__ __forceinline__ void xcd_barrier_complete(unsigned* bar, unsigned x, unsigned& nloc, unsigned& nx) {
    const unsigned G = gridDim.x * gridDim.y * gridDim.z;
    unsigned sum, cnt, mine, sp = 0u;
    for (;;) {
        sum = 0u; cnt = 0u; mine = 0u;
#pragma unroll
        for (unsigned j = 0; j < 16; ++j) { const unsigned c = xb_ld(&bar[XB_XCNT(j)]); sum += c; cnt += (c > 0u) ? 1u : 0u; mine = (j == x) ? c : mine; }
        if (sum == G) break;
        __builtin_amdgcn_s_sleep(1);
        if ((++sp & 255u) == 0u) { if (xb_ld(&bar[XB_TMO])) break; if (sp > XB_SPIN_CAP) { atomicAdd(&bar[XB_TMO], 1u); break; } }
    }
    nloc = mine > 0u ? mine : 1u; nx = cnt > 0u ? cnt : 1u;
}

__device__ __forceinline__ void xcd_barrier(const XcdBarrier& b) {
    asm volatile("s_waitcnt vmcnt(0)" ::: "memory");
    __syncthreads();
    if (threadIdx.x == 0) {
        unsigned* bar = b.bar;
        __builtin_amdgcn_s_waitcnt(0);
        unsigned nloc = b.st[0], nx = b.st[1];
        if (nloc == 0u) { xcd_barrier_complete(bar, b.x, nloc, nx); b.st[0] = nloc; b.st[1] = nx; }
        const unsigned old = xb_add(&bar[XB_XSUB(b.x)], 1u);
        const unsigned gen = old / nloc;
        if (old + 1u == (gen + 1u) * nloc) {
            __builtin_amdgcn_fence(__ATOMIC_RELEASE, "agent");
            asm volatile("s_waitcnt vmcnt(0)" ::: "memory");
            const unsigned og = xb_add(&bar[XB_TOP], 1u);
            const unsigned tg = og / nx;
            if (og + 1u == (tg + 1u) * nx) xb_add(&bar[XB_TOPGEN], 1u);
            else XB_SPIN(xb_ld(&bar[XB_TOPGEN]) == tg, bar);
            __builtin_amdgcn_fence(__ATOMIC_ACQUIRE, "agent");
            xb_add(&bar[XB_XGEN(b.x)], 1u);
            asm volatile("s_waitcnt vmcnt(0)" ::: "memory");
        } else {
            XB_SPIN(xb_ld(&bar[XB_XGEN(b.x)]) == gen, bar);
            __builtin_amdgcn_fence(__ATOMIC_ACQUIRE, "agent");
            asm volatile("s_waitcnt vmcnt(0)" ::: "memory");
        }
    }
    __syncthreads();
}
#ifndef FF2_TOUCH
#define FF2_TOUCH 2
#endif
#ifndef FF2_REV
#define FF2_REV 1
#endif
#ifndef W2_TILED
#define W2_TILED 1
#endif
constexpr int NWAVES = 8;
constexpr int M_TOK = 98304, M_PROMPT = 65536, D = 1024, NP = 3584, NWIN = 3616, FF = 4096;
constexpr int L_PROMPT = 2048, L_SAMPLE = 16384;
constexpr float EPS = 1e-6f;
constexpr size_t MiB = 1u << 20;
constexpr size_t WS_CTL = 0, CTL_ZERO_BYTES = 1 * MiB;
constexpr size_t WS_WIN = 1 * MiB;
constexpr size_t WS_WOUT = 9 * MiB;
constexpr size_t WS_W1 = 11 * MiB;
constexpr size_t WS_W2 = 19 * MiB;
constexpr size_t WS_ROPE = 27 * MiB;
constexpr size_t WS_GA = 35 * MiB;
constexpr size_t WS_RSTD = 47 * MiB;
constexpr size_t WS_SQ1 = 48 * MiB;
constexpr size_t WS_SQ2 = 54 * MiB;
constexpr size_t WS_DEC = 60 * MiB;
constexpr size_t WS_R0 = 64 * MiB;
constexpr size_t WS_R1 = 256 * MiB;
constexpr size_t WS_ST = 1024 * MiB;
constexpr size_t WS_A2 = 1216 * MiB;
constexpr size_t WS_END = 1408 * MiB;
constexpr int CW_BAR = 4096;
constexpr int RING_OFF = 0, RING_BYTES = 131072;
constexpr int LDSCTL_OFF = 147456 - 1024, MISC_OFF = LDSCTL_OFF + 320;
constexpr int LDS_BYTES = 147456;

struct Frame {
    LAS unsigned char* lds;
    volatile LAS unsigned* MISC;
    int tid, lane, wave, vcu, G;
};
__device__ __forceinline__ float wave_sum(float v) {
#pragma unroll
    for (int o = 1; o < 64; o <<= 1) v += __shfl_xor(v, o);
    return v;
}
__device__ __forceinline__ float bf2f(bf16 b) { return __uint_as_float((unsigned)b << 16); }
__device__ __forceinline__ unsigned cvtpk(float lo, float hi) { unsigned r; asm volatile("v_cvt_pk_bf16_f32 %0, %1, %2" : "=v"(r) : "v"(lo), "v"(hi)); return r; }

__device__ __forceinline__ void win_map(int nd, int& sc, float& cs) {
    cs = 1.f;
    if (nd < 512) sc = 512 + nd;
    else if (nd < 1024) sc = 2592 + (nd - 512);
    else if (nd < 1280) { sc = nd - 1024; cs = 0.125f; }
    else if (nd < 1536) sc = 256 + (nd - 1280);
    else if (nd < 2048) sc = 1024 + (nd - 1536);
    else if (nd < 3072) {
        const bool isq = nd < 2560; const int p = nd - (isq ? 2048 : 2560), h = p >> 7, pp = p & 127, u = pp >> 3, j = pp & 7;
        const int d = (j < 4) ? 4 * u + j : 64 + 4 * u + (j - 4);
        sc = (isq ? 1568 : 2080) + 128 * h + d; if (isq) cs = 0.08838834764831845f; }
    else if (nd < 3584) sc = 3104 + (nd - 3072);
    else sc = 1536 + (nd - 3584);
}
template <bool MAP, bool TILED = false>
__device__ __forceinline__ void p0_transpose_item(const float* W, int K, int Nsrc, int nblk, const float* ks, bf16* WT, LAS float* scr, int item, int lane) {
    const int kb = item / nblk, nb = item % nblk, k0 = 64 * kb, n0 = 32 * nb;
    int sc = n0 + (lane & 31); float cs = 1.f;
    if (MAP) win_map(n0 + (lane & 31), sc, cs);
    { float wv[32];
#pragma unroll
      for (int i = 0; i < 32; ++i) wv[i] = W[(size_t)(k0 + 2 * i + (lane >> 5)) * Nsrc + sc];
      float kv[32];
#pragma unroll
      for (int i = 0; i < 32; ++i) kv[i] = ks ? ks[k0 + 2 * i + (lane >> 5)] : 1.0f;
      __builtin_amdgcn_sched_barrier(0);
#pragma unroll
      for (int i = 0; i < 32; ++i) { const int kk = 2 * i + (lane >> 5); scr[kk * 33 + (lane & 31)] = wv[i] * cs * kv[i]; } }
    LDS_WAIT(); asm volatile("" ::: "memory");
    const int c = lane & 7;
#pragma unroll
    for (int j = 0; j < 4; ++j) { const int n = (lane >> 3) + 8 * j; const LAS float* s = scr + (8 * c) * 33 + n;
        v4u o; o.x = cvtpk(s[0 * 33], s[1 * 33]); o.y = cvtpk(s[2 * 33], s[3 * 33]); o.z = cvtpk(s[4 * 33], s[5 * 33]); o.w = cvtpk(s[6 * 33], s[7 * 33]);
        if (TILED) { const int nn = n0 + n; *(GAS v4u*)(WT + (((size_t)(nn >> 8) * (K >> 6) + (k0 >> 6)) * 256 + (nn & 255)) * 64 + 8 * c) = o; }
        else *(GAS v4u*)(WT + (size_t)(n0 + n) * K + k0 + 8 * c) = o; }
    LDS_WAIT(); asm volatile("" ::: "memory");
}
__device__ __forceinline__ void rope_entry(int e, float* rcos, float* rsin) {
    const int pos = e >> 6, i = e & 63;
    double inv = 1.0, b = 0.8659643233600653;
#pragma unroll
    for (int bit = 0; bit < 6; ++bit) { if ((i >> bit) & 1) inv *= b; b *= b; }
    const double ang = (double)pos * inv;
    const double n = __builtin_rint(ang * 0.6366197723675814);
    double r = __builtin_fma(-n, 1.5707963267948966, ang); r = __builtin_fma(-n, 6.123233995736766e-17, r);
    const double r2 = r * r;
    double s = -1.0 / 1307674368000.0;
    s = s * r2 + 1.0 / 6227020800.0; s = s * r2 - 1.0 / 39916800.0; s = s * r2 + 1.0 / 362880.0; s = s * r2 - 1.0 / 5040.0; s = s * r2 + 1.0 / 120.0; s = s * r2 - 1.0 / 6.0; s = s * r2 * r + r;
    double c = 1.0 / 20922789888000.0;
    c = c * r2 - 1.0 / 87178291200.0; c = c * r2 + 1.0 / 479001600.0; c = c * r2 - 1.0 / 3628800.0; c = c * r2 + 1.0 / 40320.0; c = c * r2 - 1.0 / 720.0; c = c * r2 + 1.0 / 24.0; c = c * r2 - 0.5; c = c * r2 + 1.0;
    const int q = ((int)n) & 3;
    const double cs = (q == 0) ? c : (q == 1) ? -s : (q == 2) ? -c : s;
    const double sn = (q == 0) ? s : (q == 1) ? c : (q == 2) ? -s : -c;
    rcos[e] = (float)cs; rsin[e] = (float)sn;
}
struct P0Args { const float *xp, *xs, *anw, *win, *wout, *mnw, *w1, *w2; bf16 *Win_t, *Wout_t, *W1_t, *W2_t, *Xb; float *rcos, *rsin, *ga, *rstd; };
__device__ __forceinline__ void p0_prologue(Frame& F, const P0Args& a, int parts = 3) {
    LAS float* scr = (LAS float*)(F.lds + RING_OFF + F.wave * 16384);
    const int gw = F.vcu * NWAVES + F.wave, NGW = F.G * NWAVES;
    constexpr int I_IN = (D / 64) * (NWIN / 32), I_O = (D / 64) * (D / 32), I_1 = (D / 64) * (FF / 32), I_2 = (FF / 64) * (D / 32);
    constexpr int NITEMS = I_IN + I_O + I_1 + I_2;
    if (parts & 1) for (int it = gw; it < NITEMS; it += NGW) {
        int r = it;
        if (r < I_IN) { p0_transpose_item<true>(a.win, D, NWIN, NWIN / 32, a.anw, a.Win_t, scr, r, F.lane); continue; } r -= I_IN;
        if (r < I_O) { p0_transpose_item<false>(a.wout, D, D, D / 32, nullptr, a.Wout_t, scr, r, F.lane); continue; } r -= I_O;
        if (r < I_1) { p0_transpose_item<false>(a.w1, D, FF, FF / 32, a.mnw, a.W1_t, scr, r, F.lane); continue; } r -= I_1;
        p0_transpose_item<false, W2_TILED != 0>(a.w2, FF, D, D / 32, nullptr, a.W2_t, scr, r, F.lane);
    }
    if (parts & 1) for (int e = (blockIdx.x * NWAVES * 64) + F.tid; e < 16384 * 64; e += F.G * NWAVES * 64) rope_entry(e, a.rcos, a.rsin);
    __syncthreads();
    LAS bf16* wl = (LAS bf16*)(F.lds + RING_OFF);
    { const int c = F.tid & 31, kb = F.tid >> 5;
#pragma unroll 1
      for (int b = 0; b < 4; ++b) { float wv[16], av[16];
#pragma unroll
          for (int j = 0; j < 16; ++j) { const int k = kb + 16 * (16 * b + j); wv[j] = a.win[(size_t)k * NWIN + 1536 + c]; av[j] = a.anw[k]; }
          __builtin_amdgcn_sched_barrier(0);
#pragma unroll
          for (int j = 0; j < 16; ++j) { const int k = kb + 16 * (16 * b + j); wl[c * 1032 + k] = (bf16)(cvtpk(wv[j] * av[j], 0.f) & 0xffffu); } } }
    __syncthreads();
    const int r = F.lane & 15, g = F.lane >> 4;
    LAS unsigned char* tl = F.lds + RING_OFF + 66048 + F.wave * 8448;
    if (parts & 2) {
        f32x4 xa[16], xb[16];
#define P0_LOAD(dst, it_, kc_) do { const int r0_ = (it_) * 16; const float* xp_ = (r0_ < M_PROMPT ? a.xp + (size_t)r0_ * D : a.xs + (size_t)(r0_ - M_PROMPT) * D) + 4 * F.lane + 256 * (kc_); \
            _Pragma("unroll") for (int rr = 0; rr < 16; ++rr) dst[rr] = *(const GAS f32x4*)(xp_ + (size_t)rr * D); } while (0)
#define P0_PROC(src, kc_) do { \
            _Pragma("unroll") for (int rr = 0; rr < 16; ++rr) { unsigned long long pk = (unsigned long long)cvtpk(src[rr][0], src[rr][1]) | ((unsigned long long)cvtpk(src[rr][2], src[rr][3]) << 32); \
                *(LAS unsigned long long*)(tl + rr * 528 + F.lane * 8) = pk; *(GAS unsigned long long*)(xo + (size_t)rr * D + 256 * (kc_)) = pk; } \
            asm volatile("s_waitcnt lgkmcnt(0)" ::: "memory"); \
            _Pragma("unroll") for (int s8 = 0; s8 < 8; ++s8) { \
                const bf16x8 af = *(const LAS bf16x8*)(tl + r * 528 + 64 * s8 + 16 * g); \
                const int k0 = 256 * (kc_) + 32 * s8 + 8 * g; \
                const bf16x8 b0 = *(const LAS bf16x8*)(wl + r * 1032 + k0), b1 = *(const LAS bf16x8*)(wl + (16 + r) * 1032 + k0); \
                acc0 = __builtin_amdgcn_mfma_f32_16x16x32_bf16(af, b0, acc0, 0, 0, 0); acc1 = __builtin_amdgcn_mfma_f32_16x16x32_bf16(af, b1, acc1, 0, 0, 0); \
                const v4u aw = __builtin_bit_cast(v4u, af); \
                _Pragma("unroll") for (int j = 0; j < 4; ++j) { const unsigned u = ((const unsigned*)&aw)[j]; const float lo = __uint_as_float(u << 16), hi = __uint_as_float(u & 0xffff0000u); ss += lo * lo + hi * hi; } } \
            asm volatile("s_waitcnt lgkmcnt(0)" ::: "memory"); } while (0)
        if (gw < M_TOK / 16) P0_LOAD(xa, gw, 0);
        for (int item = gw; item < M_TOK / 16; item += NGW) {
            const int row0 = item * 16;
            bf16* xo = a.Xb + (size_t)row0 * D + 4 * F.lane;
            f32x4 acc0 = {0.f, 0.f, 0.f, 0.f}, acc1 = {0.f, 0.f, 0.f, 0.f}; float ss = 0.f;
            const int nitem = item + NGW < M_TOK / 16 ? item + NGW : item;
            P0_LOAD(xb, item, 1); __builtin_amdgcn_sched_barrier(0); P0_PROC(xa, 0); __builtin_amdgcn_sched_barrier(0);
            P0_LOAD(xa, item, 2); __builtin_amdgcn_sched_barrier(0); P0_PROC(xb, 1); __builtin_amdgcn_sched_barrier(0);
            P0_LOAD(xb, item, 3); __builtin_amdgcn_sched_barrier(0); P0_PROC(xa, 2); __builtin_amdgcn_sched_barrier(0);
            P0_LOAD(xa, nitem, 0); __builtin_amdgcn_sched_barrier(0); P0_PROC(xb, 3); __builtin_amdgcn_sched_barrier(0);
            ss += __shfl_xor(ss, 16); ss += __shfl_xor(ss, 32);
            const float rs = 1.0f / sqrtf(ss * (1.0f / 1024.0f) + EPS);
            if (g == 0) a.rstd[row0 + r] = rs;
#pragma unroll
            for (int q = 0; q < 4; ++q) { const int rr = 4 * g + q; const float rq = __shfl(rs, rr);
                a.ga[(size_t)(row0 + rr) * 32 + r] = acc0[q] * rq; a.ga[(size_t)(row0 + rr) * 32 + 16 + r] = acc1[q] * rq; }
        }
#undef P0_LOAD
#undef P0_PROC
    }
}

__device__ __forceinline__ float log_sigmoid_f(float z) { return fminf(z, 0.f) - log1pf(expf(-fabsf(z))); }
struct MixArgs { bf16* proj; const float* ga; const float *waf, *baf, *wab, *bab; float* of; const float *gnw, *rnw, *rnb; };
constexpr int NTB = 16;
template <int DK, bool GLA, bool BWD>
__device__ __forceinline__ void naive_sweep(Frame& F, const MixArgs& a, int job) {
    const int grp = F.tid >> 7, gt = F.tid & 127;
    int seq, head; if (job < 16) { seq = 32 + (job >> 3); head = job & 7; } else { seq = (job - 16) >> 3; head = (job - 16) & 7; }
    const int L = seq < 32 ? L_PROMPT : L_SAMPLE, row_base = seq < 32 ? seq * L_PROMPT : M_PROMPT + (seq - 32) * L_SAMPLE;
    const int hh = GLA ? head : head - 4;
    const int qcol = GLA ? 1024 + 64 * hh : 2048 + 128 * hh, kcol = GLA ? 1280 + 64 * hh : 2560 + 128 * hh, vcol = 128 * head;
    LAS float* sq = (LAS float*)(F.lds + grp * (3 * NTB * 128 * 4)); LAS float* sk = sq + NTB * DK; LAS float* sa = sk + NTB * DK;
    const float gam = 1.0f - exp2f(-5.0f - (float)hh);
    const float* wal = BWD ? a.wab : a.waf; const float* bal = BWD ? a.bab : a.baf;
    float S[DK];
#pragma unroll
    for (int t = 0; t < DK; ++t) S[t] = 0.f;
    for (int t0 = 0; t0 < L; t0 += NTB) {
        __syncthreads();
        for (int e = gt; e < NTB * DK; e += 128) {
            const int tok = e / DK, t = e % DK, tp = t0 + tok, row = row_base + (BWD ? L - 1 - tp : tp);
            const bf16* pr = a.proj + (size_t)row * NP;
            sq[e] = bf2f(pr[qcol + t]); sk[e] = bf2f(pr[kcol + t]);
            if (GLA) { const float* gar = a.ga + (size_t)row * 32 + (BWD ? 16 : 0); float z = bal[64 * hh + t];
#pragma unroll
                for (int r = 0; r < 16; ++r) z += gar[r] * wal[r * 256 + 64 * hh + t];
                sa[e] = expf(fmaxf(log_sigmoid_f(z) * (1.0f / 16.0f), -1.0f)); }
        }
        __syncthreads();
        for (int tok = 0; tok < NTB; ++tok) {
            const int tp = t0 + tok, row = row_base + (BWD ? L - 1 - tp : tp);
            const float vv = bf2f(a.proj[(size_t)row * NP + vcol + gt]);
            float o = 0.f;
#pragma unroll
            for (int t4 = 0; t4 < DK / 4; ++t4) {
                const f32x4 q = *(const LAS f32x4*)(sq + tok * DK + 4 * t4), k = *(const LAS f32x4*)(sk + tok * DK + 4 * t4);
                f32x4 al = {gam, gam, gam, gam}; if (GLA) al = *(const LAS f32x4*)(sa + tok * DK + 4 * t4);
#pragma unroll
                for (int j = 0; j < 4; ++j) {
                    if (!BWD) { S[4 * t4 + j] = al[j] * S[4 * t4 + j] + k[j] * vv; o += q[j] * S[4 * t4 + j]; }
                    else { S[4 * t4 + j] *= al[j]; o += q[j] * S[4 * t4 + j]; S[4 * t4 + j] += k[j] * vv; }
                }
            }
            float* op = a.of + (size_t)row * D + 128 * head + gt;
            if (!BWD) *op = o; else *op += o;
        }
    }
}
template <bool BWD>
__device__ __forceinline__ void naive_mix_phase(Frame& F, const MixArgs& a) {
    if (blockIdx.x >= 68) return;
    const int job = blockIdx.x * 4 + (F.tid >> 7);
    if ((blockIdx.x & 1) == 0) { if (!MIX_GLA) naive_sweep<64, true, BWD>(F, a, job); } else { if (!MIX_RET) naive_sweep<128, false, BWD>(F, a, job); }
}
__device__ __forceinline__ void naive_combine(Frame& F, const MixArgs& a) {
    const int gw = F.vcu * NWAVES + F.wave, NGW = F.G * NWAVES, c = 2 * F.lane;
    for (int item = gw; item < M_TOK * 8; item += NGW) {
        const int row = item >> 3, head = item & 7;
        if (head < 4 ? MIX_GLA : MIX_RET) continue;
        const float* op = a.of + (size_t)row * D + 128 * head + c;
        float o0 = op[0], o1 = op[1], y0, y1;
        if (head < 4) { const float r = 1.0f / sqrtf(wave_sum(o0 * o0 + o1 * o1) * (1.0f / 128.0f) + EPS); y0 = o0 * r * a.gnw[c]; y1 = o1 * r * a.gnw[c + 1]; }
        else { const float mu = wave_sum(o0 + o1) * (1.0f / 128.0f); o0 -= mu; o1 -= mu; const float r = 1.0f / sqrtf(wave_sum(o0 * o0 + o1 * o1) * (1.0f / 128.0f) + EPS);
            const int cc = 128 * (head - 4) + c; y0 = o0 * r * a.rnw[cc] + a.rnb[cc]; y1 = o1 * r * a.rnw[cc + 1] + a.rnb[cc + 1]; }
        bf16* pr = a.proj + (size_t)row * NP;
        const int gcol = (head < 4 ? 1536 + 128 * head : 3072 + 128 * (head - 4)) + c;
        const unsigned gw2 = *(const unsigned*)(pr + gcol);
        const float g0 = __uint_as_float(gw2 << 16), g1 = __uint_as_float(gw2 & 0xffff0000u);
        y0 *= g0 / (1.0f + expf(-g0)); y1 *= g1 / (1.0f + expf(-g1));
        *(unsigned*)(pr + 128 * head + c) = cvtpk(y0, y1);
    }
}
__device__ __forceinline__ void final_norm(Frame& F, float* out, const bf16* x2b, const float* sq, const float* w) {
    const int gw = F.vcu * NWAVES + F.wave, NGW = F.G * NWAVES;
    const f32x4* w4 = (const f32x4*)w + 2 * F.lane;
    f32x4 wv[2][2];
#pragma unroll
    for (int j = 0; j < 2; ++j) { wv[j][0] = w4[128 * j]; wv[j][1] = w4[128 * j + 1]; }
    for (int r0 = 4 * gw; r0 < M_TOK; r0 += 4 * NGW) {
        v4u xw[4][2]; f32x4 s4[4];
#pragma unroll
        for (int k = 0; k < 4; ++k) { const int row = r0 + k;
            s4[k] = *(const GAS f32x4*)(sq + (size_t)row * 16 + 4 * (F.lane & 3));
            const GAS v4u* xi = (const GAS v4u*)(x2b + (size_t)row * D) + F.lane;
            xw[k][0] = xi[0]; xw[k][1] = xi[64]; }
#pragma unroll
        for (int k = 0; k < 4; ++k) { const int row = r0 + k;
            float t = (s4[k][0] + s4[k][1]) + (s4[k][2] + s4[k][3]); t += __shfl_xor(t, 1); t += __shfl_xor(t, 2);
            const float r = 1.0f / sqrtf(t * (1.0f / 1024.0f) + EPS);
            GAS f32x4* o = (GAS f32x4*)(out + (size_t)row * D) + 2 * F.lane;
#pragma unroll
            for (int j = 0; j < 2; ++j) { const v4u x = xw[k][j];
                const f32x4 x0 = {__uint_as_float(x.x << 16), __uint_as_float(x.x & 0xffff0000u), __uint_as_float(x.y << 16), __uint_as_float(x.y & 0xffff0000u)};
                const f32x4 x1 = {__uint_as_float(x.z << 16), __uint_as_float(x.z & 0xffff0000u), __uint_as_float(x.w << 16), __uint_as_float(x.w & 0xffff0000u)};
                o[128 * j] = x0 * r * wv[j][0]; o[128 * j + 1] = x1 * r * wv[j][1]; } }
    }
}

typedef float f32x2 __attribute__((ext_vector_type(2)));
typedef __bf16 bf16v2 __attribute__((ext_vector_type(2)));
typedef unsigned u32x2 __attribute__((ext_vector_type(2)));
__device__ __forceinline__ unsigned cvtpk_c(float lo, float hi) { bf16v2 v = {(__bf16)lo, (__bf16)hi}; return __builtin_bit_cast(unsigned, v); }
__device__ __forceinline__ float bflo(unsigned w) { return __uint_as_float(w << 16); }
__device__ __forceinline__ float bfhi(unsigned w) { return __uint_as_float(w & 0xffff0000u); }
__device__ __forceinline__ int opaque_i(int x) { asm volatile("" : "+v"(x)); return x; }
typedef short s16x4 __attribute__((ext_vector_type(4)));
#define TRRD(ptr) __builtin_amdgcn_ds_read_tr16_b64_v4i16((LAS s16x4*)(ptr))
constexpr size_t ST_SC_BYTES = 393216;
__device__ __forceinline__ size_t state_off(int sc, bool gla, int hh, int dir) { return (size_t)sc * ST_SC_BYTES + (gla ? (size_t)(hh * 2 + dir) * 16384 : (size_t)131072 + (size_t)(hh * 2 + dir) * 32768); }
typedef _Float16 bh16;
__device__ __forceinline__ float h2f(unsigned w, int hi) { return (float)__builtin_bit_cast(bh16, (unsigned short)(hi ? (w >> 16) : (w & 0xffffu))); }
struct CMixArgs { bf16* proj; const float* ga; const float *waf, *baf, *wab, *bab; unsigned char* st; float* dec; const float *gnw, *rnw, *rnb; bf16* mo; int mop; unsigned char* sto; unsigned char* ofs; bh16* bb0; bh16* bb1; float* gv; };
constexpr int OB_PITCH = 132;

template <bool GLA> struct RawSet;
template <> struct RawSet<true> { v4u q, k, v0, v1, bh, lh; };
template <> struct RawSet<false> { v4u q0, q1, k0, k1, v0, v1; };

template <bool GLA, bool WITH_O>
__device__ __forceinline__ void raw_load(RawSet<GLA>& R, const CMixArgs& a, int p, int s, int w, int lane0) {
    const int lane = opaque_i(lane0), sc = p >> 2, hh = p & 3, dir = s >> 2, c = dir ? 7 - s : s;
    const size_t row = (size_t)(sc * 256 + 64 * c + 8 * w + (lane >> 3)); const int pc = lane & 7;
    if constexpr (GLA) {
        if (WITH_O) R.q = *(const GAS v4u*)(a.proj + pg8::pl(pg8::PL_GQ, hh, row, 64) + 8 * pc);
        R.k = *(const GAS v4u*)(a.proj + pg8::pl(pg8::PL_GK, hh, row, 64) + 8 * pc);
        const bf16* pv = a.proj + pg8::pl(pg8::PL_GV, hh, row, 128) + 8 * pc;
        R.v0 = *(const GAS v4u*)pv; R.v1 = *(const GAS v4u*)(pv + 64);
        const bh16* bp = (dir ? a.bb1 : a.bb0) + ((size_t)(p * 4 + c) * 64) * 64 + 8 * pc;
        const int ti = 8 * w + (lane >> 3);
        R.bh = *(const GAS v4u*)(bp + ti * 64); R.lh = *(const GAS v4u*)(bp + (dir ? 0 : 63) * 64);
    } else {
        if (WITH_O) { const bf16* pq = a.proj + pg8::pl(pg8::PL_RQ, hh, row, 128) + 8 * pc; R.q0 = *(const GAS v4u*)pq; R.q1 = *(const GAS v4u*)(pq + 64); }
        const bf16* pk = a.proj + pg8::pl(pg8::PL_RK, hh, row, 128) + 8 * pc; R.k0 = *(const GAS v4u*)pk; R.k1 = *(const GAS v4u*)(pk + 64);
        const bf16* pv = a.proj + pg8::pl(pg8::PL_RV, hh, row, 128) + 8 * pc; R.v0 = *(const GAS v4u*)pv; R.v1 = *(const GAS v4u*)(pv + 64);
    }
}

template <int DK, bool GLA, bool WITH_O> struct MixLds {
    static constexpr int NT = DK / 16, NS = DK / 32;
    static constexpr int RQ = DK * 2 + 16, RP = 144, RV = 272;
    static constexpr int O_QD = 0, O_KI = 64 * RQ, O_KE = 2 * 64 * RQ, O_PB = 3 * 64 * RQ, O_VB = O_PB + 64 * RP, O_DC = O_VB + 64 * RV, O_WAL = O_DC + DK * 4,
                         O_OB = O_WAL, O_END = O_OB + 64 * OB_PITCH * 4;
    static_assert(O_END <= 146432, "mixer LDS map");
};

template <int DK, bool GLA, bool WITH_O>
__device__ __forceinline__ void mix_step(Frame& F, const CMixArgs& a, int p, int s, int pnext, RawSet<GLA>& R, f32x4 (&S)[DK / 16], float (&dsum)[8], u32x2 (&ofp)[4][4]) {
    typedef MixLds<DK, GLA, WITH_O> ML;
    constexpr int NT = ML::NT, NS = ML::NS, RQ = ML::RQ, RP = ML::RP, RV = ML::RV;
    LAS unsigned char* L = F.lds;
    const int lane0 = F.lane, w = F.wave;
    const int sc = p >> 2, hh = p & 3, dir = s >> 2, c = dir ? 7 - s : s, row0 = sc * 256, head = GLA ? hh : 4 + hh, vcol = 128 * head;
    __syncthreads();
    {
        const int lane = opaque_i(lane0), i = 8 * w + (lane >> 3), pc = lane & 7;
        *(LAS v4u*)(L + ML::O_VB + i * RV + 16 * pc) = R.v0; *(LAS v4u*)(L + ML::O_VB + i * RV + 128 + 16 * pc) = R.v1;
        if constexpr (GLA) {
            const int tk = lane >> 3;
            float q8[8], k8[8], e8[8];
#pragma unroll
            for (int e = 0; e < 8; ++e) { const float b = h2f(((const unsigned*)&R.bh)[e >> 1], e & 1), bl_ = h2f(((const unsigned*)&R.lh)[e >> 1], e & 1);
                const unsigned wq = WITH_O ? ((const unsigned*)&R.q)[e >> 1] : 0u, wk = ((const unsigned*)&R.k)[e >> 1];
                const float qv = (e & 1) ? bfhi(wq) : bflo(wq), kv = (e & 1) ? bfhi(wk) : bflo(wk);
                q8[e] = qv * __expf(b); k8[e] = kv * __expf(-b); e8[e] = kv * __expf(bl_ - b);
                if (!WITH_O) dsum[e] += bl_;
                if (w == 0 && tk == 0) ((LAS float*)(L + ML::O_DC))[8 * pc + e] = __expf(bl_); }
            v4u oq, ok, oe;
            oq.x = cvtpk_c(q8[0], q8[1]); oq.y = cvtpk_c(q8[2], q8[3]); oq.z = cvtpk_c(q8[4], q8[5]); oq.w = cvtpk_c(q8[6], q8[7]);
            ok.x = cvtpk_c(k8[0], k8[1]); ok.y = cvtpk_c(k8[2], k8[3]); ok.z = cvtpk_c(k8[4], k8[5]); ok.w = cvtpk_c(k8[6], k8[7]);
            oe.x = cvtpk_c(e8[0], e8[1]); oe.y = cvtpk_c(e8[2], e8[3]); oe.z = cvtpk_c(e8[4], e8[5]); oe.w = cvtpk_c(e8[6], e8[7]);
            if (WITH_O) { *(LAS v4u*)(L + ML::O_QD + i * RQ + 16 * pc) = oq; *(LAS v4u*)(L + ML::O_KI + i * RQ + 16 * pc) = ok; }
            *(LAS v4u*)(L + ML::O_KE + i * RQ + 16 * pc) = oe;
        } else {
            const float l2g = hh == 0 ? -0.045803689613124f : hh == 1 ? -0.022720076500083f : hh == 2 ? -0.011315313227834f : -0.005646563141142f;
            const float nq = dir ? (float)(64 - i) : (float)(i + 1), ne = dir ? (float)i : (float)(63 - i);
            const float eb = exp2f(l2g * nq), ei = exp2f(-l2g * nq), ee = exp2f(l2g * ne);
#pragma unroll
            for (int x = 0; x < 2; ++x) { v4u oq, ok, oe; const v4u rq = x ? R.q1 : R.q0, rk = x ? R.k1 : R.k0;
#pragma unroll
                for (int j = 0; j < 4; ++j) { const unsigned wq = WITH_O ? ((const unsigned*)&rq)[j] : 0u, wk = ((const unsigned*)&rk)[j];
                    ((unsigned*)&oq)[j] = cvtpk_c(bflo(wq) * eb, bfhi(wq) * eb); ((unsigned*)&ok)[j] = cvtpk_c(bflo(wk) * ei, bfhi(wk) * ei); ((unsigned*)&oe)[j] = cvtpk_c(bflo(wk) * ee, bfhi(wk) * ee); }
                if (WITH_O) { *(LAS v4u*)(L + ML::O_QD + i * RQ + 128 * x + 16 * pc) = oq; *(LAS v4u*)(L + ML::O_KI + i * RQ + 128 * x + 16 * pc) = ok; }
                *(LAS v4u*)(L + ML::O_KE + i * RQ + 128 * x + 16 * pc) = oe; }
            if (w == 0 && lane < 32) *(LAS f32x4*)(L + ML::O_DC + lane * 16) = (f32x4){exp2f(l2g * 64.0f), exp2f(l2g * 64.0f), exp2f(l2g * 64.0f), exp2f(l2g * 64.0f)};
        }
    }
    v4u gt0, gt1; f32x4 nw[4], nb[4];
    if (WITH_O) { const int lane = opaque_i(lane0);
        const bf16* gp = a.proj + (dir ? pg8::pl(GLA ? pg8::PL_GG : pg8::PL_RG, hh, (size_t)(row0 + 64 * c + 8 * w + (lane >> 3)), 128) + 16 * (lane & 7) : pg8::pl(GLA ? pg8::PL_GG : pg8::PL_RG, 0, (size_t)0, 128));
        gt0 = *(const GAS v4u*)gp; gt1 = *(const GAS v4u*)(gp + 8);
        const float* wp = GLA ? a.gnw + 16 * (lane & 7) : a.rnw + 128 * hh + 16 * (lane & 7);
#pragma unroll
        for (int k = 0; k < 4; ++k) { nw[k] = *(const GAS f32x4*)(wp + 4 * k); if (!GLA) nb[k] = *(const GAS f32x4*)(a.rnb + 128 * hh + 16 * (lane & 7) + 4 * k); } }
    raw_load<GLA, WITH_O>(R, a, s < 6 ? p : (pnext < 1536 ? pnext : p), s < 6 ? s + 2 : s - 6, w, lane0);
    __syncthreads();
    if (WITH_O) {
        const int lane = opaque_i(lane0), g = lane >> 4, lr = lane & 15;
        const int mi = w >> 1;
        bf16x8 kf[2][NS], qf2[NS];
#pragma unroll
        for (int s2 = 0; s2 < NS; ++s2) { qf2[s2] = *(const LAS bf16x8*)(L + ML::O_QD + (16 * mi + lr) * RQ + 64 * s2 + 16 * g);
#pragma unroll
            for (int jj = 0; jj < 2; ++jj) kf[jj][s2] = *(const LAS bf16x8*)(L + ML::O_KI + (16 * (2 * (w & 1) + jj) + lr) * RQ + 64 * s2 + 16 * g); }
        __builtin_amdgcn_sched_barrier(0);
#pragma unroll
        for (int jj = 0; jj < 2; ++jj) { const int nj = 2 * (w & 1) + jj;
            f32x4 acc = {0.f, 0.f, 0.f, 0.f};
#pragma unroll
            for (int s2 = 0; s2 < NS; ++s2) acc = __builtin_amdgcn_mfma_f32_16x16x32_bf16(kf[jj][s2], qf2[s2], acc, 0, 0, 0);
            const int ii = 16 * mi + lr;
#pragma unroll
            for (int r = 0; r < 4; ++r) { const int j = 16 * nj + 4 * g + r; const bool keep = dir ? (j > ii) : (j <= ii); acc[r] = keep ? acc[r] : 0.f; }
            u32x2 pk; pk.x = cvtpk_c(acc[0], acc[1]); pk.y = cvtpk_c(acc[2], acc[3]);
            *(LAS u32x2*)(L + ML::O_PB + ii * RP + 32 * nj + 8 * g) = pk; }
        __syncthreads();
    }
    f32x4 o[4];
    {
        const int lane = opaque_i(lane0), g = lane >> 4, lr = lane & 15, q4 = lr >> 2, p4 = lr & 3;
        const LAS unsigned char* vb = L + ML::O_VB + (8 * g + q4) * RV + 32 * w + 8 * p4;
        const bf16x8 vf0 = __builtin_shufflevector(TRRD(vb), TRRD(vb + 4 * RV), 0, 1, 2, 3, 4, 5, 6, 7), vf1 = __builtin_shufflevector(TRRD(vb + 32 * RV), TRRD(vb + 36 * RV), 0, 1, 2, 3, 4, 5, 6, 7);
        if (WITH_O) {
            { bf16x8 pf[4][2];
#pragma unroll
              for (int m = 0; m < 4; ++m) { pf[m][0] = *(const LAS bf16x8*)(L + ML::O_PB + (16 * m + lr) * RP + 16 * g); pf[m][1] = *(const LAS bf16x8*)(L + ML::O_PB + (16 * m + lr) * RP + 64 + 16 * g); }
              __builtin_amdgcn_sched_barrier(0);
#pragma unroll
              for (int m = 0; m < 4; ++m) { o[m] = __builtin_amdgcn_mfma_f32_16x16x32_bf16(pf[m][0], vf0, (f32x4){0.f, 0.f, 0.f, 0.f}, 0, 0, 0); o[m] = __builtin_amdgcn_mfma_f32_16x16x32_bf16(pf[m][1], vf1, o[m], 0, 0, 0); }
              __builtin_amdgcn_sched_barrier(0); }
#pragma unroll
            for (int sh = 0; sh < NS / 2; ++sh) {
                u32x2 ql[2][4][2];
#pragma unroll
                for (int x = 0; x < 2; ++x)
#pragma unroll
                    for (int m = 0; m < 4; ++m) { ql[x][m][0] = *(const LAS u32x2*)(L + ML::O_QD + (16 * m + lr) * RQ + 64 * (2 * sh + x) + 8 * g); ql[x][m][1] = *(const LAS u32x2*)(L + ML::O_QD + (16 * m + lr) * RQ + 64 * (2 * sh + x) + 32 + 8 * g); }
                __builtin_amdgcn_sched_barrier(0);
#pragma unroll
                for (int x = 0; x < 2; ++x) { const int s2 = 2 * sh + x;
                    const bf16x8 sf = __builtin_bit_cast(bf16x8, (v4u){cvtpk_c(S[2 * s2][0], S[2 * s2][1]), cvtpk_c(S[2 * s2][2], S[2 * s2][3]), cvtpk_c(S[2 * s2 + 1][0], S[2 * s2 + 1][1]), cvtpk_c(S[2 * s2 + 1][2], S[2 * s2 + 1][3])});
#pragma unroll
                    for (int m = 0; m < 4; ++m) o[m] = __builtin_amdgcn_mfma_f32_16x16x32_bf16(__builtin_bit_cast(bf16x8, (v4u){ql[x][m][0].x, ql[x][m][0].y, ql[x][m][1].x, ql[x][m][1].y}), sf, o[m], 0, 0, 0); }
                __builtin_amdgcn_sched_barrier(0);
            }
        }
#pragma unroll
        for (int th = 0; th < NT / 4; ++th) {
            f32x4 d4[4]; bf16x8 kf0[4], kf1[4];
#pragma unroll
            for (int x = 0; x < 4; ++x) { const int tt = 4 * th + x;
                d4[x] = *(const LAS f32x4*)(L + ML::O_DC + (16 * tt + 4 * g) * 4);
                const LAS unsigned char* kb = L + ML::O_KE + (8 * g + q4) * RQ + 32 * tt + 8 * p4;
                kf0[x] = __builtin_shufflevector(TRRD(kb), TRRD(kb + 4 * RQ), 0, 1, 2, 3, 4, 5, 6, 7); kf1[x] = __builtin_shufflevector(TRRD(kb + 32 * RQ), TRRD(kb + 36 * RQ), 0, 1, 2, 3, 4, 5, 6, 7); }
            __builtin_amdgcn_sched_barrier(0);
#pragma unroll
            for (int x = 0; x < 4; ++x) { const int tt = 4 * th + x;
                S[tt] = S[tt] * d4[x];
                S[tt] = __builtin_amdgcn_mfma_f32_16x16x32_bf16(kf0[x], vf0, S[tt], 0, 0, 0);
                S[tt] = __builtin_amdgcn_mfma_f32_16x16x32_bf16(kf1[x], vf1, S[tt], 0, 0, 0); }
            __builtin_amdgcn_sched_barrier(0);
        }
    }
    if (WITH_O) {
        const int lane = opaque_i(lane0), g = lane >> 4, lr = lane & 15;
        if (dir == 0) {
#pragma unroll
            for (int cc = 0; cc < 4; ++cc) if (cc == c) {
#pragma unroll
                for (int m = 0; m < 4; ++m) { ofp[cc][m].x = cvtpk_c(o[m][0], o[m][1]); ofp[cc][m].y = cvtpk_c(o[m][2], o[m][3]); } }
        } else {
            u32x2 ofr[4];
#pragma unroll
            for (int cc = 0; cc < 4; ++cc) if (cc == c) {
#pragma unroll
                for (int m = 0; m < 4; ++m) ofr[m] = ofp[cc][m]; }
            LAS float* ob = (LAS float*)(L + ML::O_OB);
#pragma unroll
            for (int m = 0; m < 4; ++m) { const f32x4 t = {o[m][0] + bflo(ofr[m].x), o[m][1] + bfhi(ofr[m].x), o[m][2] + bflo(ofr[m].y), o[m][3] + bfhi(ofr[m].y)};
#pragma unroll
                for (int r = 0; r < 4; ++r) ob[(16 * m + 4 * g + r) * OB_PITCH + 16 * w + lr] = t[r]; }
            __syncthreads();
            const int row = 8 * w + (lane >> 3), pc = lane & 7;
            f32x4 x[4];
#pragma unroll
            for (int k = 0; k < 4; ++k) x[k] = *(const LAS f32x4*)(ob + row * OB_PITCH + 16 * pc + 4 * k);
            float rs;
            if (GLA) { float ss = 0.f;
#pragma unroll
                for (int k = 0; k < 4; ++k) ss += (x[k][0] * x[k][0] + x[k][1] * x[k][1]) + (x[k][2] * x[k][2] + x[k][3] * x[k][3]);
                ss += __shfl_xor(ss, 1); ss += __shfl_xor(ss, 2); ss += __shfl_xor(ss, 4);
                rs = __builtin_amdgcn_rsqf(ss * (1.0f / 128.0f) + EPS); }
            else { float sm = 0.f;
#pragma unroll
                for (int k = 0; k < 4; ++k) sm += (x[k][0] + x[k][1]) + (x[k][2] + x[k][3]);
                sm += __shfl_xor(sm, 1); sm += __shfl_xor(sm, 2); sm += __shfl_xor(sm, 4);
                const float mu = sm * (1.0f / 128.0f); float ss = 0.f;
#pragma unroll
                for (int k = 0; k < 4; ++k) { x[k] = x[k] - mu; ss += (x[k][0] * x[k][0] + x[k][1] * x[k][1]) + (x[k][2] * x[k][2] + x[k][3] * x[k][3]); }
                ss += __shfl_xor(ss, 1); ss += __shfl_xor(ss, 2); ss += __shfl_xor(ss, 4);
                rs = __builtin_amdgcn_rsqf(ss * (1.0f / 128.0f) + EPS); }
            unsigned ow[8];
#pragma unroll
            for (int k = 0; k < 4; ++k) { f32x4 y = x[k] * rs * nw[k];
                if (!GLA) y = y + nb[k];
                const unsigned ga_ = k < 2 ? ((const unsigned*)&gt0)[2 * k] : ((const unsigned*)&gt1)[2 * k - 4], gb_ = k < 2 ? ((const unsigned*)&gt0)[2 * k + 1] : ((const unsigned*)&gt1)[2 * k - 3];
                const float g0 = bflo(ga_), g1 = bfhi(ga_), g2 = bflo(gb_), g3 = bfhi(gb_);
                y[0] *= g0 * __builtin_amdgcn_rcpf(1.0f + __expf(-g0)); y[1] *= g1 * __builtin_amdgcn_rcpf(1.0f + __expf(-g1));
                y[2] *= g2 * __builtin_amdgcn_rcpf(1.0f + __expf(-g2)); y[3] *= g3 * __builtin_amdgcn_rcpf(1.0f + __expf(-g3));
                ow[2 * k] = cvtpk_c(y[0], y[1]); ow[2 * k + 1] = cvtpk_c(y[2], y[3]); }
            bf16* op = a.mo + (size_t)(row0 + 64 * c + row) * a.mop + vcol + 16 * pc;
            *(GAS v4u*)op = (v4u){ow[0], ow[1], ow[2], ow[3]}; *(GAS v4u*)(op + 8) = (v4u){ow[4], ow[5], ow[6], ow[7]};
        }
    }
}


__device__ __forceinline__ void gla_b_stage(Frame& F, const CMixArgs& a, int p) {
    const int sc = p >> 2, hh = p & 3, w = F.wave;
    LAS float* gl = (LAS float*)F.lds;
    __syncthreads();
    { const int tid = opaque_i(F.tid);
#pragma unroll
      for (int x = 0; x < 4; ++x) *(LAS f32x4*)(gl + 4 * (tid + 512 * x)) = *(const GAS f32x4*)(a.ga + (size_t)sc * 256 * 32 + 4 * (tid + 512 * x)); }
    __syncthreads();
    const int t = opaque_i(F.lane), dir = w >> 2, c = w & 3;
    const float* wa = (dir ? a.wab : a.waf) + 64 * hh + t;
    float wv[16];
#pragma unroll
    for (int r = 0; r < 16; ++r) wv[r] = wa[r * 256];
    const float bias = (dir ? a.bab : a.baf)[64 * hh + t];
    bh16* bp = (dir ? a.bb1 : a.bb0) + ((size_t)(p * 4 + c) * 64) * 64;
    LAS float* tb = gl + 8192 + w * (16 * 68);
    float acc = 0.f;
#pragma unroll 1
    for (int k16 = 0; k16 < 64; k16 += 16) {
#pragma unroll 1
        for (int k4 = k16; k4 < k16 + 16; k4 += 4) {
            f32x4 gv[4][4];
#pragma unroll
            for (int j = 0; j < 4; ++j) { const int i = dir ? 63 - (k4 + j) : k4 + j; const LAS float* gr = gl + (64 * c + i) * 32 + 16 * dir;
#pragma unroll
                for (int x = 0; x < 4; ++x) gv[j][x] = *(const LAS f32x4*)(gr + 4 * x); }
            __builtin_amdgcn_sched_barrier(0);
#pragma unroll
            for (int j = 0; j < 4; ++j) {
                f32x2 z2 = {bias, 0.f};
#pragma unroll
                for (int x = 0; x < 4; ++x) { z2 = __builtin_elementwise_fma((f32x2){gv[j][x][0], gv[j][x][1]}, (f32x2){wv[4 * x], wv[4 * x + 1]}, z2);
                    z2 = __builtin_elementwise_fma((f32x2){gv[j][x][2], gv[j][x][3]}, (f32x2){wv[4 * x + 2], wv[4 * x + 3]}, z2); }
                const float z = z2[0] + z2[1];
                const float ls = fminf(z, 0.f) - __logf(1.0f + __expf(-fabsf(z)));
                acc += fmaxf(ls * (1.0f / 16.0f), -1.0f);
                tb[(k4 - k16 + j) * 68 + t] = acc; }
        }
#pragma unroll
        for (int x = 0; x < 2; ++x) { const int kk = 8 * x + (t >> 3), i = dir ? 63 - (k16 + kk) : k16 + kk;
            const f32x4 lo = *(const LAS f32x4*)(tb + kk * 68 + 8 * (t & 7)), hi = *(const LAS f32x4*)(tb + kk * 68 + 8 * (t & 7) + 4);
            v4u o;
#pragma unroll
            for (int q = 0; q < 2; ++q) { ((unsigned*)&o)[q] = (unsigned)__builtin_bit_cast(unsigned short, (bh16)lo[2 * q]) | ((unsigned)__builtin_bit_cast(unsigned short, (bh16)lo[2 * q + 1]) << 16);
                ((unsigned*)&o)[2 + q] = (unsigned)__builtin_bit_cast(unsigned short, (bh16)hi[2 * q]) | ((unsigned)__builtin_bit_cast(unsigned short, (bh16)hi[2 * q + 1]) << 16); }
            *(GAS v4u*)(bp + i * 64 + 8 * (t & 7)) = o; }
    }
    LAS float* tot = gl + 8192 + 8 * (16 * 68);
    tot[w * 64 + t] = acc;
    __syncthreads();
    { float gsum = 0.f;
#pragma unroll
      for (int cc = 0; cc < 4; ++cc) { const float v = tot[(dir * 4 + cc) * 64 + t]; if (dir ? (cc <= c) : (cc >= c)) gsum += v; }
      a.gv[((size_t)(p * 2 + dir) * 4 + c) * 64 + t] = gsum;
      if (c == (dir ? 3 : 0)) a.dec[(size_t)((sc * 4 + hh) * 2 + dir) * 64 + t] = __expf(gsum); }
}

template <int DK, bool GLA, bool WITH_O>
__device__ __forceinline__ void mix_units(Frame& F, const CMixArgs& a) {
    typedef MixLds<DK, GLA, WITH_O> ML;
    constexpr int NT = DK / 16;
    const int w = F.wave, lane0 = F.lane;
    int p = (int)blockIdx.x;
    if (p >= 1536) return;
    RawSet<GLA> RA, RB;
    raw_load<GLA, WITH_O>(RA, a, p, 0, w, lane0); raw_load<GLA, WITH_O>(RB, a, p, 1, w, lane0);
    f32x4 S[NT]; float dsum[8]; u32x2 ofp[4][4];
#pragma unroll 1
    for (; p < 1536; p += F.G) {
        const int sc = p >> 2, hh = p & 3, pnext = p + F.G;
#pragma unroll 1
        for (int dir = 0; dir < 2; ++dir) {
            const int lane = opaque_i(lane0);
            unsigned char* sp = a.st + state_off(sc, GLA, hh, dir) + (size_t)(unsigned)(w * NT * 512 + lane * 8);
            if (WITH_O) {
#pragma unroll
                for (int tt = 0; tt < NT; ++tt) { const u32x2 pk = *(const GAS u32x2*)(sp + tt * 512); S[tt] = (f32x4){bflo(pk.x), bfhi(pk.x), bflo(pk.y), bfhi(pk.y)}; } }
            else {
#pragma unroll
                for (int tt = 0; tt < NT; ++tt) S[tt] = (f32x4){0.f, 0.f, 0.f, 0.f};
#pragma unroll
                for (int e = 0; e < 8; ++e) dsum[e] = 0.f; }
#pragma unroll 1
            for (int h2 = 0; h2 < 2; ++h2) {
                mix_step<DK, GLA, WITH_O>(F, a, p, 4 * dir + 2 * h2, pnext, RA, S, dsum, ofp);
                mix_step<DK, GLA, WITH_O>(F, a, p, 4 * dir + 2 * h2 + 1, pnext, RB, S, dsum, ofp);
            }
            if (!WITH_O) {
#pragma unroll
                for (int tt = 0; tt < NT; ++tt) { u32x2 pk; pk.x = cvtpk_c(S[tt][0], S[tt][1]); pk.y = cvtpk_c(S[tt][2], S[tt][3]); *(GAS u32x2*)(sp + tt * 512) = pk; }
                if (GLA && w == 0 && lane < 8) { float* dp = a.dec + (size_t)((sc * 4 + hh) * 2 + dir) * 64 + 8 * lane;
#pragma unroll
                    for (int e = 0; e < 8; ++e) dp[e] = __expf(dsum[e]); }
            }
        }
    }
}

template <bool GLA> struct KvRaw;
template <> struct KvRaw<true> { v4u k, v0, v1, bfh, bbh; f32x4 gf0, gf1, gb0, gb1; };
template <> struct KvRaw<false> { v4u k0, k1, v0, v1; };
template <bool GLA>
__device__ __forceinline__ void kv_load(KvRaw<GLA>& R, const CMixArgs& a, int p, int c, int w, int lane0) {
    const int lane = opaque_i(lane0), sc = p >> 2, hh = p & 3, pc = lane & 7, ti = 8 * w + (lane >> 3);
    const size_t row = (size_t)(sc * 256 + 64 * c + ti);
    if constexpr (GLA) {
        R.k = *(const GAS v4u*)(a.proj + pg8::pl(pg8::PL_GK, hh, row, 64) + 8 * pc);
        const bf16* pv = a.proj + pg8::pl(pg8::PL_GV, hh, row, 128) + 8 * pc; R.v0 = *(const GAS v4u*)pv; R.v1 = *(const GAS v4u*)(pv + 64);
        R.bfh = *(const GAS v4u*)(a.bb0 + ((size_t)(p * 4 + c) * 64 + ti) * 64 + 8 * pc); R.bbh = *(const GAS v4u*)(a.bb1 + ((size_t)(p * 4 + c) * 64 + ti) * 64 + 8 * pc);
        const float* g0 = a.gv + ((size_t)(p * 2 + 0) * 4 + c) * 64 + 8 * pc; const float* g1 = a.gv + ((size_t)(p * 2 + 1) * 4 + c) * 64 + 8 * pc;
        R.gf0 = *(const GAS f32x4*)g0; R.gf1 = *(const GAS f32x4*)(g0 + 4); R.gb0 = *(const GAS f32x4*)g1; R.gb1 = *(const GAS f32x4*)(g1 + 4);
    } else {
        const bf16* pk = a.proj + pg8::pl(pg8::PL_RK, hh, row, 128) + 8 * pc; R.k0 = *(const GAS v4u*)pk; R.k1 = *(const GAS v4u*)(pk + 64);
        const bf16* pv = a.proj + pg8::pl(pg8::PL_RV, hh, row, 128) + 8 * pc; R.v0 = *(const GAS v4u*)pv; R.v1 = *(const GAS v4u*)(pv + 64);
    }
}
template <int DK, bool GLA>
__device__ __forceinline__ void kv_step(Frame& F, const CMixArgs& a, int p, int c, int pnext, KvRaw<GLA>& R, f32x4 (&Sf)[DK / 16], f32x4 (&Sb)[DK / 16]) {
    constexpr int NT = DK / 16, RQ = DK * 2 + 16, RV = 272, O_KF = 0, O_KB = 64 * RQ, O_VB = 2 * 64 * RQ;
    LAS unsigned char* L = F.lds;
    const int lane0 = F.lane, w = F.wave, hh = p & 3;
    __syncthreads();
    { const int lane = opaque_i(lane0), i = 8 * w + (lane >> 3), pc = lane & 7;
      *(LAS v4u*)(L + O_VB + i * RV + 16 * pc) = R.v0; *(LAS v4u*)(L + O_VB + i * RV + 128 + 16 * pc) = R.v1;
      if constexpr (GLA) {
          float f8[8], b8[8];
#pragma unroll
          for (int e = 0; e < 8; ++e) { const unsigned wk = ((const unsigned*)&R.k)[e >> 1]; const float kv = (e & 1) ? bfhi(wk) : bflo(wk);
              const float xf = (e < 4 ? R.gf0[e & 3] : R.gf1[e & 3]) - h2f(((const unsigned*)&R.bfh)[e >> 1], e & 1), xb = (e < 4 ? R.gb0[e & 3] : R.gb1[e & 3]) - h2f(((const unsigned*)&R.bbh)[e >> 1], e & 1);
              f8[e] = kv * __expf(xf); b8[e] = kv * __expf(xb); }
          *(LAS v4u*)(L + O_KF + i * RQ + 16 * pc) = (v4u){cvtpk_c(f8[0], f8[1]), cvtpk_c(f8[2], f8[3]), cvtpk_c(f8[4], f8[5]), cvtpk_c(f8[6], f8[7])};
          *(LAS v4u*)(L + O_KB + i * RQ + 16 * pc) = (v4u){cvtpk_c(b8[0], b8[1]), cvtpk_c(b8[2], b8[3]), cvtpk_c(b8[4], b8[5]), cvtpk_c(b8[6], b8[7])};
      } else {
          const float l2g = hh == 0 ? -0.045803689613124f : hh == 1 ? -0.022720076500083f : hh == 2 ? -0.011315313227834f : -0.005646563141142f;
          const float j = (float)(64 * c + i), ef = __builtin_amdgcn_exp2f(l2g * (255.0f - j)), eb = __builtin_amdgcn_exp2f(l2g * j);
#pragma unroll
          for (int x = 0; x < 2; ++x) { const v4u rk = x ? R.k1 : R.k0; v4u of, ob;
#pragma unroll
              for (int q = 0; q < 4; ++q) { const unsigned wk = ((const unsigned*)&rk)[q]; ((unsigned*)&of)[q] = cvtpk_c(bflo(wk) * ef, bfhi(wk) * ef); ((unsigned*)&ob)[q] = cvtpk_c(bflo(wk) * eb, bfhi(wk) * eb); }
              *(LAS v4u*)(L + O_KF + i * RQ + 128 * x + 16 * pc) = of; *(LAS v4u*)(L + O_KB + i * RQ + 128 * x + 16 * pc) = ob; }
      } }
    kv_load<GLA>(R, a, c < 2 ? p : (pnext < 1536 ? pnext : p), (c + 2) & 3, w, lane0);
    __syncthreads();
    { const int lane = opaque_i(lane0), g = lane >> 4, lr = lane & 15, q4 = lr >> 2, p4 = lr & 3;
      const LAS unsigned char* vb = L + O_VB + (8 * g + q4) * RV + 32 * w + 8 * p4;
      const bf16x8 vf0 = __builtin_shufflevector(TRRD(vb), TRRD(vb + 4 * RV), 0, 1, 2, 3, 4, 5, 6, 7), vf1 = __builtin_shufflevector(TRRD(vb + 32 * RV), TRRD(vb + 36 * RV), 0, 1, 2, 3, 4, 5, 6, 7);
#pragma unroll
      for (int th = 0; th < NT / 4; ++th) {
          bf16x8 kf0[4], kf1[4], kb0[4], kb1[4];
#pragma unroll
          for (int x = 0; x < 4; ++x) { const int tt = 4 * th + x;
              const LAS unsigned char* ka = L + O_KF + (8 * g + q4) * RQ + 32 * tt + 8 * p4; const LAS unsigned char* kb = L + O_KB + (8 * g + q4) * RQ + 32 * tt + 8 * p4;
              kf0[x] = __builtin_shufflevector(TRRD(ka), TRRD(ka + 4 * RQ), 0, 1, 2, 3, 4, 5, 6, 7); kf1[x] = __builtin_shufflevector(TRRD(ka + 32 * RQ), TRRD(ka + 36 * RQ), 0, 1, 2, 3, 4, 5, 6, 7);
              kb0[x] = __builtin_shufflevector(TRRD(kb), TRRD(kb + 4 * RQ), 0, 1, 2, 3, 4, 5, 6, 7); kb1[x] = __builtin_shufflevector(TRRD(kb + 32 * RQ), TRRD(kb + 36 * RQ), 0, 1, 2, 3, 4, 5, 6, 7); }
          __builtin_amdgcn_sched_barrier(0);
#pragma unroll
          for (int x = 0; x < 4; ++x) { const int tt = 4 * th + x;
              Sf[tt] = __builtin_amdgcn_mfma_f32_16x16x32_bf16(kf0[x], vf0, Sf[tt], 0, 0, 0); Sf[tt] = __builtin_amdgcn_mfma_f32_16x16x32_bf16(kf1[x], vf1, Sf[tt], 0, 0, 0);
              Sb[tt] = __builtin_amdgcn_mfma_f32_16x16x32_bf16(kb0[x], vf0, Sb[tt], 0, 0, 0); Sb[tt] = __builtin_amdgcn_mfma_f32_16x16x32_bf16(kb1[x], vf1, Sb[tt], 0, 0, 0); }
          __builtin_amdgcn_sched_barrier(0);
      } }
}
template <int DK, bool GLA>
__device__ __forceinline__ void kv_units(Frame& F, const CMixArgs& a) {
    constexpr int NT = DK / 16;
    const int w = F.wave, lane0 = F.lane;
    int p = (int)blockIdx.x;
    if (p >= 1536) return;
    if (GLA) {
#pragma unroll 1
        for (int pp = p; pp < 1536; pp += F.G) gla_b_stage(F, a, pp);
        asm volatile("s_waitcnt vmcnt(0)" ::: "memory"); __syncthreads(); }
    KvRaw<GLA> RA, RB;
    kv_load<GLA>(RA, a, p, 0, w, lane0); kv_load<GLA>(RB, a, p, 1, w, lane0);
#pragma unroll 1
    for (; p < 1536; p += F.G) {
        const int sc = p >> 2, hh = p & 3, pnext = p + F.G;
        f32x4 Sf[NT], Sb[NT];
#pragma unroll
        for (int tt = 0; tt < NT; ++tt) { Sf[tt] = (f32x4){0.f, 0.f, 0.f, 0.f}; Sb[tt] = (f32x4){0.f, 0.f, 0.f, 0.f}; }
        kv_step<DK, GLA>(F, a, p, 0, pnext, RA, Sf, Sb); kv_step<DK, GLA>(F, a, p, 1, pnext, RB, Sf, Sb);
        kv_step<DK, GLA>(F, a, p, 2, pnext, RA, Sf, Sb); kv_step<DK, GLA>(F, a, p, 3, pnext, RB, Sf, Sb);
        const int lane = opaque_i(lane0);
#pragma unroll
        for (int dir = 0; dir < 2; ++dir) { unsigned char* sp = a.st + state_off(sc, GLA, hh, dir) + (size_t)(unsigned)(w * NT * 512 + lane * 8);
#pragma unroll
            for (int tt = 0; tt < NT; ++tt) { const f32x4 s = dir ? Sb[tt] : Sf[tt]; u32x2 pk; pk.x = cvtpk_c(s[0], s[1]); pk.y = cvtpk_c(s[2], s[3]); *(GAS u32x2*)(sp + tt * 512) = pk; } }
    }
}

constexpr int RD_SLOT = 32768;
__device__ __forceinline__ void ret_dma_block(Frame& F, const CMixArgs& a, int p, int kb, int slot) {
    const int lane = opaque_i(F.lane), w = F.wave, sc = p >> 2, hh = p & 3;
#pragma unroll
    for (int x = 0; x < 2; ++x) {
        const int r = 4 * (2 * w + x) + (lane >> 4), cp = lane & 15;
        const size_t row = (size_t)(sc * 256 + 64 * kb + r);
        const bf16* gk = a.proj + pg8::pl(pg8::PL_RK, hh, row, 128) + 8 * (cp ^ (r & 15));
        const bf16* gv = a.proj + pg8::pl(pg8::PL_RV, hh, row, 128) + 8 * (cp ^ (2 * (r & 7)));
        __builtin_amdgcn_global_load_lds((const unsigned*)gk, (LAS unsigned*)(F.lds + slot * RD_SLOT + (2 * w + x) * 1024), 16, 0, 0);
        __builtin_amdgcn_global_load_lds((const unsigned*)gv, (LAS unsigned*)(F.lds + slot * RD_SLOT + 16384 + (2 * w + x) * 1024), 16, 0, 0);
    }
}
__device__ __forceinline__ void tr_read16(const unsigned (&ad)[8], u32x2 (&r)[16]) {
    asm volatile("ds_read_b64_tr_b16 %0, %16\n\tds_read_b64_tr_b16 %1, %16 offset:4096\n\tds_read_b64_tr_b16 %2, %17\n\tds_read_b64_tr_b16 %3, %17 offset:4096\n\t"
                 "ds_read_b64_tr_b16 %4, %18\n\tds_read_b64_tr_b16 %5, %18 offset:4096\n\tds_read_b64_tr_b16 %6, %19\n\tds_read_b64_tr_b16 %7, %19 offset:4096\n\t"
                 "ds_read_b64_tr_b16 %8, %20\n\tds_read_b64_tr_b16 %9, %20 offset:4096\n\tds_read_b64_tr_b16 %10, %21\n\tds_read_b64_tr_b16 %11, %21 offset:4096\n\t"
                 "ds_read_b64_tr_b16 %12, %22\n\tds_read_b64_tr_b16 %13, %22 offset:4096\n\tds_read_b64_tr_b16 %14, %23\n\tds_read_b64_tr_b16 %15, %23 offset:4096\n\t"
                 "s_waitcnt lgkmcnt(0)"
                 : "=&v"(r[0]), "=&v"(r[1]), "=&v"(r[2]), "=&v"(r[3]), "=&v"(r[4]), "=&v"(r[5]), "=&v"(r[6]), "=&v"(r[7]),
                   "=&v"(r[8]), "=&v"(r[9]), "=&v"(r[10]), "=&v"(r[11]), "=&v"(r[12]), "=&v"(r[13]), "=&v"(r[14]), "=&v"(r[15])
                 : "v"(ad[0]), "v"(ad[1]), "v"(ad[2]), "v"(ad[3]), "v"(ad[4]), "v"(ad[5]), "v"(ad[6]), "v"(ad[7]) : "memory");
}
__device__ __forceinline__ void ret_block(Frame& F, const CMixArgs& a, int p, int kb, int slot, int pnext, const bf16x8 (&Qf)[2][4], f32x4 (&O)[8][2]) {
    LAS unsigned char* L = F.lds;
    const int w = F.wave, hh = p & 3;
    const float l2g = hh == 0 ? -0.045803689613124f : hh == 1 ? -0.022720076500083f : hh == 2 ? -0.011315313227834f : -0.005646563141142f;
    asm volatile("s_waitcnt vmcnt(4)" ::: "memory");
    __builtin_amdgcn_s_barrier();
    asm volatile("" ::: "memory");
    { const int kn = kb + 2, pn2 = kn < 4 ? p : (pnext < 1536 ? pnext : p); ret_dma_block(F, a, pn2, kn & 3, slot == 0 ? 2 : slot - 1); }
    LAS unsigned char* KB = L + slot * RD_SLOT; LAS unsigned char* VB = KB + 16384;
    const int lane = opaque_i(F.lane), g = lane >> 4, lr = lane & 15, q4 = lr >> 2, p4 = lr & 3;
    const int xk16 = (lr ^ (g >> 1)) << 4, xv16 = ((p4 >> 1) ^ (2 * ((4 * g + q4) & 7))) << 4;
#pragma unroll
    for (int sp = 0; sp < 2; ++sp) {
        f32x4 st[2][2];
#pragma unroll
        for (int h = 0; h < 2; ++h)
#pragma unroll
            for (int it = 0; it < 2; ++it) st[h][it] = (f32x4){0.f, 0.f, 0.f, 0.f};
        { bf16x8 kf[2][4];
#pragma unroll
          for (int s = 0; s < 4; ++s)
#pragma unroll
              for (int h = 0; h < 2; ++h) {
                  const LAS unsigned char* kp = KB + (32 * sp + 16 * h + lr) * 256 + 8 * (g & 1);
                  const u32x2 lo = *(const LAS u32x2*)(kp + ((64 * s) ^ xk16)), hi = *(const LAS u32x2*)(kp + ((64 * s + 32) ^ xk16));
                  kf[h][s] = __builtin_bit_cast(bf16x8, (v4u){lo.x, lo.y, hi.x, hi.y}); }
          __builtin_amdgcn_sched_barrier(0);
#pragma unroll
          for (int s = 0; s < 4; ++s)
#pragma unroll
              for (int h = 0; h < 2; ++h)
#pragma unroll
                  for (int it = 0; it < 2; ++it) st[h][it] = __builtin_amdgcn_mfma_f32_16x16x32_bf16(kf[h][s], Qf[it][s], st[h][it], 0, 0, 0);
          __builtin_amdgcn_sched_barrier(0); }
        bf16x8 pf[2];
#pragma unroll
        for (int it = 0; it < 2; ++it) {
            const int i = 32 * w + 16 * it + lr;
            unsigned pw[4];
#pragma unroll
            for (int h = 0; h < 2; ++h) { float e[4];
#pragma unroll
                for (int r = 0; r < 4; ++r) { const int j = 64 * kb + 32 * sp + 16 * h + 4 * g + r; const int d = i - j; e[r] = st[h][it][r] * __builtin_amdgcn_exp2f(l2g * (float)(d < 0 ? -d : d)); }
                pw[2 * h] = cvtpk_c(e[0], e[1]); pw[2 * h + 1] = cvtpk_c(e[2], e[3]); }
            pf[it] = __builtin_bit_cast(bf16x8, (v4u){pw[0], pw[1], pw[2], pw[3]});
        }
        { unsigned ad[8]; u32x2 vr[16];
          const unsigned vb0 = (unsigned)(size_t)(VB + (32 * sp + 4 * g + q4) * 256 + 8 * (p4 & 1));
#pragma unroll
          for (int dt = 0; dt < 8; ++dt) ad[dt] = vb0 + ((32 * dt) ^ xv16);
          tr_read16(ad, vr);
          __builtin_amdgcn_sched_barrier(0);
#pragma unroll
          for (int dt = 0; dt < 8; ++dt) { const bf16x8 vf = __builtin_bit_cast(bf16x8, (v4u){vr[2 * dt].x, vr[2 * dt].y, vr[2 * dt + 1].x, vr[2 * dt + 1].y});
#pragma unroll
              for (int it = 0; it < 2; ++it) O[dt][it] = __builtin_amdgcn_mfma_f32_16x16x32_bf16(vf, pf[it], O[dt][it], 0, 0, 0); }
          __builtin_amdgcn_sched_barrier(0); }
    }
}
__device__ __forceinline__ void ret_q_load(bf16x8 (&Qf)[2][4], const CMixArgs& a, int p, int w, int lane0) {
    const int lane = opaque_i(lane0), g = lane >> 4, lr = lane & 15, sc = p >> 2, hh = p & 3;
#pragma unroll
    for (int it = 0; it < 2; ++it) { const bf16* qp = a.proj + pg8::pl(pg8::PL_RQ, hh, (size_t)(sc * 256 + 32 * w + 16 * it + lr), 128) + 4 * g;
#pragma unroll
        for (int s = 0; s < 4; ++s) { const u32x2 lo = *(const GAS u32x2*)(qp + 32 * s), hi = *(const GAS u32x2*)(qp + 32 * s + 16); Qf[it][s] = __builtin_bit_cast(bf16x8, (v4u){lo.x, lo.y, hi.x, hi.y}); } }
}
__device__ __forceinline__ void ret_units_direct(Frame& F, const CMixArgs& a) {
    const int w = F.wave;
    int p = (int)blockIdx.x;
    if (p >= 1536) return;
    bf16x8 Qf[2][4];
    asm volatile("s_waitcnt vmcnt(0)" ::: "memory"); __syncthreads();
    ret_dma_block(F, a, p, 0, 0); ret_dma_block(F, a, p, 1, 1);
    int slot = 0;
    ret_q_load(Qf, a, p, w, F.lane);
#pragma unroll 1
    for (; p < 1536; p += F.G) {
        const int sc = p >> 2, hh = p & 3, pnext = p + F.G;
        const float l2g = hh == 0 ? -0.045803689613124f : hh == 1 ? -0.022720076500083f : hh == 2 ? -0.011315313227834f : -0.005646563141142f;
        f32x4 O[8][2];
#pragma unroll
        for (int dt = 0; dt < 8; ++dt)
#pragma unroll
            for (int it = 0; it < 2; ++it) O[dt][it] = (f32x4){0.f, 0.f, 0.f, 0.f};
#pragma unroll 1
        for (int kb = 0; kb < 4; ++kb) { ret_block(F, a, p, kb, slot, pnext, Qf, O); slot = slot == 2 ? 0 : slot + 1; }
        { const int lane = opaque_i(F.lane), lr = lane & 15;
          const unsigned char* sp0 = a.st + state_off(sc, false, hh, 0) + (size_t)(unsigned)(lane * 8);
          u32x2 cA[16], cB[16];
#define RD_CLOAD(dst, k_) do { const unsigned char* b_ = sp0 + ((k_) >> 2) * 32768 + 2 * ((k_) & 3) * 512; \
              _Pragma("unroll") for (int dt = 0; dt < 8; ++dt) { dst[2 * dt] = *(const GAS u32x2*)(b_ + dt * 4096); dst[2 * dt + 1] = *(const GAS u32x2*)(b_ + dt * 4096 + 512); } } while (0)
#define RD_CMMA(src, k_) do { const int dir_ = (k_) >> 2, s_ = (k_) & 3; bf16x8 qs[2]; \
              _Pragma("unroll") for (int it = 0; it < 2; ++it) { const int i = 32 * w + 16 * it + lr; const float f = __builtin_amdgcn_exp2f(l2g * (float)(dir_ ? 256 - i : i + 1)); \
                  const v4u qw = __builtin_bit_cast(v4u, Qf[it][s_]); v4u o_; \
                  _Pragma("unroll") for (int j = 0; j < 4; ++j) ((unsigned*)&o_)[j] = cvtpk_c(bflo(((const unsigned*)&qw)[j]) * f, bfhi(((const unsigned*)&qw)[j]) * f); \
                  qs[it] = __builtin_bit_cast(bf16x8, o_); } \
              _Pragma("unroll") for (int dt = 0; dt < 8; ++dt) { const bf16x8 cf = __builtin_bit_cast(bf16x8, (v4u){src[2 * dt].x, src[2 * dt].y, src[2 * dt + 1].x, src[2 * dt + 1].y}); \
                  _Pragma("unroll") for (int it = 0; it < 2; ++it) O[dt][it] = __builtin_amdgcn_mfma_f32_16x16x32_bf16(cf, qs[it], O[dt][it], 0, 0, 0); } } while (0)
          RD_CLOAD(cA, 0); RD_CLOAD(cB, 1);
          __builtin_amdgcn_sched_barrier(0);
#pragma unroll
          for (int k = 0; k < 8; k += 2) {
              RD_CMMA(cA, k); if (k + 2 < 8) RD_CLOAD(cA, k + 2);
              __builtin_amdgcn_sched_barrier(0);
              RD_CMMA(cB, k + 1); if (k + 3 < 8) RD_CLOAD(cB, k + 3);
              __builtin_amdgcn_sched_barrier(0);
          }
#undef RD_CLOAD
#undef RD_CMMA
        }
        ret_q_load(Qf, a, pnext < 1536 ? pnext : p, w, F.lane);
        { const int lane = opaque_i(F.lane), g = lane >> 4, lr = lane & 15;
          LAS unsigned char* T = F.lds + 3 * RD_SLOT + w * (16 * 272);
          f32x4 nw[4], nb[4];
#pragma unroll
          for (int k = 0; k < 4; ++k) { nw[k] = *(const GAS f32x4*)(a.rnw + 128 * hh + 16 * (lane & 7) + 4 * k); nb[k] = *(const GAS f32x4*)(a.rnb + 128 * hh + 16 * (lane & 7) + 4 * k); }
#pragma unroll
          for (int it = 0; it < 2; ++it) {
              v4u gt[2][2];
#pragma unroll
              for (int h = 0; h < 2; ++h) { const bf16* gp = a.proj + pg8::pl(pg8::PL_RG, hh, (size_t)(sc * 256 + 32 * w + 16 * it + 8 * h + (lane >> 3)), 128) + 16 * (lane & 7);
                  gt[h][0] = *(const GAS v4u*)gp; gt[h][1] = *(const GAS v4u*)(gp + 8); }
              float sm = 0.f;
#pragma unroll
              for (int dt = 0; dt < 8; ++dt) sm += (O[dt][it][0] + O[dt][it][1]) + (O[dt][it][2] + O[dt][it][3]);
              sm += __shfl_xor(sm, 16); sm += __shfl_xor(sm, 32);
              const float mu = sm * (1.0f / 128.0f); float ss = 0.f;
#pragma unroll
              for (int dt = 0; dt < 8; ++dt) { O[dt][it] = O[dt][it] - mu; ss += (O[dt][it][0] * O[dt][it][0] + O[dt][it][1] * O[dt][it][1]) + (O[dt][it][2] * O[dt][it][2] + O[dt][it][3] * O[dt][it][3]); }
              ss += __shfl_xor(ss, 16); ss += __shfl_xor(ss, 32);
              const float rs = __builtin_amdgcn_rsqf(ss * (1.0f / 128.0f) + EPS);
#pragma unroll
              for (int dt = 0; dt < 8; ++dt) { const f32x4 y = O[dt][it] * rs;
                  u32x2 pk; pk.x = cvtpk_c(y[0], y[1]); pk.y = cvtpk_c(y[2], y[3]);
                  *(LAS u32x2*)(T + lr * 272 + 32 * dt + 8 * g) = pk; }
              asm volatile("s_waitcnt lgkmcnt(0)" ::: "memory");
#pragma unroll
              for (int h = 0; h < 2; ++h) { const int rr = 8 * h + (lane >> 3);
                  const v4u y0 = *(const LAS v4u*)(T + rr * 272 + 32 * (lane & 7)), y1 = *(const LAS v4u*)(T + rr * 272 + 32 * (lane & 7) + 16);
                  unsigned ow[8];
#pragma unroll
                  for (int k = 0; k < 8; ++k) { const unsigned yw = k < 4 ? ((const unsigned*)&y0)[k] : ((const unsigned*)&y1)[k - 4], gw = k < 4 ? ((const unsigned*)&gt[h][0])[k] : ((const unsigned*)&gt[h][1])[k - 4];
                      const float g0 = bflo(gw), g1 = bfhi(gw);
                      ow[k] = cvtpk_c((bflo(yw) * nw[k >> 1][2 * (k & 1)] + nb[k >> 1][2 * (k & 1)]) * g0 * __builtin_amdgcn_rcpf(1.0f + __expf(-g0)), (bfhi(yw) * nw[k >> 1][2 * (k & 1) + 1] + nb[k >> 1][2 * (k & 1) + 1]) * g1 * __builtin_amdgcn_rcpf(1.0f + __expf(-g1))); }
                  bf16* op = a.mo + (size_t)(sc * 256 + 32 * w + 16 * it + rr) * a.mop + 512 + 128 * hh + 16 * (lane & 7);
                  *(GAS v4u*)op = (v4u){ow[0], ow[1], ow[2], ow[3]}; *(GAS v4u*)(op + 8) = (v4u){ow[4], ow[5], ow[6], ow[7]}; }
              asm volatile("s_waitcnt lgkmcnt(0)" ::: "memory");
          } }
    }
    asm volatile("s_waitcnt vmcnt(0)" ::: "memory"); __syncthreads();
}

template <bool WITH_O>
__device__ __forceinline__ void cmix_phase(Frame& F, const CMixArgs& a, int which = 3) {
#if MIX_GLA
    if (which & 1) { if constexpr (WITH_O) mix_units<64, true, true>(F, a); else kv_units<64, true>(F, a);
    __syncthreads(); }
#endif
#if MIX_RET
    if (which & 2) { if constexpr (WITH_O) ret_units_direct(F, a); else kv_units<128, false>(F, a);
    __syncthreads(); }
#endif
}
__device__ __forceinline__ void scan_phase(Frame& F, const CMixArgs& a) {
    const int nthreads = F.G * NWAVES * 64;
    for (int chain = (int)blockIdx.x * NWAVES * 64 + F.tid; chain < 34 * 49152; chain += nthreads) {
        const int sq = chain / 49152, cidx = chain % 49152;
        const int seq = sq < 2 ? 32 + sq : sq - 2;
        const int sc0 = seq < 32 ? seq * 8 : 256 + (seq - 32) * 64, ns = seq < 32 ? 8 : 64;
        const bool gla = cidx < 16384; const int c2 = gla ? cidx : cidx - 16384;
        const int hd = gla ? (c2 >> 11) : (c2 >> 12), v = gla ? (c2 & 2047) : (c2 & 4095), hh = hd >> 1, dir = hd & 1;
        if ((gla && !MIX_GLA) || (!gla && !MIX_RET)) continue;
        const int t0 = 16 * ((v >> 6) & 3) + 4 * ((v & 63) >> 4);
        const float gret = exp2f(256.0f * log2f(1.0f - exp2f(-5.0f - (float)hh)));
        f32x4 cst = {0.f, 0.f, 0.f, 0.f};
        for (int blk = 0; blk < ns; blk += 8) {
            u32x2 kv[8]; f32x4 d[8];
#pragma unroll
            for (int j = 0; j < 8; ++j) { const int n = dir ? ns - 1 - (blk + j) : blk + j;
                kv[j] = *(const GAS u32x2*)(a.st + state_off(sc0 + n, gla, hh, dir) + (size_t)v * 8);
                d[j] = gla ? *(const GAS f32x4*)(a.dec + (size_t)(((sc0 + n) * 4 + hh) * 2 + dir) * 64 + t0) : (f32x4){gret, gret, gret, gret}; }
#pragma unroll
            for (int j = 0; j < 8; ++j) { const int n = dir ? ns - 1 - (blk + j) : blk + j;
                u32x2 pk; pk.x = cvtpk_c(cst[0], cst[1]); pk.y = cvtpk_c(cst[2], cst[3]);
                *(GAS u32x2*)(a.sto + state_off(sc0 + n, gla, hh, dir) + (size_t)v * 8) = pk;
                cst = d[j] * cst + (f32x4){bflo(kv[j].x), bfhi(kv[j].x), bflo(kv[j].y), bfhi(kv[j].y)}; }
        }
    }
}

#ifndef W2_TILED
#define W2_TILED 1
#endif
#define NAIVE_MIX (!(MIX_GLA && MIX_RET))
constexpr int PB0 = NAIVE_MIX ? 8 : 5, NPH = PB0 + 4;
struct Args { const float* in[16]; float* out; unsigned char* ws; int ph_lo, ph_hi, use_bar, pad; };
__global__ void __launch_bounds__(NWAVES * 64, 2) fwd_kernel(Args args) {
    extern __shared__ __attribute__((aligned(16))) unsigned char lds[];
    Frame F;
    F.lds = (LAS unsigned char*)lds;
    F.MISC = (volatile LAS unsigned*)(F.lds + MISC_OFF);
    F.tid = threadIdx.x; F.lane = F.tid & 63; F.wave = __builtin_amdgcn_readfirstlane(F.tid >> 6);
    F.G = gridDim.x; { const int bx = blockIdx.x; F.vcu = (F.G % 8 == 0) ? (bx % 8) * (F.G / 8) + bx / 8 : bx; }
    unsigned char* ws = args.ws;
    gu32* ctl = (gu32*)(ws + WS_CTL);
    for (int u = F.tid; u < (LDS_BYTES - LDSCTL_OFF) / 4; u += NWAVES * 64) ((LAS unsigned*)(F.lds + LDSCTL_OFF))[u] = 0u;
    __syncthreads();
    XcdBarrier bar; bar.bar = (unsigned*)(ctl + CW_BAR); bar.x = 0; bar.st = nullptr;
    if (args.use_bar) bar = xcd_barrier_post((unsigned*)(ctl + CW_BAR), F.MISC + 8);
    const int lo = args.ph_lo, hi = args.ph_hi;
#define IN(k) (lo <= (k) && (k) < hi)
#define SEAM(k) do { if (IN(k) && IN((k) + 1)) xcd_barrier(bar); } while (0)
    if (IN(0)) { const P0Args pa{args.in[0], args.in[1], args.in[2], args.in[3], args.in[11], args.in[12], args.in[13], args.in[14], (bf16*)(ws + WS_WIN), (bf16*)(ws + WS_WOUT), (bf16*)(ws + WS_W1), (bf16*)(ws + WS_W2),
            (bf16*)(ws + WS_R0), (float*)(ws + WS_ROPE), (float*)(ws + WS_ROPE) + 16384 * 64, (float*)(ws + WS_GA), (float*)(ws + WS_RSTD)};
        p0_prologue(F, pa); __syncthreads();
#if REP0
        p0_prologue(F, pa, REP0); __syncthreads();
#endif
    }
    SEAM(0);
    if (IN(1)) { pg8::Gemm g{(bf16*)(ws + WS_R0), (bf16*)(ws + WS_WIN), M_TOK, NP, D, D}; pg8::StaticOrder S; S.init(M_TOK, NP, F.G, (int)blockIdx.x);
        pg8::EpiInProj E{(bf16*)(ws + WS_R1), (float*)(ws + WS_RSTD), (float*)(ws + WS_ROPE), (float*)(ws + WS_ROPE) + 16384 * 64};
#if REP1 == 2
        { pg8::EpiPlain E2{(bf16*)(ws + WS_R1)}; pg8::gemm_phase<pg8::EpiPlain, pg8::StaticOrder, true, true>(F.lds + RING_OFF, g, S, E2); } __syncthreads();
#elif REP1 == 3
        { pg8::EpiNull E2{}; pg8::gemm_phase<pg8::EpiNull, pg8::StaticOrder, true, true>(F.lds + RING_OFF, g, S, E2); } __syncthreads();
#endif
        pg8::gemm_phase<pg8::EpiInProj, pg8::StaticOrder, true, true>(F.lds + RING_OFF, g, S, E);
#if REP1 == 1
        __syncthreads(); pg8::gemm_phase<pg8::EpiInProj, pg8::StaticOrder, true, true>(F.lds + RING_OFF, g, S, E);
#endif
    }
    SEAM(1);
    if (IN(2)) { const CMixArgs ca{(bf16*)(ws + WS_R1), (float*)(ws + WS_GA), args.in[4], args.in[5], args.in[6], args.in[7], ws + WS_ST, (float*)(ws + WS_DEC), args.in[8], args.in[9], args.in[10], (bf16*)((unsigned char*)args.out + (size_t)192 * MiB), D, ws + WS_ST, (unsigned char*)args.out, (bh16*)((unsigned char*)args.out + (size_t)96 * MiB), (bh16*)args.out, (float*)(ws + WS_DEC + 786432)};
        cmix_phase<false>(F, ca);
#if REP2
        cmix_phase<false>(F, ca, REP2);
#endif
    }
    SEAM(2);
    if (IN(3)) { const CMixArgs ca{(bf16*)(ws + WS_R1), (float*)(ws + WS_GA), args.in[4], args.in[5], args.in[6], args.in[7], ws + WS_ST, (float*)(ws + WS_DEC), args.in[8], args.in[9], args.in[10], (bf16*)((unsigned char*)args.out + (size_t)192 * MiB), D, ws + WS_ST, (unsigned char*)args.out, (bh16*)((unsigned char*)args.out + (size_t)96 * MiB), (bh16*)args.out, (float*)(ws + WS_DEC + 786432)};
#if REP3
        { CMixArgs cb = ca; cb.sto = (unsigned char*)args.out + (size_t)224 * MiB; scan_phase(F, cb); }
#endif
        scan_phase(F, ca); }
    SEAM(3);
    if (IN(4)) { const CMixArgs ca{(bf16*)(ws + WS_R1), (float*)(ws + WS_GA), args.in[4], args.in[5], args.in[6], args.in[7], ws + WS_ST, (float*)(ws + WS_DEC), args.in[8], args.in[9], args.in[10], (bf16*)((unsigned char*)args.out + (size_t)192 * MiB), D, ws + WS_ST, (unsigned char*)args.out, (bh16*)((unsigned char*)args.out + (size_t)96 * MiB), (bh16*)args.out, (float*)(ws + WS_DEC + 786432)};
#if REP4
        { CMixArgs cb = ca; cmix_phase<true>(F, cb, REP4); }
#endif
        cmix_phase<true>(F, ca); }
    SEAM(4);
#if NAIVE_MIX
    { const MixArgs ma{(bf16*)(ws + WS_R1), (float*)(ws + WS_GA), args.in[4], args.in[5], args.in[6], args.in[7], args.out, args.in[8], args.in[9], args.in[10]};
    if (IN(5)) { naive_mix_phase<false>(F, ma); __syncthreads(); }
    SEAM(5);
    if (IN(6)) { naive_mix_phase<true>(F, ma); __syncthreads(); }
    SEAM(6);
    if (IN(7)) { naive_combine(F, ma); }
    SEAM(7); }
#endif
    if (IN(PB0)) { pg8::Gemm g{(bf16*)((unsigned char*)args.out + (size_t)192 * MiB), (bf16*)(ws + WS_WOUT), M_TOK, D, D, D}; pg8::StaticOrder S; S.init(M_TOK, D, F.G, (int)blockIdx.x);
        pg8::EpiResidB2 E{(const bf16*)(ws + WS_R0), (bf16*)(ws + WS_A2), (float*)(ws + WS_SQ1)};
        pg8::gemm_phase<pg8::EpiResidB2, pg8::StaticOrder, true, true>(F.lds + RING_OFF, g, S, E);
#if REP5
        __syncthreads(); pg8::gemm_phase<pg8::EpiResidB2, pg8::StaticOrder, true, true>(F.lds + RING_OFF, g, S, E);
#endif
    }
    SEAM(PB0);
    if (IN(PB0 + 1)) {
        { const float* sq = (const float*)(ws + WS_SQ1); float* r2v = (float*)(ws + WS_RSTD);
          for (int row = (int)blockIdx.x * NWAVES * 64 + F.tid; row < M_TOK; row += F.G * NWAVES * 64) { const f32x4* s4 = (const f32x4*)(sq + (size_t)row * 16);
              const f32x4 t = (s4[0] + s4[1]) + (s4[2] + s4[3]); r2v[row] = 1.0f / (((t[0] + t[1]) + (t[2] + t[3])) * (1.0f / 1024.0f) + EPS); }
          if (args.use_bar) xcd_barrier(bar); }
        pg8::Gemm g{(bf16*)(ws + WS_A2), (bf16*)(ws + WS_W1), M_TOK, FF, D, D}; pg8::StaticOrder S; S.init(M_TOK, FF, F.G, (int)blockIdx.x);
        pg8::EpiFF1 E{(bf16*)(ws + WS_R1), (float*)(ws + WS_RSTD)};
        pg8::gemm_phase<pg8::EpiFF1, pg8::StaticOrder, true, true>(F.lds + RING_OFF, g, S, E);
#if REP6
        __syncthreads(); pg8::gemm_phase<pg8::EpiFF1, pg8::StaticOrder, true, true>(F.lds + RING_OFF, g, S, E);
#endif
    }
    SEAM(PB0 + 1);
#if H_TILED
    if (IN(PB0 + 2)) { pg8::Gemm g{(bf16*)(ws + WS_R1), (bf16*)(ws + WS_W2), M_TOK, D, FF, 64, W2_TILED ? 64 : 0, 32768, W2_TILED ? 32768 : 0, (long)FF * 512, W2_TILED ? (long)FF * 512 : 0};
#else
    if (IN(PB0 + 2)) { pg8::Gemm g{(bf16*)(ws + WS_R1), (bf16*)(ws + WS_W2), M_TOK, D, FF, FF, W2_TILED ? 64 : 0, 0, W2_TILED ? 32768 : 0, 0, W2_TILED ? (long)FF * 512 : 0};
#endif
        pg8::StaticOrder S; S.init(M_TOK, D, F.G, (int)blockIdx.x, FF2_REV);
        pg8::EpiResidB E{(bf16*)(ws + WS_A2), (float*)(ws + WS_SQ2)};
        pg8::gemm_phase<pg8::EpiResidB, pg8::StaticOrder, true, true, false, FF2_TOUCH>(F.lds + RING_OFF, g, S, E); }
    SEAM(PB0 + 2);
    if (IN(PB0 + 3)) { final_norm(F, args.out, (const bf16*)(ws + WS_A2), (float*)(ws + WS_SQ2), args.in[15]);
#if REP8
        final_norm(F, args.out, (const bf16*)(ws + WS_A2), (float*)(ws + WS_SQ2), args.in[15]);
#endif
    }
#undef IN
#undef SEAM
}

extern "C" void kernel_launch(void* const* d_in, const int* in_sizes, int n_in, void* d_out, int out_size, void* d_ws, size_t ws_size, hipStream_t stream) {
    static int grid = 0;
    if (grid == 0) {
        if (n_in != 16 || in_sizes[0] != M_PROMPT * D || out_size != M_TOK * D || ws_size < WS_END) {
            fprintf(stderr, "kernel_launch: unexpected shapes (n_in %d, in0 %d, out %d, ws %zu); nothing launched\n", n_in, n_in > 0 ? in_sizes[0] : -1, out_size, ws_size); grid = -1; return; }
        int dev = 0, cus = 0, per_cu = 0;
        if (hipGetDevice(&dev) != hipSuccess || hipDeviceGetAttribute(&cus, hipDeviceAttributeMultiprocessorCount, dev) != hipSuccess) { grid = -1; return; }
        if (hipFuncSetAttribute((const void*)fwd_kernel, hipFuncAttributeMaxDynamicSharedMemorySize, LDS_BYTES) != hipSuccess) { fprintf(stderr, "kernel_launch: hipFuncSetAttribute failed\n"); grid = -1; return; }
        if (hipOccupancyMaxActiveBlocksPerMultiprocessor(&per_cu, (const void*)fwd_kernel, NWAVES * 64, LDS_BYTES) != hipSuccess || per_cu < 1)
            fprintf(stderr, "kernel_launch: note: occupancy query reports %d workgroups per CU\n", per_cu);
        (void)hipGetLastError();
        grid = cus;
    }
    if (grid < 0) return;
    if (hipMemsetAsync((char*)d_ws + WS_CTL, 0, CTL_ZERO_BYTES, stream) != hipSuccess) return;
    Args a{};
    for (int i = 0; i < 16; ++i) a.in[i] = (const float*)d_in[i];
    a.out = (float*)d_out; a.ws = (unsigned char*)d_ws;
#if MK_SINGLE
    a.ph_lo = 0; a.ph_hi = NPH; a.use_bar = 1;
    hipLaunchKernelGGL(fwd_kernel, dim3(grid), dim3(NWAVES * 64), LDS_BYTES, stream, a);
#else
    for (int p = 0; p < NPH; ++p) { a.ph_lo = p; a.ph_hi = p + 1; a.use_bar = 0;
        hipLaunchKernelGGL(fwd_kernel, dim3(grid), dim3(NWAVES * 64), LDS_BYTES, stream, a); }
#endif
}
```

```cpp
#include <hip/hip_runtime.h>
#include <cstdio>
#ifndef MK_SINGLE
#define MK_SINGLE 1
#endif
#ifndef MIX_GLA
#define MIX_GLA 1
#define MIX_RET 1
#define REP1 0
#define REP2 0
#define REP3 0
#define REP4 0
#define REP6 0
#define DUP 0
#define ABLV 0
#define REP0 0
#define RELAX_MASK 0
#define STAG_TICKS 0
#define PROF_PHASE -1
#define PROF_A 1
#define PROF_B 2
#define PROF_BLOCK 0
#define PROF_DELAY 0
#define FF2X 0
#define LEAD_FF2 1
#define LEAD_IN 0
#define LEAD_OUT 0
#define LEAD_FF1 0
#define PROJ_ROWMAJOR 0
#define H_TILED 1
#define EPI_PLAIN_VARIANT 0
#define PROF_OA 0ull
#define PROF_OB 0ull
#define PROF_QA 25ull
#define PROF_QB 25ull
#define REP5 0
#define REP8 0
#endif
namespace pg8 {
#define PG8_LAS __attribute__((address_space(3)))
typedef unsigned short bf16_t;
typedef short bf16x8 __attribute__((ext_vector_type(8)));
typedef float f32x4 __attribute__((ext_vector_type(4)));
typedef unsigned u32x4 __attribute__((ext_vector_type(4)));
constexpr int BM = 256, BK = 64, HALF = 128, HTB = HALF * BK * 2  , STAGE_BYTES = 8 * HTB, NXCD = 8, WGM = 8;

__host__ __device__ __forceinline__ int lds_byte(int r, int c) { const int st = (r >> 4) * 2 + (c >> 5), rr = r & 15, cc = c & 31, ob = rr * 64 + cc * 2; return st * 1024 + (ob ^ (((ob >> 9) & 1) << 5)); }
__host__ __device__ __forceinline__ void stage_rc(int b, int& R, int& C) { const int st = b / 1024, sb = b % 1024, swz = sb ^ (((sb >> 9) & 1) << 5); R = (st >> 1) * 16 + swz / 64; C = (st & 1) * 32 + (swz % 64) / 2; }
__host__ __device__ __forceinline__ int perm32(int rho) { const int n = rho >> 4, i = rho & 15; return 8 * (i >> 2) + 4 * n + (i & 3); }

struct Unit { int pm, pn; };
struct Gemm { const bf16_t* A; const bf16_t* Bt; int M, N, K, lda; int ldb, ksA, ksB; long psA, psB; };

struct StaticOrder {
    int nM, nN, nwg, G, c, rev;
    __host__ __device__ void init(int M, int N, int G_, int c_, int rev_ = 0) { nM = M / BM; nN = N / BM; nwg = nM * nN; G = G_; c = c_; rev = rev_; }
    __host__ __device__ bool next(int i, Unit& u) const {
        if ((long)i * G + c >= nwg) return false;
        const long L = (long)(rev ? (nwg - 1 - c) / G - i : i) * G + c;
        int wgid = (int)L; { const int q = nwg / NXCD, r = nwg % NXCD, xcd = wgid % NXCD, off = wgid / NXCD; wgid = (xcd < r ? xcd * (q + 1) : r * (q + 1) + (xcd - r) * q) + off; }
        const int nig = WGM * nN, gid = wgid / nig, fm = gid * WGM, gsz = (nM - fm) < WGM ? (nM - fm) : WGM;
        u.pm = fm + ((wgid % nig) % gsz); u.pn = (wgid % nig) / gsz; return true;
    }
    __device__ __forceinline__ void a_ready(const Unit&) const {}
    __device__ __forceinline__ void done(const Unit&) const {}
};
struct InProjOrder {
    int x, r;
    __host__ __device__ void init(int c_) { x = c_ & 7; r = c_ >> 3; }
    __host__ __device__ bool next(int i, Unit& u) const {
        if (i >= 21) return false;
        const int gi = i / 7, ri = i % 7;
        if (ri < 6) { u.pm = x * 48 + 16 * gi + 8 * (ri & 1) + (r & 7); u.pn = 4 * (ri >> 1) + (r >> 3); }
        else { u.pm = x * 48 + 16 * gi + (r & 15); u.pn = 12 + (r >> 4); }
        return true;
    }
    __device__ __forceinline__ void a_ready(const Unit&) const {}
    __device__ __forceinline__ void done(const Unit&) const {}
};
__device__ __forceinline__ unsigned cvt_pk_bf16(float lo, float hi) { unsigned r; asm volatile("v_cvt_pk_bf16_f32 %0, %1, %2" : "=v"(r) : "v"(lo), "v"(hi)); return r; }
__device__ __forceinline__ u32x4 pack8(const f32x4& a, const f32x4& b) { u32x4 w; w.x = cvt_pk_bf16(a[0], a[1]); w.y = cvt_pk_bf16(a[2], a[3]); w.z = cvt_pk_bf16(b[0], b[1]); w.w = cvt_pk_bf16(b[2], b[3]); return w; }
#ifndef H_TILED
#define H_TILED 0
#endif
#ifndef PLANE_PAD_ROWS
#define PLANE_PAD_ROWS 64
#endif
#ifndef PROJ_ROWMAJOR
#define PROJ_ROWMAJOR 0
#endif
#ifndef RELAX_MASK
#define RELAX_MASK 0
#endif
constexpr int NPROJ = 3584, DMODEL = 1024, DFF = 4096, MPROMPT = 65536;

constexpr size_t MTOK = 98304 + PLANE_PAD_ROWS;
#if PROJ_ROWMAJOR
constexpr size_t PL_GV = 0, PL_RV = 512, PL_GQ = 1024, PL_GK = 1280, PL_GG = 1536, PL_RQ = 2048, PL_RK = 2560, PL_RG = 3072, PL_END = (size_t)98304 * 4096;
__device__ __forceinline__ size_t pl(size_t grp, int hh, size_t row, int W) { return row * 4096 + grp + (size_t)(hh * W); }
#else
constexpr size_t PL_GV = 0, PL_RV = PL_GV + 4 * MTOK * 128, PL_GQ = PL_RV + 4 * MTOK * 128, PL_GK = PL_GQ + 4 * MTOK * 64, PL_GG = PL_GK + 4 * MTOK * 64,
                 PL_RQ = PL_GG + 4 * MTOK * 128, PL_RK = PL_RQ + 4 * MTOK * 128, PL_RG = PL_RK + 4 * MTOK * 128, PL_END = PL_RG + 4 * MTOK * 128;
__device__ __forceinline__ size_t pl(size_t grp, int hh, size_t row, int W) { return grp + ((size_t)hh * MTOK + row) * (size_t)W; }
#endif
__device__ __forceinline__ void plane_of(int pn, int bj, int wc, size_t& grp, int& hh, int& W, int& col) {
    W = 128; col = 32 * wc; hh = 2 * (pn & 1) + bj;
    switch (pn >> 1) { case 0: grp = PL_GV; break; case 1: grp = PL_RV; break; case 3: grp = PL_GG; break; case 4: grp = PL_RQ; break; case 5: grp = PL_RK; break; case 6: grp = PL_RG; break;
        default: grp = (pn & 1) ? PL_GK : PL_GQ; W = 64; hh = 2 * bj + (wc >> 1); col = 32 * (wc & 1); break; }
}
struct EpiInProj {
    static constexpr bool PERM = true, AFTER_DRAIN = false, RELAX = (RELAX_MASK & 1) != 0;
    bf16_t* P; const float* rstd; const float* rcos; const float* rsin;
    __device__ __forceinline__ void operator()(const f32x4 (&acc)[2][2][4][2], const Unit& u, int wr, int wc, int fr_in, int fq_in) const {
        int fr = fr_in, fq = fq_in; asm volatile("" : "+v"(fr), "+v"(fq));
        const int row0 = u.pm * BM + wr * 64 + fr;
        const bool rot = (u.pn >= 8) && (u.pn < 12);
        const int i0 = (4 * wc + fq) * 4;
        size_t pgrp[2]; int phh[2]; int W, col;
        plane_of(u.pn, 0, wc, pgrp[0], phh[0], W, col); plane_of(u.pn, 1, wc, pgrp[1], phh[1], W, col);
        const int pos0 = row0 < MPROMPT ? (row0 & 2047) : (row0 & 16383);
        f32x4 cc = (f32x4){1.f, 1.f, 1.f, 1.f}, ss = (f32x4){0.f, 0.f, 0.f, 0.f}, cd16 = cc, sd16 = ss, cd80 = cc, sd80 = ss;
        if (rot) {
            cc = *(const f32x4*)(rcos + pos0 * 64 + i0); ss = *(const f32x4*)(rsin + pos0 * 64 + i0);
            cd16 = *(const f32x4*)(rcos + 16 * 64 + i0); sd16 = *(const f32x4*)(rsin + 16 * 64 + i0); cd80 = *(const f32x4*)(rcos + 80 * 64 + i0); sd80 = *(const f32x4*)(rsin + 80 * 64 + i0); }
        float rs[2][4];
#pragma unroll
        for (int ai = 0; ai < 2; ++ai)
#pragma unroll
            for (int m = 0; m < 4; ++m) rs[ai][m] = rstd[row0 + ai * HALF + m * 16];
        __builtin_amdgcn_sched_barrier(0);
        const f32x4 cc0 = cc, ss0 = ss;
#pragma unroll
        for (int bj = 0; bj < 2; ++bj) {
            cc = cc0; ss = ss0;
#pragma unroll
            for (int ai = 0; ai < 2; ++ai)
#pragma unroll
                for (int m = 0; m < 4; ++m) {
                    const int row = row0 + ai * HALF + m * 16;
                    f32x4 v0 = acc[ai][bj][m][0] * rs[ai][m], v1 = acc[ai][bj][m][1] * rs[ai][m];
                    if (rot) { const f32x4 lo = v0 * cc - v1 * ss, hi = v0 * ss + v1 * cc; v0 = lo; v1 = hi; }
                    *(u32x4*)(P + pl(pgrp[bj], phh[bj], (size_t)row, W) + col + 8 * fq) = pack8(v0, v1);
                    if (rot && !(ai == 1 && m == 3)) { const f32x4 cd = m == 3 ? cd80 : cd16, sd = m == 3 ? sd80 : sd16; const f32x4 nc = cc * cd - ss * sd, ns = ss * cd + cc * sd; cc = nc; ss = ns; }
                }
        }
    }
};
struct EpiResid {
    static constexpr bool PERM = true, AFTER_DRAIN = false, RELAX = false;
    const float* xp; const float* xs; float* out; bf16_t* A2; float* sq;
    __device__ __forceinline__ void operator()(const f32x4 (&acc)[2][2][4][2], const Unit& u, int wr, int wc, int fr_in, int fq_in) const {
        int fr = fr_in, fq = fq_in; asm volatile("" : "+v"(fr), "+v"(fq));
        const int row0 = u.pm * BM + wr * 64 + fr, colb = u.pn * BM + wc * 32 + 8 * fq;
#pragma unroll
        for (int ai = 0; ai < 2; ++ai)
#pragma unroll
            for (int m = 0; m < 4; ++m) {
                const int row = row0 + ai * HALF + m * 16;
                const float* xrow = (row < MPROMPT ? xp + (size_t)row * DMODEL : xs + (size_t)(row - MPROMPT) * DMODEL) + colb;
                float* orow = out + (size_t)row * DMODEL + colb;
                float ss = 0.f;
#pragma unroll
                for (int bj = 0; bj < 2; ++bj) {
                    const f32x4 x0 = *(const f32x4*)(xrow + bj * HALF), x1 = *(const f32x4*)(xrow + bj * HALF + 4);
                    const f32x4 v0 = acc[ai][bj][m][0] + x0, v1 = acc[ai][bj][m][1] + x1;
                    *(f32x4*)(orow + bj * HALF) = v0; *(f32x4*)(orow + bj * HALF + 4) = v1;
                    if (A2) *(u32x4*)(A2 + (size_t)row * DMODEL + colb + bj * HALF) = pack8(v0, v1);
                    ss += (v0[0] * v0[0] + v0[1] * v0[1]) + (v0[2] * v0[2] + v0[3] * v0[3]) + (v1[0] * v1[0] + v1[1] * v1[1]) + (v1[2] * v1[2] + v1[3] * v1[3]);
                }
                ss += __shfl_xor(ss, 16); ss += __shfl_xor(ss, 32);
                if (fq == 0) sq[(size_t)row * 16 + u.pn * 4 + wc] = ss;
            }
    }
};
struct EpiFF1 {
    static constexpr bool PERM = true, AFTER_DRAIN = false, RELAX = (RELAX_MASK & 4) != 0;
    bf16_t* H; const float* r2v;
    __device__ __forceinline__ void operator()(const f32x4 (&acc)[2][2][4][2], const Unit& u, int wr, int wc, int fr_in, int fq_in) const {
        int fr = fr_in, fq = fq_in; asm volatile("" : "+v"(fr), "+v"(fq));
        const int row0 = u.pm * BM + wr * 64 + fr, colb = u.pn * BM + wc * 32 + 8 * fq;
        float r2[2][4];
#pragma unroll
        for (int ai = 0; ai < 2; ++ai)
#pragma unroll
            for (int m = 0; m < 4; ++m) r2[ai][m] = r2v[row0 + ai * HALF + m * 16];
        __builtin_amdgcn_sched_barrier(0);
#pragma unroll
        for (int ai = 0; ai < 2; ++ai)
#pragma unroll
            for (int m = 0; m < 4; ++m) {
                const int row = row0 + ai * HALF + m * 16;
#if H_TILED
                bf16_t* rowp = H + ((size_t)u.pm * (DFF / 64) + (size_t)(u.pn * 4 + (wc >> 1))) * (256 * 64) + (size_t)(wr * 64 + fr + ai * HALF + m * 16) * 64 + (wc & 1) * 32 + 8 * fq;
#else
                bf16_t* rowp = H + (size_t)row * DFF + colb;
#endif
#pragma unroll
                for (int bj = 0; bj < 2; ++bj) {
                    f32x4 v0 = acc[ai][bj][m][0], v1 = acc[ai][bj][m][1];
#pragma unroll
                    for (int j = 0; j < 4; ++j) { const float a = fmaxf(v0[j], 0.f), b = fmaxf(v1[j], 0.f); v0[j] = a * a * r2[ai][m]; v1[j] = b * b * r2[ai][m]; }
                    *(u32x4*)(rowp + bj * (H_TILED ? 2 * 256 * 64 : HALF)) = pack8(v0, v1);
                }
            }
    }
};

struct EpiPlain {
    static constexpr bool PERM = true, AFTER_DRAIN = false, RELAX = false;
    bf16_t* P;
    __device__ __forceinline__ void operator()(const f32x4 (&acc)[2][2][4][2], const Unit& u, int wr, int wc, int fr_in, int fq_in) const {
        int fr = fr_in, fq = fq_in; asm volatile("" : "+v"(fr), "+v"(fq));
        const int row0 = u.pm * BM + wr * 64 + fr;
        size_t pgrp[2]; int phh[2]; int W, col;
        plane_of(u.pn, 0, wc, pgrp[0], phh[0], W, col); plane_of(u.pn, 1, wc, pgrp[1], phh[1], W, col);
#pragma unroll
        for (int ai = 0; ai < 2; ++ai)
#pragma unroll
            for (int m = 0; m < 4; ++m) { const int row = row0 + ai * HALF + m * 16;
#pragma unroll
                for (int bj = 0; bj < 2; ++bj) *(u32x4*)(P + pl(pgrp[bj], phh[bj], (size_t)row, W) + col + 8 * fq) = pack8(acc[ai][bj][m][0], acc[ai][bj][m][1]); }
    }
};

struct EpiResidX {
    static constexpr bool PERM = true, AFTER_DRAIN = false, RELAX = (RELAX_MASK & 2) != 0;
    const float* xp; const float* xs; bf16_t* A2; float* sq;
    __device__ __forceinline__ void operator()(const f32x4 (&acc)[2][2][4][2], const Unit& u, int wr, int wc, int fr_in, int fq_in) const {
        int fr = fr_in, fq = fq_in; asm volatile("" : "+v"(fr), "+v"(fq));
        const int row0 = u.pm * BM + wr * 64 + fr, colb = u.pn * BM + wc * 32 + 8 * fq;
#pragma unroll
        for (int ai = 0; ai < 2; ++ai) {
            f32x4 xv[4][2][2];
#pragma unroll
            for (int m = 0; m < 4; ++m) { const int row = row0 + ai * HALF + m * 16;
                const float* xrow = (row < MPROMPT ? xp + (size_t)row * DMODEL : xs + (size_t)(row - MPROMPT) * DMODEL) + colb;
#pragma unroll
                for (int bj = 0; bj < 2; ++bj) { xv[m][bj][0] = *(const f32x4*)(xrow + bj * HALF); xv[m][bj][1] = *(const f32x4*)(xrow + bj * HALF + 4); } }
            __builtin_amdgcn_sched_barrier(0);
#pragma unroll
            for (int m = 0; m < 4; ++m) {
                const int row = row0 + ai * HALF + m * 16;
                float ss = 0.f;
#pragma unroll
                for (int bj = 0; bj < 2; ++bj) {
                    const f32x4 v0 = acc[ai][bj][m][0] + xv[m][bj][0], v1 = acc[ai][bj][m][1] + xv[m][bj][1];
                    *(u32x4*)(A2 + (size_t)row * DMODEL + colb + bj * HALF) = pack8(v0, v1);
                    ss += (v0[0] * v0[0] + v0[1] * v0[1]) + (v0[2] * v0[2] + v0[3] * v0[3]) + (v1[0] * v1[0] + v1[1] * v1[1]) + (v1[2] * v1[2] + v1[3] * v1[3]);
                }
                ss += __shfl_xor(ss, 16); ss += __shfl_xor(ss, 32);
                if (fq == 0) sq[(size_t)row * 16 + u.pn * 4 + wc] = ss;
            }
            __builtin_amdgcn_sched_barrier(0);
        }
    }
};
struct EpiResidB {
    static constexpr bool PERM = true, AFTER_DRAIN = false, RELAX = (RELAX_MASK & 8) != 0;
    bf16_t* A2; float* sq;
    __device__ __forceinline__ void operator()(const f32x4 (&acc)[2][2][4][2], const Unit& u, int wr, int wc, int fr_in, int fq_in) const {
        int fr = fr_in, fq = fq_in; asm volatile("" : "+v"(fr), "+v"(fq));
        const int row0 = u.pm * BM + wr * 64 + fr, colb = u.pn * BM + wc * 32 + 8 * fq;
        u32x4 xw[2][4][2];
#pragma unroll
        for (int ai = 0; ai < 2; ++ai)
#pragma unroll
            for (int m = 0; m < 4; ++m)
#pragma unroll
                for (int bj = 0; bj < 2; ++bj) xw[ai][m][bj] = *(const u32x4*)(A2 + (size_t)(row0 + ai * HALF + m * 16) * DMODEL + colb + bj * HALF);
        __builtin_amdgcn_sched_barrier(0);
#pragma unroll
        for (int ai = 0; ai < 2; ++ai)
#pragma unroll
            for (int m = 0; m < 4; ++m) {
                const int row = row0 + ai * HALF + m * 16;
                bf16_t* xr = A2 + (size_t)row * DMODEL + colb;
                float ss = 0.f;
#pragma unroll
                for (int bj = 0; bj < 2; ++bj) {
                    const u32x4 w_ = xw[ai][m][bj];
                    const f32x4 x0 = {__uint_as_float(w_.x << 16), __uint_as_float(w_.x & 0xffff0000u), __uint_as_float(w_.y << 16), __uint_as_float(w_.y & 0xffff0000u)};
                    const f32x4 x1 = {__uint_as_float(w_.z << 16), __uint_as_float(w_.z & 0xffff0000u), __uint_as_float(w_.w << 16), __uint_as_float(w_.w & 0xffff0000u)};
                    const f32x4 v0 = acc[ai][bj][m][0] + x0, v1 = acc[ai][bj][m][1] + x1;
                    *(u32x4*)(xr + bj * HALF) = pack8(v0, v1);
                    ss += (v0[0] * v0[0] + v0[1] * v0[1]) + (v0[2] * v0[2] + v0[3] * v0[3]) + (v1[0] * v1[0] + v1[1] * v1[1]) + (v1[2] * v1[2] + v1[3] * v1[3]);
                }
                ss += __shfl_xor(ss, 16); ss += __shfl_xor(ss, 32);
                if (fq == 0) sq[(size_t)row * 16 + u.pn * 4 + wc] = ss;
            }
    }
};

struct EpiResidB2 {
    static constexpr bool PERM = true, AFTER_DRAIN = false, RELAX = (RELAX_MASK & 8) != 0;
    const bf16_t* X; bf16_t* A2; float* sq;
    __device__ __forceinline__ void operator()(const f32x4 (&acc)[2][2][4][2], const Unit& u, int wr, int wc, int fr_in, int fq_in) const {
        int fr = fr_in, fq = fq_in; asm volatile("" : "+v"(fr), "+v"(fq));
        const int row0 = u.pm * BM + wr * 64 + fr, colb = u.pn * BM + wc * 32 + 8 * fq;
        u32x4 xw[2][4][2];
#pragma unroll
        for (int ai = 0; ai < 2; ++ai)
#pragma unroll
            for (int m = 0; m < 4; ++m)
#pragma unroll
                for (int bj = 0; bj < 2; ++bj) xw[ai][m][bj] = *(const u32x4*)(X + (size_t)(row0 + ai * HALF + m * 16) * DMODEL + colb + bj * HALF);
        __builtin_amdgcn_sched_barrier(0);
#pragma unroll
        for (int ai = 0; ai < 2; ++ai)
#pragma unroll
            for (int m = 0; m < 4; ++m) {
                const int row = row0 + ai * HALF + m * 16;
                bf16_t* xr = A2 + (size_t)row * DMODEL + colb;
                float ss = 0.f;
#pragma unroll
                for (int bj = 0; bj < 2; ++bj) {
                    const u32x4 w_ = xw[ai][m][bj];
                    const f32x4 x0 = {__uint_as_float(w_.x << 16), __uint_as_float(w_.x & 0xffff0000u), __uint_as_float(w_.y << 16), __uint_as_float(w_.y & 0xffff0000u)};
                    const f32x4 x1 = {__uint_as_float(w_.z << 16), __uint_as_float(w_.z & 0xffff0000u), __uint_as_float(w_.w << 16), __uint_as_float(w_.w & 0xffff0000u)};
                    const f32x4 v0 = acc[ai][bj][m][0] + x0, v1 = acc[ai][bj][m][1] + x1;
                    *(u32x4*)(xr + bj * HALF) = pack8(v0, v1);
                    ss += (v0[0] * v0[0] + v0[1] * v0[1]) + (v0[2] * v0[2] + v0[3] * v0[3]) + (v1[0] * v1[0] + v1[1] * v1[1]) + (v1[2] * v1[2] + v1[3] * v1[3]);
                }
                ss += __shfl_xor(ss, 16); ss += __shfl_xor(ss, 32);
                if (fq == 0) sq[(size_t)row * 16 + u.pn * 4 + wc] = ss;
            }
    }
};

struct EpiNull {
    static constexpr bool PERM = true, AFTER_DRAIN = false, RELAX = false;
    __device__ __forceinline__ void operator()(const f32x4 (&acc)[2][2][4][2], const Unit& u, int wr, int wc, int fr_in, int fq_in) const {
        int fr = fr_in, fq = fq_in; asm volatile("" : "+v"(fr), "+v"(fq));
#pragma unroll
        for (int ai = 0; ai < 2; ++ai)
#pragma unroll
            for (int m = 0; m < 4; ++m)
#pragma unroll
                for (int bj = 0; bj < 2; ++bj) asm volatile("" :: "v"(acc[ai][bj][m][0]), "v"(acc[ai][bj][m][1]));
    }
};
template <class Epi, class Sched, bool ALIGN_EPI = false, bool SP2 = false, bool PROF = false, int TOUCH = 0>
__device__ __forceinline__ void gemm_phase(PG8_LAS unsigned char* lds, const Gemm g, const Sched& S, const Epi& E) {
    const int tid = threadIdx.x, wid = __builtin_amdgcn_readfirstlane(tid >> 6), lane = tid & 63, wr = wid >> 2, wc = wid & 3, fr = lane & 15, fq = lane >> 4;
    const int K = g.K, nt = K / BK, ldb = g.ldb ? g.ldb : K;
    unsigned voffA[2], voffB[2];
#pragma unroll
    for (int i = 0; i < 2; ++i) { int R, C; stage_rc(tid * 16 + i * 8192, R, C); const int Rb = Epi::PERM ? ((R & ~31) + perm32(R & 31)) : R;
        voffA[i] = (unsigned)(R * g.lda + C) * 2u; voffB[i] = (unsigned)(Rb * ldb + C) * 2u; }
    const size_t kstepA = g.ksA ? (size_t)g.ksA : (size_t)(BK * 2), kstepB = g.ksB ? (size_t)g.ksB : (size_t)(BK * 2);
    const size_t hstepB = (size_t)HALF * ldb * 2, hstepA = (size_t)HALF * g.lda * 2;
    const size_t tstepB = g.psB ? (size_t)g.psB : 2 * hstepB, tstepA = g.psA ? (size_t)g.psA : 2 * hstepA;
    const unsigned ldsw = (unsigned)wid * 1024u;
    const int aoff = lds_byte(wr * 64 + fr, fq * 8), boff = lds_byte(wc * 32 + fr, fq * 8);
#define PG8_SA(b, h) (((b) * 2 + (h)) * HTB)
#define PG8_SB(b, h) ((4 + (b) * 2 + (h)) * HTB)
#define PG8_STAGE(bufoff, gbase, voff) do { _Pragma("unroll") for (int _i = 0; _i < 2; ++_i) \
        __builtin_amdgcn_global_load_lds((const unsigned*)((const char*)(gbase) + (voff)[_i]), (PG8_LAS unsigned*)(lds + (bufoff) + ldsw + _i * 8192), 16, 0, 0); } while (0)
#define PG8_LDA(dst, b, h) do { _Pragma("unroll") for (int m = 0; m < 4; ++m) _Pragma("unroll") for (int k = 0; k < 2; ++k) dst[m][k] = *(const PG8_LAS bf16x8*)(lds + PG8_SA(b, h) + aoff + m * 2048 + k * 1024); } while (0)
#define PG8_LDB(dst, b, h) do { _Pragma("unroll") for (int n = 0; n < 2; ++n) _Pragma("unroll") for (int k = 0; k < 2; ++k) dst[n][k] = *(const PG8_LAS bf16x8*)(lds + PG8_SB(b, h) + boff + n * 2048 + k * 1024); } while (0)
#define PG8_MMA(ai, bj, At, Bt) do { __builtin_amdgcn_s_setprio(1); _Pragma("unroll") for (int m = 0; m < 4; ++m) _Pragma("unroll") for (int n = 0; n < 2; ++n) _Pragma("unroll") for (int k = 0; k < 2; ++k) \
        acc[ai][bj][m][n] = __builtin_amdgcn_mfma_f32_16x16x32_bf16(Bt[n][k], At[m][k], acc[ai][bj][m][n], 0, 0, 0); __builtin_amdgcn_s_setprio(0); } while (0)
#define PG8_WAIT_V(n) asm volatile("s_waitcnt vmcnt(" #n ")" ::: "memory")
#define PG8_WAIT_L(n) asm volatile("s_waitcnt lgkmcnt(" #n ")" ::: "memory")
#define PG8_WAIT_VF(first, nrel) asm volatile("s_cmp_lg_u32 %0, 0\n\ts_cbranch_scc1 1f\n\ts_waitcnt vmcnt(8)\n\ts_branch 2f\n1:\n\ts_waitcnt vmcnt(" #nrel ")\n2:" :: "s"(first) : "memory", "scc")
#define PG8_BAR __builtin_amdgcn_s_barrier()
#define PG8_SCHED __builtin_amdgcn_sched_barrier(0)
    Unit cur, nxt; int ui = 0;
    if (!S.next(0, cur)) return;
    f32x4 acc[2][2][4][2];
#pragma unroll
    for (int a = 0; a < 2; ++a)
#pragma unroll
        for (int b = 0; b < 2; ++b)
#pragma unroll
            for (int m = 0; m < 4; ++m)
#pragma unroll
                for (int n = 0; n < 2; ++n) acc[a][b][m][n] = (f32x4){0.f, 0.f, 0.f, 0.f};
    bf16x8 At[4][2], B0[2][2], B1[2][2];
    const char* cA = (const char*)g.A + (size_t)cur.pm * tstepA; const char* cB = (const char*)g.Bt + (size_t)cur.pn * tstepB;
    S.a_ready(cur);
    if constexpr (SP2) {
        PG8_STAGE(PG8_SB(0, 0), cB, voffB); PG8_STAGE(PG8_SB(0, 1), cB + hstepB, voffB); PG8_STAGE(PG8_SA(0, 0), cA, voffA); PG8_STAGE(PG8_SA(0, 1), cA + hstepA, voffA);
        if (wr == 1) PG8_BAR;
        PG8_WAIT_V(2); PG8_BAR;
        PG8_STAGE(PG8_SB(1, 0), cB + kstepB, voffB); PG8_STAGE(PG8_SA(1, 0), cA + kstepA, voffA); PG8_STAGE(PG8_SB(1, 1), cB + hstepB + kstepB, voffB); PG8_STAGE(PG8_SA(1, 1), cA + hstepA + kstepA, voffA);
        PG8_WAIT_V(8); PG8_BAR;
    } else {
        PG8_STAGE(PG8_SB(0, 0), cB, voffB); PG8_STAGE(PG8_SA(0, 0), cA, voffA); PG8_STAGE(PG8_SB(0, 1), cB + hstepB, voffB); PG8_STAGE(PG8_SA(0, 1), cA + hstepA, voffA);
        if (wr == 1) PG8_BAR;
        PG8_WAIT_V(4); PG8_BAR;
        PG8_STAGE(PG8_SB(1, 0), cB + kstepB, voffB); PG8_STAGE(PG8_SA(1, 0), cA + kstepA, voffA); PG8_STAGE(PG8_SB(1, 1), cB + hstepB + kstepB, voffB);
        PG8_WAIT_V(6); PG8_BAR;
    }
    for (;;) {
        const bool has_next = S.next(ui + 1, nxt);
        const char* nA = has_next ? (const char*)g.A + (size_t)nxt.pm * tstepA : cA; const char* nB = has_next ? (const char*)g.Bt + (size_t)nxt.pn * tstepB : cB;
        for (int t = 0; t < nt; t += 2) {
            const bool last = (t == nt - 2);
            const char* a1 = cA + (size_t)(t + 1) * kstepA;
            const char* a2 = last ? nA : cA + (size_t)(t + 2) * kstepA; const char* b2 = last ? nB : cB + (size_t)(t + 2) * kstepB;
            const char* a3 = a2 + kstepA; const char* b3 = b2 + kstepB;
            if (last && has_next) S.a_ready(nxt);
            if constexpr (SP2) {
            const int first = __builtin_amdgcn_readfirstlane((t == 0 && ui > 0) ? 1 : 0);
            PG8_LDB(B0, 0, 0); PG8_LDB(B1, 0, 1); PG8_SCHED; PG8_LDA(At, 0, 0);
            PG8_WAIT_VF(first, 16); PG8_WAIT_L(0); PG8_BAR; PG8_MMA(0, 0, At, B0); PG8_MMA(0, 1, At, B1); PG8_BAR; PG8_SCHED;
            PG8_LDA(At, 0, 1); PG8_STAGE(PG8_SB(0, 0), b2, voffB); PG8_STAGE(PG8_SB(0, 1), b2 + hstepB, voffB); PG8_STAGE(PG8_SA(0, 0), a2, voffA);
            PG8_WAIT_VF(first, 22); PG8_WAIT_L(0); PG8_BAR; PG8_MMA(1, 0, At, B0); PG8_MMA(1, 1, At, B1); PG8_BAR; PG8_SCHED;
            PG8_LDB(B0, 1, 0); PG8_LDB(B1, 1, 1); PG8_SCHED; PG8_LDA(At, 1, 0); PG8_STAGE(PG8_SA(0, 1), a2 + hstepA, voffA);
            PG8_WAIT_VF(first, 24); PG8_WAIT_L(0); PG8_BAR; PG8_MMA(0, 0, At, B0); PG8_MMA(0, 1, At, B1); PG8_BAR; PG8_SCHED;
            PG8_LDA(At, 1, 1); PG8_STAGE(PG8_SB(1, 0), b3, voffB); PG8_STAGE(PG8_SB(1, 1), b3 + hstepB, voffB); PG8_STAGE(PG8_SA(1, 0), a3, voffA);
            PG8_WAIT_V(8); PG8_WAIT_L(0); PG8_BAR; PG8_MMA(1, 0, At, B0); PG8_MMA(1, 1, At, B1); PG8_BAR; PG8_SCHED;
            PG8_STAGE(PG8_SA(1, 1), a3 + hstepA, voffA);
            if constexpr (TOUCH != 0) { if (t == 0 && has_next) {
                __builtin_amdgcn_global_load_lds((const unsigned*)(nA + ((size_t)tid << 12) % tstepA), (PG8_LAS unsigned*)(lds + STAGE_BYTES + wid * 256), 4, 0, 0);
                if (TOUCH > 1) __builtin_amdgcn_global_load_lds((const unsigned*)(nB + ((size_t)tid << 12) % tstepB), (PG8_LAS unsigned*)(lds + STAGE_BYTES + 2048 + wid * 256), 4, 0, 0); } }
            } else {
            PG8_LDB(B0, 0, 0); PG8_SCHED; PG8_LDA(At, 0, 0); PG8_STAGE(PG8_SA(1, 1), a1 + hstepA, voffA);
            PG8_WAIT_L(8); PG8_BAR; PG8_WAIT_L(0); PG8_MMA(0, 0, At, B0); PG8_BAR; PG8_SCHED;
            PG8_LDB(B1, 0, 1); PG8_STAGE(PG8_SB(0, 0), b2, voffB);
            PG8_BAR; PG8_WAIT_L(0); PG8_MMA(0, 1, At, B1); PG8_BAR;
            PG8_LDA(At, 0, 1); PG8_STAGE(PG8_SA(0, 0), a2, voffA);
            PG8_BAR; PG8_WAIT_L(0); PG8_MMA(1, 0, At, B0); PG8_BAR; PG8_SCHED;
            PG8_STAGE(PG8_SB(0, 1), b2 + hstepB, voffB);
            PG8_WAIT_V(6); PG8_BAR; PG8_MMA(1, 1, At, B1); PG8_BAR;
            PG8_LDB(B0, 1, 0); PG8_SCHED; PG8_LDA(At, 1, 0); PG8_STAGE(PG8_SA(0, 1), a2 + hstepA, voffA);
            PG8_WAIT_L(8); PG8_BAR; PG8_WAIT_L(0); PG8_MMA(0, 0, At, B0); PG8_BAR; PG8_SCHED;
            PG8_LDB(B1, 1, 1); PG8_STAGE(PG8_SB(1, 0), b3, voffB);
            PG8_BAR; PG8_WAIT_L(0); PG8_MMA(0, 1, At, B1); PG8_BAR;
            PG8_LDA(At, 1, 1); PG8_STAGE(PG8_SA(1, 0), a3, voffA);
            PG8_BAR; PG8_WAIT_L(0); PG8_MMA(1, 0, At, B0); PG8_BAR; PG8_SCHED;
            PG8_STAGE(PG8_SB(1, 1), b3 + hstepB, voffB);
            PG8_WAIT_V(6); PG8_BAR; PG8_MMA(1, 1, At, B1); PG8_BAR;
            }
        }
        if constexpr (ALIGN_EPI) { if (wr == 0) PG8_BAR; }
        if constexpr (!Epi::AFTER_DRAIN) { E(acc, cur, wr, wc, fr, fq); S.done(cur); }
        if (!has_next) break;
#pragma unroll
        for (int a = 0; a < 2; ++a)
#pragma unroll
            for (int b = 0; b < 2; ++b)
#pragma unroll
                for (int m = 0; m < 4; ++m)
#pragma unroll
                    for (int n = 0; n < 2; ++n) acc[a][b][m][n] = (f32x4){0.f, 0.f, 0.f, 0.f};
        cur = nxt; cA = nA; cB = nB; ++ui;
        if constexpr (ALIGN_EPI) { if (wr == 1) PG8_BAR; }
    }
    PG8_WAIT_V(0);
    if constexpr (!ALIGN_EPI) { if (wr == 0) PG8_BAR; }
    PG8_BAR;
    if constexpr (Epi::AFTER_DRAIN) { E.fused(acc, cur, wr, wc, fr, fq, lds, wid, lane); S.done(cur); }
#undef PG8_SA
#undef PG8_SB
#undef PG8_STAGE
#undef PG8_LDA
#undef PG8_LDB
#undef PG8_MMA
#undef PG8_WAIT_V
#undef PG8_WAIT_L
#undef PG8_WAIT_VF
#undef PG8_BAR
#undef PG8_SCHED
}
}
#define GAS __attribute__((address_space(1)))
#define LAS __attribute__((address_space(3)))
typedef unsigned short bf16;
typedef unsigned v4u __attribute__((ext_vector_type(4)));
typedef float f32x4 __attribute__((ext_vector_type(4)));
typedef short bf16x8 __attribute__((ext_vector_type(8)));
typedef GAS unsigned gu32;
typedef GAS unsigned long long gu64;
#define RLX_AGENT __ATOMIC_RELAXED, __HIP_MEMORY_SCOPE_AGENT
#define LDS_WAIT() asm volatile("s_waitcnt lgkmcnt(0)" ::: "memory")
#define VM_WAIT() asm volatile("s_waitcnt vmcnt(0)" ::: "memory")
__device__ __forceinline__ unsigned long long rt() { return __builtin_amdgcn_s_memrealtime(); }
__device__ __forceinline__ unsigned f2bf(float f) { unsigned u = __builtin_bit_cast(unsigned, f); return (u + 0x7fffu + ((u >> 16) & 1u)) >> 16; }
__device__ __forceinline__ unsigned pk2(float lo, float hi) { return f2bf(lo) | (f2bf(hi) << 16); }

#define XB_TMO      128
#define XB_XCNT(j)  (256  + 64 * (j))
#define XB_XSUB(j)  (1280 + 64 * (j))
#define XB_XGEN(j)  (2304 + 64 * (j))
#define XB_TOP      3328
#define XB_TOPGEN   3392
#define XCD_BAR_WORDS 3456
#define XB_SPIN_CAP (1u << 18)

__device__ __forceinline__ unsigned xb_ld(unsigned* p)              { return __hip_atomic_load(p, __ATOMIC_RELAXED, __HIP_MEMORY_SCOPE_AGENT); }
__device__ __forceinline__ unsigned xb_add(unsigned* p, unsigned v) { return __hip_atomic_fetch_add(p, v, __ATOMIC_RELAXED, __HIP_MEMORY_SCOPE_AGENT); }
__device__ __forceinline__ unsigned xb_xcc_id() { return (unsigned)__builtin_amdgcn_s_getreg((3 << 11) | 20) & 0xFu; }
#define XB_SPIN(cond, bar) do { unsigned _sp = 0; while (cond) { __builtin_amdgcn_s_sleep(1); \
    if ((++_sp & 255u) == 0u) { if (xb_ld(&(bar)[XB_TMO])) break; if (_sp > XB_SPIN_CAP) { atomicAdd(&(bar)[XB_TMO], 1u); break; } } } } while (0)

struct XcdBarrier {
    unsigned* bar; unsigned x;
    volatile LAS unsigned* st;
};

__device__ __forceinline__ XcdBarrier xcd_barrier_post(unsigned* bar, volatile LAS unsigned* st) {
    XcdBarrier b; b.bar = bar; b.x = xb_xcc_id(); b.st = st;
    if (threadIdx.x == 0) (void)xb_add(&bar[XB_XCNT(b.x)], 1u);
    return b;
}
__device__ __forceinline__ void xcd_barrier_complete(unsigned* bar, unsigned x, unsigned& nloc, unsigned& nx) {
    const unsigned G = gridDim.x * gridDim.y * gridDim.z;
    unsigned sum, cnt, mine, sp = 0u;
    for (;;) {
        sum = 0u; cnt = 0u; mine = 0u;
#pragma unroll
        for (unsigned j = 0; j < 16; ++j) { const unsigned c = xb_ld(&bar[XB_XCNT(j)]); sum += c; cnt += (c > 0u) ? 1u : 0u; mine = (j == x) ? c : mine; }
        if (sum == G) break;
        __builtin_amdgcn_s_sleep(1);
        if ((++sp & 255u) == 0u) { if (xb_ld(&bar[XB_TMO])) break; if (sp > XB_SPIN_CAP) { atomicAdd(&bar[XB_TMO], 1u); break; } }
    }
    nloc = mine > 0u ? mine : 1u; nx = cnt > 0u ? cnt : 1u;
}

__device__ __forceinline__ void xcd_barrier(const XcdBarrier& b) {
    asm volatile("s_waitcnt vmcnt(0)" ::: "memory");
    __syncthreads();
    if (threadIdx.x == 0) {
        unsigned* bar = b.bar;
        __builtin_amdgcn_s_waitcnt(0);
        unsigned nloc = b.st[0], nx = b.st[1];
        if (nloc == 0u) { xcd_barrier_complete(bar, b.x, nloc, nx); b.st[0] = nloc; b.st[1] = nx; }
        const unsigned old = xb_add(&bar[XB_XSUB(b.x)], 1u);
        const unsigned gen = old / nloc;
        if (old + 1u == (gen + 1u) * nloc) {
            __builtin_amdgcn_fence(__ATOMIC_RELEASE, "agent");
            asm volatile("s_waitcnt vmcnt(0)" ::: "memory");
            const unsigned og = xb_add(&bar[XB_TOP], 1u);
            const unsigned tg = og / nx;
            if (og + 1u == (tg + 1u) * nx) xb_add(&bar[XB_TOPGEN], 1u);
            else XB_SPIN(xb_ld(&bar[XB_TOPGEN]) == tg, bar);
            __builtin_amdgcn_fence(__ATOMIC_ACQUIRE, "agent");
            xb_add(&bar[XB_XGEN(b.x)], 1u);
            asm volatile("s_waitcnt vmcnt(0)" ::: "memory");
        } else {
            XB_SPIN(xb_ld(&bar[XB_XGEN(b.x)]) == gen, bar);
            __builtin_amdgcn_fence(__ATOMIC_ACQUIRE, "agent");
            asm volatile("s_waitcnt vmcnt(0)" ::: "memory");
        }
    }
    __syncthreads();
}
#ifndef MIX_SWAP
#define MIX_SWAP 1
#endif
#ifndef FF2_TOUCH
#define FF2_TOUCH 2
#endif
#ifndef FF2_REV
#define FF2_REV 1
#endif
#ifndef W2_TILED
#define W2_TILED 1
#endif
constexpr int NWAVES = 8;
constexpr int M_TOK = 98304, M_PROMPT = 65536, D = 1024, NP = 3584, NWIN = 3616, FF = 4096;
constexpr int L_PROMPT = 2048, L_SAMPLE = 16384;
constexpr float EPS = 1e-6f;
constexpr size_t MiB = 1u << 20;
constexpr size_t WS_CTL = 0, CTL_ZERO_BYTES = 1 * MiB;
constexpr size_t WS_WIN = 1 * MiB;
constexpr size_t WS_WOUT = 9 * MiB;
constexpr size_t WS_W1 = 11 * MiB;
constexpr size_t WS_W2 = 19 * MiB;
constexpr size_t WS_ROPE = 27 * MiB;
constexpr size_t WS_GA = 35 * MiB;
constexpr size_t WS_RSTD = 47 * MiB;
constexpr size_t WS_SQ1 = 48 * MiB;
constexpr size_t WS_SQ2 = 54 * MiB;
constexpr size_t WS_DEC = 60 * MiB;
constexpr size_t WS_R0 = 64 * MiB;
constexpr size_t WS_R1 = 256 * MiB;
constexpr size_t WS_ST = 1024 * MiB;
constexpr size_t WS_A2 = 1216 * MiB;
constexpr size_t WS_END = 1408 * MiB;
constexpr int CW_BAR = 4096;
constexpr int RING_OFF = 0, RING_BYTES = 131072;
constexpr int LDSCTL_OFF = 147456 - 1024, MISC_OFF = LDSCTL_OFF + 320;
constexpr int LDS_BYTES = 147456;

struct Frame {
    LAS unsigned char* lds;
    volatile LAS unsigned* MISC;
    int tid, lane, wave, vcu, G;
};
__device__ __forceinline__ float wave_sum(float v) {
#pragma unroll
    for (int o = 1; o < 64; o <<= 1) v += __shfl_xor(v, o);
    return v;
}
__device__ __forceinline__ float bf2f(bf16 b) { return __uint_as_float((unsigned)b << 16); }
__device__ __forceinline__ unsigned cvtpk(float lo, float hi) { unsigned r; asm volatile("v_cvt_pk_bf16_f32 %0, %1, %2" : "=v"(r) : "v"(lo), "v"(hi)); return r; }

__device__ __forceinline__ void win_map(int nd, int& sc, float& cs) {
    cs = 1.f;
    if (nd < 512) sc = 512 + nd;
    else if (nd < 1024) sc = 2592 + (nd - 512);
    else if (nd < 1280) { sc = nd - 1024; cs = 0.125f; }
    else if (nd < 1536) sc = 256 + (nd - 1280);
    else if (nd < 2048) sc = 1024 + (nd - 1536);
    else if (nd < 3072) {
        const bool isq = nd < 2560; const int p = nd - (isq ? 2048 : 2560), h = p >> 7, pp = p & 127, u = pp >> 3, j = pp & 7;
        const int d = (j < 4) ? 4 * u + j : 64 + 4 * u + (j - 4);
        sc = (isq ? 1568 : 2080) + 128 * h + d; if (isq) cs = 0.08838834764831845f; }
    else if (nd < 3584) sc = 3104 + (nd - 3072);
    else sc = 1536 + (nd - 3584);
}
template <bool MAP, bool TILED = false>
__device__ __forceinline__ void p0_transpose_item(const float* W, int K, int Nsrc, int nblk, const float* ks, bf16* WT, LAS float* scr, int item, int lane) {
    const int kb = item / nblk, nb = item % nblk, k0 = 64 * kb, n0 = 32 * nb;
    int sc = n0 + (lane & 31); float cs = 1.f;
    if (MAP) win_map(n0 + (lane & 31), sc, cs);
    { float wv[32];
#pragma unroll
      for (int i = 0; i < 32; ++i) wv[i] = W[(size_t)(k0 + 2 * i + (lane >> 5)) * Nsrc + sc];
      float kv[32];
#pragma unroll
      for (int i = 0; i < 32; ++i) kv[i] = ks ? ks[k0 + 2 * i + (lane >> 5)] : 1.0f;
      __builtin_amdgcn_sched_barrier(0);
#pragma unroll
      for (int i = 0; i < 32; ++i) { const int kk = 2 * i + (lane >> 5); scr[kk * 33 + (lane & 31)] = wv[i] * cs * kv[i]; } }
    LDS_WAIT(); asm volatile("" ::: "memory");
    const int c = lane & 7;
#pragma unroll
    for (int j = 0; j < 4; ++j) { const int n = (lane >> 3) + 8 * j; const LAS float* s = scr + (8 * c) * 33 + n;
        v4u o; o.x = cvtpk(s[0 * 33], s[1 * 33]); o.y = cvtpk(s[2 * 33], s[3 * 33]); o.z = cvtpk(s[4 * 33], s[5 * 33]); o.w = cvtpk(s[6 * 33], s[7 * 33]);
        if (TILED) { const int nn = n0 + n; *(GAS v4u*)(WT + (((size_t)(nn >> 8) * (K >> 6) + (k0 >> 6)) * 256 + (nn & 255)) * 64 + 8 * c) = o; }
        else *(GAS v4u*)(WT + (size_t)(n0 + n) * K + k0 + 8 * c) = o; }
    LDS_WAIT(); asm volatile("" ::: "memory");
}
__device__ __forceinline__ void rope_entry(int e, float* rcos, float* rsin) {
    const int pos = e >> 6, i = e & 63;
    double inv = 1.0, b = 0.8659643233600653;
#pragma unroll
    for (int bit = 0; bit < 6; ++bit) { if ((i >> bit) & 1) inv *= b; b *= b; }
    const double ang = (double)pos * inv;
    const double n = __builtin_rint(ang * 0.6366197723675814);
    double r = __builtin_fma(-n, 1.5707963267948966, ang); r = __builtin_fma(-n, 6.123233995736766e-17, r);
    const double r2 = r * r;
    double s = -1.0 / 1307674368000.0;
    s = s * r2 + 1.0 / 6227020800.0; s = s * r2 - 1.0 / 39916800.0; s = s * r2 + 1.0 / 362880.0; s = s * r2 - 1.0 / 5040.0; s = s * r2 + 1.0 / 120.0; s = s * r2 - 1.0 / 6.0; s = s * r2 * r + r;
    double c = 1.0 / 20922789888000.0;
    c = c * r2 - 1.0 / 87178291200.0; c = c * r2 + 1.0 / 479001600.0; c = c * r2 - 1.0 / 3628800.0; c = c * r2 + 1.0 / 40320.0; c = c * r2 - 1.0 / 720.0; c = c * r2 + 1.0 / 24.0; c = c * r2 - 0.5; c = c * r2 + 1.0;
    const int q = ((int)n) & 3;
    const double cs = (q == 0) ? c : (q == 1) ? -s : (q == 2) ? -c : s;
    const double sn = (q == 0) ? s : (q == 1) ? c : (q == 2) ? -s : -c;
    rcos[e] = (float)cs; rsin[e] = (float)sn;
}
struct P0Args { const float *xp, *xs, *anw, *win, *wout, *mnw, *w1, *w2; bf16 *Win_t, *Wout_t, *W1_t, *W2_t, *Xb; float *rcos, *rsin, *ga, *rstd; };
__device__ __forceinline__ void p0_prologue(Frame& F, const P0Args& a, int parts = 3) {
    LAS float* scr = (LAS float*)(F.lds + RING_OFF + F.wave * 16384);
    const int gw = F.vcu * NWAVES + F.wave, NGW = F.G * NWAVES;
    constexpr int I_IN = (D / 64) * (NWIN / 32), I_O = (D / 64) * (D / 32), I_1 = (D / 64) * (FF / 32), I_2 = (FF / 64) * (D / 32);
    constexpr int NITEMS = I_IN + I_O + I_1 + I_2;
    if (parts & 1) for (int it = gw; it < NITEMS; it += NGW) {
        int r = it;
        if (r < I_IN) { p0_transpose_item<true>(a.win, D, NWIN, NWIN / 32, a.anw, a.Win_t, scr, r, F.lane); continue; } r -= I_IN;
        if (r < I_O) { p0_transpose_item<false>(a.wout, D, D, D / 32, nullptr, a.Wout_t, scr, r, F.lane); continue; } r -= I_O;
        if (r < I_1) { p0_transpose_item<false>(a.w1, D, FF, FF / 32, a.mnw, a.W1_t, scr, r, F.lane); continue; } r -= I_1;
        p0_transpose_item<false, W2_TILED != 0>(a.w2, FF, D, D / 32, nullptr, a.W2_t, scr, r, F.lane);
    }
    if (parts & 1) for (int e = (blockIdx.x * NWAVES * 64) + F.tid; e < 16384 * 64; e += F.G * NWAVES * 64) rope_entry(e, a.rcos, a.rsin);
    __syncthreads();
    LAS bf16* wl = (LAS bf16*)(F.lds + RING_OFF);
    { const int c = F.tid & 31, kb = F.tid >> 5;
#pragma unroll 1
      for (int b = 0; b < 4; ++b) { float wv[16], av[16];
#pragma unroll
          for (int j = 0; j < 16; ++j) { const int k = kb + 16 * (16 * b + j); wv[j] = a.win[(size_t)k * NWIN + 1536 + c]; av[j] = a.anw[k]; }
          __builtin_amdgcn_sched_barrier(0);
#pragma unroll
          for (int j = 0; j < 16; ++j) { const int k = kb + 16 * (16 * b + j); wl[c * 1032 + k] = (bf16)(cvtpk(wv[j] * av[j], 0.f) & 0xffffu); } } }
    __syncthreads();
    const int r = F.lane & 15, g = F.lane >> 4;
    LAS unsigned char* tl = F.lds + RING_OFF + 66048 + F.wave * 8448;
    if (parts & 2) {
        f32x4 xa[16], xb[16];
#define P0_LOAD(dst, it_, kc_) do { const int r0_ = (it_) * 16; const float* xp_ = (r0_ < M_PROMPT ? a.xp + (size_t)r0_ * D : a.xs + (size_t)(r0_ - M_PROMPT) * D) + 4 * F.lane + 256 * (kc_); \
            _Pragma("unroll") for (int rr = 0; rr < 16; ++rr) dst[rr] = *(const GAS f32x4*)(xp_ + (size_t)rr * D); } while (0)
#define P0_PROC(src, kc_) do { \
            _Pragma("unroll") for (int rr = 0; rr < 16; ++rr) { unsigned long long pk = (unsigned long long)cvtpk(src[rr][0], src[rr][1]) | ((unsigned long long)cvtpk(src[rr][2], src[rr][3]) << 32); \
                *(LAS unsigned long long*)(tl + rr * 528 + F.lane * 8) = pk; *(GAS unsigned long long*)(xo + (size_t)rr * D + 256 * (kc_)) = pk; } \
            asm volatile("s_waitcnt lgkmcnt(0)" ::: "memory"); \
            _Pragma("unroll") for (int s8 = 0; s8 < 8; ++s8) { \
                const bf16x8 af = *(const LAS bf16x8*)(tl + r * 528 + 64 * s8 + 16 * g); \
                const int k0 = 256 * (kc_) + 32 * s8 + 8 * g; \
                const bf16x8 b0 = *(const LAS bf16x8*)(wl + r * 1032 + k0), b1 = *(const LAS bf16x8*)(wl + (16 + r) * 1032 + k0); \
                acc0 = __builtin_amdgcn_mfma_f32_16x16x32_bf16(af, b0, acc0, 0, 0, 0); acc1 = __builtin_amdgcn_mfma_f32_16x16x32_bf16(af, b1, acc1, 0, 0, 0); \
                const v4u aw = __builtin_bit_cast(v4u, af); \
                _Pragma("unroll") for (int j = 0; j < 4; ++j) { const unsigned u = ((const unsigned*)&aw)[j]; const float lo = __uint_as_float(u << 16), hi = __uint_as_float(u & 0xffff0000u); ss += lo * lo + hi * hi; } } \
            asm volatile("s_waitcnt lgkmcnt(0)" ::: "memory"); } while (0)
        if (gw < M_TOK / 16) P0_LOAD(xa, gw, 0);
        for (int item = gw; item < M_TOK / 16; item += NGW) {
            const int row0 = item * 16;
            bf16* xo = a.Xb + (size_t)row0 * D + 4 * F.lane;
            f32x4 acc0 = {0.f, 0.f, 0.f, 0.f}, acc1 = {0.f, 0.f, 0.f, 0.f}; float ss = 0.f;
            const int nitem = item + NGW < M_TOK / 16 ? item + NGW : item;
            P0_LOAD(xb, item, 1); __builtin_amdgcn_sched_barrier(0); P0_PROC(xa, 0); __builtin_amdgcn_sched_barrier(0);
            P0_LOAD(xa, item, 2); __builtin_amdgcn_sched_barrier(0); P0_PROC(xb, 1); __builtin_amdgcn_sched_barrier(0);
            P0_LOAD(xb, item, 3); __builtin_amdgcn_sched_barrier(0); P0_PROC(xa, 2); __builtin_amdgcn_sched_barrier(0);
            P0_LOAD(xa, nitem, 0); __builtin_amdgcn_sched_barrier(0); P0_PROC(xb, 3); __builtin_amdgcn_sched_barrier(0);
            ss += __shfl_xor(ss, 16); ss += __shfl_xor(ss, 32);
            const float rs = 1.0f / sqrtf(ss * (1.0f / 1024.0f) + EPS);
            if (g == 0) a.rstd[row0 + r] = rs;
#pragma unroll
            for (int q = 0; q < 4; ++q) { const int rr = 4 * g + q; const float rq = __shfl(rs, rr);
                a.ga[(size_t)(row0 + rr) * 32 + r] = acc0[q] * rq; a.ga[(size_t)(row0 + rr) * 32 + 16 + r] = acc1[q] * rq; }
        }
#undef P0_LOAD
#undef P0_PROC
    }
}

__device__ __forceinline__ float log_sigmoid_f(float z) { return fminf(z, 0.f) - log1pf(expf(-fabsf(z))); }
struct MixArgs { bf16* proj; const float* ga; const float *waf, *baf, *wab, *bab; float* of; const float *gnw, *rnw, *rnb; };
constexpr int NTB = 16;
template <int DK, bool GLA, bool BWD>
__device__ __forceinline__ void naive_sweep(Frame& F, const MixArgs& a, int job) {
    const int grp = F.tid >> 7, gt = F.tid & 127;
    int seq, head; if (job < 16) { seq = 32 + (job >> 3); head = job & 7; } else { seq = (job - 16) >> 3; head = (job - 16) & 7; }
    const int L = seq < 32 ? L_PROMPT : L_SAMPLE, row_base = seq < 32 ? seq * L_PROMPT : M_PROMPT + (seq - 32) * L_SAMPLE;
    const int hh = GLA ? head : head - 4;
    const int qcol = GLA ? 1024 + 64 * hh : 2048 + 128 * hh, kcol = GLA ? 1280 + 64 * hh : 2560 + 128 * hh, vcol = 128 * head;
    LAS float* sq = (LAS float*)(F.lds + grp * (3 * NTB * 128 * 4)); LAS float* sk = sq + NTB * DK; LAS float* sa = sk + NTB * DK;
    const float gam = 1.0f - exp2f(-5.0f - (float)hh);
    const float* wal = BWD ? a.wab : a.waf; const float* bal = BWD ? a.bab : a.baf;
    float S[DK];
#pragma unroll
    for (int t = 0; t < DK; ++t) S[t] = 0.f;
    for (int t0 = 0; t0 < L; t0 += NTB) {
        __syncthreads();
        for (int e = gt; e < NTB * DK; e += 128) {
            const int tok = e / DK, t = e % DK, tp = t0 + tok, row = row_base + (BWD ? L - 1 - tp : tp);
            const bf16* pr = a.proj + (size_t)row * NP;
            sq[e] = bf2f(pr[qcol + t]); sk[e] = bf2f(pr[kcol + t]);
            if (GLA) { const float* gar = a.ga + (size_t)row * 32 + (BWD ? 16 : 0); float z = bal[64 * hh + t];
#pragma unroll
                for (int r = 0; r < 16; ++r) z += gar[r] * wal[r * 256 + 64 * hh + t];
                sa[e] = expf(fmaxf(log_sigmoid_f(z) * (1.0f / 16.0f), -1.0f)); }
        }
        __syncthreads();
        for (int tok = 0; tok < NTB; ++tok) {
            const int tp = t0 + tok, row = row_base + (BWD ? L - 1 - tp : tp);
            const float vv = bf2f(a.proj[(size_t)row * NP + vcol + gt]);
            float o = 0.f;
#pragma unroll
            for (int t4 = 0; t4 < DK / 4; ++t4) {
                const f32x4 q = *(const LAS f32x4*)(sq + tok * DK + 4 * t4), k = *(const LAS f32x4*)(sk + tok * DK + 4 * t4);
                f32x4 al = {gam, gam, gam, gam}; if (GLA) al = *(const LAS f32x4*)(sa + tok * DK + 4 * t4);
#pragma unroll
                for (int j = 0; j < 4; ++j) {
                    if (!BWD) { S[4 * t4 + j] = al[j] * S[4 * t4 + j] + k[j] * vv; o += q[j] * S[4 * t4 + j]; }
                    else { S[4 * t4 + j] *= al[j]; o += q[j] * S[4 * t4 + j]; S[4 * t4 + j] += k[j] * vv; }
                }
            }
            float* op = a.of + (size_t)row * D + 128 * head + gt;
            if (!BWD) *op = o; else *op += o;
        }
    }
}
template <bool BWD>
__device__ __forceinline__ void naive_mix_phase(Frame& F, const MixArgs& a) {
    if (blockIdx.x >= 68) return;
    const int job = blockIdx.x * 4 + (F.tid >> 7);
    if ((blockIdx.x & 1) == 0) { if (!MIX_GLA) naive_sweep<64, true, BWD>(F, a, job); } else { if (!MIX_RET) naive_sweep<128, false, BWD>(F, a, job); }
}
__device__ __forceinline__ void naive_combine(Frame& F, const MixArgs& a) {
    const int gw = F.vcu * NWAVES + F.wave, NGW = F.G * NWAVES, c = 2 * F.lane;
    for (int item = gw; item < M_TOK * 8; item += NGW) {
        const int row = item >> 3, head = item & 7;
        if (head < 4 ? MIX_GLA : MIX_RET) continue;
        const float* op = a.of + (size_t)row * D + 128 * head + c;
        float o0 = op[0], o1 = op[1], y0, y1;
        if (head < 4) { const float r = 1.0f / sqrtf(wave_sum(o0 * o0 + o1 * o1) * (1.0f / 128.0f) + EPS); y0 = o0 * r * a.gnw[c]; y1 = o1 * r * a.gnw[c + 1]; }
        else { const float mu = wave_sum(o0 + o1) * (1.0f / 128.0f); o0 -= mu; o1 -= mu; const float r = 1.0f / sqrtf(wave_sum(o0 * o0 + o1 * o1) * (1.0f / 128.0f) + EPS);
            const int cc = 128 * (head - 4) + c; y0 = o0 * r * a.rnw[cc] + a.rnb[cc]; y1 = o1 * r * a.rnw[cc + 1] + a.rnb[cc + 1]; }
        bf16* pr = a.proj + (size_t)row * NP;
        const int gcol = (head < 4 ? 1536 + 128 * head : 3072 + 128 * (head - 4)) + c;
        const unsigned gw2 = *(const unsigned*)(pr + gcol);
        const float g0 = __uint_as_float(gw2 << 16), g1 = __uint_as_float(gw2 & 0xffff0000u);
        y0 *= g0 / (1.0f + expf(-g0)); y1 *= g1 / (1.0f + expf(-g1));
        *(unsigned*)(pr + 128 * head + c) = cvtpk(y0, y1);
    }
}
__device__ __forceinline__ void final_norm(Frame& F, float* out, const bf16* x2b, const float* sq, const float* w) {
    const int gw = F.vcu * NWAVES + F.wave, NGW = F.G * NWAVES;
    const f32x4* w4 = (const f32x4*)w + 2 * F.lane;
    f32x4 wv[2][2];
#pragma unroll
    for (int j = 0; j < 2; ++j) { wv[j][0] = w4[128 * j]; wv[j][1] = w4[128 * j + 1]; }
    for (int r0 = 4 * gw; r0 < M_TOK; r0 += 4 * NGW) {
        v4u xw[4][2]; f32x4 s4[4];
#pragma unroll
        for (int k = 0; k < 4; ++k) { const int row = r0 + k;
            s4[k] = *(const GAS f32x4*)(sq + (size_t)row * 16 + 4 * (F.lane & 3));
            const GAS v4u* xi = (const GAS v4u*)(x2b + (size_t)row * D) + F.lane;
            xw[k][0] = xi[0]; xw[k][1] = xi[64]; }
#pragma unroll
        for (int k = 0; k < 4; ++k) { const int row = r0 + k;
            float t = (s4[k][0] + s4[k][1]) + (s4[k][2] + s4[k][3]); t += __shfl_xor(t, 1); t += __shfl_xor(t, 2);
            const float r = 1.0f / sqrtf(t * (1.0f / 1024.0f) + EPS);
            GAS f32x4* o = (GAS f32x4*)(out + (size_t)row * D) + 2 * F.lane;
#pragma unroll
            for (int j = 0; j < 2; ++j) { const v4u x = xw[k][j];
                const f32x4 x0 = {__uint_as_float(x.x << 16), __uint_as_float(x.x & 0xffff0000u), __uint_as_float(x.y << 16), __uint_as_float(x.y & 0xffff0000u)};
                const f32x4 x1 = {__uint_as_float(x.z << 16), __uint_as_float(x.z & 0xffff0000u), __uint_as_float(x.w << 16), __uint_as_float(x.w & 0xffff0000u)};
                o[128 * j] = x0 * r * wv[j][0]; o[128 * j + 1] = x1 * r * wv[j][1]; } }
    }
}

typedef float f32x2 __attribute__((ext_vector_type(2)));
typedef __bf16 bf16v2 __attribute__((ext_vector_type(2)));
typedef unsigned u32x2 __attribute__((ext_vector_type(2)));
__device__ __forceinline__ unsigned cvtpk_c(float lo, float hi) { bf16v2 v = {(__bf16)lo, (__bf16)hi}; return __builtin_bit_cast(unsigned, v); }
__device__ __forceinline__ float bflo(unsigned w) { return __uint_as_float(w << 16); }
__device__ __forceinline__ float bfhi(unsigned w) { return __uint_as_float(w & 0xffff0000u); }
__device__ __forceinline__ int opaque_i(int x) { asm volatile("" : "+v"(x)); return x; }
typedef short s16x4 __attribute__((ext_vector_type(4)));
#define TRRD(ptr) __builtin_amdgcn_ds_read_tr16_b64_v4i16((LAS s16x4*)(ptr))
constexpr size_t ST_SC_BYTES = 393216;
__device__ __forceinline__ size_t state_off(int sc, bool gla, int hh, int dir) { return (size_t)sc * ST_SC_BYTES + (gla ? (size_t)(hh * 2 + dir) * 16384 : (size_t)131072 + (size_t)(hh * 2 + dir) * 32768); }
typedef _Float16 bh16;
__device__ __forceinline__ float h2f(unsigned w, int hi) { return (float)__builtin_bit_cast(bh16, (unsigned short)(hi ? (w >> 16) : (w & 0xffffu))); }
struct CMixArgs { bf16* proj; const float* ga; const float *waf, *baf, *wab, *bab; unsigned char* st; float* dec; const float *gnw, *rnw, *rnb; bf16* mo; int mop; unsigned char* sto; unsigned char* ofs; bh16* bb0; bh16* bb1; float* gv; };
constexpr int OB_PITCH = 132;

template <bool GLA> struct RawSet;
template <> struct RawSet<true> { v4u q, k, v0, v1, bh, lh; };
template <> struct RawSet<false> { v4u q0, q1, k0, k1, v0, v1; };

template <bool GLA, bool WITH_O>
__device__ __forceinline__ void raw_load(RawSet<GLA>& R, const CMixArgs& a, int p, int s, int w, int lane0) {
    const int lane = opaque_i(lane0), sc = p >> 2, hh = p & 3, dir = s >> 2, c = dir ? 7 - s : s;
    const size_t row = (size_t)(sc * 256 + 64 * c + 8 * w + (lane >> 3)); const int pc = lane & 7;
    if constexpr (GLA) {
        if (WITH_O) R.q = *(const GAS v4u*)(a.proj + pg8::pl(pg8::PL_GQ, hh, row, 64) + 8 * pc);
        R.k = *(const GAS v4u*)(a.proj + pg8::pl(pg8::PL_GK, hh, row, 64) + 8 * pc);
        const bf16* pv = a.proj + pg8::pl(pg8::PL_GV, hh, row, 128) + 8 * pc;
        R.v0 = *(const GAS v4u*)pv; R.v1 = *(const GAS v4u*)(pv + 64);
        const bh16* bp = (dir ? a.bb1 : a.bb0) + ((size_t)(p * 4 + c) * 64) * 64 + 8 * pc;
        const int ti = 8 * w + (lane >> 3);
        R.bh = *(const GAS v4u*)(bp + ti * 64); R.lh = *(const GAS v4u*)(bp + (dir ? 0 : 63) * 64);
    } else {
        if (WITH_O) { const bf16* pq = a.proj + pg8::pl(pg8::PL_RQ, hh, row, 128) + 8 * pc; R.q0 = *(const GAS v4u*)pq; R.q1 = *(const GAS v4u*)(pq + 64); }
        const bf16* pk = a.proj + pg8::pl(pg8::PL_RK, hh, row, 128) + 8 * pc; R.k0 = *(const GAS v4u*)pk; R.k1 = *(const GAS v4u*)(pk + 64);
        const bf16* pv = a.proj + pg8::pl(pg8::PL_RV, hh, row, 128) + 8 * pc; R.v0 = *(const GAS v4u*)pv; R.v1 = *(const GAS v4u*)(pv + 64);
    }
}

template <int DK, bool GLA, bool WITH_O> struct MixLds {
    static constexpr int NT = DK / 16, NS = DK / 32;
    static constexpr int RQ = DK * 2 + 16, RP = 144, RV = 272;
    static constexpr int O_QD = 0, O_KI = 64 * RQ, O_KE = 2 * 64 * RQ, O_PB = 3 * 64 * RQ, O_VB = O_PB + 64 * RP, O_DC = O_VB + 64 * RV, O_WAL = O_DC + DK * 4,
                         O_OB = O_WAL, O_END = O_OB + 64 * OB_PITCH * 4;
    static_assert(O_END <= 146432, "mixer LDS map");
};

template <int DK, bool GLA, bool WITH_O>
__device__ __forceinline__ void mix_step(Frame& F, const CMixArgs& a, int p, int s, int pnext, RawSet<GLA>& R, f32x4 (&S)[DK / 16], float (&dsum)[8], u32x2 (&ofp)[4][4]) {
    typedef MixLds<DK, GLA, WITH_O> ML;
    constexpr int NT = ML::NT, NS = ML::NS, RQ = ML::RQ, RP = ML::RP, RV = ML::RV;
    LAS unsigned char* L = F.lds;
    const int lane0 = F.lane, w = F.wave;
    const int sc = p >> 2, hh = p & 3, dir = s >> 2, c = dir ? 7 - s : s, row0 = sc * 256, head = GLA ? hh : 4 + hh, vcol = 128 * head;
    __syncthreads();
    {
        const int lane = opaque_i(lane0), i = 8 * w + (lane >> 3), pc = lane & 7;
        *(LAS v4u*)(L + ML::O_VB + i * RV + 16 * pc) = R.v0; *(LAS v4u*)(L + ML::O_VB + i * RV + 128 + 16 * pc) = R.v1;
        if constexpr (GLA) {
            const int tk = lane >> 3;
            float q8[8], k8[8], e8[8];
#pragma unroll
            for (int e = 0; e < 8; ++e) { const float b = h2f(((const unsigned*)&R.bh)[e >> 1], e & 1), bl_ = h2f(((const unsigned*)&R.lh)[e >> 1], e & 1);
                const unsigned wq = WITH_O ? ((const unsigned*)&R.q)[e >> 1] : 0u, wk = ((const unsigned*)&R.k)[e >> 1];
                const float qv = (e & 1) ? bfhi(wq) : bflo(wq), kv = (e & 1) ? bfhi(wk) : bflo(wk);
                q8[e] = qv * __expf(b); k8[e] = kv * __expf(-b); e8[e] = kv * __expf(bl_ - b);
                if (!WITH_O) dsum[e] += bl_;
                if (w == 0 && tk == 0) ((LAS float*)(L + ML::O_DC))[8 * pc + e] = __expf(bl_); }
            v4u oq, ok, oe;
            oq.x = cvtpk_c(q8[0], q8[1]); oq.y = cvtpk_c(q8[2], q8[3]); oq.z = cvtpk_c(q8[4], q8[5]); oq.w = cvtpk_c(q8[6], q8[7]);
            ok.x = cvtpk_c(k8[0], k8[1]); ok.y = cvtpk_c(k8[2], k8[3]); ok.z = cvtpk_c(k8[4], k8[5]); ok.w = cvtpk_c(k8[6], k8[7]);
            oe.x = cvtpk_c(e8[0], e8[1]); oe.y = cvtpk_c(e8[2], e8[3]); oe.z = cvtpk_c(e8[4], e8[5]); oe.w = cvtpk_c(e8[6], e8[7]);
            if (WITH_O) { *(LAS v4u*)(L + ML::O_QD + i * RQ + 16 * pc) = oq; *(LAS v4u*)(L + ML::O_KI + i * RQ + 16 * pc) = ok; }
            *(LAS v4u*)(L + ML::O_KE + i * RQ + 16 * pc) = oe;
        } else {
            const float l2g = hh == 0 ? -0.045803689613124f : hh == 1 ? -0.022720076500083f : hh == 2 ? -0.011315313227834f : -0.005646563141142f;
            const float nq = dir ? (float)(64 - i) : (float)(i + 1), ne = dir ? (float)i : (float)(63 - i);
            const float eb = exp2f(l2g * nq), ei = exp2f(-l2g * nq), ee = exp2f(l2g * ne);
#pragma unroll
            for (int x = 0; x < 2; ++x) { v4u oq, ok, oe; const v4u rq = x ? R.q1 : R.q0, rk = x ? R.k1 : R.k0;
#pragma unroll
                for (int j = 0; j < 4; ++j) { const unsigned wq = WITH_O ? ((const unsigned*)&rq)[j] : 0u, wk = ((const unsigned*)&rk)[j];
                    ((unsigned*)&oq)[j] = cvtpk_c(bflo(wq) * eb, bfhi(wq) * eb); ((unsigned*)&ok)[j] = cvtpk_c(bflo(wk) * ei, bfhi(wk) * ei); ((unsigned*)&oe)[j] = cvtpk_c(bflo(wk) * ee, bfhi(wk) * ee); }
                if (WITH_O) { *(LAS v4u*)(L + ML::O_QD + i * RQ + 128 * x + 16 * pc) = oq; *(LAS v4u*)(L + ML::O_KI + i * RQ + 128 * x + 16 * pc) = ok; }
                *(LAS v4u*)(L + ML::O_KE + i * RQ + 128 * x + 16 * pc) = oe; }
            if (w == 0 && lane < 32) *(LAS f32x4*)(L + ML::O_DC + lane * 16) = (f32x4){exp2f(l2g * 64.0f), exp2f(l2g * 64.0f), exp2f(l2g * 64.0f), exp2f(l2g * 64.0f)};
        }
    }
    v4u gt0, gt1; f32x4 nw[4], nb[4];
    if (WITH_O) { const int lane = opaque_i(lane0);
        const bf16* gp = a.proj + (dir ? pg8::pl(GLA ? pg8::PL_GG : pg8::PL_RG, hh, (size_t)(row0 + 64 * c + 8 * w + (lane >> 3)), 128) + 16 * (lane & 7) : pg8::pl(GLA ? pg8::PL_GG : pg8::PL_RG, 0, (size_t)0, 128));
        gt0 = *(const GAS v4u*)gp; gt1 = *(const GAS v4u*)(gp + 8);
        const float* wp = GLA ? a.gnw + 16 * (lane & 7) : a.rnw + 128 * hh + 16 * (lane & 7);
#pragma unroll
        for (int k = 0; k < 4; ++k) { nw[k] = *(const GAS f32x4*)(wp + 4 * k); if (!GLA) nb[k] = *(const GAS f32x4*)(a.rnb + 128 * hh + 16 * (lane & 7) + 4 * k); } }
    raw_load<GLA, WITH_O>(R, a, s < 6 ? p : (pnext < 1536 ? pnext : p), s < 6 ? s + 2 : s - 6, w, lane0);
    __syncthreads();
    if (WITH_O) {
        const int lane = opaque_i(lane0), g = lane >> 4, lr = lane & 15;
        const int mi = w >> 1;
        bf16x8 kf[2][NS], qf2[NS];
#pragma unroll
        for (int s2 = 0; s2 < NS; ++s2) { qf2[s2] = *(const LAS bf16x8*)(L + ML::O_QD + (16 * mi + lr) * RQ + 64 * s2 + 16 * g);
#pragma unroll
            for (int jj = 0; jj < 2; ++jj) kf[jj][s2] = *(const LAS bf16x8*)(L + ML::O_KI + (16 * (2 * (w & 1) + jj) + lr) * RQ + 64 * s2 + 16 * g); }
        __builtin_amdgcn_sched_barrier(0);
#pragma unroll
        for (int jj = 0; jj < 2; ++jj) { const int nj = 2 * (w & 1) + jj;
            f32x4 acc = {0.f, 0.f, 0.f, 0.f};
#pragma unroll
            for (int s2 = 0; s2 < NS; ++s2) acc = __builtin_amdgcn_mfma_f32_16x16x32_bf16(kf[jj][s2], qf2[s2], acc, 0, 0, 0);
            const int ii = 16 * mi + lr;
#pragma unroll
            for (int r = 0; r < 4; ++r) { const int j = 16 * nj + 4 * g + r; const bool keep = dir ? (j > ii) : (j <= ii); acc[r] = keep ? acc[r] : 0.f; }
            u32x2 pk; pk.x = cvtpk_c(acc[0], acc[1]); pk.y = cvtpk_c(acc[2], acc[3]);
            *(LAS u32x2*)(L + ML::O_PB + ii * RP + 32 * nj + 8 * g) = pk; }
        __syncthreads();
    }
    f32x4 o[4];
    {
        const int lane = opaque_i(lane0), g = lane >> 4, lr = lane & 15, q4 = lr >> 2, p4 = lr & 3;
        const LAS unsigned char* vb = L + ML::O_VB + (8 * g + q4) * RV + 32 * w + 8 * p4;
        const bf16x8 vf0 = __builtin_shufflevector(TRRD(vb), TRRD(vb + 4 * RV), 0, 1, 2, 3, 4, 5, 6, 7), vf1 = __builtin_shufflevector(TRRD(vb + 32 * RV), TRRD(vb + 36 * RV), 0, 1, 2, 3, 4, 5, 6, 7);
        if (WITH_O) {
            { bf16x8 pf[4][2];
#pragma unroll
              for (int m = 0; m < 4; ++m) { pf[m][0] = *(const LAS bf16x8*)(L + ML::O_PB + (16 * m + lr) * RP + 16 * g); pf[m][1] = *(const LAS bf16x8*)(L + ML::O_PB + (16 * m + lr) * RP + 64 + 16 * g); }
              __builtin_amdgcn_sched_barrier(0);
#pragma unroll
              for (int m = 0; m < 4; ++m) { o[m] = __builtin_amdgcn_mfma_f32_16x16x32_bf16(pf[m][0], vf0, (f32x4){0.f, 0.f, 0.f, 0.f}, 0, 0, 0); o[m] = __builtin_amdgcn_mfma_f32_16x16x32_bf16(pf[m][1], vf1, o[m], 0, 0, 0); }
              __builtin_amdgcn_sched_barrier(0); }
#pragma unroll
            for (int sh = 0; sh < NS / 2; ++sh) {
                u32x2 ql[2][4][2];
#pragma unroll
                for (int x = 0; x < 2; ++x)
#pragma unroll
                    for (int m = 0; m < 4; ++m) { ql[x][m][0] = *(const LAS u32x2*)(L + ML::O_QD + (16 * m + lr) * RQ + 64 * (2 * sh + x) + 8 * g); ql[x][m][1] = *(const LAS u32x2*)(L + ML::O_QD + (16 * m + lr) * RQ + 64 * (2 * sh + x) + 32 + 8 * g); }
                __builtin_amdgcn_sched_barrier(0);
#pragma unroll
                for (int x = 0; x < 2; ++x) { const int s2 = 2 * sh + x;
                    const bf16x8 sf = __builtin_bit_cast(bf16x8, (v4u){cvtpk_c(S[2 * s2][0], S[2 * s2][1]), cvtpk_c(S[2 * s2][2], S[2 * s2][3]), cvtpk_c(S[2 * s2 + 1][0], S[2 * s2 + 1][1]), cvtpk_c(S[2 * s2 + 1][2], S[2 * s2 + 1][3])});
#pragma unroll
                    for (int m = 0; m < 4; ++m) o[m] = __builtin_amdgcn_mfma_f32_16x16x32_bf16(__builtin_bit_cast(bf16x8, (v4u){ql[x][m][0].x, ql[x][m][0].y, ql[x][m][1].x, ql[x][m][1].y}), sf, o[m], 0, 0, 0); }
                __builtin_amdgcn_sched_barrier(0);
            }
        }
#pragma unroll
        for (int th = 0; th < NT / 4; ++th) {
            f32x4 d4[4]; bf16x8 kf0[4], kf1[4];
#pragma unroll
            for (int x = 0; x < 4; ++x) { const int tt = 4 * th + x;
                d4[x] = *(const LAS f32x4*)(L + ML::O_DC + (16 * tt + 4 * g) * 4);
                const LAS unsigned char* kb = L + ML::O_KE + (8 * g + q4) * RQ + 32 * tt + 8 * p4;
                kf0[x] = __builtin_shufflevector(TRRD(kb), TRRD(kb + 4 * RQ), 0, 1, 2, 3, 4, 5, 6, 7); kf1[x] = __builtin_shufflevector(TRRD(kb + 32 * RQ), TRRD(kb + 36 * RQ), 0, 1, 2, 3, 4, 5, 6, 7); }
            __builtin_amdgcn_sched_barrier(0);
#pragma unroll
            for (int x = 0; x < 4; ++x) { const int tt = 4 * th + x;
                S[tt] = S[tt] * d4[x];
                S[tt] = __builtin_amdgcn_mfma_f32_16x16x32_bf16(kf0[x], vf0, S[tt], 0, 0, 0);
                S[tt] = __builtin_amdgcn_mfma_f32_16x16x32_bf16(kf1[x], vf1, S[tt], 0, 0, 0); }
            __builtin_amdgcn_sched_barrier(0);
        }
    }
    if (WITH_O) {
        const int lane = opaque_i(lane0), g = lane >> 4, lr = lane & 15;
        if (dir == 0) {
#pragma unroll
            for (int cc = 0; cc < 4; ++cc) if (cc == c) {
#pragma unroll
                for (int m = 0; m < 4; ++m) { ofp[cc][m].x = cvtpk_c(o[m][0], o[m][1]); ofp[cc][m].y = cvtpk_c(o[m][2], o[m][3]); } }
        } else {
            u32x2 ofr[4];
#pragma unroll
            for (int cc = 0; cc < 4; ++cc) if (cc == c) {
#pragma unroll
                for (int m = 0; m < 4; ++m) ofr[m] = ofp[cc][m]; }
            LAS float* ob = (LAS float*)(L + ML::O_OB);
#pragma unroll
            for (int m = 0; m < 4; ++m) { const f32x4 t = {o[m][0] + bflo(ofr[m].x), o[m][1] + bfhi(ofr[m].x), o[m][2] + bflo(ofr[m].y), o[m][3] + bfhi(ofr[m].y)};
#pragma unroll
                for (int r = 0; r < 4; ++r) ob[(16 * m + 4 * g + r) * OB_PITCH + 16 * w + lr] = t[r]; }
            __syncthreads();
            const int row = 8 * w + (lane >> 3), pc = lane & 7;
            f32x4 x[4];
#pragma unroll
            for (int k = 0; k < 4; ++k) x[k] = *(const LAS f32x4*)(ob + row * OB_PITCH + 16 * pc + 4 * k);
            float rs;
            if (GLA) { float ss = 0.f;
#pragma unroll
                for (int k = 0; k < 4; ++k) ss += (x[k][0] * x[k][0] + x[k][1] * x[k][1]) + (x[k][2] * x[k][2] + x[k][3] * x[k][3]);
                ss += __shfl_xor(ss, 1); ss += __shfl_xor(ss, 2); ss += __shfl_xor(ss, 4);
                rs = __builtin_amdgcn_rsqf(ss * (1.0f / 128.0f) + EPS); }
            else { float sm = 0.f;
#pragma unroll
                for (int k = 0; k < 4; ++k) sm += (x[k][0] + x[k][1]) + (x[k][2] + x[k][3]);
                sm += __shfl_xor(sm, 1); sm += __shfl_xor(sm, 2); sm += __shfl_xor(sm, 4);
                const float mu = sm * (1.0f / 128.0f); float ss = 0.f;
#pragma unroll
                for (int k = 0; k < 4; ++k) { x[k] = x[k] - mu; ss += (x[k][0] * x[k][0] + x[k][1] * x[k][1]) + (x[k][2] * x[k][2] + x[k][3] * x[k][3]); }
                ss += __shfl_xor(ss, 1); ss += __shfl_xor(ss, 2); ss += __shfl_xor(ss, 4);
                rs = __builtin_amdgcn_rsqf(ss * (1.0f / 128.0f) + EPS); }
            unsigned ow[8];
#pragma unroll
            for (int k = 0; k < 4; ++k) { f32x4 y = x[k] * rs * nw[k];
                if (!GLA) y = y + nb[k];
                const unsigned ga_ = k < 2 ? ((const unsigned*)&gt0)[2 * k] : ((const unsigned*)&gt1)[2 * k - 4], gb_ = k < 2 ? ((const unsigned*)&gt0)[2 * k + 1] : ((const unsigned*)&gt1)[2 * k - 3];
                const float g0 = bflo(ga_), g1 = bfhi(ga_), g2 = bflo(gb_), g3 = bfhi(gb_);
                y[0] *= g0 * __builtin_amdgcn_rcpf(1.0f + __expf(-g0)); y[1] *= g1 * __builtin_amdgcn_rcpf(1.0f + __expf(-g1));
                y[2] *= g2 * __builtin_amdgcn_rcpf(1.0f + __expf(-g2)); y[3] *= g3 * __builtin_amdgcn_rcpf(1.0f + __expf(-g3));
                ow[2 * k] = cvtpk_c(y[0], y[1]); ow[2 * k + 1] = cvtpk_c(y[2], y[3]); }
            bf16* op = a.mo + (size_t)(row0 + 64 * c + row) * a.mop + vcol + 16 * pc;
            *(GAS v4u*)op = (v4u){ow[0], ow[1], ow[2], ow[3]}; *(GAS v4u*)(op + 8) = (v4u){ow[4], ow[5], ow[6], ow[7]};
        }
    }
}


__device__ __forceinline__ void gla_b_stage(Frame& F, const CMixArgs& a, int p) {
    const int sc = p >> 2, hh = p & 3, w = F.wave;
    LAS float* gl = (LAS float*)F.lds;
    __syncthreads();
    { const int tid = opaque_i(F.tid);
#pragma unroll
      for (int x = 0; x < 4; ++x) *(LAS f32x4*)(gl + 4 * (tid + 512 * x)) = *(const GAS f32x4*)(a.ga + (size_t)sc * 256 * 32 + 4 * (tid + 512 * x)); }
    __syncthreads();
    const int t = opaque_i(F.lane), dir = w >> 2, c = w & 3;
    const float* wa = (dir ? a.wab : a.waf) + 64 * hh + t;
    float wv[16];
#pragma unroll
    for (int r = 0; r < 16; ++r) wv[r] = wa[r * 256];
    const float bias = (dir ? a.bab : a.baf)[64 * hh + t];
    bh16* bp = (dir ? a.bb1 : a.bb0) + ((size_t)(p * 4 + c) * 64) * 64;
    LAS float* tb = gl + 8192 + w * (16 * 68);
    float acc = 0.f;
#pragma unroll 1
    for (int k16 = 0; k16 < 64; k16 += 16) {
#pragma unroll 1
        for (int k4 = k16; k4 < k16 + 16; k4 += 4) {
            f32x4 gv[4][4];
#pragma unroll
            for (int j = 0; j < 4; ++j) { const int i = dir ? 63 - (k4 + j) : k4 + j; const LAS float* gr = gl + (64 * c + i) * 32 + 16 * dir;
#pragma unroll
                for (int x = 0; x < 4; ++x) gv[j][x] = *(const LAS f32x4*)(gr + 4 * x); }
            __builtin_amdgcn_sched_barrier(0);
#pragma unroll
            for (int j = 0; j < 4; ++j) {
                f32x2 z2 = {bias, 0.f};
#pragma unroll
                for (int x = 0; x < 4; ++x) { z2 = __builtin_elementwise_fma((f32x2){gv[j][x][0], gv[j][x][1]}, (f32x2){wv[4 * x], wv[4 * x + 1]}, z2);
                    z2 = __builtin_elementwise_fma((f32x2){gv[j][x][2], gv[j][x][3]}, (f32x2){wv[4 * x + 2], wv[4 * x + 3]}, z2); }
                const float z = z2[0] + z2[1];
                const float ls = fminf(z, 0.f) - __logf(1.0f + __expf(-fabsf(z)));
                acc += fmaxf(ls * (1.0f / 16.0f), -1.0f);
                tb[(k4 - k16 + j) * 68 + t] = acc; }
        }
#pragma unroll
        for (int x = 0; x < 2; ++x) { const int kk = 8 * x + (t >> 3), i = dir ? 63 - (k16 + kk) : k16 + kk;
            const f32x4 lo = *(const LAS f32x4*)(tb + kk * 68 + 8 * (t & 7)), hi = *(const LAS f32x4*)(tb + kk * 68 + 8 * (t & 7) + 4);
            v4u o;
#pragma unroll
            for (int q = 0; q < 2; ++q) { ((unsigned*)&o)[q] = (unsigned)__builtin_bit_cast(unsigned short, (bh16)lo[2 * q]) | ((unsigned)__builtin_bit_cast(unsigned short, (bh16)lo[2 * q + 1]) << 16);
                ((unsigned*)&o)[2 + q] = (unsigned)__builtin_bit_cast(unsigned short, (bh16)hi[2 * q]) | ((unsigned)__builtin_bit_cast(unsigned short, (bh16)hi[2 * q + 1]) << 16); }
            *(GAS v4u*)(bp + i * 64 + 8 * (t & 7)) = o; }
    }
    LAS float* tot = gl + 8192 + 8 * (16 * 68);
    tot[w * 64 + t] = acc;
    __syncthreads();
    { float gsum = 0.f;
#pragma unroll
      for (int cc = 0; cc < 4; ++cc) { const float v = tot[(dir * 4 + cc) * 64 + t]; if (dir ? (cc <= c) : (cc >= c)) gsum += v; }
      a.gv[((size_t)(p * 2 + dir) * 4 + c) * 64 + t] = gsum;
      if (c == (dir ? 3 : 0)) a.dec[(size_t)((sc * 4 + hh) * 2 + dir) * 64 + t] = __expf(gsum); }
}

template <int DK, bool GLA, bool WITH_O>
__device__ __forceinline__ void mix_units(Frame& F, const CMixArgs& a) {
    typedef MixLds<DK, GLA, WITH_O> ML;
    constexpr int NT = DK / 16;
    const int w = F.wave, lane0 = F.lane;
    int p = (int)blockIdx.x;
    if (p >= 1536) return;
    RawSet<GLA> RA, RB;
    raw_load<GLA, WITH_O>(RA, a, p, 0, w, lane0); raw_load<GLA, WITH_O>(RB, a, p, 1, w, lane0);
    f32x4 S[NT]; float dsum[8]; u32x2 ofp[4][4];
#pragma unroll 1
    for (; p < 1536; p += F.G) {
        const int sc = p >> 2, hh = p & 3, pnext = p + F.G;
#pragma unroll 1
        for (int dir = 0; dir < 2; ++dir) {
            const int lane = opaque_i(lane0);
            unsigned char* sp = a.st + state_off(sc, GLA, hh, dir) + (size_t)(unsigned)(w * NT * 512 + lane * 8);
            if (WITH_O) {
#pragma unroll
                for (int tt = 0; tt < NT; ++tt) { const u32x2 pk = *(const GAS u32x2*)(sp + tt * 512); S[tt] = (f32x4){bflo(pk.x), bfhi(pk.x), bflo(pk.y), bfhi(pk.y)}; } }
            else {
#pragma unroll
                for (int tt = 0; tt < NT; ++tt) S[tt] = (f32x4){0.f, 0.f, 0.f, 0.f};
#pragma unroll
                for (int e = 0; e < 8; ++e) dsum[e] = 0.f; }
#pragma unroll 1
            for (int h2 = 0; h2 < 2; ++h2) {
                mix_step<DK, GLA, WITH_O>(F, a, p, 4 * dir + 2 * h2, pnext, RA, S, dsum, ofp);
                mix_step<DK, GLA, WITH_O>(F, a, p, 4 * dir + 2 * h2 + 1, pnext, RB, S, dsum, ofp);
            }
            if (!WITH_O) {
#pragma unroll
                for (int tt = 0; tt < NT; ++tt) { u32x2 pk; pk.x = cvtpk_c(S[tt][0], S[tt][1]); pk.y = cvtpk_c(S[tt][2], S[tt][3]); *(GAS u32x2*)(sp + tt * 512) = pk; }
                if (GLA && w == 0 && lane < 8) { float* dp = a.dec + (size_t)((sc * 4 + hh) * 2 + dir) * 64 + 8 * lane;
#pragma unroll
                    for (int e = 0; e < 8; ++e) dp[e] = __expf(dsum[e]); }
            }
        }
    }
}

template <bool GLA> struct KvRaw;
template <> struct KvRaw<true> { v4u k, v0, v1, bfh, bbh; f32x4 gf0, gf1, gb0, gb1; };
template <> struct KvRaw<false> { v4u k0, k1, v0, v1; };
template <bool GLA>
__device__ __forceinline__ void kv_load(KvRaw<GLA>& R, const CMixArgs& a, int p, int c, int w, int lane0) {
    const int lane = opaque_i(lane0), sc = p >> 2, hh = p & 3, pc = lane & 7, ti = 8 * w + (lane >> 3);
    const size_t row = (size_t)(sc * 256 + 64 * c + ti);
    if constexpr (GLA) {
        R.k = *(const GAS v4u*)(a.proj + pg8::pl(pg8::PL_GK, hh, row, 64) + 8 * pc);
        const bf16* pv = a.proj + pg8::pl(pg8::PL_GV, hh, row, 128) + 8 * pc; R.v0 = *(const GAS v4u*)pv; R.v1 = *(const GAS v4u*)(pv + 64);
        R.bfh = *(const GAS v4u*)(a.bb0 + ((size_t)(p * 4 + c) * 64 + ti) * 64 + 8 * pc); R.bbh = *(const GAS v4u*)(a.bb1 + ((size_t)(p * 4 + c) * 64 + ti) * 64 + 8 * pc);
        const float* g0 = a.gv + ((size_t)(p * 2 + 0) * 4 + c) * 64 + 8 * pc; const float* g1 = a.gv + ((size_t)(p * 2 + 1) * 4 + c) * 64 + 8 * pc;
        R.gf0 = *(const GAS f32x4*)g0; R.gf1 = *(const GAS f32x4*)(g0 + 4); R.gb0 = *(const GAS f32x4*)g1; R.gb1 = *(const GAS f32x4*)(g1 + 4);
    } else {
        const bf16* pk = a.proj + pg8::pl(pg8::PL_RK, hh, row, 128) + 8 * pc; R.k0 = *(const GAS v4u*)pk; R.k1 = *(const GAS v4u*)(pk + 64);
        const bf16* pv = a.proj + pg8::pl(pg8::PL_RV, hh, row, 128) + 8 * pc; R.v0 = *(const GAS v4u*)pv; R.v1 = *(const GAS v4u*)(pv + 64);
    }
}
template <int DK, bool GLA>
__device__ __forceinline__ void kv_step(Frame& F, const CMixArgs& a, int p, int c, int pnext, KvRaw<GLA>& R, f32x4 (&Sf)[DK / 16], f32x4 (&Sb)[DK / 16]) {
    constexpr int NT = DK / 16, RQ = DK * 2 + 16, RV = 272, O_KF = 0, O_KB = 64 * RQ, O_VB = 2 * 64 * RQ;
    LAS unsigned char* L = F.lds;
    const int lane0 = F.lane, w = F.wave, hh = p & 3;
    __syncthreads();
    { const int lane = opaque_i(lane0), i = 8 * w + (lane >> 3), pc = lane & 7;
      *(LAS v4u*)(L + O_VB + i * RV + 16 * pc) = R.v0; *(LAS v4u*)(L + O_VB + i * RV + 128 + 16 * pc) = R.v1;
      if constexpr (GLA) {
          float f8[8], b8[8];
#pragma unroll
          for (int e = 0; e < 8; ++e) { const unsigned wk = ((const unsigned*)&R.k)[e >> 1]; const float kv = (e & 1) ? bfhi(wk) : bflo(wk);
              const float xf = (e < 4 ? R.gf0[e & 3] : R.gf1[e & 3]) - h2f(((const unsigned*)&R.bfh)[e >> 1], e & 1), xb = (e < 4 ? R.gb0[e & 3] : R.gb1[e & 3]) - h2f(((const unsigned*)&R.bbh)[e >> 1], e & 1);
              f8[e] = kv * __expf(xf); b8[e] = kv * __expf(xb); }
          *(LAS v4u*)(L + O_KF + i * RQ + 16 * pc) = (v4u){cvtpk_c(f8[0], f8[1]), cvtpk_c(f8[2], f8[3]), cvtpk_c(f8[4], f8[5]), cvtpk_c(f8[6], f8[7])};
          *(LAS v4u*)(L + O_KB + i * RQ + 16 * pc) = (v4u){cvtpk_c(b8[0], b8[1]), cvtpk_c(b8[2], b8[3]), cvtpk_c(b8[4], b8[5]), cvtpk_c(b8[6], b8[7])};
      } else {
          const float l2g = hh == 0 ? -0.045803689613124f : hh == 1 ? -0.022720076500083f : hh == 2 ? -0.011315313227834f : -0.005646563141142f;
          const float j = (float)(64 * c + i), ef = __builtin_amdgcn_exp2f(l2g * (255.0f - j)), eb = __builtin_amdgcn_exp2f(l2g * j);
#pragma unroll
          for (int x = 0; x < 2; ++x) { const v4u rk = x ? R.k1 : R.k0; v4u of, ob;
#pragma unroll
              for (int q = 0; q < 4; ++q) { const unsigned wk = ((const unsigned*)&rk)[q]; ((unsigned*)&of)[q] = cvtpk_c(bflo(wk) * ef, bfhi(wk) * ef); ((unsigned*)&ob)[q] = cvtpk_c(bflo(wk) * eb, bfhi(wk) * eb); }
              *(LAS v4u*)(L + O_KF + i * RQ + 128 * x + 16 * pc) = of; *(LAS v4u*)(L + O_KB + i * RQ + 128 * x + 16 * pc) = ob; }
      } }
    kv_load<GLA>(R, a, c < 2 ? p : (pnext < 1536 ? pnext : p), (c + 2) & 3, w, lane0);
    __syncthreads();
    { const int lane = opaque_i(lane0), g = lane >> 4, lr = lane & 15, q4 = lr >> 2, p4 = lr & 3;
      const LAS unsigned char* vb = L + O_VB + (8 * g + q4) * RV + 32 * w + 8 * p4;
      const bf16x8 vf0 = __builtin_shufflevector(TRRD(vb), TRRD(vb + 4 * RV), 0, 1, 2, 3, 4, 5, 6, 7), vf1 = __builtin_shufflevector(TRRD(vb + 32 * RV), TRRD(vb + 36 * RV), 0, 1, 2, 3, 4, 5, 6, 7);
#pragma unroll
      for (int th = 0; th < NT / 4; ++th) {
          bf16x8 kf0[4], kf1[4], kb0[4], kb1[4];
#pragma unroll
          for (int x = 0; x < 4; ++x) { const int tt = 4 * th + x;
              const LAS unsigned char* ka = L + O_KF + (8 * g + q4) * RQ + 32 * tt + 8 * p4; const LAS unsigned char* kb = L + O_KB + (8 * g + q4) * RQ + 32 * tt + 8 * p4;
              kf0[x] = __builtin_shufflevector(TRRD(ka), TRRD(ka + 4 * RQ), 0, 1, 2, 3, 4, 5, 6, 7); kf1[x] = __builtin_shufflevector(TRRD(ka + 32 * RQ), TRRD(ka + 36 * RQ), 0, 1, 2, 3, 4, 5, 6, 7);
              kb0[x] = __builtin_shufflevector(TRRD(kb), TRRD(kb + 4 * RQ), 0, 1, 2, 3, 4, 5, 6, 7); kb1[x] = __builtin_shufflevector(TRRD(kb + 32 * RQ), TRRD(kb + 36 * RQ), 0, 1, 2, 3, 4, 5, 6, 7); }
          __builtin_amdgcn_sched_barrier(0);
#pragma unroll
          for (int x = 0; x < 4; ++x) { const int tt = 4 * th + x;
              Sf[tt] = __builtin_amdgcn_mfma_f32_16x16x32_bf16(kf0[x], vf0, Sf[tt], 0, 0, 0); Sf[tt] = __builtin_amdgcn_mfma_f32_16x16x32_bf16(kf1[x], vf1, Sf[tt], 0, 0, 0);
              Sb[tt] = __builtin_amdgcn_mfma_f32_16x16x32_bf16(kb0[x], vf0, Sb[tt], 0, 0, 0); Sb[tt] = __builtin_amdgcn_mfma_f32_16x16x32_bf16(kb1[x], vf1, Sb[tt], 0, 0, 0); }
          __builtin_amdgcn_sched_barrier(0);
      } }
}
template <int DK, bool GLA>
__device__ __forceinline__ void kv_units(Frame& F, const CMixArgs& a) {
    constexpr int NT = DK / 16;
    const int w = F.wave, lane0 = F.lane;
    int p = (int)blockIdx.x;
    if (p >= 1536) return;
    if (GLA) {
#pragma unroll 1
        for (int pp = p; pp < 1536; pp += F.G) gla_b_stage(F, a, pp);
        asm volatile("s_waitcnt vmcnt(0)" ::: "memory"); __syncthreads(); }
    KvRaw<GLA> RA, RB;
    kv_load<GLA>(RA, a, p, 0, w, lane0); kv_load<GLA>(RB, a, p, 1, w, lane0);
#pragma unroll 1
    for (; p < 1536; p += F.G) {
        const int sc = p >> 2, hh = p & 3, pnext = p + F.G;
        f32x4 Sf[NT], Sb[NT];
#pragma unroll
        for (int tt = 0; tt < NT; ++tt) { Sf[tt] = (f32x4){0.f, 0.f, 0.f, 0.f}; Sb[tt] = (f32x4){0.f, 0.f, 0.f, 0.f}; }
        kv_step<DK, GLA>(F, a, p, 0, pnext, RA, Sf, Sb); kv_step<DK, GLA>(F, a, p, 1, pnext, RB, Sf, Sb);
        kv_step<DK, GLA>(F, a, p, 2, pnext, RA, Sf, Sb); kv_step<DK, GLA>(F, a, p, 3, pnext, RB, Sf, Sb);
        const int lane = opaque_i(lane0);
#pragma unroll
        for (int dir = 0; dir < 2; ++dir) { unsigned char* sp = a.st + state_off(sc, GLA, hh, dir) + (size_t)(unsigned)(w * NT * 512 + lane * 8);
#pragma unroll
            for (int tt = 0; tt < NT; ++tt) { const f32x4 s = dir ? Sb[tt] : Sf[tt]; u32x2 pk; pk.x = cvtpk_c(s[0], s[1]); pk.y = cvtpk_c(s[2], s[3]); *(GAS u32x2*)(sp + tt * 512) = pk; } }
    }
}

constexpr int RD_SLOT = 32768;
__device__ __forceinline__ void ret_dma_block(Frame& F, const CMixArgs& a, int p, int kb, int slot) {
    const int lane = opaque_i(F.lane), w = F.wave, sc = p >> 2, hh = p & 3;
#pragma unroll
    for (int x = 0; x < 2; ++x) {
        const int r = 4 * (2 * w + x) + (lane >> 4), cp = lane & 15;
        const size_t row = (size_t)(sc * 256 + 64 * kb + r);
        const bf16* gk = a.proj + pg8::pl(pg8::PL_RK, hh, row, 128) + 8 * (cp ^ (r & 15));
        const bf16* gv = a.proj + pg8::pl(pg8::PL_RV, hh, row, 128) + 8 * (cp ^ (2 * (r & 7)));
        __builtin_amdgcn_global_load_lds((const unsigned*)gk, (LAS unsigned*)(F.lds + slot * RD_SLOT + (2 * w + x) * 1024), 16, 0, 0);
        __builtin_amdgcn_global_load_lds((const unsigned*)gv, (LAS unsigned*)(F.lds + slot * RD_SLOT + 16384 + (2 * w + x) * 1024), 16, 0, 0);
    }
}
__device__ __forceinline__ void tr_read16(const unsigned (&ad)[8], u32x2 (&r)[16]) {
    asm volatile("ds_read_b64_tr_b16 %0, %16\n\tds_read_b64_tr_b16 %1, %16 offset:4096\n\tds_read_b64_tr_b16 %2, %17\n\tds_read_b64_tr_b16 %3, %17 offset:4096\n\t"
                 "ds_read_b64_tr_b16 %4, %18\n\tds_read_b64_tr_b16 %5, %18 offset:4096\n\tds_read_b64_tr_b16 %6, %19\n\tds_read_b64_tr_b16 %7, %19 offset:4096\n\t"
                 "ds_read_b64_tr_b16 %8, %20\n\tds_read_b64_tr_b16 %9, %20 offset:4096\n\tds_read_b64_tr_b16 %10, %21\n\tds_read_b64_tr_b16 %11, %21 offset:4096\n\t"
                 "ds_read_b64_tr_b16 %12, %22\n\tds_read_b64_tr_b16 %13, %22 offset:4096\n\tds_read_b64_tr_b16 %14, %23\n\tds_read_b64_tr_b16 %15, %23 offset:4096\n\t"
                 "s_waitcnt lgkmcnt(0)"
                 : "=&v"(r[0]), "=&v"(r[1]), "=&v"(r[2]), "=&v"(r[3]), "=&v"(r[4]), "=&v"(r[5]), "=&v"(r[6]), "=&v"(r[7]),
                   "=&v"(r[8]), "=&v"(r[9]), "=&v"(r[10]), "=&v"(r[11]), "=&v"(r[12]), "=&v"(r[13]), "=&v"(r[14]), "=&v"(r[15])
                 : "v"(ad[0]), "v"(ad[1]), "v"(ad[2]), "v"(ad[3]), "v"(ad[4]), "v"(ad[5]), "v"(ad[6]), "v"(ad[7]) : "memory");
}
__device__ __forceinline__ void ret_block(Frame& F, const CMixArgs& a, int p, int kb, int slot, int pnext, const bf16x8 (&Qf)[2][4], f32x4 (&O)[8][2]) {
    LAS unsigned char* L = F.lds;
    const int w = F.wave, hh = p & 3;
    const float l2g = hh == 0 ? -0.045803689613124f : hh == 1 ? -0.022720076500083f : hh == 2 ? -0.011315313227834f : -0.005646563141142f;
    asm volatile("s_waitcnt vmcnt(4)" ::: "memory");
    __builtin_amdgcn_s_barrier();
    asm volatile("" ::: "memory");
    { const int kn = kb + 2, pn2 = kn < 4 ? p : (pnext < 1536 ? pnext : p); ret_dma_block(F, a, pn2, kn & 3, slot == 0 ? 2 : slot - 1); }
    LAS unsigned char* KB = L + slot * RD_SLOT; LAS unsigned char* VB = KB + 16384;
    const int lane = opaque_i(F.lane), g = lane >> 4, lr = lane & 15, q4 = lr >> 2, p4 = lr & 3;
    const int xk16 = (lr ^ (g >> 1)) << 4, xv16 = ((p4 >> 1) ^ (2 * ((4 * g + q4) & 7))) << 4;
#pragma unroll
    for (int sp = 0; sp < 2; ++sp) {
        f32x4 st[2][2];
#pragma unroll
        for (int h = 0; h < 2; ++h)
#pragma unroll
            for (int it = 0; it < 2; ++it) st[h][it] = (f32x4){0.f, 0.f, 0.f, 0.f};
        { bf16x8 kf[2][4];
#pragma unroll
          for (int s = 0; s < 4; ++s)
#pragma unroll
              for (int h = 0; h < 2; ++h) {
                  const LAS unsigned char* kp = KB + (32 * sp + 16 * h + lr) * 256 + 8 * (g & 1);
                  const u32x2 lo = *(const LAS u32x2*)(kp + ((64 * s) ^ xk16)), hi = *(const LAS u32x2*)(kp + ((64 * s + 32) ^ xk16));
                  kf[h][s] = __builtin_bit_cast(bf16x8, (v4u){lo.x, lo.y, hi.x, hi.y}); }
          __builtin_amdgcn_sched_barrier(0);
#pragma unroll
          for (int s = 0; s < 4; ++s)
#pragma unroll
              for (int h = 0; h < 2; ++h)
#pragma unroll
                  for (int it = 0; it < 2; ++it) st[h][it] = __builtin_amdgcn_mfma_f32_16x16x32_bf16(kf[h][s], Qf[it][s], st[h][it], 0, 0, 0);
          __builtin_amdgcn_sched_barrier(0); }
        bf16x8 pf[2];
#pragma unroll
        for (int it = 0; it < 2; ++it) {
            const int i = 32 * w + 16 * it + lr;
            unsigned pw[4];
#pragma unroll
            for (int h = 0; h < 2; ++h) { float e[4];
#pragma unroll
                for (int r = 0; r < 4; ++r) { const int j = 64 * kb + 32 * sp + 16 * h + 4 * g + r; const int d = i - j; e[r] = st[h][it][r] * __builtin_amdgcn_exp2f(l2g * (float)(d < 0 ? -d : d)); }
                pw[2 * h] = cvtpk_c(e[0], e[1]); pw[2 * h + 1] = cvtpk_c(e[2], e[3]); }
            pf[it] = __builtin_bit_cast(bf16x8, (v4u){pw[0], pw[1], pw[2], pw[3]});
        }
        { unsigned ad[8]; u32x2 vr[16];
          const unsigned vb0 = (unsigned)(size_t)(VB + (32 * sp + 4 * g + q4) * 256 + 8 * (p4 & 1));
#pragma unroll
          for (int dt = 0; dt < 8; ++dt) ad[dt] = vb0 + ((32 * dt) ^ xv16);
          tr_read16(ad, vr);
          __builtin_amdgcn_sched_barrier(0);
#pragma unroll
          for (int dt = 0; dt < 8; ++dt) { const bf16x8 vf = __builtin_bit_cast(bf16x8, (v4u){vr[2 * dt].x, vr[2 * dt].y, vr[2 * dt + 1].x, vr[2 * dt + 1].y});
#pragma unroll
              for (int it = 0; it < 2; ++it) O[dt][it] = __builtin_amdgcn_mfma_f32_16x16x32_bf16(vf, pf[it], O[dt][it], 0, 0, 0); }
          __builtin_amdgcn_sched_barrier(0); }
    }
}
__device__ __forceinline__ void ret_q_load(bf16x8 (&Qf)[2][4], const CMixArgs& a, int p, int w, int lane0) {
    const int lane = opaque_i(lane0), g = lane >> 4, lr = lane & 15, sc = p >> 2, hh = p & 3;
#pragma unroll
    for (int it = 0; it < 2; ++it) { const bf16* qp = a.proj + pg8::pl(pg8::PL_RQ, hh, (size_t)(sc * 256 + 32 * w + 16 * it + lr), 128) + 4 * g;
#pragma unroll
        for (int s = 0; s < 4; ++s) { const u32x2 lo = *(const GAS u32x2*)(qp + 32 * s), hi = *(const GAS u32x2*)(qp + 32 * s + 16); Qf[it][s] = __builtin_bit_cast(bf16x8, (v4u){lo.x, lo.y, hi.x, hi.y}); } }
}
__device__ __forceinline__ void ret_units_direct(Frame& F, const CMixArgs& a) {
    const int w = F.wave;
    int p = (int)blockIdx.x;
    if (p >= 1536) return;
    bf16x8 Qf[2][4];
    asm volatile("s_waitcnt vmcnt(0)" ::: "memory"); __syncthreads();
    ret_dma_block(F, a, p, 0, 0); ret_dma_block(F, a, p, 1, 1);
    int slot = 0;
    ret_q_load(Qf, a, p, w, F.lane);
#pragma unroll 1
    for (; p < 1536; p += F.G) {
        const int sc = p >> 2, hh = p & 3, pnext = p + F.G;
        const float l2g = hh == 0 ? -0.045803689613124f : hh == 1 ? -0.022720076500083f : hh == 2 ? -0.011315313227834f : -0.005646563141142f;
        f32x4 O[8][2];
#pragma unroll
        for (int dt = 0; dt < 8; ++dt)
#pragma unroll
            for (int it = 0; it < 2; ++it) O[dt][it] = (f32x4){0.f, 0.f, 0.f, 0.f};
#pragma unroll 1
        for (int kb = 0; kb < 4; ++kb) { ret_block(F, a, p, kb, slot, pnext, Qf, O); slot = slot == 2 ? 0 : slot + 1; }
        { const int lane = opaque_i(F.lane), lr = lane & 15;
          const unsigned char* sp0 = a.st + state_off(sc, false, hh, 0) + (size_t)(unsigned)(lane * 8);
          u32x2 cA[16], cB[16];
#define RD_CLOAD(dst, k_) do { const unsigned char* b_ = sp0 + ((k_) >> 2) * 32768 + 2 * ((k_) & 3) * 512; \
              _Pragma("unroll") for (int dt = 0; dt < 8; ++dt) { dst[2 * dt] = *(const GAS u32x2*)(b_ + dt * 4096); dst[2 * dt + 1] = *(const GAS u32x2*)(b_ + dt * 4096 + 512); } } while (0)
#define RD_CMMA(src, k_) do { const int dir_ = (k_) >> 2, s_ = (k_) & 3; bf16x8 qs[2]; \
              _Pragma("unroll") for (int it = 0; it < 2; ++it) { const int i = 32 * w + 16 * it + lr; const float f = __builtin_amdgcn_exp2f(l2g * (float)(dir_ ? 256 - i : i + 1)); \
                  const v4u qw = __builtin_bit_cast(v4u, Qf[it][s_]); v4u o_; \
                  _Pragma("unroll") for (int j = 0; j < 4; ++j) ((unsigned*)&o_)[j] = cvtpk_c(bflo(((const unsigned*)&qw)[j]) * f, bfhi(((const unsigned*)&qw)[j]) * f); \
                  qs[it] = __builtin_bit_cast(bf16x8, o_); } \
              _Pragma("unroll") for (int dt = 0; dt < 8; ++dt) { const bf16x8 cf = __builtin_bit_cast(bf16x8, (v4u){src[2 * dt].x, src[2 * dt].y, src[2 * dt + 1].x, src[2 * dt + 1].y}); \
                  _Pragma("unroll") for (int it = 0; it < 2; ++it) O[dt][it] = __builtin_amdgcn_mfma_f32_16x16x32_bf16(cf, qs[it], O[dt][it], 0, 0, 0); } } while (0)
          RD_CLOAD(cA, 0); RD_CLOAD(cB, 1);
          __builtin_amdgcn_sched_barrier(0);
#pragma unroll
          for (int k = 0; k < 8; k += 2) {
              RD_CMMA(cA, k); if (k + 2 < 8) RD_CLOAD(cA, k + 2);
              __builtin_amdgcn_sched_barrier(0);
              RD_CMMA(cB, k + 1); if (k + 3 < 8) RD_CLOAD(cB, k + 3);
              __builtin_amdgcn_sched_barrier(0);
          }
#undef RD_CLOAD
#undef RD_CMMA
        }
        ret_q_load(Qf, a, pnext < 1536 ? pnext : p, w, F.lane);
        { const int lane = opaque_i(F.lane), g = lane >> 4, lr = lane & 15;
          LAS unsigned char* T = F.lds + 3 * RD_SLOT + w * (16 * 272);
          f32x4 nw[4], nb[4];
#pragma unroll
          for (int k = 0; k < 4; ++k) { nw[k] = *(const GAS f32x4*)(a.rnw + 128 * hh + 16 * (lane & 7) + 4 * k); nb[k] = *(const GAS f32x4*)(a.rnb + 128 * hh + 16 * (lane & 7) + 4 * k); }
#pragma unroll
          for (int it = 0; it < 2; ++it) {
              v4u gt[2][2];
#pragma unroll
              for (int h = 0; h < 2; ++h) { const bf16* gp = a.proj + pg8::pl(pg8::PL_RG, hh, (size_t)(sc * 256 + 32 * w + 16 * it + 8 * h + (lane >> 3)), 128) + 16 * (lane & 7);
                  gt[h][0] = *(const GAS v4u*)gp; gt[h][1] = *(const GAS v4u*)(gp + 8); }
              float sm = 0.f;
#pragma unroll
              for (int dt = 0; dt < 8; ++dt) sm += (O[dt][it][0] + O[dt][it][1]) + (O[dt][it][2] + O[dt][it][3]);
              sm += __shfl_xor(sm, 16); sm += __shfl_xor(sm, 32);
              const float mu = sm * (1.0f / 128.0f); float ss = 0.f;
#pragma unroll
              for (int dt = 0; dt < 8; ++dt) { O[dt][it] = O[dt][it] - mu; ss += (O[dt][it][0] * O[dt][it][0] + O[dt][it][1] * O[dt][it][1]) + (O[dt][it][2] * O[dt][it][2] + O[dt][it][3] * O[dt][it][3]); }
              ss += __shfl_xor(ss, 16); ss += __shfl_xor(ss, 32);
              const float rs = __builtin_amdgcn_rsqf(ss * (1.0f / 128.0f) + EPS);
#pragma unroll
              for (int dt = 0; dt < 8; ++dt) { const f32x4 y = O[dt][it] * rs;
                  u32x2 pk; pk.x = cvtpk_c(y[0], y[1]); pk.y = cvtpk_c(y[2], y[3]);
                  *(LAS u32x2*)(T + lr * 272 + 32 * dt + 8 * g) = pk; }
              asm volatile("s_waitcnt lgkmcnt(0)" ::: "memory");
#pragma unroll
              for (int h = 0; h < 2; ++h) { const int rr = 8 * h + (lane >> 3);
                  const v4u y0 = *(const LAS v4u*)(T + rr * 272 + 32 * (lane & 7)), y1 = *(const LAS v4u*)(T + rr * 272 + 32 * (lane & 7) + 16);
                  unsigned ow[8];
#pragma unroll
                  for (int k = 0; k < 8; ++k) { const unsigned yw = k < 4 ? ((const unsigned*)&y0)[k] : ((const unsigned*)&y1)[k - 4], gw = k < 4 ? ((const unsigned*)&gt[h][0])[k] : ((const unsigned*)&gt[h][1])[k - 4];
                      const float g0 = bflo(gw), g1 = bfhi(gw);
                      ow[k] = cvtpk_c((bflo(yw) * nw[k >> 1][2 * (k & 1)] + nb[k >> 1][2 * (k & 1)]) * g0 * __builtin_amdgcn_rcpf(1.0f + __expf(-g0)), (bfhi(yw) * nw[k >> 1][2 * (k & 1) + 1] + nb[k >> 1][2 * (k & 1) + 1]) * g1 * __builtin_amdgcn_rcpf(1.0f + __expf(-g1))); }
                  bf16* op = a.mo + (size_t)(sc * 256 + 32 * w + 16 * it + rr) * a.mop + 512 + 128 * hh + 16 * (lane & 7);
                  *(GAS v4u*)op = (v4u){ow[0], ow[1], ow[2], ow[3]}; *(GAS v4u*)(op + 8) = (v4u){ow[4], ow[5], ow[6], ow[7]}; }
              asm volatile("s_waitcnt lgkmcnt(0)" ::: "memory");
          } }
    }
    asm volatile("s_waitcnt vmcnt(0)" ::: "memory"); __syncthreads();
}

template <bool WITH_O>
__device__ __forceinline__ void cmix_phase(Frame& F, const CMixArgs& a, int which = 3) {
    const bool swap = WITH_O && MIX_SWAP && (((int)blockIdx.x >> 3) & 1);
#pragma unroll 1
    for (int pass = 0; pass < 2; ++pass) {
        const bool gla = (pass == 0) != swap;
        if (gla) {
#if MIX_GLA
            if (which & 1) { if constexpr (WITH_O) mix_units<64, true, true>(F, a); else kv_units<64, true>(F, a);
            __syncthreads(); }
#endif
        } else {
#if MIX_RET
            if (which & 2) { if constexpr (WITH_O) ret_units_direct(F, a); else kv_units<128, false>(F, a);
            __syncthreads(); }
#endif
        }
    }
}
__device__ __forceinline__ void scan_phase(Frame& F, const CMixArgs& a) {
    const int nthreads = F.G * NWAVES * 64;
    for (int chain = (int)blockIdx.x * NWAVES * 64 + F.tid; chain < 34 * 49152; chain += nthreads) {
        const int sq = chain / 49152, cidx = chain % 49152;
        const int seq = sq < 2 ? 32 + sq : sq - 2;
        const int sc0 = seq < 32 ? seq * 8 : 256 + (seq - 32) * 64, ns = seq < 32 ? 8 : 64;
        const bool gla = cidx < 16384; const int c2 = gla ? cidx : cidx - 16384;
        const int hd = gla ? (c2 >> 11) : (c2 >> 12), v = gla ? (c2 & 2047) : (c2 & 4095), hh = hd >> 1, dir = hd & 1;
        if ((gla && !MIX_GLA) || (!gla && !MIX_RET)) continue;
        const int t0 = 16 * ((v >> 6) & 3) + 4 * ((v & 63) >> 4);
        const float gret = exp2f(256.0f * log2f(1.0f - exp2f(-5.0f - (float)hh)));
        f32x4 cst = {0.f, 0.f, 0.f, 0.f};
        for (int blk = 0; blk < ns; blk += 8) {
            u32x2 kv[8]; f32x4 d[8];
#pragma unroll
            for (int j = 0; j < 8; ++j) { const int n = dir ? ns - 1 - (blk + j) : blk + j;
                kv[j] = *(const GAS u32x2*)(a.st + state_off(sc0 + n, gla, hh, dir) + (size_t)v * 8);
                d[j] = gla ? *(const GAS f32x4*)(a.dec + (size_t)(((sc0 + n) * 4 + hh) * 2 + dir) * 64 + t0) : (f32x4){gret, gret, gret, gret}; }
#pragma unroll
            for (int j = 0; j < 8; ++j) { const int n = dir ? ns - 1 - (blk + j) : blk + j;
                u32x2 pk; pk.x = cvtpk_c(cst[0], cst[1]); pk.y = cvtpk_c(cst[2], cst[3]);
                *(GAS u32x2*)(a.sto + state_off(sc0 + n, gla, hh, dir) + (size_t)v * 8) = pk;
                cst = d[j] * cst + (f32x4){bflo(kv[j].x), bfhi(kv[j].x), bflo(kv[j].y), bfhi(kv[j].y)}; }
        }
    }
}

#ifndef W2_TILED
#define W2_TILED 1
#endif
#define NAIVE_MIX (!(MIX_GLA && MIX_RET))
constexpr int PB0 = NAIVE_MIX ? 8 : 5, NPH = PB0 + 4;
struct Args { const float* in[16]; float* out; unsigned char* ws; int ph_lo, ph_hi, use_bar, pad; };
__global__ void __launch_bounds__(NWAVES * 64, 2) fwd_kernel(Args args) {
    extern __shared__ __attribute__((aligned(16))) unsigned char lds[];
    Frame F;
    F.lds = (LAS unsigned char*)lds;
    F.MISC = (volatile LAS unsigned*)(F.lds + MISC_OFF);
    F.tid = threadIdx.x; F.lane = F.tid & 63; F.wave = __builtin_amdgcn_readfirstlane(F.tid >> 6);
    F.G = gridDim.x; { const int bx = blockIdx.x; F.vcu = (F.G % 8 == 0) ? (bx % 8) * (F.G / 8) + bx / 8 : bx; }
    unsigned char* ws = args.ws;
    gu32* ctl = (gu32*)(ws + WS_CTL);
    for (int u = F.tid; u < (LDS_BYTES - LDSCTL_OFF) / 4; u += NWAVES * 64) ((LAS unsigned*)(F.lds + LDSCTL_OFF))[u] = 0u;
    __syncthreads();
    XcdBarrier bar; bar.bar = (unsigned*)(ctl + CW_BAR); bar.x = 0; bar.st = nullptr;
    if (args.use_bar) bar = xcd_barrier_post((unsigned*)(ctl + CW_BAR), F.MISC + 8);
    const int lo = args.ph_lo, hi = args.ph_hi;
#define IN(k) (lo <= (k) && (k) < hi)
#define SEAM(k) do { if (IN(k) && IN((k) + 1)) xcd_barrier(bar); } while (0)
    if (IN(0)) { const P0Args pa{args.in[0], args.in[1], args.in[2], args.in[3], args.in[11], args.in[12], args.in[13], args.in[14], (bf16*)(ws + WS_WIN), (bf16*)(ws + WS_WOUT), (bf16*)(ws + WS_W1), (bf16*)(ws + WS_W2),
            (bf16*)(ws + WS_R0), (float*)(ws + WS_ROPE), (float*)(ws + WS_ROPE) + 16384 * 64, (float*)(ws + WS_GA), (float*)(ws + WS_RSTD)};
        p0_prologue(F, pa); __syncthreads();
#if REP0
        p0_prologue(F, pa, REP0); __syncthreads();
#endif
    }
    SEAM(0);
    if (IN(1)) { pg8::Gemm g{(bf16*)(ws + WS_R0), (bf16*)(ws + WS_WIN), M_TOK, NP, D, D}; pg8::StaticOrder S; S.init(M_TOK, NP, F.G, (int)blockIdx.x);
        pg8::EpiInProj E{(bf16*)(ws + WS_R1), (float*)(ws + WS_RSTD), (float*)(ws + WS_ROPE), (float*)(ws + WS_ROPE) + 16384 * 64};
#if REP1 == 2
        { pg8::EpiPlain E2{(bf16*)(ws + WS_R1)}; pg8::gemm_phase<pg8::EpiPlain, pg8::StaticOrder, true, true>(F.lds + RING_OFF, g, S, E2); } __syncthreads();
#elif REP1 == 3
        { pg8::EpiNull E2{}; pg8::gemm_phase<pg8::EpiNull, pg8::StaticOrder, true, true>(F.lds + RING_OFF, g, S, E2); } __syncthreads();
#endif
        pg8::gemm_phase<pg8::EpiInProj, pg8::StaticOrder, true, true>(F.lds + RING_OFF, g, S, E);
#if REP1 == 1
        __syncthreads(); pg8::gemm_phase<pg8::EpiInProj, pg8::StaticOrder, true, true>(F.lds + RING_OFF, g, S, E);
#endif
    }
    SEAM(1);
    if (IN(2)) { const CMixArgs ca{(bf16*)(ws + WS_R1), (float*)(ws + WS_GA), args.in[4], args.in[5], args.in[6], args.in[7], ws + WS_ST, (float*)(ws + WS_DEC), args.in[8], args.in[9], args.in[10], (bf16*)((unsigned char*)args.out + (size_t)192 * MiB), D, ws + WS_ST, (unsigned char*)args.out, (bh16*)((unsigned char*)args.out + (size_t)96 * MiB), (bh16*)args.out, (float*)(ws + WS_DEC + 786432)};
        cmix_phase<false>(F, ca);
#if REP2
        cmix_phase<false>(F, ca, REP2);
#endif
    }
    SEAM(2);
    if (IN(3)) { const CMixArgs ca{(bf16*)(ws + WS_R1), (float*)(ws + WS_GA), args.in[4], args.in[5], args.in[6], args.in[7], ws + WS_ST, (float*)(ws + WS_DEC), args.in[8], args.in[9], args.in[10], (bf16*)((unsigned char*)args.out + (size_t)192 * MiB), D, ws + WS_ST, (unsigned char*)args.out, (bh16*)((unsigned char*)args.out + (size_t)96 * MiB), (bh16*)args.out, (float*)(ws + WS_DEC + 786432)};
#if REP3
        { CMixArgs cb = ca; cb.sto = (unsigned char*)args.out + (size_t)224 * MiB; scan_phase(F, cb); }
#endif
        scan_phase(F, ca); }
    SEAM(3);
    if (IN(4)) { const CMixArgs ca{(bf16*)(ws + WS_R1), (float*)(ws + WS_GA), args.in[4], args.in[5], args.in[6], args.in[7], ws + WS_ST, (float*)(ws + WS_DEC), args.in[8], args.in[9], args.in[10], (bf16*)((unsigned char*)args.out + (size_t)192 * MiB), D, ws + WS_ST, (unsigned char*)args.out, (bh16*)((unsigned char*)args.out + (size_t)96 * MiB), (bh16*)args.out, (float*)(ws + WS_DEC + 786432)};
#if REP4
        { CMixArgs cb = ca; cmix_phase<true>(F, cb, REP4); }
#endif
        cmix_phase<true>(F, ca); }
    SEAM(4);
#if NAIVE_MIX
    { const MixArgs ma{(bf16*)(ws + WS_R1), (float*)(ws + WS_GA), args.in[4], args.in[5], args.in[6], args.in[7], args.out, args.in[8], args.in[9], args.in[10]};
    if (IN(5)) { naive_mix_phase<false>(F, ma); __syncthreads(); }
    SEAM(5);
    if (IN(6)) { naive_mix_phase<true>(F, ma); __syncthreads(); }
    SEAM(6);
    if (IN(7)) { naive_combine(F, ma); }
    SEAM(7); }
#endif
    if (IN(PB0)) { pg8::Gemm g{(bf16*)((unsigned char*)args.out + (size_t)192 * MiB), (bf16*)(ws + WS_WOUT), M_TOK, D, D, D}; pg8::StaticOrder S; S.init(M_TOK, D, F.G, (int)blockIdx.x);
        pg8::EpiResidB2 E{(const bf16*)(ws + WS_R0), (bf16*)(ws + WS_A2), (float*)(ws + WS_SQ1)};
        pg8::gemm_phase<pg8::EpiResidB2, pg8::StaticOrder, true, true>(F.lds + RING_OFF, g, S, E);
#if REP5
        __syncthreads(); pg8::gemm_phase<pg8::EpiResidB2, pg8::StaticOrder, true, true>(F.lds + RING_OFF, g, S, E);
#endif
    }
    SEAM(PB0);
    if (IN(PB0 + 1)) {
        { const float* sq = (const float*)(ws + WS_SQ1); float* r2v = (float*)(ws + WS_RSTD);
          for (int row = (int)blockIdx.x * NWAVES * 64 + F.tid; row < M_TOK; row += F.G * NWAVES * 64) { const f32x4* s4 = (const f32x4*)(sq + (size_t)row * 16);
              const f32x4 t = (s4[0] + s4[1]) + (s4[2] + s4[3]); r2v[row] = 1.0f / (((t[0] + t[1]) + (t[2] + t[3])) * (1.0f / 1024.0f) + EPS); }
          if (args.use_bar) xcd_barrier(bar); }
        pg8::Gemm g{(bf16*)(ws + WS_A2), (bf16*)(ws + WS_W1), M_TOK, FF, D, D}; pg8::StaticOrder S; S.init(M_TOK, FF, F.G, (int)blockIdx.x);
        pg8::EpiFF1 E{(bf16*)(ws + WS_R1), (float*)(ws + WS_RSTD)};
        pg8::gemm_phase<pg8::EpiFF1, pg8::StaticOrder, true, true>(F.lds + RING_OFF, g, S, E);
#if REP6
        __syncthreads(); pg8::gemm_phase<pg8::EpiFF1, pg8::StaticOrder, true, true>(F.lds + RING_OFF, g, S, E);
#endif
    }
    SEAM(PB0 + 1);
#if H_TILED
    if (IN(PB0 + 2)) { pg8::Gemm g{(bf16*)(ws + WS_R1), (bf16*)(ws + WS_W2), M_TOK, D, FF, 64, W2_TILED ? 64 : 0, 32768, W2_TILED ? 32768 : 0, (long)FF * 512, W2_TILED ? (long)FF * 512 : 0};
#else
    if (IN(PB0 + 2)) { pg8::Gemm g{(bf16*)(ws + WS_R1), (bf16*)(ws + WS_W2), M_TOK, D, FF, FF, W2_TILED ? 64 : 0, 0, W2_TILED ? 32768 : 0, 0, W2_TILED ? (long)FF * 512 : 0};
#endif
        pg8::StaticOrder S; S.init(M_TOK, D, F.G, (int)blockIdx.x, FF2_REV);
        pg8::EpiResidB E{(bf16*)(ws + WS_A2), (float*)(ws + WS_SQ2)};
        pg8::gemm_phase<pg8::EpiResidB, pg8::StaticOrder, true, true, false, FF2_TOUCH>(F.lds + RING_OFF, g, S, E); }
    SEAM(PB0 + 2);
    if (IN(PB0 + 3)) { final_norm(F, args.out, (const bf16*)(ws + WS_A2), (float*)(ws + WS_SQ2), args.in[15]);
#if REP8
        final_norm(F, args.out, (const bf16*)(ws + WS_A2), (float*)(ws + WS_SQ2), args.in[15]);
#endif
    }
#undef IN
#undef SEAM
}

extern "C" void kernel_launch(void* const* d_in, const int* in_sizes, int n_in, void* d_out, int out_size, void* d_ws, size_t ws_size, hipStream_t stream) {
    static int grid = 0;
    if (grid == 0) {
        if (n_in != 16 || in_sizes[0] != M_PROMPT * D || out_size != M_TOK * D || ws_size < WS_END) {
            fprintf(stderr, "kernel_launch: unexpected shapes (n_in %d, in0 %d, out %d, ws %zu); nothing launched\n", n_in, n_in > 0 ? in_sizes[0] : -1, out_size, ws_size); grid = -1; return; }
        int dev = 0, cus = 0, per_cu = 0;
        if (hipGetDevice(&dev) != hipSuccess || hipDeviceGetAttribute(&cus, hipDeviceAttributeMultiprocessorCount, dev) != hipSuccess) { grid = -1; return; }
        if (hipFuncSetAttribute((const void*)fwd_kernel, hipFuncAttributeMaxDynamicSharedMemorySize, LDS_BYTES) != hipSuccess) { fprintf(stderr, "kernel_launch: hipFuncSetAttribute failed\n"); grid = -1; return; }
        if (hipOccupancyMaxActiveBlocksPerMultiprocessor(&per_cu, (const void*)fwd_kernel, NWAVES * 64, LDS_BYTES) != hipSuccess || per_cu < 1)
            fprintf(stderr, "kernel_launch: note: occupancy query reports %d workgroups per CU\n", per_cu);
        (void)hipGetLastError();
        grid = cus;
    }
    if (grid < 0) return;
    if (hipMemsetAsync((char*)d_ws + WS_CTL, 0, CTL_ZERO_BYTES, stream) != hipSuccess) return;
    Args a{};
    for (int i = 0; i < 16; ++i) a.in[i] = (const float*)d_in[i];
    a.out = (float*)d_out; a.ws = (unsigned char*)d_ws;
#if MK_SINGLE
    a.ph_lo = 0; a.ph_hi = NPH; a.use_bar = 1;
    hipLaunchKernelGGL(fwd_kernel, dim3(grid), dim3(NWAVES * 64), LDS_BYTES, stream, a);
#else
    for (int p = 0; p < NPH; ++p) { a.ph_lo = p; a.ph_hi = p + 1; a.use_bar = 0;
        hipLaunchKernelGGL(fwd_kernel, dim3(grid), dim3(NWAVES * 64), LDS_BYTES, stream, a); }
#endif
}
```
